# Optimizing an MI355X kernel written in HIP

```python
import math
import jax, jax.numpy as jnp
from jax import lax
import numpy as np

D_MODEL = 1024
BATCH = 8
SEQ = 2048
DEPTH = 1

MLA_HEADS = 8
MLA_NOPE = 64
MLA_ROPE = 32
MLA_V = 64
MLA_QK = MLA_NOPE + MLA_ROPE
MLA_Q_RANK = 384
MLA_KV_RANK = 256
ROPE_THETA = 10000.0
NSA_HEADS = 8
NSA_KV_HEADS = 2
NSA_GROUP = NSA_HEADS // NSA_KV_HEADS
NSA_HEAD_DIM = 64
N_BRANCH = 3
CMP_BLOCK = 32
CMP_STRIDE = 16
CMP_HIDDEN = 128
SEL_BLOCK = 64
SEL_TOP_N = 16
WINDOW = 512
FORCE_SCORE = 1e4
REL_BUCKETS = 32
REL_MAX_DIST = 128
D_FF = 4 * D_MODEL
Q_BLOCK = 128
SEL_Q_BLOCK = 64
EPS = 1e-6

MLA_OUT = MLA_HEADS * MLA_V
NSA_OUT = NSA_HEADS * NSA_HEAD_DIM
MIX_WIDTH = MLA_OUT + NSA_OUT
IN_SPLIT_SIZES = (MLA_Q_RANK, MLA_KV_RANK, MLA_ROPE, NSA_HEADS * NSA_HEAD_DIM,
                  2 * N_BRANCH * NSA_KV_HEADS * NSA_HEAD_DIM, N_BRANCH * NSA_HEADS)
D_IN = sum(IN_SPLIT_SIZES)

kernel_name = "hymba_mla_nsa_hybrid_block"


def rms_norm(x, g):
    xf = x.astype(jnp.float32)
    y = xf * lax.rsqrt(jnp.mean(xf * xf, axis=-1, keepdims=True) + EPS)
    return (y * g.astype(jnp.float32)).astype(x.dtype)


def rope(x, pos):
    half = x.shape[-1] // 2
    inv = 1.0 / (ROPE_THETA ** (jnp.arange(half, dtype=jnp.float32) / half))
    ang = pos.astype(jnp.float32)[:, None] * inv[None, :]
    cos = jnp.cos(ang)[None, :, None, :]
    sin = jnp.sin(ang)[None, :, None, :]
    xf = x.astype(jnp.float32)
    x1, x2 = xf[..., :half], xf[..., half:]
    return jnp.concatenate([x1 * cos - x2 * sin, x2 * cos + x1 * sin], axis=-1).astype(x.dtype)


def t5_bucket(dist):
    n = jnp.maximum(dist, 0)
    max_exact = REL_BUCKETS // 2
    large = max_exact + (jnp.log(jnp.maximum(n, 1).astype(jnp.float32) / max_exact)
                         / math.log(REL_MAX_DIST / max_exact)
                         * (REL_BUCKETS - max_exact)).astype(jnp.int32)
    large = jnp.minimum(large, REL_BUCKETS - 1)
    return jnp.where(n < max_exact, n, large)


def masked_softmax(s, mask):
    s = jnp.where(mask, s.astype(jnp.float32), -jnp.inf)
    m = jnp.max(s, axis=-1, keepdims=True)
    m = jnp.where(jnp.isfinite(m), m, 0.0)
    p = jnp.exp(s - m)
    return p / jnp.maximum(jnp.sum(p, axis=-1, keepdims=True), 1e-30)


def mla_mixer(h_q, h_kv, h_kr, cq_g, ckv_g, w_uq, w_ukv, q_gain, k_gain):
    B, S, _ = h_q.shape
    pos = jnp.arange(S)
    q = (rms_norm(h_q, cq_g) @ w_uq).reshape(B, S, MLA_HEADS, MLA_QK)
    kv = (rms_norm(h_kv, ckv_g) @ w_ukv).reshape(B, S, MLA_HEADS, MLA_NOPE + MLA_V)
    k_nope, v = kv[..., :MLA_NOPE], kv[..., MLA_NOPE:]
    k_r = jnp.broadcast_to(h_kr[:, :, None, :], (B, S, MLA_HEADS, MLA_ROPE))
    k = jnp.concatenate([k_nope, k_r], axis=-1)
    q = rms_norm(q, q_gain)
    k = rms_norm(k, k_gain)
    q = jnp.concatenate([q[..., :MLA_NOPE], rope(q[..., MLA_NOPE:], pos)], axis=-1)
    k = jnp.concatenate([k[..., :MLA_NOPE], rope(k[..., MLA_NOPE:], pos)], axis=-1)
    scale = MLA_QK ** -0.5
    nb = S // Q_BLOCK
    qb = q.reshape(B, nb, Q_BLOCK, MLA_HEADS, MLA_QK).transpose(1, 0, 2, 3, 4)

    def block(args):
        qi, i = args
        s = jnp.einsum('bqhd,bkhd->bhqk', qi, k).astype(jnp.float32) * scale
        qpos = i * Q_BLOCK + jnp.arange(Q_BLOCK)
        p = masked_softmax(s, pos[None, :] <= qpos[:, None])
        return jnp.einsum('bhqk,bkhd->bqhd', p.astype(v.dtype), v)

    o = lax.map(block, (qb, jnp.arange(nb)))
    return o.transpose(1, 0, 2, 3, 4).reshape(B, S, MLA_OUT)


def nsa_mixer(q_in, kv_in, gate_logits, q_gain, k_gain, cmp_pe, cmp_w1, cmp_w2, rel_bias):
    B, S, _ = q_in.shape
    H, G, R, Dh = NSA_HEADS, NSA_KV_HEADS, NSA_GROUP, NSA_HEAD_DIM
    pos = jnp.arange(S)
    scale = Dh ** -0.5
    qg = rms_norm(q_in.reshape(B, S, H, Dh), q_gain).reshape(B, S, G, R, Dh)
    kv = kv_in.reshape(B, S, N_BRANCH, 2, G, Dh)

    n_chunk = S // CMP_STRIDE
    n_cmp = n_chunk - 1

    def compress(t, pe, w1, w2):
        c = t.reshape(B, n_chunk, CMP_STRIDE, G, Dh)
        blocks = jnp.concatenate([c[:, :-1], c[:, 1:]], axis=2)
        blocks = blocks + pe[None, None, :, None, :]
        flat = blocks.transpose(0, 1, 3, 2, 4).reshape(B, n_cmp, G, CMP_BLOCK * Dh)
        return jax.nn.silu(flat @ w1) @ w2

    k_cmp = rms_norm(compress(kv[:, :, 0, 0], cmp_pe[0], cmp_w1[0], cmp_w2[0]), k_gain[0])
    v_cmp = compress(kv[:, :, 0, 1], cmp_pe[1], cmp_w1[1], cmp_w2[1])
    cmp_start = jnp.arange(n_cmp) * CMP_STRIDE
    dist_c = pos[:, None] - (cmp_start + CMP_BLOCK - 1)[None, :]
    bias_c = rel_bias[t5_bucket(dist_c)].reshape(S, n_cmp, G, R).transpose(2, 3, 0, 1)
    s_c = jnp.einsum('bsgrd,bcgd->bgrsc', qg, k_cmp).astype(jnp.float32) * scale + bias_c
    p_c = masked_softmax(s_c, dist_c >= 0)
    o_cmp = jnp.einsum('bgrsc,bcgd->bsgrd', p_c.astype(v_cmp.dtype), v_cmp)

    n_sel = S // SEL_BLOCK
    sel_start = jnp.arange(n_sel) * SEL_BLOCK
    overlap = jnp.clip(jnp.minimum(cmp_start[:, None] + CMP_BLOCK, sel_start[None, :] + SEL_BLOCK)
                       - jnp.maximum(cmp_start[:, None], sel_start[None, :]), 0, None)
    overlap = overlap.astype(jnp.float32) / CMP_BLOCK
    imp = jnp.einsum('bgrsc,cj->bgsj', p_c, overlap)
    blk_t = pos // SEL_BLOCK
    j = jnp.arange(n_sel)[None, :]
    valid = j <= blk_t[:, None]
    forced = valid & ((j == 0) | (j == blk_t[:, None]) | (j == blk_t[:, None] - 1))
    score = jnp.where(forced, FORCE_SCORE, jnp.where(valid, imp, -jnp.inf))
    n_top = min(SEL_TOP_N, n_sel)
    _, sel_idx = lax.top_k(score, n_top)

    k_sel = rms_norm(kv[:, :, 1, 0], k_gain[1])
    v_sel = kv[:, :, 1, 1]
    ksb = k_sel.reshape(B, n_sel, SEL_BLOCK, G, Dh).transpose(0, 3, 1, 2, 4)
    vsb = v_sel.reshape(B, n_sel, SEL_BLOCK, G, Dh).transpose(0, 3, 1, 2, 4)
    table_g = rel_bias.reshape(REL_BUCKETS, G, R).transpose(1, 0, 2)
    n_qc = S // SEL_Q_BLOCK
    q_c = qg.reshape(B, n_qc, SEL_Q_BLOCK, G, R, Dh).transpose(1, 0, 2, 3, 4, 5)
    idx_c = sel_idx.reshape(B, G, n_qc, SEL_Q_BLOCK, n_top).transpose(2, 0, 1, 3, 4)
    pos_c = pos.reshape(n_qc, SEL_Q_BLOCK)
    bi = jnp.arange(B)[:, None, None, None]
    gi = jnp.arange(G)[None, :, None, None]
    m_sel = n_top * SEL_BLOCK

    def sel_block(args):
        qi, idx, qpos = args
        kb = ksb[bi, gi, idx]
        vb = vsb[bi, gi, idx].reshape(B, G, SEL_Q_BLOCK, m_sel, Dh)
        key_pos = idx[..., None] * SEL_BLOCK + jnp.arange(SEL_BLOCK)
        dist = qpos[None, None, :, None, None] - key_pos
        bias = table_g[gi[..., None], t5_bucket(dist)]
        s = jnp.einsum('bqgrd,bgqnkd->bgrqnk', qi, kb).astype(jnp.float32) * scale \
            + jnp.moveaxis(bias, -1, 2)
        s = s.reshape(B, G, R, SEL_Q_BLOCK, m_sel)
        mask = (dist >= 0).reshape(B, G, 1, SEL_Q_BLOCK, m_sel)
        p = masked_softmax(s, mask)
        return jnp.einsum('bgrqm,bgqmd->bqgrd', p.astype(vb.dtype), vb)

    o_sel = lax.map(sel_block, (q_c, idx_c, pos_c))
    o_sel = o_sel.transpose(1, 0, 2, 3, 4, 5).reshape(B, S, G, R, Dh)

    k_win = rms_norm(kv[:, :, 2, 0], k_gain[2])
    v_win = kv[:, :, 2, 1]
    kp = jnp.pad(k_win, ((0, 0), (WINDOW, 0), (0, 0), (0, 0)))
    vp = jnp.pad(v_win, ((0, 0), (WINDOW, 0), (0, 0), (0, 0)))
    span = Q_BLOCK + WINDOW
    n_wb = S // Q_BLOCK
    off = WINDOW + jnp.arange(Q_BLOCK)[:, None] - jnp.arange(span)[None, :]
    band = (off >= 0) & (off < WINDOW)
    bias_w = rel_bias[t5_bucket(off)].reshape(Q_BLOCK, span, G, R).transpose(2, 3, 0, 1)
    q_w = qg.reshape(B, n_wb, Q_BLOCK, G, R, Dh).transpose(1, 0, 2, 3, 4, 5)

    def win_block(args):
        qi, i = args
        start = i * Q_BLOCK
        kb = lax.dynamic_slice_in_dim(kp, start, span, axis=1)
        vb = lax.dynamic_slice_in_dim(vp, start, span, axis=1)
        key_pos = start - WINDOW + jnp.arange(span)
        mask = band & (key_pos >= 0)[None, :]
        s = jnp.einsum('bqgrd,bkgd->bgrqk', qi, kb).astype(jnp.float32) * scale + bias_w
        p = masked_softmax(s, mask)
        return jnp.einsum('bgrqk,bkgd->bqgrd', p.astype(vb.dtype), vb)

    o_win = lax.map(win_block, (q_w, jnp.arange(n_wb)))
    o_win = o_win.transpose(1, 0, 2, 3, 4, 5).reshape(B, S, G, R, Dh)

    g = jax.nn.sigmoid(gate_logits.astype(jnp.float32)).reshape(B, S, N_BRANCH, G, R, 1)
    o = g[:, :, 0] * o_cmp + g[:, :, 1] * o_sel + g[:, :, 2] * o_win
    return o.astype(q_in.dtype).reshape(B, S, NSA_OUT)


def setup_inputs(seed: int = 0) -> dict:
    key = jax.random.key(seed)
    ks = jax.random.split(key, 21)
    L = DEPTH

    def nrm(k, shape, scale):
        return jax.random.normal(k, shape, jnp.float32) * scale

    def gain(k, shape):
        return 1.0 + 0.01 * jax.random.normal(k, shape, jnp.float32)

    return {
        "x": nrm(ks[0], (BATCH, SEQ, D_MODEL), 1.0),
        "ln1_g": gain(ks[1], (L, D_MODEL)),
        "w_in": nrm(ks[2], (L, D_MODEL, D_IN), D_MODEL ** -0.5),
        "mla_cq_norm_g": gain(ks[3], (L, MLA_Q_RANK)),
        "mla_ckv_norm_g": gain(ks[4], (L, MLA_KV_RANK)),
        "mla_w_uq": nrm(ks[5], (L, MLA_Q_RANK, MLA_HEADS * MLA_QK), MLA_Q_RANK ** -0.5),
        "mla_w_ukv": nrm(ks[6], (L, MLA_KV_RANK, MLA_HEADS * (MLA_NOPE + MLA_V)), MLA_KV_RANK ** -0.5),
        "mla_q_gain": gain(ks[7], (L, MLA_QK)),
        "mla_k_gain": gain(ks[8], (L, MLA_QK)),
        "nsa_q_gain": gain(ks[9], (L, NSA_HEAD_DIM)),
        "nsa_k_gain": gain(ks[10], (L, N_BRANCH, NSA_HEAD_DIM)),
        "nsa_cmp_pe": nrm(ks[11], (L, 2, CMP_BLOCK, NSA_HEAD_DIM), 0.1),
        "nsa_cmp_w1": nrm(ks[12], (L, 2, CMP_BLOCK * NSA_HEAD_DIM, CMP_HIDDEN), (CMP_BLOCK * NSA_HEAD_DIM) ** -0.5),
        "nsa_cmp_w2": nrm(ks[13], (L, 2, CMP_HIDDEN, NSA_HEAD_DIM), CMP_HIDDEN ** -0.5),
        "rel_bias": nrm(ks[14], (REL_BUCKETS, NSA_HEADS), 0.5),
        "grp_norm_mla": gain(ks[15], (L, MLA_OUT)),
        "grp_norm_nsa": gain(ks[16], (L, NSA_OUT)),
        "w_o": nrm(ks[17], (L, MIX_WIDTH, D_MODEL), MIX_WIDTH ** -0.5),
        "ln2_g": gain(ks[18], (L, D_MODEL)),
        "w_up": nrm(ks[19], (L, D_MODEL, D_FF), D_MODEL ** -0.5),
        "w_down": nrm(ks[20], (L, D_FF, D_MODEL), D_FF ** -0.5),
    }


def reference(x, ln1_g, w_in, mla_cq_norm_g, mla_ckv_norm_g, mla_w_uq, mla_w_ukv, mla_q_gain,
              mla_k_gain, nsa_q_gain, nsa_k_gain, nsa_cmp_pe, nsa_cmp_w1, nsa_cmp_w2, rel_bias,
              grp_norm_mla, grp_norm_nsa, w_o, ln2_g, w_up, w_down):
    offsets = []
    acc = 0
    for size in IN_SPLIT_SIZES[:-1]:
        acc += size
        offsets.append(acc)
    for l in range(DEPTH):
        h = rms_norm(x, ln1_g[l])
        proj = h @ w_in[l]
        h_q, h_kv, h_kr, q_b, kv_b, gate_b = jnp.split(proj, offsets, axis=-1)
        o_a = mla_mixer(h_q, h_kv, h_kr, mla_cq_norm_g[l], mla_ckv_norm_g[l], mla_w_uq[l],
                        mla_w_ukv[l], mla_q_gain[l], mla_k_gain[l])
        o_b = nsa_mixer(q_b, kv_b, gate_b, nsa_q_gain[l], nsa_k_gain[l], nsa_cmp_pe[l],
                        nsa_cmp_w1[l], nsa_cmp_w2[l], rel_bias)
        mix = jnp.concatenate([rms_norm(o_a, grp_norm_mla[l]), rms_norm(o_b, grp_norm_nsa[l])], axis=-1)
        x = x + mix @ w_o[l]
        h2 = rms_norm(x, ln2_g[l])
        x = x + jnp.square(jax.nn.relu(h2 @ w_up[l])) @ w_down[l]
    return x
```

```cpp
#include <hip/hip_runtime.h>
#include <hip/hip_cooperative_groups.h>
#include <cstdio>
#include <cstdint>
namespace cg = cooperative_groups;

#define LAS __attribute__((address_space(3)))
typedef unsigned short bf16_t;
typedef short bf16x8 __attribute__((ext_vector_type(8)));
typedef float f32x4 __attribute__((ext_vector_type(4)));
typedef unsigned u32x4 __attribute__((ext_vector_type(4)));
typedef unsigned u32x2 __attribute__((ext_vector_type(2)));

constexpr int BATCH = 8, SEQ = 2048, DM = 1024, M = BATCH * SEQ;
constexpr int DIN = 1976, DINP = 2048;
constexpr int C_HQ = 0, C_HKV = 384, C_HKR = 640, C_QB = 672, C_KVB = 1184, C_GATE = 1952;
constexpr int C_KCMP = C_KVB, C_VCMP = C_KVB + 128, C_KSEL = C_KVB + 256, C_VSEL = C_KVB + 384, C_KWIN = C_KVB + 512, C_VWIN = C_KVB + 640;
constexpr int QR = 384, KVR = 256, MQ = 768, MKV = 1024, FF = 4096;
constexpr int NCMP = 127;
constexpr float EPS = 1e-6f;
constexpr float LOG2E = 1.4426950408889634f;
constexpr float QS_MLA = 0.10206207261596577f * LOG2E;
constexpr float QS_NSA = 0.125f * LOG2E;

constexpr size_t MiB = 1u << 20;
constexpr size_t WS_WIN = 1 * MiB, WS_WUQ = 5 * MiB, WS_WUKV = 6 * MiB, WS_WO = 7 * MiB, WS_WUP = 9 * MiB, WS_WDN = 17 * MiB;
constexpr size_t WS_KCMP = 26 * MiB, WS_VCMP = 26 * MiB + 512 * 1024;
constexpr size_t WS_HB = 32 * MiB;
constexpr size_t WS_MIX = 32 * MiB;
constexpr size_t WS_PROJ = 64 * MiB;
constexpr size_t WS_QM = 128 * MiB;
constexpr size_t WS_KVM = 152 * MiB;
constexpr size_t WS_KMLA = 184 * MiB;
constexpr size_t WS_QN = 208 * MiB;
constexpr size_t WS_KSEL = 224 * MiB;
constexpr size_t WS_KWIN = 228 * MiB;
constexpr size_t WS_HQN = 232 * MiB;
constexpr size_t WS_HKVN = 244 * MiB;
constexpr size_t WS_H2 = 192 * MiB;
constexpr size_t WS_HID = 64 * MiB;

constexpr int LDS_BYTES = 147456;
constexpr int NW = 8;

struct Params {
    const float* in[21];
    float* out;
    unsigned char* ws;
};

__device__ __forceinline__ unsigned f2bf(float f) { unsigned u = __builtin_bit_cast(unsigned, f); return (u + 0x7fffu + ((u >> 16) & 1u)) >> 16; }
__device__ __forceinline__ float bf2f(unsigned b) { return __builtin_bit_cast(float, b << 16); }
__device__ __forceinline__ unsigned pk2(float lo, float hi) { return f2bf(lo) | (f2bf(hi) << 16); }
__device__ __forceinline__ float wave_sum(float v) {
#pragma unroll
    for (int o = 1; o < 64; o <<= 1) v += __shfl_xor(v, o);
    return v;
}
__device__ __forceinline__ float wave_max(float v) {
#pragma unroll
    for (int o = 1; o < 64; o <<= 1) v = fmaxf(v, __shfl_xor(v, o));
    return v;
}
__device__ __forceinline__ int t5_bucket(int n) {
    if (n < 16) return n;
    int b = 16;
    b += (n >= 19); b += (n >= 21); b += (n >= 24); b += (n >= 27); b += (n >= 31); b += (n >= 35); b += (n >= 40); b += (n >= 46);
    b += (n >= 52); b += (n >= 59); b += (n >= 67); b += (n >= 77); b += (n >= 87); b += (n >= 99); b += (n >= 113);
    return b;
}

__device__ __forceinline__ void p0_transpose_item(const float* W, int K, int N, int Npad, bf16_t* WT, LAS float* scr, int item, int lane) {
    const int nblk = Npad / 32, kb = item / nblk, nb = item % nblk, k0 = 64 * kb, n0 = 32 * nb;
    const int nn = n0 + (lane & 31);
#pragma unroll 8
    for (int i = 0; i < 32; ++i) { const int kk = 2 * i + (lane >> 5); scr[kk * 33 + (lane & 31)] = (nn < N) ? W[(size_t)(k0 + kk) * N + nn] : 0.f; }
    asm volatile("s_waitcnt lgkmcnt(0)" ::: "memory");
    const int c = lane & 7;
#pragma unroll
    for (int j = 0; j < 4; ++j) { const int n = (lane >> 3) + 8 * j; const LAS float* s = scr + (8 * c) * 33 + n;
        u32x4 o; o.x = pk2(s[0 * 33], s[1 * 33]); o.y = pk2(s[2 * 33], s[3 * 33]); o.z = pk2(s[4 * 33], s[5 * 33]); o.w = pk2(s[6 * 33], s[7 * 33]);
        *(u32x4*)(WT + (size_t)(n0 + n) * K + k0 + 8 * c) = o; }
    asm volatile("s_waitcnt lgkmcnt(0)" ::: "memory");
}
__device__ __forceinline__ void rms_row_to_bf16(const float* xrow, const float* g, bf16_t* orow, int lane) {
    const f32x4* xr = (const f32x4*)xrow + lane; const f32x4* gr = (const f32x4*)g + lane;
    f32x4 v[4]; float s = 0.f;
#pragma unroll
    for (int j = 0; j < 4; ++j) { v[j] = xr[64 * j]; s += (v[j].x * v[j].x + v[j].y * v[j].y) + (v[j].z * v[j].z + v[j].w * v[j].w); }
    const float rstd = 1.f / sqrtf(wave_sum(s) * (1.f / DM) + EPS);
    unsigned long long* o8 = (unsigned long long*)orow + lane;
#pragma unroll
    for (int j = 0; j < 4; ++j) { const f32x4 gg = gr[64 * j];
        o8[64 * j] = (unsigned long long)pk2(v[j].x * rstd * gg.x, v[j].y * rstd * gg.y) | ((unsigned long long)pk2(v[j].z * rstd * gg.z, v[j].w * rstd * gg.w) << 32); }
}

template <class Epi>
__device__ __forceinline__ void gemm_simple(const bf16_t* A, int lda, const bf16_t* Bt, int ldb, int Mr, int N, int K, const Epi& epi, int gw, int NGW, int lane) {
    const int tn_cnt = N / 64, ntiles = (Mr / 64) * tn_cnt;
    const int fr = lane & 15, fq = lane >> 4;
    for (int tile = gw; tile < ntiles; tile += NGW) {
        const int tm = tile / tn_cnt, tn = tile % tn_cnt;
        f32x4 acc[4][4];
#pragma unroll
        for (int m = 0; m < 4; ++m)
#pragma unroll
            for (int n = 0; n < 4; ++n) acc[m][n] = (f32x4){0.f, 0.f, 0.f, 0.f};
        const bf16_t* ap = A + (size_t)(tm * 64 + fr) * lda + fq * 8;
        const bf16_t* bp = Bt + (size_t)(tn * 64 + fr) * ldb + fq * 8;
        for (int k0 = 0; k0 < K; k0 += 32) {
            bf16x8 a[4], b[4];
#pragma unroll
            for (int m = 0; m < 4; ++m) a[m] = *(const bf16x8*)(ap + (size_t)(16 * m) * lda + k0);
#pragma unroll
            for (int n = 0; n < 4; ++n) b[n] = *(const bf16x8*)(bp + (size_t)(16 * n) * ldb + k0);
#pragma unroll
            for (int m = 0; m < 4; ++m)
#pragma unroll
                for (int n = 0; n < 4; ++n) acc[m][n] = __builtin_amdgcn_mfma_f32_16x16x32_bf16(a[m], b[n], acc[m][n], 0, 0, 0);
        }
#pragma unroll
        for (int m = 0; m < 4; ++m)
#pragma unroll
            for (int n = 0; n < 4; ++n)
#pragma unroll
                for (int j = 0; j < 4; ++j) epi(tm * 64 + 16 * m + fq * 4 + j, tn * 64 + 16 * n + fr, acc[m][n][j]);
    }
}
struct EpiStoreBf16 { bf16_t* C; int ldc; __device__ __forceinline__ void operator()(int r, int c, float v) const { C[(size_t)r * ldc + c] = (bf16_t)f2bf(v); } };
struct EpiRelu2Bf16 { bf16_t* C; int ldc; __device__ __forceinline__ void operator()(int r, int c, float v) const { const float t = fmaxf(v, 0.f); C[(size_t)r * ldc + c] = (bf16_t)f2bf(t * t); } };
struct EpiResF32 { const float* base; float* out; int ldc; __device__ __forceinline__ void operator()(int r, int c, float v) const { out[(size_t)r * ldc + c] = base[(size_t)r * ldc + c] + v; } };

__device__ __forceinline__ void glueA_row(const Params& p, int row, int lane) {
    unsigned char* ws = p.ws;
    const bf16_t* pr = (const bf16_t*)(ws + WS_PROJ) + (size_t)row * DINP;
    { float v[6]; float s = 0.f;
#pragma unroll
      for (int j = 0; j < 6; ++j) { v[j] = bf2f(pr[C_HQ + lane + 64 * j]); s += v[j] * v[j]; }
      const float rstd = 1.f / sqrtf(wave_sum(s) * (1.f / QR) + EPS); bf16_t* o = (bf16_t*)(ws + WS_HQN) + (size_t)row * QR;
#pragma unroll
      for (int j = 0; j < 6; ++j) o[lane + 64 * j] = (bf16_t)f2bf(v[j] * rstd * p.in[3][lane + 64 * j]); }
    { float v[4]; float s = 0.f;
#pragma unroll
      for (int j = 0; j < 4; ++j) { v[j] = bf2f(pr[C_HKV + lane + 64 * j]); s += v[j] * v[j]; }
      const float rstd = 1.f / sqrtf(wave_sum(s) * (1.f / KVR) + EPS); bf16_t* o = (bf16_t*)(ws + WS_HKVN) + (size_t)row * KVR;
#pragma unroll
      for (int j = 0; j < 4; ++j) o[lane + 64 * j] = (bf16_t)f2bf(v[j] * rstd * p.in[4][lane + 64 * j]); }
    { bf16_t* o = (bf16_t*)(ws + WS_QN) + (size_t)row * 512; const float g = p.in[9][lane] * QS_NSA;
#pragma unroll
      for (int h = 0; h < 8; ++h) { const float v = bf2f(pr[C_QB + 64 * h + lane]); const float rstd = 1.f / sqrtf(wave_sum(v * v) * (1.f / 64) + EPS); o[64 * h + lane] = (bf16_t)f2bf(v * rstd * g); } }
    { bf16_t* os = (bf16_t*)(ws + WS_KSEL) + (size_t)row * 128; bf16_t* ow = (bf16_t*)(ws + WS_KWIN) + (size_t)row * 128;
      const float g1 = p.in[10][64 + lane], g2 = p.in[10][128 + lane];
#pragma unroll
      for (int g = 0; g < 2; ++g) {
          const float v = bf2f(pr[C_KSEL + 64 * g + lane]); const float rs = 1.f / sqrtf(wave_sum(v * v) * (1.f / 64) + EPS); os[64 * g + lane] = (bf16_t)f2bf(v * rs * g1);
          const float w = bf2f(pr[C_KWIN + 64 * g + lane]); const float rw = 1.f / sqrtf(wave_sum(w * w) * (1.f / 64) + EPS); ow[64 * g + lane] = (bf16_t)f2bf(w * rw * g2); } }
}
__device__ __forceinline__ void compress_task(const Params& p, int task, int lane) {
    unsigned char* ws = p.ws;
    const int g = task & 1, c = (task >> 1) & 127, b = (task >> 8) & 7, kv = task >> 11;
    bf16_t* dst = (bf16_t*)(ws + (kv ? WS_VCMP : WS_KCMP)) + ((size_t)(b * 128 + c) * 2 + g) * 64;
    if (c >= NCMP) { dst[lane] = 0; return; }
    const bf16_t* pr = (const bf16_t*)(ws + WS_PROJ) + (size_t)(b * SEQ + 16 * c) * DINP + (kv ? C_VCMP : C_KCMP) + 64 * g;
    const float* pe = p.in[11] + kv * 2048; const float* w1 = p.in[12] + (size_t)kv * 2048 * 128; const float* w2 = p.in[13] + kv * 128 * 64;
    float a0 = 0.f, a1 = 0.f;
    for (int r = 0; r < 32; ++r) {
        const float av = bf2f(pr[(size_t)r * DINP + lane]) + pe[r * 64 + lane];
        const float* wr = w1 + (size_t)(r * 64) * 128;
#pragma unroll 8
        for (int d = 0; d < 64; ++d) { const float a = __shfl(av, d); a0 += a * wr[d * 128 + lane]; a1 += a * wr[d * 128 + 64 + lane]; }
    }
    const float h0 = a0 / (1.f + __expf(-a0)), h1 = a1 / (1.f + __expf(-a1));
    float o = 0.f;
#pragma unroll 8
    for (int n = 0; n < 64; ++n) { o += __shfl(h0, n) * w2[n * 64 + lane] + __shfl(h1, n) * w2[(n + 64) * 64 + lane]; }
    if (kv == 0) { const float rstd = 1.f / sqrtf(wave_sum(o * o) * (1.f / 64) + EPS); o = o * rstd * p.in[10][lane]; }
    dst[lane] = (bf16_t)f2bf(o);
}

__device__ __forceinline__ void glueB_row(const Params& p, int row, int lane) {
    unsigned char* ws = p.ws;
    const int pos = row & (SEQ - 1);
    const int i = lane & 15;
    const float inv = exp2f(-(float)i * (13.287712379549449f / 16.f));
    const float ang = (float)pos * inv;
    float sn, cs; sincosf(ang, &sn, &cs);
    const float sgn = (lane & 16) ? 1.f : -1.f;
    bf16_t* q = (bf16_t*)(ws + WS_QM) + (size_t)row * MQ;
    const bf16_t* kvm = (const bf16_t*)(ws + WS_KVM) + (size_t)row * MKV;
    const bf16_t* pr = (const bf16_t*)(ws + WS_PROJ) + (size_t)row * DINP;
    bf16_t* ko = (bf16_t*)(ws + WS_KMLA) + (size_t)row * MQ;
    const float qg0 = p.in[7][lane], qg1 = p.in[7][64 + (lane & 31)], kg0 = p.in[8][lane], kg1 = p.in[8][64 + (lane & 31)];
    const float kr = bf2f(pr[C_HKR + (lane & 31)]);
#pragma unroll
    for (int h = 0; h < 8; ++h) {
        { const float v0 = bf2f(q[96 * h + lane]); const float v1 = (lane < 32) ? bf2f(q[96 * h + 64 + lane]) : 0.f;
          const float rstd = 1.f / sqrtf(wave_sum(v0 * v0 + v1 * v1) * (1.f / 96) + EPS);
          const float n0 = v0 * rstd * qg0, n1 = v1 * rstd * qg1; const float pn = __shfl_xor(n1, 16);
          const float r1 = n1 * cs + sgn * pn * sn;
          q[96 * h + lane] = (bf16_t)f2bf(n0 * QS_MLA); if (lane < 32) q[96 * h + 64 + lane] = (bf16_t)f2bf(r1 * QS_MLA); }
        { const float v0 = bf2f(kvm[128 * h + lane]); const float v1 = (lane < 32) ? kr : 0.f;
          const float rstd = 1.f / sqrtf(wave_sum(v0 * v0 + v1 * v1) * (1.f / 96) + EPS);
          const float n0 = v0 * rstd * kg0, n1 = v1 * rstd * kg1; const float pn = __shfl_xor(n1, 16);
          const float r1 = n1 * cs + sgn * pn * sn;
          ko[96 * h + lane] = (bf16_t)f2bf(n0); if (lane < 32) ko[96 * h + 64 + lane] = (bf16_t)f2bf(r1); }
    }
}

struct OnlineSm { float m, l; };
template <int DQ>
__device__ __forceinline__ void sm_key(const LAS float* q, float (&o)[64], OnlineSm& st, const bf16_t* krow, const bf16_t* vrow, float bias2) {
    float s = bias2;
#pragma unroll
    for (int c = 0; c < DQ / 8; ++c) { const bf16x8 kk = *(const bf16x8*)(krow + 8 * c); const f32x4 qa = *(const LAS f32x4*)(q + 8 * c), qb = *(const LAS f32x4*)(q + 8 * c + 4);
        s += qa[0] * bf2f((unsigned short)kk[0]) + qa[1] * bf2f((unsigned short)kk[1]) + qa[2] * bf2f((unsigned short)kk[2]) + qa[3] * bf2f((unsigned short)kk[3]);
        s += qb[0] * bf2f((unsigned short)kk[4]) + qb[1] * bf2f((unsigned short)kk[5]) + qb[2] * bf2f((unsigned short)kk[6]) + qb[3] * bf2f((unsigned short)kk[7]); }
    const float mn = fmaxf(st.m, s), al = exp2f(st.m - mn), pp = exp2f(s - mn);
    st.l = st.l * al + pp; st.m = mn;
#pragma unroll
    for (int c = 0; c < 8; ++c) { const bf16x8 vv = *(const bf16x8*)(vrow + 8 * c);
#pragma unroll
        for (int j = 0; j < 8; ++j) o[8 * c + j] = o[8 * c + j] * al + pp * bf2f((unsigned short)vv[j]); }
}
__device__ __forceinline__ float sm_finish(float (&o)[64], const OnlineSm& st, int lane) {
    const float mm = wave_max(st.m);
    const float w = (st.m == -INFINITY) ? 0.f : exp2f(st.m - mm);
    const float L = wave_sum(st.l * w);
#pragma unroll
    for (int d = 0; d < 64; ++d) o[d] *= w;
#define RS_STEP(n) { const bool up = (lane & (n)) != 0; _Pragma("unroll") for (int i = 0; i < (n); ++i) { const float keep = up ? o[(n) + i] : o[i]; const float send = up ? o[i] : o[(n) + i]; o[i] = keep + __shfl_xor(send, (n)); } }
    RS_STEP(32) RS_STEP(16) RS_STEP(8) RS_STEP(4) RS_STEP(2) RS_STEP(1)
#undef RS_STEP
    return (L > 0.f) ? o[0] / L : 0.f;
}

__device__ __forceinline__ void mla_task(const Params& p, int task, int lane, LAS float* q) {
    unsigned char* ws = p.ws;
    const int t = task & (SEQ - 1), h = (task >> 11) & 7, b = task >> 14;
    const size_t row = (size_t)b * SEQ + t;
    const bf16_t* qp = (const bf16_t*)(ws + WS_QM) + row * MQ + 96 * h;
    q[lane] = bf2f(qp[lane]); if (lane < 32) q[64 + lane] = bf2f(qp[64 + lane]);
    asm volatile("s_waitcnt lgkmcnt(0)" ::: "memory");
    float o[64];
#pragma unroll
    for (int d = 0; d < 64; ++d) o[d] = 0.f;
    OnlineSm st{-INFINITY, 0.f};
    const bf16_t* K = (const bf16_t*)(ws + WS_KMLA) + (size_t)b * SEQ * MQ + 96 * h;
    const bf16_t* V = (const bf16_t*)(ws + WS_KVM) + (size_t)b * SEQ * MKV + 128 * h + 64;
    for (int j = lane; j <= t; j += 64) sm_key<96>(q, o, st, K + (size_t)j * MQ, V + (size_t)j * MKV, 0.f);
    const float r = sm_finish(o, st, lane);
    ((bf16_t*)(ws + WS_MIX))[row * DM + 64 * h + lane] = (bf16_t)f2bf(r);
}

__device__ __forceinline__ void nsa_task(const Params& p, int task, int lane, const LAS float* tb, LAS float* q) {
    unsigned char* ws = p.ws;
    const int t = task & (SEQ - 1), g = (task >> 11) & 1, b = task >> 12;
    const size_t row = (size_t)b * SEQ + t;
    const bf16_t* pr = (const bf16_t*)(ws + WS_PROJ);
    const bf16_t* kc = (const bf16_t*)(ws + WS_KCMP) + ((size_t)b * 128 * 2 + g) * 64;
    const bf16_t* vc = (const bf16_t*)(ws + WS_VCMP) + ((size_t)b * 128 * 2 + g) * 64;
    const int blk_t = t >> 6;
    float w0 = 0.f, w1 = 0.f;
    const int c0 = lane, c1 = lane + 64;
    const int d0 = t - (16 * c0 + 31), d1 = t - (16 * c1 + 31);
    const bool v0 = d0 >= 0, v1 = (d1 >= 0) && (c1 < NCMP);
    const int ncv = (t >= 31) ? ((t - 31) >> 4) + 1 : 0;
#pragma unroll 1
    for (int r = 0; r < 4; ++r) {
        const int h = 4 * g + r;
        const bf16_t* qp = (const bf16_t*)(ws + WS_QN) + row * 512 + 64 * h;
        float s0 = 0.f, s1 = 0.f;
        { const bf16_t* k0 = kc + (size_t)c0 * 128; const bf16_t* k1 = kc + (size_t)(c1 < 128 ? c1 : 127) * 128;
#pragma unroll
          for (int c = 0; c < 8; ++c) { const bf16x8 qq = *(const bf16x8*)(qp + 8 * c), a = *(const bf16x8*)(k0 + 8 * c), bb = *(const bf16x8*)(k1 + 8 * c);
#pragma unroll
              for (int j = 0; j < 8; ++j) { const float qf = bf2f((unsigned short)qq[j]); s0 += qf * bf2f((unsigned short)a[j]); s1 += qf * bf2f((unsigned short)bb[j]); } } }
        s0 = v0 ? s0 + tb[h * 128 + (d0 < 127 ? d0 : 127)] : -INFINITY;
        s1 = v1 ? s1 + tb[h * 128 + (d1 < 127 ? d1 : 127)] : -INFINITY;
        const float mm = wave_max(fmaxf(s0, s1));
        float p0 = 0.f, p1 = 0.f;
        if (mm != -INFINITY) { p0 = v0 ? exp2f(s0 - mm) : 0.f; p1 = v1 ? exp2f(s1 - mm) : 0.f; const float sum = wave_sum(p0 + p1); const float inv = 1.f / fmaxf(sum, 1e-30f); p0 *= inv; p1 *= inv; }
        w0 += p0; w1 += p1;
        float o = 0.f;
        for (int c = 0; c < ncv; ++c) { const float pc = (c < 64) ? __shfl(p0, c) : __shfl(p1, c - 64); o += pc * bf2f(vc[(size_t)c * 128 + lane]); }
        q[128 + 64 * r + lane] = o;
    }
    unsigned selmask;
    {
        const float A0 = ((lane & 3) == 3) ? 0.5f * w0 : w0, A1 = ((lane & 3) == 3) ? 0.5f * w1 : w1;
        float G0 = A0 + __shfl_xor(A0, 1); G0 += __shfl_xor(G0, 2);
        float G1 = A1 + __shfl_xor(A1, 1); G1 += __shfl_xor(G1, 2);
        const float up0 = __shfl_up(w0, 1), up1 = __shfl_up(w1, 1), w0_63 = __shfl(w0, 63);
        const float implo = G0 + ((lane >= 4) ? 0.5f * up0 : 0.f);
        const float imphi = G1 + ((lane >= 4) ? 0.5f * up1 : 0.5f * w0_63);
        const int j = lane & 31;
        const float ilo = __shfl(implo, 4 * (lane & 15)), ihi = __shfl(imphi, 4 * (lane & 15));
        const float imp = (j < 16) ? ilo : ihi;
        float sc;
        if (j > blk_t) sc = -INFINITY; else if (j == 0 || j == blk_t || j == blk_t - 1) sc = 1e4f; else sc = imp;
        int rank = 0;
#pragma unroll
        for (int i = 0; i < 32; ++i) { const float si = __shfl(sc, i); rank += (si > sc || (si == sc && i < j)) ? 1 : 0; }
        const unsigned long long bal = __ballot(lane < 32 && rank < 16);
        selmask = (unsigned)bal;
    }
    const bf16_t* Ks = (const bf16_t*)(ws + WS_KSEL) + (size_t)b * SEQ * 128 + 64 * g;
    const bf16_t* Kw = (const bf16_t*)(ws + WS_KWIN) + (size_t)b * SEQ * 128 + 64 * g;
    const bf16_t* Vs = pr + (size_t)b * SEQ * DINP + C_VSEL + 64 * g;
    const bf16_t* Vw = pr + (size_t)b * SEQ * DINP + C_VWIN + 64 * g;
#pragma unroll 1
    for (int r = 0; r < 4; ++r) {
        const int h = 4 * g + r;
        const bf16_t* qp = (const bf16_t*)(ws + WS_QN) + row * 512 + 64 * h;
        q[lane] = bf2f(qp[lane]);
        asm volatile("s_waitcnt lgkmcnt(0)" ::: "memory");
        float o[64];
#pragma unroll
        for (int d = 0; d < 64; ++d) o[d] = 0.f;
        OnlineSm st{-INFINITY, 0.f};
        for (int jb = 0; jb <= blk_t; ++jb) {
            if (!((selmask >> jb) & 1u)) continue;
            const int j = 64 * jb + lane;
            if (j <= t) { const int dist = t - j; sm_key<64>(q, o, st, Ks + (size_t)j * 128, Vs + (size_t)j * DINP, tb[h * 128 + (dist < 127 ? dist : 127)]); }
        }
        const float osel = sm_finish(o, st, lane);
#pragma unroll
        for (int d = 0; d < 64; ++d) o[d] = 0.f;
        st.m = -INFINITY; st.l = 0.f;
        { const int jlo = (t - 511 > 0) ? t - 511 : 0;
          for (int j = jlo + lane; j <= t; j += 64) { const int dist = t - j; sm_key<64>(q, o, st, Kw + (size_t)j * 128, Vw + (size_t)j * DINP, tb[h * 128 + (dist < 127 ? dist : 127)]); } }
        const float owin = sm_finish(o, st, lane);
        const bf16_t* gp = pr + row * DINP + C_GATE;
        const float g0 = 1.f / (1.f + __expf(-bf2f(gp[h]))), g1 = 1.f / (1.f + __expf(-bf2f(gp[8 + h]))), g2 = 1.f / (1.f + __expf(-bf2f(gp[16 + h])));
        const float oc = q[128 + 64 * r + lane];
        ((bf16_t*)(ws + WS_MIX))[row * DM + 512 + 64 * h + lane] = (bf16_t)f2bf(g0 * oc + g1 * osel + g2 * owin);
    }
}

__device__ __forceinline__ void glueC_row(const Params& p, int row, int lane) {
    bf16_t* mx = (bf16_t*)(p.ws + WS_MIX) + (size_t)row * DM;
#pragma unroll
    for (int half = 0; half < 2; ++half) {
        const float* g = p.in[15 + half];
        float v[8]; float s = 0.f;
#pragma unroll
        for (int j = 0; j < 8; ++j) { v[j] = bf2f(mx[512 * half + lane + 64 * j]); s += v[j] * v[j]; }
        const float rstd = 1.f / sqrtf(wave_sum(s) * (1.f / 512) + EPS);
#pragma unroll
        for (int j = 0; j < 8; ++j) mx[512 * half + lane + 64 * j] = (bf16_t)f2bf(v[j] * rstd * g[lane + 64 * j]);
    }
}

__global__ void __launch_bounds__(512, 2) mega(Params p) {
    extern __shared__ __attribute__((aligned(16))) unsigned char lds[];
    cg::grid_group grid = cg::this_grid();
    const int tid = threadIdx.x, lane = tid & 63, wave = __builtin_amdgcn_readfirstlane(tid >> 6);
    const int G = gridDim.x, bid = blockIdx.x;
    const int gw = bid * NW + wave, NGW = G * NW;
    unsigned char* ws = p.ws;
    LAS unsigned char* L = (LAS unsigned char*)lds;

    {
        LAS float* scr = (LAS float*)(L + wave * 8704);
        constexpr int I0 = (1024 / 64) * (DINP / 32), I1 = (QR / 64) * (MQ / 32), I2 = (KVR / 64) * (MKV / 32), I3 = 16 * 32, I4 = 16 * (FF / 32), I5 = (FF / 64) * 32;
        constexpr int NIT = I0 + I1 + I2 + I3 + I4 + I5;
        for (int it = gw; it < NIT; it += NGW) {
            int r = it;
            if (r < I0) { p0_transpose_item(p.in[2], 1024, DIN, DINP, (bf16_t*)(ws + WS_WIN), scr, r, lane); continue; } r -= I0;
            if (r < I1) { p0_transpose_item(p.in[5], QR, MQ, MQ, (bf16_t*)(ws + WS_WUQ), scr, r, lane); continue; } r -= I1;
            if (r < I2) { p0_transpose_item(p.in[6], KVR, MKV, MKV, (bf16_t*)(ws + WS_WUKV), scr, r, lane); continue; } r -= I2;
            if (r < I3) { p0_transpose_item(p.in[17], 1024, 1024, 1024, (bf16_t*)(ws + WS_WO), scr, r, lane); continue; } r -= I3;
            if (r < I4) { p0_transpose_item(p.in[19], 1024, FF, FF, (bf16_t*)(ws + WS_WUP), scr, r, lane); continue; } r -= I4;
            p0_transpose_item(p.in[20], FF, 1024, 1024, (bf16_t*)(ws + WS_WDN), scr, r, lane);
        }
        for (int m = gw; m < M; m += NGW) rms_row_to_bf16(p.in[0] + (size_t)m * DM, p.in[1], (bf16_t*)(ws + WS_HB) + (size_t)m * DM, lane);
    }
    grid.sync();
    gemm_simple((const bf16_t*)(ws + WS_HB), DM, (const bf16_t*)(ws + WS_WIN), DM, M, DINP, DM, EpiStoreBf16{(bf16_t*)(ws + WS_PROJ), DINP}, gw, NGW, lane);
    grid.sync();
    for (int m = gw; m < M; m += NGW) glueA_row(p, m, lane);
    for (int t = gw; t < 2 * 8 * 128 * 2; t += NGW) compress_task(p, t, lane);
    grid.sync();
    gemm_simple((const bf16_t*)(ws + WS_HQN), QR, (const bf16_t*)(ws + WS_WUQ), QR, M, MQ, QR, EpiStoreBf16{(bf16_t*)(ws + WS_QM), MQ}, gw, NGW, lane);
    gemm_simple((const bf16_t*)(ws + WS_HKVN), KVR, (const bf16_t*)(ws + WS_WUKV), KVR, M, MKV, KVR, EpiStoreBf16{(bf16_t*)(ws + WS_KVM), MKV}, gw, NGW, lane);
    grid.sync();
    for (int m = gw; m < M; m += NGW) glueB_row(p, m, lane);
    grid.sync();
    {
        LAS float* tb = (LAS float*)L;
        for (int i = tid; i < 8 * 128; i += 512) { const int h = i >> 7, n = i & 127; tb[i] = p.in[14][t5_bucket(n) * 8 + h] * LOG2E; }
        __syncthreads();
        LAS float* qw = (LAS float*)(L + 4096 + wave * 2048);
#ifndef NO_NSA
        for (int t = gw; t < BATCH * 2 * SEQ; t += NGW) nsa_task(p, t, lane, tb, qw);
#endif
#ifndef NO_MLA
        for (int t = gw; t < BATCH * 8 * SEQ; t += NGW) mla_task(p, t, lane, qw);
#endif
    }
    grid.sync();
    for (int m = gw; m < M; m += NGW) glueC_row(p, m, lane);
    grid.sync();
    gemm_simple((const bf16_t*)(ws + WS_MIX), DM, (const bf16_t*)(ws + WS_WO), DM, M, DM, DM, EpiResF32{p.in[0], p.out, DM}, gw, NGW, lane);
    grid.sync();
    for (int m = gw; m < M; m += NGW) rms_row_to_bf16(p.out + (size_t)m * DM, p.in[18], (bf16_t*)(ws + WS_H2) + (size_t)m * DM, lane);
    grid.sync();
    gemm_simple((const bf16_t*)(ws + WS_H2), DM, (const bf16_t*)(ws + WS_WUP), DM, M, FF, DM, EpiRelu2Bf16{(bf16_t*)(ws + WS_HID), FF}, gw, NGW, lane);
    grid.sync();
    gemm_simple((const bf16_t*)(ws + WS_HID), FF, (const bf16_t*)(ws + WS_WDN), FF, M, DM, FF, EpiResF32{p.out, p.out, DM}, gw, NGW, lane);
}

extern "C" void kernel_launch(void* const* d_in, const int* in_sizes, int n_in, void* d_out, int out_size,
                              void* d_ws, size_t ws_size, hipStream_t stream) {
    static int grid_blocks = 0;
    if (!grid_blocks) {
        int dev = 0, cus = 0, per_cu = 0;
        (void)hipGetDevice(&dev);
        (void)hipDeviceGetAttribute(&cus, hipDeviceAttributeMultiprocessorCount, dev);
        (void)hipFuncSetAttribute((const void*)mega, hipFuncAttributeMaxDynamicSharedMemorySize, LDS_BYTES);
        (void)hipOccupancyMaxActiveBlocksPerMultiprocessor(&per_cu, (const void*)mega, 512, LDS_BYTES);
        if (per_cu != 1) fprintf(stderr, "note: occupancy query reports %d blocks/CU; launching 1 per CU\n", per_cu);
        grid_blocks = cus;
        if (n_in != 21 || out_size != M * DM || ws_size < 256 * MiB) fprintf(stderr, "unexpected shapes: n_in %d out %d ws %zu\n", n_in, out_size, ws_size);
    }
    Params p{};
    for (int i = 0; i < 21; ++i) p.in[i] = (const float*)d_in[i];
    p.out = (float*)d_out; p.ws = (unsigned char*)d_ws;
    void* args[] = {&p};
    hipError_t e = hipLaunchCooperativeKernel((const void*)mega, dim3(grid_blocks), dim3(512), args, LDS_BYTES, stream);
    if (e != hipSuccess) fprintf(stderr, "cooperative launch failed: %s (grid %d)\n", hipGetErrorString(e), grid_blocks);
}
```

```cpp
#include <hip/hip_runtime.h>
#include <hip/hip_cooperative_groups.h>
#include <cstdio>
#include <cstdint>
namespace cg = cooperative_groups;

#define LAS __attribute__((address_space(3)))
typedef unsigned short bf16_t;
typedef short bf16x8 __attribute__((ext_vector_type(8)));
typedef float f32x4 __attribute__((ext_vector_type(4)));
typedef unsigned u32x4 __attribute__((ext_vector_type(4)));
typedef unsigned u32x2 __attribute__((ext_vector_type(2)));

constexpr int BATCH = 8, SEQ = 2048, DM = 1024, M = BATCH * SEQ;
constexpr int DIN = 1976, DINP = 2048;
constexpr int C_HQ = 0, C_HKV = 384, C_HKR = 640, C_QB = 672, C_KVB = 1184, C_GATE = 1952;
constexpr int C_KCMP = C_KVB, C_VCMP = C_KVB + 128, C_KSEL = C_KVB + 256, C_VSEL = C_KVB + 384, C_KWIN = C_KVB + 512, C_VWIN = C_KVB + 640;
constexpr int QR = 384, KVR = 256, MQ = 768, MKV = 1024, FF = 4096;
constexpr int NCMP = 127;
constexpr float EPS = 1e-6f;
constexpr float LOG2E = 1.4426950408889634f;
constexpr float QS_MLA = 0.10206207261596577f * LOG2E;
constexpr float QS_NSA = 0.125f * LOG2E;

constexpr size_t MiB = 1u << 20;
constexpr size_t WS_WIN = 1 * MiB, WS_WUQ = 5 * MiB, WS_WUKV = 6 * MiB, WS_WO = 7 * MiB, WS_WUP = 9 * MiB, WS_WDN = 17 * MiB;
constexpr size_t WS_KCMP = 26 * MiB, WS_VCMP = 26 * MiB + 512 * 1024;
constexpr size_t WS_HB = 32 * MiB;
constexpr size_t WS_MIX = 32 * MiB;
constexpr size_t WS_PROJ = 64 * MiB;
constexpr size_t WS_QM = 128 * MiB;
constexpr size_t WS_KVM = 152 * MiB;
constexpr size_t WS_KMLA = 184 * MiB;
constexpr size_t WS_QN = 208 * MiB;
constexpr size_t WS_KSEL = 224 * MiB;
constexpr size_t WS_KWIN = 228 * MiB;
constexpr size_t WS_HQN = 232 * MiB;
constexpr size_t WS_HKVN = 244 * MiB;
constexpr size_t WS_H2 = 192 * MiB;
constexpr size_t WS_HID = 64 * MiB;

constexpr int LDS_BYTES = 147456;
constexpr int NW = 8;

struct Params {
    const float* in[21];
    float* out;
    unsigned char* ws;
};

__device__ __forceinline__ unsigned f2bf(float f) { unsigned u = __builtin_bit_cast(unsigned, f); return (u + 0x7fffu + ((u >> 16) & 1u)) >> 16; }
__device__ __forceinline__ float bf2f(unsigned b) { return __builtin_bit_cast(float, b << 16); }
__device__ __forceinline__ unsigned pk2(float lo, float hi) { return f2bf(lo) | (f2bf(hi) << 16); }
__device__ __forceinline__ float wave_sum(float v) {
#pragma unroll
    for (int o = 1; o < 64; o <<= 1) v += __shfl_xor(v, o);
    return v;
}
__device__ __forceinline__ float wave_max(float v) {
#pragma unroll
    for (int o = 1; o < 64; o <<= 1) v = fmaxf(v, __shfl_xor(v, o));
    return v;
}
__device__ __forceinline__ int t5_bucket(int n) {
    if (n < 16) return n;
    int b = 16;
    b += (n >= 19); b += (n >= 21); b += (n >= 24); b += (n >= 27); b += (n >= 31); b += (n >= 35); b += (n >= 40); b += (n >= 46);
    b += (n >= 52); b += (n >= 59); b += (n >= 67); b += (n >= 77); b += (n >= 87); b += (n >= 99); b += (n >= 113);
    return b;
}

__device__ __forceinline__ void p0_transpose_item(const float* W, int K, int N, int Npad, bf16_t* WT, LAS float* scr, int item, int lane) {
    const int nblk = Npad / 32, kb = item / nblk, nb = item % nblk, k0 = 64 * kb, n0 = 32 * nb;
    const int nn = n0 + (lane & 31);
#pragma unroll 8
    for (int i = 0; i < 32; ++i) { const int kk = 2 * i + (lane >> 5); scr[kk * 33 + (lane & 31)] = (nn < N) ? W[(size_t)(k0 + kk) * N + nn] : 0.f; }
    asm volatile("s_waitcnt lgkmcnt(0)" ::: "memory");
    const int c = lane & 7;
#pragma unroll
    for (int j = 0; j < 4; ++j) { const int n = (lane >> 3) + 8 * j; const LAS float* s = scr + (8 * c) * 33 + n;
        u32x4 o; o.x = pk2(s[0 * 33], s[1 * 33]); o.y = pk2(s[2 * 33], s[3 * 33]); o.z = pk2(s[4 * 33], s[5 * 33]); o.w = pk2(s[6 * 33], s[7 * 33]);
        *(u32x4*)(WT + (size_t)(n0 + n) * K + k0 + 8 * c) = o; }
    asm volatile("s_waitcnt lgkmcnt(0)" ::: "memory");
}
__device__ __forceinline__ void rms_row_to_bf16(const float* xrow, const float* g, bf16_t* orow, int lane) {
    const f32x4* xr = (const f32x4*)xrow + lane; const f32x4* gr = (const f32x4*)g + lane;
    f32x4 v[4]; float s = 0.f;
#pragma unroll
    for (int j = 0; j < 4; ++j) { v[j] = xr[64 * j]; s += (v[j].x * v[j].x + v[j].y * v[j].y) + (v[j].z * v[j].z + v[j].w * v[j].w); }
    const float rstd = 1.f / sqrtf(wave_sum(s) * (1.f / DM) + EPS);
    unsigned long long* o8 = (unsigned long long*)orow + lane;
#pragma unroll
    for (int j = 0; j < 4; ++j) { const f32x4 gg = gr[64 * j];
        o8[64 * j] = (unsigned long long)pk2(v[j].x * rstd * gg.x, v[j].y * rstd * gg.y) | ((unsigned long long)pk2(v[j].z * rstd * gg.z, v[j].w * rstd * gg.w) << 32); }
}

template <class Epi>
__device__ __forceinline__ void gemm_simple(const bf16_t* A, int lda, const bf16_t* Bt, int ldb, int Mr, int N, int K, const Epi& epi, int gw, int NGW, int lane) {
    const int tn_cnt = N / 64, ntiles = (Mr / 64) * tn_cnt;
    const int fr = lane & 15, fq = lane >> 4;
    for (int tile = gw; tile < ntiles; tile += NGW) {
        const int tm = tile / tn_cnt, tn = tile % tn_cnt;
        f32x4 acc[4][4];
#pragma unroll
        for (int m = 0; m < 4; ++m)
#pragma unroll
            for (int n = 0; n < 4; ++n) acc[m][n] = (f32x4){0.f, 0.f, 0.f, 0.f};
        const bf16_t* ap = A + (size_t)(tm * 64 + fr) * lda + fq * 8;
        const bf16_t* bp = Bt + (size_t)(tn * 64 + fr) * ldb + fq * 8;
        for (int k0 = 0; k0 < K; k0 += 32) {
            bf16x8 a[4], b[4];
#pragma unroll
            for (int m = 0; m < 4; ++m) a[m] = *(const bf16x8*)(ap + (size_t)(16 * m) * lda + k0);
#pragma unroll
            for (int n = 0; n < 4; ++n) b[n] = *(const bf16x8*)(bp + (size_t)(16 * n) * ldb + k0);
#pragma unroll
            for (int m = 0; m < 4; ++m)
#pragma unroll
                for (int n = 0; n < 4; ++n) acc[m][n] = __builtin_amdgcn_mfma_f32_16x16x32_bf16(a[m], b[n], acc[m][n], 0, 0, 0);
        }
#pragma unroll
        for (int m = 0; m < 4; ++m)
#pragma unroll
            for (int n = 0; n < 4; ++n)
#pragma unroll
                for (int j = 0; j < 4; ++j) epi(tm * 64 + 16 * m + fq * 4 + j, tn * 64 + 16 * n + fr, acc[m][n][j]);
    }
}
struct EpiStoreBf16 { bf16_t* C; int ldc; __device__ __forceinline__ void operator()(int r, int c, float v) const { C[(size_t)r * ldc + c] = (bf16_t)f2bf(v); } };
struct EpiRelu2Bf16 { bf16_t* C; int ldc; __device__ __forceinline__ void operator()(int r, int c, float v) const { const float t = fmaxf(v, 0.f); C[(size_t)r * ldc + c] = (bf16_t)f2bf(t * t); } };
struct EpiResF32 { const float* base; float* out; int ldc; __device__ __forceinline__ void operator()(int r, int c, float v) const { out[(size_t)r * ldc + c] = base[(size_t)r * ldc + c] + v; } };

namespace pg8 {
#define PG8_LAS __attribute__((address_space(3)))
typedef unsigned short bf16_t;
typedef short bf16x8 __attribute__((ext_vector_type(8)));
typedef float f32x4 __attribute__((ext_vector_type(4)));
typedef unsigned u32x4 __attribute__((ext_vector_type(4)));
constexpr int BM = 256, BK = 64, HALF = 128, HTB = HALF * BK * 2  , STAGE_BYTES = 8 * HTB, NXCD = 8, WGM = 8;

__host__ __device__ __forceinline__ int lds_byte(int r, int c) { const int st = (r >> 4) * 2 + (c >> 5), rr = r & 15, cc = c & 31, ob = rr * 64 + cc * 2; return st * 1024 + (ob ^ (((ob >> 9) & 1) << 5)); }
__host__ __device__ __forceinline__ void stage_rc(int b, int& R, int& C) { const int st = b / 1024, sb = b % 1024, swz = sb ^ (((sb >> 9) & 1) << 5); R = (st >> 1) * 16 + swz / 64; C = (st & 1) * 32 + (swz % 64) / 2; }
__host__ __device__ __forceinline__ int perm32(int rho) { const int n = rho >> 4, i = rho & 15; return 8 * (i >> 2) + 4 * n + (i & 3); }

struct Unit { int pm, pn; };
struct Gemm { const bf16_t* A; const bf16_t* Bt; int M, N, K, lda, ldb; };

struct StaticOrder {
    int nM, nN, nwg, G, c;
    __host__ __device__ void init(int M, int N, int G_, int c_) { nM = M / BM; nN = N / BM; nwg = nM * nN; G = G_; c = c_; }
    __host__ __device__ bool next(int i, Unit& u) const {
        const long L = (long)i * G + c; if (L >= nwg) return false;
        int wgid = (int)L; { const int q = nwg / NXCD, r = nwg % NXCD, xcd = wgid % NXCD, off = wgid / NXCD; wgid = (xcd < r ? xcd * (q + 1) : r * (q + 1) + (xcd - r) * q) + off; }
        const int nig = WGM * nN, gid = wgid / nig, fm = gid * WGM, gsz = (nM - fm) < WGM ? (nM - fm) : WGM;
        u.pm = fm + ((wgid % nig) % gsz); u.pn = (wgid % nig) / gsz; return true;
    }
    __device__ __forceinline__ void a_ready(const Unit&) const {}
    __device__ __forceinline__ void done(const Unit&) const {}
};

template <class Epi, class Sched, bool ALIGN_EPI = false, bool SP2 = false>
__device__ __forceinline__ void gemm_phase(PG8_LAS unsigned char* lds, const Gemm g, const Sched& S, const Epi& E) {
    const int tid = threadIdx.x, wid = __builtin_amdgcn_readfirstlane(tid >> 6), lane = tid & 63, wr = wid >> 2, wc = wid & 3, fr = lane & 15, fq = lane >> 4;
    const int K = g.K, nt = K / BK;
    unsigned voffA[2], voffB[2];
#pragma unroll
    for (int i = 0; i < 2; ++i) { int R, C; stage_rc(tid * 16 + i * 8192, R, C); const int Rb = Epi::PERM ? ((R & ~31) + perm32(R & 31)) : R;
        voffA[i] = (unsigned)(R * g.lda + C) * 2u; voffB[i] = (unsigned)(Rb * g.ldb + C) * 2u; }
    const size_t kstep = (size_t)(BK * 2);
    const size_t hstepA = (size_t)HALF * g.lda * 2, hstepB = (size_t)HALF * g.ldb * 2;
    const size_t tstepA = 2 * hstepA, tstepB = 2 * hstepB;
    const unsigned ldsw = (unsigned)wid * 1024u;
    const int aoff = lds_byte(wr * 64 + fr, fq * 8), boff = lds_byte(wc * 32 + fr, fq * 8);
#define PG8_SA(b, h) (((b) * 2 + (h)) * HTB)
#define PG8_SB(b, h) ((4 + (b) * 2 + (h)) * HTB)
#define PG8_STAGE(bufoff, gbase, voff) do { _Pragma("unroll") for (int _i = 0; _i < 2; ++_i) \
        __builtin_amdgcn_global_load_lds((const unsigned*)((const char*)(gbase) + (voff)[_i]), (PG8_LAS unsigned*)(lds + (bufoff) + ldsw + _i * 8192), 16, 0, 0); } while (0)
#define PG8_LDA(dst, b, h) do { _Pragma("unroll") for (int m = 0; m < 4; ++m) _Pragma("unroll") for (int k = 0; k < 2; ++k) dst[m][k] = *(const PG8_LAS bf16x8*)(lds + PG8_SA(b, h) + aoff + m * 2048 + k * 1024); } while (0)
#define PG8_LDB(dst, b, h) do { _Pragma("unroll") for (int n = 0; n < 2; ++n) _Pragma("unroll") for (int k = 0; k < 2; ++k) dst[n][k] = *(const PG8_LAS bf16x8*)(lds + PG8_SB(b, h) + boff + n * 2048 + k * 1024); } while (0)
#define PG8_MMA(ai, bj, At, Bt) do { __builtin_amdgcn_s_setprio(1); _Pragma("unroll") for (int m = 0; m < 4; ++m) _Pragma("unroll") for (int n = 0; n < 2; ++n) _Pragma("unroll") for (int k = 0; k < 2; ++k) \
        acc[ai][bj][m][n] = __builtin_amdgcn_mfma_f32_16x16x32_bf16(Bt[n][k], At[m][k], acc[ai][bj][m][n], 0, 0, 0); __builtin_amdgcn_s_setprio(0); } while (0)
#define PG8_WAIT_V(n) asm volatile("s_waitcnt vmcnt(" #n ")" ::: "memory")
#define PG8_WAIT_L(n) asm volatile("s_waitcnt lgkmcnt(" #n ")" ::: "memory")
#define PG8_BAR __builtin_amdgcn_s_barrier()
#define PG8_SCHED __builtin_amdgcn_sched_barrier(0)
    Unit cur, nxt; int ui = 0;
    if (!S.next(0, cur)) return;
    f32x4 acc[2][2][4][2];
#pragma unroll
    for (int a = 0; a < 2; ++a)
#pragma unroll
        for (int b = 0; b < 2; ++b)
#pragma unroll
            for (int m = 0; m < 4; ++m)
#pragma unroll
                for (int n = 0; n < 2; ++n) acc[a][b][m][n] = (f32x4){0.f, 0.f, 0.f, 0.f};
    bf16x8 At[4][2], B0[2][2], B1[2][2];
    const char* cA = (const char*)g.A + (size_t)cur.pm * tstepA; const char* cB = (const char*)g.Bt + (size_t)cur.pn * tstepB;
    S.a_ready(cur);
    if constexpr (SP2) {
        PG8_STAGE(PG8_SB(0, 0), cB, voffB); PG8_STAGE(PG8_SB(0, 1), cB + hstepB, voffB); PG8_STAGE(PG8_SA(0, 0), cA, voffA); PG8_STAGE(PG8_SA(0, 1), cA + hstepA, voffA);
        if (wr == 1) PG8_BAR;
        PG8_WAIT_V(2); PG8_BAR;
        PG8_STAGE(PG8_SB(1, 0), cB + kstep, voffB); PG8_STAGE(PG8_SA(1, 0), cA + kstep, voffA); PG8_STAGE(PG8_SB(1, 1), cB + hstepB + kstep, voffB);
        PG8_WAIT_V(6); PG8_BAR;
    } else {
        PG8_STAGE(PG8_SB(0, 0), cB, voffB); PG8_STAGE(PG8_SA(0, 0), cA, voffA); PG8_STAGE(PG8_SB(0, 1), cB + hstepB, voffB); PG8_STAGE(PG8_SA(0, 1), cA + hstepA, voffA);
        if (wr == 1) PG8_BAR;
        PG8_WAIT_V(4); PG8_BAR;
        PG8_STAGE(PG8_SB(1, 0), cB + kstep, voffB); PG8_STAGE(PG8_SA(1, 0), cA + kstep, voffA); PG8_STAGE(PG8_SB(1, 1), cB + hstepB + kstep, voffB);
        PG8_WAIT_V(6); PG8_BAR;
    }
    for (;;) {
        const bool has_next = S.next(ui + 1, nxt);
        const char* nA = has_next ? (const char*)g.A + (size_t)nxt.pm * tstepA : cA; const char* nB = has_next ? (const char*)g.Bt + (size_t)nxt.pn * tstepB : cB;
        for (int t = 0; t < nt; t += 2) {
            const bool last = (t == nt - 2);
            const char* a1 = cA + (size_t)(t + 1) * kstep;
            const char* a2 = last ? nA : cA + (size_t)(t + 2) * kstep; const char* b2 = last ? nB : cB + (size_t)(t + 2) * kstep;
            const char* a3 = a2 + kstep; const char* b3 = b2 + kstep;
            if (last && has_next) S.a_ready(nxt);
            if constexpr (SP2) {
            PG8_LDB(B0, 0, 0); PG8_LDB(B1, 0, 1); PG8_SCHED; PG8_LDA(At, 0, 0); PG8_STAGE(PG8_SA(1, 1), a1 + hstepA, voffA);
            PG8_WAIT_V(8); PG8_WAIT_L(0); PG8_BAR; PG8_MMA(0, 0, At, B0); PG8_MMA(0, 1, At, B1); PG8_BAR; PG8_SCHED;
            PG8_LDA(At, 0, 1); PG8_STAGE(PG8_SB(0, 0), b2, voffB); PG8_STAGE(PG8_SB(0, 1), b2 + hstepB, voffB); PG8_STAGE(PG8_SA(0, 0), a2, voffA);
            PG8_WAIT_V(8); PG8_WAIT_L(0); PG8_BAR; PG8_MMA(1, 0, At, B0); PG8_MMA(1, 1, At, B1); PG8_BAR; PG8_SCHED;
            PG8_LDB(B0, 1, 0); PG8_LDB(B1, 1, 1); PG8_SCHED; PG8_LDA(At, 1, 0); PG8_STAGE(PG8_SA(0, 1), a2 + hstepA, voffA);
            PG8_WAIT_V(8); PG8_WAIT_L(0); PG8_BAR; PG8_MMA(0, 0, At, B0); PG8_MMA(0, 1, At, B1); PG8_BAR; PG8_SCHED;
            PG8_LDA(At, 1, 1); PG8_STAGE(PG8_SB(1, 0), b3, voffB); PG8_STAGE(PG8_SB(1, 1), b3 + hstepB, voffB); PG8_STAGE(PG8_SA(1, 0), a3, voffA);
            PG8_WAIT_V(8); PG8_WAIT_L(0); PG8_BAR; PG8_MMA(1, 0, At, B0); PG8_MMA(1, 1, At, B1); PG8_BAR; PG8_SCHED;
            } else {
            PG8_LDB(B0, 0, 0); PG8_SCHED; PG8_LDA(At, 0, 0); PG8_STAGE(PG8_SA(1, 1), a1 + hstepA, voffA);
            PG8_WAIT_L(8); PG8_BAR; PG8_WAIT_L(0); PG8_MMA(0, 0, At, B0); PG8_BAR; PG8_SCHED;
            PG8_LDB(B1, 0, 1); PG8_STAGE(PG8_SB(0, 0), b2, voffB);
            PG8_BAR; PG8_WAIT_L(0); PG8_MMA(0, 1, At, B1); PG8_BAR;
            PG8_LDA(At, 0, 1); PG8_STAGE(PG8_SA(0, 0), a2, voffA);
            PG8_BAR; PG8_WAIT_L(0); PG8_MMA(1, 0, At, B0); PG8_BAR; PG8_SCHED;
            PG8_STAGE(PG8_SB(0, 1), b2 + hstepB, voffB);
            PG8_WAIT_V(6); PG8_BAR; PG8_MMA(1, 1, At, B1); PG8_BAR;
            PG8_LDB(B0, 1, 0); PG8_SCHED; PG8_LDA(At, 1, 0); PG8_STAGE(PG8_SA(0, 1), a2 + hstepA, voffA);
            PG8_WAIT_L(8); PG8_BAR; PG8_WAIT_L(0); PG8_MMA(0, 0, At, B0); PG8_BAR; PG8_SCHED;
            PG8_LDB(B1, 1, 1); PG8_STAGE(PG8_SB(1, 0), b3, voffB);
            PG8_BAR; PG8_WAIT_L(0); PG8_MMA(0, 1, At, B1); PG8_BAR;
            PG8_LDA(At, 1, 1); PG8_STAGE(PG8_SA(1, 0), a3, voffA);
            PG8_BAR; PG8_WAIT_L(0); PG8_MMA(1, 0, At, B0); PG8_BAR; PG8_SCHED;
            PG8_STAGE(PG8_SB(1, 1), b3 + hstepB, voffB);
            PG8_WAIT_V(6); PG8_BAR; PG8_MMA(1, 1, At, B1); PG8_BAR;
            }
        }
        if constexpr (ALIGN_EPI) { if (wr == 0) PG8_BAR; }
        if constexpr (!Epi::AFTER_DRAIN) { E(acc, cur, wr, wc, fr, fq); S.done(cur); }
        if (!has_next) break;
#pragma unroll
        for (int a = 0; a < 2; ++a)
#pragma unroll
            for (int b = 0; b < 2; ++b)
#pragma unroll
                for (int m = 0; m < 4; ++m)
#pragma unroll
                    for (int n = 0; n < 2; ++n) acc[a][b][m][n] = (f32x4){0.f, 0.f, 0.f, 0.f};
        cur = nxt; cA = nA; cB = nB; ++ui;
        if constexpr (ALIGN_EPI) { if (wr == 1) PG8_BAR; }
    }
    PG8_WAIT_V(0);
    if constexpr (!ALIGN_EPI) { if (wr == 0) PG8_BAR; }
    PG8_BAR;
    if constexpr (Epi::AFTER_DRAIN) { E.fused(acc, cur, wr, wc, fr, fq, lds, wid, lane); S.done(cur); }
#undef PG8_SA
#undef PG8_SB
#undef PG8_STAGE
#undef PG8_LDA
#undef PG8_LDB
#undef PG8_MMA
#undef PG8_WAIT_V
#undef PG8_WAIT_L
#undef PG8_BAR
#undef PG8_SCHED
}
}

__device__ __forceinline__ unsigned cvt_pk_bf16(float lo, float hi) { unsigned r; asm volatile("v_cvt_pk_bf16_f32 %0, %1, %2" : "=v"(r) : "v"(lo), "v"(hi)); return r; }
template <int ACT> struct PEpiBf16 {
    static constexpr bool PERM = true, AFTER_DRAIN = false;
    bf16_t* O; int ldc;
    __device__ __forceinline__ void operator()(const f32x4 (&acc)[2][2][4][2], const pg8::Unit& u, int wr, int wc, int fr, int fq) const {
        const int row0 = u.pm * 256 + wr * 64 + fr, col0 = u.pn * 256 + wc * 32 + 8 * fq;
#pragma unroll
        for (int ai = 0; ai < 2; ++ai)
#pragma unroll
            for (int m = 0; m < 4; ++m) { bf16_t* rowp = O + (size_t)(row0 + ai * 128 + m * 16) * ldc + col0;
#pragma unroll
                for (int bj = 0; bj < 2; ++bj) { f32x4 v0 = acc[ai][bj][m][0], v1 = acc[ai][bj][m][1];
                    if (ACT == 2) {
#pragma unroll
                        for (int e = 0; e < 4; ++e) { const float a = fmaxf(v0[e], 0.f), b = fmaxf(v1[e], 0.f); v0[e] = a * a; v1[e] = b * b; } }
                    u32x4 w; w.x = cvt_pk_bf16(v0[0], v0[1]); w.y = cvt_pk_bf16(v0[2], v0[3]); w.z = cvt_pk_bf16(v1[0], v1[1]); w.w = cvt_pk_bf16(v1[2], v1[3]);
                    *(u32x4*)(rowp + bj * 128) = w; } }
    }
};
struct PEpiResF32 {
    static constexpr bool PERM = false, AFTER_DRAIN = false;
    const float* base; float* out; int ldc;
    __device__ __forceinline__ void operator()(const f32x4 (&acc)[2][2][4][2], const pg8::Unit& u, int wr, int wc, int fr, int fq) const {
        const int col0 = u.pn * 256 + wc * 32 + 4 * fq;
#pragma unroll
        for (int ai = 0; ai < 2; ++ai)
#pragma unroll
            for (int m = 0; m < 4; ++m) { const size_t off = (size_t)(u.pm * 256 + ai * 128 + wr * 64 + m * 16 + fr) * ldc + col0;
#pragma unroll
                for (int bj = 0; bj < 2; ++bj)
#pragma unroll
                    for (int n = 0; n < 2; ++n) { const f32x4 bs = *(const f32x4*)(base + off + bj * 128 + n * 16); *(f32x4*)(out + off + bj * 128 + n * 16) = bs + acc[ai][bj][m][n]; } }
    }
};

__device__ __forceinline__ void glueA_row(const Params& p, int row, int lane) {
    unsigned char* ws = p.ws;
    const bf16_t* pr = (const bf16_t*)(ws + WS_PROJ) + (size_t)row * DINP;
    { float v[6]; float s = 0.f;
#pragma unroll
      for (int j = 0; j < 6; ++j) { v[j] = bf2f(pr[C_HQ + lane + 64 * j]); s += v[j] * v[j]; }
      const float rstd = 1.f / sqrtf(wave_sum(s) * (1.f / QR) + EPS); bf16_t* o = (bf16_t*)(ws + WS_HQN) + (size_t)row * QR;
#pragma unroll
      for (int j = 0; j < 6; ++j) o[lane + 64 * j] = (bf16_t)f2bf(v[j] * rstd * p.in[3][lane + 64 * j]); }
    { float v[4]; float s = 0.f;
#pragma unroll
      for (int j = 0; j < 4; ++j) { v[j] = bf2f(pr[C_HKV + lane + 64 * j]); s += v[j] * v[j]; }
      const float rstd = 1.f / sqrtf(wave_sum(s) * (1.f / KVR) + EPS); bf16_t* o = (bf16_t*)(ws + WS_HKVN) + (size_t)row * KVR;
#pragma unroll
      for (int j = 0; j < 4; ++j) o[lane + 64 * j] = (bf16_t)f2bf(v[j] * rstd * p.in[4][lane + 64 * j]); }
    { bf16_t* o = (bf16_t*)(ws + WS_QN) + (size_t)row * 512; const float g = p.in[9][lane] * QS_NSA;
#pragma unroll
      for (int h = 0; h < 8; ++h) { const float v = bf2f(pr[C_QB + 64 * h + lane]); const float rstd = 1.f / sqrtf(wave_sum(v * v) * (1.f / 64) + EPS); o[64 * h + lane] = (bf16_t)f2bf(v * rstd * g); } }
    { bf16_t* os = (bf16_t*)(ws + WS_KSEL) + (size_t)row * 128; bf16_t* ow = (bf16_t*)(ws + WS_KWIN) + (size_t)row * 128;
      const float g1 = p.in[10][64 + lane], g2 = p.in[10][128 + lane];
#pragma unroll
      for (int g = 0; g < 2; ++g) {
          const float v = bf2f(pr[C_KSEL + 64 * g + lane]); const float rs = 1.f / sqrtf(wave_sum(v * v) * (1.f / 64) + EPS); os[64 * g + lane] = (bf16_t)f2bf(v * rs * g1);
          const float w = bf2f(pr[C_KWIN + 64 * g + lane]); const float rw = 1.f / sqrtf(wave_sum(w * w) * (1.f / 64) + EPS); ow[64 * g + lane] = (bf16_t)f2bf(w * rw * g2); } }
}
__device__ __forceinline__ void compress_task(const Params& p, int task, int lane) {
    unsigned char* ws = p.ws;
    const int g = task & 1, c = (task >> 1) & 127, b = (task >> 8) & 7, kv = task >> 11;
    bf16_t* dst = (bf16_t*)(ws + (kv ? WS_VCMP : WS_KCMP)) + ((size_t)(b * 128 + c) * 2 + g) * 64;
    if (c >= NCMP) { dst[lane] = 0; return; }
    const bf16_t* pr = (const bf16_t*)(ws + WS_PROJ) + (size_t)(b * SEQ + 16 * c) * DINP + (kv ? C_VCMP : C_KCMP) + 64 * g;
    const float* pe = p.in[11] + kv * 2048; const float* w1 = p.in[12] + (size_t)kv * 2048 * 128; const float* w2 = p.in[13] + kv * 128 * 64;
    float a0 = 0.f, a1 = 0.f;
    for (int r = 0; r < 32; ++r) {
        const float av = bf2f(pr[(size_t)r * DINP + lane]) + pe[r * 64 + lane];
        const float* wr = w1 + (size_t)(r * 64) * 128;
#pragma unroll 8
        for (int d = 0; d < 64; ++d) { const float a = __shfl(av, d); a0 += a * wr[d * 128 + lane]; a1 += a * wr[d * 128 + 64 + lane]; }
    }
    const float h0 = a0 / (1.f + __expf(-a0)), h1 = a1 / (1.f + __expf(-a1));
    float o = 0.f;
#pragma unroll 8
    for (int n = 0; n < 64; ++n) { o += __shfl(h0, n) * w2[n * 64 + lane] + __shfl(h1, n) * w2[(n + 64) * 64 + lane]; }
    if (kv == 0) { const float rstd = 1.f / sqrtf(wave_sum(o * o) * (1.f / 64) + EPS); o = o * rstd * p.in[10][lane]; }
    dst[lane] = (bf16_t)f2bf(o);
}

__device__ __forceinline__ void glueB_row(const Params& p, int row, int lane) {
    unsigned char* ws = p.ws;
    const int pos = row & (SEQ - 1);
    const int i = lane & 15;
    const float inv = exp2f(-(float)i * (13.287712379549449f / 16.f));
    const float ang = (float)pos * inv;
    float sn, cs; sincosf(ang, &sn, &cs);
    const float sgn = (lane & 16) ? 1.f : -1.f;
    bf16_t* q = (bf16_t*)(ws + WS_QM) + (size_t)row * MQ;
    const bf16_t* kvm = (const bf16_t*)(ws + WS_KVM) + (size_t)row * MKV;
    const bf16_t* pr = (const bf16_t*)(ws + WS_PROJ) + (size_t)row * DINP;
    bf16_t* ko = (bf16_t*)(ws + WS_KMLA) + (size_t)row * MQ;
    const float qg0 = p.in[7][lane], qg1 = p.in[7][64 + (lane & 31)], kg0 = p.in[8][lane], kg1 = p.in[8][64 + (lane & 31)];
    const float kr = bf2f(pr[C_HKR + (lane & 31)]);
#pragma unroll
    for (int h = 0; h < 8; ++h) {
        { const float v0 = bf2f(q[96 * h + lane]); const float v1 = (lane < 32) ? bf2f(q[96 * h + 64 + lane]) : 0.f;
          const float rstd = 1.f / sqrtf(wave_sum(v0 * v0 + v1 * v1) * (1.f / 96) + EPS);
          const float n0 = v0 * rstd * qg0, n1 = v1 * rstd * qg1; const float pn = __shfl_xor(n1, 16);
          const float r1 = n1 * cs + sgn * pn * sn;
          q[96 * h + lane] = (bf16_t)f2bf(n0 * QS_MLA); if (lane < 32) q[96 * h + 64 + lane] = (bf16_t)f2bf(r1 * QS_MLA); }
        { const float v0 = bf2f(kvm[128 * h + lane]); const float v1 = (lane < 32) ? kr : 0.f;
          const float rstd = 1.f / sqrtf(wave_sum(v0 * v0 + v1 * v1) * (1.f / 96) + EPS);
          const float n0 = v0 * rstd * kg0, n1 = v1 * rstd * kg1; const float pn = __shfl_xor(n1, 16);
          const float r1 = n1 * cs + sgn * pn * sn;
          ko[96 * h + lane] = (bf16_t)f2bf(n0); if (lane < 32) ko[96 * h + 64 + lane] = (bf16_t)f2bf(r1); }
    }
}

struct OnlineSm { float m, l; };
template <int DQ>
__device__ __forceinline__ void sm_key(const LAS float* q, float (&o)[64], OnlineSm& st, const bf16_t* krow, const bf16_t* vrow, float bias2) {
    float s = bias2;
#pragma unroll
    for (int c = 0; c < DQ / 8; ++c) { const bf16x8 kk = *(const bf16x8*)(krow + 8 * c); const f32x4 qa = *(const LAS f32x4*)(q + 8 * c), qb = *(const LAS f32x4*)(q + 8 * c + 4);
        s += qa[0] * bf2f((unsigned short)kk[0]) + qa[1] * bf2f((unsigned short)kk[1]) + qa[2] * bf2f((unsigned short)kk[2]) + qa[3] * bf2f((unsigned short)kk[3]);
        s += qb[0] * bf2f((unsigned short)kk[4]) + qb[1] * bf2f((unsigned short)kk[5]) + qb[2] * bf2f((unsigned short)kk[6]) + qb[3] * bf2f((unsigned short)kk[7]); }
    const float mn = fmaxf(st.m, s), al = exp2f(st.m - mn), pp = exp2f(s - mn);
    st.l = st.l * al + pp; st.m = mn;
#pragma unroll
    for (int c = 0; c < 8; ++c) { const bf16x8 vv = *(const bf16x8*)(vrow + 8 * c);
#pragma unroll
        for (int j = 0; j < 8; ++j) o[8 * c + j] = o[8 * c + j] * al + pp * bf2f((unsigned short)vv[j]); }
}
__device__ __forceinline__ float sm_finish(float (&o)[64], const OnlineSm& st, int lane) {
    const float mm = wave_max(st.m);
    const float w = (st.m == -INFINITY) ? 0.f : exp2f(st.m - mm);
    const float L = wave_sum(st.l * w);
#pragma unroll
    for (int d = 0; d < 64; ++d) o[d] *= w;
#define RS_STEP(n) { const bool up = (lane & (n)) != 0; _Pragma("unroll") for (int i = 0; i < (n); ++i) { const float keep = up ? o[(n) + i] : o[i]; const float send = up ? o[i] : o[(n) + i]; o[i] = keep + __shfl_xor(send, (n)); } }
    RS_STEP(32) RS_STEP(16) RS_STEP(8) RS_STEP(4) RS_STEP(2) RS_STEP(1)
#undef RS_STEP
    return (L > 0.f) ? o[0] / L : 0.f;
}

__device__ __forceinline__ void mla_task(const Params& p, int task, int lane, LAS float* q) {
    unsigned char* ws = p.ws;
    const int t = task & (SEQ - 1), h = (task >> 11) & 7, b = task >> 14;
    const size_t row = (size_t)b * SEQ + t;
    const bf16_t* qp = (const bf16_t*)(ws + WS_QM) + row * MQ + 96 * h;
    q[lane] = bf2f(qp[lane]); if (lane < 32) q[64 + lane] = bf2f(qp[64 + lane]);
    asm volatile("s_waitcnt lgkmcnt(0)" ::: "memory");
    float o[64];
#pragma unroll
    for (int d = 0; d < 64; ++d) o[d] = 0.f;
    OnlineSm st{-INFINITY, 0.f};
    const bf16_t* K = (const bf16_t*)(ws + WS_KMLA) + (size_t)b * SEQ * MQ + 96 * h;
    const bf16_t* V = (const bf16_t*)(ws + WS_KVM) + (size_t)b * SEQ * MKV + 128 * h + 64;
    for (int j = lane; j <= t; j += 64) sm_key<96>(q, o, st, K + (size_t)j * MQ, V + (size_t)j * MKV, 0.f);
    const float r = sm_finish(o, st, lane);
    ((bf16_t*)(ws + WS_MIX))[row * DM + 64 * h + lane] = (bf16_t)f2bf(r);
}

__device__ __forceinline__ void nsa_task(const Params& p, int task, int lane, const LAS float* tb, LAS float* q) {
    unsigned char* ws = p.ws;
    const int t = task & (SEQ - 1), g = (task >> 11) & 1, b = task >> 12;
    const size_t row = (size_t)b * SEQ + t;
    const bf16_t* pr = (const bf16_t*)(ws + WS_PROJ);
    const bf16_t* kc = (const bf16_t*)(ws + WS_KCMP) + ((size_t)b * 128 * 2 + g) * 64;
    const bf16_t* vc = (const bf16_t*)(ws + WS_VCMP) + ((size_t)b * 128 * 2 + g) * 64;
    const int blk_t = t >> 6;
    float w0 = 0.f, w1 = 0.f;
    const int c0 = lane, c1 = lane + 64;
    const int d0 = t - (16 * c0 + 31), d1 = t - (16 * c1 + 31);
    const bool v0 = d0 >= 0, v1 = (d1 >= 0) && (c1 < NCMP);
    const int ncv = (t >= 31) ? ((t - 31) >> 4) + 1 : 0;
#pragma unroll 1
    for (int r = 0; r < 4; ++r) {
        const int h = 4 * g + r;
        const bf16_t* qp = (const bf16_t*)(ws + WS_QN) + row * 512 + 64 * h;
        float s0 = 0.f, s1 = 0.f;
        { const bf16_t* k0 = kc + (size_t)c0 * 128; const bf16_t* k1 = kc + (size_t)(c1 < 128 ? c1 : 127) * 128;
#pragma unroll
          for (int c = 0; c < 8; ++c) { const bf16x8 qq = *(const bf16x8*)(qp + 8 * c), a = *(const bf16x8*)(k0 + 8 * c), bb = *(const bf16x8*)(k1 + 8 * c);
#pragma unroll
              for (int j = 0; j < 8; ++j) { const float qf = bf2f((unsigned short)qq[j]); s0 += qf * bf2f((unsigned short)a[j]); s1 += qf * bf2f((unsigned short)bb[j]); } } }
        s0 = v0 ? s0 + tb[h * 128 + (d0 < 127 ? d0 : 127)] : -INFINITY;
        s1 = v1 ? s1 + tb[h * 128 + (d1 < 127 ? d1 : 127)] : -INFINITY;
        const float mm = wave_max(fmaxf(s0, s1));
        float p0 = 0.f, p1 = 0.f;
        if (mm != -INFINITY) { p0 = v0 ? exp2f(s0 - mm) : 0.f; p1 = v1 ? exp2f(s1 - mm) : 0.f; const float sum = wave_sum(p0 + p1); const float inv = 1.f / fmaxf(sum, 1e-30f); p0 *= inv; p1 *= inv; }
        w0 += p0; w1 += p1;
        float o = 0.f;
        for (int c = 0; c < ncv; ++c) { const float pc = (c < 64) ? __shfl(p0, c) : __shfl(p1, c - 64); o += pc * bf2f(vc[(size_t)c * 128 + lane]); }
        q[128 + 64 * r + lane] = o;
    }
    unsigned selmask;
    {
        const float A0 = ((lane & 3) == 3) ? 0.5f * w0 : w0, A1 = ((lane & 3) == 3) ? 0.5f * w1 : w1;
        float G0 = A0 + __shfl_xor(A0, 1); G0 += __shfl_xor(G0, 2);
        float G1 = A1 + __shfl_xor(A1, 1); G1 += __shfl_xor(G1, 2);
        const float up0 = __shfl_up(w0, 1), up1 = __shfl_up(w1, 1), w0_63 = __shfl(w0, 63);
        const float implo = G0 + ((lane >= 4) ? 0.5f * up0 : 0.f);
        const float imphi = G1 + ((lane >= 4) ? 0.5f * up1 : 0.5f * w0_63);
        const int j = lane & 31;
        const float ilo = __shfl(implo, 4 * (lane & 15)), ihi = __shfl(imphi, 4 * (lane & 15));
        const float imp = (j < 16) ? ilo : ihi;
        float sc;
        if (j > blk_t) sc = -INFINITY; else if (j == 0 || j == blk_t || j == blk_t - 1) sc = 1e4f; else sc = imp;
        int rank = 0;
#pragma unroll
        for (int i = 0; i < 32; ++i) { const float si = __shfl(sc, i); rank += (si > sc || (si == sc && i < j)) ? 1 : 0; }
        const unsigned long long bal = __ballot(lane < 32 && rank < 16);
        selmask = (unsigned)bal;
    }
    const bf16_t* Ks = (const bf16_t*)(ws + WS_KSEL) + (size_t)b * SEQ * 128 + 64 * g;
    const bf16_t* Kw = (const bf16_t*)(ws + WS_KWIN) + (size_t)b * SEQ * 128 + 64 * g;
    const bf16_t* Vs = pr + (size_t)b * SEQ * DINP + C_VSEL + 64 * g;
    const bf16_t* Vw = pr + (size_t)b * SEQ * DINP + C_VWIN + 64 * g;
#pragma unroll 1
    for (int r = 0; r < 4; ++r) {
        const int h = 4 * g + r;
        const bf16_t* qp = (const bf16_t*)(ws + WS_QN) + row * 512 + 64 * h;
        q[lane] = bf2f(qp[lane]);
        asm volatile("s_waitcnt lgkmcnt(0)" ::: "memory");
        float o[64];
#pragma unroll
        for (int d = 0; d < 64; ++d) o[d] = 0.f;
        OnlineSm st{-INFINITY, 0.f};
        for (int jb = 0; jb <= blk_t; ++jb) {
            if (!((selmask >> jb) & 1u)) continue;
            const int j = 64 * jb + lane;
            if (j <= t) { const int dist = t - j; sm_key<64>(q, o, st, Ks + (size_t)j * 128, Vs + (size_t)j * DINP, tb[h * 128 + (dist < 127 ? dist : 127)]); }
        }
        const float osel = sm_finish(o, st, lane);
#pragma unroll
        for (int d = 0; d < 64; ++d) o[d] = 0.f;
        st.m = -INFINITY; st.l = 0.f;
        { const int jlo = (t - 511 > 0) ? t - 511 : 0;
          for (int j = jlo + lane; j <= t; j += 64) { const int dist = t - j; sm_key<64>(q, o, st, Kw + (size_t)j * 128, Vw + (size_t)j * DINP, tb[h * 128 + (dist < 127 ? dist : 127)]); } }
        const float owin = sm_finish(o, st, lane);
        const bf16_t* gp = pr + row * DINP + C_GATE;
        const float g0 = 1.f / (1.f + __expf(-bf2f(gp[h]))), g1 = 1.f / (1.f + __expf(-bf2f(gp[8 + h]))), g2 = 1.f / (1.f + __expf(-bf2f(gp[16 + h])));
        const float oc = q[128 + 64 * r + lane];
        ((bf16_t*)(ws + WS_MIX))[row * DM + 512 + 64 * h + lane] = (bf16_t)f2bf(g0 * oc + g1 * osel + g2 * owin);
    }
}

__device__ __forceinline__ void glueC_row(const Params& p, int row, int lane) {
    bf16_t* mx = (bf16_t*)(p.ws + WS_MIX) + (size_t)row * DM;
#pragma unroll
    for (int half = 0; half < 2; ++half) {
        const float* g = p.in[15 + half];
        float v[8]; float s = 0.f;
#pragma unroll
        for (int j = 0; j < 8; ++j) { v[j] = bf2f(mx[512 * half + lane + 64 * j]); s += v[j] * v[j]; }
        const float rstd = 1.f / sqrtf(wave_sum(s) * (1.f / 512) + EPS);
#pragma unroll
        for (int j = 0; j < 8; ++j) mx[512 * half + lane + 64 * j] = (bf16_t)f2bf(v[j] * rstd * g[lane + 64 * j]);
    }
}

__global__ void __launch_bounds__(512, 2) mega(Params p) {
    extern __shared__ __attribute__((aligned(16))) unsigned char lds[];
    cg::grid_group grid = cg::this_grid();
    const int tid = threadIdx.x, lane = tid & 63, wave = __builtin_amdgcn_readfirstlane(tid >> 6);
    const int G = gridDim.x, bid = blockIdx.x;
    const int gw = bid * NW + wave, NGW = G * NW;
    unsigned char* ws = p.ws;
    LAS unsigned char* L = (LAS unsigned char*)lds;

    {
        LAS float* scr = (LAS float*)(L + wave * 8704);
        constexpr int I0 = (1024 / 64) * (DINP / 32), I1 = (QR / 64) * (MQ / 32), I2 = (KVR / 64) * (MKV / 32), I3 = 16 * 32, I4 = 16 * (FF / 32), I5 = (FF / 64) * 32;
        constexpr int NIT = I0 + I1 + I2 + I3 + I4 + I5;
        for (int it = gw; it < NIT; it += NGW) {
            int r = it;
            if (r < I0) { p0_transpose_item(p.in[2], 1024, DIN, DINP, (bf16_t*)(ws + WS_WIN), scr, r, lane); continue; } r -= I0;
            if (r < I1) { p0_transpose_item(p.in[5], QR, MQ, MQ, (bf16_t*)(ws + WS_WUQ), scr, r, lane); continue; } r -= I1;
            if (r < I2) { p0_transpose_item(p.in[6], KVR, MKV, MKV, (bf16_t*)(ws + WS_WUKV), scr, r, lane); continue; } r -= I2;
            if (r < I3) { p0_transpose_item(p.in[17], 1024, 1024, 1024, (bf16_t*)(ws + WS_WO), scr, r, lane); continue; } r -= I3;
            if (r < I4) { p0_transpose_item(p.in[19], 1024, FF, FF, (bf16_t*)(ws + WS_WUP), scr, r, lane); continue; } r -= I4;
            p0_transpose_item(p.in[20], FF, 1024, 1024, (bf16_t*)(ws + WS_WDN), scr, r, lane);
        }
        for (int m = gw; m < M; m += NGW) rms_row_to_bf16(p.in[0] + (size_t)m * DM, p.in[1], (bf16_t*)(ws + WS_HB) + (size_t)m * DM, lane);
    }
    grid.sync();
    { pg8::Gemm g{(const bf16_t*)(ws + WS_HB), (const bf16_t*)(ws + WS_WIN), M, DINP, DM, DM, DM}; pg8::StaticOrder S; S.init(M, DINP, G, bid);
      PEpiBf16<0> E{(bf16_t*)(ws + WS_PROJ), DINP}; pg8::gemm_phase<PEpiBf16<0>, pg8::StaticOrder, true, true>(L, g, S, E); }
    grid.sync();
    for (int m = gw; m < M; m += NGW) glueA_row(p, m, lane);
    for (int t = gw; t < 2 * 8 * 128 * 2; t += NGW) compress_task(p, t, lane);
    grid.sync();
    { pg8::Gemm g{(const bf16_t*)(ws + WS_HQN), (const bf16_t*)(ws + WS_WUQ), M, MQ, QR, QR, QR}; pg8::StaticOrder S; S.init(M, MQ, G, bid);
      PEpiBf16<0> E{(bf16_t*)(ws + WS_QM), MQ}; pg8::gemm_phase<PEpiBf16<0>, pg8::StaticOrder, true, true>(L, g, S, E); }
    { pg8::Gemm g{(const bf16_t*)(ws + WS_HKVN), (const bf16_t*)(ws + WS_WUKV), M, MKV, KVR, KVR, KVR}; pg8::StaticOrder S; S.init(M, MKV, G, bid);
      PEpiBf16<0> E{(bf16_t*)(ws + WS_KVM), MKV}; pg8::gemm_phase<PEpiBf16<0>, pg8::StaticOrder, true, true>(L, g, S, E); }
    grid.sync();
    for (int m = gw; m < M; m += NGW) glueB_row(p, m, lane);
    grid.sync();
    {
        LAS float* tb = (LAS float*)L;
        for (int i = tid; i < 8 * 128; i += 512) { const int h = i >> 7, n = i & 127; tb[i] = p.in[14][t5_bucket(n) * 8 + h] * LOG2E; }
        __syncthreads();
        LAS float* qw = (LAS float*)(L + 4096 + wave * 2048);
#ifndef NO_NSA
        for (int t = gw; t < BATCH * 2 * SEQ; t += NGW) nsa_task(p, t, lane, tb, qw);
#endif
#ifndef NO_MLA
        for (int t = gw; t < BATCH * 8 * SEQ; t += NGW) mla_task(p, t, lane, qw);
#endif
    }
    grid.sync();
    for (int m = gw; m < M; m += NGW) glueC_row(p, m, lane);
    grid.sync();
    { pg8::Gemm g{(const bf16_t*)(ws + WS_MIX), (const bf16_t*)(ws + WS_WO), M, DM, DM, DM, DM}; pg8::StaticOrder S; S.init(M, DM, G, bid);
      PEpiResF32 E{p.in[0], p.out, DM}; pg8::gemm_phase<PEpiResF32, pg8::StaticOrder, true, true>(L, g, S, E); }
    grid.sync();
    for (int m = gw; m < M; m += NGW) rms_row_to_bf16(p.out + (size_t)m * DM, p.in[18], (bf16_t*)(ws + WS_H2) + (size_t)m * DM, lane);
    grid.sync();
    { pg8::Gemm g{(const bf16_t*)(ws + WS_H2), (const bf16_t*)(ws + WS_WUP), M, FF, DM, DM, DM}; pg8::StaticOrder S; S.init(M, FF, G, bid);
      PEpiBf16<2> E{(bf16_t*)(ws + WS_HID), FF}; pg8::gemm_phase<PEpiBf16<2>, pg8::StaticOrder, true, true>(L, g, S, E); }
    grid.sync();
    { pg8::Gemm g{(const bf16_t*)(ws + WS_HID), (const bf16_t*)(ws + WS_WDN), M, DM, FF, FF, FF}; pg8::StaticOrder S; S.init(M, DM, G, bid);
      PEpiResF32 E{p.out, p.out, DM}; pg8::gemm_phase<PEpiResF32, pg8::StaticOrder, true, true>(L, g, S, E); }
}

extern "C" void kernel_launch(void* const* d_in, const int* in_sizes, int n_in, void* d_out, int out_size,
                              void* d_ws, size_t ws_size, hipStream_t stream) {
    static int grid_blocks = 0;
    if (!grid_blocks) {
        int dev = 0, cus = 0, per_cu = 0;
        (void)hipGetDevice(&dev);
        (void)hipDeviceGetAttribute(&cus, hipDeviceAttributeMultiprocessorCount, dev);
        (void)hipFuncSetAttribute((const void*)mega, hipFuncAttributeMaxDynamicSharedMemorySize, LDS_BYTES);
        (void)hipOccupancyMaxActiveBlocksPerMultiprocessor(&per_cu, (const void*)mega, 512, LDS_BYTES);
        if (per_cu != 1) fprintf(stderr, "note: occupancy query reports %d blocks/CU; launching 1 per CU\n", per_cu);
        grid_blocks = cus;
        if (n_in != 21 || out_size != M * DM || ws_size < 256 * MiB) fprintf(stderr, "unexpected shapes: n_in %d out %d ws %zu\n", n_in, out_size, ws_size);
    }
    Params p{};
    for (int i = 0; i < 21; ++i) p.in[i] = (const float*)d_in[i];
    p.out = (float*)d_out; p.ws = (unsigned char*)d_ws;
    void* args[] = {&p};
    hipError_t e = hipLaunchCooperativeKernel((const void*)mega, dim3(grid_blocks), dim3(512), args, LDS_BYTES, stream);
    if (e != hipSuccess) fprintf(stderr, "cooperative launch failed: %s (grid %d)\n", hipGetErrorString(e), grid_blocks);
}
```

```cpp
#include <hip/hip_runtime.h>
#include <hip/hip_cooperative_groups.h>
#include <cstdio>
#include <cstdint>
namespace cg = cooperative_groups;

#define LAS __attribute__((address_space(3)))
typedef unsigned short bf16_t;
typedef short bf16x8 __attribute__((ext_vector_type(8)));
typedef float f32x4 __attribute__((ext_vector_type(4)));
typedef unsigned u32x4 __attribute__((ext_vector_type(4)));
typedef unsigned u32x2 __attribute__((ext_vector_type(2)));

constexpr int BATCH = 8, SEQ = 2048, DM = 1024, M = BATCH * SEQ;
constexpr int DIN = 1976, DINP = 2048;
constexpr int C_HQ = 0, C_HKV = 384, C_HKR = 640, C_QB = 672, C_KVB = 1184, C_GATE = 1952;
constexpr int C_KCMP = C_KVB, C_VCMP = C_KVB + 128, C_KSEL = C_KVB + 256, C_VSEL = C_KVB + 384, C_KWIN = C_KVB + 512, C_VWIN = C_KVB + 640;
constexpr int QR = 384, KVR = 256, MQ = 768, MKV = 1024, FF = 4096;
constexpr int NCMP = 127;
constexpr float EPS = 1e-6f;
constexpr float LOG2E = 1.4426950408889634f;
constexpr float QS_MLA = 0.10206207261596577f * LOG2E;
constexpr float QS_NSA = 0.125f * LOG2E;

constexpr size_t MiB = 1u << 20;
constexpr size_t WS_WIN = 1 * MiB, WS_WUQ = 5 * MiB, WS_WUKV = 6 * MiB, WS_WO = 7 * MiB, WS_WUP = 9 * MiB, WS_WDN = 17 * MiB;
constexpr size_t WS_KCMP = 26 * MiB, WS_VCMP = 26 * MiB + 512 * 1024;
constexpr size_t WS_HB = 32 * MiB;
constexpr size_t WS_MIX = 32 * MiB;
constexpr size_t WS_PROJ = 64 * MiB;
constexpr size_t WS_QM = 128 * MiB;
constexpr size_t WS_KVM = 152 * MiB;
constexpr size_t WS_KMLA = 184 * MiB;
constexpr size_t WS_QN = 208 * MiB;
constexpr size_t WS_KSEL = 224 * MiB;
constexpr size_t WS_KWIN = 228 * MiB;
constexpr size_t WS_HQN = 232 * MiB;
constexpr size_t WS_HKVN = 244 * MiB;
constexpr size_t WS_H2 = 192 * MiB;
constexpr size_t WS_HID = 64 * MiB;

constexpr int LDS_BYTES = 147456;
constexpr int NW = 8;

struct Params {
    const float* in[21];
    float* out;
    unsigned char* ws;
};

typedef const float* cfptr_t;
__device__ __forceinline__ const float* inptr(int i) {
    const __attribute__((address_space(4))) char* ka = (const __attribute__((address_space(4))) char*)__builtin_amdgcn_kernarg_segment_ptr();
    int off = i * 8; asm volatile("" : "+s"(off));
    return *(const __attribute__((address_space(4))) cfptr_t*)(ka + off);
}
__device__ __forceinline__ unsigned f2bf(float f) { unsigned u = __builtin_bit_cast(unsigned, f); return (u + 0x7fffu + ((u >> 16) & 1u)) >> 16; }
__device__ __forceinline__ float bf2f(unsigned b) { return __builtin_bit_cast(float, b << 16); }
__device__ __forceinline__ unsigned pk2(float lo, float hi) { return f2bf(lo) | (f2bf(hi) << 16); }
__device__ __forceinline__ float wave_sum(float v) {
#pragma unroll
    for (int o = 1; o < 64; o <<= 1) v += __shfl_xor(v, o);
    return v;
}
__device__ __forceinline__ float wave_max(float v) {
#pragma unroll
    for (int o = 1; o < 64; o <<= 1) v = fmaxf(v, __shfl_xor(v, o));
    return v;
}
__device__ __forceinline__ int t5_bucket(int n) {
    if (n < 16) return n;
    int b = 16;
    b += (n >= 19); b += (n >= 21); b += (n >= 24); b += (n >= 27); b += (n >= 31); b += (n >= 35); b += (n >= 40); b += (n >= 46);
    b += (n >= 52); b += (n >= 59); b += (n >= 67); b += (n >= 77); b += (n >= 87); b += (n >= 99); b += (n >= 113);
    return b;
}

__device__ __forceinline__ void p0_transpose_item(const float* W, int K, int N, int Npad, bf16_t* WT, LAS float* scr, int item, int lane) {
    const int nblk = Npad / 32, kb = item / nblk, nb = item % nblk, k0 = 64 * kb, n0 = 32 * nb;
    const int nn = n0 + (lane & 31);
#pragma unroll 8
    for (int i = 0; i < 32; ++i) { const int kk = 2 * i + (lane >> 5); scr[kk * 33 + (lane & 31)] = (nn < N) ? W[(size_t)(k0 + kk) * N + nn] : 0.f; }
    asm volatile("s_waitcnt lgkmcnt(0)" ::: "memory");
    const int c = lane & 7;
#pragma unroll
    for (int j = 0; j < 4; ++j) { const int n = (lane >> 3) + 8 * j; const LAS float* s = scr + (8 * c) * 33 + n;
        u32x4 o; o.x = pk2(s[0 * 33], s[1 * 33]); o.y = pk2(s[2 * 33], s[3 * 33]); o.z = pk2(s[4 * 33], s[5 * 33]); o.w = pk2(s[6 * 33], s[7 * 33]);
        *(u32x4*)(WT + (size_t)(n0 + n) * K + k0 + 8 * c) = o; }
    asm volatile("s_waitcnt lgkmcnt(0)" ::: "memory");
}
__device__ __forceinline__ void rms_row_to_bf16(const float* xrow, const float* g, bf16_t* orow, int lane) {
    const f32x4* xr = (const f32x4*)xrow + lane; const f32x4* gr = (const f32x4*)g + lane;
    f32x4 v[4]; float s = 0.f;
#pragma unroll
    for (int j = 0; j < 4; ++j) { v[j] = xr[64 * j]; s += (v[j].x * v[j].x + v[j].y * v[j].y) + (v[j].z * v[j].z + v[j].w * v[j].w); }
    const float rstd = 1.f / sqrtf(wave_sum(s) * (1.f / DM) + EPS);
    unsigned long long* o8 = (unsigned long long*)orow + lane;
#pragma unroll
    for (int j = 0; j < 4; ++j) { const f32x4 gg = gr[64 * j];
        o8[64 * j] = (unsigned long long)pk2(v[j].x * rstd * gg.x, v[j].y * rstd * gg.y) | ((unsigned long long)pk2(v[j].z * rstd * gg.z, v[j].w * rstd * gg.w) << 32); }
}

template <class Epi>
__device__ __forceinline__ void gemm_simple(const bf16_t* A, int lda, const bf16_t* Bt, int ldb, int Mr, int N, int K, const Epi& epi, int gw, int NGW, int lane) {
    const int tn_cnt = N / 64, ntiles = (Mr / 64) * tn_cnt;
    const int fr = lane & 15, fq = lane >> 4;
    for (int tile = gw; tile < ntiles; tile += NGW) {
        const int tm = tile / tn_cnt, tn = tile % tn_cnt;
        f32x4 acc[4][4];
#pragma unroll
        for (int m = 0; m < 4; ++m)
#pragma unroll
            for (int n = 0; n < 4; ++n) acc[m][n] = (f32x4){0.f, 0.f, 0.f, 0.f};
        const bf16_t* ap = A + (size_t)(tm * 64 + fr) * lda + fq * 8;
        const bf16_t* bp = Bt + (size_t)(tn * 64 + fr) * ldb + fq * 8;
        for (int k0 = 0; k0 < K; k0 += 32) {
            bf16x8 a[4], b[4];
#pragma unroll
            for (int m = 0; m < 4; ++m) a[m] = *(const bf16x8*)(ap + (size_t)(16 * m) * lda + k0);
#pragma unroll
            for (int n = 0; n < 4; ++n) b[n] = *(const bf16x8*)(bp + (size_t)(16 * n) * ldb + k0);
#pragma unroll
            for (int m = 0; m < 4; ++m)
#pragma unroll
                for (int n = 0; n < 4; ++n) acc[m][n] = __builtin_amdgcn_mfma_f32_16x16x32_bf16(a[m], b[n], acc[m][n], 0, 0, 0);
        }
#pragma unroll
        for (int m = 0; m < 4; ++m)
#pragma unroll
            for (int n = 0; n < 4; ++n)
#pragma unroll
                for (int j = 0; j < 4; ++j) epi(tm * 64 + 16 * m + fq * 4 + j, tn * 64 + 16 * n + fr, acc[m][n][j]);
    }
}
struct EpiStoreBf16 { bf16_t* C; int ldc; __device__ __forceinline__ void operator()(int r, int c, float v) const { C[(size_t)r * ldc + c] = (bf16_t)f2bf(v); } };
struct EpiRelu2Bf16 { bf16_t* C; int ldc; __device__ __forceinline__ void operator()(int r, int c, float v) const { const float t = fmaxf(v, 0.f); C[(size_t)r * ldc + c] = (bf16_t)f2bf(t * t); } };
struct EpiResF32 { const float* base; float* out; int ldc; __device__ __forceinline__ void operator()(int r, int c, float v) const { out[(size_t)r * ldc + c] = base[(size_t)r * ldc + c] + v; } };

__device__ __forceinline__ int opaque_tid() { int t = threadIdx.x; asm volatile("" : "+v"(t)); return t; }
namespace pg8 {
#define PG8_LAS __attribute__((address_space(3)))
typedef unsigned short bf16_t;
typedef short bf16x8 __attribute__((ext_vector_type(8)));
typedef float f32x4 __attribute__((ext_vector_type(4)));
typedef unsigned u32x4 __attribute__((ext_vector_type(4)));
constexpr int BM = 256, BK = 64, HALF = 128, HTB = HALF * BK * 2  , STAGE_BYTES = 8 * HTB, NXCD = 8, WGM = 8;

__host__ __device__ __forceinline__ int lds_byte(int r, int c) { const int st = (r >> 4) * 2 + (c >> 5), rr = r & 15, cc = c & 31, ob = rr * 64 + cc * 2; return st * 1024 + (ob ^ (((ob >> 9) & 1) << 5)); }
__host__ __device__ __forceinline__ void stage_rc(int b, int& R, int& C) { const int st = b / 1024, sb = b % 1024, swz = sb ^ (((sb >> 9) & 1) << 5); R = (st >> 1) * 16 + swz / 64; C = (st & 1) * 32 + (swz % 64) / 2; }
__host__ __device__ __forceinline__ int perm32(int rho) { const int n = rho >> 4, i = rho & 15; return 8 * (i >> 2) + 4 * n + (i & 3); }

struct Unit { int pm, pn; };
struct Gemm { const bf16_t* A; const bf16_t* Bt; int M, N, K, lda, ldb; };

struct StaticOrder {
    int nM, nN, nwg, G, c;
    __host__ __device__ void init(int M, int N, int G_, int c_) { nM = M / BM; nN = N / BM; nwg = nM * nN; G = G_; c = c_; }
    __host__ __device__ bool next(int i, Unit& u) const {
        const long L = (long)i * G + c; if (L >= nwg) return false;
        int wgid = (int)L; { const int q = nwg / NXCD, r = nwg % NXCD, xcd = wgid % NXCD, off = wgid / NXCD; wgid = (xcd < r ? xcd * (q + 1) : r * (q + 1) + (xcd - r) * q) + off; }
        const int nig = WGM * nN, gid = wgid / nig, fm = gid * WGM, gsz = (nM - fm) < WGM ? (nM - fm) : WGM;
        u.pm = fm + ((wgid % nig) % gsz); u.pn = (wgid % nig) / gsz; return true;
    }
    __device__ __forceinline__ void a_ready(const Unit&) const {}
    __device__ __forceinline__ void done(const Unit&) const {}
};

template <class Epi, class Sched, bool ALIGN_EPI = false, bool SP2 = false>
__device__ __forceinline__ void gemm_phase(PG8_LAS unsigned char* lds, const Gemm g, const Sched& S, const Epi& E) {
    const int tid = opaque_tid(), wid = __builtin_amdgcn_readfirstlane(tid >> 6), lane = tid & 63, wr = wid >> 2, wc = wid & 3, fr = lane & 15, fq = lane >> 4;
    const int K = g.K, nt = K / BK;
    unsigned voffA[2], voffB[2];
#pragma unroll
    for (int i = 0; i < 2; ++i) { int R, C; stage_rc(tid * 16 + i * 8192, R, C); const int Rb = Epi::PERM ? ((R & ~31) + perm32(R & 31)) : R;
        voffA[i] = (unsigned)(R * g.lda + C) * 2u; voffB[i] = (unsigned)(Rb * g.ldb + C) * 2u; }
    const size_t kstep = (size_t)(BK * 2);
    const size_t hstepA = (size_t)HALF * g.lda * 2, hstepB = (size_t)HALF * g.ldb * 2;
    const size_t tstepA = 2 * hstepA, tstepB = 2 * hstepB;
    const unsigned ldsw = (unsigned)wid * 1024u;
    const int aoff = lds_byte(wr * 64 + fr, fq * 8), boff = lds_byte(wc * 32 + fr, fq * 8);
#define PG8_SA(b, h) (((b) * 2 + (h)) * HTB)
#define PG8_SB(b, h) ((4 + (b) * 2 + (h)) * HTB)
#define PG8_STAGE(bufoff, gbase, voff) do { _Pragma("unroll") for (int _i = 0; _i < 2; ++_i) \
        __builtin_amdgcn_global_load_lds((const unsigned*)((const char*)(gbase) + (voff)[_i]), (PG8_LAS unsigned*)(lds + (bufoff) + ldsw + _i * 8192), 16, 0, 0); } while (0)
#define PG8_LDA(dst, b, h) do { _Pragma("unroll") for (int m = 0; m < 4; ++m) _Pragma("unroll") for (int k = 0; k < 2; ++k) dst[m][k] = *(const PG8_LAS bf16x8*)(lds + PG8_SA(b, h) + aoff + m * 2048 + k * 1024); } while (0)
#define PG8_LDB(dst, b, h) do { _Pragma("unroll") for (int n = 0; n < 2; ++n) _Pragma("unroll") for (int k = 0; k < 2; ++k) dst[n][k] = *(const PG8_LAS bf16x8*)(lds + PG8_SB(b, h) + boff + n * 2048 + k * 1024); } while (0)
#define PG8_MMA(ai, bj, At, Bt) do { __builtin_amdgcn_s_setprio(1); _Pragma("unroll") for (int m = 0; m < 4; ++m) _Pragma("unroll") for (int n = 0; n < 2; ++n) _Pragma("unroll") for (int k = 0; k < 2; ++k) \
        acc[ai][bj][m][n] = __builtin_amdgcn_mfma_f32_16x16x32_bf16(Bt[n][k], At[m][k], acc[ai][bj][m][n], 0, 0, 0); __builtin_amdgcn_s_setprio(0); } while (0)
#define PG8_WAIT_V(n) asm volatile("s_waitcnt vmcnt(" #n ")" ::: "memory")
#define PG8_WAIT_L(n) asm volatile("s_waitcnt lgkmcnt(" #n ")" ::: "memory")
#define PG8_BAR __builtin_amdgcn_s_barrier()
#define PG8_SCHED __builtin_amdgcn_sched_barrier(0)
    Unit cur, nxt; int ui = 0;
    if (!S.next(0, cur)) return;
    f32x4 acc[2][2][4][2];
#pragma unroll
    for (int a = 0; a < 2; ++a)
#pragma unroll
        for (int b = 0; b < 2; ++b)
#pragma unroll
            for (int m = 0; m < 4; ++m)
#pragma unroll
                for (int n = 0; n < 2; ++n) acc[a][b][m][n] = (f32x4){0.f, 0.f, 0.f, 0.f};
    bf16x8 At[4][2], B0[2][2], B1[2][2];
    const char* cA = (const char*)g.A + (size_t)cur.pm * tstepA; const char* cB = (const char*)g.Bt + (size_t)cur.pn * tstepB;
    S.a_ready(cur);
    if constexpr (SP2) {
        PG8_STAGE(PG8_SB(0, 0), cB, voffB); PG8_STAGE(PG8_SB(0, 1), cB + hstepB, voffB); PG8_STAGE(PG8_SA(0, 0), cA, voffA); PG8_STAGE(PG8_SA(0, 1), cA + hstepA, voffA);
        if (wr == 1) PG8_BAR;
        PG8_WAIT_V(2); PG8_BAR;
        PG8_STAGE(PG8_SB(1, 0), cB + kstep, voffB); PG8_STAGE(PG8_SA(1, 0), cA + kstep, voffA); PG8_STAGE(PG8_SB(1, 1), cB + hstepB + kstep, voffB);
        PG8_WAIT_V(6); PG8_BAR;
    } else {
        PG8_STAGE(PG8_SB(0, 0), cB, voffB); PG8_STAGE(PG8_SA(0, 0), cA, voffA); PG8_STAGE(PG8_SB(0, 1), cB + hstepB, voffB); PG8_STAGE(PG8_SA(0, 1), cA + hstepA, voffA);
        if (wr == 1) PG8_BAR;
        PG8_WAIT_V(4); PG8_BAR;
        PG8_STAGE(PG8_SB(1, 0), cB + kstep, voffB); PG8_STAGE(PG8_SA(1, 0), cA + kstep, voffA); PG8_STAGE(PG8_SB(1, 1), cB + hstepB + kstep, voffB);
        PG8_WAIT_V(6); PG8_BAR;
    }
    for (;;) {
        const bool has_next = S.next(ui + 1, nxt);
        const char* nA = has_next ? (const char*)g.A + (size_t)nxt.pm * tstepA : cA; const char* nB = has_next ? (const char*)g.Bt + (size_t)nxt.pn * tstepB : cB;
        for (int t = 0; t < nt; t += 2) {
            const bool last = (t == nt - 2);
            const char* a1 = cA + (size_t)(t + 1) * kstep;
            const char* a2 = last ? nA : cA + (size_t)(t + 2) * kstep; const char* b2 = last ? nB : cB + (size_t)(t + 2) * kstep;
            const char* a3 = a2 + kstep; const char* b3 = b2 + kstep;
            if (last && has_next) S.a_ready(nxt);
            if constexpr (SP2) {
            PG8_LDB(B0, 0, 0); PG8_LDB(B1, 0, 1); PG8_SCHED; PG8_LDA(At, 0, 0); PG8_STAGE(PG8_SA(1, 1), a1 + hstepA, voffA);
            PG8_WAIT_V(8); PG8_WAIT_L(0); PG8_BAR; PG8_MMA(0, 0, At, B0); PG8_MMA(0, 1, At, B1); PG8_BAR; PG8_SCHED;
            PG8_LDA(At, 0, 1); PG8_STAGE(PG8_SB(0, 0), b2, voffB); PG8_STAGE(PG8_SB(0, 1), b2 + hstepB, voffB); PG8_STAGE(PG8_SA(0, 0), a2, voffA);
            PG8_WAIT_V(8); PG8_WAIT_L(0); PG8_BAR; PG8_MMA(1, 0, At, B0); PG8_MMA(1, 1, At, B1); PG8_BAR; PG8_SCHED;
            PG8_LDB(B0, 1, 0); PG8_LDB(B1, 1, 1); PG8_SCHED; PG8_LDA(At, 1, 0); PG8_STAGE(PG8_SA(0, 1), a2 + hstepA, voffA);
            PG8_WAIT_V(8); PG8_WAIT_L(0); PG8_BAR; PG8_MMA(0, 0, At, B0); PG8_MMA(0, 1, At, B1); PG8_BAR; PG8_SCHED;
            PG8_LDA(At, 1, 1); PG8_STAGE(PG8_SB(1, 0), b3, voffB); PG8_STAGE(PG8_SB(1, 1), b3 + hstepB, voffB); PG8_STAGE(PG8_SA(1, 0), a3, voffA);
            PG8_WAIT_V(8); PG8_WAIT_L(0); PG8_BAR; PG8_MMA(1, 0, At, B0); PG8_MMA(1, 1, At, B1); PG8_BAR; PG8_SCHED;
            } else {
            PG8_LDB(B0, 0, 0); PG8_SCHED; PG8_LDA(At, 0, 0); PG8_STAGE(PG8_SA(1, 1), a1 + hstepA, voffA);
            PG8_WAIT_L(8); PG8_BAR; PG8_WAIT_L(0); PG8_MMA(0, 0, At, B0); PG8_BAR; PG8_SCHED;
            PG8_LDB(B1, 0, 1); PG8_STAGE(PG8_SB(0, 0), b2, voffB);
            PG8_BAR; PG8_WAIT_L(0); PG8_MMA(0, 1, At, B1); PG8_BAR;
            PG8_LDA(At, 0, 1); PG8_STAGE(PG8_SA(0, 0), a2, voffA);
            PG8_BAR; PG8_WAIT_L(0); PG8_MMA(1, 0, At, B0); PG8_BAR; PG8_SCHED;
            PG8_STAGE(PG8_SB(0, 1), b2 + hstepB, voffB);
            PG8_WAIT_V(6); PG8_BAR; PG8_MMA(1, 1, At, B1); PG8_BAR;
            PG8_LDB(B0, 1, 0); PG8_SCHED; PG8_LDA(At, 1, 0); PG8_STAGE(PG8_SA(0, 1), a2 + hstepA, voffA);
            PG8_WAIT_L(8); PG8_BAR; PG8_WAIT_L(0); PG8_MMA(0, 0, At, B0); PG8_BAR; PG8_SCHED;
            PG8_LDB(B1, 1, 1); PG8_STAGE(PG8_SB(1, 0), b3, voffB);
            PG8_BAR; PG8_WAIT_L(0); PG8_MMA(0, 1, At, B1); PG8_BAR;
            PG8_LDA(At, 1, 1); PG8_STAGE(PG8_SA(1, 0), a3, voffA);
            PG8_BAR; PG8_WAIT_L(0); PG8_MMA(1, 0, At, B0); PG8_BAR; PG8_SCHED;
            PG8_STAGE(PG8_SB(1, 1), b3 + hstepB, voffB);
            PG8_WAIT_V(6); PG8_BAR; PG8_MMA(1, 1, At, B1); PG8_BAR;
            }
        }
        if constexpr (ALIGN_EPI) { if (wr == 0) PG8_BAR; }
        if constexpr (!Epi::AFTER_DRAIN) { E(acc, cur, wr, wc, fr, fq); S.done(cur); }
        if (!has_next) break;
#pragma unroll
        for (int a = 0; a < 2; ++a)
#pragma unroll
            for (int b = 0; b < 2; ++b)
#pragma unroll
                for (int m = 0; m < 4; ++m)
#pragma unroll
                    for (int n = 0; n < 2; ++n) acc[a][b][m][n] = (f32x4){0.f, 0.f, 0.f, 0.f};
        cur = nxt; cA = nA; cB = nB; ++ui;
        if constexpr (ALIGN_EPI) { if (wr == 1) PG8_BAR; }
    }
    PG8_WAIT_V(0);
    if constexpr (!ALIGN_EPI) { if (wr == 0) PG8_BAR; }
    PG8_BAR;
    if constexpr (Epi::AFTER_DRAIN) { E.fused(acc, cur, wr, wc, fr, fq, lds, wid, lane); S.done(cur); }
#undef PG8_SA
#undef PG8_SB
#undef PG8_STAGE
#undef PG8_LDA
#undef PG8_LDB
#undef PG8_MMA
#undef PG8_WAIT_V
#undef PG8_WAIT_L
#undef PG8_BAR
#undef PG8_SCHED
}
}

__device__ __forceinline__ unsigned cvt_pk_bf16(float lo, float hi) { unsigned r; asm volatile("v_cvt_pk_bf16_f32 %0, %1, %2" : "=v"(r) : "v"(lo), "v"(hi)); return r; }
template <int ACT> struct PEpiBf16 {
    static constexpr bool PERM = true, AFTER_DRAIN = false;
    bf16_t* O; int ldc;
    __device__ __forceinline__ void operator()(const f32x4 (&acc)[2][2][4][2], const pg8::Unit& u, int wr, int wc, int fr, int fq) const {
        const int row0 = u.pm * 256 + wr * 64 + fr, col0 = u.pn * 256 + wc * 32 + 8 * fq;
#pragma unroll
        for (int ai = 0; ai < 2; ++ai)
#pragma unroll
            for (int m = 0; m < 4; ++m) { bf16_t* rowp = O + (size_t)(row0 + ai * 128 + m * 16) * ldc + col0;
#pragma unroll
                for (int bj = 0; bj < 2; ++bj) { f32x4 v0 = acc[ai][bj][m][0], v1 = acc[ai][bj][m][1];
                    if (ACT == 2) {
#pragma unroll
                        for (int e = 0; e < 4; ++e) { const float a = fmaxf(v0[e], 0.f), b = fmaxf(v1[e], 0.f); v0[e] = a * a; v1[e] = b * b; } }
                    u32x4 w; w.x = cvt_pk_bf16(v0[0], v0[1]); w.y = cvt_pk_bf16(v0[2], v0[3]); w.z = cvt_pk_bf16(v1[0], v1[1]); w.w = cvt_pk_bf16(v1[2], v1[3]);
                    *(u32x4*)(rowp + bj * 128) = w; } }
    }
};
struct PEpiResF32 {
    static constexpr bool PERM = false, AFTER_DRAIN = false;
    const float* base; float* out; int ldc;
    __device__ __forceinline__ void operator()(const f32x4 (&acc)[2][2][4][2], const pg8::Unit& u, int wr, int wc, int fr, int fq) const {
        const int col0 = u.pn * 256 + wc * 32 + 4 * fq;
#pragma unroll
        for (int ai = 0; ai < 2; ++ai)
#pragma unroll
            for (int m = 0; m < 4; ++m) { const size_t off = (size_t)(u.pm * 256 + ai * 128 + wr * 64 + m * 16 + fr) * ldc + col0;
#pragma unroll
                for (int bj = 0; bj < 2; ++bj)
#pragma unroll
                    for (int n = 0; n < 2; ++n) { const f32x4 bs = *(const f32x4*)(base + off + bj * 128 + n * 16); *(f32x4*)(out + off + bj * 128 + n * 16) = bs + acc[ai][bj][m][n]; } }
    }
};

__device__ __forceinline__ void glueA_row(unsigned char* ws, int row, int lane) {
    const bf16_t* pr = (const bf16_t*)(ws + WS_PROJ) + (size_t)row * DINP;
    { float v[6]; float s = 0.f;
#pragma unroll
      for (int j = 0; j < 6; ++j) { v[j] = bf2f(pr[C_HQ + lane + 64 * j]); s += v[j] * v[j]; }
      const float rstd = 1.f / sqrtf(wave_sum(s) * (1.f / QR) + EPS); bf16_t* o = (bf16_t*)(ws + WS_HQN) + (size_t)row * QR;
#pragma unroll
      for (int j = 0; j < 6; ++j) o[lane + 64 * j] = (bf16_t)f2bf(v[j] * rstd * inptr(3)[lane + 64 * j]); }
    { float v[4]; float s = 0.f;
#pragma unroll
      for (int j = 0; j < 4; ++j) { v[j] = bf2f(pr[C_HKV + lane + 64 * j]); s += v[j] * v[j]; }
      const float rstd = 1.f / sqrtf(wave_sum(s) * (1.f / KVR) + EPS); bf16_t* o = (bf16_t*)(ws + WS_HKVN) + (size_t)row * KVR;
#pragma unroll
      for (int j = 0; j < 4; ++j) o[lane + 64 * j] = (bf16_t)f2bf(v[j] * rstd * inptr(4)[lane + 64 * j]); }
    { bf16_t* o = (bf16_t*)(ws + WS_QN) + (size_t)row * 512; const float g = inptr(9)[lane] * QS_NSA;
#pragma unroll
      for (int h = 0; h < 8; ++h) { const float v = bf2f(pr[C_QB + 64 * h + lane]); const float rstd = 1.f / sqrtf(wave_sum(v * v) * (1.f / 64) + EPS); o[64 * h + lane] = (bf16_t)f2bf(v * rstd * g); } }
    { bf16_t* os = (bf16_t*)(ws + WS_KSEL) + (size_t)row * 128; bf16_t* ow = (bf16_t*)(ws + WS_KWIN) + (size_t)row * 128;
      const float g1 = inptr(10)[64 + lane], g2 = inptr(10)[128 + lane];
#pragma unroll
      for (int g = 0; g < 2; ++g) {
          const float v = bf2f(pr[C_KSEL + 64 * g + lane]); const float rs = 1.f / sqrtf(wave_sum(v * v) * (1.f / 64) + EPS); os[64 * g + lane] = (bf16_t)f2bf(v * rs * g1);
          const float w = bf2f(pr[C_KWIN + 64 * g + lane]); const float rw = 1.f / sqrtf(wave_sum(w * w) * (1.f / 64) + EPS); ow[64 * g + lane] = (bf16_t)f2bf(w * rw * g2); } }
}
__device__ __forceinline__ void compress_task(unsigned char* ws, int task, int lane) {
    const int g = task & 1, c = (task >> 1) & 127, b = (task >> 8) & 7, kv = task >> 11;
    bf16_t* dst = (bf16_t*)(ws + (kv ? WS_VCMP : WS_KCMP)) + ((size_t)(b * 128 + c) * 2 + g) * 64;
    if (c >= NCMP) { dst[lane] = 0; return; }
    const bf16_t* pr = (const bf16_t*)(ws + WS_PROJ) + (size_t)(b * SEQ + 16 * c) * DINP + (kv ? C_VCMP : C_KCMP) + 64 * g;
    const float* pe = inptr(11) + kv * 2048; const float* w1 = inptr(12) + (size_t)kv * 2048 * 128; const float* w2 = inptr(13) + kv * 128 * 64;
    float a0 = 0.f, a1 = 0.f;
    for (int r = 0; r < 32; ++r) {
        const float av = bf2f(pr[(size_t)r * DINP + lane]) + pe[r * 64 + lane];
        const float* wr = w1 + (size_t)(r * 64) * 128;
#pragma unroll 8
        for (int d = 0; d < 64; ++d) { const float a = __shfl(av, d); a0 += a * wr[d * 128 + lane]; a1 += a * wr[d * 128 + 64 + lane]; }
    }
    const float h0 = a0 / (1.f + __expf(-a0)), h1 = a1 / (1.f + __expf(-a1));
    float o = 0.f;
#pragma unroll 8
    for (int n = 0; n < 64; ++n) { o += __shfl(h0, n) * w2[n * 64 + lane] + __shfl(h1, n) * w2[(n + 64) * 64 + lane]; }
    if (kv == 0) { const float rstd = 1.f / sqrtf(wave_sum(o * o) * (1.f / 64) + EPS); o = o * rstd * inptr(10)[lane]; }
    dst[lane] = (bf16_t)f2bf(o);
}

__device__ __forceinline__ void glueB_row(unsigned char* ws, int row, int lane) {
    const int pos = row & (SEQ - 1);
    const int i = lane & 15;
    const float inv = exp2f(-(float)i * (13.287712379549449f / 16.f));
    const float ang = (float)pos * inv;
    float sn, cs; sincosf(ang, &sn, &cs);
    const float sgn = (lane & 16) ? 1.f : -1.f;
    bf16_t* q = (bf16_t*)(ws + WS_QM) + (size_t)row * MQ;
    const bf16_t* kvm = (const bf16_t*)(ws + WS_KVM) + (size_t)row * MKV;
    const bf16_t* pr = (const bf16_t*)(ws + WS_PROJ) + (size_t)row * DINP;
    bf16_t* ko = (bf16_t*)(ws + WS_KMLA) + (size_t)row * MQ;
    const float qg0 = inptr(7)[lane], qg1 = inptr(7)[64 + (lane & 31)], kg0 = inptr(8)[lane], kg1 = inptr(8)[64 + (lane & 31)];
    const float kr = bf2f(pr[C_HKR + (lane & 31)]);
#pragma unroll
    for (int h = 0; h < 8; ++h) {
        { const float v0 = bf2f(q[96 * h + lane]); const float v1 = (lane < 32) ? bf2f(q[96 * h + 64 + lane]) : 0.f;
          const float rstd = 1.f / sqrtf(wave_sum(v0 * v0 + v1 * v1) * (1.f / 96) + EPS);
          const float n0 = v0 * rstd * qg0, n1 = v1 * rstd * qg1; const float pn = __shfl_xor(n1, 16);
          const float r1 = n1 * cs + sgn * pn * sn;
          q[96 * h + lane] = (bf16_t)f2bf(n0 * QS_MLA); if (lane < 32) q[96 * h + 64 + lane] = (bf16_t)f2bf(r1 * QS_MLA); }
        { const float v0 = bf2f(kvm[128 * h + lane]); const float v1 = (lane < 32) ? kr : 0.f;
          const float rstd = 1.f / sqrtf(wave_sum(v0 * v0 + v1 * v1) * (1.f / 96) + EPS);
          const float n0 = v0 * rstd * kg0, n1 = v1 * rstd * kg1; const float pn = __shfl_xor(n1, 16);
          const float r1 = n1 * cs + sgn * pn * sn;
          ko[96 * h + lane] = (bf16_t)f2bf(n0); if (lane < 32) ko[96 * h + 64 + lane] = (bf16_t)f2bf(r1); }
    }
}

struct OnlineSm { float m, l; };
template <int DQ>
__device__ __forceinline__ void sm_key(const LAS float* q, float (&o)[64], OnlineSm& st, const bf16_t* krow, const bf16_t* vrow, float bias2) {
    float s = bias2;
#pragma unroll
    for (int c = 0; c < DQ / 8; ++c) { const bf16x8 kk = *(const bf16x8*)(krow + 8 * c); const f32x4 qa = *(const LAS f32x4*)(q + 8 * c), qb = *(const LAS f32x4*)(q + 8 * c + 4);
        s += qa[0] * bf2f((unsigned short)kk[0]) + qa[1] * bf2f((unsigned short)kk[1]) + qa[2] * bf2f((unsigned short)kk[2]) + qa[3] * bf2f((unsigned short)kk[3]);
        s += qb[0] * bf2f((unsigned short)kk[4]) + qb[1] * bf2f((unsigned short)kk[5]) + qb[2] * bf2f((unsigned short)kk[6]) + qb[3] * bf2f((unsigned short)kk[7]); }
    const float mn = fmaxf(st.m, s), al = exp2f(st.m - mn), pp = exp2f(s - mn);
    st.l = st.l * al + pp; st.m = mn;
#pragma unroll
    for (int c = 0; c < 8; ++c) { const bf16x8 vv = *(const bf16x8*)(vrow + 8 * c);
#pragma unroll
        for (int j = 0; j < 8; ++j) o[8 * c + j] = o[8 * c + j] * al + pp * bf2f((unsigned short)vv[j]); }
}
__device__ __forceinline__ float sm_finish(float (&o)[64], const OnlineSm& st, int lane) {
    const float mm = wave_max(st.m);
    const float w = (st.m == -INFINITY) ? 0.f : exp2f(st.m - mm);
    const float L = wave_sum(st.l * w);
#pragma unroll
    for (int d = 0; d < 64; ++d) o[d] *= w;
#define RS_STEP(n) { const bool up = (lane & (n)) != 0; _Pragma("unroll") for (int i = 0; i < (n); ++i) { const float keep = up ? o[(n) + i] : o[i]; const float send = up ? o[i] : o[(n) + i]; o[i] = keep + __shfl_xor(send, (n)); } }
    RS_STEP(32) RS_STEP(16) RS_STEP(8) RS_STEP(4) RS_STEP(2) RS_STEP(1)
#undef RS_STEP
    return (L > 0.f) ? o[0] / L : 0.f;
}

__device__ __forceinline__ void mla_task(unsigned char* ws, int task, int lane, LAS float* q) {
    const int t = task & (SEQ - 1), h = (task >> 11) & 7, b = task >> 14;
    const size_t row = (size_t)b * SEQ + t;
    const bf16_t* qp = (const bf16_t*)(ws + WS_QM) + row * MQ + 96 * h;
    q[lane] = bf2f(qp[lane]); if (lane < 32) q[64 + lane] = bf2f(qp[64 + lane]);
    asm volatile("s_waitcnt lgkmcnt(0)" ::: "memory");
    float o[64];
#pragma unroll
    for (int d = 0; d < 64; ++d) o[d] = 0.f;
    OnlineSm st{-INFINITY, 0.f};
    const bf16_t* K = (const bf16_t*)(ws + WS_KMLA) + (size_t)b * SEQ * MQ + 96 * h;
    const bf16_t* V = (const bf16_t*)(ws + WS_KVM) + (size_t)b * SEQ * MKV + 128 * h + 64;
    for (int j = lane; j <= t; j += 64) sm_key<96>(q, o, st, K + (size_t)j * MQ, V + (size_t)j * MKV, 0.f);
    const float r = sm_finish(o, st, lane);
    ((bf16_t*)(ws + WS_MIX))[row * DM + 64 * h + lane] = (bf16_t)f2bf(r);
}

__device__ __forceinline__ void nsa_task(unsigned char* ws, int task, int lane, const LAS float* tb, LAS float* q) {
    const int t = task & (SEQ - 1), g = (task >> 11) & 1, b = task >> 12;
    const size_t row = (size_t)b * SEQ + t;
    const bf16_t* pr = (const bf16_t*)(ws + WS_PROJ);
    const bf16_t* kc = (const bf16_t*)(ws + WS_KCMP) + ((size_t)b * 128 * 2 + g) * 64;
    const bf16_t* vc = (const bf16_t*)(ws + WS_VCMP) + ((size_t)b * 128 * 2 + g) * 64;
    const int blk_t = t >> 6;
    float w0 = 0.f, w1 = 0.f;
    const int c0 = lane, c1 = lane + 64;
    const int d0 = t - (16 * c0 + 31), d1 = t - (16 * c1 + 31);
    const bool v0 = d0 >= 0, v1 = (d1 >= 0) && (c1 < NCMP);
    const int ncv = (t >= 31) ? ((t - 31) >> 4) + 1 : 0;
#pragma unroll 1
    for (int r = 0; r < 4; ++r) {
        const int h = 4 * g + r;
        const bf16_t* qp = (const bf16_t*)(ws + WS_QN) + row * 512 + 64 * h;
        float s0 = 0.f, s1 = 0.f;
        { const bf16_t* k0 = kc + (size_t)c0 * 128; const bf16_t* k1 = kc + (size_t)(c1 < 128 ? c1 : 127) * 128;
#pragma unroll
          for (int c = 0; c < 8; ++c) { const bf16x8 qq = *(const bf16x8*)(qp + 8 * c), a = *(const bf16x8*)(k0 + 8 * c), bb = *(const bf16x8*)(k1 + 8 * c);
#pragma unroll
              for (int j = 0; j < 8; ++j) { const float qf = bf2f((unsigned short)qq[j]); s0 += qf * bf2f((unsigned short)a[j]); s1 += qf * bf2f((unsigned short)bb[j]); } } }
        s0 = v0 ? s0 + tb[h * 128 + (d0 < 127 ? d0 : 127)] : -INFINITY;
        s1 = v1 ? s1 + tb[h * 128 + (d1 < 127 ? d1 : 127)] : -INFINITY;
        const float mm = wave_max(fmaxf(s0, s1));
        float p0 = 0.f, p1 = 0.f;
        if (mm != -INFINITY) { p0 = v0 ? exp2f(s0 - mm) : 0.f; p1 = v1 ? exp2f(s1 - mm) : 0.f; const float sum = wave_sum(p0 + p1); const float inv = 1.f / fmaxf(sum, 1e-30f); p0 *= inv; p1 *= inv; }
        w0 += p0; w1 += p1;
        float o = 0.f;
        for (int c = 0; c < ncv; ++c) { const float pc = (c < 64) ? __shfl(p0, c) : __shfl(p1, c - 64); o += pc * bf2f(vc[(size_t)c * 128 + lane]); }
        q[128 + 64 * r + lane] = o;
    }
    unsigned selmask;
    {
        const float A0 = ((lane & 3) == 3) ? 0.5f * w0 : w0, A1 = ((lane & 3) == 3) ? 0.5f * w1 : w1;
        float G0 = A0 + __shfl_xor(A0, 1); G0 += __shfl_xor(G0, 2);
        float G1 = A1 + __shfl_xor(A1, 1); G1 += __shfl_xor(G1, 2);
        const float up0 = __shfl_up(w0, 1), up1 = __shfl_up(w1, 1), w0_63 = __shfl(w0, 63);
        const float implo = G0 + ((lane >= 4) ? 0.5f * up0 : 0.f);
        const float imphi = G1 + ((lane >= 4) ? 0.5f * up1 : 0.5f * w0_63);
        const int j = lane & 31;
        const float ilo = __shfl(implo, 4 * (lane & 15)), ihi = __shfl(imphi, 4 * (lane & 15));
        const float imp = (j < 16) ? ilo : ihi;
        float sc;
        if (j > blk_t) sc = -INFINITY; else if (j == 0 || j == blk_t || j == blk_t - 1) sc = 1e4f; else sc = imp;
        int rank = 0;
#pragma unroll
        for (int i = 0; i < 32; ++i) { const float si = __shfl(sc, i); rank += (si > sc || (si == sc && i < j)) ? 1 : 0; }
        const unsigned long long bal = __ballot(lane < 32 && rank < 16);
        selmask = (unsigned)bal;
    }
    const bf16_t* Ks = (const bf16_t*)(ws + WS_KSEL) + (size_t)b * SEQ * 128 + 64 * g;
    const bf16_t* Kw = (const bf16_t*)(ws + WS_KWIN) + (size_t)b * SEQ * 128 + 64 * g;
    const bf16_t* Vs = pr + (size_t)b * SEQ * DINP + C_VSEL + 64 * g;
    const bf16_t* Vw = pr + (size_t)b * SEQ * DINP + C_VWIN + 64 * g;
#pragma unroll 1
    for (int r = 0; r < 4; ++r) {
        const int h = 4 * g + r;
        const bf16_t* qp = (const bf16_t*)(ws + WS_QN) + row * 512 + 64 * h;
        q[lane] = bf2f(qp[lane]);
        asm volatile("s_waitcnt lgkmcnt(0)" ::: "memory");
        float o[64];
#pragma unroll
        for (int d = 0; d < 64; ++d) o[d] = 0.f;
        OnlineSm st{-INFINITY, 0.f};
        for (int jb = 0; jb <= blk_t; ++jb) {
            if (!((selmask >> jb) & 1u)) continue;
            const int j = 64 * jb + lane;
            if (j <= t) { const int dist = t - j; sm_key<64>(q, o, st, Ks + (size_t)j * 128, Vs + (size_t)j * DINP, tb[h * 128 + (dist < 127 ? dist : 127)]); }
        }
        const float osel = sm_finish(o, st, lane);
#pragma unroll
        for (int d = 0; d < 64; ++d) o[d] = 0.f;
        st.m = -INFINITY; st.l = 0.f;
        { const int jlo = (t - 511 > 0) ? t - 511 : 0;
          for (int j = jlo + lane; j <= t; j += 64) { const int dist = t - j; sm_key<64>(q, o, st, Kw + (size_t)j * 128, Vw + (size_t)j * DINP, tb[h * 128 + (dist < 127 ? dist : 127)]); } }
        const float owin = sm_finish(o, st, lane);
        const bf16_t* gp = pr + row * DINP + C_GATE;
        const float g0 = 1.f / (1.f + __expf(-bf2f(gp[h]))), g1 = 1.f / (1.f + __expf(-bf2f(gp[8 + h]))), g2 = 1.f / (1.f + __expf(-bf2f(gp[16 + h])));
        const float oc = q[128 + 64 * r + lane];
        ((bf16_t*)(ws + WS_MIX))[row * DM + 512 + 64 * h + lane] = (bf16_t)f2bf(g0 * oc + g1 * osel + g2 * owin);
    }
}

namespace att {
typedef float f32x16 __attribute__((ext_vector_type(16)));
typedef short s16x4 __attribute__((ext_vector_type(4)));
typedef short v4i16_t __attribute__((ext_vector_type(4)));
typedef float f32x2_t __attribute__((ext_vector_type(2)));
typedef __bf16 bf16x2_t __attribute__((ext_vector_type(2)));
typedef const LAS unsigned char* lcp;
constexpr int L_TB = 0, L_K = 4096, KSLOT = 12288, L_V = L_K + 2 * KSLOT, VSLOT = 8192, L_WSF = L_V + 2 * VSLOT, L_OST = L_WSF + 4096,
              L_IMP = L_OST + 32768, L_SELM = L_IMP + 32768, L_GATE = L_SELM + 256, L_SC = L_GATE + 3072, L_INVL = L_SC + 8192, L_END = L_INVL + 1024;
static_assert(L_END <= 131072, "attention LDS map");
constexpr float THR = 8.0f;
__device__ __forceinline__ int crow(int r, int hi) { return (r & 3) + 8 * (r >> 2) + 4 * hi; }
__device__ __forceinline__ void glds16(const void* gsrc, unsigned lds_dst) { unsigned keep;
    asm volatile("s_mov_b32 %0, m0\n\ts_mov_b32 m0, %2\n\ts_nop 0\n\tglobal_load_lds_dwordx4 %1, off\n\ts_mov_b32 m0, %0" : "=&s"(keep) : "v"(gsrc), "s"(lds_dst) : "memory"); }
__device__ __forceinline__ unsigned cvtpk(float lo, float hi) { f32x2_t v = {lo, hi}; bf16x2_t b = __builtin_convertvector(v, bf16x2_t); return __builtin_bit_cast(unsigned, b); }
__device__ __forceinline__ s16x4 vtr(lcp p) { return __builtin_bit_cast(s16x4, __builtin_amdgcn_ds_read_tr16_b64_v4i16((LAS v4i16_t*)p)); }
__device__ __forceinline__ float swap_max(float m) { return __builtin_fmaxf(m, __shfl_xor(m, 32)); }
__device__ __forceinline__ float swap_sum(float m) { return m + __shfl_xor(m, 32); }
__device__ __forceinline__ float max16(const f32x16& p) { float a = __builtin_fmaxf(p[0], p[1]), b = __builtin_fmaxf(p[2], p[3]);
#pragma unroll
    for (int r = 4; r < 16; r += 4) { a = __builtin_fmaxf(a, __builtin_fmaxf(p[r], p[r + 1])); b = __builtin_fmaxf(b, __builtin_fmaxf(p[r + 2], p[r + 3])); }
    return __builtin_fmaxf(a, b); }
__device__ __forceinline__ float sum16(const f32x16& p) { float a = p[0] + p[1], b = p[2] + p[3];
#pragma unroll
    for (int r = 4; r < 16; r += 4) { a += p[r] + p[r + 1]; b += p[r + 2] + p[r + 3]; }
    return a + b; }
#define ATT_BAR() asm volatile("s_waitcnt vmcnt(0) lgkmcnt(0)\n\ts_barrier" ::: "memory")

template <int DQ> __device__ __forceinline__ void qkt(f32x16& p0, f32x16& p1, lcp kslot, const bf16x8* qr, const f32x16& cinit, int r32, int hi) {
    lcp kb = kslot + hi * 1024 + r32 * 16;
#pragma unroll
    for (int d0 = 0; d0 < DQ / 16; ++d0) {
        const bf16x8 b0 = *(const LAS bf16x8*)(kb + d0 * 2048), b1 = *(const LAS bf16x8*)(kb + d0 * 2048 + 512);
        if (d0 == 0) { p0 = __builtin_amdgcn_mfma_f32_32x32x16_bf16(b0, qr[0], cinit, 0, 0, 0); p1 = __builtin_amdgcn_mfma_f32_32x32x16_bf16(b1, qr[0], cinit, 0, 0, 0); }
        else { p0 = __builtin_amdgcn_mfma_f32_32x32x16_bf16(b0, qr[d0], p0, 0, 0, 0); p1 = __builtin_amdgcn_mfma_f32_32x32x16_bf16(b1, qr[d0], p1, 0, 0, 0); }
    }
}
__device__ __forceinline__ void pv(f32x16 (&o)[2], lcp vp, const f32x16& p0, const f32x16& p1) {
    u32x4 pw[4];
    pw[0] = (u32x4){cvtpk(p0[0], p0[1]), cvtpk(p0[2], p0[3]), cvtpk(p0[4], p0[5]), cvtpk(p0[6], p0[7])};
    pw[1] = (u32x4){cvtpk(p0[8], p0[9]), cvtpk(p0[10], p0[11]), cvtpk(p0[12], p0[13]), cvtpk(p0[14], p0[15])};
    pw[2] = (u32x4){cvtpk(p1[0], p1[1]), cvtpk(p1[2], p1[3]), cvtpk(p1[4], p1[5]), cvtpk(p1[6], p1[7])};
    pw[3] = (u32x4){cvtpk(p1[8], p1[9]), cvtpk(p1[10], p1[11]), cvtpk(p1[12], p1[13]), cvtpk(p1[14], p1[15])};
#pragma unroll
    for (int d0 = 0; d0 < 2; ++d0)
#pragma unroll
        for (int ks = 0; ks < 4; ++ks) {
            const s16x4 lo = vtr(vp + d0 * 4096 + ks * 1024), hh = vtr(vp + d0 * 4096 + ks * 1024 + 512);
            const bf16x8 vf = (bf16x8){lo[0], lo[1], lo[2], lo[3], hh[0], hh[1], hh[2], hh[3]};
            o[d0] = __builtin_amdgcn_mfma_f32_32x32x16_bf16(__builtin_bit_cast(bf16x8, pw[ks]), vf, o[d0], 0, 0, 0);
        }
}
template <int DQ> __device__ __forceinline__ void dma_tile(unsigned lds0, const bf16_t* Kg, int kpitch, const bf16_t* Vg, int vpitch, int key0, int slot, int wid, int lane) {
    const bf16_t* ksrc = Kg + (size_t)(key0 + lane) * kpitch + wid * 8;
    glds16(ksrc, (unsigned)__builtin_amdgcn_readfirstlane(lds0 + L_K + slot * KSLOT + wid * 1024));
    if (DQ == 96) { if (wid < 4) glds16(ksrc + 64, (unsigned)__builtin_amdgcn_readfirstlane(lds0 + L_K + slot * KSLOT + (8 + wid) * 1024)); }
    const bf16_t* vsrc = Vg + (size_t)(key0 + 16 * (wid & 3) + (lane >> 2)) * vpitch + (wid >> 2) * 32 + (lane & 3) * 8;
    glds16(vsrc, (unsigned)__builtin_amdgcn_readfirstlane(lds0 + L_V + slot * VSLOT + wid * 1024));
}

template <int DQ, class Pol>
__device__ __forceinline__ void flash_loop(LAS unsigned char* L, const bf16_t* Kg, int kpitch, const bf16_t* Vg, int vpitch, const bf16x8* qr, const Pol& pol, f32x16 (&o)[2], float& l_out, int wid, int lane) {
    const int r32 = lane & 31, hi = lane >> 5;
    const unsigned lds0 = (unsigned)(uintptr_t)L;
    LAS float* wsf = (LAS float*)(L + L_WSF) + wid * 128;
    lcp vp0 = L + L_V + ((lane >> 4) & 1) * 32 + (lane & 3) * 8 + (4 * hi + ((lane & 15) >> 2)) * 64;
    float mhat = 0.f, l = 0.f;
#pragma unroll
    for (int r = 0; r < 16; ++r) { o[0][r] = 0.f; o[1][r] = 0.f; }
    const int n = pol.ntiles;
    dma_tile<DQ>(lds0, Kg, kpitch, Vg, vpitch, pol.key0(0), 0, wid, lane);
    for (int i = 0; i < n; ++i) {
        ATT_BAR();
        if (i + 1 < n) dma_tile<DQ>(lds0, Kg, kpitch, Vg, vpitch, pol.key0(i + 1), (i + 1) & 1, wid, lane);
        if (pol.active(i)) {
            const int slot = i & 1;
            f32x16 p0, p1;
            { f32x16 negm; const float nm = -mhat;
#pragma unroll
              for (int r = 0; r < 16; ++r) negm[r] = nm;
              qkt<DQ>(p0, p1, L + L_K + slot * KSLOT, qr, negm, r32, hi); }
            pol.fix(p0, p1, i);
            const float rm = swap_max(__builtin_fmaxf(max16(p0), max16(p1)));
            const bool first = (i == 0);
            if (first || __any(rm > THR)) {
                float dl = first ? rm : __builtin_fmaxf(rm, 0.f);
                if (dl == -INFINITY) dl = 0.f;
                mhat += dl;
#pragma unroll
                for (int r = 0; r < 16; ++r) { p0[r] -= dl; p1[r] -= dl; }
                if (!first) {
                    const float f = __builtin_amdgcn_exp2f(-dl); l *= f;
                    if (hi == 0) wsf[r32] = f;
#pragma unroll
                    for (int r = 0; r < 16; ++r) { const float fr_ = wsf[crow(r, hi)]; o[0][r] *= fr_; o[1][r] *= fr_; }
                }
            }
#pragma unroll
            for (int r = 0; r < 16; ++r) { p0[r] = __builtin_amdgcn_exp2f(p0[r]); p1[r] = __builtin_amdgcn_exp2f(p1[r]); }
            l += sum16(p0) + sum16(p1);
            pv(o, vp0 + slot * VSLOT, p0, p1);
        }
    }
    ATT_BAR();
    l_out = swap_sum(l);
}

__device__ __forceinline__ void acc_scaled(f32x16 (&oc)[2], const f32x16 (&o)[2], float rowscale, LAS float* wsf, int r32, int hi) {
    if (hi == 0) wsf[32 + r32] = rowscale;
#pragma unroll
    for (int r = 0; r < 16; ++r) { const float s = wsf[32 + crow(r, hi)]; oc[0][r] += s * o[0][r]; oc[1][r] += s * o[1][r]; }
}
__device__ __forceinline__ void store_tile(const f32x16 (&oc)[2], bf16_t* dst, int pitch, LAS unsigned char* L, int wid, int lane) {
    const int r32 = lane & 31, hi = lane >> 5;
    LAS bf16_t* stg = (LAS bf16_t*)(L + L_OST + wid * 4096);
#pragma unroll
    for (int r = 0; r < 16; ++r) { const int orow = crow(r, hi);
#pragma unroll
        for (int d0 = 0; d0 < 2; ++d0) stg[orow * 64 + d0 * 32 + r32] = (bf16_t)f2bf(oc[d0][r]); }
    asm volatile("s_waitcnt lgkmcnt(0)" ::: "memory");
#pragma unroll
    for (int i = 0; i < 4; ++i) { const int row = i * 8 + (lane >> 3), ch = lane & 7; const u32x4 v = *(const LAS u32x4*)(stg + row * 64 + ch * 8); *(u32x4*)(dst + (size_t)row * pitch + ch * 8) = v; }
    asm volatile("s_waitcnt lgkmcnt(0)" ::: "memory");
}

struct PolMla { int ntiles, qw0, r32, hi;
    __device__ __forceinline__ int key0(int i) const { return 64 * i; }
    __device__ __forceinline__ bool active(int i) const { return 64 * i <= qw0 + 31; }
    __device__ __forceinline__ void fix(f32x16& p0, f32x16& p1, int i) const {
        if (64 * i + 63 > qw0) { const int q = qw0 + r32, kb = 64 * i + 4 * hi;
#pragma unroll
            for (int r = 0; r < 16; ++r) { const int kv = kb + (r & 3) + 8 * (r >> 2); if (kv > q) p0[r] = -INFINITY; if (kv + 32 > q) p1[r] = -INFINITY; } }
    }
};
struct PolSel { int ntiles, qc, q, hi; unsigned selm; const LAS float* tbh;
    __device__ __forceinline__ int key0(int i) const { return 64 * (qc - i); }
    __device__ __forceinline__ bool active(int i) const { return __any((selm >> (qc - i)) & 1u) != 0; }
    __device__ __forceinline__ void fix(f32x16& p0, f32x16& p1, int i) const {
        const bool bit = ((selm >> (qc - i)) & 1u) != 0u;
        if (i <= 2) { const int kb = 64 * (qc - i) + 4 * hi;
#pragma unroll
            for (int r = 0; r < 16; ++r) { const int d0 = q - (kb + (r & 3) + 8 * (r >> 2)), d1 = d0 - 32;
                p0[r] = (d0 < 0) ? -INFINITY : p0[r] + tbh[d0 < 127 ? d0 : 127]; p1[r] = (d1 < 0) ? -INFINITY : p1[r] + tbh[d1 < 127 ? d1 : 127]; } }
        if (!bit) {
#pragma unroll
            for (int r = 0; r < 16; ++r) { p0[r] = -INFINITY; p1[r] = -INFINITY; } }
    }
};
struct PolWin { int ntiles, qc, q, hi; const LAS float* tbh;
    __device__ __forceinline__ int key0(int i) const { return 64 * (qc - i); }
    __device__ __forceinline__ bool active(int) const { return true; }
    __device__ __forceinline__ void fix(f32x16& p0, f32x16& p1, int i) const {
        if (i <= 2 || i == 8) { const int kb = 64 * (qc - i) + 4 * hi;
#pragma unroll
            for (int r = 0; r < 16; ++r) { const int d0 = q - (kb + (r & 3) + 8 * (r >> 2)), d1 = d0 - 32;
                const float b0 = (i <= 2) ? tbh[d0 < 0 ? 0 : (d0 < 127 ? d0 : 127)] : 0.f, b1 = (i <= 2) ? tbh[d1 < 0 ? 0 : (d1 < 127 ? d1 : 127)] : 0.f;
                p0[r] = (d0 < 0 || d0 >= 512) ? -INFINITY : p0[r] + b0; p1[r] = (d1 < 0 || d1 >= 512) ? -INFINITY : p1[r] + b1; } }
    }
};

__device__ __forceinline__ void mla_unit(unsigned char* ws, LAS unsigned char* L, int b, int h, int qb) {
    const int tid = opaque_tid(), lane = tid & 63, wid = __builtin_amdgcn_readfirstlane(tid >> 6);
    const int r32 = lane & 31, hi = lane >> 5;
    const size_t rowbase = (size_t)b * SEQ; const int qw0 = 256 * qb + 32 * wid;
    const bf16_t* Qw = (const bf16_t*)(ws + WS_QM) + (rowbase + qw0 + r32) * MQ + 96 * h + 8 * hi;
    bf16x8 qr[6];
#pragma unroll
    for (int d0 = 0; d0 < 6; ++d0) qr[d0] = *(const bf16x8*)(Qw + 16 * d0);
    const bf16_t* Kg = (const bf16_t*)(ws + WS_KMLA) + rowbase * MQ + 96 * h;
    const bf16_t* Vg = (const bf16_t*)(ws + WS_KVM) + rowbase * MKV + 128 * h + 64;
    PolMla pol{4 * qb + 4, qw0, r32, hi};
    f32x16 o[2]; float l;
    flash_loop<96>(L, Kg, MQ, Vg, MKV, qr, pol, o, l, wid, lane);
    LAS float* wsf = (LAS float*)(L + L_WSF) + wid * 128;
    f32x16 oc[2];
#pragma unroll
    for (int r = 0; r < 16; ++r) { oc[0][r] = 0.f; oc[1][r] = 0.f; }
    acc_scaled(oc, o, (l > 0.f) ? 1.f / l : 0.f, wsf, r32, hi);
    store_tile(oc, (bf16_t*)(ws + WS_MIX) + (rowbase + qw0) * DM + 64 * h, DM, L, wid, lane);
}

__device__ __forceinline__ void nsa_unit(unsigned char* ws, LAS unsigned char* L, int b, int g, int qc) {
    const int tid = opaque_tid(), lane = tid & 63, wid = __builtin_amdgcn_readfirstlane(tid >> 6);
    const int r32 = lane & 31, hi = lane >> 5, rh = wid & 3, qh = wid >> 2, h = 4 * g + rh;
    const size_t rowbase = (size_t)b * SEQ; const int q0 = 64 * qc, qloc = 32 * qh + r32, q = q0 + qloc;
    const unsigned lds0 = (unsigned)(uintptr_t)L;
    LAS float* wsf = (LAS float*)(L + L_WSF) + wid * 128;
    const LAS float* tbh = (const LAS float*)(L + L_TB) + h * 128;
    LAS float* gate = (LAS float*)(L + L_GATE);
    const bf16_t* pr = (const bf16_t*)(ws + WS_PROJ);
    for (int i = tid; i < 768; i += 512) { const int br = i >> 8, r = (i >> 6) & 3, qq = i & 63;
        const float x = bf2f(pr[(rowbase + q0 + qq) * DINP + C_GATE + 8 * br + 4 * g + r]); gate[i] = 1.f / (1.f + __expf(-x)); }
    const bf16_t* Qw = (const bf16_t*)(ws + WS_QN) + (rowbase + q) * 512 + 64 * h + 8 * hi;
    bf16x8 qr[4];
#pragma unroll
    for (int d0 = 0; d0 < 4; ++d0) qr[d0] = *(const bf16x8*)(Qw + 16 * d0);
    f32x16 oc[2];
#pragma unroll
    for (int r = 0; r < 16; ++r) { oc[0][r] = 0.f; oc[1][r] = 0.f; }
#ifndef NO_CMP
    {
        const bf16_t* Kg = (const bf16_t*)(ws + WS_KCMP) + ((size_t)b * 256 + g) * 64;
        const bf16_t* Vg = (const bf16_t*)(ws + WS_VCMP) + ((size_t)b * 256 + g) * 64;
        dma_tile<64>(lds0, Kg, 128, Vg, 128, 0, 0, wid, lane);
        dma_tile<64>(lds0, Kg, 128, Vg, 128, 64, 1, wid, lane);
        ATT_BAR();
        lcp vp0 = L + L_V + ((lane >> 4) & 1) * 32 + (lane & 3) * 8 + (4 * hi + ((lane & 15) >> 2)) * 64;
        LAS float* imp = (LAS float*)(L + L_IMP) + (rh * 64 + qloc) * 32;
        f32x16 o[2];
#pragma unroll
        for (int r = 0; r < 16; ++r) { o[0][r] = 0.f; o[1][r] = 0.f; }
        float m = -INFINITY, lsum = 0.f, prev_last = 0.f;
#pragma unroll 1
        for (int pass = 0; pass < 2; ++pass) {
#pragma unroll 1
            for (int T = 0; T < 2; ++T) {
                f32x16 a0, a1;
                { f32x16 zero;
#pragma unroll
                  for (int r = 0; r < 16; ++r) zero[r] = 0.f;
                  qkt<64>(a0, a1, L + L_K + T * KSLOT, qr, zero, r32, hi); }
#pragma unroll
                for (int r = 0; r < 16; ++r) { const int c = 64 * T + crow(r, hi);
                    { const int d = q - 16 * c - 31;        a0[r] = (d < 0) ? -INFINITY : a0[r] + tbh[d < 127 ? d : 127]; }
                    { const int d = q - 16 * (c + 32) - 31; a1[r] = (d < 0 || c + 32 >= NCMP) ? -INFINITY : a1[r] + tbh[d < 127 ? d : 127]; } }
                if (pass == 0) { m = __builtin_fmaxf(m, __builtin_fmaxf(max16(a0), max16(a1))); }
                else {
#pragma unroll
                    for (int r = 0; r < 16; ++r) { a0[r] = __builtin_amdgcn_exp2f(a0[r] - m); a1[r] = __builtin_amdgcn_exp2f(a1[r] - m); }
                    lsum += sum16(a0) + sum16(a1);
                    float own[8], car[8];
#pragma unroll
                    for (int a = 0; a < 4; ++a) {
                        own[a]     = a0[4 * a] + a0[4 * a + 1] + a0[4 * a + 2] + 0.5f * a0[4 * a + 3]; car[a]     = 0.5f * a0[4 * a + 3];
                        own[4 + a] = a1[4 * a] + a1[4 * a + 1] + a1[4 * a + 2] + 0.5f * a1[4 * a + 3]; car[4 + a] = 0.5f * a1[4 * a + 3]; }
#pragma unroll
                    for (int k = 0; k < 8; ++k) car[k] = __shfl_xor(car[k], 32);
#pragma unroll
                    for (int k = 0; k < 8; ++k) { const float add = hi ? car[k] : (k >= 1 ? car[k - 1] : prev_last); imp[16 * T + 2 * k + hi] = own[k] + add; }
                    prev_last = car[7];
                    pv(o, vp0 + T * VSLOT, a0, a1);
                }
            }
            if (pass == 0) { m = swap_max(m); if (m == -INFINITY) m = 0.f; }
        }
        lsum = swap_sum(lsum);
        const float inv = (lsum > 0.f) ? 1.f / lsum : 0.f;
        if (hi == 0) ((LAS float*)(L + L_INVL))[rh * 64 + qloc] = inv;
        ATT_BAR();
        acc_scaled(oc, o, gate[(0 * 4 + rh) * 64 + qloc] * inv, wsf, r32, hi);
    }
#endif
#ifndef NO_TOPK
    {
        const LAS float* imp = (const LAS float*)(L + L_IMP); LAS float* sc = (LAS float*)(L + L_SC);
        const int qq = tid >> 3, jj = tid & 7;
#pragma unroll
        for (int k = 0; k < 4; ++k) { const int j = jj + 8 * k; const LAS float* il = (const LAS float*)(L + L_INVL);
            const float tot = (imp[(0 * 64 + qq) * 32 + j] * il[qq] + imp[(1 * 64 + qq) * 32 + j] * il[64 + qq]) + (imp[(2 * 64 + qq) * 32 + j] * il[128 + qq] + imp[(3 * 64 + qq) * 32 + j] * il[192 + qq]);
            float s; if (j > qc) s = -INFINITY; else if (j == 0 || j == qc || j == qc - 1) s = 1e4f; else s = tot; sc[qq * 32 + j] = s; }
        ATT_BAR();
        unsigned bits = 0u;
#pragma unroll
        for (int k = 0; k < 4; ++k) { const int j = jj + 8 * k; const float me = sc[qq * 32 + j]; int rank = 0;
            for (int i = 0; i < 32; ++i) { const float si = sc[qq * 32 + i]; rank += (si > me || (si == me && i < j)) ? 1 : 0; }
            if (rank < 16) bits |= 1u << j; }
        bits |= __shfl_xor(bits, 1); bits |= __shfl_xor(bits, 2); bits |= __shfl_xor(bits, 4);
        if (jj == 0) ((LAS unsigned*)(L + L_SELM))[qq] = bits;
        ATT_BAR();
    }
#endif
#ifndef NO_SEL
    {
        const unsigned selm = ((const LAS unsigned*)(L + L_SELM))[qloc];
        const bf16_t* Kg = (const bf16_t*)(ws + WS_KSEL) + rowbase * 128 + 64 * g;
        const bf16_t* Vg = pr + rowbase * DINP + C_VSEL + 64 * g;
        PolSel pol{qc + 1, qc, q, hi, selm, tbh};
        f32x16 o[2]; float l;
        flash_loop<64>(L, Kg, 128, Vg, DINP, qr, pol, o, l, wid, lane);
        acc_scaled(oc, o, (l > 0.f) ? gate[(1 * 4 + rh) * 64 + qloc] / l : 0.f, wsf, r32, hi);
    }
#endif
#ifndef NO_WIN
    {
        const bf16_t* Kg = (const bf16_t*)(ws + WS_KWIN) + rowbase * 128 + 64 * g;
        const bf16_t* Vg = pr + rowbase * DINP + C_VWIN + 64 * g;
        PolWin pol{(qc < 8 ? qc : 8) + 1, qc, q, hi, tbh};
        f32x16 o[2]; float l;
        flash_loop<64>(L, Kg, 128, Vg, DINP, qr, pol, o, l, wid, lane);
        acc_scaled(oc, o, (l > 0.f) ? gate[(2 * 4 + rh) * 64 + qloc] / l : 0.f, wsf, r32, hi);
    }
#endif
    store_tile(oc, (bf16_t*)(ws + WS_MIX) + (rowbase + q0 + 32 * qh) * DM + 512 + 64 * h, DM, L, wid, lane);
    ATT_BAR();
}
#undef ATT_BAR
}

__device__ __forceinline__ void glueC_row(unsigned char* ws, int row, int lane) {
    bf16_t* mx = (bf16_t*)(ws + WS_MIX) + (size_t)row * DM;
#pragma unroll
    for (int half = 0; half < 2; ++half) {
        const float* g = inptr(15 + half);
        float v[8]; float s = 0.f;
#pragma unroll
        for (int j = 0; j < 8; ++j) { v[j] = bf2f(mx[512 * half + lane + 64 * j]); s += v[j] * v[j]; }
        const float rstd = 1.f / sqrtf(wave_sum(s) * (1.f / 512) + EPS);
#pragma unroll
        for (int j = 0; j < 8; ++j) mx[512 * half + lane + 64 * j] = (bf16_t)f2bf(v[j] * rstd * g[lane + 64 * j]);
    }
}

__global__ void __launch_bounds__(512, 2) mega(Params p) {
    extern __shared__ __attribute__((aligned(16))) unsigned char lds[];
    cg::grid_group grid = cg::this_grid();
    const int G = gridDim.x, bid = blockIdx.x, NGW = G * NW;
#define PHASE_IDS() const int tid = opaque_tid(), lane = tid & 63, wave = __builtin_amdgcn_readfirstlane(tid >> 6), gw = bid * NW + wave; (void)tid; (void)lane; (void)gw
    unsigned char* ws = (unsigned char*)inptr(22);
    LAS unsigned char* L = (LAS unsigned char*)lds;

    {
        PHASE_IDS();
        LAS float* scr = (LAS float*)(L + wave * 8704);
        constexpr int I0 = (1024 / 64) * (DINP / 32), I1 = (QR / 64) * (MQ / 32), I2 = (KVR / 64) * (MKV / 32), I3 = 16 * 32, I4 = 16 * (FF / 32), I5 = (FF / 64) * 32;
        constexpr int NIT = I0 + I1 + I2 + I3 + I4 + I5;
        for (int it = gw; it < NIT; it += NGW) {
            int r = it;
            if (r < I0) { p0_transpose_item(inptr(2), 1024, DIN, DINP, (bf16_t*)(ws + WS_WIN), scr, r, lane); continue; } r -= I0;
            if (r < I1) { p0_transpose_item(inptr(5), QR, MQ, MQ, (bf16_t*)(ws + WS_WUQ), scr, r, lane); continue; } r -= I1;
            if (r < I2) { p0_transpose_item(inptr(6), KVR, MKV, MKV, (bf16_t*)(ws + WS_WUKV), scr, r, lane); continue; } r -= I2;
            if (r < I3) { p0_transpose_item(inptr(17), 1024, 1024, 1024, (bf16_t*)(ws + WS_WO), scr, r, lane); continue; } r -= I3;
            if (r < I4) { p0_transpose_item(inptr(19), 1024, FF, FF, (bf16_t*)(ws + WS_WUP), scr, r, lane); continue; } r -= I4;
            p0_transpose_item(inptr(20), FF, 1024, 1024, (bf16_t*)(ws + WS_WDN), scr, r, lane);
        }
        for (int m = gw; m < M; m += NGW) rms_row_to_bf16(inptr(0) + (size_t)m * DM, inptr(1), (bf16_t*)(ws + WS_HB) + (size_t)m * DM, lane);
    }
    grid.sync();
    { pg8::Gemm g{(const bf16_t*)(ws + WS_HB), (const bf16_t*)(ws + WS_WIN), M, DINP, DM, DM, DM}; pg8::StaticOrder S; S.init(M, DINP, G, bid);
      PEpiBf16<0> E{(bf16_t*)(ws + WS_PROJ), DINP}; pg8::gemm_phase<PEpiBf16<0>, pg8::StaticOrder, true, true>(L, g, S, E); }
    grid.sync();
    { PHASE_IDS();
      for (int m = gw; m < M; m += NGW) glueA_row(ws, m, lane);
      for (int t = gw; t < 2 * 8 * 128 * 2; t += NGW) compress_task(ws, t, lane); }
    grid.sync();
    { pg8::Gemm g{(const bf16_t*)(ws + WS_HQN), (const bf16_t*)(ws + WS_WUQ), M, MQ, QR, QR, QR}; pg8::StaticOrder S; S.init(M, MQ, G, bid);
      PEpiBf16<0> E{(bf16_t*)(ws + WS_QM), MQ}; pg8::gemm_phase<PEpiBf16<0>, pg8::StaticOrder, true, true>(L, g, S, E); }
    { pg8::Gemm g{(const bf16_t*)(ws + WS_HKVN), (const bf16_t*)(ws + WS_WUKV), M, MKV, KVR, KVR, KVR}; pg8::StaticOrder S; S.init(M, MKV, G, bid);
      PEpiBf16<0> E{(bf16_t*)(ws + WS_KVM), MKV}; pg8::gemm_phase<PEpiBf16<0>, pg8::StaticOrder, true, true>(L, g, S, E); }
    grid.sync();
    { PHASE_IDS(); for (int m = gw; m < M; m += NGW) glueB_row(ws, m, lane); }
    grid.sync();
    {
        PHASE_IDS();
        LAS float* tb = (LAS float*)L;
        for (int i = tid; i < 8 * 128; i += 512) { const int h = i >> 7, n = i & 127; tb[i] = (inptr(14)[t5_bucket(n) * 8 + h] - inptr(14)[31 * 8 + h]) * LOG2E; }
        __syncthreads();
        const int vcu = (G % 8 == 0) ? (bid % 8) * (G / 8) + bid / 8 : bid;
#ifdef NAIVE_NSA
        { LAS float* qw = (LAS float*)(L + 4096 + wave * 2048); for (int t = gw; t < BATCH * 2 * SEQ; t += NGW) nsa_task(ws, t, lane, tb, qw); __syncthreads(); }
#endif
#ifdef NAIVE_MLA
        { LAS float* qw = (LAS float*)(L + 4096 + wave * 2048); for (int t = gw; t < BATCH * 8 * SEQ; t += NGW) mla_task(ws, t, lane, qw); __syncthreads(); }
#endif
        for (int pr_ = vcu; pr_ < 256; pr_ += G) {
#ifndef NAIVE_NSA
            { const int bg = pr_ >> 4, s_ = pr_ & 15;
#pragma unroll 1
              for (int u_ = 0; u_ < 2; ++u_) att::nsa_unit(ws, L, bg >> 1, bg & 1, u_ ? s_ : 31 - s_);
            }
#endif
#ifndef NAIVE_MLA
            { const int bh = pr_ >> 2, s_ = pr_ & 3;
#pragma unroll 1
              for (int u_ = 0; u_ < 2; ++u_) att::mla_unit(ws, L, bh >> 3, bh & 7, u_ ? s_ : 7 - s_);
            }
#endif
        }
    }
    grid.sync();
    { PHASE_IDS(); for (int m = gw; m < M; m += NGW) glueC_row(ws, m, lane); }
    grid.sync();
    { pg8::Gemm g{(const bf16_t*)(ws + WS_MIX), (const bf16_t*)(ws + WS_WO), M, DM, DM, DM, DM}; pg8::StaticOrder S; S.init(M, DM, G, bid);
      PEpiResF32 E{inptr(0), ((float*)inptr(21)), DM}; pg8::gemm_phase<PEpiResF32, pg8::StaticOrder, true, true>(L, g, S, E); }
    grid.sync();
    { PHASE_IDS(); for (int m = gw; m < M; m += NGW) rms_row_to_bf16(((float*)inptr(21)) + (size_t)m * DM, inptr(18), (bf16_t*)(ws + WS_H2) + (size_t)m * DM, lane); }
    grid.sync();
    { pg8::Gemm g{(const bf16_t*)(ws + WS_H2), (const bf16_t*)(ws + WS_WUP), M, FF, DM, DM, DM}; pg8::StaticOrder S; S.init(M, FF, G, bid);
      PEpiBf16<2> E{(bf16_t*)(ws + WS_HID), FF}; pg8::gemm_phase<PEpiBf16<2>, pg8::StaticOrder, true, true>(L, g, S, E); }
    grid.sync();
    { pg8::Gemm g{(const bf16_t*)(ws + WS_HID), (const bf16_t*)(ws + WS_WDN), M, DM, FF, FF, FF}; pg8::StaticOrder S; S.init(M, DM, G, bid);
      PEpiResF32 E{((float*)inptr(21)), ((float*)inptr(21)), DM}; pg8::gemm_phase<PEpiResF32, pg8::StaticOrder, true, true>(L, g, S, E); }
}

extern "C" void kernel_launch(void* const* d_in, const int* in_sizes, int n_in, void* d_out, int out_size,
                              void* d_ws, size_t ws_size, hipStream_t stream) {
    static int grid_blocks = 0;
    if (!grid_blocks) {
        int dev = 0, cus = 0, per_cu = 0;
        (void)hipGetDevice(&dev);
        (void)hipDeviceGetAttribute(&cus, hipDeviceAttributeMultiprocessorCount, dev);
        (void)hipFuncSetAttribute((const void*)mega, hipFuncAttributeMaxDynamicSharedMemorySize, LDS_BYTES);
        (void)hipOccupancyMaxActiveBlocksPerMultiprocessor(&per_cu, (const void*)mega, 512, LDS_BYTES);
        if (per_cu != 1) fprintf(stderr, "note: occupancy query reports %d blocks/CU; launching 1 per CU\n", per_cu);
        grid_blocks = cus;
        if (n_in != 21 || out_size != M * DM || ws_size < 256 * MiB) fprintf(stderr, "unexpected shapes: n_in %d out %d ws %zu\n", n_in, out_size, ws_size);
    }
    Params p{};
    for (int i = 0; i < 21; ++i) p.in[i] = (const float*)d_in[i];
    p.out = (float*)d_out; p.ws = (unsigned char*)d_ws;
    void* args[] = {&p};
    hipError_t e = hipLaunchCooperativeKernel((const void*)mega, dim3(grid_blocks), dim3(512), args, LDS_BYTES, stream);
    if (e != hipSuccess) fprintf(stderr, "cooperative launch failed: %s (grid %d)\n", hipGetErrorString(e), grid_blocks);
}
```

```cpp
#ifndef EXP
#define EXP 0
#endif
#include <hip/hip_runtime.h>
#include <cstdio>
#include <cstdint>

#define LAS __attribute__((address_space(3)))
typedef unsigned short bf16_t;
typedef short bf16x8 __attribute__((ext_vector_type(8)));
typedef float f32x4 __attribute__((ext_vector_type(4)));
typedef unsigned u32x4 __attribute__((ext_vector_type(4)));
typedef unsigned u32x2 __attribute__((ext_vector_type(2)));

constexpr int BATCH = 8, SEQ = 2048, DM = 1024, M = BATCH * SEQ;
constexpr int DIN = 1976, DINP = 2048;
constexpr int C_HQ = 0, C_HKV = 384, C_HKR = 640, C_QB = 672, C_KVB = 1184, C_GATE = 1952;
constexpr int C_KCMP = C_KVB, C_VCMP = C_KVB + 128, C_KSEL = C_KVB + 256, C_VSEL = C_KVB + 384, C_KWIN = C_KVB + 512, C_VWIN = C_KVB + 640;
constexpr int QR = 384, KVR = 256, MQ = 768, MKV = 1024, FF = 4096;
constexpr int NCMP = 127;
constexpr float EPS = 1e-6f;
constexpr float LOG2E = 1.4426950408889634f;
constexpr float QS_MLA = 0.10206207261596577f * LOG2E;
constexpr float QS_NSA = 0.125f * LOG2E;

constexpr size_t MiB = 1u << 20;
constexpr size_t WS_CTL = 0, CTL_ZERO_BYTES = 65536;
constexpr size_t WS_WIN = 1 * MiB, WS_WUQ = 5 * MiB, WS_WUKV = 6 * MiB, WS_WO = 7 * MiB, WS_WUP = 9 * MiB, WS_WDN = 17 * MiB;
constexpr size_t WS_KCMP = 26 * MiB, WS_VCMP = 26 * MiB + 512 * 1024;
constexpr size_t WS_W1T = 25 * MiB;
constexpr size_t WS_W2T = 27 * MiB;
constexpr size_t WS_RSQ = 28 * MiB, WS_RSKV = 28 * MiB + 65536, WS_SSQ2 = 28 * MiB + 131072;
constexpr size_t WS_HB = 32 * MiB;
constexpr size_t WS_MIX = 32 * MiB;
constexpr size_t WS_PROJ = 64 * MiB;
constexpr size_t WS_QM = 128 * MiB;
constexpr size_t WS_KVM = 152 * MiB;
constexpr size_t WS_KMLA = 184 * MiB;
constexpr size_t WS_QN = 208 * MiB;
constexpr size_t WS_KSEL = 224 * MiB;
constexpr size_t WS_KWIN = 228 * MiB;
constexpr size_t WS_HQN = 232 * MiB;
constexpr size_t WS_HKVN = 244 * MiB;
constexpr size_t WS_H2 = 192 * MiB;
constexpr size_t WS_HID = 64 * MiB;

constexpr int LDS_BYTES = 155648, LDS_BST = 154624;
constexpr int NW = 8;

struct Params {
    const float* in[21];
    float* out;
    unsigned char* ws;
};

typedef const float* cfptr_t;
__device__ __forceinline__ const float* inptr(int i) {
    const __attribute__((address_space(4))) char* ka = (const __attribute__((address_space(4))) char*)__builtin_amdgcn_kernarg_segment_ptr();
    int off = i * 8; asm volatile("" : "+s"(off));
    return *(const __attribute__((address_space(4))) cfptr_t*)(ka + off);
}
__device__ __forceinline__ unsigned f2bf(float f) { unsigned u = __builtin_bit_cast(unsigned, f); return (u + 0x7fffu + ((u >> 16) & 1u)) >> 16; }
__device__ __forceinline__ float bf2f(unsigned b) { return __builtin_bit_cast(float, b << 16); }
__device__ __forceinline__ unsigned pk2(float lo, float hi) { return f2bf(lo) | (f2bf(hi) << 16); }
__device__ __forceinline__ float wave_sum(float v) {
#pragma unroll
    for (int o = 1; o < 64; o <<= 1) v += __shfl_xor(v, o);
    return v;
}
__device__ __forceinline__ float wave_max(float v) {
#pragma unroll
    for (int o = 1; o < 64; o <<= 1) v = fmaxf(v, __shfl_xor(v, o));
    return v;
}
__device__ __forceinline__ int t5_bucket(int n) {
    if (n < 16) return n;
    int b = 16;
    b += (n >= 19); b += (n >= 21); b += (n >= 24); b += (n >= 27); b += (n >= 31); b += (n >= 35); b += (n >= 40); b += (n >= 46);
    b += (n >= 52); b += (n >= 59); b += (n >= 67); b += (n >= 77); b += (n >= 87); b += (n >= 99); b += (n >= 113);
    return b;
}

__device__ __forceinline__ void p0_transpose_item(const float* W, int K, int N, int Npad, bf16_t* WT, LAS float* scr, int item, int lane, const float* gk = nullptr) {
    const int nblk = Npad / 32, kb = item / nblk, nb = item % nblk, k0 = 64 * kb, n0 = 32 * nb;
    const int nn = n0 + (lane & 31);
#pragma unroll 8
    for (int i = 0; i < 32; ++i) { const int kk = 2 * i + (lane >> 5); const float gg = gk ? gk[k0 + kk] : 1.f; scr[kk * 33 + (lane & 31)] = (nn < N) ? W[(size_t)(k0 + kk) * N + nn] * gg : 0.f; }
    asm volatile("s_waitcnt lgkmcnt(0)" ::: "memory");
    const int c = lane & 7;
#pragma unroll
    for (int j = 0; j < 4; ++j) { const int n = (lane >> 3) + 8 * j; const LAS float* s = scr + (8 * c) * 33 + n;
        u32x4 o; o.x = pk2(s[0 * 33], s[1 * 33]); o.y = pk2(s[2 * 33], s[3 * 33]); o.z = pk2(s[4 * 33], s[5 * 33]); o.w = pk2(s[6 * 33], s[7 * 33]);
        *(u32x4*)(WT + (size_t)(n0 + n) * K + k0 + 8 * c) = o; }
    asm volatile("s_waitcnt lgkmcnt(0)" ::: "memory");
}
__device__ __forceinline__ void rms_row_to_bf16(const float* xrow, const float* g, bf16_t* orow, int lane) {
    const f32x4* xr = (const f32x4*)xrow + lane; const f32x4* gr = (const f32x4*)g + lane;
    f32x4 v[4]; float s = 0.f;
#pragma unroll
    for (int j = 0; j < 4; ++j) { v[j] = xr[64 * j]; s += (v[j].x * v[j].x + v[j].y * v[j].y) + (v[j].z * v[j].z + v[j].w * v[j].w); }
    const float rstd = 1.f / sqrtf(wave_sum(s) * (1.f / DM) + EPS);
    unsigned long long* o8 = (unsigned long long*)orow + lane;
#pragma unroll
    for (int j = 0; j < 4; ++j) { const f32x4 gg = gr[64 * j];
        o8[64 * j] = (unsigned long long)pk2(v[j].x * rstd * gg.x, v[j].y * rstd * gg.y) | ((unsigned long long)pk2(v[j].z * rstd * gg.z, v[j].w * rstd * gg.w) << 32); }
}

__device__ __forceinline__ int opaque_tid() { int t = threadIdx.x; asm volatile("" : "+v"(t)); return t; }
namespace pg8 {
#define PG8_LAS __attribute__((address_space(3)))
typedef unsigned short bf16_t;
typedef short bf16x8 __attribute__((ext_vector_type(8)));
typedef float f32x4 __attribute__((ext_vector_type(4)));
typedef unsigned u32x4 __attribute__((ext_vector_type(4)));
constexpr int BM = 256, BK = 64, HALF = 128, HTB = HALF * BK * 2  , STAGE_BYTES = 8 * HTB, NXCD = 8, WGM = 8;

__host__ __device__ __forceinline__ int lds_byte(int r, int c) { const int st = (r >> 4) * 2 + (c >> 5), rr = r & 15, cc = c & 31, ob = rr * 64 + cc * 2; return st * 1024 + (ob ^ (((ob >> 9) & 1) << 5)); }
__host__ __device__ __forceinline__ void stage_rc(int b, int& R, int& C) { const int st = b / 1024, sb = b % 1024, swz = sb ^ (((sb >> 9) & 1) << 5); R = (st >> 1) * 16 + swz / 64; C = (st & 1) * 32 + (swz % 64) / 2; }
__host__ __device__ __forceinline__ int perm32(int rho) { const int n = rho >> 4, i = rho & 15; return 8 * (i >> 2) + 4 * n + (i & 3); }

struct Unit { int pm, pn; };
struct Gemm { const bf16_t* A; const bf16_t* Bt; int M, N, K, lda, ldb; };

struct StaticOrder {
    int nM, nN, nwg, G, c;
    __host__ __device__ void init(int M, int N, int G_, int c_) { nM = M / BM; nN = N / BM; nwg = nM * nN; G = G_; c = c_; }
    __host__ __device__ bool next(int i, Unit& u) const {
        const long L = (long)i * G + c; if (L >= nwg) return false;
        int wgid = (int)L; { const int q = nwg / NXCD, r = nwg % NXCD, xcd = wgid % NXCD, off = wgid / NXCD; wgid = (xcd < r ? xcd * (q + 1) : r * (q + 1) + (xcd - r) * q) + off; }
        const int nig = WGM * nN, gid = wgid / nig, fm = gid * WGM, gsz = (nM - fm) < WGM ? (nM - fm) : WGM;
        u.pm = fm + ((wgid % nig) % gsz); u.pn = (wgid % nig) / gsz; return true;
    }
    __device__ __forceinline__ void a_ready(const Unit&) const {}
    __device__ __forceinline__ void done(const Unit&) const {}
};

template <class Epi, class Sched, bool ALIGN_EPI = false, bool SP2 = false>
__device__ __forceinline__ void gemm_phase(PG8_LAS unsigned char* lds, const Gemm g, const Sched& S, const Epi& E) {
    const int tid = opaque_tid(), wid = __builtin_amdgcn_readfirstlane(tid >> 6), lane = tid & 63, wr = wid >> 2, wc = wid & 3, fr = lane & 15, fq = lane >> 4;
    const int K = g.K, nt = K / BK;
    unsigned voffA[2], voffB[2];
#pragma unroll
    for (int i = 0; i < 2; ++i) { int R, C; stage_rc(tid * 16 + i * 8192, R, C); const int Rb = Epi::PERM ? ((R & ~31) + perm32(R & 31)) : R;
        voffA[i] = (unsigned)(R * g.lda + C) * 2u; voffB[i] = (unsigned)(Rb * g.ldb + C) * 2u; }
    const size_t kstep = (size_t)(BK * 2);
    const size_t hstepA = (size_t)HALF * g.lda * 2, hstepB = (size_t)HALF * g.ldb * 2;
    const size_t tstepA = 2 * hstepA, tstepB = 2 * hstepB;
    const unsigned ldsw = (unsigned)wid * 1024u;
    const int aoff = lds_byte(wr * 64 + fr, fq * 8), boff = lds_byte(wc * 32 + fr, fq * 8);
#define PG8_SA(b, h) (((b) * 2 + (h)) * HTB)
#define PG8_SB(b, h) ((4 + (b) * 2 + (h)) * HTB)
#define PG8_STAGE(bufoff, gbase, voff) do { _Pragma("unroll") for (int _i = 0; _i < 2; ++_i) \
        __builtin_amdgcn_global_load_lds((const unsigned*)((const char*)(gbase) + (voff)[_i]), (PG8_LAS unsigned*)(lds + (bufoff) + ldsw + _i * 8192), 16, 0, 0); } while (0)
#define PG8_LDA(dst, b, h) do { _Pragma("unroll") for (int m = 0; m < 4; ++m) _Pragma("unroll") for (int k = 0; k < 2; ++k) dst[m][k] = *(const PG8_LAS bf16x8*)(lds + PG8_SA(b, h) + aoff + m * 2048 + k * 1024); } while (0)
#define PG8_LDB(dst, b, h) do { _Pragma("unroll") for (int n = 0; n < 2; ++n) _Pragma("unroll") for (int k = 0; k < 2; ++k) dst[n][k] = *(const PG8_LAS bf16x8*)(lds + PG8_SB(b, h) + boff + n * 2048 + k * 1024); } while (0)
#define PG8_MMA(ai, bj, At, Bt) do { __builtin_amdgcn_s_setprio(1); _Pragma("unroll") for (int m = 0; m < 4; ++m) _Pragma("unroll") for (int n = 0; n < 2; ++n) _Pragma("unroll") for (int k = 0; k < 2; ++k) \
        acc[ai][bj][m][n] = __builtin_amdgcn_mfma_f32_16x16x32_bf16(Bt[n][k], At[m][k], acc[ai][bj][m][n], 0, 0, 0); __builtin_amdgcn_s_setprio(0); } while (0)
#define PG8_WAIT_V(n) asm volatile("s_waitcnt vmcnt(" #n ")" ::: "memory")
#define PG8_WAIT_L(n) asm volatile("s_waitcnt lgkmcnt(" #n ")" ::: "memory")
#define PG8_BAR __builtin_amdgcn_s_barrier()
#define PG8_SCHED __builtin_amdgcn_sched_barrier(0)
    Unit cur, nxt; int ui = 0;
    if (!S.next(0, cur)) return;
    f32x4 acc[2][2][4][2];
#pragma unroll
    for (int a = 0; a < 2; ++a)
#pragma unroll
        for (int b = 0; b < 2; ++b)
#pragma unroll
            for (int m = 0; m < 4; ++m)
#pragma unroll
                for (int n = 0; n < 2; ++n) acc[a][b][m][n] = (f32x4){0.f, 0.f, 0.f, 0.f};
    bf16x8 At[4][2], B0[2][2], B1[2][2];
    const char* cA = (const char*)g.A + (size_t)cur.pm * tstepA; const char* cB = (const char*)g.Bt + (size_t)cur.pn * tstepB;
    S.a_ready(cur);
    if constexpr (SP2) {
        PG8_STAGE(PG8_SB(0, 0), cB, voffB); PG8_STAGE(PG8_SB(0, 1), cB + hstepB, voffB); PG8_STAGE(PG8_SA(0, 0), cA, voffA); PG8_STAGE(PG8_SA(0, 1), cA + hstepA, voffA);
        if (wr == 1) PG8_BAR;
        PG8_WAIT_V(2); PG8_BAR;
        PG8_STAGE(PG8_SB(1, 0), cB + kstep, voffB); PG8_STAGE(PG8_SA(1, 0), cA + kstep, voffA); PG8_STAGE(PG8_SB(1, 1), cB + hstepB + kstep, voffB);
        PG8_WAIT_V(6); PG8_BAR;
    } else {
        PG8_STAGE(PG8_SB(0, 0), cB, voffB); PG8_STAGE(PG8_SA(0, 0), cA, voffA); PG8_STAGE(PG8_SB(0, 1), cB + hstepB, voffB); PG8_STAGE(PG8_SA(0, 1), cA + hstepA, voffA);
        if (wr == 1) PG8_BAR;
        PG8_WAIT_V(4); PG8_BAR;
        PG8_STAGE(PG8_SB(1, 0), cB + kstep, voffB); PG8_STAGE(PG8_SA(1, 0), cA + kstep, voffA); PG8_STAGE(PG8_SB(1, 1), cB + hstepB + kstep, voffB);
        PG8_WAIT_V(6); PG8_BAR;
    }
    for (;;) {
        const bool has_next = S.next(ui + 1, nxt);
        const char* nA = has_next ? (const char*)g.A + (size_t)nxt.pm * tstepA : cA; const char* nB = has_next ? (const char*)g.Bt + (size_t)nxt.pn * tstepB : cB;
        for (int t = 0; t < nt; t += 2) {
            const bool last = (t == nt - 2);
            const char* a1 = cA + (size_t)(t + 1) * kstep;
            const char* a2 = last ? nA : cA + (size_t)(t + 2) * kstep; const char* b2 = last ? nB : cB + (size_t)(t + 2) * kstep;
            const char* a3 = a2 + kstep; const char* b3 = b2 + kstep;
            if (last && has_next) S.a_ready(nxt);
            if constexpr (SP2) {
            PG8_LDB(B0, 0, 0); PG8_LDB(B1, 0, 1); PG8_SCHED; PG8_LDA(At, 0, 0); PG8_STAGE(PG8_SA(1, 1), a1 + hstepA, voffA);
            PG8_WAIT_V(8); PG8_WAIT_L(0); PG8_BAR; PG8_MMA(0, 0, At, B0); PG8_MMA(0, 1, At, B1); PG8_BAR; PG8_SCHED;
            PG8_LDA(At, 0, 1); PG8_STAGE(PG8_SB(0, 0), b2, voffB); PG8_STAGE(PG8_SB(0, 1), b2 + hstepB, voffB); PG8_STAGE(PG8_SA(0, 0), a2, voffA);
            PG8_WAIT_V(8); PG8_WAIT_L(0); PG8_BAR; PG8_MMA(1, 0, At, B0); PG8_MMA(1, 1, At, B1); PG8_BAR; PG8_SCHED;
            PG8_LDB(B0, 1, 0); PG8_LDB(B1, 1, 1); PG8_SCHED; PG8_LDA(At, 1, 0); PG8_STAGE(PG8_SA(0, 1), a2 + hstepA, voffA);
            PG8_WAIT_V(8); PG8_WAIT_L(0); PG8_BAR; PG8_MMA(0, 0, At, B0); PG8_MMA(0, 1, At, B1); PG8_BAR; PG8_SCHED;
            PG8_LDA(At, 1, 1); PG8_STAGE(PG8_SB(1, 0), b3, voffB); PG8_STAGE(PG8_SB(1, 1), b3 + hstepB, voffB); PG8_STAGE(PG8_SA(1, 0), a3, voffA);
            PG8_WAIT_V(8); PG8_WAIT_L(0); PG8_BAR; PG8_MMA(1, 0, At, B0); PG8_MMA(1, 1, At, B1); PG8_BAR; PG8_SCHED;
            } else {
            PG8_LDB(B0, 0, 0); PG8_SCHED; PG8_LDA(At, 0, 0); PG8_STAGE(PG8_SA(1, 1), a1 + hstepA, voffA);
            PG8_WAIT_L(8); PG8_BAR; PG8_WAIT_L(0); PG8_MMA(0, 0, At, B0); PG8_BAR; PG8_SCHED;
            PG8_LDB(B1, 0, 1); PG8_STAGE(PG8_SB(0, 0), b2, voffB);
            PG8_BAR; PG8_WAIT_L(0); PG8_MMA(0, 1, At, B1); PG8_BAR;
            PG8_LDA(At, 0, 1); PG8_STAGE(PG8_SA(0, 0), a2, voffA);
            PG8_BAR; PG8_WAIT_L(0); PG8_MMA(1, 0, At, B0); PG8_BAR; PG8_SCHED;
            PG8_STAGE(PG8_SB(0, 1), b2 + hstepB, voffB);
            PG8_WAIT_V(6); PG8_BAR; PG8_MMA(1, 1, At, B1); PG8_BAR;
            PG8_LDB(B0, 1, 0); PG8_SCHED; PG8_LDA(At, 1, 0); PG8_STAGE(PG8_SA(0, 1), a2 + hstepA, voffA);
            PG8_WAIT_L(8); PG8_BAR; PG8_WAIT_L(0); PG8_MMA(0, 0, At, B0); PG8_BAR; PG8_SCHED;
            PG8_LDB(B1, 1, 1); PG8_STAGE(PG8_SB(1, 0), b3, voffB);
            PG8_BAR; PG8_WAIT_L(0); PG8_MMA(0, 1, At, B1); PG8_BAR;
            PG8_LDA(At, 1, 1); PG8_STAGE(PG8_SA(1, 0), a3, voffA);
            PG8_BAR; PG8_WAIT_L(0); PG8_MMA(1, 0, At, B0); PG8_BAR; PG8_SCHED;
            PG8_STAGE(PG8_SB(1, 1), b3 + hstepB, voffB);
            PG8_WAIT_V(6); PG8_BAR; PG8_MMA(1, 1, At, B1); PG8_BAR;
            }
        }
        if constexpr (ALIGN_EPI) { if (wr == 0) PG8_BAR; }
        if constexpr (!Epi::AFTER_DRAIN) { E(acc, cur, wr, wc, fr, fq); S.done(cur); }
        if (!has_next) break;
#pragma unroll
        for (int a = 0; a < 2; ++a)
#pragma unroll
            for (int b = 0; b < 2; ++b)
#pragma unroll
                for (int m = 0; m < 4; ++m)
#pragma unroll
                    for (int n = 0; n < 2; ++n) acc[a][b][m][n] = (f32x4){0.f, 0.f, 0.f, 0.f};
        cur = nxt; cA = nA; cB = nB; ++ui;
        if constexpr (ALIGN_EPI) { if (wr == 1) PG8_BAR; }
    }
    PG8_WAIT_V(0);
    if constexpr (!ALIGN_EPI) { if (wr == 0) PG8_BAR; }
    PG8_BAR;
    if constexpr (Epi::AFTER_DRAIN) { E.fused(acc, cur, wr, wc, fr, fq, lds, wid, lane); S.done(cur); }
#undef PG8_SA
#undef PG8_SB
#undef PG8_STAGE
#undef PG8_LDA
#undef PG8_LDB
#undef PG8_MMA
#undef PG8_WAIT_V
#undef PG8_WAIT_L
#undef PG8_BAR
#undef PG8_SCHED
}
}

__device__ __forceinline__ unsigned cvt_pk_bf16(float lo, float hi) { unsigned r; asm volatile("v_cvt_pk_bf16_f32 %0, %1, %2" : "=v"(r) : "v"(lo), "v"(hi)); return r; }
template <int ACT> struct PEpiBf16 {
    static constexpr bool PERM = true, AFTER_DRAIN = false;
    bf16_t* O; int ldc; const float* rs;
    __device__ __forceinline__ void operator()(const f32x4 (&acc)[2][2][4][2], const pg8::Unit& u, int wr, int wc, int fr, int fq) const {
        const int row0 = u.pm * 256 + wr * 64 + fr, col0 = u.pn * 256 + wc * 32 + 8 * fq;
#pragma unroll
        for (int ai = 0; ai < 2; ++ai)
#pragma unroll
            for (int m = 0; m < 4; ++m) { bf16_t* rowp = O + (size_t)(row0 + ai * 128 + m * 16) * ldc + col0; float rsc = rs ? rs[row0 + ai * 128 + m * 16] : 1.f; if (ACT == 2) rsc = 1.f / sqrtf(rsc * (1.f / 1024) + EPS);
#pragma unroll
                for (int bj = 0; bj < 2; ++bj) { f32x4 v0 = acc[ai][bj][m][0] * rsc, v1 = acc[ai][bj][m][1] * rsc;
                    if (ACT == 2) {
#pragma unroll
                        for (int e = 0; e < 4; ++e) { const float a = fmaxf(v0[e], 0.f), b = fmaxf(v1[e], 0.f); v0[e] = a * a; v1[e] = b * b; } }
                    u32x4 w; w.x = cvt_pk_bf16(v0[0], v0[1]); w.y = cvt_pk_bf16(v0[2], v0[3]); w.z = cvt_pk_bf16(v1[0], v1[1]); w.w = cvt_pk_bf16(v1[2], v1[3]);
                    *(u32x4*)(rowp + bj * 128) = w; } }
    }
};
struct PEpiResF32 {
    static constexpr bool PERM = false, AFTER_DRAIN = false;
    const float* base; float* out; int ldc;
    __device__ __forceinline__ void operator()(const f32x4 (&acc)[2][2][4][2], const pg8::Unit& u, int wr, int wc, int fr, int fq) const {
        const int col0 = u.pn * 256 + wc * 32 + 4 * fq;
#pragma unroll
        for (int ai = 0; ai < 2; ++ai)
#pragma unroll
            for (int m = 0; m < 4; ++m) { const size_t off = (size_t)(u.pm * 256 + ai * 128 + wr * 64 + m * 16 + fr) * ldc + col0;
#pragma unroll
                for (int bj = 0; bj < 2; ++bj)
#pragma unroll
                    for (int n = 0; n < 2; ++n) { const f32x4 bs = *(const f32x4*)(base + off + bj * 128 + n * 16); *(f32x4*)(out + off + bj * 128 + n * 16) = bs + acc[ai][bj][m][n]; } }
    }
};

struct PEpiWo {
    static constexpr bool PERM = false, AFTER_DRAIN = false;
    const float* base; float* out; bf16_t* xb; float* ssq; int ldc;
    __device__ __forceinline__ void operator()(const f32x4 (&acc)[2][2][4][2], const pg8::Unit& u, int wr, int wc, int fr, int fq) const {
        const int col0 = u.pn * 256 + wc * 32 + 4 * fq; const int lane = fq * 16 + fr;
#pragma unroll
        for (int ai = 0; ai < 2; ++ai)
#pragma unroll
            for (int m = 0; m < 4; ++m) { const int row = u.pm * 256 + ai * 128 + wr * 64 + m * 16 + fr; const size_t off = (size_t)row * ldc + col0; float ss = 0.f;
#pragma unroll
                for (int bj = 0; bj < 2; ++bj)
#pragma unroll
                    for (int n = 0; n < 2; ++n) { const f32x4 bs = *(const f32x4*)(base + off + bj * 128 + n * 16); const f32x4 v = bs + acc[ai][bj][m][n];
                        *(f32x4*)(out + off + bj * 128 + n * 16) = v; ss += (v[0] * v[0] + v[1] * v[1]) + (v[2] * v[2] + v[3] * v[3]);
                        u32x2 w; w.x = cvt_pk_bf16(v[0], v[1]); w.y = cvt_pk_bf16(v[2], v[3]); *(u32x2*)(xb + off + bj * 128 + n * 16) = w; }
                ss += __builtin_bit_cast(float, __builtin_amdgcn_ds_bpermute((lane ^ 16) << 2, __builtin_bit_cast(int, ss)));
                ss += __builtin_bit_cast(float, __builtin_amdgcn_ds_bpermute((lane ^ 32) << 2, __builtin_bit_cast(int, ss)));
                if (fq == 0) __hip_atomic_fetch_add(ssq + row, ss, __ATOMIC_RELAXED, __HIP_MEMORY_SCOPE_AGENT); }
    }
};

__device__ __forceinline__ float sq8(const bf16x8 v) { float s = 0.f;
#pragma unroll
    for (int j = 0; j < 8; ++j) { const float f = bf2f((unsigned short)v[j]); s += f * f; }
    return s; }
__device__ __forceinline__ u32x4 scale8(const bf16x8 v, float sc, const f32x4 ga, const f32x4 gb) { u32x4 o;
    o.x = pk2(bf2f((unsigned short)v[0]) * sc * ga[0], bf2f((unsigned short)v[1]) * sc * ga[1]); o.y = pk2(bf2f((unsigned short)v[2]) * sc * ga[2], bf2f((unsigned short)v[3]) * sc * ga[3]);
    o.z = pk2(bf2f((unsigned short)v[4]) * sc * gb[0], bf2f((unsigned short)v[5]) * sc * gb[1]); o.w = pk2(bf2f((unsigned short)v[6]) * sc * gb[2], bf2f((unsigned short)v[7]) * sc * gb[3]);
    return o; }
__device__ __forceinline__ void glueA_row(unsigned char* ws, int row, int lane) {
    const bf16_t* pr = (const bf16_t*)(ws + WS_PROJ) + (size_t)row * DINP;
    const bf16x8 vq = *(const bf16x8*)(pr + C_HQ + 8 * (lane < 48 ? lane : 47)), vkv = *(const bf16x8*)(pr + C_HKV + 8 * (lane & 31));
    const int br = (lane >> 4) & 1, g = (lane >> 3) & 1, l8 = lane & 7;
    const bf16x8 vk = *(const bf16x8*)(pr + (br ? C_KWIN : C_KSEL) + 64 * g + 8 * l8);
    const float sq = wave_sum(lane < 48 ? sq8(vq) : 0.f), skv = wave_sum(lane < 32 ? sq8(vkv) : 0.f);
    float sk = sq8(vk); sk += __shfl_xor(sk, 1); sk += __shfl_xor(sk, 2); sk += __shfl_xor(sk, 4);
    if (lane == 0) { ((float*)(ws + WS_RSQ))[row] = 1.f / sqrtf(sq * (1.f / QR) + EPS); ((float*)(ws + WS_RSKV))[row] = 1.f / sqrtf(skv * (1.f / KVR) + EPS); }
    if (lane < 32) {
        const float rstd = 1.f / sqrtf(sk * (1.f / 64) + EPS); const float* kg = inptr(10) + (1 + br) * 64 + 8 * l8;
        *(u32x4*)((bf16_t*)(ws + (br ? WS_KWIN : WS_KSEL)) + (size_t)row * 128 + 64 * g + 8 * l8) = scale8(vk, rstd, *(const f32x4*)kg, *(const f32x4*)(kg + 4));
    }
}
__device__ __forceinline__ void kpass_row(unsigned char* ws, int row, int lane) {
    const int pos = row & (SEQ - 1), h = lane >> 3, l = lane & 7;
    const bf16x8 v = *(const bf16x8*)((const bf16_t*)(ws + WS_KVM) + (size_t)row * MKV + 128 * h + 8 * l);
    const bf16_t* kr = (const bf16_t*)(ws + WS_PROJ) + (size_t)row * DINP + C_HKR + 2 * l;
    const unsigned ra = *(const unsigned*)kr, rb = *(const unsigned*)(kr + 16);
    const float x1a = bf2f(ra & 0xffffu), x1b = bf2f(ra >> 16), x2a = bf2f(rb & 0xffffu), x2b = bf2f(rb >> 16);
    float ss = sq8(v) + (x1a * x1a + x1b * x1b) + (x2a * x2a + x2b * x2b);
    ss += __shfl_xor(ss, 1); ss += __shfl_xor(ss, 2); ss += __shfl_xor(ss, 4);
    const float rstd = 1.f / sqrtf(ss * (1.f / 96) + EPS);
    const float* kg = inptr(8);
    bf16_t* ko = (bf16_t*)(ws + WS_KMLA) + (size_t)row * MQ + 96 * h;
    *(u32x4*)(ko + 8 * l) = scale8(v, rstd, *(const f32x4*)(kg + 8 * l), *(const f32x4*)(kg + 8 * l + 4));
    float o1[2], o2[2];
#pragma unroll
    for (int e = 0; e < 2; ++e) { const int i = 2 * l + e;
        const float inv = exp2f(-(float)i * (13.287712379549449f / 16.f)); float sn, cs; sincosf((float)pos * inv, &sn, &cs);
        const float n1 = (e ? x1b : x1a) * rstd * kg[64 + i], n2 = (e ? x2b : x2a) * rstd * kg[80 + i];
        o1[e] = n1 * cs - n2 * sn; o2[e] = n2 * cs + n1 * sn; }
    *(unsigned*)(ko + 64 + 2 * l) = pk2(o1[0], o1[1]); *(unsigned*)(ko + 80 + 2 * l) = pk2(o2[0], o2[1]);
}
__device__ __forceinline__ void glueC_row(unsigned char* ws, int row, int lane) {
    bf16_t* mx = (bf16_t*)(ws + WS_MIX) + (size_t)row * DM + 8 * lane;
#pragma unroll
    for (int half = 0; half < 2; ++half) {
        const bf16x8 v = *(const bf16x8*)(mx + 512 * half);
        const float rstd = 1.f / sqrtf(wave_sum(sq8(v)) * (1.f / 512) + EPS);
        const float* gp = inptr(15 + half) + 8 * lane;
        *(u32x4*)(mx + 512 * half) = scale8(v, rstd, *(const f32x4*)gp, *(const f32x4*)(gp + 4));
    }
}

__device__ __forceinline__ void compress_block(unsigned char* ws, LAS unsigned char* L, int task) {
    const int tid = opaque_tid(), lane = tid & 63, wid = __builtin_amdgcn_readfirstlane(tid >> 6), fr = lane & 15, fq = lane >> 4;
    const int tc = task & 15, b = (task >> 4) & 7, kv = task >> 7;
    int c = 8 * tc + (fr >> 1); const int g = fr & 1; if (c > NCMP - 1) c = NCMP - 1;
    const bf16_t* arow = (const bf16_t*)(ws + WS_PROJ) + (size_t)(b * SEQ + 16 * c) * DINP + (kv ? C_VCMP : C_KCMP) + 64 * g + 8 * fq;
    const float* pe = inptr(11) + kv * 2048 + 8 * fq;
    const bf16_t* w1t = (const bf16_t*)(ws + WS_W1T) + (size_t)kv * 128 * 2048 + (size_t)fr * 2048 + 8 * fq;
    f32x4 acc[8];
#pragma unroll
    for (int n = 0; n < 8; ++n) acc[n] = (f32x4){0.f, 0.f, 0.f, 0.f};
#pragma unroll 2
    for (int s8 = 0; s8 < 8; ++s8) {
        const int s = 8 * wid + s8, r = s >> 1, db = (s & 1) * 32;
        const bf16x8 araw = *(const bf16x8*)(arow + (size_t)r * DINP + db);
        const f32x4 pa = *(const f32x4*)(pe + r * 64 + db), pb = *(const f32x4*)(pe + r * 64 + db + 4);
        u32x4 aw; aw.x = pk2(bf2f((unsigned short)araw[0]) + pa[0], bf2f((unsigned short)araw[1]) + pa[1]); aw.y = pk2(bf2f((unsigned short)araw[2]) + pa[2], bf2f((unsigned short)araw[3]) + pa[3]);
        aw.z = pk2(bf2f((unsigned short)araw[4]) + pb[0], bf2f((unsigned short)araw[5]) + pb[1]); aw.w = pk2(bf2f((unsigned short)araw[6]) + pb[2], bf2f((unsigned short)araw[7]) + pb[3]);
        const bf16x8 a = __builtin_bit_cast(bf16x8, aw);
#pragma unroll
        for (int n = 0; n < 8; ++n) { const bf16x8 bb = *(const bf16x8*)(w1t + (size_t)(16 * n) * 2048 + 32 * s);
            acc[n] = __builtin_amdgcn_mfma_f32_16x16x32_bf16(a, bb, acc[n], 0, 0, 0); }
    }
    LAS float* part = (LAS float*)L;
#pragma unroll
    for (int n = 0; n < 8; ++n)
#pragma unroll
        for (int j = 0; j < 4; ++j) part[(wid * 16 + 4 * fq + j) * 128 + 16 * n + fr] = acc[n][j];
    __syncthreads();
    LAS bf16_t* hb_ = (LAS bf16_t*)(L + 65536);
#pragma unroll
    for (int e = 0; e < 4; ++e) { const int idx = tid + 512 * e; float v = 0.f;
#pragma unroll
        for (int w = 0; w < 8; ++w) v += part[w * 2048 + idx];
        hb_[idx] = (bf16_t)f2bf(v / (1.f + __expf(-v))); }
    __syncthreads();
    if (wid == 0) {
        const bf16_t* w2t = (const bf16_t*)(ws + WS_W2T) + kv * 64 * 128 + fr * 128 + 8 * fq;
        f32x4 o[4];
#pragma unroll
        for (int n = 0; n < 4; ++n) o[n] = (f32x4){0.f, 0.f, 0.f, 0.f};
#pragma unroll
        for (int ks = 0; ks < 4; ++ks) { const bf16x8 a = *(const LAS bf16x8*)(hb_ + fr * 128 + 32 * ks + 8 * fq);
#pragma unroll
            for (int n = 0; n < 4; ++n) { const bf16x8 bb = *(const bf16x8*)(w2t + (size_t)(16 * n) * 128 + 32 * ks); o[n] = __builtin_amdgcn_mfma_f32_16x16x32_bf16(a, bb, o[n], 0, 0, 0); } }
        bf16_t* dstb = (bf16_t*)(ws + (kv ? WS_VCMP : WS_KCMP)) + (size_t)b * 128 * 2 * 64;
        const float* kg = inptr(10);
#pragma unroll
        for (int j = 0; j < 4; ++j) { const int row = 4 * fq + j, cc = 8 * tc + (row >> 1), gg = row & 1;
            float sc = 1.f;
            if (kv == 0) { float ss = o[0][j] * o[0][j] + o[1][j] * o[1][j] + o[2][j] * o[2][j] + o[3][j] * o[3][j];
                ss += __shfl_xor(ss, 1); ss += __shfl_xor(ss, 2); ss += __shfl_xor(ss, 4); ss += __shfl_xor(ss, 8); sc = 1.f / sqrtf(ss * (1.f / 64) + EPS); }
#pragma unroll
            for (int n = 0; n < 4; ++n) { const int col = 16 * n + fr; float v = o[n][j] * sc; if (kv == 0) v *= kg[col]; if (cc >= NCMP) v = 0.f;
                dstb[((size_t)cc * 2 + gg) * 64 + col] = (bf16_t)f2bf(v); } }
    }
    __syncthreads();
}

namespace att {
typedef float f32x16 __attribute__((ext_vector_type(16)));
typedef short s16x4 __attribute__((ext_vector_type(4)));
typedef short v4i16_t __attribute__((ext_vector_type(4)));
typedef float f32x2_t __attribute__((ext_vector_type(2)));
typedef __bf16 bf16x2_t __attribute__((ext_vector_type(2)));
typedef const LAS unsigned char* lcp;
constexpr int NSLOT = 3;
constexpr int L_TB = 0, L_K = 4096, KSLOT = 12288, L_V = L_K + NSLOT * KSLOT, VSLOT = 8192, L_WSF = L_V + NSLOT * VSLOT, L_OST = L_WSF + 4096,
              L_IMP = L_OST + 32768, L_SELM = L_IMP + 32768, L_GATE = L_SELM + 256, L_SC = L_GATE + 3072, L_INVL = L_SC + 8192, L_END = L_INVL + 1024;
static_assert(L_V + NSLOT * VSLOT <= 65536, "LDS-DMA destinations stay below 64 KiB");
static_assert(L_END <= LDS_BST, "attention LDS map");
constexpr float THR = 8.0f;
__device__ __forceinline__ int crow(int r, int hi) { return (r & 3) + 8 * (r >> 2) + 4 * hi; }
__device__ __forceinline__ void glds16(const void* gsrc, unsigned lds_dst) { unsigned keep;
    asm volatile("s_mov_b32 %0, m0\n\ts_mov_b32 m0, %2\n\ts_nop 0\n\tglobal_load_lds_dwordx4 %1, off\n\ts_mov_b32 m0, %0" : "=&s"(keep) : "v"(gsrc), "s"(lds_dst) : "memory"); }
__device__ __forceinline__ unsigned cvtpk(float lo, float hi) { f32x2_t v = {lo, hi}; bf16x2_t b = __builtin_convertvector(v, bf16x2_t); return __builtin_bit_cast(unsigned, b); }
__device__ __forceinline__ s16x4 vtr(lcp p) { return __builtin_bit_cast(s16x4, __builtin_amdgcn_ds_read_tr16_b64_v4i16((LAS v4i16_t*)p)); }
__device__ __forceinline__ float lane_xor(float v, int lane, int x) { return __builtin_bit_cast(float, __builtin_amdgcn_ds_bpermute((lane ^ x) << 2, __builtin_bit_cast(int, v))); }
__device__ __forceinline__ unsigned lane_xor_u(unsigned v, int lane, int x) { return (unsigned)__builtin_amdgcn_ds_bpermute((lane ^ x) << 2, (int)v); }
__device__ __forceinline__ float swap_max(float m, int lane) { return __builtin_fmaxf(m, lane_xor(m, lane, 32)); }
__device__ __forceinline__ float swap_sum(float m, int lane) { return m + lane_xor(m, lane, 32); }
__device__ __forceinline__ float max16(const f32x16& p) { float a = __builtin_fmaxf(p[0], p[1]), b = __builtin_fmaxf(p[2], p[3]);
#pragma unroll
    for (int r = 4; r < 16; r += 4) { a = __builtin_fmaxf(a, __builtin_fmaxf(p[r], p[r + 1])); b = __builtin_fmaxf(b, __builtin_fmaxf(p[r + 2], p[r + 3])); }
    return __builtin_fmaxf(a, b); }
__device__ __forceinline__ float sum16(const f32x16& p) { float a = p[0] + p[1], b = p[2] + p[3];
#pragma unroll
    for (int r = 4; r < 16; r += 4) { a += p[r] + p[r + 1]; b += p[r + 2] + p[r + 3]; }
    return a + b; }
#define ATT_BAR() asm volatile("s_waitcnt vmcnt(0) lgkmcnt(0)\n\ts_barrier" ::: "memory")

template <int DQ> __device__ __forceinline__ void qkt(f32x16& p0, f32x16& p1, lcp kslot, const bf16x8* qr, const f32x16& cinit, int r32, int hi) {
    lcp kb = kslot + hi * 1024 + r32 * 16;
    constexpr int NB = 2;
#pragma unroll
    for (int db = 0; db < DQ / 16; db += NB) {
        bf16x8 kf[2 * NB];
#pragma unroll
        for (int e = 0; e < NB; ++e) { kf[2 * e] = *(const LAS bf16x8*)(kb + (db + e) * 2048); kf[2 * e + 1] = *(const LAS bf16x8*)(kb + (db + e) * 2048 + 512); }
        __builtin_amdgcn_sched_barrier(0);
#pragma unroll
        for (int e = 0; e < NB; ++e) { const int d0 = db + e;
            if (d0 == 0) { p0 = __builtin_amdgcn_mfma_f32_32x32x16_bf16(kf[0], qr[0], cinit, 0, 0, 0); p1 = __builtin_amdgcn_mfma_f32_32x32x16_bf16(kf[1], qr[0], cinit, 0, 0, 0); }
            else { p0 = __builtin_amdgcn_mfma_f32_32x32x16_bf16(kf[2 * e], qr[d0], p0, 0, 0, 0); p1 = __builtin_amdgcn_mfma_f32_32x32x16_bf16(kf[2 * e + 1], qr[d0], p1, 0, 0, 0); }
        }
    }
}
__device__ __forceinline__ void vload_half(bf16x8 (&vf)[8], lcp vp, int d0) {
#pragma unroll
    for (int ks = 0; ks < 4; ++ks) {
        const s16x4 lo = vtr(vp + d0 * 4096 + ks * 1024), hh = vtr(vp + d0 * 4096 + ks * 1024 + 512);
        vf[d0 * 4 + ks] = (bf16x8){lo[0], lo[1], lo[2], lo[3], hh[0], hh[1], hh[2], hh[3]};
    }
    __builtin_amdgcn_sched_barrier(0);
}
__device__ __forceinline__ void vload(bf16x8 (&vf)[8], lcp vp) { vload_half(vf, vp, 0); vload_half(vf, vp, 1); }
__device__ __forceinline__ void pv_mma(f32x16 (&o)[2], const bf16x8 (&vf)[8], const f32x16& p0, const f32x16& p1) {
    u32x4 pw[4];
    pw[0] = (u32x4){cvtpk(p0[0], p0[1]), cvtpk(p0[2], p0[3]), cvtpk(p0[4], p0[5]), cvtpk(p0[6], p0[7])};
    pw[1] = (u32x4){cvtpk(p0[8], p0[9]), cvtpk(p0[10], p0[11]), cvtpk(p0[12], p0[13]), cvtpk(p0[14], p0[15])};
    pw[2] = (u32x4){cvtpk(p1[0], p1[1]), cvtpk(p1[2], p1[3]), cvtpk(p1[4], p1[5]), cvtpk(p1[6], p1[7])};
    pw[3] = (u32x4){cvtpk(p1[8], p1[9]), cvtpk(p1[10], p1[11]), cvtpk(p1[12], p1[13]), cvtpk(p1[14], p1[15])};
#pragma unroll
    for (int d0 = 0; d0 < 2; ++d0)
#pragma unroll
        for (int ks = 0; ks < 4; ++ks) o[d0] = __builtin_amdgcn_mfma_f32_32x32x16_bf16(__builtin_bit_cast(bf16x8, pw[ks]), vf[d0 * 4 + ks], o[d0], 0, 0, 0);
}
__device__ __forceinline__ void pv(f32x16 (&o)[2], lcp vp, const f32x16& p0, const f32x16& p1) { bf16x8 vf[8]; vload(vf, vp); pv_mma(o, vf, p0, p1); }
template <int DQ> __device__ __forceinline__ void dma_tile(unsigned lds0, const bf16_t* Kg, int kpitch, const bf16_t* Vg, int vpitch, int key0, int slot, int wid, int lane) {
    const bf16_t* ksrc = Kg + (size_t)(key0 + lane) * kpitch + wid * 8;
    glds16(ksrc, (unsigned)__builtin_amdgcn_readfirstlane(lds0 + L_K + slot * KSLOT + wid * 1024));
    if (DQ == 96) { if (wid < 4) glds16(ksrc + 64, (unsigned)__builtin_amdgcn_readfirstlane(lds0 + L_K + slot * KSLOT + (8 + wid) * 1024)); }
    const bf16_t* vsrc = Vg + (size_t)(key0 + 16 * (wid & 3) + (lane >> 2)) * vpitch + (wid >> 2) * 32 + (lane & 3) * 8;
    glds16(vsrc, (unsigned)__builtin_amdgcn_readfirstlane(lds0 + L_V + slot * VSLOT + wid * 1024));
}

template <int DQ, class Pol>
__device__ __forceinline__ void flash_loop(LAS unsigned char* L, const bf16_t* Kg, int kpitch, const bf16_t* Vg, int vpitch, const bf16x8* qr, const Pol& pol, f32x16 (&o)[2], float& l_out, int wid, int lane) {
    const int r32 = lane & 31, hi = lane >> 5;
    const unsigned lds0 = (unsigned)(uintptr_t)L;
    LAS float* wsf = (LAS float*)(L + L_WSF) + wid * 128;
    lcp vp0 = L + L_V + ((lane >> 4) & 1) * 32 + (lane & 3) * 8 + (4 * hi + ((lane & 15) >> 2)) * 64;
    float mhat = 0.f, l = 0.f;
#pragma unroll
    for (int r = 0; r < 16; ++r) { o[0][r] = 0.f; o[1][r] = 0.f; }
    const int n = pol.ntiles;
    dma_tile<DQ>(lds0, Kg, kpitch, Vg, vpitch, pol.key0(0), 0, wid, lane);
    if (n > 1) dma_tile<DQ>(lds0, Kg, kpitch, Vg, vpitch, pol.key0(1), 1, wid, lane);
    int slot = 0, slot2 = 2;
    for (int i = 0; i < n; ++i) {
        if (i + 1 < n) { if (DQ == 96 && wid < 4) asm volatile("s_waitcnt vmcnt(3) lgkmcnt(0)\n\ts_barrier" ::: "memory"); else asm volatile("s_waitcnt vmcnt(2) lgkmcnt(0)\n\ts_barrier" ::: "memory"); }
        else ATT_BAR();
        if (i + 2 < n) dma_tile<DQ>(lds0, Kg, kpitch, Vg, vpitch, pol.key0(i + 2), slot2, wid, lane);
        if (pol.active(i)) {
            f32x16 p0, p1;
            { f32x16 negm; const float nm = -mhat;
#pragma unroll
              for (int r = 0; r < 16; ++r) negm[r] = nm;
              qkt<DQ>(p0, p1, L + L_K + slot * KSLOT, qr, negm, r32, hi); }
            bf16x8 vf[8]; vload_half(vf, vp0 + slot * VSLOT, 0);
            pol.fix(p0, p1, i);
            const float rm = swap_max(__builtin_fmaxf(max16(p0), max16(p1)), lane);
            const bool first = (i == 0);
            if (first || __any(rm > THR)) {
                float dl = first ? rm : __builtin_fmaxf(rm, 0.f);
                if (dl == -INFINITY) dl = 0.f;
                mhat += dl;
#pragma unroll
                for (int r = 0; r < 16; ++r) { p0[r] -= dl; p1[r] -= dl; }
                if (!first) {
                    const float f = __builtin_amdgcn_exp2f(-dl); l *= f;
                    if (hi == 0) wsf[r32] = f;
#pragma unroll
                    for (int r = 0; r < 16; ++r) { const float fr_ = wsf[crow(r, hi)]; o[0][r] *= fr_; o[1][r] *= fr_; }
                }
            }
#pragma unroll
            for (int r = 0; r < 16; ++r) { p0[r] = __builtin_amdgcn_exp2f(p0[r]); p1[r] = __builtin_amdgcn_exp2f(p1[r]); }
            vload_half(vf, vp0 + slot * VSLOT, 1);
            l += sum16(p0) + sum16(p1);
            pv_mma(o, vf, p0, p1);
        }
        slot = (slot == NSLOT - 1) ? 0 : slot + 1; slot2 = (slot2 == NSLOT - 1) ? 0 : slot2 + 1;
    }
    ATT_BAR();
    l_out = swap_sum(l, lane);
}

__device__ __forceinline__ void acc_scaled(f32x16 (&oc)[2], const f32x16 (&o)[2], float rowscale, LAS float* wsf, int r32, int hi) {
    if (hi == 0) wsf[32 + r32] = rowscale;
#pragma unroll
    for (int r = 0; r < 16; ++r) { const float s = wsf[32 + crow(r, hi)]; oc[0][r] += s * o[0][r]; oc[1][r] += s * o[1][r]; }
}
__device__ __forceinline__ void park_store(const f32x16 (&oc)[2], LAS float* park, int lane) {
#pragma unroll
    for (int d0 = 0; d0 < 2; ++d0)
#pragma unroll
        for (int r = 0; r < 16; ++r) park[(d0 * 16 + r) * 64 + lane] = oc[d0][r];
}
template <bool FINAL> __device__ __forceinline__ void park_acc(f32x16 (&oc)[2], LAS float* park, const f32x16 (&o)[2], float rowscale, LAS float* wsf, int lane) {
    const int r32 = lane & 31, hi = lane >> 5;
    if (hi == 0) wsf[32 + r32] = rowscale;
#pragma unroll
    for (int r = 0; r < 16; ++r) { const float s = wsf[32 + crow(r, hi)];
#pragma unroll
        for (int d0 = 0; d0 < 2; ++d0) { const float v = park[(d0 * 16 + r) * 64 + lane] + s * o[d0][r]; if (FINAL) oc[d0][r] = v; else park[(d0 * 16 + r) * 64 + lane] = v; } }
}
__device__ __forceinline__ void store_tile(const f32x16 (&oc)[2], bf16_t* dst, int pitch, LAS unsigned char* L, int wid, int lane) {
    const int r32 = lane & 31, hi = lane >> 5;
    LAS bf16_t* stg = (LAS bf16_t*)(L + L_OST + wid * 8192);
#pragma unroll
    for (int r = 0; r < 16; ++r) { const int orow = crow(r, hi);
#pragma unroll
        for (int d0 = 0; d0 < 2; ++d0) stg[orow * 64 + d0 * 32 + r32] = (bf16_t)f2bf(oc[d0][r]); }
    asm volatile("s_waitcnt lgkmcnt(0)" ::: "memory");
#pragma unroll
    for (int i = 0; i < 4; ++i) { const int row = i * 8 + (lane >> 3), ch = lane & 7; const u32x4 v = *(const LAS u32x4*)(stg + row * 64 + ch * 8); *(u32x4*)(dst + (size_t)row * pitch + ch * 8) = v; }
    asm volatile("s_waitcnt lgkmcnt(0)" ::: "memory");
}

struct PolMla { int ntiles, qw0, r32, hi;
    __device__ __forceinline__ int key0(int i) const { return 64 * i; }
    __device__ __forceinline__ bool active(int i) const { return 64 * i <= qw0 + 31; }
    __device__ __forceinline__ void fix(f32x16& p0, f32x16& p1, int i) const {
        if (64 * i + 63 > qw0) { const int q = qw0 + r32, kb = 64 * i + 4 * hi;
#pragma unroll
            for (int r = 0; r < 16; ++r) { const int kv = kb + (r & 3) + 8 * (r >> 2); if (kv > q) p0[r] = -INFINITY; if (kv + 32 > q) p1[r] = -INFINITY; } }
    }
};
struct PolSel { int ntiles, qc, q, hi; unsigned selm; const LAS float* tbh;
    __device__ __forceinline__ int key0(int i) const { return 64 * (qc - i); }
    __device__ __forceinline__ bool active(int i) const { return __any((selm >> (qc - i)) & 1u) != 0; }
    __device__ __forceinline__ void fix(f32x16& p0, f32x16& p1, int i) const {
        const bool bit = ((selm >> (qc - i)) & 1u) != 0u;
        if (i <= 2) { const int kb = 64 * (qc - i) + 4 * hi;
#pragma unroll
            for (int r = 0; r < 16; ++r) { const int d0 = q - (kb + (r & 3) + 8 * (r >> 2)), d1 = d0 - 32;
                p0[r] = (d0 < 0) ? -INFINITY : p0[r] + tbh[d0 < 127 ? d0 : 127]; p1[r] = (d1 < 0) ? -INFINITY : p1[r] + tbh[d1 < 127 ? d1 : 127]; } }
        if (!bit) {
#pragma unroll
            for (int r = 0; r < 16; ++r) { p0[r] = -INFINITY; p1[r] = -INFINITY; } }
    }
};
struct PolWin { int ntiles, qc, q, hi; const LAS float* tbh;
    __device__ __forceinline__ int key0(int i) const { return 64 * (qc - i); }
    __device__ __forceinline__ bool active(int) const { return true; }
    __device__ __forceinline__ void fix(f32x16& p0, f32x16& p1, int i) const {
        if (i <= 2 || i == 8) { const int kb = 64 * (qc - i) + 4 * hi;
#pragma unroll
            for (int r = 0; r < 16; ++r) { const int d0 = q - (kb + (r & 3) + 8 * (r >> 2)), d1 = d0 - 32;
                const float b0 = (i <= 2) ? tbh[d0 < 0 ? 0 : (d0 < 127 ? d0 : 127)] : 0.f, b1 = (i <= 2) ? tbh[d1 < 0 ? 0 : (d1 < 127 ? d1 : 127)] : 0.f;
                p0[r] = (d0 < 0 || d0 >= 512) ? -INFINITY : p0[r] + b0; p1[r] = (d1 < 0 || d1 >= 512) ? -INFINITY : p1[r] + b1; } }
    }
};

__device__ __forceinline__ void mla_unit(unsigned char* ws, LAS unsigned char* L, int b, int h, int qb) {
    const int tid = opaque_tid(), lane = tid & 63, wid = __builtin_amdgcn_readfirstlane(tid >> 6);
    const int r32 = lane & 31, hi = lane >> 5;
    const size_t rowbase = (size_t)b * SEQ; const int qw0 = 256 * qb + 32 * wid;
    bf16x8 qr[6];
    { const bf16_t* Qw = (const bf16_t*)(ws + WS_QM) + (rowbase + qw0 + r32) * MQ + 96 * h + 8 * hi;
      bf16x8 raw[6]; float ss = 0.f;
#pragma unroll
      for (int d0 = 0; d0 < 6; ++d0) { raw[d0] = *(const bf16x8*)(Qw + 16 * d0); ss += sq8(raw[d0]); }
      ss += lane_xor(ss, lane, 32);
      const float rstd = QS_MLA / sqrtf(ss * (1.f / 96) + EPS);
      const float* qg = inptr(7) + 8 * hi;
#pragma unroll
      for (int d0 = 0; d0 < 4; ++d0) qr[d0] = __builtin_bit_cast(bf16x8, scale8(raw[d0], rstd, *(const f32x4*)(qg + 16 * d0), *(const f32x4*)(qg + 16 * d0 + 4)));
      float o1[8], o2[8]; const float posf = (float)(qw0 + r32);
#pragma unroll
      for (int j = 0; j < 8; ++j) { const int i = 8 * hi + j; const float inv = exp2f(-(float)i * (13.287712379549449f / 16.f)); float sn, cs; sincosf(posf * inv, &sn, &cs);
          const float n1 = bf2f((unsigned short)raw[4][j]) * rstd * qg[64 + j], n2 = bf2f((unsigned short)raw[5][j]) * rstd * qg[80 + j];
          o1[j] = n1 * cs - n2 * sn; o2[j] = n2 * cs + n1 * sn; }
      u32x4 w4, w5; w4.x = pk2(o1[0], o1[1]); w4.y = pk2(o1[2], o1[3]); w4.z = pk2(o1[4], o1[5]); w4.w = pk2(o1[6], o1[7]);
      w5.x = pk2(o2[0], o2[1]); w5.y = pk2(o2[2], o2[3]); w5.z = pk2(o2[4], o2[5]); w5.w = pk2(o2[6], o2[7]);
      qr[4] = __builtin_bit_cast(bf16x8, w4); qr[5] = __builtin_bit_cast(bf16x8, w5); }
    const bf16_t* Kg = (const bf16_t*)(ws + WS_KMLA) + rowbase * MQ + 96 * h;
    const bf16_t* Vg = (const bf16_t*)(ws + WS_KVM) + rowbase * MKV + 128 * h + 64;
    PolMla pol{4 * qb + 4, qw0, r32, hi};
    f32x16 o[2]; float l;
    flash_loop<96>(L, Kg, MQ, Vg, MKV, qr, pol, o, l, wid, lane);
    LAS float* wsf = (LAS float*)(L + L_WSF) + wid * 128;
    f32x16 oc[2];
#pragma unroll
    for (int r = 0; r < 16; ++r) { oc[0][r] = 0.f; oc[1][r] = 0.f; }
    acc_scaled(oc, o, (l > 0.f) ? 1.f / l : 0.f, wsf, r32, hi);
    store_tile(oc, (bf16_t*)(ws + WS_MIX) + (rowbase + qw0) * DM + 64 * h, DM, L, wid, lane);
}

__device__ __forceinline__ void nsa_unit(unsigned char* ws, LAS unsigned char* L, int b, int g, int qc) {
#define NSA_IDS() const int tid = opaque_tid(), lane = tid & 63, wid = __builtin_amdgcn_readfirstlane(tid >> 6); \
    const int r32 = lane & 31, hi = lane >> 5, rh = wid & 3, qh = wid >> 2, h = 4 * g + rh, qloc = 32 * qh + r32, q = q0 + qloc; \
    const unsigned lds0 = (unsigned)(uintptr_t)L; LAS float* wsf = (LAS float*)(L + L_WSF) + wid * 128; const LAS float* tbh = (const LAS float*)(L + L_TB) + h * 128; \
    LAS float* gate = (LAS float*)(L + L_GATE); (void)tid; (void)lane; (void)r32; (void)hi; (void)rh; (void)qh; (void)h; (void)qloc; (void)q; (void)lds0; (void)wsf; (void)tbh; (void)gate
    const size_t rowbase = (size_t)b * SEQ; const int q0 = 64 * qc;
    const bf16_t* pr = (const bf16_t*)(ws + WS_PROJ);
    bf16x8 qr[4];
    {
    NSA_IDS();
    for (int i = tid; i < 768; i += 512) { const int br = i >> 8, r = (i >> 6) & 3, qq = i & 63;
        const float x = bf2f(pr[(rowbase + q0 + qq) * DINP + C_GATE + 8 * br + 4 * g + r]); gate[i] = 1.f / (1.f + __expf(-x)); }
    { const bf16_t* Qw = pr + (rowbase + q) * DINP + C_QB + 64 * h + 8 * hi;
      bf16x8 raw[4]; float ss = 0.f;
#pragma unroll
      for (int d0 = 0; d0 < 4; ++d0) { raw[d0] = *(const bf16x8*)(Qw + 16 * d0); ss += sq8(raw[d0]); }
      ss += lane_xor(ss, lane, 32);
      const float rstd = QS_NSA / sqrtf(ss * (1.f / 64) + EPS);
      const float* qg = inptr(9) + 8 * hi;
#pragma unroll
      for (int d0 = 0; d0 < 4; ++d0) qr[d0] = __builtin_bit_cast(bf16x8, scale8(raw[d0], rstd, *(const f32x4*)(qg + 16 * d0), *(const f32x4*)(qg + 16 * d0 + 4))); }
    }
    f32x16 oc[2];
#pragma unroll
    for (int r = 0; r < 16; ++r) { oc[0][r] = 0.f; oc[1][r] = 0.f; }
    {
        NSA_IDS();
        const bf16_t* Kg = (const bf16_t*)(ws + WS_KCMP) + ((size_t)b * 256 + g) * 64;
        const bf16_t* Vg = (const bf16_t*)(ws + WS_VCMP) + ((size_t)b * 256 + g) * 64;
        dma_tile<64>(lds0, Kg, 128, Vg, 128, 0, 0, wid, lane);
        dma_tile<64>(lds0, Kg, 128, Vg, 128, 64, 1, wid, lane);
        ATT_BAR();
        lcp vp0 = L + L_V + ((lane >> 4) & 1) * 32 + (lane & 3) * 8 + (4 * hi + ((lane & 15) >> 2)) * 64;
        LAS float* imp = (LAS float*)(L + L_IMP) + (rh * 64 + qloc) * 32;
        f32x16 o[2];
#pragma unroll
        for (int r = 0; r < 16; ++r) { o[0][r] = 0.f; o[1][r] = 0.f; }
        float m = -INFINITY, lsum = 0.f, prev_last = 0.f;
#pragma unroll 1
        for (int pass = 0; pass < 2; ++pass) {
#pragma unroll 1
            for (int T = 0; T < 2; ++T) {
                f32x16 a0, a1;
                { f32x16 zero;
#pragma unroll
                  for (int r = 0; r < 16; ++r) zero[r] = 0.f;
                  qkt<64>(a0, a1, L + L_K + T * KSLOT, qr, zero, r32, hi); }
#pragma unroll
                for (int r = 0; r < 16; ++r) { const int c = 64 * T + crow(r, hi);
                    { const int d = q - 16 * c - 31;        a0[r] = (d < 0) ? -INFINITY : a0[r] + tbh[d < 127 ? d : 127]; }
                    { const int d = q - 16 * (c + 32) - 31; a1[r] = (d < 0 || c + 32 >= NCMP) ? -INFINITY : a1[r] + tbh[d < 127 ? d : 127]; } }
                if (pass == 0) { m = __builtin_fmaxf(m, __builtin_fmaxf(max16(a0), max16(a1))); }
                else {
#pragma unroll
                    for (int r = 0; r < 16; ++r) { a0[r] = __builtin_amdgcn_exp2f(a0[r] - m); a1[r] = __builtin_amdgcn_exp2f(a1[r] - m); }
                    lsum += sum16(a0) + sum16(a1);
                    float own[8], car[8];
#pragma unroll
                    for (int a = 0; a < 4; ++a) {
                        own[a]     = a0[4 * a] + a0[4 * a + 1] + a0[4 * a + 2] + 0.5f * a0[4 * a + 3]; car[a]     = 0.5f * a0[4 * a + 3];
                        own[4 + a] = a1[4 * a] + a1[4 * a + 1] + a1[4 * a + 2] + 0.5f * a1[4 * a + 3]; car[4 + a] = 0.5f * a1[4 * a + 3]; }
#pragma unroll
                    for (int k = 0; k < 8; ++k) car[k] = lane_xor(car[k], lane, 32);
#pragma unroll
                    for (int k = 0; k < 8; ++k) { const float add = hi ? car[k] : (k >= 1 ? car[k - 1] : prev_last); imp[16 * T + 2 * k + hi] = own[k] + add; }
                    prev_last = car[7];
                    pv(o, vp0 + T * VSLOT, a0, a1);
                }
            }
            if (pass == 0) { m = swap_max(m, lane); if (m == -INFINITY) m = 0.f; }
        }
        lsum = swap_sum(lsum, lane);
        const float inv = (lsum > 0.f) ? 1.f / lsum : 0.f;
        if (hi == 0) ((LAS float*)(L + L_INVL))[rh * 64 + qloc] = inv;
        ATT_BAR();
        acc_scaled(oc, o, gate[(0 * 4 + rh) * 64 + qloc] * inv, wsf, r32, hi);
    }
    {
        const int tid = opaque_tid();
        const LAS float* imp = (const LAS float*)(L + L_IMP); LAS float* sc = (LAS float*)(L + L_SC);
        const int qq = tid >> 3, jj = tid & 7;
#pragma unroll
        for (int k = 0; k < 4; ++k) { const int j = jj + 8 * k; const LAS float* il = (const LAS float*)(L + L_INVL);
            const float tot = (imp[(0 * 64 + qq) * 32 + j] * il[qq] + imp[(1 * 64 + qq) * 32 + j] * il[64 + qq]) + (imp[(2 * 64 + qq) * 32 + j] * il[128 + qq] + imp[(3 * 64 + qq) * 32 + j] * il[192 + qq]);
            float s; if (j > qc) s = -INFINITY; else if (j == 0 || j == qc || j == qc - 1) s = 1e4f; else s = tot; sc[qq * 32 + j] = s; }
        ATT_BAR();
        unsigned bits = 0u;
#pragma unroll
        for (int k = 0; k < 4; ++k) { const int j = jj + 8 * k; const float me = sc[qq * 32 + j]; int rank = 0;
            for (int i = 0; i < 32; ++i) { const float si = sc[qq * 32 + i]; rank += (si > me || (si == me && i < j)) ? 1 : 0; }
            if (rank < 16) bits |= 1u << j; }
        { const int lane = tid & 63; bits |= lane_xor_u(bits, lane, 1); bits |= lane_xor_u(bits, lane, 2); bits |= lane_xor_u(bits, lane, 4); }
        if (jj == 0) ((LAS unsigned*)(L + L_SELM))[qq] = bits;
        ATT_BAR();
    }
    { NSA_IDS(); park_store(oc, (LAS float*)(L + L_OST) + wid * 2048, lane); }
    {
        NSA_IDS();
        const unsigned selm = ((const LAS unsigned*)(L + L_SELM))[qloc];
        const bf16_t* Kg = (const bf16_t*)(ws + WS_KSEL) + rowbase * 128 + 64 * g;
        const bf16_t* Vg = pr + rowbase * DINP + C_VSEL + 64 * g;
        PolSel pol{qc + 1, qc, q, hi, selm, tbh};
        f32x16 o[2]; float l;
        flash_loop<64>(L, Kg, 128, Vg, DINP, qr, pol, o, l, wid, lane);
        { f32x16 dummy[2]; park_acc<false>(dummy, (LAS float*)(L + L_OST) + wid * 2048, o, (l > 0.f) ? gate[(1 * 4 + rh) * 64 + qloc] / l : 0.f, wsf, lane); }
    }
    {
        NSA_IDS();
        const bf16_t* Kg = (const bf16_t*)(ws + WS_KWIN) + rowbase * 128 + 64 * g;
        const bf16_t* Vg = pr + rowbase * DINP + C_VWIN + 64 * g;
        PolWin pol{(qc < 8 ? qc : 8) + 1, qc, q, hi, tbh};
        f32x16 o[2]; float l;
        flash_loop<64>(L, Kg, 128, Vg, DINP, qr, pol, o, l, wid, lane);
        f32x16 fin[2]; park_acc<true>(fin, (LAS float*)(L + L_OST) + wid * 2048, o, (l > 0.f) ? gate[(2 * 4 + rh) * 64 + qloc] / l : 0.f, wsf, lane);
        store_tile(fin, (bf16_t*)(ws + WS_MIX) + (rowbase + q0 + 32 * qh) * DM + 512 + 64 * h, DM, L, wid, lane);
    }
    ATT_BAR();
}
#undef ATT_BAR
#undef NSA_IDS
}

#define XB_TMO      128
#define XB_XCNT(j)  (256  + 64 * (j))
#define XB_XSUB(j)  (1280 + 64 * (j))
#define XB_XGEN(j)  (2304 + 64 * (j))
#define XB_TOP      3328
#define XB_TOPGEN   3392
#define XCD_BAR_WORDS 3456
#define XB_SPIN_CAP (1u << 18)

__device__ __forceinline__ unsigned xb_ld(unsigned* p)              { return __hip_atomic_load(p, __ATOMIC_RELAXED, __HIP_MEMORY_SCOPE_AGENT); }
__device__ __forceinline__ unsigned xb_add(unsigned* p, unsigned v) { return __hip_atomic_fetch_add(p, v, __ATOMIC_RELAXED, __HIP_MEMORY_SCOPE_AGENT); }
__device__ __forceinline__ unsigned xb_xcc_id() { return (unsigned)__builtin_amdgcn_s_getreg((3 << 11) | 20) & 0xFu; }
#define XB_SPIN(cond, bar) do { unsigned _sp = 0; while (cond) { __builtin_amdgcn_s_sleep(1); \
    if ((++_sp & 255u) == 0u) { if (xb_ld(&(bar)[XB_TMO])) break; if (_sp > XB_SPIN_CAP) { atomicAdd(&(bar)[XB_TMO], 1u); break; } } } } while (0)

struct XcdBarrier {
    unsigned* bar; unsigned x;
    volatile LAS unsigned* st;
};

__device__ __forceinline__ XcdBarrier xcd_barrier_post(unsigned* bar, volatile LAS unsigned* st) {
    XcdBarrier b; b.bar = bar; b.x = xb_xcc_id(); b.st = st;
    if (threadIdx.x == 0) (void)xb_add(&bar[XB_XCNT(b.x)], 1u);
    return b;
}
__device__ __forceinline__ void xcd_barrier_complete(unsigned* bar, unsigned x, unsigned& nloc, unsigned& nx) {
    const unsigned G = gridDim.x * gridDim.y * gridDim.z;
    unsigned sum, cnt, mine, sp = 0u;
    for (;;) {
        sum = 0u; cnt = 0u; mine = 0u;
#pragma unroll
        for (unsigned j = 0; j < 16; ++j) { const unsigned c = xb_ld(&bar[XB_XCNT(j)]); sum += c; cnt += (c > 0u) ? 1u : 0u; mine = (j == x) ? c : mine; }
        if (sum == G) break;
        __builtin_amdgcn_s_sleep(1);
        if ((++sp & 255u) == 0u) { if (xb_ld(&bar[XB_TMO])) break; if (sp > XB_SPIN_CAP) { atomicAdd(&bar[XB_TMO], 1u); break; } }
    }
    nloc = mine > 0u ? mine : 1u; nx = cnt > 0u ? cnt : 1u;
}

__device__ __forceinline__ void xcd_barrier(const XcdBarrier& b) {
    asm volatile("s_waitcnt vmcnt(0)" ::: "memory");
    __syncthreads();
    if (threadIdx.x == 0) {
        unsigned* bar = b.bar;
        __builtin_amdgcn_s_waitcnt(0);
        unsigned nloc = b.st[0], nx = b.st[1];
        if (nloc == 0u) { xcd_barrier_complete(bar, b.x, nloc, nx); b.st[0] = nloc; b.st[1] = nx; }
        const unsigned old = xb_add(&bar[XB_XSUB(b.x)], 1u);
        const unsigned gen = old / nloc;
        if (old + 1u == (gen + 1u) * nloc) {
            __builtin_amdgcn_fence(__ATOMIC_RELEASE, "agent");
            asm volatile("s_waitcnt vmcnt(0)" ::: "memory");
            const unsigned og = xb_add(&bar[XB_TOP], 1u);
            const unsigned tg = og / nx;
            if (og + 1u == (tg + 1u) * nx) xb_add(&bar[XB_TOPGEN], 1u);
            else XB_SPIN(xb_ld(&bar[XB_TOPGEN]) == tg, bar);
            __builtin_amdgcn_fence(__ATOMIC_ACQUIRE, "agent");
            xb_add(&bar[XB_XGEN(b.x)], 1u);
            asm volatile("s_waitcnt vmcnt(0)" ::: "memory");
        } else {
            XB_SPIN(xb_ld(&bar[XB_XGEN(b.x)]) == gen, bar);
            __builtin_amdgcn_fence(__ATOMIC_ACQUIRE, "agent");
            asm volatile("s_waitcnt vmcnt(0)" ::: "memory");
        }
    }
    __syncthreads();
}

__global__ void __launch_bounds__(512, 2) mega(Params p) {
    extern __shared__ __attribute__((aligned(16))) unsigned char lds[];
    const int G = gridDim.x, bid = blockIdx.x, NGW = G * NW;
#define PHASE_IDS() const int tid = opaque_tid(), lane = tid & 63, wave = __builtin_amdgcn_readfirstlane(tid >> 6), gw = bid * NW + wave; (void)tid; (void)lane; (void)gw
    unsigned char* ws = (unsigned char*)inptr(22);
    LAS unsigned char* L = (LAS unsigned char*)lds;
    volatile LAS unsigned* bst = (volatile LAS unsigned*)(L + LDS_BST);
    if (threadIdx.x < 4) bst[threadIdx.x] = 0u;
    __syncthreads();
    const XcdBarrier bar = xcd_barrier_post((unsigned*)(ws + WS_CTL), bst);

#if EXP == 5
    for (int e_ = 0; e_ < 2; ++e_)
#endif
    {
        PHASE_IDS();
        LAS float* scr = (LAS float*)(L + wave * 8704);
        constexpr int I0 = (1024 / 64) * (DINP / 32), I1 = (QR / 64) * (MQ / 32), I2 = (KVR / 64) * (MKV / 32), I3 = 16 * 32, I4 = 16 * (FF / 32), I5 = (FF / 64) * 32;
        constexpr int I6 = (2048 / 64) * (128 / 32), I7 = (128 / 64) * (64 / 32);
        constexpr int NIT = I0 + I1 + I2 + I3 + I4 + I5 + 2 * I6 + 2 * I7;
        for (int it = gw; it < NIT; it += NGW) {
            int r = it;
            if (r < I0) { p0_transpose_item(inptr(2), 1024, DIN, DINP, (bf16_t*)(ws + WS_WIN), scr, r, lane); continue; } r -= I0;
            if (r < I1) { p0_transpose_item(inptr(5), QR, MQ, MQ, (bf16_t*)(ws + WS_WUQ), scr, r, lane, inptr(3)); continue; } r -= I1;
            if (r < I2) { p0_transpose_item(inptr(6), KVR, MKV, MKV, (bf16_t*)(ws + WS_WUKV), scr, r, lane, inptr(4)); continue; } r -= I2;
            if (r < I3) { p0_transpose_item(inptr(17), 1024, 1024, 1024, (bf16_t*)(ws + WS_WO), scr, r, lane); continue; } r -= I3;
            if (r < I4) { p0_transpose_item(inptr(19), 1024, FF, FF, (bf16_t*)(ws + WS_WUP), scr, r, lane, inptr(18)); continue; } r -= I4;
            if (r < I5) { p0_transpose_item(inptr(20), FF, 1024, 1024, (bf16_t*)(ws + WS_WDN), scr, r, lane); continue; } r -= I5;
            if (r < 2 * I6) { const int kv = r / I6; p0_transpose_item(inptr(12) + (size_t)kv * 2048 * 128, 2048, 128, 128, (bf16_t*)(ws + WS_W1T) + (size_t)kv * 128 * 2048, scr, r % I6, lane); continue; } r -= 2 * I6;
            { const int kv = r / I7; p0_transpose_item(inptr(13) + kv * 128 * 64, 128, 64, 64, (bf16_t*)(ws + WS_W2T) + kv * 64 * 128, scr, r % I7, lane); }
        }
        for (int m = gw; m < M; m += NGW) rms_row_to_bf16(inptr(0) + (size_t)m * DM, inptr(1), (bf16_t*)(ws + WS_HB) + (size_t)m * DM, lane);
        for (int m = bid * 512 + tid; m < M; m += G * 512) ((float*)(ws + WS_SSQ2))[m] = 0.f;
    }
    xcd_barrier(bar);
#if EXP == 1
    for (int e_ = 0; e_ < 10; ++e_) xcd_barrier(bar);
#endif
    { pg8::Gemm g{(const bf16_t*)(ws + WS_HB), (const bf16_t*)(ws + WS_WIN), M, DINP, DM, DM, DM}; pg8::StaticOrder S; S.init(M, DINP, G, bid);
      PEpiBf16<0> E{(bf16_t*)(ws + WS_PROJ), DINP, nullptr}; pg8::gemm_phase<PEpiBf16<0>, pg8::StaticOrder, true, true>(L, g, S, E); }
    xcd_barrier(bar);
#if EXP == 3
    for (int e_ = 0; e_ < 2; ++e_)
#endif
    { PHASE_IDS();
      for (int m = gw; m < M; m += NGW) glueA_row(ws, m, lane);
      __syncthreads();
      for (int t = bid; t < 256; t += G) compress_block(ws, L, t); }
    xcd_barrier(bar);
    { pg8::Gemm g{(const bf16_t*)(ws + WS_PROJ) + C_HQ, (const bf16_t*)(ws + WS_WUQ), M, MQ, QR, DINP, QR}; pg8::StaticOrder S; S.init(M, MQ, G, bid);
      PEpiBf16<0> E{(bf16_t*)(ws + WS_QM), MQ, (const float*)(ws + WS_RSQ)}; pg8::gemm_phase<PEpiBf16<0>, pg8::StaticOrder, true, true>(L, g, S, E); }
    { pg8::Gemm g{(const bf16_t*)(ws + WS_PROJ) + C_HKV, (const bf16_t*)(ws + WS_WUKV), M, MKV, KVR, DINP, KVR}; pg8::StaticOrder S; S.init(M, MKV, G, bid);
      PEpiBf16<0> E{(bf16_t*)(ws + WS_KVM), MKV, (const float*)(ws + WS_RSKV)}; pg8::gemm_phase<PEpiBf16<0>, pg8::StaticOrder, true, true>(L, g, S, E); }
    xcd_barrier(bar);
#if EXP == 6
    for (int e_ = 0; e_ < 2; ++e_)
#endif
    { PHASE_IDS(); for (int m = gw; m < M; m += NGW) kpass_row(ws, m, lane); }
    xcd_barrier(bar);
#if EXP == 2
    for (int e_ = 0; e_ < 2; ++e_)
#endif
    {
        PHASE_IDS();
        LAS float* tb = (LAS float*)L;
        for (int i = tid; i < 8 * 128; i += 512) { const int h = i >> 7, n = i & 127; tb[i] = (inptr(14)[t5_bucket(n) * 8 + h] - inptr(14)[31 * 8 + h]) * LOG2E; }
        __syncthreads();
        const int vcu = (G % 8 == 0) ? (bid % 8) * (G / 8) + bid / 8 : bid;
        for (int pr_ = vcu; pr_ < 256; pr_ += G) {
            { const int bg = pr_ >> 4, s_ = pr_ & 15;
#pragma unroll 1
              for (int u_ = 0; u_ < 2; ++u_) att::nsa_unit(ws, L, bg >> 1, bg & 1, u_ ? s_ : 31 - s_);
            }
            { const int bh = pr_ >> 2, s_ = pr_ & 3;
#pragma unroll 1
              for (int u_ = 0; u_ < 2; ++u_) att::mla_unit(ws, L, bh >> 3, bh & 7, u_ ? s_ : 7 - s_);
            }
        }
    }
    xcd_barrier(bar);
    { PHASE_IDS(); for (int m = gw; m < M; m += NGW) glueC_row(ws, m, lane); }
    xcd_barrier(bar);
    { pg8::Gemm g{(const bf16_t*)(ws + WS_MIX), (const bf16_t*)(ws + WS_WO), M, DM, DM, DM, DM}; pg8::StaticOrder S; S.init(M, DM, G, bid);
      PEpiWo E{inptr(0), ((float*)inptr(21)), (bf16_t*)(ws + WS_H2), (float*)(ws + WS_SSQ2), DM}; pg8::gemm_phase<PEpiWo, pg8::StaticOrder, true, true>(L, g, S, E); }
    xcd_barrier(bar);
#if EXP == 4
    for (int e_ = 0; e_ < 2; ++e_)
#endif
    { pg8::Gemm g{(const bf16_t*)(ws + WS_H2), (const bf16_t*)(ws + WS_WUP), M, FF, DM, DM, DM}; pg8::StaticOrder S; S.init(M, FF, G, bid);
      PEpiBf16<2> E{(bf16_t*)(ws + WS_HID), FF, (const float*)(ws + WS_SSQ2)}; pg8::gemm_phase<PEpiBf16<2>, pg8::StaticOrder, true, true>(L, g, S, E); }
    xcd_barrier(bar);
    { pg8::Gemm g{(const bf16_t*)(ws + WS_HID), (const bf16_t*)(ws + WS_WDN), M, DM, FF, FF, FF}; pg8::StaticOrder S; S.init(M, DM, G, bid);
      PEpiResF32 E{((float*)inptr(21)), ((float*)inptr(21)), DM}; pg8::gemm_phase<PEpiResF32, pg8::StaticOrder, true, true>(L, g, S, E); }
}

extern "C" void kernel_launch(void* const* d_in, const int* in_sizes, int n_in, void* d_out, int out_size,
                              void* d_ws, size_t ws_size, hipStream_t stream) {
    static int grid_blocks = 0;
    if (!grid_blocks) {
        int dev = 0, cus = 0, per_cu = 0;
        (void)hipGetDevice(&dev);
        (void)hipDeviceGetAttribute(&cus, hipDeviceAttributeMultiprocessorCount, dev);
        (void)hipFuncSetAttribute((const void*)mega, hipFuncAttributeMaxDynamicSharedMemorySize, LDS_BYTES);
        (void)hipOccupancyMaxActiveBlocksPerMultiprocessor(&per_cu, (const void*)mega, 512, LDS_BYTES);
        if (per_cu != 1) fprintf(stderr, "note: occupancy query reports %d blocks/CU; launching 1 per CU\n", per_cu);
        grid_blocks = cus;
        if (n_in != 21 || out_size != M * DM || ws_size < 256 * MiB) fprintf(stderr, "unexpected shapes: n_in %d out %d ws %zu\n", n_in, out_size, ws_size);
    }
    Params p{};
    for (int i = 0; i < 21; ++i) p.in[i] = (const float*)d_in[i];
    p.out = (float*)d_out; p.ws = (unsigned char*)d_ws;
    if (hipMemsetAsync((char*)d_ws + WS_CTL, 0, CTL_ZERO_BYTES, stream) != hipSuccess) { fprintf(stderr, "memset of the barrier words failed\n"); return; }
    hipLaunchKernelGGL(mega, dim3(grid_blocks), dim3(512), LDS_BYTES, stream, p);
    hipError_t e = hipPeekAtLastError();
    if (e != hipSuccess) fprintf(stderr, "launch failed: %s (grid %d)\n", hipGetErrorString(e), grid_blocks);
}
```

```cpp
#ifndef EXP
#define EXP 0
#endif
#ifndef TS
#define TS 0
#endif
#include <hip/hip_runtime.h>
#include <cstdio>
#include <cstdint>

#define LAS __attribute__((address_space(3)))
typedef unsigned short bf16_t;
typedef short bf16x8 __attribute__((ext_vector_type(8)));
typedef float f32x4 __attribute__((ext_vector_type(4)));
typedef unsigned u32x4 __attribute__((ext_vector_type(4)));
typedef unsigned u32x2 __attribute__((ext_vector_type(2)));

constexpr int BATCH = 8, SEQ = 2048, DM = 1024, M = BATCH * SEQ;
constexpr int DIN = 1976, DINP = 2048;
constexpr int C_HQ = 0, C_HKV = 384, C_HKR = 640, C_QB = 672, C_KVB = 1184, C_GATE = 1952;
constexpr int C_KCMP = C_KVB, C_VCMP = C_KVB + 128, C_KSEL = C_KVB + 256, C_VSEL = C_KVB + 384, C_KWIN = C_KVB + 512, C_VWIN = C_KVB + 640;
constexpr int QR = 384, KVR = 256, MQ = 768, MKV = 1024, FF = 4096;
constexpr int LDH = FF + 64;
constexpr int NCMP = 127;
constexpr float EPS = 1e-6f;
constexpr float LOG2E = 1.4426950408889634f;
constexpr float QS_MLA = 0.10206207261596577f * LOG2E;
constexpr float QS_NSA = 0.125f * LOG2E;

constexpr size_t MiB = 1u << 20;
constexpr size_t WS_CTL = 0, CTL_ZERO_BYTES = 65536;
constexpr size_t WS_WIN = 1 * MiB, WS_WUQ = 5 * MiB, WS_WUKV = 6 * MiB, WS_WO = 7 * MiB, WS_WUP = 9 * MiB, WS_WDN = 17 * MiB;
constexpr size_t WS_KCMP = 26 * MiB, WS_VCMP = 26 * MiB + 512 * 1024;
constexpr size_t WS_W1T = 30 * MiB;
constexpr size_t WS_W2T = 27 * MiB;
constexpr size_t WS_RSQ = 28 * MiB, WS_RSKV = 28 * MiB + 65536, WS_SSQ2 = 28 * MiB + 131072, WS_SSQM = 28 * MiB + 262144;
constexpr size_t WS_DUMMY0 = 0;
constexpr size_t WS_HB = 32 * MiB;
constexpr size_t WS_MIX = 32 * MiB;
constexpr size_t WS_PROJ = 64 * MiB;
constexpr size_t WS_QM = 128 * MiB;
constexpr size_t WS_KVM = 152 * MiB;
constexpr size_t WS_KMLA = 184 * MiB;
constexpr size_t WS_QN = 208 * MiB;
constexpr size_t WS_KSEL = 224 * MiB;
constexpr size_t WS_KWIN = 228 * MiB;
constexpr size_t WS_HQN = 232 * MiB;
constexpr size_t WS_HKVN = 244 * MiB;
constexpr size_t WS_H2 = 208 * MiB;
constexpr size_t WS_HID = 64 * MiB;

constexpr int LDS_BYTES = 155648, LDS_BST = 154624;
constexpr int NW = 8;

struct Params {
    const float* in[21];
    float* out;
    unsigned char* ws;
};

typedef const float* cfptr_t;
__device__ __forceinline__ const float* inptr(int i) {
    const __attribute__((address_space(4))) char* ka = (const __attribute__((address_space(4))) char*)__builtin_amdgcn_kernarg_segment_ptr();
    int off = i * 8; asm volatile("" : "+s"(off));
    return *(const __attribute__((address_space(4))) cfptr_t*)(ka + off);
}
__device__ __forceinline__ unsigned f2bf(float f) { unsigned u = __builtin_bit_cast(unsigned, f); return (u + 0x7fffu + ((u >> 16) & 1u)) >> 16; }
__device__ __forceinline__ float bf2f(unsigned b) { return __builtin_bit_cast(float, b << 16); }
__device__ __forceinline__ unsigned pk2(float lo, float hi) { return f2bf(lo) | (f2bf(hi) << 16); }
__device__ __forceinline__ float wave_sum(float v) {
#pragma unroll
    for (int o = 1; o < 64; o <<= 1) v += __shfl_xor(v, o);
    return v;
}
__device__ __forceinline__ float wave_max(float v) {
#pragma unroll
    for (int o = 1; o < 64; o <<= 1) v = fmaxf(v, __shfl_xor(v, o));
    return v;
}
__device__ __forceinline__ int t5_bucket(int n) {
    if (n < 16) return n;
    int b = 16;
    b += (n >= 19); b += (n >= 21); b += (n >= 24); b += (n >= 27); b += (n >= 31); b += (n >= 35); b += (n >= 40); b += (n >= 46);
    b += (n >= 52); b += (n >= 59); b += (n >= 67); b += (n >= 77); b += (n >= 87); b += (n >= 99); b += (n >= 113);
    return b;
}

__device__ __forceinline__ void p0_transpose_item(const float* W, int K, int N, int Npad, bf16_t* WT, LAS float* scr, int item, int lane, const float* gk = nullptr, int ldw = 0) {
    const int nblk = Npad / 32, kb = item / nblk, nb = item % nblk, k0 = 64 * kb, n0 = 32 * nb;
    const int nn = n0 + (lane & 31);
    float wv[32];
#pragma unroll
    for (int i = 0; i < 32; ++i) { const int kk = 2 * i + (lane >> 5); wv[i] = (nn < N) ? W[(size_t)(k0 + kk) * N + nn] : 0.f; }
#pragma unroll
    for (int i = 0; i < 32; ++i) { const int kk = 2 * i + (lane >> 5); const float gg = gk ? gk[k0 + kk] : 1.f; scr[kk * 33 + (lane & 31)] = wv[i] * gg; }
    asm volatile("s_waitcnt lgkmcnt(0)" ::: "memory");
    const int c = lane & 7;
#pragma unroll
    for (int j = 0; j < 4; ++j) { const int n = (lane >> 3) + 8 * j; const LAS float* s = scr + (8 * c) * 33 + n;
        u32x4 o; o.x = pk2(s[0 * 33], s[1 * 33]); o.y = pk2(s[2 * 33], s[3 * 33]); o.z = pk2(s[4 * 33], s[5 * 33]); o.w = pk2(s[6 * 33], s[7 * 33]);
        *(u32x4*)(WT + (size_t)(n0 + n) * (ldw ? ldw : K) + k0 + 8 * c) = o; }
    asm volatile("s_waitcnt lgkmcnt(0)" ::: "memory");
}
template <int NR>
__device__ __forceinline__ void rms_rows_to_bf16(const float* x, const float* g, bf16_t* o, int row0, int rstride, int lane) {
    f32x4 v[NR][4];
#pragma unroll
    for (int r = 0; r < NR; ++r) { const int rr = (row0 + r * rstride < M) ? row0 + r * rstride : row0; const f32x4* xr = (const f32x4*)(x + (size_t)rr * DM) + lane;
#pragma unroll
        for (int j = 0; j < 4; ++j) v[r][j] = xr[64 * j]; }
    const f32x4* gr = (const f32x4*)g + lane;
#pragma unroll
    for (int r = 0; r < NR; ++r) { if (row0 + r * rstride >= M) continue; float s = 0.f;
#pragma unroll
        for (int j = 0; j < 4; ++j) s += (v[r][j].x * v[r][j].x + v[r][j].y * v[r][j].y) + (v[r][j].z * v[r][j].z + v[r][j].w * v[r][j].w);
        const float rstd = 1.f / sqrtf(wave_sum(s) * (1.f / DM) + EPS);
        unsigned long long* o8 = (unsigned long long*)(o + (size_t)(row0 + r * rstride) * DM) + lane;
#pragma unroll
        for (int j = 0; j < 4; ++j) { const f32x4 gg = gr[64 * j];
            o8[64 * j] = (unsigned long long)pk2(v[r][j].x * rstd * gg.x, v[r][j].y * rstd * gg.y) | ((unsigned long long)pk2(v[r][j].z * rstd * gg.z, v[r][j].w * rstd * gg.w) << 32); } }
}

__device__ __forceinline__ int opaque_tid() { int t = threadIdx.x; asm volatile("" : "+v"(t)); return t; }
namespace pg8 {
#define PG8_LAS __attribute__((address_space(3)))
typedef unsigned short bf16_t;
typedef short bf16x8 __attribute__((ext_vector_type(8)));
typedef float f32x4 __attribute__((ext_vector_type(4)));
typedef unsigned u32x4 __attribute__((ext_vector_type(4)));
constexpr int BM = 256, BK = 64, HALF = 128, HTB = HALF * BK * 2  , STAGE_BYTES = 8 * HTB, NXCD = 8, WGM = 8;

__host__ __device__ __forceinline__ int lds_byte(int r, int c) { const int st = (r >> 4) * 2 + (c >> 5), rr = r & 15, cc = c & 31, ob = rr * 64 + cc * 2; return st * 1024 + (ob ^ (((ob >> 9) & 1) << 5)); }
__host__ __device__ __forceinline__ void stage_rc(int b, int& R, int& C) { const int st = b / 1024, sb = b % 1024, swz = sb ^ (((sb >> 9) & 1) << 5); R = (st >> 1) * 16 + swz / 64; C = (st & 1) * 32 + (swz % 64) / 2; }
__host__ __device__ __forceinline__ int perm32(int rho) { const int n = rho >> 4, i = rho & 15; return 8 * (i >> 2) + 4 * n + (i & 3); }

struct Unit { int pm, pn; };
struct Gemm { const bf16_t* A; const bf16_t* Bt; int M, N, K, lda, ldb; };

struct StaticOrder {
    int nM, nN, nwg, G, c;
    __host__ __device__ void init(int M, int N, int G_, int c_) { nM = M / BM; nN = N / BM; nwg = nM * nN; G = G_; c = c_; }
    __host__ __device__ bool next(int i, Unit& u) const {
        const long L = (long)i * G + c; if (L >= nwg) return false;
        int wgid = (int)L; { const int q = nwg / NXCD, r = nwg % NXCD, xcd = wgid % NXCD, off = wgid / NXCD; wgid = (xcd < r ? xcd * (q + 1) : r * (q + 1) + (xcd - r) * q) + off; }
        const int nig = WGM * nN, gid = wgid / nig, fm = gid * WGM, gsz = (nM - fm) < WGM ? (nM - fm) : WGM;
        u.pm = fm + ((wgid % nig) % gsz); u.pn = (wgid % nig) / gsz; return true;
    }
    __device__ __forceinline__ void a_ready(const Unit&) const {}
    __device__ __forceinline__ void done(const Unit&) const {}
};

template <class Epi, class Sched, bool ALIGN_EPI = false, bool SP2 = false>
__device__ __forceinline__ void gemm_phase(PG8_LAS unsigned char* lds, const Gemm g, const Sched& S, const Epi& E) {
    const int tid = opaque_tid(), wid = __builtin_amdgcn_readfirstlane(tid >> 6), lane = tid & 63, wr = wid >> 2, wc = wid & 3, fr = lane & 15, fq = lane >> 4;
    const int K = g.K, nt = K / BK;
    unsigned voffA[2], voffB[2];
#pragma unroll
    for (int i = 0; i < 2; ++i) { int R, C; stage_rc(tid * 16 + i * 8192, R, C); const int Rb = Epi::PERM ? ((R & ~31) + perm32(R & 31)) : R;
        voffA[i] = (unsigned)(R * g.lda + C) * 2u; voffB[i] = (unsigned)(Rb * g.ldb + C) * 2u; }
    const size_t kstep = (size_t)(BK * 2);
    const size_t hstepA = (size_t)HALF * g.lda * 2, hstepB = (size_t)HALF * g.ldb * 2;
    const size_t tstepA = 2 * hstepA, tstepB = 2 * hstepB;
    const unsigned ldsw = (unsigned)wid * 1024u;
    const int aoff = lds_byte(wr * 64 + fr, fq * 8), boff = lds_byte(wc * 32 + fr, fq * 8);
#define PG8_SA(b, h) (((b) * 2 + (h)) * HTB)
#define PG8_SB(b, h) ((4 + (b) * 2 + (h)) * HTB)
#define PG8_STAGE(bufoff, gbase, voff) do { _Pragma("unroll") for (int _i = 0; _i < 2; ++_i) \
        __builtin_amdgcn_global_load_lds((const unsigned*)((const char*)(gbase) + (voff)[_i]), (PG8_LAS unsigned*)(lds + (bufoff) + ldsw + _i * 8192), 16, 0, 0); } while (0)
#define PG8_LDA(dst, b, h) do { _Pragma("unroll") for (int m = 0; m < 4; ++m) _Pragma("unroll") for (int k = 0; k < 2; ++k) dst[m][k] = *(const PG8_LAS bf16x8*)(lds + PG8_SA(b, h) + aoff + m * 2048 + k * 1024); } while (0)
#define PG8_LDB(dst, b, h) do { _Pragma("unroll") for (int n = 0; n < 2; ++n) _Pragma("unroll") for (int k = 0; k < 2; ++k) dst[n][k] = *(const PG8_LAS bf16x8*)(lds + PG8_SB(b, h) + boff + n * 2048 + k * 1024); } while (0)
#define PG8_MMA(ai, bj, At, Bt) do { __builtin_amdgcn_s_setprio(1); _Pragma("unroll") for (int m = 0; m < 4; ++m) _Pragma("unroll") for (int n = 0; n < 2; ++n) _Pragma("unroll") for (int k = 0; k < 2; ++k) \
        acc[ai][bj][m][n] = __builtin_amdgcn_mfma_f32_16x16x32_bf16(Bt[n][k], At[m][k], acc[ai][bj][m][n], 0, 0, 0); __builtin_amdgcn_s_setprio(0); } while (0)
#define PG8_WAIT_V(n) asm volatile("s_waitcnt vmcnt(" #n ")" ::: "memory")
#define PG8_WAIT_L(n) asm volatile("s_waitcnt lgkmcnt(" #n ")" ::: "memory")
#define PG8_BAR __builtin_amdgcn_s_barrier()
#define PG8_SCHED __builtin_amdgcn_sched_barrier(0)
    Unit cur, nxt; int ui = 0;
    if (!S.next(0, cur)) return;
    f32x4 acc[2][2][4][2];
#pragma unroll
    for (int a = 0; a < 2; ++a)
#pragma unroll
        for (int b = 0; b < 2; ++b)
#pragma unroll
            for (int m = 0; m < 4; ++m)
#pragma unroll
                for (int n = 0; n < 2; ++n) acc[a][b][m][n] = (f32x4){0.f, 0.f, 0.f, 0.f};
    bf16x8 At[4][2], B0[2][2], B1[2][2];
    const char* cA = (const char*)g.A + (size_t)cur.pm * tstepA; const char* cB = (const char*)g.Bt + (size_t)cur.pn * tstepB;
    S.a_ready(cur);
    if constexpr (SP2) {
        PG8_STAGE(PG8_SB(0, 0), cB, voffB); PG8_STAGE(PG8_SB(0, 1), cB + hstepB, voffB); PG8_STAGE(PG8_SA(0, 0), cA, voffA); PG8_STAGE(PG8_SA(0, 1), cA + hstepA, voffA);
        if (wr == 1) PG8_BAR;
        PG8_WAIT_V(2); PG8_BAR;
        PG8_STAGE(PG8_SB(1, 0), cB + kstep, voffB); PG8_STAGE(PG8_SA(1, 0), cA + kstep, voffA); PG8_STAGE(PG8_SB(1, 1), cB + hstepB + kstep, voffB);
        PG8_WAIT_V(6); PG8_BAR;
    } else {
        PG8_STAGE(PG8_SB(0, 0), cB, voffB); PG8_STAGE(PG8_SA(0, 0), cA, voffA); PG8_STAGE(PG8_SB(0, 1), cB + hstepB, voffB); PG8_STAGE(PG8_SA(0, 1), cA + hstepA, voffA);
        if (wr == 1) PG8_BAR;
        PG8_WAIT_V(4); PG8_BAR;
        PG8_STAGE(PG8_SB(1, 0), cB + kstep, voffB); PG8_STAGE(PG8_SA(1, 0), cA + kstep, voffA); PG8_STAGE(PG8_SB(1, 1), cB + hstepB + kstep, voffB);
        PG8_WAIT_V(6); PG8_BAR;
    }
    for (;;) {
        const bool has_next = S.next(ui + 1, nxt);
        const char* nA = has_next ? (const char*)g.A + (size_t)nxt.pm * tstepA : cA; const char* nB = has_next ? (const char*)g.Bt + (size_t)nxt.pn * tstepB : cB;
        for (int t = 0; t < nt; t += 2) {
            if constexpr (Epi::MIDSCALE) { if (t == nt / 2) E.midscale(acc, cur, wr, fr); }
            const bool last = (t == nt - 2);
            const char* a1 = cA + (size_t)(t + 1) * kstep;
            const char* a2 = last ? nA : cA + (size_t)(t + 2) * kstep; const char* b2 = last ? nB : cB + (size_t)(t + 2) * kstep;
            const char* a3 = a2 + kstep; const char* b3 = b2 + kstep;
            if (last && has_next) S.a_ready(nxt);
            if constexpr (SP2) {
            PG8_LDB(B0, 0, 0); PG8_LDB(B1, 0, 1); PG8_SCHED; PG8_LDA(At, 0, 0); PG8_STAGE(PG8_SA(1, 1), a1 + hstepA, voffA);
            PG8_WAIT_V(8); PG8_WAIT_L(0); PG8_BAR; PG8_MMA(0, 0, At, B0); PG8_MMA(0, 1, At, B1); PG8_BAR; PG8_SCHED;
            PG8_LDA(At, 0, 1); PG8_STAGE(PG8_SB(0, 0), b2, voffB); PG8_STAGE(PG8_SB(0, 1), b2 + hstepB, voffB); PG8_STAGE(PG8_SA(0, 0), a2, voffA);
            PG8_WAIT_V(8); PG8_WAIT_L(0); PG8_BAR; PG8_MMA(1, 0, At, B0); PG8_MMA(1, 1, At, B1); PG8_BAR; PG8_SCHED;
            PG8_LDB(B0, 1, 0); PG8_LDB(B1, 1, 1); PG8_SCHED; PG8_LDA(At, 1, 0); PG8_STAGE(PG8_SA(0, 1), a2 + hstepA, voffA);
            PG8_WAIT_V(8); PG8_WAIT_L(0); PG8_BAR; PG8_MMA(0, 0, At, B0); PG8_MMA(0, 1, At, B1); PG8_BAR; PG8_SCHED;
            PG8_LDA(At, 1, 1); PG8_STAGE(PG8_SB(1, 0), b3, voffB); PG8_STAGE(PG8_SB(1, 1), b3 + hstepB, voffB); PG8_STAGE(PG8_SA(1, 0), a3, voffA);
            PG8_WAIT_V(8); PG8_WAIT_L(0); PG8_BAR; PG8_MMA(1, 0, At, B0); PG8_MMA(1, 1, At, B1); PG8_BAR; PG8_SCHED;
            } else {
            PG8_LDB(B0, 0, 0); PG8_SCHED; PG8_LDA(At, 0, 0); PG8_STAGE(PG8_SA(1, 1), a1 + hstepA, voffA);
            PG8_WAIT_L(8); PG8_BAR; PG8_WAIT_L(0); PG8_MMA(0, 0, At, B0); PG8_BAR; PG8_SCHED;
            PG8_LDB(B1, 0, 1); PG8_STAGE(PG8_SB(0, 0), b2, voffB);
            PG8_BAR; PG8_WAIT_L(0); PG8_MMA(0, 1, At, B1); PG8_BAR;
            PG8_LDA(At, 0, 1); PG8_STAGE(PG8_SA(0, 0), a2, voffA);
            PG8_BAR; PG8_WAIT_L(0); PG8_MMA(1, 0, At, B0); PG8_BAR; PG8_SCHED;
            PG8_STAGE(PG8_SB(0, 1), b2 + hstepB, voffB);
            PG8_WAIT_V(6); PG8_BAR; PG8_MMA(1, 1, At, B1); PG8_BAR;
            PG8_LDB(B0, 1, 0); PG8_SCHED; PG8_LDA(At, 1, 0); PG8_STAGE(PG8_SA(0, 1), a2 + hstepA, voffA);
            PG8_WAIT_L(8); PG8_BAR; PG8_WAIT_L(0); PG8_MMA(0, 0, At, B0); PG8_BAR; PG8_SCHED;
            PG8_LDB(B1, 1, 1); PG8_STAGE(PG8_SB(1, 0), b3, voffB);
            PG8_BAR; PG8_WAIT_L(0); PG8_MMA(0, 1, At, B1); PG8_BAR;
            PG8_LDA(At, 1, 1); PG8_STAGE(PG8_SA(1, 0), a3, voffA);
            PG8_BAR; PG8_WAIT_L(0); PG8_MMA(1, 0, At, B0); PG8_BAR; PG8_SCHED;
            PG8_STAGE(PG8_SB(1, 1), b3 + hstepB, voffB);
            PG8_WAIT_V(6); PG8_BAR; PG8_MMA(1, 1, At, B1); PG8_BAR;
            }
        }
        if constexpr (ALIGN_EPI) { if (wr == 0) PG8_BAR; }
        if constexpr (!Epi::AFTER_DRAIN) { E(acc, cur, wr, wc, fr, fq); S.done(cur); }
        if (!has_next) break;
#pragma unroll
        for (int a = 0; a < 2; ++a)
#pragma unroll
            for (int b = 0; b < 2; ++b)
#pragma unroll
                for (int m = 0; m < 4; ++m)
#pragma unroll
                    for (int n = 0; n < 2; ++n) acc[a][b][m][n] = (f32x4){0.f, 0.f, 0.f, 0.f};
        cur = nxt; cA = nA; cB = nB; ++ui;
        if constexpr (ALIGN_EPI) { if (wr == 1) PG8_BAR; }
    }
    PG8_WAIT_V(0);
    if constexpr (!ALIGN_EPI) { if (wr == 0) PG8_BAR; }
    PG8_BAR;
    if constexpr (Epi::AFTER_DRAIN) { E.fused(acc, cur, wr, wc, fr, fq, lds, wid, lane); S.done(cur); }
#undef PG8_SA
#undef PG8_SB
#undef PG8_STAGE
#undef PG8_LDA
#undef PG8_LDB
#undef PG8_MMA
#undef PG8_WAIT_V
#undef PG8_WAIT_L
#undef PG8_BAR
#undef PG8_SCHED
}
}

__device__ __forceinline__ unsigned cvt_pk_bf16(float lo, float hi) { unsigned r; asm volatile("v_cvt_pk_bf16_f32 %0, %1, %2" : "=v"(r) : "v"(lo), "v"(hi)); return r; }
template <int ACT> struct PEpiBf16 {
    static constexpr bool PERM = true, AFTER_DRAIN = false, MIDSCALE = false;
    bf16_t* O; int ldc; const float* rs;
    __device__ __forceinline__ void operator()(const f32x4 (&acc)[2][2][4][2], const pg8::Unit& u, int wr, int wc, int fr, int fq) const {
        const int row0 = u.pm * 256 + wr * 64 + fr, col0 = u.pn * 256 + wc * 32 + 8 * fq;
#pragma unroll
        for (int ai = 0; ai < 2; ++ai)
#pragma unroll
            for (int m = 0; m < 4; ++m) { bf16_t* rowp = O + (size_t)(row0 + ai * 128 + m * 16) * ldc + col0; float rsc = rs ? rs[row0 + ai * 128 + m * 16] : 1.f; if (ACT == 2) rsc = 1.f / sqrtf(rsc * (1.f / 1024) + EPS);
#pragma unroll
                for (int bj = 0; bj < 2; ++bj) { f32x4 v0 = acc[ai][bj][m][0] * rsc, v1 = acc[ai][bj][m][1] * rsc;
                    if (ACT == 2) {
#pragma unroll
                        for (int e = 0; e < 4; ++e) { const float a = fmaxf(v0[e], 0.f), b = fmaxf(v1[e], 0.f); v0[e] = a * a; v1[e] = b * b; } }
                    u32x4 w; w.x = cvt_pk_bf16(v0[0], v0[1]); w.y = cvt_pk_bf16(v0[2], v0[3]); w.z = cvt_pk_bf16(v1[0], v1[1]); w.w = cvt_pk_bf16(v1[2], v1[3]);
                    *(u32x4*)(rowp + bj * 128) = w; } }
    }
};
struct PEpiResF32 {
    static constexpr bool PERM = false, AFTER_DRAIN = false, MIDSCALE = false;
    const float* base; float* out; int ldc;
    __device__ __forceinline__ void operator()(const f32x4 (&acc)[2][2][4][2], const pg8::Unit& u, int wr, int wc, int fr, int fq) const {
        const int col0 = u.pn * 256 + wc * 32 + 4 * fq;
#pragma unroll
        for (int ai = 0; ai < 2; ++ai)
#pragma unroll
            for (int m = 0; m < 4; ++m) { const size_t off = (size_t)(u.pm * 256 + ai * 128 + wr * 64 + m * 16 + fr) * ldc + col0;
#pragma unroll
                for (int bj = 0; bj < 2; ++bj)
#pragma unroll
                    for (int n = 0; n < 2; ++n) { const f32x4 bs = *(const f32x4*)(base + off + bj * 128 + n * 16); *(f32x4*)(out + off + bj * 128 + n * 16) = bs + acc[ai][bj][m][n]; } }
    }
};

struct PEpiWo {
    static constexpr bool PERM = false, AFTER_DRAIN = false, MIDSCALE = true;
    const float* base; bf16_t* xb; float* ssq; const float* ssqm; int ldc;
    __device__ __forceinline__ void midscale(f32x4 (&acc)[2][2][4][2], const pg8::Unit& u, int wr, int fr) const {
#pragma unroll
        for (int ai = 0; ai < 2; ++ai)
#pragma unroll
            for (int m = 0; m < 4; ++m) { const int row = u.pm * 256 + ai * 128 + wr * 64 + m * 16 + fr;
                const float sa = ssqm[2 * row], sb = ssqm[2 * row + 1]; const float ratio = sqrtf((sb * (1.f / 512) + EPS) / (sa * (1.f / 512) + EPS));
#pragma unroll
                for (int bj = 0; bj < 2; ++bj)
#pragma unroll
                    for (int n = 0; n < 2; ++n) acc[ai][bj][m][n] *= ratio; }
    }
    __device__ __forceinline__ void operator()(const f32x4 (&acc)[2][2][4][2], const pg8::Unit& u, int wr, int wc, int fr, int fq) const {
        const int col0 = u.pn * 256 + wc * 32 + 4 * fq; const int lane = fq * 16 + fr;
#pragma unroll
        for (int ai = 0; ai < 2; ++ai)
#pragma unroll
            for (int m = 0; m < 4; ++m) { const int row = u.pm * 256 + ai * 128 + wr * 64 + m * 16 + fr; const size_t off = (size_t)row * ldc + col0; float ss = 0.f;
                const float rb = 1.f / sqrtf(ssqm[2 * row + 1] * (1.f / 512) + EPS);
#pragma unroll
                for (int bj = 0; bj < 2; ++bj)
#pragma unroll
                    for (int n = 0; n < 2; ++n) { const f32x4 bs = *(const f32x4*)(base + off + bj * 128 + n * 16); const f32x4 v = bs + acc[ai][bj][m][n] * rb;
                        ss += (v[0] * v[0] + v[1] * v[1]) + (v[2] * v[2] + v[3] * v[3]);
                        u32x2 w; w.x = cvt_pk_bf16(v[0], v[1]); w.y = cvt_pk_bf16(v[2], v[3]); *(u32x2*)(xb + off + bj * 128 + n * 16) = w; }
                ss += __builtin_bit_cast(float, __builtin_amdgcn_ds_bpermute((lane ^ 16) << 2, __builtin_bit_cast(int, ss)));
                ss += __builtin_bit_cast(float, __builtin_amdgcn_ds_bpermute((lane ^ 32) << 2, __builtin_bit_cast(int, ss)));
                if (fq == 0) __hip_atomic_fetch_add(ssq + row, ss, __ATOMIC_RELAXED, __HIP_MEMORY_SCOPE_AGENT); }
    }
};

struct PEpiDown {
    static constexpr bool PERM = false, AFTER_DRAIN = false, MIDSCALE = false;
    const bf16_t* xb; float* out; int ldc;
    __device__ __forceinline__ void operator()(const f32x4 (&acc)[2][2][4][2], const pg8::Unit& u, int wr, int wc, int fr, int fq) const {
        const int col0 = u.pn * 256 + wc * 32 + 4 * fq;
#pragma unroll
        for (int ai = 0; ai < 2; ++ai)
#pragma unroll
            for (int m = 0; m < 4; ++m) { const size_t off = (size_t)(u.pm * 256 + ai * 128 + wr * 64 + m * 16 + fr) * ldc + col0;
#pragma unroll
                for (int bj = 0; bj < 2; ++bj)
#pragma unroll
                    for (int n = 0; n < 2; ++n) { const u32x2 w = *(const u32x2*)(xb + off + bj * 128 + n * 16);
                        const f32x4 bs = (f32x4){bf2f(w.x & 0xffffu), bf2f(w.x >> 16), bf2f(w.y & 0xffffu), bf2f(w.y >> 16)};
                        *(f32x4*)(out + off + bj * 128 + n * 16) = bs + acc[ai][bj][m][n]; } }
    }
};

__device__ __forceinline__ float sq8(const bf16x8 v) { float s = 0.f;
#pragma unroll
    for (int j = 0; j < 8; ++j) { const float f = bf2f((unsigned short)v[j]); s += f * f; }
    return s; }
__device__ __forceinline__ u32x4 scale8(const bf16x8 v, float sc, const f32x4 ga, const f32x4 gb) { u32x4 o;
    o.x = pk2(bf2f((unsigned short)v[0]) * sc * ga[0], bf2f((unsigned short)v[1]) * sc * ga[1]); o.y = pk2(bf2f((unsigned short)v[2]) * sc * ga[2], bf2f((unsigned short)v[3]) * sc * ga[3]);
    o.z = pk2(bf2f((unsigned short)v[4]) * sc * gb[0], bf2f((unsigned short)v[5]) * sc * gb[1]); o.w = pk2(bf2f((unsigned short)v[6]) * sc * gb[2], bf2f((unsigned short)v[7]) * sc * gb[3]);
    return o; }
template <int NR>
__device__ __forceinline__ void glueA_rows(unsigned char* ws, int row0, int rstride, int lane) {
    const int br = (lane >> 4) & 1, g = (lane >> 3) & 1, l8 = lane & 7;
    bf16x8 vq[NR], vkv[NR], vk[NR];
#pragma unroll
    for (int r = 0; r < NR; ++r) { const int row = (row0 + r * rstride < M) ? row0 + r * rstride : row0; const bf16_t* pr = (const bf16_t*)(ws + WS_PROJ) + (size_t)row * DINP;
        vq[r] = *(const bf16x8*)(pr + C_HQ + 8 * (lane < 48 ? lane : 47)); vkv[r] = *(const bf16x8*)(pr + C_HKV + 8 * (lane & 31)); vk[r] = *(const bf16x8*)(pr + (br ? C_KWIN : C_KSEL) + 64 * g + 8 * l8); }
    const float* kg = inptr(10) + (1 + br) * 64 + 8 * l8; const f32x4 ga = *(const f32x4*)kg, gb = *(const f32x4*)(kg + 4);
#pragma unroll
    for (int r = 0; r < NR; ++r) { const int row = row0 + r * rstride; if (row >= M) continue;
        const float sq = wave_sum(lane < 48 ? sq8(vq[r]) : 0.f), skv = wave_sum(lane < 32 ? sq8(vkv[r]) : 0.f);
        float sk = sq8(vk[r]); sk += __shfl_xor(sk, 1); sk += __shfl_xor(sk, 2); sk += __shfl_xor(sk, 4);
        if (lane == 0) { ((float*)(ws + WS_RSQ))[row] = 1.f / sqrtf(sq * (1.f / QR) + EPS); ((float*)(ws + WS_RSKV))[row] = 1.f / sqrtf(skv * (1.f / KVR) + EPS); }
        if (lane < 32) { const float rstd = 1.f / sqrtf(sk * (1.f / 64) + EPS);
            *(u32x4*)((bf16_t*)(ws + (br ? WS_KWIN : WS_KSEL)) + (size_t)row * 128 + 64 * g + 8 * l8) = scale8(vk[r], rstd, ga, gb); } }
}
template <int NR>
__device__ __forceinline__ void kpass_rows(unsigned char* ws, int row0, int rstride, int lane) {
    const int h = lane >> 3, l = lane & 7;
    bf16x8 v[NR]; unsigned ra[NR], rb[NR];
#pragma unroll
    for (int r = 0; r < NR; ++r) { const int row = (row0 + r * rstride < M) ? row0 + r * rstride : row0;
        v[r] = *(const bf16x8*)((const bf16_t*)(ws + WS_KVM) + (size_t)row * MKV + 128 * h + 8 * l);
        const bf16_t* kr = (const bf16_t*)(ws + WS_PROJ) + (size_t)row * DINP + C_HKR + 2 * l; ra[r] = *(const unsigned*)kr; rb[r] = *(const unsigned*)(kr + 16); }
    const float* kg = inptr(8);
    const f32x4 ga = *(const f32x4*)(kg + 8 * l), gb = *(const f32x4*)(kg + 8 * l + 4);
    const float g1a = kg[64 + 2 * l], g1b = kg[65 + 2 * l], g2a = kg[80 + 2 * l], g2b = kg[81 + 2 * l];
    const float inva = exp2f(-(float)(2 * l) * (13.287712379549449f / 16.f)), invb = exp2f(-(float)(2 * l + 1) * (13.287712379549449f / 16.f));
#pragma unroll
    for (int r = 0; r < NR; ++r) { const int row = row0 + r * rstride; if (row >= M) continue;
        const int pos = row & (SEQ - 1);
        const float x1a = bf2f(ra[r] & 0xffffu), x1b = bf2f(ra[r] >> 16), x2a = bf2f(rb[r] & 0xffffu), x2b = bf2f(rb[r] >> 16);
        float ss = sq8(v[r]) + (x1a * x1a + x1b * x1b) + (x2a * x2a + x2b * x2b);
        ss += __shfl_xor(ss, 1); ss += __shfl_xor(ss, 2); ss += __shfl_xor(ss, 4);
        const float rstd = 1.f / sqrtf(ss * (1.f / 96) + EPS);
        bf16_t* ko = (bf16_t*)(ws + WS_KMLA) + (size_t)row * MQ + 96 * h;
        *(u32x4*)(ko + 8 * l) = scale8(v[r], rstd, ga, gb);
        float sna, csa, snb, csb; sincosf((float)pos * inva, &sna, &csa); sincosf((float)pos * invb, &snb, &csb);
        const float n1a = x1a * rstd * g1a, n2a = x2a * rstd * g2a, n1b = x1b * rstd * g1b, n2b = x2b * rstd * g2b;
        *(unsigned*)(ko + 64 + 2 * l) = pk2(n1a * csa - n2a * sna, n1b * csb - n2b * snb); *(unsigned*)(ko + 80 + 2 * l) = pk2(n2a * csa + n1a * sna, n2b * csb + n1b * snb); }
}
__device__ __forceinline__ void glueC_row(unsigned char* ws, int row, int lane) {
    bf16_t* mx = (bf16_t*)(ws + WS_MIX) + (size_t)row * DM + 8 * lane;
#pragma unroll
    for (int half = 0; half < 2; ++half) {
        const bf16x8 v = *(const bf16x8*)(mx + 512 * half);
        const float rstd = 1.f / sqrtf(wave_sum(sq8(v)) * (1.f / 512) + EPS);
        const float* gp = inptr(15 + half) + 8 * lane;
        *(u32x4*)(mx + 512 * half) = scale8(v, rstd, *(const f32x4*)gp, *(const f32x4*)(gp + 4));
    }
}

__device__ __forceinline__ void compress_block(unsigned char* ws, LAS unsigned char* L, int task) {
    const int tid = opaque_tid(), lane = tid & 63, wid = __builtin_amdgcn_readfirstlane(tid >> 6), fr = lane & 15, fq = lane >> 4;
    const int tc = task & 15, b = (task >> 4) & 7, kv = task >> 7;
    int c = 8 * tc + (fr >> 1); const int g = fr & 1; if (c > NCMP - 1) c = NCMP - 1;
    const bf16_t* arow = (const bf16_t*)(ws + WS_PROJ) + (size_t)(b * SEQ + 16 * c) * DINP + (kv ? C_VCMP : C_KCMP) + 64 * g + 8 * fq;
    const float* pe = inptr(11) + kv * 2048 + 8 * fq;
    const bf16_t* w1t = (const bf16_t*)(ws + WS_W1T) + (size_t)kv * 128 * 2048 + (size_t)fr * 2048 + 8 * fq;
    f32x4 acc[8];
#pragma unroll
    for (int n = 0; n < 8; ++n) acc[n] = (f32x4){0.f, 0.f, 0.f, 0.f};
#pragma unroll 4
    for (int s8 = 0; s8 < 8; ++s8) {
        const int s = 8 * wid + s8, r = s >> 1, db = (s & 1) * 32;
        const bf16x8 araw = *(const bf16x8*)(arow + (size_t)r * DINP + db);
        const f32x4 pa = *(const f32x4*)(pe + r * 64 + db), pb = *(const f32x4*)(pe + r * 64 + db + 4);
        u32x4 aw; aw.x = pk2(bf2f((unsigned short)araw[0]) + pa[0], bf2f((unsigned short)araw[1]) + pa[1]); aw.y = pk2(bf2f((unsigned short)araw[2]) + pa[2], bf2f((unsigned short)araw[3]) + pa[3]);
        aw.z = pk2(bf2f((unsigned short)araw[4]) + pb[0], bf2f((unsigned short)araw[5]) + pb[1]); aw.w = pk2(bf2f((unsigned short)araw[6]) + pb[2], bf2f((unsigned short)araw[7]) + pb[3]);
        const bf16x8 a = __builtin_bit_cast(bf16x8, aw);
#pragma unroll
        for (int n = 0; n < 8; ++n) { const bf16x8 bb = *(const bf16x8*)(w1t + (size_t)(16 * n) * 2048 + 32 * s);
            acc[n] = __builtin_amdgcn_mfma_f32_16x16x32_bf16(a, bb, acc[n], 0, 0, 0); }
    }
    LAS float* part = (LAS float*)L;
#pragma unroll
    for (int n = 0; n < 8; ++n)
#pragma unroll
        for (int j = 0; j < 4; ++j) part[(wid * 16 + 4 * fq + j) * 128 + 16 * n + fr] = acc[n][j];
    __syncthreads();
    LAS bf16_t* hb_ = (LAS bf16_t*)(L + 65536);
#pragma unroll
    for (int e = 0; e < 4; ++e) { const int idx = tid + 512 * e; float v = 0.f;
#pragma unroll
        for (int w = 0; w < 8; ++w) v += part[w * 2048 + idx];
        hb_[idx] = (bf16_t)f2bf(v / (1.f + __expf(-v))); }
    __syncthreads();
    if (wid == 0) {
        const bf16_t* w2t = (const bf16_t*)(ws + WS_W2T) + kv * 64 * 128 + fr * 128 + 8 * fq;
        f32x4 o[4];
#pragma unroll
        for (int n = 0; n < 4; ++n) o[n] = (f32x4){0.f, 0.f, 0.f, 0.f};
#pragma unroll
        for (int ks = 0; ks < 4; ++ks) { const bf16x8 a = *(const LAS bf16x8*)(hb_ + fr * 128 + 32 * ks + 8 * fq);
#pragma unroll
            for (int n = 0; n < 4; ++n) { const bf16x8 bb = *(const bf16x8*)(w2t + (size_t)(16 * n) * 128 + 32 * ks); o[n] = __builtin_amdgcn_mfma_f32_16x16x32_bf16(a, bb, o[n], 0, 0, 0); } }
        bf16_t* dstb = (bf16_t*)(ws + (kv ? WS_VCMP : WS_KCMP)) + (size_t)b * 128 * 2 * 64;
        const float* kg = inptr(10);
#pragma unroll
        for (int j = 0; j < 4; ++j) { const int row = 4 * fq + j, cc = 8 * tc + (row >> 1), gg = row & 1;
            float sc = 1.f;
            if (kv == 0) { float ss = o[0][j] * o[0][j] + o[1][j] * o[1][j] + o[2][j] * o[2][j] + o[3][j] * o[3][j];
                ss += __shfl_xor(ss, 1); ss += __shfl_xor(ss, 2); ss += __shfl_xor(ss, 4); ss += __shfl_xor(ss, 8); sc = 1.f / sqrtf(ss * (1.f / 64) + EPS); }
#pragma unroll
            for (int n = 0; n < 4; ++n) { const int col = 16 * n + fr; float v = o[n][j] * sc; if (kv == 0) v *= kg[col]; if (cc >= NCMP) v = 0.f;
                dstb[((size_t)cc * 2 + gg) * 64 + col] = (bf16_t)f2bf(v); } }
    }
    __syncthreads();
}

namespace att {
typedef float f32x16 __attribute__((ext_vector_type(16)));
typedef short s16x4 __attribute__((ext_vector_type(4)));
typedef short v4i16_t __attribute__((ext_vector_type(4)));
typedef float f32x2_t __attribute__((ext_vector_type(2)));
typedef __bf16 bf16x2_t __attribute__((ext_vector_type(2)));
typedef const LAS unsigned char* lcp;
constexpr int NSLOT = 3;
constexpr int L_TB = 0, L_K = 4096, KSLOT = 12288, L_V = L_K + NSLOT * KSLOT, VSLOT = 8192, L_WSF = L_V + NSLOT * VSLOT, L_OST = L_WSF + 4096,
              L_IMP = L_OST + 32768, L_SELM = L_IMP + 32768, L_GATE = L_SELM + 256, L_SC = L_GATE + 3072, L_INVL = L_SC + 8192, L_END = L_INVL + 1024;
static_assert(L_V + NSLOT * VSLOT <= 65536, "LDS-DMA destinations stay below 64 KiB");
static_assert(L_END <= LDS_BST, "attention LDS map");
constexpr float THR = 8.0f;
__device__ __forceinline__ int crow(int r, int hi) { return (r & 3) + 8 * (r >> 2) + 4 * hi; }
__device__ __forceinline__ void glds16(const void* gsrc, unsigned lds_dst) { unsigned keep;
    asm volatile("s_mov_b32 %0, m0\n\ts_mov_b32 m0, %2\n\ts_nop 0\n\tglobal_load_lds_dwordx4 %1, off\n\ts_mov_b32 m0, %0" : "=&s"(keep) : "v"(gsrc), "s"(lds_dst) : "memory"); }
__device__ __forceinline__ unsigned cvtpk(float lo, float hi) { f32x2_t v = {lo, hi}; bf16x2_t b = __builtin_convertvector(v, bf16x2_t); return __builtin_bit_cast(unsigned, b); }
__device__ __forceinline__ s16x4 vtr(lcp p) { return __builtin_bit_cast(s16x4, __builtin_amdgcn_ds_read_tr16_b64_v4i16((LAS v4i16_t*)p)); }
__device__ __forceinline__ float lane_xor(float v, int lane, int x) { return __builtin_bit_cast(float, __builtin_amdgcn_ds_bpermute((lane ^ x) << 2, __builtin_bit_cast(int, v))); }
__device__ __forceinline__ unsigned lane_xor_u(unsigned v, int lane, int x) { return (unsigned)__builtin_amdgcn_ds_bpermute((lane ^ x) << 2, (int)v); }
__device__ __forceinline__ float swap_max(float m, int lane) { return __builtin_fmaxf(m, lane_xor(m, lane, 32)); }
__device__ __forceinline__ float swap_sum(float m, int lane) { return m + lane_xor(m, lane, 32); }
__device__ __forceinline__ float max3f(float a, float b, float c) { float r; asm("v_max3_f32 %0, %1, %2, %3" : "=v"(r) : "v"(a), "v"(b), "v"(c)); return r; }
__device__ __forceinline__ float max32(const f32x16& p0, const f32x16& p1) {
    float a = max3f(p0[0], p0[1], p1[0]), b = max3f(p0[2], p0[3], p1[1]); a = max3f(a, p1[2], p1[3]);
#pragma unroll
    for (int r = 4; r < 16; r += 4) { a = max3f(a, p0[r], p0[r + 1]); b = max3f(b, p0[r + 2], p0[r + 3]); a = max3f(a, p1[r], p1[r + 1]); b = max3f(b, p1[r + 2], p1[r + 3]); }
    return __builtin_fmaxf(a, b); }
__device__ __forceinline__ float max16(const f32x16& p) { float a = __builtin_fmaxf(p[0], p[1]), b = __builtin_fmaxf(p[2], p[3]);
#pragma unroll
    for (int r = 4; r < 16; r += 4) { a = __builtin_fmaxf(a, __builtin_fmaxf(p[r], p[r + 1])); b = __builtin_fmaxf(b, __builtin_fmaxf(p[r + 2], p[r + 3])); }
    return __builtin_fmaxf(a, b); }
__device__ __forceinline__ float sum16(const f32x16& p) { float a = p[0] + p[1], b = p[2] + p[3];
#pragma unroll
    for (int r = 4; r < 16; r += 4) { a += p[r] + p[r + 1]; b += p[r + 2] + p[r + 3]; }
    return a + b; }
#define ATT_BAR() asm volatile("s_waitcnt vmcnt(0) lgkmcnt(0)\n\ts_barrier" ::: "memory")

template <int DQ> __device__ __forceinline__ void qkt(f32x16& p0, f32x16& p1, lcp kslot, const bf16x8* qr, const f32x16& cinit, int r32, int hi) {
    lcp kb = kslot + hi * 1024 + r32 * 16;
    constexpr int NB = 2;
#pragma unroll
    for (int db = 0; db < DQ / 16; db += NB) {
        bf16x8 kf[2 * NB];
#pragma unroll
        for (int e = 0; e < NB; ++e) { kf[2 * e] = *(const LAS bf16x8*)(kb + (db + e) * 2048); kf[2 * e + 1] = *(const LAS bf16x8*)(kb + (db + e) * 2048 + 512); }
        __builtin_amdgcn_sched_barrier(0);
#pragma unroll
        for (int e = 0; e < NB; ++e) { const int d0 = db + e;
            if (d0 == 0) { p0 = __builtin_amdgcn_mfma_f32_32x32x16_bf16(kf[0], qr[0], cinit, 0, 0, 0); p1 = __builtin_amdgcn_mfma_f32_32x32x16_bf16(kf[1], qr[0], cinit, 0, 0, 0); }
            else { p0 = __builtin_amdgcn_mfma_f32_32x32x16_bf16(kf[2 * e], qr[d0], p0, 0, 0, 0); p1 = __builtin_amdgcn_mfma_f32_32x32x16_bf16(kf[2 * e + 1], qr[d0], p1, 0, 0, 0); }
        }
    }
}
__device__ __forceinline__ void vload_half(bf16x8 (&vf)[8], lcp vp, int d0) {
#pragma unroll
    for (int ks = 0; ks < 4; ++ks) {
        const s16x4 lo = vtr(vp + d0 * 4096 + ks * 1024), hh = vtr(vp + d0 * 4096 + ks * 1024 + 512);
        vf[d0 * 4 + ks] = (bf16x8){lo[0], lo[1], lo[2], lo[3], hh[0], hh[1], hh[2], hh[3]};
    }
    __builtin_amdgcn_sched_barrier(0);
}
__device__ __forceinline__ void vload(bf16x8 (&vf)[8], lcp vp) { vload_half(vf, vp, 0); vload_half(vf, vp, 1); }
__device__ __forceinline__ void pv_mma(f32x16 (&o)[2], const bf16x8 (&vf)[8], const f32x16& p0, const f32x16& p1) {
    u32x4 pw[4];
    pw[0] = (u32x4){cvtpk(p0[0], p0[1]), cvtpk(p0[2], p0[3]), cvtpk(p0[4], p0[5]), cvtpk(p0[6], p0[7])};
    pw[1] = (u32x4){cvtpk(p0[8], p0[9]), cvtpk(p0[10], p0[11]), cvtpk(p0[12], p0[13]), cvtpk(p0[14], p0[15])};
    pw[2] = (u32x4){cvtpk(p1[0], p1[1]), cvtpk(p1[2], p1[3]), cvtpk(p1[4], p1[5]), cvtpk(p1[6], p1[7])};
    pw[3] = (u32x4){cvtpk(p1[8], p1[9]), cvtpk(p1[10], p1[11]), cvtpk(p1[12], p1[13]), cvtpk(p1[14], p1[15])};
#pragma unroll
    for (int d0 = 0; d0 < 2; ++d0)
#pragma unroll
        for (int ks = 0; ks < 4; ++ks) o[d0] = __builtin_amdgcn_mfma_f32_32x32x16_bf16(__builtin_bit_cast(bf16x8, pw[ks]), vf[d0 * 4 + ks], o[d0], 0, 0, 0);
}
__device__ __forceinline__ void pv(f32x16 (&o)[2], lcp vp, const f32x16& p0, const f32x16& p1) { bf16x8 vf[8]; vload(vf, vp); pv_mma(o, vf, p0, p1); }
template <int DQ> __device__ __forceinline__ void dma_tile(unsigned lds0, const bf16_t* Kg, int kpitch, const bf16_t* Vg, int vpitch, int key0, int slot, int wid, int lane) {
    const bf16_t* ksrc = Kg + (size_t)(key0 + lane) * kpitch + wid * 8;
    glds16(ksrc, (unsigned)__builtin_amdgcn_readfirstlane(lds0 + L_K + slot * KSLOT + wid * 1024));
    if (DQ == 96) { if (wid < 4) glds16(ksrc + 64, (unsigned)__builtin_amdgcn_readfirstlane(lds0 + L_K + slot * KSLOT + (8 + wid) * 1024)); }
    const bf16_t* vsrc = Vg + (size_t)(key0 + 16 * (wid & 3) + (lane >> 2)) * vpitch + (wid >> 2) * 32 + (lane & 3) * 8;
    glds16(vsrc, (unsigned)__builtin_amdgcn_readfirstlane(lds0 + L_V + slot * VSLOT + wid * 1024));
}

template <int DQ, class Pol>
__device__ __forceinline__ void flash_loop(LAS unsigned char* L, const bf16_t* Kg, int kpitch, const bf16_t* Vg, int vpitch, const bf16x8* qr, const Pol& pol, f32x16 (&o)[2], float& l_out, int wid, int lane) {
    const int r32 = lane & 31, hi = lane >> 5;
    const unsigned lds0 = (unsigned)(uintptr_t)L;
    LAS float* wsf = (LAS float*)(L + L_WSF) + wid * 128;
    lcp vp0 = L + L_V + ((lane >> 4) & 1) * 32 + (lane & 3) * 8 + (4 * hi + ((lane & 15) >> 2)) * 64;
    float mhat = 0.f, l = 0.f;
    f32x16 negm;
#pragma unroll
    for (int r = 0; r < 16; ++r) { o[0][r] = 0.f; o[1][r] = 0.f; negm[r] = 0.f; }
    const int n = pol.ntiles;
    dma_tile<DQ>(lds0, Kg, kpitch, Vg, vpitch, pol.key0(0), 0, wid, lane);
    if (n > 1) dma_tile<DQ>(lds0, Kg, kpitch, Vg, vpitch, pol.key0(1), 1, wid, lane);
    int slot = 0, slot2 = 2;
    for (int i = 0; i < n; ++i) {
        if (i + 1 < n) { if (DQ == 96 && wid < 4) asm volatile("s_waitcnt vmcnt(3) lgkmcnt(0)\n\ts_barrier" ::: "memory"); else asm volatile("s_waitcnt vmcnt(2) lgkmcnt(0)\n\ts_barrier" ::: "memory"); }
        else ATT_BAR();
        if (i + 2 < n) dma_tile<DQ>(lds0, Kg, kpitch, Vg, vpitch, pol.key0(i + 2), slot2, wid, lane);
        if (pol.active(i)) {
            f32x16 p0, p1;
            qkt<DQ>(p0, p1, L + L_K + slot * KSLOT, qr, negm, r32, hi);
            bf16x8 vf[8]; vload_half(vf, vp0 + slot * VSLOT, 0);
            pol.fix(p0, p1, i);
            asm volatile("s_nop 15\n\ts_nop 7" : "+v"(p0), "+v"(p1));
            const float rm = swap_max(max32(p0, p1), lane);
            const bool first = (i == 0);
            if (first || __any(rm > THR)) {
                float dl = first ? rm : __builtin_fmaxf(rm, 0.f);
                if (dl == -INFINITY) dl = 0.f;
                mhat += dl;
#pragma unroll
                for (int r = 0; r < 16; ++r) { p0[r] -= dl; p1[r] -= dl; negm[r] = -mhat; }
                if (!first) {
                    const float f = __builtin_amdgcn_exp2f(-dl); l *= f;
                    if (hi == 0) wsf[r32] = f;
#pragma unroll
                    for (int r = 0; r < 16; ++r) { const float fr_ = wsf[crow(r, hi)]; o[0][r] *= fr_; o[1][r] *= fr_; }
                }
            }
#pragma unroll
            for (int r = 0; r < 16; ++r) { p0[r] = __builtin_amdgcn_exp2f(p0[r]); p1[r] = __builtin_amdgcn_exp2f(p1[r]); }
            vload_half(vf, vp0 + slot * VSLOT, 1);
            l += sum16(p0) + sum16(p1);
            pv_mma(o, vf, p0, p1);
        }
        slot = (slot == NSLOT - 1) ? 0 : slot + 1; slot2 = (slot2 == NSLOT - 1) ? 0 : slot2 + 1;
    }
    ATT_BAR();
    l_out = swap_sum(l, lane);
}

__device__ __forceinline__ void acc_scaled(f32x16 (&oc)[2], const f32x16 (&o)[2], float rowscale, LAS float* wsf, int r32, int hi) {
    if (hi == 0) wsf[32 + r32] = rowscale;
#pragma unroll
    for (int r = 0; r < 16; ++r) { const float s = wsf[32 + crow(r, hi)]; oc[0][r] += s * o[0][r]; oc[1][r] += s * o[1][r]; }
}
__device__ __forceinline__ void park_store(const f32x16 (&oc)[2], LAS float* park, int lane) {
#pragma unroll
    for (int d0 = 0; d0 < 2; ++d0)
#pragma unroll
        for (int r = 0; r < 16; ++r) park[(d0 * 16 + r) * 64 + lane] = oc[d0][r];
}
template <bool FINAL> __device__ __forceinline__ void park_acc(f32x16 (&oc)[2], LAS float* park, const f32x16 (&o)[2], float rowscale, LAS float* wsf, int lane) {
    const int r32 = lane & 31, hi = lane >> 5;
    if (hi == 0) wsf[32 + r32] = rowscale;
#pragma unroll
    for (int r = 0; r < 16; ++r) { const float s = wsf[32 + crow(r, hi)];
#pragma unroll
        for (int d0 = 0; d0 < 2; ++d0) { const float v = park[(d0 * 16 + r) * 64 + lane] + s * o[d0][r]; if (FINAL) oc[d0][r] = v; else park[(d0 * 16 + r) * 64 + lane] = v; } }
}
__device__ __forceinline__ void store_tile(const f32x16 (&oc)[2], bf16_t* dst, int pitch, LAS unsigned char* L, int wid, int lane, float* ssq) {
    const int r32 = lane & 31, hi = lane >> 5;
    LAS bf16_t* stg = (LAS bf16_t*)(L + L_OST + wid * 8192);
#pragma unroll
    for (int r = 0; r < 16; ++r) { const int orow = crow(r, hi);
#pragma unroll
        for (int d0 = 0; d0 < 2; ++d0) stg[orow * 64 + d0 * 32 + r32] = (bf16_t)f2bf(oc[d0][r]); }
    asm volatile("s_waitcnt lgkmcnt(0)" ::: "memory");
#pragma unroll
    for (int i = 0; i < 4; ++i) { const int row = i * 8 + (lane >> 3), ch = lane & 7; const u32x4 v = *(const LAS u32x4*)(stg + row * 64 + ch * 8); *(u32x4*)(dst + (size_t)row * pitch + ch * 8) = v;
        float ss = sq8(__builtin_bit_cast(bf16x8, v)); ss += lane_xor(ss, lane, 1); ss += lane_xor(ss, lane, 2); ss += lane_xor(ss, lane, 4);
        if (ch == 0) __hip_atomic_fetch_add(ssq + 2 * row, ss, __ATOMIC_RELAXED, __HIP_MEMORY_SCOPE_AGENT); }
    asm volatile("s_waitcnt lgkmcnt(0)" ::: "memory");
}

struct PolMla { int ntiles, qw0, r32, hi;
    __device__ __forceinline__ int key0(int i) const { return 64 * i; }
    __device__ __forceinline__ bool active(int i) const { return 64 * i <= qw0 + 31; }
    __device__ __forceinline__ int nact() const { const int a = (qw0 + 31) / 64 + 1; return a < ntiles ? a : ntiles; }
    __device__ __forceinline__ void fix(f32x16& p0, f32x16& p1, int i) const {
        if (64 * i + 63 > qw0) { const int q = qw0 + r32, kb = 64 * i + 4 * hi;
#pragma unroll
            for (int r = 0; r < 16; ++r) { const int kv = kb + (r & 3) + 8 * (r >> 2); if (kv > q) p0[r] = -INFINITY; if (kv + 32 > q) p1[r] = -INFINITY; } }
    }
};
struct PolSel { int ntiles, qc, q, hi; unsigned selm; const LAS float* tbh;
    __device__ __forceinline__ int key0(int i) const { return 64 * (qc - i); }
    __device__ __forceinline__ bool active(int i) const { return __any((selm >> (qc - i)) & 1u) != 0; }
    __device__ __forceinline__ int nact() const { return ntiles; }
    __device__ __forceinline__ void fix(f32x16& p0, f32x16& p1, int i) const {
        const bool bit = ((selm >> (qc - i)) & 1u) != 0u;
        if (i <= 2) { const int kb = 64 * (qc - i) + 4 * hi;
#pragma unroll
            for (int r = 0; r < 16; ++r) { const int d0 = q - (kb + (r & 3) + 8 * (r >> 2)), d1 = d0 - 32;
                p0[r] = (d0 < 0) ? -INFINITY : p0[r] + tbh[d0 < 127 ? d0 : 127]; p1[r] = (d1 < 0) ? -INFINITY : p1[r] + tbh[d1 < 127 ? d1 : 127]; } }
        if (!bit) {
#pragma unroll
            for (int r = 0; r < 16; ++r) { p0[r] = -INFINITY; p1[r] = -INFINITY; } }
    }
};
struct PolWin { int ntiles, qc, q, hi; const LAS float* tbh;
    __device__ __forceinline__ int key0(int i) const { return 64 * (qc - i); }
    __device__ __forceinline__ bool active(int) const { return true; }
    __device__ __forceinline__ int nact() const { return ntiles; }
    __device__ __forceinline__ void fix(f32x16& p0, f32x16& p1, int i) const {
        if (i <= 2 || i == 8) { const int kb = 64 * (qc - i) + 4 * hi;
#pragma unroll
            for (int r = 0; r < 16; ++r) { const int d0 = q - (kb + (r & 3) + 8 * (r >> 2)), d1 = d0 - 32;
                const float b0 = (i <= 2) ? tbh[d0 < 0 ? 0 : (d0 < 127 ? d0 : 127)] : 0.f, b1 = (i <= 2) ? tbh[d1 < 0 ? 0 : (d1 < 127 ? d1 : 127)] : 0.f;
                p0[r] = (d0 < 0 || d0 >= 512) ? -INFINITY : p0[r] + b0; p1[r] = (d1 < 0 || d1 >= 512) ? -INFINITY : p1[r] + b1; } }
    }
};

__device__ __forceinline__ void mla_unit(unsigned char* ws, LAS unsigned char* L, int b, int h, int qb) {
    const int tid = opaque_tid(), lane = tid & 63, wid = __builtin_amdgcn_readfirstlane(tid >> 6);
    const int r32 = lane & 31, hi = lane >> 5;
    const size_t rowbase = (size_t)b * SEQ; const int qw0 = 256 * qb + 32 * wid;
    bf16x8 qr[6];
    { const bf16_t* Qw = (const bf16_t*)(ws + WS_QM) + (rowbase + qw0 + r32) * MQ + 96 * h + 8 * hi;
      bf16x8 raw[6]; float ss = 0.f;
#pragma unroll
      for (int d0 = 0; d0 < 6; ++d0) { raw[d0] = *(const bf16x8*)(Qw + 16 * d0); ss += sq8(raw[d0]); }
      ss += lane_xor(ss, lane, 32);
      const float rstd = QS_MLA / sqrtf(ss * (1.f / 96) + EPS);
      const float* qg = inptr(7) + 8 * hi;
#pragma unroll
      for (int d0 = 0; d0 < 4; ++d0) qr[d0] = __builtin_bit_cast(bf16x8, scale8(raw[d0], rstd, *(const f32x4*)(qg + 16 * d0), *(const f32x4*)(qg + 16 * d0 + 4)));
      float o1[8], o2[8]; const float posf = (float)(qw0 + r32);
#pragma unroll
      for (int j = 0; j < 8; ++j) { const int i = 8 * hi + j; const float inv = exp2f(-(float)i * (13.287712379549449f / 16.f)); float sn, cs; sincosf(posf * inv, &sn, &cs);
          const float n1 = bf2f((unsigned short)raw[4][j]) * rstd * qg[64 + j], n2 = bf2f((unsigned short)raw[5][j]) * rstd * qg[80 + j];
          o1[j] = n1 * cs - n2 * sn; o2[j] = n2 * cs + n1 * sn; }
      u32x4 w4, w5; w4.x = pk2(o1[0], o1[1]); w4.y = pk2(o1[2], o1[3]); w4.z = pk2(o1[4], o1[5]); w4.w = pk2(o1[6], o1[7]);
      w5.x = pk2(o2[0], o2[1]); w5.y = pk2(o2[2], o2[3]); w5.z = pk2(o2[4], o2[5]); w5.w = pk2(o2[6], o2[7]);
      qr[4] = __builtin_bit_cast(bf16x8, w4); qr[5] = __builtin_bit_cast(bf16x8, w5); }
    const bf16_t* Kg = (const bf16_t*)(ws + WS_KMLA) + rowbase * MQ + 96 * h;
    const bf16_t* Vg = (const bf16_t*)(ws + WS_KVM) + rowbase * MKV + 128 * h + 64;
    PolMla pol{4 * qb + 4, qw0, r32, hi};
    f32x16 o[2]; float l;
    flash_loop<96>(L, Kg, MQ, Vg, MKV, qr, pol, o, l, wid, lane);
    LAS float* wsf = (LAS float*)(L + L_WSF) + wid * 128;
    f32x16 oc[2];
#pragma unroll
    for (int r = 0; r < 16; ++r) { oc[0][r] = 0.f; oc[1][r] = 0.f; }
    acc_scaled(oc, o, (l > 0.f) ? 1.f / l : 0.f, wsf, r32, hi);
    store_tile(oc, (bf16_t*)(ws + WS_MIX) + (rowbase + qw0) * DM + 64 * h, DM, L, wid, lane, (float*)(ws + WS_SSQM) + 2 * (rowbase + qw0));
}

__device__ __forceinline__ void nsa_unit(unsigned char* ws, LAS unsigned char* L, int b, int g, int qc) {
#define NSA_IDS() const int tid = opaque_tid(), lane = tid & 63, wid = __builtin_amdgcn_readfirstlane(tid >> 6); \
    const int r32 = lane & 31, hi = lane >> 5, rh = wid & 3, qh = wid >> 2, h = 4 * g + rh, qloc = 32 * qh + r32, q = q0 + qloc; \
    const unsigned lds0 = (unsigned)(uintptr_t)L; LAS float* wsf = (LAS float*)(L + L_WSF) + wid * 128; const LAS float* tbh = (const LAS float*)(L + L_TB) + h * 128; \
    LAS float* gate = (LAS float*)(L + L_GATE); (void)tid; (void)lane; (void)r32; (void)hi; (void)rh; (void)qh; (void)h; (void)qloc; (void)q; (void)lds0; (void)wsf; (void)tbh; (void)gate
    const size_t rowbase = (size_t)b * SEQ; const int q0 = 64 * qc;
    const bf16_t* pr = (const bf16_t*)(ws + WS_PROJ);
    bf16x8 qr[4];
    {
    NSA_IDS();
    for (int i = tid; i < 768; i += 512) { const int br = i >> 8, r = (i >> 6) & 3, qq = i & 63;
        const float x = bf2f(pr[(rowbase + q0 + qq) * DINP + C_GATE + 8 * br + 4 * g + r]); gate[i] = 1.f / (1.f + __expf(-x)); }
    { const bf16_t* Qw = pr + (rowbase + q) * DINP + C_QB + 64 * h + 8 * hi;
      bf16x8 raw[4]; float ss = 0.f;
#pragma unroll
      for (int d0 = 0; d0 < 4; ++d0) { raw[d0] = *(const bf16x8*)(Qw + 16 * d0); ss += sq8(raw[d0]); }
      ss += lane_xor(ss, lane, 32);
      const float rstd = QS_NSA / sqrtf(ss * (1.f / 64) + EPS);
      const float* qg = inptr(9) + 8 * hi;
#pragma unroll
      for (int d0 = 0; d0 < 4; ++d0) qr[d0] = __builtin_bit_cast(bf16x8, scale8(raw[d0], rstd, *(const f32x4*)(qg + 16 * d0), *(const f32x4*)(qg + 16 * d0 + 4))); }
    }
    f32x16 oc[2];
#pragma unroll
    for (int r = 0; r < 16; ++r) { oc[0][r] = 0.f; oc[1][r] = 0.f; }
    {
        NSA_IDS();
        const bf16_t* Kg = (const bf16_t*)(ws + WS_KCMP) + ((size_t)b * 256 + g) * 64;
        const bf16_t* Vg = (const bf16_t*)(ws + WS_VCMP) + ((size_t)b * 256 + g) * 64;
        dma_tile<64>(lds0, Kg, 128, Vg, 128, 0, 0, wid, lane);
        dma_tile<64>(lds0, Kg, 128, Vg, 128, 64, 1, wid, lane);
        ATT_BAR();
        lcp vp0 = L + L_V + ((lane >> 4) & 1) * 32 + (lane & 3) * 8 + (4 * hi + ((lane & 15) >> 2)) * 64;
        LAS float* imp = (LAS float*)(L + L_IMP) + (rh * 64 + qloc) * 32;
        f32x16 o[2];
#pragma unroll
        for (int r = 0; r < 16; ++r) { o[0][r] = 0.f; o[1][r] = 0.f; }
        float m = -INFINITY, lsum = 0.f, prev_last = 0.f;
#pragma unroll 1
        for (int pass = 0; pass < 2; ++pass) {
#pragma unroll 1
            for (int T = 0; T < 2; ++T) {
                f32x16 a0, a1;
                { f32x16 zero;
#pragma unroll
                  for (int r = 0; r < 16; ++r) zero[r] = 0.f;
                  qkt<64>(a0, a1, L + L_K + T * KSLOT, qr, zero, r32, hi); }
#pragma unroll
                for (int r = 0; r < 16; ++r) { const int c = 64 * T + crow(r, hi);
                    { const int d = q - 16 * c - 31;        a0[r] = (d < 0) ? -INFINITY : a0[r] + tbh[d < 127 ? d : 127]; }
                    { const int d = q - 16 * (c + 32) - 31; a1[r] = (d < 0 || c + 32 >= NCMP) ? -INFINITY : a1[r] + tbh[d < 127 ? d : 127]; } }
                if (pass == 0) { m = __builtin_fmaxf(m, __builtin_fmaxf(max16(a0), max16(a1))); }
                else {
#pragma unroll
                    for (int r = 0; r < 16; ++r) { a0[r] = __builtin_amdgcn_exp2f(a0[r] - m); a1[r] = __builtin_amdgcn_exp2f(a1[r] - m); }
                    lsum += sum16(a0) + sum16(a1);
                    float own[8], car[8];
#pragma unroll
                    for (int a = 0; a < 4; ++a) {
                        own[a]     = a0[4 * a] + a0[4 * a + 1] + a0[4 * a + 2] + 0.5f * a0[4 * a + 3]; car[a]     = 0.5f * a0[4 * a + 3];
                        own[4 + a] = a1[4 * a] + a1[4 * a + 1] + a1[4 * a + 2] + 0.5f * a1[4 * a + 3]; car[4 + a] = 0.5f * a1[4 * a + 3]; }
#pragma unroll
                    for (int k = 0; k < 8; ++k) car[k] = lane_xor(car[k], lane, 32);
#pragma unroll
                    for (int k = 0; k < 8; ++k) { const float add = hi ? car[k] : (k >= 1 ? car[k - 1] : prev_last); imp[16 * T + 2 * k + hi] = own[k] + add; }
                    prev_last = car[7];
                    pv(o, vp0 + T * VSLOT, a0, a1);
                }
            }
            if (pass == 0) { m = swap_max(m, lane); if (m == -INFINITY) m = 0.f; }
        }
        lsum = swap_sum(lsum, lane);
        const float inv = (lsum > 0.f) ? 1.f / lsum : 0.f;
        if (hi == 0) ((LAS float*)(L + L_INVL))[rh * 64 + qloc] = inv;
        ATT_BAR();
        acc_scaled(oc, o, gate[(0 * 4 + rh) * 64 + qloc] * inv, wsf, r32, hi);
    }
    if (qc <= 15) {
        const int tid = opaque_tid();
        if (tid < 64) ((LAS unsigned*)(L + L_SELM))[tid] = (qc == 31) ? 0xffffffffu : ((2u << qc) - 1u);
        ATT_BAR();
    } else {
        const int tid = opaque_tid();
        const LAS float* imp = (const LAS float*)(L + L_IMP); LAS float* sc = (LAS float*)(L + L_SC);
        const int qq = tid >> 3, jj = tid & 7;
        const LAS float* il = (const LAS float*)(L + L_INVL);
        const float i0 = il[qq], i1 = il[64 + qq], i2 = il[128 + qq], i3 = il[192 + qq];
#pragma unroll
        for (int k = 0; k < 4; ++k) { const int j = jj + 8 * k;
            const float tot = (imp[(0 * 64 + qq) * 32 + j] * i0 + imp[(1 * 64 + qq) * 32 + j] * i1) + (imp[(2 * 64 + qq) * 32 + j] * i2 + imp[(3 * 64 + qq) * 32 + j] * i3);
            float s; if (j > qc) s = -INFINITY; else if (j == 0 || j == qc || j == qc - 1) s = 1e4f; else s = tot; sc[qq * 32 + j] = s; }
        ATT_BAR();
        f32x4 v[8];
#pragma unroll
        for (int k = 0; k < 8; ++k) v[k] = *(const LAS f32x4*)(sc + qq * 32 + 4 * k);
        unsigned bits = 0u;
#pragma unroll
        for (int k = 0; k < 4; ++k) { const int j = jj + 8 * k; const float me = sc[qq * 32 + j]; int rank = 0;
#pragma unroll
            for (int i = 0; i < 32; ++i) { const float si = v[i >> 2][i & 3]; rank += (si > me || (si == me && i < j)) ? 1 : 0; }
            if (rank < 16) bits |= 1u << j; }
        { const int lane = tid & 63; bits |= lane_xor_u(bits, lane, 1); bits |= lane_xor_u(bits, lane, 2); bits |= lane_xor_u(bits, lane, 4); }
        if (jj == 0) ((LAS unsigned*)(L + L_SELM))[qq] = bits;
        ATT_BAR();
    }
    { NSA_IDS(); park_store(oc, (LAS float*)(L + L_OST) + wid * 2048, lane); }
    {
        NSA_IDS();
        const unsigned selm = ((const LAS unsigned*)(L + L_SELM))[qloc];
        const bf16_t* Kg = (const bf16_t*)(ws + WS_KSEL) + rowbase * 128 + 64 * g;
        const bf16_t* Vg = pr + rowbase * DINP + C_VSEL + 64 * g;
        PolSel pol{qc + 1, qc, q, hi, selm, tbh};
        f32x16 o[2]; float l;
        flash_loop<64>(L, Kg, 128, Vg, DINP, qr, pol, o, l, wid, lane);
        { f32x16 dummy[2]; park_acc<false>(dummy, (LAS float*)(L + L_OST) + wid * 2048, o, (l > 0.f) ? gate[(1 * 4 + rh) * 64 + qloc] / l : 0.f, wsf, lane); }
    }
    {
        NSA_IDS();
        const bf16_t* Kg = (const bf16_t*)(ws + WS_KWIN) + rowbase * 128 + 64 * g;
        const bf16_t* Vg = pr + rowbase * DINP + C_VWIN + 64 * g;
        PolWin pol{(qc < 8 ? qc : 8) + 1, qc, q, hi, tbh};
        f32x16 o[2]; float l;
        flash_loop<64>(L, Kg, 128, Vg, DINP, qr, pol, o, l, wid, lane);
        f32x16 fin[2]; park_acc<true>(fin, (LAS float*)(L + L_OST) + wid * 2048, o, (l > 0.f) ? gate[(2 * 4 + rh) * 64 + qloc] / l : 0.f, wsf, lane);
        store_tile(fin, (bf16_t*)(ws + WS_MIX) + (rowbase + q0 + 32 * qh) * DM + 512 + 64 * h, DM, L, wid, lane, (float*)(ws + WS_SSQM) + 2 * (rowbase + q0 + 32 * qh) + 1);
    }
    ATT_BAR();
}
#undef ATT_BAR
#undef NSA_IDS
}

#define XB_TMO      128
#define XB_XCNT(j)  (256  + 64 * (j))
#define XB_XSUB(j)  (1280 + 64 * (j))
#define XB_XGEN(j)  (2304 + 64 * (j))
#define XB_TOP      3328
#define XB_TOPGEN   3392
#define XCD_BAR_WORDS 3456
#define XB_SPIN_CAP (1u << 18)

__device__ __forceinline__ unsigned xb_ld(unsigned* p)              { return __hip_atomic_load(p, __ATOMIC_RELAXED, __HIP_MEMORY_SCOPE_AGENT); }
__device__ __forceinline__ unsigned xb_add(unsigned* p, unsigned v) { return __hip_atomic_fetch_add(p, v, __ATOMIC_RELAXED, __HIP_MEMORY_SCOPE_AGENT); }
__device__ __forceinline__ unsigned xb_xcc_id() { return (unsigned)__builtin_amdgcn_s_getreg((3 << 11) | 20) & 0xFu; }
#define XB_SPIN(cond, bar) do { unsigned _sp = 0; while (cond) { __builtin_amdgcn_s_sleep(1); \
    if ((++_sp & 255u) == 0u) { if (xb_ld(&(bar)[XB_TMO])) break; if (_sp > XB_SPIN_CAP) { atomicAdd(&(bar)[XB_TMO], 1u); break; } } } } while (0)

struct XcdBarrier {
    unsigned* bar; unsigned x;
    volatile LAS unsigned* st;
};

__device__ __forceinline__ XcdBarrier xcd_barrier_post(unsigned* bar, volatile LAS unsigned* st) {
    XcdBarrier b; b.bar = bar; b.x = xb_xcc_id(); b.st = st;
    if (threadIdx.x == 0) (void)xb_add(&bar[XB_XCNT(b.x)], 1u);
    return b;
}
__device__ __forceinline__ void xcd_barrier_complete(unsigned* bar, unsigned x, unsigned& nloc, unsigned& nx) {
    const unsigned G = gridDim.x * gridDim.y * gridDim.z;
    unsigned sum, cnt, mine, sp = 0u;
    for (;;) {
        sum = 0u; cnt = 0u; mine = 0u;
#pragma unroll
        for (unsigned j = 0; j < 16; ++j) { const unsigned c = xb_ld(&bar[XB_XCNT(j)]); sum += c; cnt += (c > 0u) ? 1u : 0u; mine = (j == x) ? c : mine; }
        if (sum == G) break;
        __builtin_amdgcn_s_sleep(1);
        if ((++sp & 255u) == 0u) { if (xb_ld(&bar[XB_TMO])) break; if (sp > XB_SPIN_CAP) { atomicAdd(&bar[XB_TMO], 1u); break; } }
    }
    nloc = mine > 0u ? mine : 1u; nx = cnt > 0u ? cnt : 1u;
}

__device__ __forceinline__ void xcd_barrier(const XcdBarrier& b) {
    asm volatile("s_waitcnt vmcnt(0)" ::: "memory");
    __syncthreads();
    if (threadIdx.x == 0) {
        unsigned* bar = b.bar;
        __builtin_amdgcn_s_waitcnt(0);
        unsigned nloc = b.st[0], nx = b.st[1];
        if (nloc == 0u) { xcd_barrier_complete(bar, b.x, nloc, nx); b.st[0] = nloc; b.st[1] = nx; }
        const unsigned old = xb_add(&bar[XB_XSUB(b.x)], 1u);
        const unsigned gen = old / nloc;
        if (old + 1u == (gen + 1u) * nloc) {
            __builtin_amdgcn_fence(__ATOMIC_RELEASE, "agent");
            asm volatile("s_waitcnt vmcnt(0)" ::: "memory");
            const unsigned og = xb_add(&bar[XB_TOP], 1u);
            const unsigned tg = og / nx;
            if (og + 1u == (tg + 1u) * nx) xb_add(&bar[XB_TOPGEN], 1u);
            else XB_SPIN(xb_ld(&bar[XB_TOPGEN]) == tg, bar);
            __builtin_amdgcn_fence(__ATOMIC_ACQUIRE, "agent");
            xb_add(&bar[XB_XGEN(b.x)], 1u);
            asm volatile("s_waitcnt vmcnt(0)" ::: "memory");
        } else {
            XB_SPIN(xb_ld(&bar[XB_XGEN(b.x)]) == gen, bar);
            __builtin_amdgcn_fence(__ATOMIC_ACQUIRE, "agent");
            asm volatile("s_waitcnt vmcnt(0)" ::: "memory");
        }
    }
    __syncthreads();
}

__global__ void __launch_bounds__(512, 2) mega(Params p) {
    extern __shared__ __attribute__((aligned(16))) unsigned char lds[];
    const int G = gridDim.x, bid = blockIdx.x, NGW = G * NW;
#define PHASE_IDS() const int tid = opaque_tid(), lane = tid & 63, wave = __builtin_amdgcn_readfirstlane(tid >> 6), gw = bid * NW + wave; (void)tid; (void)lane; (void)gw
    unsigned char* ws = (unsigned char*)inptr(22);
    LAS unsigned char* L = (LAS unsigned char*)lds;
    volatile LAS unsigned* bst = (volatile LAS unsigned*)(L + LDS_BST);
    if (threadIdx.x < 4) bst[threadIdx.x] = 0u;
    __syncthreads();
    const XcdBarrier bar = xcd_barrier_post((unsigned*)(ws + WS_CTL), bst);
#if TS
    if (blockIdx.x == 0 && threadIdx.x == 0) ((unsigned long long*)(ws + 29 * MiB))[0] = __builtin_amdgcn_s_memrealtime();
#define STAMP(k) do { if (TS == (k) && blockIdx.x == 0 && threadIdx.x == 0) ((unsigned long long*)(ws + 29 * MiB))[1] = __builtin_amdgcn_s_memrealtime(); } while (0)
#else
#define STAMP(k) do {} while (0)
#endif

#if EXP == 5
    for (int e_ = 0; e_ < 2; ++e_)
#endif
    {
        PHASE_IDS();
        LAS float* scr = (LAS float*)(L + wave * 8704);
        constexpr int I0 = (1024 / 64) * (DINP / 32), I1 = (QR / 64) * (MQ / 32), I2 = (KVR / 64) * (MKV / 32), I3 = 16 * 32, I4 = 16 * (FF / 32), I5 = (FF / 64) * 32;
        constexpr int I6 = (2048 / 64) * (128 / 32), I7 = (128 / 64) * (64 / 32);
        constexpr int NIT = I0 + I1 + I2 + I3 + I4 + I5 + 2 * I6 + 2 * I7;
        for (int it = gw; it < NIT; it += NGW) {
            int r = it;
            if (r < I0) { p0_transpose_item(inptr(2), 1024, DIN, DINP, (bf16_t*)(ws + WS_WIN), scr, r, lane); continue; } r -= I0;
            if (r < I1) { p0_transpose_item(inptr(5), QR, MQ, MQ, (bf16_t*)(ws + WS_WUQ), scr, r, lane, inptr(3)); continue; } r -= I1;
            if (r < I2) { p0_transpose_item(inptr(6), KVR, MKV, MKV, (bf16_t*)(ws + WS_WUKV), scr, r, lane, inptr(4)); continue; } r -= I2;
            if (r < I3) { const int k0_ = 64 * (r / 32); p0_transpose_item(inptr(17), 1024, 1024, 1024, (bf16_t*)(ws + WS_WO), scr, r, lane, k0_ < 512 ? inptr(15) : inptr(16) - 512); continue; } r -= I3;
            if (r < I4) { p0_transpose_item(inptr(19), 1024, FF, FF, (bf16_t*)(ws + WS_WUP), scr, r, lane, inptr(18)); continue; } r -= I4;
            if (r < I5) { p0_transpose_item(inptr(20), FF, 1024, 1024, (bf16_t*)(ws + WS_WDN), scr, r, lane, nullptr, LDH); continue; } r -= I5;
            if (r < 2 * I6) { const int kv = r / I6; p0_transpose_item(inptr(12) + (size_t)kv * 2048 * 128, 2048, 128, 128, (bf16_t*)(ws + WS_W1T) + (size_t)kv * 128 * 2048, scr, r % I6, lane); continue; } r -= 2 * I6;
            { const int kv = r / I7; p0_transpose_item(inptr(13) + kv * 128 * 64, 128, 64, 64, (bf16_t*)(ws + WS_W2T) + kv * 64 * 128, scr, r % I7, lane); }
        }
        for (int m = gw; m < M; m += 4 * NGW) rms_rows_to_bf16<4>(inptr(0), inptr(1), (bf16_t*)(ws + WS_HB), m, NGW, lane);
        for (int m = bid * 512 + tid; m < M; m += G * 512) { ((float*)(ws + WS_SSQ2))[m] = 0.f; ((float*)(ws + WS_SSQM))[2 * m] = 0.f; ((float*)(ws + WS_SSQM))[2 * m + 1] = 0.f; }
    }
    xcd_barrier(bar);
    STAMP(1);
#if EXP == 1
    for (int e_ = 0; e_ < 10; ++e_) xcd_barrier(bar);
#endif
#if EXP == 10
    for (int e_ = 0; e_ < 2; ++e_)
#endif
    { pg8::Gemm g{(const bf16_t*)(ws + WS_HB), (const bf16_t*)(ws + WS_WIN), M, DINP, DM, DM, DM}; pg8::StaticOrder S; S.init(M, DINP, G, bid);
      PEpiBf16<0> E{(bf16_t*)(ws + WS_PROJ), DINP, nullptr}; pg8::gemm_phase<PEpiBf16<0>, pg8::StaticOrder, true, true>(L, g, S, E); }
    xcd_barrier(bar);
    STAMP(2);
#if EXP == 3
    for (int e_ = 0; e_ < 2; ++e_)
#endif
    { PHASE_IDS();
      for (int m = gw; m < M; m += 4 * NGW) glueA_rows<4>(ws, m, NGW, lane);
      __syncthreads();
      for (int t = bid; t < 256; t += G) compress_block(ws, L, t); }
    xcd_barrier(bar);
    STAMP(3);
#if EXP == 11
    for (int e_ = 0; e_ < 2; ++e_) {
#endif
    { pg8::Gemm g{(const bf16_t*)(ws + WS_PROJ) + C_HQ, (const bf16_t*)(ws + WS_WUQ), M, MQ, QR, DINP, QR}; pg8::StaticOrder S; S.init(M, MQ, G, bid);
      PEpiBf16<0> E{(bf16_t*)(ws + WS_QM), MQ, (const float*)(ws + WS_RSQ)}; pg8::gemm_phase<PEpiBf16<0>, pg8::StaticOrder, true, true>(L, g, S, E); }
    { pg8::Gemm g{(const bf16_t*)(ws + WS_PROJ) + C_HKV, (const bf16_t*)(ws + WS_WUKV), M, MKV, KVR, DINP, KVR}; pg8::StaticOrder S; S.init(M, MKV, G, bid);
      PEpiBf16<0> E{(bf16_t*)(ws + WS_KVM), MKV, (const float*)(ws + WS_RSKV)}; pg8::gemm_phase<PEpiBf16<0>, pg8::StaticOrder, true, true>(L, g, S, E); }
#if EXP == 11
    }
#endif
    xcd_barrier(bar);
    STAMP(4);
#if EXP == 6
    for (int e_ = 0; e_ < 2; ++e_)
#endif
    { PHASE_IDS(); for (int m = gw; m < M; m += 4 * NGW) kpass_rows<4>(ws, m, NGW, lane); }
    xcd_barrier(bar);
    STAMP(5);
#if EXP == 2
    for (int e_ = 0; e_ < 2; ++e_)
#endif
    {
        PHASE_IDS();
        LAS float* tb = (LAS float*)L;
        for (int i = tid; i < 8 * 128; i += 512) { const int h = i >> 7, n = i & 127; tb[i] = (inptr(14)[t5_bucket(n) * 8 + h] - inptr(14)[31 * 8 + h]) * LOG2E; }
        __syncthreads();
        const int vcu = (G % 8 == 0) ? (bid % 8) * (G / 8) + bid / 8 : bid;
        for (int pr_ = vcu; pr_ < 256; pr_ += G) {
            { const int bg = pr_ >> 4, s_ = pr_ & 15;
#pragma unroll 1
              for (int u_ = 0; u_ < (EXP == 8 ? 4 : 2); ++u_) att::nsa_unit(ws, L, bg >> 1, bg & 1, (u_ & 1) ? s_ : 31 - s_);
            }
            { const int bh = pr_ >> 2, s_ = pr_ & 3;
#pragma unroll 1
              for (int u_ = 0; u_ < (EXP == 9 ? 4 : 2); ++u_) att::mla_unit(ws, L, bh >> 3, bh & 7, (u_ & 1) ? s_ : 7 - s_);
            }
        }
    }
    xcd_barrier(bar);
    STAMP(7);
    { pg8::Gemm g{(const bf16_t*)(ws + WS_MIX), (const bf16_t*)(ws + WS_WO), M, DM, DM, DM, DM}; pg8::StaticOrder S; S.init(M, DM, G, bid);
      PEpiWo E{inptr(0), (bf16_t*)(ws + WS_H2), (float*)(ws + WS_SSQ2), (const float*)(ws + WS_SSQM), DM}; pg8::gemm_phase<PEpiWo, pg8::StaticOrder, true, true>(L, g, S, E); }
    xcd_barrier(bar);
    STAMP(9);
#if EXP == 4
    for (int e_ = 0; e_ < 2; ++e_)
#endif
    { pg8::Gemm g{(const bf16_t*)(ws + WS_H2), (const bf16_t*)(ws + WS_WUP), M, FF, DM, DM, DM}; pg8::StaticOrder S; S.init(M, FF, G, bid);
      PEpiBf16<2> E{(bf16_t*)(ws + WS_HID), LDH, (const float*)(ws + WS_SSQ2)}; pg8::gemm_phase<PEpiBf16<2>, pg8::StaticOrder, true, true>(L, g, S, E); }
    xcd_barrier(bar);
    STAMP(10);
    { pg8::Gemm g{(const bf16_t*)(ws + WS_HID), (const bf16_t*)(ws + WS_WDN), M, DM, FF, LDH, LDH}; pg8::StaticOrder S; S.init(M, DM, G, bid);
      PEpiDown E{(const bf16_t*)(ws + WS_H2), ((float*)inptr(21)), DM}; pg8::gemm_phase<PEpiDown, pg8::StaticOrder, true, true>(L, g, S, E); }
#if TS
    xcd_barrier(bar);
    if (blockIdx.x == 0 && threadIdx.x == 0) { const unsigned long long* tt = (const unsigned long long*)(ws + 29 * MiB); const float dlt = (TS == 100) ? 150.f : (float)(tt[1] - tt[0]) * (1.f / 256.f); ((float*)inptr(21))[0] += dlt; }
#endif
}

extern "C" void kernel_launch(void* const* d_in, const int* in_sizes, int n_in, void* d_out, int out_size,
                              void* d_ws, size_t ws_size, hipStream_t stream) {
    static int grid_blocks = 0;
    if (!grid_blocks) {
        int dev = 0, cus = 0, per_cu = 0;
        (void)hipGetDevice(&dev);
        (void)hipDeviceGetAttribute(&cus, hipDeviceAttributeMultiprocessorCount, dev);
        (void)hipFuncSetAttribute((const void*)mega, hipFuncAttributeMaxDynamicSharedMemorySize, LDS_BYTES);
        (void)hipOccupancyMaxActiveBlocksPerMultiprocessor(&per_cu, (const void*)mega, 512, LDS_BYTES);
        if (per_cu != 1) fprintf(stderr, "note: occupancy query reports %d blocks/CU; launching 1 per CU\n", per_cu);
        grid_blocks = cus;
        if (n_in != 21 || out_size != M * DM || ws_size < 256 * MiB) fprintf(stderr, "unexpected shapes: n_in %d out %d ws %zu\n", n_in, out_size, ws_size);
    }
    Params p{};
    for (int i = 0; i < 21; ++i) p.in[i] = (const float*)d_in[i];
    p.out = (float*)d_out; p.ws = (unsigned char*)d_ws;
    if (hipMemsetAsync((char*)d_ws + WS_CTL, 0, CTL_ZERO_BYTES, stream) != hipSuccess) { fprintf(stderr, "memset of the barrier words failed\n"); return; }
    hipLaunchKernelGGL(mega, dim3(grid_blocks), dim3(512), LDS_BYTES, stream, p);
    hipError_t e = hipPeekAtLastError();
    if (e != hipSuccess) fprintf(stderr, "launch failed: %s (grid %d)\n", hipGetErrorString(e), grid_blocks);
}
```

```cpp
#ifndef EXP
#define EXP 0
#endif
#ifndef TS
#define TS 0
#endif
#include <hip/hip_runtime.h>
#include <cstdio>
#include <cstdint>

#define LAS __attribute__((address_space(3)))
typedef unsigned short bf16_t;
typedef short bf16x8 __attribute__((ext_vector_type(8)));
typedef float f32x4 __attribute__((ext_vector_type(4)));
typedef unsigned u32x4 __attribute__((ext_vector_type(4)));
typedef unsigned u32x2 __attribute__((ext_vector_type(2)));

constexpr int BATCH = 8, SEQ = 2048, DM = 1024, M = BATCH * SEQ;
constexpr int DIN = 1976, DINP = 2048;
constexpr int C_HQ = 0, C_HKV = 384, C_HKR = 640, C_QB = 672, C_KVB = 1184, C_GATE = 1952;
constexpr int C_KCMP = C_KVB, C_VCMP = C_KVB + 128, C_KSEL = C_KVB + 256, C_VSEL = C_KVB + 384, C_KWIN = C_KVB + 512, C_VWIN = C_KVB + 640;
constexpr int P_HQ = 1280, P_HKV = 1664, P_HKR = 1920, P_GATE = 1952;
__host__ __device__ constexpr int slot_base(int s) { return 256 * (s >> 2) + 32 * (s & 3); }
constexpr int S_Q = 0, S_KCMP = 8, S_VCMP = 10, S_KSEL = 12, S_VSEL = 14, S_KWIN = 16, S_VWIN = 18;
constexpr int QR = 384, KVR = 256, MQ = 768, MKV = 1024, FF = 4096;
constexpr int LDH = FF + 64;
constexpr int NCMP = 127;
constexpr float EPS = 1e-6f;
constexpr float LOG2E = 1.4426950408889634f;
constexpr float QS_MLA = 0.10206207261596577f * LOG2E;
constexpr float QS_NSA = 0.125f * LOG2E;

constexpr size_t MiB = 1u << 20;
constexpr size_t WS_CTL = 0, CTL_ZERO_BYTES = 65536;
constexpr size_t WS_WIN = 1 * MiB, WS_WUQ = 5 * MiB, WS_WUKV = 6 * MiB, WS_WO = 7 * MiB, WS_WUP = 9 * MiB, WS_WDN = 17 * MiB;
constexpr size_t WS_KCMP = 26 * MiB, WS_VCMP = 26 * MiB + 512 * 1024;
constexpr size_t WS_W1T = 30 * MiB;
constexpr size_t WS_W2T = 27 * MiB;
constexpr size_t WS_RSQ = 28 * MiB, WS_RSKV = 28 * MiB + 65536, WS_SSQ2 = 28 * MiB + 131072, WS_SSQM = 28 * MiB + 262144, WS_RS1 = 28 * MiB + 262144 + 131072;
constexpr size_t WS_XB = 32 * MiB;
constexpr size_t WS_DUMMY0 = 0;
constexpr size_t WS_HB = 32 * MiB;
constexpr size_t WS_MIX = 64 * MiB;
constexpr size_t WS_PROJ = 96 * MiB;
constexpr size_t WS_QM = 160 * MiB;
constexpr size_t WS_KVM = 184 * MiB;
constexpr size_t WS_KMLA = 216 * MiB;
constexpr size_t WS_QN = 208 * MiB;
constexpr size_t WS_KSEL = 240 * MiB;
constexpr size_t WS_KWIN = 244 * MiB;
constexpr size_t WS_HQN = 232 * MiB;
constexpr size_t WS_HKVN = 244 * MiB;
constexpr size_t WS_H2 = 224 * MiB;
constexpr size_t WS_HID = 32 * MiB;

constexpr int LDS_BYTES = 155648, LDS_BST = 154624;
constexpr int NW = 8;

struct Params {
    const float* in[21];
    float* out;
    unsigned char* ws;
};

typedef const float* cfptr_t;
__device__ __forceinline__ const float* inptr(int i) {
    const __attribute__((address_space(4))) char* ka = (const __attribute__((address_space(4))) char*)__builtin_amdgcn_kernarg_segment_ptr();
    int off = i * 8; asm volatile("" : "+s"(off));
    return *(const __attribute__((address_space(4))) cfptr_t*)(ka + off);
}
__device__ __forceinline__ unsigned f2bf(float f) { unsigned u = __builtin_bit_cast(unsigned, f); return (u + 0x7fffu + ((u >> 16) & 1u)) >> 16; }
__device__ __forceinline__ float bf2f(unsigned b) { return __builtin_bit_cast(float, b << 16); }
__device__ __forceinline__ unsigned pk2(float lo, float hi) { return f2bf(lo) | (f2bf(hi) << 16); }
__device__ __forceinline__ float wave_sum(float v) {
#pragma unroll
    for (int o = 1; o < 64; o <<= 1) v += __shfl_xor(v, o);
    return v;
}
__device__ __forceinline__ float wave_max(float v) {
#pragma unroll
    for (int o = 1; o < 64; o <<= 1) v = fmaxf(v, __shfl_xor(v, o));
    return v;
}
__device__ __forceinline__ int t5_bucket(int n) {
    if (n < 16) return n;
    int b = 16;
    b += (n >= 19); b += (n >= 21); b += (n >= 24); b += (n >= 27); b += (n >= 31); b += (n >= 35); b += (n >= 40); b += (n >= 46);
    b += (n >= 52); b += (n >= 59); b += (n >= 67); b += (n >= 77); b += (n >= 87); b += (n >= 99); b += (n >= 113);
    return b;
}

__device__ __forceinline__ void p0_transpose_item(const float* W, int K, int N, int Npad, bf16_t* WT, LAS float* scr, int item, int lane, const float* gk = nullptr, int ldw = 0, bool projmap = false) {
    const int nblk = Npad / 32, kb = item / nblk, nb = item % nblk, k0 = 64 * kb, n0 = 32 * nb;
    int nsrc = n0;
    if (projmap) { if (n0 < 1280) { const int sl = 4 * (n0 >> 8) + ((n0 & 127) >> 5), e0 = 32 * ((n0 >> 7) & 1); nsrc = (sl < 8 ? C_QB + 64 * sl : C_KVB + 64 * (sl - 8)) + e0; }
                   else if (n0 < 1280 + 672) nsrc = n0 - 1280; else if (n0 == P_GATE) nsrc = C_GATE; else nsrc = N; }
    const int nn = nsrc + (lane & 31);
    float wv[32];
#pragma unroll
    for (int i = 0; i < 32; ++i) { const int kk = 2 * i + (lane >> 5); wv[i] = (nn < N) ? W[(size_t)(k0 + kk) * N + nn] : 0.f; }
#pragma unroll
    for (int i = 0; i < 32; ++i) { const int kk = 2 * i + (lane >> 5); const float gg = gk ? gk[k0 + kk] : 1.f; scr[kk * 33 + (lane & 31)] = wv[i] * gg; }
    asm volatile("s_waitcnt lgkmcnt(0)" ::: "memory");
    const int c = lane & 7;
#pragma unroll
    for (int j = 0; j < 4; ++j) { const int n = (lane >> 3) + 8 * j; const LAS float* s = scr + (8 * c) * 33 + n;
        u32x4 o; o.x = pk2(s[0 * 33], s[1 * 33]); o.y = pk2(s[2 * 33], s[3 * 33]); o.z = pk2(s[4 * 33], s[5 * 33]); o.w = pk2(s[6 * 33], s[7 * 33]);
        *(u32x4*)(WT + (size_t)(n0 + n) * (ldw ? ldw : K) + k0 + 8 * c) = o; }
    asm volatile("s_waitcnt lgkmcnt(0)" ::: "memory");
}
template <int NR>
__device__ __forceinline__ void rows_to_bf16_rstd(const float* x, bf16_t* o, float* rstd_out, int row0, int rstride, int lane) {
    f32x4 v[NR][4];
#pragma unroll
    for (int r = 0; r < NR; ++r) { const int rr = (row0 + r * rstride < M) ? row0 + r * rstride : row0; const f32x4* xr = (const f32x4*)(x + (size_t)rr * DM) + lane;
#pragma unroll
        for (int j = 0; j < 4; ++j) v[r][j] = xr[64 * j]; }
#pragma unroll
    for (int r = 0; r < NR; ++r) { if (row0 + r * rstride >= M) continue; float s = 0.f;
#pragma unroll
        for (int j = 0; j < 4; ++j) s += (v[r][j].x * v[r][j].x + v[r][j].y * v[r][j].y) + (v[r][j].z * v[r][j].z + v[r][j].w * v[r][j].w);
        s = wave_sum(s);
        if (lane == 0) rstd_out[row0 + r * rstride] = 1.f / sqrtf(s * (1.f / DM) + EPS);
        unsigned long long* o8 = (unsigned long long*)(o + (size_t)(row0 + r * rstride) * DM) + lane;
#pragma unroll
        for (int j = 0; j < 4; ++j) o8[64 * j] = (unsigned long long)pk2(v[r][j].x, v[r][j].y) | ((unsigned long long)pk2(v[r][j].z, v[r][j].w) << 32); }
}

__device__ __forceinline__ int opaque_tid() { int t = threadIdx.x; asm volatile("" : "+v"(t)); return t; }
namespace pg8 {
#define PG8_LAS __attribute__((address_space(3)))
typedef unsigned short bf16_t;
typedef short bf16x8 __attribute__((ext_vector_type(8)));
typedef float f32x4 __attribute__((ext_vector_type(4)));
typedef unsigned u32x4 __attribute__((ext_vector_type(4)));
constexpr int BM = 256, BK = 64, HALF = 128, HTB = HALF * BK * 2  , STAGE_BYTES = 8 * HTB, NXCD = 8, WGM = 8;

__host__ __device__ __forceinline__ int lds_byte(int r, int c) { const int st = (r >> 4) * 2 + (c >> 5), rr = r & 15, cc = c & 31, ob = rr * 64 + cc * 2; return st * 1024 + (ob ^ (((ob >> 9) & 1) << 5)); }
__host__ __device__ __forceinline__ void stage_rc(int b, int& R, int& C) { const int st = b / 1024, sb = b % 1024, swz = sb ^ (((sb >> 9) & 1) << 5); R = (st >> 1) * 16 + swz / 64; C = (st & 1) * 32 + (swz % 64) / 2; }
__host__ __device__ __forceinline__ int perm32(int rho) { const int n = rho >> 4, i = rho & 15; return 8 * (i >> 2) + 4 * n + (i & 3); }

struct Unit { int pm, pn; };
struct Gemm { const bf16_t* A; const bf16_t* Bt; int M, N, K, lda, ldb; };

struct StaticOrder {
    int nM, nN, nwg, G, c;
    __host__ __device__ void init(int M, int N, int G_, int c_) { nM = M / BM; nN = N / BM; nwg = nM * nN; G = G_; c = c_; }
    __host__ __device__ bool next(int i, Unit& u) const {
        const long L = (long)i * G + c; if (L >= nwg) return false;
        int wgid = (int)L; { const int q = nwg / NXCD, r = nwg % NXCD, xcd = wgid % NXCD, off = wgid / NXCD; wgid = (xcd < r ? xcd * (q + 1) : r * (q + 1) + (xcd - r) * q) + off; }
        const int nig = WGM * nN, gid = wgid / nig, fm = gid * WGM, gsz = (nM - fm) < WGM ? (nM - fm) : WGM;
        u.pm = fm + ((wgid % nig) % gsz); u.pn = (wgid % nig) / gsz; return true;
    }
    __device__ __forceinline__ void a_ready(const Unit&) const {}
    __device__ __forceinline__ void done(const Unit&) const {}
};

template <class Epi, class Sched, bool ALIGN_EPI = false, bool SP2 = false>
__device__ __forceinline__ void gemm_phase(PG8_LAS unsigned char* lds, const Gemm g, const Sched& S, const Epi& E) {
    const int tid = opaque_tid(), wid = __builtin_amdgcn_readfirstlane(tid >> 6), lane = tid & 63, wr = wid >> 2, wc = wid & 3, fr = lane & 15, fq = lane >> 4;
    const int K = g.K, nt = K / BK;
    unsigned voffA[2], voffB[2];
#pragma unroll
    for (int i = 0; i < 2; ++i) { int R, C; stage_rc(tid * 16 + i * 8192, R, C); const int Rb = Epi::PERM ? ((R & ~31) + perm32(R & 31)) : R;
        voffA[i] = (unsigned)(R * g.lda + C) * 2u; voffB[i] = (unsigned)(Rb * g.ldb + C) * 2u; }
    const size_t kstep = (size_t)(BK * 2);
    const size_t hstepA = (size_t)HALF * g.lda * 2, hstepB = (size_t)HALF * g.ldb * 2;
    const size_t tstepA = 2 * hstepA, tstepB = 2 * hstepB;
    const unsigned ldsw = (unsigned)wid * 1024u;
    const int aoff = lds_byte(wr * 64 + fr, fq * 8), boff = lds_byte(wc * 32 + fr, fq * 8);
#define PG8_SA(b, h) (((b) * 2 + (h)) * HTB)
#define PG8_SB(b, h) ((4 + (b) * 2 + (h)) * HTB)
#define PG8_STAGE(bufoff, gbase, voff) do { _Pragma("unroll") for (int _i = 0; _i < 2; ++_i) \
        __builtin_amdgcn_global_load_lds((const unsigned*)((const char*)(gbase) + (voff)[_i]), (PG8_LAS unsigned*)(lds + (bufoff) + ldsw + _i * 8192), 16, 0, 0); } while (0)
#define PG8_LDA(dst, b, h) do { _Pragma("unroll") for (int m = 0; m < 4; ++m) _Pragma("unroll") for (int k = 0; k < 2; ++k) dst[m][k] = *(const PG8_LAS bf16x8*)(lds + PG8_SA(b, h) + aoff + m * 2048 + k * 1024); } while (0)
#define PG8_LDB(dst, b, h) do { _Pragma("unroll") for (int n = 0; n < 2; ++n) _Pragma("unroll") for (int k = 0; k < 2; ++k) dst[n][k] = *(const PG8_LAS bf16x8*)(lds + PG8_SB(b, h) + boff + n * 2048 + k * 1024); } while (0)
#define PG8_MMA(ai, bj, At, Bt) do { __builtin_amdgcn_s_setprio(1); _Pragma("unroll") for (int m = 0; m < 4; ++m) _Pragma("unroll") for (int n = 0; n < 2; ++n) _Pragma("unroll") for (int k = 0; k < 2; ++k) \
        acc[ai][bj][m][n] = __builtin_amdgcn_mfma_f32_16x16x32_bf16(Bt[n][k], At[m][k], acc[ai][bj][m][n], 0, 0, 0); __builtin_amdgcn_s_setprio(0); } while (0)
#define PG8_WAIT_V(n) asm volatile("s_waitcnt vmcnt(" #n ")" ::: "memory")
#define PG8_WAIT_L(n) asm volatile("s_waitcnt lgkmcnt(" #n ")" ::: "memory")
#define PG8_BAR __builtin_amdgcn_s_barrier()
#define PG8_SCHED __builtin_amdgcn_sched_barrier(0)
    Unit cur, nxt; int ui = 0;
    if (!S.next(0, cur)) return;
    f32x4 acc[2][2][4][2];
#pragma unroll
    for (int a = 0; a < 2; ++a)
#pragma unroll
        for (int b = 0; b < 2; ++b)
#pragma unroll
            for (int m = 0; m < 4; ++m)
#pragma unroll
                for (int n = 0; n < 2; ++n) acc[a][b][m][n] = (f32x4){0.f, 0.f, 0.f, 0.f};
    bf16x8 At[4][2], B0[2][2], B1[2][2];
    const char* cA = (const char*)g.A + (size_t)cur.pm * tstepA; const char* cB = (const char*)g.Bt + (size_t)cur.pn * tstepB;
    S.a_ready(cur);
    if constexpr (SP2) {
        PG8_STAGE(PG8_SB(0, 0), cB, voffB); PG8_STAGE(PG8_SB(0, 1), cB + hstepB, voffB); PG8_STAGE(PG8_SA(0, 0), cA, voffA); PG8_STAGE(PG8_SA(0, 1), cA + hstepA, voffA);
        if (wr == 1) PG8_BAR;
        PG8_WAIT_V(2); PG8_BAR;
        PG8_STAGE(PG8_SB(1, 0), cB + kstep, voffB); PG8_STAGE(PG8_SA(1, 0), cA + kstep, voffA); PG8_STAGE(PG8_SB(1, 1), cB + hstepB + kstep, voffB);
        PG8_WAIT_V(6); PG8_BAR;
    } else {
        PG8_STAGE(PG8_SB(0, 0), cB, voffB); PG8_STAGE(PG8_SA(0, 0), cA, voffA); PG8_STAGE(PG8_SB(0, 1), cB + hstepB, voffB); PG8_STAGE(PG8_SA(0, 1), cA + hstepA, voffA);
        if (wr == 1) PG8_BAR;
        PG8_WAIT_V(4); PG8_BAR;
        PG8_STAGE(PG8_SB(1, 0), cB + kstep, voffB); PG8_STAGE(PG8_SA(1, 0), cA + kstep, voffA); PG8_STAGE(PG8_SB(1, 1), cB + hstepB + kstep, voffB);
        PG8_WAIT_V(6); PG8_BAR;
    }
    for (;;) {
        const bool has_next = S.next(ui + 1, nxt);
        const char* nA = has_next ? (const char*)g.A + (size_t)nxt.pm * tstepA : cA; const char* nB = has_next ? (const char*)g.Bt + (size_t)nxt.pn * tstepB : cB;
        for (int t = 0; t < nt; t += 2) {
            if constexpr (Epi::MIDSCALE) { if (t == nt / 2) E.midscale(acc, cur, wr, fr); }
            const bool last = (t == nt - 2);
            const char* a1 = cA + (size_t)(t + 1) * kstep;
            const char* a2 = last ? nA : cA + (size_t)(t + 2) * kstep; const char* b2 = last ? nB : cB + (size_t)(t + 2) * kstep;
            const char* a3 = a2 + kstep; const char* b3 = b2 + kstep;
            if (last && has_next) S.a_ready(nxt);
            if constexpr (SP2) {
            PG8_LDB(B0, 0, 0); PG8_LDB(B1, 0, 1); PG8_SCHED; PG8_LDA(At, 0, 0); PG8_STAGE(PG8_SA(1, 1), a1 + hstepA, voffA);
            PG8_WAIT_V(8); PG8_WAIT_L(0); PG8_BAR; PG8_MMA(0, 0, At, B0); PG8_MMA(0, 1, At, B1); PG8_BAR; PG8_SCHED;
            PG8_LDA(At, 0, 1); PG8_STAGE(PG8_SB(0, 0), b2, voffB); PG8_STAGE(PG8_SB(0, 1), b2 + hstepB, voffB); PG8_STAGE(PG8_SA(0, 0), a2, voffA);
            PG8_WAIT_V(8); PG8_WAIT_L(0); PG8_BAR; PG8_MMA(1, 0, At, B0); PG8_MMA(1, 1, At, B1); PG8_BAR; PG8_SCHED;
            PG8_LDB(B0, 1, 0); PG8_LDB(B1, 1, 1); PG8_SCHED; PG8_LDA(At, 1, 0); PG8_STAGE(PG8_SA(0, 1), a2 + hstepA, voffA);
            PG8_WAIT_V(8); PG8_WAIT_L(0); PG8_BAR; PG8_MMA(0, 0, At, B0); PG8_MMA(0, 1, At, B1); PG8_BAR; PG8_SCHED;
            PG8_LDA(At, 1, 1); PG8_STAGE(PG8_SB(1, 0), b3, voffB); PG8_STAGE(PG8_SB(1, 1), b3 + hstepB, voffB); PG8_STAGE(PG8_SA(1, 0), a3, voffA);
            PG8_WAIT_V(8); PG8_WAIT_L(0); PG8_BAR; PG8_MMA(1, 0, At, B0); PG8_MMA(1, 1, At, B1); PG8_BAR; PG8_SCHED;
            } else {
            PG8_LDB(B0, 0, 0); PG8_SCHED; PG8_LDA(At, 0, 0); PG8_STAGE(PG8_SA(1, 1), a1 + hstepA, voffA);
            PG8_WAIT_L(8); PG8_BAR; PG8_WAIT_L(0); PG8_MMA(0, 0, At, B0); PG8_BAR; PG8_SCHED;
            PG8_LDB(B1, 0, 1); PG8_STAGE(PG8_SB(0, 0), b2, voffB);
            PG8_BAR; PG8_WAIT_L(0); PG8_MMA(0, 1, At, B1); PG8_BAR;
            PG8_LDA(At, 0, 1); PG8_STAGE(PG8_SA(0, 0), a2, voffA);
            PG8_BAR; PG8_WAIT_L(0); PG8_MMA(1, 0, At, B0); PG8_BAR; PG8_SCHED;
            PG8_STAGE(PG8_SB(0, 1), b2 + hstepB, voffB);
            PG8_WAIT_V(6); PG8_BAR; PG8_MMA(1, 1, At, B1); PG8_BAR;
            PG8_LDB(B0, 1, 0); PG8_SCHED; PG8_LDA(At, 1, 0); PG8_STAGE(PG8_SA(0, 1), a2 + hstepA, voffA);
            PG8_WAIT_L(8); PG8_BAR; PG8_WAIT_L(0); PG8_MMA(0, 0, At, B0); PG8_BAR; PG8_SCHED;
            PG8_LDB(B1, 1, 1); PG8_STAGE(PG8_SB(1, 0), b3, voffB);
            PG8_BAR; PG8_WAIT_L(0); PG8_MMA(0, 1, At, B1); PG8_BAR;
            PG8_LDA(At, 1, 1); PG8_STAGE(PG8_SA(1, 0), a3, voffA);
            PG8_BAR; PG8_WAIT_L(0); PG8_MMA(1, 0, At, B0); PG8_BAR; PG8_SCHED;
            PG8_STAGE(PG8_SB(1, 1), b3 + hstepB, voffB);
            PG8_WAIT_V(6); PG8_BAR; PG8_MMA(1, 1, At, B1); PG8_BAR;
            }
        }
        if constexpr (ALIGN_EPI) { if (wr == 0) PG8_BAR; }
        if constexpr (!Epi::AFTER_DRAIN) { E(acc, cur, wr, wc, fr, fq); S.done(cur); }
        if (!has_next) break;
#pragma unroll
        for (int a = 0; a < 2; ++a)
#pragma unroll
            for (int b = 0; b < 2; ++b)
#pragma unroll
                for (int m = 0; m < 4; ++m)
#pragma unroll
                    for (int n = 0; n < 2; ++n) acc[a][b][m][n] = (f32x4){0.f, 0.f, 0.f, 0.f};
        cur = nxt; cA = nA; cB = nB; ++ui;
        if constexpr (ALIGN_EPI) { if (wr == 1) PG8_BAR; }
    }
    PG8_WAIT_V(0);
    if constexpr (!ALIGN_EPI) { if (wr == 0) PG8_BAR; }
    PG8_BAR;
    if constexpr (Epi::AFTER_DRAIN) { E.fused(acc, cur, wr, wc, fr, fq, lds, wid, lane); S.done(cur); }
#undef PG8_SA
#undef PG8_SB
#undef PG8_STAGE
#undef PG8_LDA
#undef PG8_LDB
#undef PG8_MMA
#undef PG8_WAIT_V
#undef PG8_WAIT_L
#undef PG8_BAR
#undef PG8_SCHED
}
}

__device__ __forceinline__ unsigned cvt_pk_bf16(float lo, float hi) { unsigned r; asm volatile("v_cvt_pk_bf16_f32 %0, %1, %2" : "=v"(r) : "v"(lo), "v"(hi)); return r; }
template <int ACT> struct PEpiBf16 {
    static constexpr bool PERM = true, AFTER_DRAIN = false, MIDSCALE = false;
    bf16_t* O; int ldc; const float* rs; float invn;
    __device__ __forceinline__ void operator()(const f32x4 (&acc)[2][2][4][2], const pg8::Unit& u, int wr, int wc, int fr, int fq) const {
        const int row0 = u.pm * 256 + wr * 64 + fr, col0 = u.pn * 256 + wc * 32 + 8 * fq;
        float rsc[2][4];
#pragma unroll
        for (int ai = 0; ai < 2; ++ai)
#pragma unroll
            for (int m = 0; m < 4; ++m) rsc[ai][m] = rs ? rs[row0 + ai * 128 + m * 16] : 1.f;
        if (invn > 0.f) {
#pragma unroll
            for (int ai = 0; ai < 2; ++ai)
#pragma unroll
                for (int m = 0; m < 4; ++m) rsc[ai][m] = 1.f / sqrtf(rsc[ai][m] * invn + EPS); }
#pragma unroll
        for (int ai = 0; ai < 2; ++ai)
#pragma unroll
            for (int m = 0; m < 4; ++m) { bf16_t* rowp = O + (size_t)(row0 + ai * 128 + m * 16) * ldc + col0; const float sc_ = rsc[ai][m];
#pragma unroll
                for (int bj = 0; bj < 2; ++bj) { f32x4 v0 = acc[ai][bj][m][0] * sc_, v1 = acc[ai][bj][m][1] * sc_;
                    if (ACT == 2) {
#pragma unroll
                        for (int e = 0; e < 4; ++e) { const float a = fmaxf(v0[e], 0.f), b = fmaxf(v1[e], 0.f); v0[e] = a * a; v1[e] = b * b; } }
                    u32x4 w; w.x = cvt_pk_bf16(v0[0], v0[1]); w.y = cvt_pk_bf16(v0[2], v0[3]); w.z = cvt_pk_bf16(v1[0], v1[1]); w.w = cvt_pk_bf16(v1[2], v1[3]);
                    *(u32x4*)(rowp + bj * 128) = w; } }
    }
};
struct PEpiProj {
    static constexpr bool PERM = true, AFTER_DRAIN = false, MIDSCALE = false;
    bf16_t* O; int ldc; const float* rs1; float* ssq_q; float* ssq_kv; const float* qgain; const float* kgain;
    __device__ __forceinline__ void operator()(const f32x4 (&acc)[2][2][4][2], const pg8::Unit& u, int wr, int wc, int fr, int fq) const {
        const int row0 = u.pm * 256 + wr * 64 + fr, col0 = u.pn * 256 + wc * 32 + 8 * fq, lane = fq * 16 + fr;
        float rsc[2][4];
#pragma unroll
        for (int ai = 0; ai < 2; ++ai)
#pragma unroll
            for (int m = 0; m < 4; ++m) rsc[ai][m] = rs1[row0 + ai * 128 + m * 16];
        const int sl = 4 * u.pn + wc;
        int mode = 0; const float* g = nullptr; float gs = 1.f;
        if (u.pn < 5) { if (sl < 8) { mode = 1; g = qgain; gs = QS_NSA; } else if (sl == S_KSEL || sl == S_KSEL + 1) { mode = 1; g = kgain + 64; } else if (sl == S_KWIN || sl == S_KWIN + 1) { mode = 1; g = kgain + 128; } }
        f32x4 ga[2][2];
        if (mode == 1) {
#pragma unroll
            for (int bj = 0; bj < 2; ++bj) { ga[bj][0] = *(const f32x4*)(g + 32 * bj + 8 * fq) * gs; ga[bj][1] = *(const f32x4*)(g + 32 * bj + 8 * fq + 4) * gs; } }
#pragma unroll
        for (int ai = 0; ai < 2; ++ai)
#pragma unroll
            for (int m = 0; m < 4; ++m) { const int row = row0 + ai * 128 + m * 16; bf16_t* rowp = O + (size_t)row * ldc + col0; const float sc_ = rsc[ai][m];
                f32x4 v[2][2];
#pragma unroll
                for (int bj = 0; bj < 2; ++bj) { v[bj][0] = acc[ai][bj][m][0] * sc_; v[bj][1] = acc[ai][bj][m][1] * sc_; }
                if (mode == 1) {
                    float ss = 0.f;
#pragma unroll
                    for (int bj = 0; bj < 2; ++bj)
#pragma unroll
                        for (int n = 0; n < 2; ++n) ss += (v[bj][n][0] * v[bj][n][0] + v[bj][n][1] * v[bj][n][1]) + (v[bj][n][2] * v[bj][n][2] + v[bj][n][3] * v[bj][n][3]);
                    ss += __builtin_bit_cast(float, __builtin_amdgcn_ds_bpermute((lane ^ 16) << 2, __builtin_bit_cast(int, ss)));
                    ss += __builtin_bit_cast(float, __builtin_amdgcn_ds_bpermute((lane ^ 32) << 2, __builtin_bit_cast(int, ss)));
                    const float rstd = 1.f / sqrtf(ss * (1.f / 64) + EPS);
#pragma unroll
                    for (int bj = 0; bj < 2; ++bj) { v[bj][0] = v[bj][0] * rstd * ga[bj][0]; v[bj][1] = v[bj][1] * rstd * ga[bj][1]; }
                } else if (u.pn >= 5) {
#pragma unroll
                    for (int bj = 0; bj < 2; ++bj) { const int cb = u.pn * 256 + bj * 128;
                        float* dst = (cb < P_HKV) ? ssq_q : (cb < P_HKR ? ssq_kv : nullptr);
                        if (dst) { float ss = (v[bj][0][0] * v[bj][0][0] + v[bj][0][1] * v[bj][0][1]) + (v[bj][0][2] * v[bj][0][2] + v[bj][0][3] * v[bj][0][3]) + (v[bj][1][0] * v[bj][1][0] + v[bj][1][1] * v[bj][1][1]) + (v[bj][1][2] * v[bj][1][2] + v[bj][1][3] * v[bj][1][3]);
                            ss += __builtin_bit_cast(float, __builtin_amdgcn_ds_bpermute((lane ^ 16) << 2, __builtin_bit_cast(int, ss)));
                            ss += __builtin_bit_cast(float, __builtin_amdgcn_ds_bpermute((lane ^ 32) << 2, __builtin_bit_cast(int, ss)));
                            if (fq == 0) __hip_atomic_fetch_add(dst + row, ss, __ATOMIC_RELAXED, __HIP_MEMORY_SCOPE_AGENT); } }
                }
#pragma unroll
                for (int bj = 0; bj < 2; ++bj) { u32x4 w; w.x = cvt_pk_bf16(v[bj][0][0], v[bj][0][1]); w.y = cvt_pk_bf16(v[bj][0][2], v[bj][0][3]); w.z = cvt_pk_bf16(v[bj][1][0], v[bj][1][1]); w.w = cvt_pk_bf16(v[bj][1][2], v[bj][1][3]);
                    *(u32x4*)(rowp + bj * 128) = w; } }
    }
};
struct PEpiResF32 {
    static constexpr bool PERM = false, AFTER_DRAIN = false, MIDSCALE = false;
    const float* base; float* out; int ldc;
    __device__ __forceinline__ void operator()(const f32x4 (&acc)[2][2][4][2], const pg8::Unit& u, int wr, int wc, int fr, int fq) const {
        const int col0 = u.pn * 256 + wc * 32 + 4 * fq;
#pragma unroll
        for (int ai = 0; ai < 2; ++ai)
#pragma unroll
            for (int m = 0; m < 4; ++m) { const size_t off = (size_t)(u.pm * 256 + ai * 128 + wr * 64 + m * 16 + fr) * ldc + col0;
#pragma unroll
                for (int bj = 0; bj < 2; ++bj)
#pragma unroll
                    for (int n = 0; n < 2; ++n) { const f32x4 bs = *(const f32x4*)(base + off + bj * 128 + n * 16); *(f32x4*)(out + off + bj * 128 + n * 16) = bs + acc[ai][bj][m][n]; } }
    }
};

struct PEpiWo {
    static constexpr bool PERM = false, AFTER_DRAIN = false, MIDSCALE = true;
    const bf16_t* base; bf16_t* xb; float* ssq; const float* ssqm; int ldc;
    __device__ __forceinline__ void midscale(f32x4 (&acc)[2][2][4][2], const pg8::Unit& u, int wr, int fr) const {
#pragma unroll
        for (int ai = 0; ai < 2; ++ai)
#pragma unroll
            for (int m = 0; m < 4; ++m) { const int row = u.pm * 256 + ai * 128 + wr * 64 + m * 16 + fr;
                const float sa = ssqm[2 * row], sb = ssqm[2 * row + 1]; const float ratio = sqrtf((sb * (1.f / 512) + EPS) / (sa * (1.f / 512) + EPS));
#pragma unroll
                for (int bj = 0; bj < 2; ++bj)
#pragma unroll
                    for (int n = 0; n < 2; ++n) acc[ai][bj][m][n] *= ratio; }
    }
    __device__ __forceinline__ void operator()(const f32x4 (&acc)[2][2][4][2], const pg8::Unit& u, int wr, int wc, int fr, int fq) const {
        const int col0 = u.pn * 256 + wc * 32 + 4 * fq; const int lane = fq * 16 + fr;
        const int rowb = u.pm * 256 + wr * 64 + fr;
        float rb[8];
#pragma unroll
        for (int g_ = 0; g_ < 8; ++g_) rb[g_] = ssqm[2 * (rowb + (g_ >> 2) * 128 + (g_ & 3) * 16) + 1];
        u32x2 nxt[2][2];
#pragma unroll
        for (int bj = 0; bj < 2; ++bj)
#pragma unroll
            for (int n = 0; n < 2; ++n) nxt[bj][n] = *(const u32x2*)(base + (size_t)rowb * ldc + col0 + bj * 128 + n * 16);
#pragma unroll
        for (int g_ = 0; g_ < 8; ++g_) { const int ai = g_ >> 2, m = g_ & 3; const int row = rowb + ai * 128 + m * 16; const size_t off = (size_t)row * ldc + col0; float ss = 0.f;
            u32x2 cur[2][2];
#pragma unroll
            for (int bj = 0; bj < 2; ++bj)
#pragma unroll
                for (int n = 0; n < 2; ++n) cur[bj][n] = nxt[bj][n];
            if (g_ < 7) { const size_t offn = (size_t)(rowb + ((g_ + 1) >> 2) * 128 + ((g_ + 1) & 3) * 16) * ldc + col0;
#pragma unroll
                for (int bj = 0; bj < 2; ++bj)
#pragma unroll
                    for (int n = 0; n < 2; ++n) nxt[bj][n] = *(const u32x2*)(base + offn + bj * 128 + n * 16); }
            const float rbs = 1.f / sqrtf(rb[g_] * (1.f / 512) + EPS);
#pragma unroll
            for (int bj = 0; bj < 2; ++bj)
#pragma unroll
                for (int n = 0; n < 2; ++n) { const u32x2 cw = cur[bj][n]; const f32x4 v = (f32x4){bf2f(cw.x & 0xffffu), bf2f(cw.x >> 16), bf2f(cw.y & 0xffffu), bf2f(cw.y >> 16)} + acc[ai][bj][m][n] * rbs;
                    ss += (v[0] * v[0] + v[1] * v[1]) + (v[2] * v[2] + v[3] * v[3]);
                    u32x2 w; w.x = cvt_pk_bf16(v[0], v[1]); w.y = cvt_pk_bf16(v[2], v[3]); *(u32x2*)(xb + off + bj * 128 + n * 16) = w; }
            ss += __builtin_bit_cast(float, __builtin_amdgcn_ds_bpermute((lane ^ 16) << 2, __builtin_bit_cast(int, ss)));
            ss += __builtin_bit_cast(float, __builtin_amdgcn_ds_bpermute((lane ^ 32) << 2, __builtin_bit_cast(int, ss)));
            if (fq == 0) __hip_atomic_fetch_add(ssq + row, ss, __ATOMIC_RELAXED, __HIP_MEMORY_SCOPE_AGENT); }
    }
};


struct PEpiDown {
    static constexpr bool PERM = false, AFTER_DRAIN = false, MIDSCALE = false;
    const bf16_t* xb; float* out; int ldc;
    __device__ __forceinline__ void operator()(const f32x4 (&acc)[2][2][4][2], const pg8::Unit& u, int wr, int wc, int fr, int fq) const {
        const int col0 = u.pn * 256 + wc * 32 + 4 * fq; const int rowb = u.pm * 256 + wr * 64 + fr;
        u32x2 nxt[2][2];
#pragma unroll
        for (int bj = 0; bj < 2; ++bj)
#pragma unroll
            for (int n = 0; n < 2; ++n) nxt[bj][n] = *(const u32x2*)(xb + (size_t)rowb * ldc + col0 + bj * 128 + n * 16);
#pragma unroll
        for (int g_ = 0; g_ < 8; ++g_) { const int ai = g_ >> 2, m = g_ & 3; const size_t off = (size_t)(rowb + ai * 128 + m * 16) * ldc + col0;
            u32x2 cur[2][2];
#pragma unroll
            for (int bj = 0; bj < 2; ++bj)
#pragma unroll
                for (int n = 0; n < 2; ++n) cur[bj][n] = nxt[bj][n];
            if (g_ < 7) { const size_t offn = (size_t)(rowb + ((g_ + 1) >> 2) * 128 + ((g_ + 1) & 3) * 16) * ldc + col0;
#pragma unroll
                for (int bj = 0; bj < 2; ++bj)
#pragma unroll
                    for (int n = 0; n < 2; ++n) nxt[bj][n] = *(const u32x2*)(xb + offn + bj * 128 + n * 16); }
#pragma unroll
            for (int bj = 0; bj < 2; ++bj)
#pragma unroll
                for (int n = 0; n < 2; ++n) { const u32x2 w = cur[bj][n];
                    const f32x4 bs = (f32x4){bf2f(w.x & 0xffffu), bf2f(w.x >> 16), bf2f(w.y & 0xffffu), bf2f(w.y >> 16)};
                    *(f32x4*)(out + off + bj * 128 + n * 16) = bs + acc[ai][bj][m][n]; } }
    }
};

__device__ __forceinline__ float sq8(const bf16x8 v) { float s = 0.f;
#pragma unroll
    for (int j = 0; j < 8; ++j) { const float f = bf2f((unsigned short)v[j]); s += f * f; }
    return s; }
__device__ __forceinline__ u32x4 scale8(const bf16x8 v, float sc, const f32x4 ga, const f32x4 gb) { u32x4 o;
    o.x = pk2(bf2f((unsigned short)v[0]) * sc * ga[0], bf2f((unsigned short)v[1]) * sc * ga[1]); o.y = pk2(bf2f((unsigned short)v[2]) * sc * ga[2], bf2f((unsigned short)v[3]) * sc * ga[3]);
    o.z = pk2(bf2f((unsigned short)v[4]) * sc * gb[0], bf2f((unsigned short)v[5]) * sc * gb[1]); o.w = pk2(bf2f((unsigned short)v[6]) * sc * gb[2], bf2f((unsigned short)v[7]) * sc * gb[3]);
    return o; }
template <int NR>
__device__ __forceinline__ void glueA_rows(unsigned char* ws, int row0, int rstride, int lane) {
    const int br = (lane >> 4) & 1, g = (lane >> 3) & 1, l8 = lane & 7;
    bf16x8 vq[NR], vkv[NR], vk[NR];
#pragma unroll
    for (int r = 0; r < NR; ++r) { const int row = (row0 + r * rstride < M) ? row0 + r * rstride : row0; const bf16_t* pr = (const bf16_t*)(ws + WS_PROJ) + (size_t)row * DINP;
        vq[r] = *(const bf16x8*)(pr + C_HQ + 8 * (lane < 48 ? lane : 47)); vkv[r] = *(const bf16x8*)(pr + C_HKV + 8 * (lane & 31)); vk[r] = *(const bf16x8*)(pr + (br ? C_KWIN : C_KSEL) + 64 * g + 8 * l8); }
    const float* kg = inptr(10) + (1 + br) * 64 + 8 * l8; const f32x4 ga = *(const f32x4*)kg, gb = *(const f32x4*)(kg + 4);
#pragma unroll
    for (int r = 0; r < NR; ++r) { const int row = row0 + r * rstride; if (row >= M) continue;
        const float sq = wave_sum(lane < 48 ? sq8(vq[r]) : 0.f), skv = wave_sum(lane < 32 ? sq8(vkv[r]) : 0.f);
        float sk = sq8(vk[r]); sk += __shfl_xor(sk, 1); sk += __shfl_xor(sk, 2); sk += __shfl_xor(sk, 4);
        if (lane == 0) { ((float*)(ws + WS_RSQ))[row] = 1.f / sqrtf(sq * (1.f / QR) + EPS); ((float*)(ws + WS_RSKV))[row] = 1.f / sqrtf(skv * (1.f / KVR) + EPS); }
        if (lane < 32) { const float rstd = 1.f / sqrtf(sk * (1.f / 64) + EPS);
            *(u32x4*)((bf16_t*)(ws + (br ? WS_KWIN : WS_KSEL)) + (size_t)row * 128 + 64 * g + 8 * l8) = scale8(vk[r], rstd, ga, gb); } }
}
template <int NR>
__device__ __forceinline__ void kpass_rows(unsigned char* ws, int row0, int rstride, int lane) {
    const int h = lane >> 3, l = lane & 7;
    bf16x8 v[NR]; unsigned ra[NR], rb[NR];
#pragma unroll
    for (int r = 0; r < NR; ++r) { const int row = (row0 + r * rstride < M) ? row0 + r * rstride : row0;
        v[r] = *(const bf16x8*)((const bf16_t*)(ws + WS_KVM) + (size_t)row * MKV + 128 * h + 8 * l);
        const bf16_t* kr = (const bf16_t*)(ws + WS_PROJ) + (size_t)row * DINP + P_HKR + 2 * l; ra[r] = *(const unsigned*)kr; rb[r] = *(const unsigned*)(kr + 16); }
    const float* kg = inptr(8);
    const f32x4 ga = *(const f32x4*)(kg + 8 * l), gb = *(const f32x4*)(kg + 8 * l + 4);
    const float g1a = kg[64 + 2 * l], g1b = kg[65 + 2 * l], g2a = kg[80 + 2 * l], g2b = kg[81 + 2 * l];
    const float inva = exp2f(-(float)(2 * l) * (13.287712379549449f / 16.f)), invb = exp2f(-(float)(2 * l + 1) * (13.287712379549449f / 16.f));
#pragma unroll
    for (int r = 0; r < NR; ++r) { const int row = row0 + r * rstride; if (row >= M) continue;
        const int pos = row & (SEQ - 1);
        const float x1a = bf2f(ra[r] & 0xffffu), x1b = bf2f(ra[r] >> 16), x2a = bf2f(rb[r] & 0xffffu), x2b = bf2f(rb[r] >> 16);
        float ss = sq8(v[r]) + (x1a * x1a + x1b * x1b) + (x2a * x2a + x2b * x2b);
        ss += __shfl_xor(ss, 1); ss += __shfl_xor(ss, 2); ss += __shfl_xor(ss, 4);
        const float rstd = 1.f / sqrtf(ss * (1.f / 96) + EPS);
        bf16_t* ko = (bf16_t*)(ws + WS_KMLA) + (size_t)row * MQ + 96 * h;
        *(u32x4*)(ko + 8 * l) = scale8(v[r], rstd, ga, gb);
        float sna, csa, snb, csb; sincosf((float)pos * inva, &sna, &csa); sincosf((float)pos * invb, &snb, &csb);
        const float n1a = x1a * rstd * g1a, n2a = x2a * rstd * g2a, n1b = x1b * rstd * g1b, n2b = x2b * rstd * g2b;
        *(unsigned*)(ko + 64 + 2 * l) = pk2(n1a * csa - n2a * sna, n1b * csb - n2b * snb); *(unsigned*)(ko + 80 + 2 * l) = pk2(n2a * csa + n1a * sna, n2b * csb + n1b * snb); }
}
__device__ __forceinline__ void glueC_row(unsigned char* ws, int row, int lane) {
    bf16_t* mx = (bf16_t*)(ws + WS_MIX) + (size_t)row * DM + 8 * lane;
#pragma unroll
    for (int half = 0; half < 2; ++half) {
        const bf16x8 v = *(const bf16x8*)(mx + 512 * half);
        const float rstd = 1.f / sqrtf(wave_sum(sq8(v)) * (1.f / 512) + EPS);
        const float* gp = inptr(15 + half) + 8 * lane;
        *(u32x4*)(mx + 512 * half) = scale8(v, rstd, *(const f32x4*)gp, *(const f32x4*)(gp + 4));
    }
}

__device__ __forceinline__ void compress_block(unsigned char* ws, LAS unsigned char* L, int task) {
    const int tid = opaque_tid(), lane = tid & 63, wid = __builtin_amdgcn_readfirstlane(tid >> 6), fr = lane & 15, fq = lane >> 4;
    const int tc = task & 15, b = (task >> 4) & 7, kv = task >> 7;
    int c = 8 * tc + (fr >> 1); const int g = fr & 1; if (c > NCMP - 1) c = NCMP - 1;
    const bf16_t* arow = (const bf16_t*)(ws + WS_PROJ) + (size_t)(b * SEQ + 16 * c) * DINP + slot_base((kv ? S_VCMP : S_KCMP) + g) + 8 * fq;
    const float* pe = inptr(11) + kv * 2048 + 8 * fq;
    const bf16_t* w1t = (const bf16_t*)(ws + WS_W1T) + (size_t)kv * 128 * 2048 + (size_t)fr * 2048 + 8 * fq;
    f32x4 acc[8];
#pragma unroll
    for (int n = 0; n < 8; ++n) acc[n] = (f32x4){0.f, 0.f, 0.f, 0.f};
#pragma unroll 4
    for (int s8 = 0; s8 < 8; ++s8) {
        const int s = 8 * wid + s8, r = s >> 1, db = (s & 1) * 32;
        const bf16x8 araw = *(const bf16x8*)(arow + (size_t)r * DINP + 4 * db);
        const f32x4 pa = *(const f32x4*)(pe + r * 64 + db), pb = *(const f32x4*)(pe + r * 64 + db + 4);
        u32x4 aw; aw.x = pk2(bf2f((unsigned short)araw[0]) + pa[0], bf2f((unsigned short)araw[1]) + pa[1]); aw.y = pk2(bf2f((unsigned short)araw[2]) + pa[2], bf2f((unsigned short)araw[3]) + pa[3]);
        aw.z = pk2(bf2f((unsigned short)araw[4]) + pb[0], bf2f((unsigned short)araw[5]) + pb[1]); aw.w = pk2(bf2f((unsigned short)araw[6]) + pb[2], bf2f((unsigned short)araw[7]) + pb[3]);
        const bf16x8 a = __builtin_bit_cast(bf16x8, aw);
#pragma unroll
        for (int n = 0; n < 8; ++n) { const bf16x8 bb = *(const bf16x8*)(w1t + (size_t)(16 * n) * 2048 + 32 * s);
            acc[n] = __builtin_amdgcn_mfma_f32_16x16x32_bf16(a, bb, acc[n], 0, 0, 0); }
    }
    LAS float* part = (LAS float*)L;
#pragma unroll
    for (int n = 0; n < 8; ++n)
#pragma unroll
        for (int j = 0; j < 4; ++j) part[(wid * 16 + 4 * fq + j) * 128 + 16 * n + fr] = acc[n][j];
    __syncthreads();
    LAS bf16_t* hb_ = (LAS bf16_t*)(L + 65536);
#pragma unroll
    for (int e = 0; e < 4; ++e) { const int idx = tid + 512 * e; float v = 0.f;
#pragma unroll
        for (int w = 0; w < 8; ++w) v += part[w * 2048 + idx];
        hb_[idx] = (bf16_t)f2bf(v / (1.f + __expf(-v))); }
    __syncthreads();
    if (wid == 0) {
        const bf16_t* w2t = (const bf16_t*)(ws + WS_W2T) + kv * 64 * 128 + fr * 128 + 8 * fq;
        f32x4 o[4];
#pragma unroll
        for (int n = 0; n < 4; ++n) o[n] = (f32x4){0.f, 0.f, 0.f, 0.f};
#pragma unroll
        for (int ks = 0; ks < 4; ++ks) { const bf16x8 a = *(const LAS bf16x8*)(hb_ + fr * 128 + 32 * ks + 8 * fq);
#pragma unroll
            for (int n = 0; n < 4; ++n) { const bf16x8 bb = *(const bf16x8*)(w2t + (size_t)(16 * n) * 128 + 32 * ks); o[n] = __builtin_amdgcn_mfma_f32_16x16x32_bf16(a, bb, o[n], 0, 0, 0); } }
        bf16_t* dstb = (bf16_t*)(ws + (kv ? WS_VCMP : WS_KCMP)) + (size_t)b * 128 * 2 * 64;
        const float* kg = inptr(10);
#pragma unroll
        for (int j = 0; j < 4; ++j) { const int row = 4 * fq + j, cc = 8 * tc + (row >> 1), gg = row & 1;
            float sc = 1.f;
            if (kv == 0) { float ss = o[0][j] * o[0][j] + o[1][j] * o[1][j] + o[2][j] * o[2][j] + o[3][j] * o[3][j];
                ss += __shfl_xor(ss, 1); ss += __shfl_xor(ss, 2); ss += __shfl_xor(ss, 4); ss += __shfl_xor(ss, 8); sc = 1.f / sqrtf(ss * (1.f / 64) + EPS); }
#pragma unroll
            for (int n = 0; n < 4; ++n) { const int col = 16 * n + fr; float v = o[n][j] * sc; if (kv == 0) v *= kg[col]; if (cc >= NCMP) v = 0.f;
                dstb[((size_t)cc * 2 + gg) * 64 + col] = (bf16_t)f2bf(v); } }
    }
    __syncthreads();
}

namespace att {
typedef float f32x16 __attribute__((ext_vector_type(16)));
typedef short s16x4 __attribute__((ext_vector_type(4)));
typedef short v4i16_t __attribute__((ext_vector_type(4)));
typedef float f32x2_t __attribute__((ext_vector_type(2)));
typedef __bf16 bf16x2_t __attribute__((ext_vector_type(2)));
typedef const LAS unsigned char* lcp;
constexpr int NSLOT = 3;
constexpr int L_TB = 0, L_K = 4096, KSLOT = 12288, L_V = L_K + NSLOT * KSLOT, VSLOT = 8192, L_WSF = L_V + NSLOT * VSLOT, L_OST = L_WSF + 4096,
              L_IMP = L_OST + 32768, L_SELM = L_IMP + 32768, L_GATE = L_SELM + 256, L_SC = L_GATE + 3072, L_INVL = L_SC + 8192, L_END = L_INVL + 1024;
static_assert(L_V + NSLOT * VSLOT <= 65536, "LDS-DMA destinations stay below 64 KiB");
static_assert(L_END <= LDS_BST, "attention LDS map");
constexpr float THR = 8.0f;
__device__ __forceinline__ int crow(int r, int hi) { return (r & 3) + 8 * (r >> 2) + 4 * hi; }
__device__ __forceinline__ void glds16(const void* gsrc, unsigned lds_dst) { unsigned keep;
    asm volatile("s_mov_b32 %0, m0\n\ts_mov_b32 m0, %2\n\ts_nop 0\n\tglobal_load_lds_dwordx4 %1, off\n\ts_mov_b32 m0, %0" : "=&s"(keep) : "v"(gsrc), "s"(lds_dst) : "memory"); }
__device__ __forceinline__ unsigned cvtpk(float lo, float hi) { f32x2_t v = {lo, hi}; bf16x2_t b = __builtin_convertvector(v, bf16x2_t); return __builtin_bit_cast(unsigned, b); }
__device__ __forceinline__ s16x4 vtr(lcp p) { return __builtin_bit_cast(s16x4, __builtin_amdgcn_ds_read_tr16_b64_v4i16((LAS v4i16_t*)p)); }
__device__ __forceinline__ float lane_xor(float v, int lane, int x) { return __builtin_bit_cast(float, __builtin_amdgcn_ds_bpermute((lane ^ x) << 2, __builtin_bit_cast(int, v))); }
__device__ __forceinline__ unsigned lane_xor_u(unsigned v, int lane, int x) { return (unsigned)__builtin_amdgcn_ds_bpermute((lane ^ x) << 2, (int)v); }
__device__ __forceinline__ float swap_max(float m, int lane) { return __builtin_fmaxf(m, lane_xor(m, lane, 32)); }
__device__ __forceinline__ float swap_sum(float m, int lane) { return m + lane_xor(m, lane, 32); }
__device__ __forceinline__ float max3f(float a, float b, float c) { float r; asm("v_max3_f32 %0, %1, %2, %3" : "=v"(r) : "v"(a), "v"(b), "v"(c)); return r; }
__device__ __forceinline__ float max32(const f32x16& p0, const f32x16& p1) {
    float a = max3f(p0[0], p0[1], p1[0]), b = max3f(p0[2], p0[3], p1[1]); a = max3f(a, p1[2], p1[3]);
#pragma unroll
    for (int r = 4; r < 16; r += 4) { a = max3f(a, p0[r], p0[r + 1]); b = max3f(b, p0[r + 2], p0[r + 3]); a = max3f(a, p1[r], p1[r + 1]); b = max3f(b, p1[r + 2], p1[r + 3]); }
    return __builtin_fmaxf(a, b); }
__device__ __forceinline__ float max16(const f32x16& p) { float a = __builtin_fmaxf(p[0], p[1]), b = __builtin_fmaxf(p[2], p[3]);
#pragma unroll
    for (int r = 4; r < 16; r += 4) { a = __builtin_fmaxf(a, __builtin_fmaxf(p[r], p[r + 1])); b = __builtin_fmaxf(b, __builtin_fmaxf(p[r + 2], p[r + 3])); }
    return __builtin_fmaxf(a, b); }
__device__ __forceinline__ float sum16(const f32x16& p) { float a = p[0] + p[1], b = p[2] + p[3];
#pragma unroll
    for (int r = 4; r < 16; r += 4) { a += p[r] + p[r + 1]; b += p[r + 2] + p[r + 3]; }
    return a + b; }
#define ATT_BAR() asm volatile("s_waitcnt vmcnt(0) lgkmcnt(0)\n\ts_barrier" ::: "memory")

template <int DQ> __device__ __forceinline__ void qkt(f32x16& p0, f32x16& p1, lcp kslot, const bf16x8* qr, const f32x16& cinit, int r32, int hi) {
    lcp kb = kslot + hi * 1024 + r32 * 16;
    constexpr int NB = 2;
#pragma unroll
    for (int db = 0; db < DQ / 16; db += NB) {
        bf16x8 kf[2 * NB];
#pragma unroll
        for (int e = 0; e < NB; ++e) { kf[2 * e] = *(const LAS bf16x8*)(kb + (db + e) * 2048); kf[2 * e + 1] = *(const LAS bf16x8*)(kb + (db + e) * 2048 + 512); }
        __builtin_amdgcn_sched_barrier(0);
#pragma unroll
        for (int e = 0; e < NB; ++e) { const int d0 = db + e;
            if (d0 == 0) { p0 = __builtin_amdgcn_mfma_f32_32x32x16_bf16(kf[0], qr[0], cinit, 0, 0, 0); p1 = __builtin_amdgcn_mfma_f32_32x32x16_bf16(kf[1], qr[0], cinit, 0, 0, 0); }
            else { p0 = __builtin_amdgcn_mfma_f32_32x32x16_bf16(kf[2 * e], qr[d0], p0, 0, 0, 0); p1 = __builtin_amdgcn_mfma_f32_32x32x16_bf16(kf[2 * e + 1], qr[d0], p1, 0, 0, 0); }
        }
    }
}
__device__ __forceinline__ void vload_half(bf16x8 (&vf)[8], lcp vp, int d0) {
#pragma unroll
    for (int ks = 0; ks < 4; ++ks) {
        const s16x4 lo = vtr(vp + d0 * 4096 + ks * 1024), hh = vtr(vp + d0 * 4096 + ks * 1024 + 512);
        vf[d0 * 4 + ks] = (bf16x8){lo[0], lo[1], lo[2], lo[3], hh[0], hh[1], hh[2], hh[3]};
    }
    __builtin_amdgcn_sched_barrier(0);
}
__device__ __forceinline__ void vload(bf16x8 (&vf)[8], lcp vp) { vload_half(vf, vp, 0); vload_half(vf, vp, 1); }
__device__ __forceinline__ void pv_mma(f32x16 (&o)[2], const bf16x8 (&vf)[8], const f32x16& p0, const f32x16& p1) {
    u32x4 pw[4];
    pw[0] = (u32x4){cvtpk(p0[0], p0[1]), cvtpk(p0[2], p0[3]), cvtpk(p0[4], p0[5]), cvtpk(p0[6], p0[7])};
    pw[1] = (u32x4){cvtpk(p0[8], p0[9]), cvtpk(p0[10], p0[11]), cvtpk(p0[12], p0[13]), cvtpk(p0[14], p0[15])};
    pw[2] = (u32x4){cvtpk(p1[0], p1[1]), cvtpk(p1[2], p1[3]), cvtpk(p1[4], p1[5]), cvtpk(p1[6], p1[7])};
    pw[3] = (u32x4){cvtpk(p1[8], p1[9]), cvtpk(p1[10], p1[11]), cvtpk(p1[12], p1[13]), cvtpk(p1[14], p1[15])};
#pragma unroll
    for (int d0 = 0; d0 < 2; ++d0)
#pragma unroll
        for (int ks = 0; ks < 4; ++ks) o[d0] = __builtin_amdgcn_mfma_f32_32x32x16_bf16(__builtin_bit_cast(bf16x8, pw[ks]), vf[d0 * 4 + ks], o[d0], 0, 0, 0);
}
__device__ __forceinline__ void pv(f32x16 (&o)[2], lcp vp, const f32x16& p0, const f32x16& p1) { bf16x8 vf[8]; vload(vf, vp); pv_mma(o, vf, p0, p1); }
template <int DQ, bool SLOT = false> __device__ __forceinline__ void dma_tile(unsigned lds0, const bf16_t* Kg, int kpitch, const bf16_t* Vg, int vpitch, int key0, int slot, int wid, int lane) {
    const bf16_t* ksrc = Kg + (size_t)(key0 + lane) * kpitch + (SLOT ? 128 * (wid >> 2) + 8 * (wid & 3) : wid * 8);
    glds16(ksrc, (unsigned)__builtin_amdgcn_readfirstlane(lds0 + L_K + slot * KSLOT + wid * 1024));
    if (DQ == 96) { if (wid < 4) glds16(ksrc + 64, (unsigned)__builtin_amdgcn_readfirstlane(lds0 + L_K + slot * KSLOT + (8 + wid) * 1024)); }
    const bf16_t* vsrc = Vg + (size_t)(key0 + 16 * (wid & 3) + (lane >> 2)) * vpitch + (wid >> 2) * (SLOT ? 128 : 32) + (lane & 3) * 8;
    glds16(vsrc, (unsigned)__builtin_amdgcn_readfirstlane(lds0 + L_V + slot * VSLOT + wid * 1024));
}

template <int DQ, bool SLOT = false, class Pol>
__device__ __forceinline__ void flash_loop(LAS unsigned char* L, const bf16_t* Kg, int kpitch, const bf16_t* Vg, int vpitch, const bf16x8* qr, const Pol& pol, f32x16 (&o)[2], float& l_out, int wid, int lane) {
    const int r32 = lane & 31, hi = lane >> 5;
    const unsigned lds0 = (unsigned)(uintptr_t)L;
    LAS float* wsf = (LAS float*)(L + L_WSF) + wid * 128;
    lcp vp0 = L + L_V + ((lane >> 4) & 1) * 32 + (lane & 3) * 8 + (4 * hi + ((lane & 15) >> 2)) * 64;
    float mhat = 0.f, l = 0.f;
    f32x16 negm;
#pragma unroll
    for (int r = 0; r < 16; ++r) { o[0][r] = 0.f; o[1][r] = 0.f; negm[r] = 0.f; }
    const int n = pol.ntiles;
    dma_tile<DQ, SLOT>(lds0, Kg, kpitch, Vg, vpitch, pol.key0(0), 0, wid, lane);
    if (n > 1) dma_tile<DQ, SLOT>(lds0, Kg, kpitch, Vg, vpitch, pol.key0(1), 1, wid, lane);
    int slot = 0, slot2 = 2;
    for (int i = 0; i < n; ++i) {
        if (i + 1 < n) { if (DQ == 96 && wid < 4) asm volatile("s_waitcnt vmcnt(3) lgkmcnt(0)\n\ts_barrier" ::: "memory"); else asm volatile("s_waitcnt vmcnt(2) lgkmcnt(0)\n\ts_barrier" ::: "memory"); }
        else ATT_BAR();
        if (i + 2 < n) dma_tile<DQ, SLOT>(lds0, Kg, kpitch, Vg, vpitch, pol.key0(i + 2), slot2, wid, lane);
        if (pol.active(i)) {
            f32x16 p0, p1;
            qkt<DQ>(p0, p1, L + L_K + slot * KSLOT, qr, negm, r32, hi);
            bf16x8 vf[8]; vload_half(vf, vp0 + slot * VSLOT, 0);
            pol.fix(p0, p1, i);
            asm volatile("s_nop 15\n\ts_nop 7" : "+v"(p0), "+v"(p1));
            const float rm = swap_max(max32(p0, p1), lane);
            const bool first = (i == 0);
            if (first || __any(rm > THR)) {
                float dl = first ? rm : __builtin_fmaxf(rm, 0.f);
                if (dl == -INFINITY) dl = 0.f;
                mhat += dl;
#pragma unroll
                for (int r = 0; r < 16; ++r) { p0[r] -= dl; p1[r] -= dl; negm[r] = -mhat; }
                if (!first) {
                    const float f = __builtin_amdgcn_exp2f(-dl); l *= f;
                    if (hi == 0) wsf[r32] = f;
#pragma unroll
                    for (int r = 0; r < 16; ++r) { const float fr_ = wsf[crow(r, hi)]; o[0][r] *= fr_; o[1][r] *= fr_; }
                }
            }
#pragma unroll
            for (int r = 0; r < 16; ++r) { p0[r] = __builtin_amdgcn_exp2f(p0[r]); p1[r] = __builtin_amdgcn_exp2f(p1[r]); }
            vload_half(vf, vp0 + slot * VSLOT, 1);
            l += sum16(p0) + sum16(p1);
            pv_mma(o, vf, p0, p1);
        }
        slot = (slot == NSLOT - 1) ? 0 : slot + 1; slot2 = (slot2 == NSLOT - 1) ? 0 : slot2 + 1;
    }
    ATT_BAR();
    l_out = swap_sum(l, lane);
}

__device__ __forceinline__ void acc_scaled(f32x16 (&oc)[2], const f32x16 (&o)[2], float rowscale, LAS float* wsf, int r32, int hi) {
    if (hi == 0) wsf[32 + r32] = rowscale;
#pragma unroll
    for (int r = 0; r < 16; ++r) { const float s = wsf[32 + crow(r, hi)]; oc[0][r] += s * o[0][r]; oc[1][r] += s * o[1][r]; }
}
__device__ __forceinline__ void park_store(const f32x16 (&oc)[2], LAS float* park, int lane) {
#pragma unroll
    for (int d0 = 0; d0 < 2; ++d0)
#pragma unroll
        for (int r = 0; r < 16; ++r) park[(d0 * 16 + r) * 64 + lane] = oc[d0][r];
}
template <bool FINAL> __device__ __forceinline__ void park_acc(f32x16 (&oc)[2], LAS float* park, const f32x16 (&o)[2], float rowscale, LAS float* wsf, int lane) {
    const int r32 = lane & 31, hi = lane >> 5;
    if (hi == 0) wsf[32 + r32] = rowscale;
#pragma unroll
    for (int r = 0; r < 16; ++r) { const float s = wsf[32 + crow(r, hi)];
#pragma unroll
        for (int d0 = 0; d0 < 2; ++d0) { const float v = park[(d0 * 16 + r) * 64 + lane] + s * o[d0][r]; if (FINAL) oc[d0][r] = v; else park[(d0 * 16 + r) * 64 + lane] = v; } }
}
__device__ __forceinline__ void store_tile(const f32x16 (&oc)[2], bf16_t* dst, int pitch, LAS unsigned char* L, int wid, int lane, float* ssq) {
    const int r32 = lane & 31, hi = lane >> 5;
    LAS bf16_t* stg = (LAS bf16_t*)(L + L_OST + wid * 8192);
#pragma unroll
    for (int r = 0; r < 16; ++r) { const int orow = crow(r, hi);
#pragma unroll
        for (int d0 = 0; d0 < 2; ++d0) stg[orow * 64 + d0 * 32 + r32] = (bf16_t)f2bf(oc[d0][r]); }
    asm volatile("s_waitcnt lgkmcnt(0)" ::: "memory");
#pragma unroll
    for (int i = 0; i < 4; ++i) { const int row = i * 8 + (lane >> 3), ch = lane & 7; const u32x4 v = *(const LAS u32x4*)(stg + row * 64 + ch * 8); *(u32x4*)(dst + (size_t)row * pitch + ch * 8) = v;
        float ss = sq8(__builtin_bit_cast(bf16x8, v)); ss += lane_xor(ss, lane, 1); ss += lane_xor(ss, lane, 2); ss += lane_xor(ss, lane, 4);
        if (ch == 0) __hip_atomic_fetch_add(ssq + 2 * row, ss, __ATOMIC_RELAXED, __HIP_MEMORY_SCOPE_AGENT); }
    asm volatile("s_waitcnt lgkmcnt(0)" ::: "memory");
}

struct PolMla { int ntiles, qw0, r32, hi;
    __device__ __forceinline__ int key0(int i) const { return 64 * i; }
    __device__ __forceinline__ bool active(int i) const { return 64 * i <= qw0 + 31; }
    __device__ __forceinline__ int nact() const { const int a = (qw0 + 31) / 64 + 1; return a < ntiles ? a : ntiles; }
    __device__ __forceinline__ void fix(f32x16& p0, f32x16& p1, int i) const {
        if (64 * i + 63 > qw0) { const int q = qw0 + r32, kb = 64 * i + 4 * hi;
#pragma unroll
            for (int r = 0; r < 16; ++r) { const int kv = kb + (r & 3) + 8 * (r >> 2); if (kv > q) p0[r] = -INFINITY; if (kv + 32 > q) p1[r] = -INFINITY; } }
    }
};
struct PolSel { int ntiles, qc, q, hi; unsigned selm; const LAS float* tbh;
    __device__ __forceinline__ int key0(int i) const { return 64 * (qc - i); }
    __device__ __forceinline__ bool active(int i) const { return __any((selm >> (qc - i)) & 1u) != 0; }
    __device__ __forceinline__ int nact() const { return ntiles; }
    __device__ __forceinline__ void fix(f32x16& p0, f32x16& p1, int i) const {
        const bool bit = ((selm >> (qc - i)) & 1u) != 0u;
        if (i <= 2) { const int kb = 64 * (qc - i) + 4 * hi;
#pragma unroll
            for (int r = 0; r < 16; ++r) { const int d0 = q - (kb + (r & 3) + 8 * (r >> 2)), d1 = d0 - 32;
                p0[r] = (d0 < 0) ? -INFINITY : p0[r] + tbh[d0 < 127 ? d0 : 127]; p1[r] = (d1 < 0) ? -INFINITY : p1[r] + tbh[d1 < 127 ? d1 : 127]; } }
        if (!bit) {
#pragma unroll
            for (int r = 0; r < 16; ++r) { p0[r] = -INFINITY; p1[r] = -INFINITY; } }
    }
};
struct PolWin { int ntiles, qc, q, hi; const LAS float* tbh;
    __device__ __forceinline__ int key0(int i) const { return 64 * (qc - i); }
    __device__ __forceinline__ bool active(int) const { return true; }
    __device__ __forceinline__ int nact() const { return ntiles; }
    __device__ __forceinline__ void fix(f32x16& p0, f32x16& p1, int i) const {
        if (i <= 2 || i == 8) { const int kb = 64 * (qc - i) + 4 * hi;
#pragma unroll
            for (int r = 0; r < 16; ++r) { const int d0 = q - (kb + (r & 3) + 8 * (r >> 2)), d1 = d0 - 32;
                const float b0 = (i <= 2) ? tbh[d0 < 0 ? 0 : (d0 < 127 ? d0 : 127)] : 0.f, b1 = (i <= 2) ? tbh[d1 < 0 ? 0 : (d1 < 127 ? d1 : 127)] : 0.f;
                p0[r] = (d0 < 0 || d0 >= 512) ? -INFINITY : p0[r] + b0; p1[r] = (d1 < 0 || d1 >= 512) ? -INFINITY : p1[r] + b1; } }
    }
};

__device__ __forceinline__ void mla_unit(unsigned char* ws, LAS unsigned char* L, int b, int h, int qb) {
    const int tid = opaque_tid(), lane = tid & 63, wid = __builtin_amdgcn_readfirstlane(tid >> 6);
    const int r32 = lane & 31, hi = lane >> 5;
    const size_t rowbase = (size_t)b * SEQ; const int qw0 = 256 * qb + 32 * wid;
    bf16x8 qr[6];
    { const bf16_t* Qw = (const bf16_t*)(ws + WS_QM) + (rowbase + qw0 + r32) * MQ + 96 * h + 8 * hi;
      bf16x8 raw[6]; float ss = 0.f;
#pragma unroll
      for (int d0 = 0; d0 < 6; ++d0) { raw[d0] = *(const bf16x8*)(Qw + 16 * d0); ss += sq8(raw[d0]); }
      ss += lane_xor(ss, lane, 32);
      const float rstd = QS_MLA / sqrtf(ss * (1.f / 96) + EPS);
      const float* qg = inptr(7) + 8 * hi;
#pragma unroll
      for (int d0 = 0; d0 < 4; ++d0) qr[d0] = __builtin_bit_cast(bf16x8, scale8(raw[d0], rstd, *(const f32x4*)(qg + 16 * d0), *(const f32x4*)(qg + 16 * d0 + 4)));
      float o1[8], o2[8]; const float posf = (float)(qw0 + r32);
#pragma unroll
      for (int j = 0; j < 8; ++j) { const int i = 8 * hi + j; const float inv = exp2f(-(float)i * (13.287712379549449f / 16.f)); float sn, cs; sincosf(posf * inv, &sn, &cs);
          const float n1 = bf2f((unsigned short)raw[4][j]) * rstd * qg[64 + j], n2 = bf2f((unsigned short)raw[5][j]) * rstd * qg[80 + j];
          o1[j] = n1 * cs - n2 * sn; o2[j] = n2 * cs + n1 * sn; }
      u32x4 w4, w5; w4.x = pk2(o1[0], o1[1]); w4.y = pk2(o1[2], o1[3]); w4.z = pk2(o1[4], o1[5]); w4.w = pk2(o1[6], o1[7]);
      w5.x = pk2(o2[0], o2[1]); w5.y = pk2(o2[2], o2[3]); w5.z = pk2(o2[4], o2[5]); w5.w = pk2(o2[6], o2[7]);
      qr[4] = __builtin_bit_cast(bf16x8, w4); qr[5] = __builtin_bit_cast(bf16x8, w5); }
    const bf16_t* Kg = (const bf16_t*)(ws + WS_KMLA) + rowbase * MQ + 96 * h;
    const bf16_t* Vg = (const bf16_t*)(ws + WS_KVM) + rowbase * MKV + 128 * h + 64;
    PolMla pol{4 * qb + 4, qw0, r32, hi};
    f32x16 o[2]; float l;
    flash_loop<96>(L, Kg, MQ, Vg, MKV, qr, pol, o, l, wid, lane);
    LAS float* wsf = (LAS float*)(L + L_WSF) + wid * 128;
    f32x16 oc[2];
#pragma unroll
    for (int r = 0; r < 16; ++r) { oc[0][r] = 0.f; oc[1][r] = 0.f; }
    acc_scaled(oc, o, (l > 0.f) ? 1.f / l : 0.f, wsf, r32, hi);
    store_tile(oc, (bf16_t*)(ws + WS_MIX) + (rowbase + qw0) * DM + 64 * h, DM, L, wid, lane, (float*)(ws + WS_SSQM) + 2 * (rowbase + qw0));
}

__device__ __forceinline__ void nsa_unit(unsigned char* ws, LAS unsigned char* L, int b, int g, int qc) {
#define NSA_IDS() const int tid = opaque_tid(), lane = tid & 63, wid = __builtin_amdgcn_readfirstlane(tid >> 6); \
    const int r32 = lane & 31, hi = lane >> 5, rh = wid & 3, qh = wid >> 2, h = 4 * g + rh, qloc = 32 * qh + r32, q = q0 + qloc; \
    const unsigned lds0 = (unsigned)(uintptr_t)L; LAS float* wsf = (LAS float*)(L + L_WSF) + wid * 128; const LAS float* tbh = (const LAS float*)(L + L_TB) + h * 128; \
    LAS float* gate = (LAS float*)(L + L_GATE); (void)tid; (void)lane; (void)r32; (void)hi; (void)rh; (void)qh; (void)h; (void)qloc; (void)q; (void)lds0; (void)wsf; (void)tbh; (void)gate
    const size_t rowbase = (size_t)b * SEQ; const int q0 = 64 * qc;
    const bf16_t* pr = (const bf16_t*)(ws + WS_PROJ);
    bf16x8 qr[4];
    {
    NSA_IDS();
    for (int i = tid; i < 768; i += 512) { const int br = i >> 8, r = (i >> 6) & 3, qq = i & 63;
        const float x = bf2f(pr[(rowbase + q0 + qq) * DINP + P_GATE + 8 * br + 4 * g + r]); gate[i] = 1.f / (1.f + __expf(-x)); }
    { const bf16_t* Qw = pr + (rowbase + q) * DINP + slot_base(S_Q + h) + 8 * hi;
#pragma unroll
      for (int d0 = 0; d0 < 4; ++d0) qr[d0] = *(const bf16x8*)(Qw + 128 * (d0 >> 1) + 16 * (d0 & 1)); }
    }
    f32x16 oc[2];
#pragma unroll
    for (int r = 0; r < 16; ++r) { oc[0][r] = 0.f; oc[1][r] = 0.f; }
    {
        NSA_IDS();
        const bf16_t* Kg = (const bf16_t*)(ws + WS_KCMP) + ((size_t)b * 256 + g) * 64;
        const bf16_t* Vg = (const bf16_t*)(ws + WS_VCMP) + ((size_t)b * 256 + g) * 64;
        dma_tile<64>(lds0, Kg, 128, Vg, 128, 0, 0, wid, lane);
        dma_tile<64>(lds0, Kg, 128, Vg, 128, 64, 1, wid, lane);
        ATT_BAR();
        lcp vp0 = L + L_V + ((lane >> 4) & 1) * 32 + (lane & 3) * 8 + (4 * hi + ((lane & 15) >> 2)) * 64;
        LAS float* imp = (LAS float*)(L + L_IMP) + (rh * 64 + qloc) * 32;
        f32x16 o[2];
#pragma unroll
        for (int r = 0; r < 16; ++r) { o[0][r] = 0.f; o[1][r] = 0.f; }
        float m = -INFINITY, lsum = 0.f, prev_last = 0.f;
#pragma unroll 1
        for (int pass = 0; pass < 2; ++pass) {
#pragma unroll 1
            for (int T = 0; T < 2; ++T) {
                f32x16 a0, a1;
                { f32x16 zero;
#pragma unroll
                  for (int r = 0; r < 16; ++r) zero[r] = 0.f;
                  qkt<64>(a0, a1, L + L_K + T * KSLOT, qr, zero, r32, hi); }
#pragma unroll
                for (int r = 0; r < 16; ++r) { const int c = 64 * T + crow(r, hi);
                    { const int d = q - 16 * c - 31;        a0[r] = (d < 0) ? -INFINITY : a0[r] + tbh[d < 127 ? d : 127]; }
                    { const int d = q - 16 * (c + 32) - 31; a1[r] = (d < 0 || c + 32 >= NCMP) ? -INFINITY : a1[r] + tbh[d < 127 ? d : 127]; } }
                if (pass == 0) { m = __builtin_fmaxf(m, __builtin_fmaxf(max16(a0), max16(a1))); }
                else {
#pragma unroll
                    for (int r = 0; r < 16; ++r) { a0[r] = __builtin_amdgcn_exp2f(a0[r] - m); a1[r] = __builtin_amdgcn_exp2f(a1[r] - m); }
                    lsum += sum16(a0) + sum16(a1);
                    float own[8], car[8];
#pragma unroll
                    for (int a = 0; a < 4; ++a) {
                        own[a]     = a0[4 * a] + a0[4 * a + 1] + a0[4 * a + 2] + 0.5f * a0[4 * a + 3]; car[a]     = 0.5f * a0[4 * a + 3];
                        own[4 + a] = a1[4 * a] + a1[4 * a + 1] + a1[4 * a + 2] + 0.5f * a1[4 * a + 3]; car[4 + a] = 0.5f * a1[4 * a + 3]; }
#pragma unroll
                    for (int k = 0; k < 8; ++k) car[k] = lane_xor(car[k], lane, 32);
#pragma unroll
                    for (int k = 0; k < 8; ++k) { const float add = hi ? car[k] : (k >= 1 ? car[k - 1] : prev_last); imp[16 * T + 2 * k + hi] = own[k] + add; }
                    prev_last = car[7];
                    pv(o, vp0 + T * VSLOT, a0, a1);
                }
            }
            if (pass == 0) { m = swap_max(m, lane); if (m == -INFINITY) m = 0.f; }
        }
        lsum = swap_sum(lsum, lane);
        const float inv = (lsum > 0.f) ? 1.f / lsum : 0.f;
        if (hi == 0) ((LAS float*)(L + L_INVL))[rh * 64 + qloc] = inv;
        ATT_BAR();
        acc_scaled(oc, o, gate[(0 * 4 + rh) * 64 + qloc] * inv, wsf, r32, hi);
    }
    if (qc <= 15) {
        const int tid = opaque_tid();
        if (tid < 64) ((LAS unsigned*)(L + L_SELM))[tid] = (qc == 31) ? 0xffffffffu : ((2u << qc) - 1u);
        ATT_BAR();
    } else {
        const int tid = opaque_tid();
        const LAS float* imp = (const LAS float*)(L + L_IMP); LAS float* sc = (LAS float*)(L + L_SC);
        const int qq = tid >> 3, jj = tid & 7;
        const LAS float* il = (const LAS float*)(L + L_INVL);
        const float i0 = il[qq], i1 = il[64 + qq], i2 = il[128 + qq], i3 = il[192 + qq];
#pragma unroll
        for (int k = 0; k < 4; ++k) { const int j = jj + 8 * k;
            const float tot = (imp[(0 * 64 + qq) * 32 + j] * i0 + imp[(1 * 64 + qq) * 32 + j] * i1) + (imp[(2 * 64 + qq) * 32 + j] * i2 + imp[(3 * 64 + qq) * 32 + j] * i3);
            float s; if (j > qc) s = -INFINITY; else if (j == 0 || j == qc || j == qc - 1) s = 1e4f; else s = tot; sc[qq * 32 + j] = s; }
        ATT_BAR();
        f32x4 v[8];
#pragma unroll
        for (int k = 0; k < 8; ++k) v[k] = *(const LAS f32x4*)(sc + qq * 32 + 4 * k);
        unsigned bits = 0u;
#pragma unroll
        for (int k = 0; k < 4; ++k) { const int j = jj + 8 * k; const float me = sc[qq * 32 + j]; int rank = 0;
#pragma unroll
            for (int i = 0; i < 32; ++i) { const float si = v[i >> 2][i & 3]; rank += (si > me || (si == me && i < j)) ? 1 : 0; }
            if (rank < 16) bits |= 1u << j; }
        { const int lane = tid & 63; bits |= lane_xor_u(bits, lane, 1); bits |= lane_xor_u(bits, lane, 2); bits |= lane_xor_u(bits, lane, 4); }
        if (jj == 0) ((LAS unsigned*)(L + L_SELM))[qq] = bits;
        ATT_BAR();
    }
    { NSA_IDS(); park_store(oc, (LAS float*)(L + L_OST) + wid * 2048, lane); }
    {
        NSA_IDS();
        const unsigned selm = ((const LAS unsigned*)(L + L_SELM))[qloc];
        const bf16_t* Kg = pr + rowbase * DINP + slot_base(S_KSEL + g);
        const bf16_t* Vg = pr + rowbase * DINP + slot_base(S_VSEL + g);
        PolSel pol{qc + 1, qc, q, hi, selm, tbh};
        f32x16 o[2]; float l;
        flash_loop<64, true>(L, Kg, DINP, Vg, DINP, qr, pol, o, l, wid, lane);
        { f32x16 dummy[2]; park_acc<false>(dummy, (LAS float*)(L + L_OST) + wid * 2048, o, (l > 0.f) ? gate[(1 * 4 + rh) * 64 + qloc] / l : 0.f, wsf, lane); }
    }
    {
        NSA_IDS();
        const bf16_t* Kg = pr + rowbase * DINP + slot_base(S_KWIN + g);
        const bf16_t* Vg = pr + rowbase * DINP + slot_base(S_VWIN + g);
        PolWin pol{(qc < 8 ? qc : 8) + 1, qc, q, hi, tbh};
        f32x16 o[2]; float l;
        flash_loop<64, true>(L, Kg, DINP, Vg, DINP, qr, pol, o, l, wid, lane);
        f32x16 fin[2]; park_acc<true>(fin, (LAS float*)(L + L_OST) + wid * 2048, o, (l > 0.f) ? gate[(2 * 4 + rh) * 64 + qloc] / l : 0.f, wsf, lane);
        store_tile(fin, (bf16_t*)(ws + WS_MIX) + (rowbase + q0 + 32 * qh) * DM + 512 + 64 * h, DM, L, wid, lane, (float*)(ws + WS_SSQM) + 2 * (rowbase + q0 + 32 * qh) + 1);
    }
    ATT_BAR();
}
#undef ATT_BAR
#undef NSA_IDS
}

#define XB_TMO      128
#define XB_XCNT(j)  (256  + 64 * (j))
#define XB_XSUB(j)  (1280 + 64 * (j))
#define XB_XGEN(j)  (2304 + 64 * (j))
#define XB_TOP      3328
#define XB_TOPGEN   3392
#define XCD_BAR_WORDS 3456
#define XB_SPIN_CAP (1u << 18)

__device__ __forceinline__ unsigned xb_ld(unsigned* p)              { return __hip_atomic_load(p, __ATOMIC_RELAXED, __HIP_MEMORY_SCOPE_AGENT); }
__device__ __forceinline__ unsigned xb_add(unsigned* p, unsigned v) { return __hip_atomic_fetch_add(p, v, __ATOMIC_RELAXED, __HIP_MEMORY_SCOPE_AGENT); }
__device__ __forceinline__ unsigned xb_xcc_id() { return (unsigned)__builtin_amdgcn_s_getreg((3 << 11) | 20) & 0xFu; }
#define XB_SPIN(cond, bar) do { unsigned _sp = 0; while (cond) { __builtin_amdgcn_s_sleep(1); \
    if ((++_sp & 255u) == 0u) { if (xb_ld(&(bar)[XB_TMO])) break; if (_sp > XB_SPIN_CAP) { atomicAdd(&(bar)[XB_TMO], 1u); break; } } } } while (0)

struct XcdBarrier {
    unsigned* bar; unsigned x;
    volatile LAS unsigned* st;
};

__device__ __forceinline__ XcdBarrier xcd_barrier_post(unsigned* bar, volatile LAS unsigned* st) {
    XcdBarrier b; b.bar = bar; b.x = xb_xcc_id(); b.st = st;
    if (threadIdx.x == 0) (void)xb_add(&bar[XB_XCNT(b.x)], 1u);
    return b;
}
__device__ __forceinline__ void xcd_barrier_complete(unsigned* bar, unsigned x, unsigned& nloc, unsigned& nx) {
    const unsigned G = gridDim.x * gridDim.y * gridDim.z;
    unsigned sum, cnt, mine, sp = 0u;
    for (;;) {
        sum = 0u; cnt = 0u; mine = 0u;
#pragma unroll
        for (unsigned j = 0; j < 16; ++j) { const unsigned c = xb_ld(&bar[XB_XCNT(j)]); sum += c; cnt += (c > 0u) ? 1u : 0u; mine = (j == x) ? c : mine; }
        if (sum == G) break;
        __builtin_amdgcn_s_sleep(1);
        if ((++sp & 255u) == 0u) { if (xb_ld(&bar[XB_TMO])) break; if (sp > XB_SPIN_CAP) { atomicAdd(&bar[XB_TMO], 1u); break; } }
    }
    nloc = mine > 0u ? mine : 1u; nx = cnt > 0u ? cnt : 1u;
}

__device__ __forceinline__ void xcd_barrier(const XcdBarrier& b) {
    asm volatile("s_waitcnt vmcnt(0)" ::: "memory");
    __syncthreads();
    if (threadIdx.x == 0) {
        unsigned* bar = b.bar;
        __builtin_amdgcn_s_waitcnt(0);
        unsigned nloc = b.st[0], nx = b.st[1];
        if (nloc == 0u) { xcd_barrier_complete(bar, b.x, nloc, nx); b.st[0] = nloc; b.st[1] = nx; }
        const unsigned old = xb_add(&bar[XB_XSUB(b.x)], 1u);
        const unsigned gen = old / nloc;
        if (old + 1u == (gen + 1u) * nloc) {
            __builtin_amdgcn_fence(__ATOMIC_RELEASE, "agent");
            asm volatile("s_waitcnt vmcnt(0)" ::: "memory");
            const unsigned og = xb_add(&bar[XB_TOP], 1u);
            const unsigned tg = og / nx;
            if (og + 1u == (tg + 1u) * nx) xb_add(&bar[XB_TOPGEN], 1u);
            else XB_SPIN(xb_ld(&bar[XB_TOPGEN]) == tg, bar);
            __builtin_amdgcn_fence(__ATOMIC_ACQUIRE, "agent");
            xb_add(&bar[XB_XGEN(b.x)], 1u);
            asm volatile("s_waitcnt vmcnt(0)" ::: "memory");
        } else {
            XB_SPIN(xb_ld(&bar[XB_XGEN(b.x)]) == gen, bar);
            __builtin_amdgcn_fence(__ATOMIC_ACQUIRE, "agent");
            asm volatile("s_waitcnt vmcnt(0)" ::: "memory");
        }
    }
    __syncthreads();
}

__global__ void __launch_bounds__(512, 2) mega(Params p) {
    extern __shared__ __attribute__((aligned(16))) unsigned char lds[];
    const int G = gridDim.x, bid = blockIdx.x, NGW = G * NW;
#define PHASE_IDS() const int tid = opaque_tid(), lane = tid & 63, wave = __builtin_amdgcn_readfirstlane(tid >> 6), gw = bid * NW + wave; (void)tid; (void)lane; (void)gw
    unsigned char* ws = (unsigned char*)inptr(22);
    LAS unsigned char* L = (LAS unsigned char*)lds;
    volatile LAS unsigned* bst = (volatile LAS unsigned*)(L + LDS_BST);
    if (threadIdx.x < 4) bst[threadIdx.x] = 0u;
    __syncthreads();
    const XcdBarrier bar = xcd_barrier_post((unsigned*)(ws + WS_CTL), bst);
#if TS
    if (blockIdx.x == 0 && threadIdx.x == 0) ((unsigned long long*)(ws + 29 * MiB))[0] = __builtin_amdgcn_s_memrealtime();
#define STAMP(k) do { if (TS == (k) && blockIdx.x == 0 && threadIdx.x == 0) ((unsigned long long*)(ws + 29 * MiB))[1] = __builtin_amdgcn_s_memrealtime(); } while (0)
#else
#define STAMP(k) do {} while (0)
#endif

#if EXP == 5
    for (int e_ = 0; e_ < 2; ++e_)
#endif
    {
        PHASE_IDS();
        LAS float* scr = (LAS float*)(L + wave * 8704);
        constexpr int I0 = (1024 / 64) * (DINP / 32), I1 = (QR / 64) * (MQ / 32), I2 = (KVR / 64) * (MKV / 32), I3 = 16 * 32, I4 = 16 * (FF / 32), I5 = (FF / 64) * 32;
        constexpr int I6 = (2048 / 64) * (128 / 32), I7 = (128 / 64) * (64 / 32);
        constexpr int NIT = I0 + I1 + I2 + I3 + I4 + I5 + 2 * I6 + 2 * I7;
        for (int it = gw; it < NIT; it += NGW) {
            int r = it;
            if (r < I0) { p0_transpose_item(inptr(2), 1024, DIN, DINP, (bf16_t*)(ws + WS_WIN), scr, r, lane, inptr(1), 0, true); continue; } r -= I0;
            if (r < I1) { p0_transpose_item(inptr(5), QR, MQ, MQ, (bf16_t*)(ws + WS_WUQ), scr, r, lane, inptr(3)); continue; } r -= I1;
            if (r < I2) { p0_transpose_item(inptr(6), KVR, MKV, MKV, (bf16_t*)(ws + WS_WUKV), scr, r, lane, inptr(4)); continue; } r -= I2;
            if (r < I3) { const int k0_ = 64 * (r / 32); p0_transpose_item(inptr(17), 1024, 1024, 1024, (bf16_t*)(ws + WS_WO), scr, r, lane, k0_ < 512 ? inptr(15) : inptr(16) - 512); continue; } r -= I3;
            if (r < I4) { p0_transpose_item(inptr(19), 1024, FF, FF, (bf16_t*)(ws + WS_WUP), scr, r, lane, inptr(18)); continue; } r -= I4;
            if (r < I5) { p0_transpose_item(inptr(20), FF, 1024, 1024, (bf16_t*)(ws + WS_WDN), scr, r, lane, nullptr, LDH); continue; } r -= I5;
            if (r < 2 * I6) { const int kv = r / I6; p0_transpose_item(inptr(12) + (size_t)kv * 2048 * 128, 2048, 128, 128, (bf16_t*)(ws + WS_W1T) + (size_t)kv * 128 * 2048, scr, r % I6, lane); continue; } r -= 2 * I6;
            { const int kv = r / I7; p0_transpose_item(inptr(13) + kv * 128 * 64, 128, 64, 64, (bf16_t*)(ws + WS_W2T) + kv * 64 * 128, scr, r % I7, lane); }
        }
        for (int m = gw; m < M; m += 4 * NGW) rows_to_bf16_rstd<4>(inptr(0), (bf16_t*)(ws + WS_XB), (float*)(ws + WS_RS1), m, NGW, lane);
        for (int m = bid * 512 + tid; m < M; m += G * 512) { ((float*)(ws + WS_SSQ2))[m] = 0.f; ((float*)(ws + WS_RSQ))[m] = 0.f; ((float*)(ws + WS_RSKV))[m] = 0.f; ((float*)(ws + WS_SSQM))[2 * m] = 0.f; ((float*)(ws + WS_SSQM))[2 * m + 1] = 0.f; }
    }
    xcd_barrier(bar);
    STAMP(1);
#if EXP == 1
    for (int e_ = 0; e_ < 10; ++e_) xcd_barrier(bar);
#endif
#if EXP == 10
    for (int e_ = 0; e_ < 2; ++e_)
#endif
    { pg8::Gemm g{(const bf16_t*)(ws + WS_XB), (const bf16_t*)(ws + WS_WIN), M, DINP, DM, DM, DM}; pg8::StaticOrder S; S.init(M, DINP, G, bid);
      PEpiProj E{(bf16_t*)(ws + WS_PROJ), DINP, (const float*)(ws + WS_RS1), (float*)(ws + WS_RSQ), (float*)(ws + WS_RSKV), inptr(9), inptr(10)}; pg8::gemm_phase<PEpiProj, pg8::StaticOrder, true, true>(L, g, S, E); }
    xcd_barrier(bar);
    STAMP(2);
#if EXP == 3
    for (int e_ = 0; e_ < 2; ++e_)
#endif
    { PHASE_IDS();
      __syncthreads();
      for (int t = bid; t < 256; t += G) compress_block(ws, L, t); }
    xcd_barrier(bar);
    STAMP(3);
#if EXP == 11
    for (int e_ = 0; e_ < 2; ++e_) {
#endif
    { pg8::Gemm g{(const bf16_t*)(ws + WS_PROJ) + P_HQ, (const bf16_t*)(ws + WS_WUQ), M, MQ, QR, DINP, QR}; pg8::StaticOrder S; S.init(M, MQ, G, bid);
      PEpiBf16<0> E{(bf16_t*)(ws + WS_QM), MQ, (const float*)(ws + WS_RSQ), 1.f / QR}; pg8::gemm_phase<PEpiBf16<0>, pg8::StaticOrder, true, true>(L, g, S, E); }
    { pg8::Gemm g{(const bf16_t*)(ws + WS_PROJ) + P_HKV, (const bf16_t*)(ws + WS_WUKV), M, MKV, KVR, DINP, KVR}; pg8::StaticOrder S; S.init(M, MKV, G, bid);
      PEpiBf16<0> E{(bf16_t*)(ws + WS_KVM), MKV, (const float*)(ws + WS_RSKV), 1.f / KVR}; pg8::gemm_phase<PEpiBf16<0>, pg8::StaticOrder, true, true>(L, g, S, E); }
#if EXP == 11
    }
#endif
    xcd_barrier(bar);
    STAMP(4);
#if EXP == 6
    for (int e_ = 0; e_ < 2; ++e_)
#endif
    { PHASE_IDS(); for (int m = gw; m < M; m += 4 * NGW) kpass_rows<4>(ws, m, NGW, lane); }
    xcd_barrier(bar);
    STAMP(5);
#if EXP == 2
    for (int e_ = 0; e_ < 2; ++e_)
#endif
    {
        PHASE_IDS();
        LAS float* tb = (LAS float*)L;
        for (int i = tid; i < 8 * 128; i += 512) { const int h = i >> 7, n = i & 127; tb[i] = (inptr(14)[t5_bucket(n) * 8 + h] - inptr(14)[31 * 8 + h]) * LOG2E; }
        __syncthreads();
        const int vcu = (G % 8 == 0) ? (bid % 8) * (G / 8) + bid / 8 : bid;
        for (int pr_ = vcu; pr_ < 256; pr_ += G) {
            { const int bg = pr_ >> 4, s_ = pr_ & 15;
#pragma unroll 1
              for (int u_ = 0; u_ < (EXP == 8 ? 4 : 2); ++u_) att::nsa_unit(ws, L, bg >> 1, bg & 1, (u_ & 1) ? s_ : 31 - s_);
            }
            { const int bh = pr_ >> 2, s_ = pr_ & 3;
#pragma unroll 1
              for (int u_ = 0; u_ < (EXP == 9 ? 4 : 2); ++u_) att::mla_unit(ws, L, bh >> 3, bh & 7, (u_ & 1) ? s_ : 7 - s_);
            }
        }
    }
    xcd_barrier(bar);
    STAMP(7);
    { pg8::Gemm g{(const bf16_t*)(ws + WS_MIX), (const bf16_t*)(ws + WS_WO), M, DM, DM, DM, DM}; pg8::StaticOrder S; S.init(M, DM, G, bid);
      PEpiWo E{(const bf16_t*)(ws + WS_XB), (bf16_t*)(ws + WS_H2), (float*)(ws + WS_SSQ2), (const float*)(ws + WS_SSQM), DM}; pg8::gemm_phase<PEpiWo, pg8::StaticOrder, true, true>(L, g, S, E); }
    xcd_barrier(bar);
    STAMP(9);
#if EXP == 4
    for (int e_ = 0; e_ < 2; ++e_)
#endif
    { pg8::Gemm g{(const bf16_t*)(ws + WS_H2), (const bf16_t*)(ws + WS_WUP), M, FF, DM, DM, DM}; pg8::StaticOrder S; S.init(M, FF, G, bid);
      PEpiBf16<2> E{(bf16_t*)(ws + WS_HID), LDH, (const float*)(ws + WS_SSQ2), 1.f / 1024}; pg8::gemm_phase<PEpiBf16<2>, pg8::StaticOrder, true, true>(L, g, S, E); }
    xcd_barrier(bar);
    STAMP(10);
    { pg8::Gemm g{(const bf16_t*)(ws + WS_HID), (const bf16_t*)(ws + WS_WDN), M, DM, FF, LDH, LDH}; pg8::StaticOrder S; S.init(M, DM, G, bid);
      PEpiDown E{(const bf16_t*)(ws + WS_H2), ((float*)inptr(21)), DM}; pg8::gemm_phase<PEpiDown, pg8::StaticOrder, true, true>(L, g, S, E); }
#if TS
    xcd_barrier(bar);
    if (blockIdx.x == 0 && threadIdx.x == 0) { const unsigned long long* tt = (const unsigned long long*)(ws + 29 * MiB); const float dlt = (TS == 100) ? 150.f : (float)(tt[1] - tt[0]) * (1.f / 256.f); ((float*)inptr(21))[0] += dlt; }
#endif
}

extern "C" void kernel_launch(void* const* d_in, const int* in_sizes, int n_in, void* d_out, int out_size,
                              void* d_ws, size_t ws_size, hipStream_t stream) {
    static int grid_blocks = 0;
    if (!grid_blocks) {
        int dev = 0, cus = 0, per_cu = 0;
        (void)hipGetDevice(&dev);
        (void)hipDeviceGetAttribute(&cus, hipDeviceAttributeMultiprocessorCount, dev);
        (void)hipFuncSetAttribute((const void*)mega, hipFuncAttributeMaxDynamicSharedMemorySize, LDS_BYTES);
        (void)hipOccupancyMaxActiveBlocksPerMultiprocessor(&per_cu, (const void*)mega, 512, LDS_BYTES);
        if (per_cu != 1) fprintf(stderr, "note: occupancy query reports %d blocks/CU; launching 1 per CU\n", per_cu);
        grid_blocks = cus;
        if (n_in != 21 || out_size != M * DM || ws_size < 256 * MiB) fprintf(stderr, "unexpected shapes: n_in %d out %d ws %zu\n", n_in, out_size, ws_size);
    }
    Params p{};
    for (int i = 0; i < 21; ++i) p.in[i] = (const float*)d_in[i];
    p.out = (float*)d_out; p.ws = (unsigned char*)d_ws;
    if (hipMemsetAsync((char*)d_ws + WS_CTL, 0, CTL_ZERO_BYTES, stream) != hipSuccess) { fprintf(stderr, "memset of the barrier words failed\n"); return; }
    hipLaunchKernelGGL(mega, dim3(grid_blocks), dim3(512), LDS_BYTES, stream, p);
    hipError_t e = hipPeekAtLastError();
    if (e != hipSuccess) fprintf(stderr, "launch failed: %s (grid %d)\n", hipGetErrorString(e), grid_blocks);
}
```

```cpp
#ifndef EXP
#define EXP 0
#endif
#ifndef TS
#define TS 0
#endif
#include <hip/hip_runtime.h>
#include <cstdio>
#include <cstdint>

#define LAS __attribute__((address_space(3)))
typedef unsigned short bf16_t;
typedef short bf16x8 __attribute__((ext_vector_type(8)));
typedef float f32x4 __attribute__((ext_vector_type(4)));
typedef unsigned u32x4 __attribute__((ext_vector_type(4)));
typedef unsigned u32x2 __attribute__((ext_vector_type(2)));

constexpr int BATCH = 8, SEQ = 2048, DM = 1024, M = BATCH * SEQ;
constexpr int DIN = 1976, DINP = 2048;
constexpr int C_HQ = 0, C_HKV = 384, C_HKR = 640, C_QB = 672, C_KVB = 1184, C_GATE = 1952;
constexpr int C_KCMP = C_KVB, C_VCMP = C_KVB + 128, C_KSEL = C_KVB + 256, C_VSEL = C_KVB + 384, C_KWIN = C_KVB + 512, C_VWIN = C_KVB + 640;
constexpr int P_HQ = 1280, P_HKV = 1664, P_HKR = 1920, P_GATE = 1952;
__host__ __device__ constexpr int slot_base(int s) { return 256 * (s >> 2) + 32 * (s & 3); }
constexpr int S_Q = 0, S_KCMP = 8, S_VCMP = 10, S_KSEL = 12, S_VSEL = 14, S_KWIN = 16, S_VWIN = 18;
constexpr int QR = 384, KVR = 256, MQ = 768, MKV = 1024, FF = 4096;
constexpr int LDH = FF + 64;
constexpr int NCMP = 127;
constexpr float EPS = 1e-6f;
constexpr float LOG2E = 1.4426950408889634f;
constexpr float QS_MLA = 0.10206207261596577f * LOG2E;
constexpr float QS_NSA = 0.125f * LOG2E;

constexpr size_t MiB = 1u << 20;
constexpr size_t WS_CTL = 0, CTL_ZERO_BYTES = 65536;
constexpr size_t WS_WIN = 1 * MiB, WS_WUQ = 5 * MiB, WS_WUKV = 6 * MiB, WS_WO = 7 * MiB, WS_WUP = 9 * MiB, WS_WDN = 17 * MiB;
constexpr size_t WS_KCMP = 26 * MiB, WS_VCMP = 26 * MiB + 512 * 1024;
constexpr size_t WS_W1T = 30 * MiB;
constexpr size_t WS_W2T = 27 * MiB;
constexpr size_t WS_RSQ = 28 * MiB, WS_RSKV = 28 * MiB + 65536, WS_SSQ2 = 28 * MiB + 131072, WS_SSQM = 28 * MiB + 262144, WS_RS1 = 28 * MiB + 262144 + 131072;
constexpr size_t WS_SSQKR = 28 * MiB + 524288;
constexpr size_t WS_ROPE = 29 * MiB + 65536;
constexpr size_t WS_XB = 32 * MiB;
constexpr size_t WS_DUMMY0 = 0;
constexpr size_t WS_HB = 32 * MiB;
constexpr size_t WS_MIX = 64 * MiB;
constexpr size_t WS_PROJ = 96 * MiB;
constexpr size_t WS_QM = 160 * MiB;
constexpr size_t WS_KVM = 184 * MiB;
constexpr size_t WS_KMLA = 216 * MiB;
constexpr size_t WS_QN = 208 * MiB;
constexpr size_t WS_KSEL = 240 * MiB;
constexpr size_t WS_KWIN = 244 * MiB;
constexpr size_t WS_HQN = 232 * MiB;
constexpr size_t WS_HKVN = 244 * MiB;
constexpr size_t WS_H2 = 224 * MiB;
constexpr size_t WS_HID = 32 * MiB;

constexpr int LDS_BYTES = 155648, LDS_BST = 154624;
constexpr int NW = 8;

struct Params {
    const float* in[21];
    float* out;
    unsigned char* ws;
};

typedef const float* cfptr_t;
__device__ __forceinline__ const float* inptr(int i) {
    const __attribute__((address_space(4))) char* ka = (const __attribute__((address_space(4))) char*)__builtin_amdgcn_kernarg_segment_ptr();
    int off = i * 8; asm volatile("" : "+s"(off));
    return *(const __attribute__((address_space(4))) cfptr_t*)(ka + off);
}
__device__ __forceinline__ unsigned f2bf(float f) { unsigned u = __builtin_bit_cast(unsigned, f); return (u + 0x7fffu + ((u >> 16) & 1u)) >> 16; }
__device__ __forceinline__ float bf2f(unsigned b) { return __builtin_bit_cast(float, b << 16); }
__device__ __forceinline__ unsigned pk2(float lo, float hi) { return f2bf(lo) | (f2bf(hi) << 16); }
__device__ __forceinline__ float wave_sum(float v) {
#pragma unroll
    for (int o = 1; o < 64; o <<= 1) v += __shfl_xor(v, o);
    return v;
}
__device__ __forceinline__ float wave_max(float v) {
#pragma unroll
    for (int o = 1; o < 64; o <<= 1) v = fmaxf(v, __shfl_xor(v, o));
    return v;
}
__device__ __forceinline__ int t5_bucket(int n) {
    if (n < 16) return n;
    int b = 16;
    b += (n >= 19); b += (n >= 21); b += (n >= 24); b += (n >= 27); b += (n >= 31); b += (n >= 35); b += (n >= 40); b += (n >= 46);
    b += (n >= 52); b += (n >= 59); b += (n >= 67); b += (n >= 77); b += (n >= 87); b += (n >= 99); b += (n >= 113);
    return b;
}

__device__ __forceinline__ void p0_transpose_item(const float* W, int K, int N, int Npad, bf16_t* WT, LAS float* scr, int item, int lane, const float* gk = nullptr, int ldw = 0, int projmap = 0) {
    const int nblk = Npad / 32, kb = item / nblk, nb = item % nblk, k0 = 64 * kb, n0 = 32 * nb;
    int nsrc = n0;
    if (projmap == 2) { const int pn_ = n0 >> 8, bj_ = (n0 >> 7) & 1, wc_ = (n0 >> 5) & 3; nsrc = (wc_ < 2 ? 128 * (2 * pn_ + wc_) : 128 * (2 * pn_ + wc_ - 2) + 64) + 32 * bj_; }
    else if (projmap) { if (n0 < 1280) { const int sl = 4 * (n0 >> 8) + ((n0 & 127) >> 5), e0 = 32 * ((n0 >> 7) & 1); nsrc = (sl < 8 ? C_QB + 64 * sl : C_KVB + 64 * (sl - 8)) + e0; }
                   else if (n0 < 1280 + 672) nsrc = n0 - 1280; else if (n0 == P_GATE) nsrc = C_GATE; else nsrc = N; }
    const int nn = nsrc + (lane & 31);
    float wv[32];
#pragma unroll
    for (int i = 0; i < 32; ++i) { const int kk = 2 * i + (lane >> 5); wv[i] = (nn < N) ? W[(size_t)(k0 + kk) * N + nn] : 0.f; }
#pragma unroll
    for (int i = 0; i < 32; ++i) { const int kk = 2 * i + (lane >> 5); const float gg = gk ? gk[k0 + kk] : 1.f; scr[kk * 33 + (lane & 31)] = wv[i] * gg; }
    asm volatile("s_waitcnt lgkmcnt(0)" ::: "memory");
    const int c = lane & 7;
#pragma unroll
    for (int j = 0; j < 4; ++j) { const int n = (lane >> 3) + 8 * j; const LAS float* s = scr + (8 * c) * 33 + n;
        u32x4 o; o.x = pk2(s[0 * 33], s[1 * 33]); o.y = pk2(s[2 * 33], s[3 * 33]); o.z = pk2(s[4 * 33], s[5 * 33]); o.w = pk2(s[6 * 33], s[7 * 33]);
        *(u32x4*)(WT + (size_t)(n0 + n) * (ldw ? ldw : K) + k0 + 8 * c) = o; }
    asm volatile("s_waitcnt lgkmcnt(0)" ::: "memory");
}
template <int NR>
__device__ __forceinline__ void rows_to_bf16_rstd(const float* x, bf16_t* o, float* rstd_out, int row0, int rstride, int lane) {
    f32x4 v[NR][4];
#pragma unroll
    for (int r = 0; r < NR; ++r) { const int rr = (row0 + r * rstride < M) ? row0 + r * rstride : row0; const f32x4* xr = (const f32x4*)(x + (size_t)rr * DM) + lane;
#pragma unroll
        for (int j = 0; j < 4; ++j) v[r][j] = xr[64 * j]; }
#pragma unroll
    for (int r = 0; r < NR; ++r) { if (row0 + r * rstride >= M) continue; float s = 0.f;
#pragma unroll
        for (int j = 0; j < 4; ++j) s += (v[r][j].x * v[r][j].x + v[r][j].y * v[r][j].y) + (v[r][j].z * v[r][j].z + v[r][j].w * v[r][j].w);
        s = wave_sum(s);
        if (lane == 0) rstd_out[row0 + r * rstride] = 1.f / sqrtf(s * (1.f / DM) + EPS);
        unsigned long long* o8 = (unsigned long long*)(o + (size_t)(row0 + r * rstride) * DM) + lane;
#pragma unroll
        for (int j = 0; j < 4; ++j) o8[64 * j] = (unsigned long long)pk2(v[r][j].x, v[r][j].y) | ((unsigned long long)pk2(v[r][j].z, v[r][j].w) << 32); }
}

__device__ __forceinline__ int opaque_tid(int wv) { int lane; asm volatile("v_mbcnt_lo_u32_b32 %0, -1, 0\n\tv_mbcnt_hi_u32_b32 %0, -1, %0" : "=v"(lane)); return (wv << 6) | lane; }
namespace pg8 {
#define PG8_LAS __attribute__((address_space(3)))
typedef unsigned short bf16_t;
typedef short bf16x8 __attribute__((ext_vector_type(8)));
typedef float f32x4 __attribute__((ext_vector_type(4)));
typedef unsigned u32x4 __attribute__((ext_vector_type(4)));
constexpr int BM = 256, BK = 64, HALF = 128, HTB = HALF * BK * 2  , STAGE_BYTES = 8 * HTB, NXCD = 8, WGM = 8;

__host__ __device__ __forceinline__ int lds_byte(int r, int c) { const int st = (r >> 4) * 2 + (c >> 5), rr = r & 15, cc = c & 31, ob = rr * 64 + cc * 2; return st * 1024 + (ob ^ (((ob >> 9) & 1) << 5)); }
__host__ __device__ __forceinline__ void stage_rc(int b, int& R, int& C) { const int st = b / 1024, sb = b % 1024, swz = sb ^ (((sb >> 9) & 1) << 5); R = (st >> 1) * 16 + swz / 64; C = (st & 1) * 32 + (swz % 64) / 2; }
__host__ __device__ __forceinline__ int perm32(int rho) { const int n = rho >> 4, i = rho & 15; return 8 * (i >> 2) + 4 * n + (i & 3); }

struct Unit { int pm, pn; };
struct Gemm { const bf16_t* A; const bf16_t* Bt; int M, N, K, lda, ldb; };

struct StaticOrder {
    int nM, nN, nwg, G, c;
    __host__ __device__ void init(int M, int N, int G_, int c_) { nM = M / BM; nN = N / BM; nwg = nM * nN; G = G_; c = c_; }
    __host__ __device__ bool next(int i, Unit& u) const {
        const long L = (long)i * G + c; if (L >= nwg) return false;
        int wgid = (int)L; { const int q = nwg / NXCD, r = nwg % NXCD, xcd = wgid % NXCD, off = wgid / NXCD; wgid = (xcd < r ? xcd * (q + 1) : r * (q + 1) + (xcd - r) * q) + off; }
        const int nig = WGM * nN, gid = wgid / nig, fm = gid * WGM, gsz = (nM - fm) < WGM ? (nM - fm) : WGM;
        u.pm = fm + ((wgid % nig) % gsz); u.pn = (wgid % nig) / gsz; return true;
    }
    __device__ __forceinline__ void a_ready(const Unit&) const {}
    __device__ __forceinline__ void done(const Unit&) const {}
};

template <class Epi, class Sched, bool ALIGN_EPI = false, bool SP2 = false>
__device__ __forceinline__ void gemm_phase(PG8_LAS unsigned char* lds, const Gemm g, const Sched& S, const Epi& E, int wv) {
    const int tid = opaque_tid(wv), wid = __builtin_amdgcn_readfirstlane(tid >> 6), lane = tid & 63, wr = wid >> 2, wc = wid & 3, fr = lane & 15, fq = lane >> 4;
    const int K = g.K, nt = K / BK;
    unsigned voffA[2], voffB[2];
#pragma unroll
    for (int i = 0; i < 2; ++i) { int R, C; stage_rc(tid * 16 + i * 8192, R, C); const int Rb = Epi::PERM ? ((R & ~31) + perm32(R & 31)) : R;
        voffA[i] = (unsigned)(R * g.lda + C) * 2u; voffB[i] = (unsigned)(Rb * g.ldb + C) * 2u; }
    const size_t kstep = (size_t)(BK * 2);
    const size_t hstepA = (size_t)HALF * g.lda * 2, hstepB = (size_t)HALF * g.ldb * 2;
    const size_t tstepA = 2 * hstepA, tstepB = 2 * hstepB;
    const unsigned ldsw = (unsigned)wid * 1024u;
    const int aoff = lds_byte(wr * 64 + fr, fq * 8), boff = lds_byte(wc * 32 + fr, fq * 8);
#define PG8_SA(b, h) (((b) * 2 + (h)) * HTB)
#define PG8_SB(b, h) ((4 + (b) * 2 + (h)) * HTB)
#define PG8_STAGE(bufoff, gbase, voff) do { _Pragma("unroll") for (int _i = 0; _i < 2; ++_i) \
        __builtin_amdgcn_global_load_lds((const unsigned*)((const char*)(gbase) + (voff)[_i]), (PG8_LAS unsigned*)(lds + (bufoff) + ldsw + _i * 8192), 16, 0, 0); } while (0)
#define PG8_LDA(dst, b, h) do { _Pragma("unroll") for (int m = 0; m < 4; ++m) _Pragma("unroll") for (int k = 0; k < 2; ++k) dst[m][k] = *(const PG8_LAS bf16x8*)(lds + PG8_SA(b, h) + aoff + m * 2048 + k * 1024); } while (0)
#define PG8_LDB(dst, b, h) do { _Pragma("unroll") for (int n = 0; n < 2; ++n) _Pragma("unroll") for (int k = 0; k < 2; ++k) dst[n][k] = *(const PG8_LAS bf16x8*)(lds + PG8_SB(b, h) + boff + n * 2048 + k * 1024); } while (0)
#define PG8_MMA(ai, bj, At, Bt) do { __builtin_amdgcn_s_setprio(1); _Pragma("unroll") for (int m = 0; m < 4; ++m) _Pragma("unroll") for (int n = 0; n < 2; ++n) _Pragma("unroll") for (int k = 0; k < 2; ++k) \
        acc[ai][bj][m][n] = __builtin_amdgcn_mfma_f32_16x16x32_bf16(Bt[n][k], At[m][k], acc[ai][bj][m][n], 0, 0, 0); __builtin_amdgcn_s_setprio(0); } while (0)
#define PG8_WAIT_V(n) asm volatile("s_waitcnt vmcnt(" #n ")" ::: "memory")
#define PG8_WAIT_L(n) asm volatile("s_waitcnt lgkmcnt(" #n ")" ::: "memory")
#define PG8_BAR __builtin_amdgcn_s_barrier()
#define PG8_SCHED __builtin_amdgcn_sched_barrier(0)
    Unit cur, nxt; int ui = 0;
    if (!S.next(0, cur)) return;
    f32x4 acc[2][2][4][2];
#pragma unroll
    for (int a = 0; a < 2; ++a)
#pragma unroll
        for (int b = 0; b < 2; ++b)
#pragma unroll
            for (int m = 0; m < 4; ++m)
#pragma unroll
                for (int n = 0; n < 2; ++n) acc[a][b][m][n] = (f32x4){0.f, 0.f, 0.f, 0.f};
    bf16x8 At[4][2], B0[2][2], B1[2][2];
    const char* cA = (const char*)g.A + (size_t)cur.pm * tstepA; const char* cB = (const char*)g.Bt + (size_t)cur.pn * tstepB;
    asm volatile("" : "+s"(cA), "+s"(cB));
    S.a_ready(cur);
    if constexpr (SP2) {
        PG8_STAGE(PG8_SB(0, 0), cB, voffB); PG8_STAGE(PG8_SB(0, 1), cB + hstepB, voffB); PG8_STAGE(PG8_SA(0, 0), cA, voffA); PG8_STAGE(PG8_SA(0, 1), cA + hstepA, voffA);
        if (wr == 1) PG8_BAR;
        PG8_WAIT_V(2); PG8_BAR;
        PG8_STAGE(PG8_SB(1, 0), cB + kstep, voffB); PG8_STAGE(PG8_SA(1, 0), cA + kstep, voffA); PG8_STAGE(PG8_SB(1, 1), cB + hstepB + kstep, voffB);
        PG8_WAIT_V(6); PG8_BAR;
    } else {
        PG8_STAGE(PG8_SB(0, 0), cB, voffB); PG8_STAGE(PG8_SA(0, 0), cA, voffA); PG8_STAGE(PG8_SB(0, 1), cB + hstepB, voffB); PG8_STAGE(PG8_SA(0, 1), cA + hstepA, voffA);
        if (wr == 1) PG8_BAR;
        PG8_WAIT_V(4); PG8_BAR;
        PG8_STAGE(PG8_SB(1, 0), cB + kstep, voffB); PG8_STAGE(PG8_SA(1, 0), cA + kstep, voffA); PG8_STAGE(PG8_SB(1, 1), cB + hstepB + kstep, voffB);
        PG8_WAIT_V(6); PG8_BAR;
    }
    for (;;) {
        const bool has_next = S.next(ui + 1, nxt);
        const char* nA = has_next ? (const char*)g.A + (size_t)nxt.pm * tstepA : cA; const char* nB = has_next ? (const char*)g.Bt + (size_t)nxt.pn * tstepB : cB;
        asm volatile("" : "+s"(nA), "+s"(nB));
        for (int t = 0; t < nt; t += 2) {
            if constexpr (Epi::MIDSCALE) { if (t == nt / 2) E.midscale(acc, cur, wr, fr); }
            const bool last = (t == nt - 2);
            const char* a1 = cA + (size_t)(t + 1) * kstep;
            const char* a2 = last ? nA : cA + (size_t)(t + 2) * kstep; const char* b2 = last ? nB : cB + (size_t)(t + 2) * kstep;
            const char* a3 = a2 + kstep; const char* b3 = b2 + kstep;
            asm volatile("" : "+s"(a1), "+s"(a2), "+s"(b2), "+s"(a3), "+s"(b3));
            if (last && has_next) S.a_ready(nxt);
            if constexpr (SP2) {
            PG8_LDB(B0, 0, 0); PG8_LDB(B1, 0, 1); PG8_SCHED; PG8_LDA(At, 0, 0); PG8_STAGE(PG8_SA(1, 1), a1 + hstepA, voffA);
            PG8_WAIT_V(8); PG8_WAIT_L(0); PG8_BAR; PG8_MMA(0, 0, At, B0); PG8_MMA(0, 1, At, B1); PG8_BAR; PG8_SCHED;
            PG8_LDA(At, 0, 1); PG8_STAGE(PG8_SB(0, 0), b2, voffB); PG8_STAGE(PG8_SB(0, 1), b2 + hstepB, voffB); PG8_STAGE(PG8_SA(0, 0), a2, voffA);
            PG8_WAIT_V(8); PG8_WAIT_L(0); PG8_BAR; PG8_MMA(1, 0, At, B0); PG8_MMA(1, 1, At, B1); PG8_BAR; PG8_SCHED;
            PG8_LDB(B0, 1, 0); PG8_LDB(B1, 1, 1); PG8_SCHED; PG8_LDA(At, 1, 0); PG8_STAGE(PG8_SA(0, 1), a2 + hstepA, voffA);
            PG8_WAIT_V(8); PG8_WAIT_L(0); PG8_BAR; PG8_MMA(0, 0, At, B0); PG8_MMA(0, 1, At, B1); PG8_BAR; PG8_SCHED;
            PG8_LDA(At, 1, 1); PG8_STAGE(PG8_SB(1, 0), b3, voffB); PG8_STAGE(PG8_SB(1, 1), b3 + hstepB, voffB); PG8_STAGE(PG8_SA(1, 0), a3, voffA);
            PG8_WAIT_V(8); PG8_WAIT_L(0); PG8_BAR; PG8_MMA(1, 0, At, B0); PG8_MMA(1, 1, At, B1); PG8_BAR; PG8_SCHED;
            } else {
            PG8_LDB(B0, 0, 0); PG8_SCHED; PG8_LDA(At, 0, 0); PG8_STAGE(PG8_SA(1, 1), a1 + hstepA, voffA);
            PG8_WAIT_L(8); PG8_BAR; PG8_WAIT_L(0); PG8_MMA(0, 0, At, B0); PG8_BAR; PG8_SCHED;
            PG8_LDB(B1, 0, 1); PG8_STAGE(PG8_SB(0, 0), b2, voffB);
            PG8_BAR; PG8_WAIT_L(0); PG8_MMA(0, 1, At, B1); PG8_BAR;
            PG8_LDA(At, 0, 1); PG8_STAGE(PG8_SA(0, 0), a2, voffA);
            PG8_BAR; PG8_WAIT_L(0); PG8_MMA(1, 0, At, B0); PG8_BAR; PG8_SCHED;
            PG8_STAGE(PG8_SB(0, 1), b2 + hstepB, voffB);
            PG8_WAIT_V(6); PG8_BAR; PG8_MMA(1, 1, At, B1); PG8_BAR;
            PG8_LDB(B0, 1, 0); PG8_SCHED; PG8_LDA(At, 1, 0); PG8_STAGE(PG8_SA(0, 1), a2 + hstepA, voffA);
            PG8_WAIT_L(8); PG8_BAR; PG8_WAIT_L(0); PG8_MMA(0, 0, At, B0); PG8_BAR; PG8_SCHED;
            PG8_LDB(B1, 1, 1); PG8_STAGE(PG8_SB(1, 0), b3, voffB);
            PG8_BAR; PG8_WAIT_L(0); PG8_MMA(0, 1, At, B1); PG8_BAR;
            PG8_LDA(At, 1, 1); PG8_STAGE(PG8_SA(1, 0), a3, voffA);
            PG8_BAR; PG8_WAIT_L(0); PG8_MMA(1, 0, At, B0); PG8_BAR; PG8_SCHED;
            PG8_STAGE(PG8_SB(1, 1), b3 + hstepB, voffB);
            PG8_WAIT_V(6); PG8_BAR; PG8_MMA(1, 1, At, B1); PG8_BAR;
            }
        }
        if constexpr (ALIGN_EPI) { if (wr == 0) PG8_BAR; }
        if constexpr (!Epi::AFTER_DRAIN) { const int l2_ = opaque_tid(wv) & 63; E(acc, cur, wr, wc, l2_ & 15, l2_ >> 4); S.done(cur); }
        if (!has_next) break;
#pragma unroll
        for (int a = 0; a < 2; ++a)
#pragma unroll
            for (int b = 0; b < 2; ++b)
#pragma unroll
                for (int m = 0; m < 4; ++m)
#pragma unroll
                    for (int n = 0; n < 2; ++n) acc[a][b][m][n] = (f32x4){0.f, 0.f, 0.f, 0.f};
        cur = nxt; cA = nA; cB = nB; ++ui;
        if constexpr (ALIGN_EPI) { if (wr == 1) PG8_BAR; }
    }
    PG8_WAIT_V(0);
    if constexpr (!ALIGN_EPI) { if (wr == 0) PG8_BAR; }
    PG8_BAR;
    if constexpr (Epi::AFTER_DRAIN) { E.fused(acc, cur, wr, wc, fr, fq, lds, wid, lane); S.done(cur); }
#undef PG8_SA
#undef PG8_SB
#undef PG8_STAGE
#undef PG8_LDA
#undef PG8_LDB
#undef PG8_MMA
#undef PG8_WAIT_V
#undef PG8_WAIT_L
#undef PG8_BAR
#undef PG8_SCHED
}
}

__device__ __forceinline__ unsigned cvt_pk_bf16(float lo, float hi) { unsigned r; asm volatile("v_cvt_pk_bf16_f32 %0, %1, %2" : "=v"(r) : "v"(lo), "v"(hi)); return r; }
template <int ACT> struct PEpiBf16 {
    static constexpr bool PERM = true, AFTER_DRAIN = false, MIDSCALE = false;
    bf16_t* O; int ldc; const float* rs; float invn;
    __device__ __forceinline__ void operator()(const f32x4 (&acc)[2][2][4][2], const pg8::Unit& u, int wr, int wc, int fr, int fq) const {
        const int row0 = u.pm * 256 + wr * 64 + fr, col0 = u.pn * 256 + wc * 32 + 8 * fq;
        float rsc[2][4];
#pragma unroll
        for (int ai = 0; ai < 2; ++ai)
#pragma unroll
            for (int m = 0; m < 4; ++m) rsc[ai][m] = rs ? rs[row0 + ai * 128 + m * 16] : 1.f;
        if (invn > 0.f) {
#pragma unroll
            for (int ai = 0; ai < 2; ++ai)
#pragma unroll
                for (int m = 0; m < 4; ++m) rsc[ai][m] = 1.f / sqrtf(rsc[ai][m] * invn + EPS); }
#pragma unroll
        for (int ai = 0; ai < 2; ++ai)
#pragma unroll
            for (int m = 0; m < 4; ++m) { bf16_t* rowp = O + (size_t)(row0 + ai * 128 + m * 16) * ldc + col0; const float sc_ = rsc[ai][m];
#pragma unroll
                for (int bj = 0; bj < 2; ++bj) { f32x4 v0 = acc[ai][bj][m][0] * sc_, v1 = acc[ai][bj][m][1] * sc_;
                    if (ACT == 2) {
#pragma unroll
                        for (int e = 0; e < 4; ++e) { const float a = fmaxf(v0[e], 0.f), b = fmaxf(v1[e], 0.f); v0[e] = a * a; v1[e] = b * b; } }
                    u32x4 w; w.x = cvt_pk_bf16(v0[0], v0[1]); w.y = cvt_pk_bf16(v0[2], v0[3]); w.z = cvt_pk_bf16(v1[0], v1[1]); w.w = cvt_pk_bf16(v1[2], v1[3]);
                    *(u32x4*)(rowp + bj * 128) = w; } }
    }
};
struct PEpiProj {
    static constexpr bool PERM = true, AFTER_DRAIN = false, MIDSCALE = false;
    bf16_t* O; int ldc; const float* rs1; float* ssq_q; float* ssq_kv; float* ssq_kr; const float* qgain; const float* kgain; const float* rope; const float* kgm;
    __device__ __forceinline__ void operator()(const f32x4 (&acc)[2][2][4][2], const pg8::Unit& u, int wr, int wc, int fr, int fq) const {
        const int row0 = u.pm * 256 + wr * 64 + fr, col0 = u.pn * 256 + wc * 32 + 8 * fq, lane = fq * 16 + fr;
        float rsc[2][4];
#pragma unroll
        for (int ai = 0; ai < 2; ++ai)
#pragma unroll
            for (int m = 0; m < 4; ++m) rsc[ai][m] = rs1[row0 + ai * 128 + m * 16];
        const int sl = 4 * u.pn + wc;
        int mode = 0; const float* g = nullptr; float gs = 1.f;
        if (u.pn < 5) { if (sl < 8) { mode = 1; g = qgain; gs = QS_NSA; } else if (sl == S_KSEL || sl == S_KSEL + 1) { mode = 1; g = kgain + 64; } else if (sl == S_KWIN || sl == S_KWIN + 1) { mode = 1; g = kgain + 128; } }
        f32x4 ga[2][2];
        if (mode == 1) {
#pragma unroll
            for (int bj = 0; bj < 2; ++bj) { ga[bj][0] = *(const f32x4*)(g + 32 * bj + 8 * fq) * gs; ga[bj][1] = *(const f32x4*)(g + 32 * bj + 8 * fq + 4) * gs; } }
#pragma unroll
        for (int ai = 0; ai < 2; ++ai)
#pragma unroll
            for (int m = 0; m < 4; ++m) { const int row = row0 + ai * 128 + m * 16; bf16_t* rowp = O + (size_t)row * ldc + col0; const float sc_ = rsc[ai][m];
                f32x4 v[2][2];
#pragma unroll
                for (int bj = 0; bj < 2; ++bj) { v[bj][0] = acc[ai][bj][m][0] * sc_; v[bj][1] = acc[ai][bj][m][1] * sc_; }
                if (mode == 1) {
                    float ss = 0.f;
#pragma unroll
                    for (int bj = 0; bj < 2; ++bj)
#pragma unroll
                        for (int n = 0; n < 2; ++n) ss += (v[bj][n][0] * v[bj][n][0] + v[bj][n][1] * v[bj][n][1]) + (v[bj][n][2] * v[bj][n][2] + v[bj][n][3] * v[bj][n][3]);
                    ss += __builtin_bit_cast(float, __builtin_amdgcn_ds_bpermute((lane ^ 16) << 2, __builtin_bit_cast(int, ss)));
                    ss += __builtin_bit_cast(float, __builtin_amdgcn_ds_bpermute((lane ^ 32) << 2, __builtin_bit_cast(int, ss)));
                    const float rstd = 1.f / sqrtf(ss * (1.f / 64) + EPS);
#pragma unroll
                    for (int bj = 0; bj < 2; ++bj) { v[bj][0] = v[bj][0] * rstd * ga[bj][0]; v[bj][1] = v[bj][1] * rstd * ga[bj][1]; }
                } else if (u.pn >= 5) {
#pragma unroll
                    for (int bj = 0; bj < 2; ++bj) { const int cb = u.pn * 256 + bj * 128;
                        float* dst = (cb < P_HKV) ? ssq_q : (cb < P_HKR ? ssq_kv : ((cb == P_HKR && wc == 0) ? ssq_kr : nullptr));
                        if (dst) { float ss = (v[bj][0][0] * v[bj][0][0] + v[bj][0][1] * v[bj][0][1]) + (v[bj][0][2] * v[bj][0][2] + v[bj][0][3] * v[bj][0][3]) + (v[bj][1][0] * v[bj][1][0] + v[bj][1][1] * v[bj][1][1]) + (v[bj][1][2] * v[bj][1][2] + v[bj][1][3] * v[bj][1][3]);
                            ss += __builtin_bit_cast(float, __builtin_amdgcn_ds_bpermute((lane ^ 16) << 2, __builtin_bit_cast(int, ss)));
                            ss += __builtin_bit_cast(float, __builtin_amdgcn_ds_bpermute((lane ^ 32) << 2, __builtin_bit_cast(int, ss)));
                            if (fq == 0) __hip_atomic_fetch_add(dst + row, ss, __ATOMIC_RELAXED, __HIP_MEMORY_SCOPE_AGENT); }
                        if (cb == P_HKR && wc == 0) {
                            const f32x4 g0 = *(const f32x4*)(kgm + 64 + 8 * fq), g1 = *(const f32x4*)(kgm + 64 + 8 * fq + 4);
                            const float* rp = rope + (size_t)(row & (SEQ - 1)) * 32 + 8 * (fq & 1);
                            const f32x4 c0 = *(const f32x4*)rp, c1 = *(const f32x4*)(rp + 4), s0 = *(const f32x4*)(rp + 16), s1 = *(const f32x4*)(rp + 20);
#pragma unroll
                            for (int n = 0; n < 2; ++n)
#pragma unroll
                                for (int j = 0; j < 4; ++j) { const float nv = v[bj][n][j] * (n ? g1[j] : g0[j]);
                                    const float pv = __builtin_bit_cast(float, __builtin_amdgcn_ds_bpermute((lane ^ 32) << 2, __builtin_bit_cast(int, nv)));
                                    const float cs = n ? c1[j] : c0[j], sn = n ? s1[j] : s0[j]; v[bj][n][j] = (fq < 2) ? nv * cs - pv * sn : nv * cs + pv * sn; } } }
                }
#pragma unroll
                for (int bj = 0; bj < 2; ++bj) { u32x4 w; w.x = cvt_pk_bf16(v[bj][0][0], v[bj][0][1]); w.y = cvt_pk_bf16(v[bj][0][2], v[bj][0][3]); w.z = cvt_pk_bf16(v[bj][1][0], v[bj][1][1]); w.w = cvt_pk_bf16(v[bj][1][2], v[bj][1][3]);
                    *(u32x4*)(rowp + bj * 128) = w; } }
    }
};
struct PEpiKV {
    static constexpr bool PERM = true, AFTER_DRAIN = false, MIDSCALE = false;
    bf16_t* V; bf16_t* K; const bf16_t* proj; const float* ssq_kv; const float* ssq_kr; const float* rope; const float* kgain;
    __device__ __forceinline__ void operator()(const f32x4 (&acc)[2][2][4][2], const pg8::Unit& u, int wr, int wc, int fr_, int fq_) const {
        int fr = fr_, fq = fq_; asm volatile("" : "+v"(fr), "+v"(fq)); const float* kgain = this->kgain; asm volatile("" : "+s"(kgain)); const float* rope = this->rope; asm volatile("" : "+s"(rope));
        const int row0 = u.pm * 256 + wr * 64 + fr, lane = fq * 16 + fr;
        float rsc[2][4];
#pragma unroll
        for (int ai = 0; ai < 2; ++ai)
#pragma unroll
            for (int m = 0; m < 4; ++m) rsc[ai][m] = 1.f / sqrtf(ssq_kv[row0 + ai * 128 + m * 16] * (1.f / KVR) + EPS);
        if (wc >= 2) {
            const int col0 = u.pn * 256 + wc * 32 + 8 * fq;
#pragma unroll
            for (int ai = 0; ai < 2; ++ai)
#pragma unroll
                for (int m = 0; m < 4; ++m) { bf16_t* rowp = V + (size_t)(row0 + ai * 128 + m * 16) * MKV + col0; const float sc_ = rsc[ai][m];
#pragma unroll
                    for (int bj = 0; bj < 2; ++bj) { const f32x4 v0 = acc[ai][bj][m][0] * sc_, v1 = acc[ai][bj][m][1] * sc_;
                        u32x4 w; w.x = cvt_pk_bf16(v0[0], v0[1]); w.y = cvt_pk_bf16(v0[2], v0[3]); w.z = cvt_pk_bf16(v1[0], v1[1]); w.w = cvt_pk_bf16(v1[2], v1[3]);
                        *(u32x4*)(rowp + bj * 128) = w; } }
            return;
        }
        const int hh = 2 * u.pn + wc;
#pragma unroll
        for (int ai = 0; ai < 2; ++ai)
#pragma unroll
            for (int m = 0; m < 4; ++m) { const int row = row0 + ai * 128 + m * 16; const float sc_ = rsc[ai][m];
                bf16_t* ko = K + (size_t)row * MQ + 96 * hh;
                float rstd;
                {
                    f32x4 v[2][2]; float ss = 0.f;
#pragma unroll
                    for (int bj = 0; bj < 2; ++bj)
#pragma unroll
                        for (int n = 0; n < 2; ++n) { v[bj][n] = acc[ai][bj][m][n] * sc_; ss += (v[bj][n][0] * v[bj][n][0] + v[bj][n][1] * v[bj][n][1]) + (v[bj][n][2] * v[bj][n][2] + v[bj][n][3] * v[bj][n][3]); }
                    ss += __builtin_bit_cast(float, __builtin_amdgcn_ds_bpermute((lane ^ 16) << 2, __builtin_bit_cast(int, ss)));
                    ss += __builtin_bit_cast(float, __builtin_amdgcn_ds_bpermute((lane ^ 32) << 2, __builtin_bit_cast(int, ss)));
                    rstd = 1.f / sqrtf((ss + ssq_kr[row]) * (1.f / 96) + EPS);
#pragma unroll
                    for (int bj = 0; bj < 2; ++bj) { const f32x4 g0 = *(const f32x4*)(kgain + 32 * bj + 8 * fq), g1 = *(const f32x4*)(kgain + 32 * bj + 8 * fq + 4);
                        const f32x4 a = v[bj][0] * rstd * g0, b = v[bj][1] * rstd * g1;
                        u32x4 w; w.x = cvt_pk_bf16(a[0], a[1]); w.y = cvt_pk_bf16(a[2], a[3]); w.z = cvt_pk_bf16(b[0], b[1]); w.w = cvt_pk_bf16(b[2], b[3]);
                        *(u32x4*)(ko + 32 * bj + 8 * fq) = w; }
                }
                asm volatile("" ::: "memory");
                {
                    const bf16x8 kr8 = *(const bf16x8*)(proj + (size_t)row * DINP + P_HKR + 8 * fq);
                    u32x4 w; w.x = cvt_pk_bf16(bf2f((unsigned short)kr8[0]) * rstd, bf2f((unsigned short)kr8[1]) * rstd); w.y = cvt_pk_bf16(bf2f((unsigned short)kr8[2]) * rstd, bf2f((unsigned short)kr8[3]) * rstd);
                    w.z = cvt_pk_bf16(bf2f((unsigned short)kr8[4]) * rstd, bf2f((unsigned short)kr8[5]) * rstd); w.w = cvt_pk_bf16(bf2f((unsigned short)kr8[6]) * rstd, bf2f((unsigned short)kr8[7]) * rstd);
                    *(u32x4*)(ko + 64 + 8 * fq) = w;
                }
                asm volatile("" ::: "memory"); }
    }
};
struct PEpiResF32 {
    static constexpr bool PERM = false, AFTER_DRAIN = false, MIDSCALE = false;
    const float* base; float* out; int ldc;
    __device__ __forceinline__ void operator()(const f32x4 (&acc)[2][2][4][2], const pg8::Unit& u, int wr, int wc, int fr, int fq) const {
        const int col0 = u.pn * 256 + wc * 32 + 4 * fq;
#pragma unroll
        for (int ai = 0; ai < 2; ++ai)
#pragma unroll
            for (int m = 0; m < 4; ++m) { const size_t off = (size_t)(u.pm * 256 + ai * 128 + wr * 64 + m * 16 + fr) * ldc + col0;
#pragma unroll
                for (int bj = 0; bj < 2; ++bj)
#pragma unroll
                    for (int n = 0; n < 2; ++n) { const f32x4 bs = *(const f32x4*)(base + off + bj * 128 + n * 16); *(f32x4*)(out + off + bj * 128 + n * 16) = bs + acc[ai][bj][m][n]; } }
    }
};

struct PEpiWo {
    static constexpr bool PERM = false, AFTER_DRAIN = false, MIDSCALE = true;
    const bf16_t* base; bf16_t* xb; float* ssq; const float* ssqm; int ldc;
    __device__ __forceinline__ void midscale(f32x4 (&acc)[2][2][4][2], const pg8::Unit& u, int wr, int fr) const {
#pragma unroll
        for (int ai = 0; ai < 2; ++ai)
#pragma unroll
            for (int m = 0; m < 4; ++m) { const int row = u.pm * 256 + ai * 128 + wr * 64 + m * 16 + fr;
                const float sa = ssqm[2 * row], sb = ssqm[2 * row + 1]; const float ratio = sqrtf((sb * (1.f / 512) + EPS) / (sa * (1.f / 512) + EPS));
#pragma unroll
                for (int bj = 0; bj < 2; ++bj)
#pragma unroll
                    for (int n = 0; n < 2; ++n) acc[ai][bj][m][n] *= ratio; }
    }
    __device__ __forceinline__ void operator()(const f32x4 (&acc)[2][2][4][2], const pg8::Unit& u, int wr, int wc, int fr, int fq) const {
        const int col0 = u.pn * 256 + wc * 32 + 4 * fq; const int lane = fq * 16 + fr;
        const int rowb = u.pm * 256 + wr * 64 + fr;
        float rb[8];
#pragma unroll
        for (int g_ = 0; g_ < 8; ++g_) rb[g_] = ssqm[2 * (rowb + (g_ >> 2) * 128 + (g_ & 3) * 16) + 1];
        u32x2 nxt[2][2];
#pragma unroll
        for (int bj = 0; bj < 2; ++bj)
#pragma unroll
            for (int n = 0; n < 2; ++n) nxt[bj][n] = *(const u32x2*)(base + (size_t)rowb * ldc + col0 + bj * 128 + n * 16);
#pragma unroll
        for (int g_ = 0; g_ < 8; ++g_) { const int ai = g_ >> 2, m = g_ & 3; const int row = rowb + ai * 128 + m * 16; const size_t off = (size_t)row * ldc + col0; float ss = 0.f;
            u32x2 cur[2][2];
#pragma unroll
            for (int bj = 0; bj < 2; ++bj)
#pragma unroll
                for (int n = 0; n < 2; ++n) cur[bj][n] = nxt[bj][n];
            if (g_ < 7) { const size_t offn = (size_t)(rowb + ((g_ + 1) >> 2) * 128 + ((g_ + 1) & 3) * 16) * ldc + col0;
#pragma unroll
                for (int bj = 0; bj < 2; ++bj)
#pragma unroll
                    for (int n = 0; n < 2; ++n) nxt[bj][n] = *(const u32x2*)(base + offn + bj * 128 + n * 16); }
            const float rbs = 1.f / sqrtf(rb[g_] * (1.f / 512) + EPS);
#pragma unroll
            for (int bj = 0; bj < 2; ++bj)
#pragma unroll
                for (int n = 0; n < 2; ++n) { const u32x2 cw = cur[bj][n]; const f32x4 v = (f32x4){bf2f(cw.x & 0xffffu), bf2f(cw.x >> 16), bf2f(cw.y & 0xffffu), bf2f(cw.y >> 16)} + acc[ai][bj][m][n] * rbs;
                    ss += (v[0] * v[0] + v[1] * v[1]) + (v[2] * v[2] + v[3] * v[3]);
                    u32x2 w; w.x = cvt_pk_bf16(v[0], v[1]); w.y = cvt_pk_bf16(v[2], v[3]); *(u32x2*)(xb + off + bj * 128 + n * 16) = w; }
            ss += __builtin_bit_cast(float, __builtin_amdgcn_ds_bpermute((lane ^ 16) << 2, __builtin_bit_cast(int, ss)));
            ss += __builtin_bit_cast(float, __builtin_amdgcn_ds_bpermute((lane ^ 32) << 2, __builtin_bit_cast(int, ss)));
            if (fq == 0) __hip_atomic_fetch_add(ssq + row, ss, __ATOMIC_RELAXED, __HIP_MEMORY_SCOPE_AGENT); }
    }
};


struct PEpiDown {
    static constexpr bool PERM = false, AFTER_DRAIN = false, MIDSCALE = false;
    const bf16_t* xb; float* out; int ldc;
    __device__ __forceinline__ void operator()(const f32x4 (&acc)[2][2][4][2], const pg8::Unit& u, int wr, int wc, int fr, int fq) const {
        const int col0 = u.pn * 256 + wc * 32 + 4 * fq; const int rowb = u.pm * 256 + wr * 64 + fr;
        u32x2 nxt[2][2];
#pragma unroll
        for (int bj = 0; bj < 2; ++bj)
#pragma unroll
            for (int n = 0; n < 2; ++n) nxt[bj][n] = *(const u32x2*)(xb + (size_t)rowb * ldc + col0 + bj * 128 + n * 16);
#pragma unroll
        for (int g_ = 0; g_ < 8; ++g_) { const int ai = g_ >> 2, m = g_ & 3; const size_t off = (size_t)(rowb + ai * 128 + m * 16) * ldc + col0;
            u32x2 cur[2][2];
#pragma unroll
            for (int bj = 0; bj < 2; ++bj)
#pragma unroll
                for (int n = 0; n < 2; ++n) cur[bj][n] = nxt[bj][n];
            if (g_ < 7) { const size_t offn = (size_t)(rowb + ((g_ + 1) >> 2) * 128 + ((g_ + 1) & 3) * 16) * ldc + col0;
#pragma unroll
                for (int bj = 0; bj < 2; ++bj)
#pragma unroll
                    for (int n = 0; n < 2; ++n) nxt[bj][n] = *(const u32x2*)(xb + offn + bj * 128 + n * 16); }
#pragma unroll
            for (int bj = 0; bj < 2; ++bj)
#pragma unroll
                for (int n = 0; n < 2; ++n) { const u32x2 w = cur[bj][n];
                    const f32x4 bs = (f32x4){bf2f(w.x & 0xffffu), bf2f(w.x >> 16), bf2f(w.y & 0xffffu), bf2f(w.y >> 16)};
                    *(f32x4*)(out + off + bj * 128 + n * 16) = bs + acc[ai][bj][m][n]; } }
    }
};

__device__ __forceinline__ float sq8(const bf16x8 v) { float s = 0.f;
#pragma unroll
    for (int j = 0; j < 8; ++j) { const float f = bf2f((unsigned short)v[j]); s += f * f; }
    return s; }
__device__ __forceinline__ u32x4 scale8(const bf16x8 v, float sc, const f32x4 ga, const f32x4 gb) { u32x4 o;
    o.x = pk2(bf2f((unsigned short)v[0]) * sc * ga[0], bf2f((unsigned short)v[1]) * sc * ga[1]); o.y = pk2(bf2f((unsigned short)v[2]) * sc * ga[2], bf2f((unsigned short)v[3]) * sc * ga[3]);
    o.z = pk2(bf2f((unsigned short)v[4]) * sc * gb[0], bf2f((unsigned short)v[5]) * sc * gb[1]); o.w = pk2(bf2f((unsigned short)v[6]) * sc * gb[2], bf2f((unsigned short)v[7]) * sc * gb[3]);
    return o; }
template <int NR>
__device__ __forceinline__ void glueA_rows(unsigned char* ws, int row0, int rstride, int lane) {
    const int br = (lane >> 4) & 1, g = (lane >> 3) & 1, l8 = lane & 7;
    bf16x8 vq[NR], vkv[NR], vk[NR];
#pragma unroll
    for (int r = 0; r < NR; ++r) { const int row = (row0 + r * rstride < M) ? row0 + r * rstride : row0; const bf16_t* pr = (const bf16_t*)(ws + WS_PROJ) + (size_t)row * DINP;
        vq[r] = *(const bf16x8*)(pr + C_HQ + 8 * (lane < 48 ? lane : 47)); vkv[r] = *(const bf16x8*)(pr + C_HKV + 8 * (lane & 31)); vk[r] = *(const bf16x8*)(pr + (br ? C_KWIN : C_KSEL) + 64 * g + 8 * l8); }
    const float* kg = inptr(10) + (1 + br) * 64 + 8 * l8; const f32x4 ga = *(const f32x4*)kg, gb = *(const f32x4*)(kg + 4);
#pragma unroll
    for (int r = 0; r < NR; ++r) { const int row = row0 + r * rstride; if (row >= M) continue;
        const float sq = wave_sum(lane < 48 ? sq8(vq[r]) : 0.f), skv = wave_sum(lane < 32 ? sq8(vkv[r]) : 0.f);
        float sk = sq8(vk[r]); sk += __shfl_xor(sk, 1); sk += __shfl_xor(sk, 2); sk += __shfl_xor(sk, 4);
        if (lane == 0) { ((float*)(ws + WS_RSQ))[row] = 1.f / sqrtf(sq * (1.f / QR) + EPS); ((float*)(ws + WS_RSKV))[row] = 1.f / sqrtf(skv * (1.f / KVR) + EPS); }
        if (lane < 32) { const float rstd = 1.f / sqrtf(sk * (1.f / 64) + EPS);
            *(u32x4*)((bf16_t*)(ws + (br ? WS_KWIN : WS_KSEL)) + (size_t)row * 128 + 64 * g + 8 * l8) = scale8(vk[r], rstd, ga, gb); } }
}
template <int NR>
__device__ __forceinline__ void kpass_rows(unsigned char* ws, int row0, int rstride, int lane) {
    const int h = lane >> 3, l = lane & 7;
    bf16x8 v[NR]; unsigned ra[NR], rb[NR];
#pragma unroll
    for (int r = 0; r < NR; ++r) { const int row = (row0 + r * rstride < M) ? row0 + r * rstride : row0;
        v[r] = *(const bf16x8*)((const bf16_t*)(ws + WS_KVM) + (size_t)row * MKV + 128 * h + 8 * l);
        const bf16_t* kr = (const bf16_t*)(ws + WS_PROJ) + (size_t)row * DINP + P_HKR + 2 * l; ra[r] = *(const unsigned*)kr; rb[r] = *(const unsigned*)(kr + 16); }
    const float* kg = inptr(8);
    const f32x4 ga = *(const f32x4*)(kg + 8 * l), gb = *(const f32x4*)(kg + 8 * l + 4);
    const float g1a = kg[64 + 2 * l], g1b = kg[65 + 2 * l], g2a = kg[80 + 2 * l], g2b = kg[81 + 2 * l];
    const float inva = exp2f(-(float)(2 * l) * (13.287712379549449f / 16.f)), invb = exp2f(-(float)(2 * l + 1) * (13.287712379549449f / 16.f));
#pragma unroll
    for (int r = 0; r < NR; ++r) { const int row = row0 + r * rstride; if (row >= M) continue;
        const int pos = row & (SEQ - 1);
        const float x1a = bf2f(ra[r] & 0xffffu), x1b = bf2f(ra[r] >> 16), x2a = bf2f(rb[r] & 0xffffu), x2b = bf2f(rb[r] >> 16);
        float ss = sq8(v[r]) + (x1a * x1a + x1b * x1b) + (x2a * x2a + x2b * x2b);
        ss += __shfl_xor(ss, 1); ss += __shfl_xor(ss, 2); ss += __shfl_xor(ss, 4);
        const float rstd = 1.f / sqrtf(ss * (1.f / 96) + EPS);
        bf16_t* ko = (bf16_t*)(ws + WS_KMLA) + (size_t)row * MQ + 96 * h;
        *(u32x4*)(ko + 8 * l) = scale8(v[r], rstd, ga, gb);
        float sna, csa, snb, csb; sincosf((float)pos * inva, &sna, &csa); sincosf((float)pos * invb, &snb, &csb);
        const float n1a = x1a * rstd * g1a, n2a = x2a * rstd * g2a, n1b = x1b * rstd * g1b, n2b = x2b * rstd * g2b;
        *(unsigned*)(ko + 64 + 2 * l) = pk2(n1a * csa - n2a * sna, n1b * csb - n2b * snb); *(unsigned*)(ko + 80 + 2 * l) = pk2(n2a * csa + n1a * sna, n2b * csb + n1b * snb); }
}
__device__ __forceinline__ void glueC_row(unsigned char* ws, int row, int lane) {
    bf16_t* mx = (bf16_t*)(ws + WS_MIX) + (size_t)row * DM + 8 * lane;
#pragma unroll
    for (int half = 0; half < 2; ++half) {
        const bf16x8 v = *(const bf16x8*)(mx + 512 * half);
        const float rstd = 1.f / sqrtf(wave_sum(sq8(v)) * (1.f / 512) + EPS);
        const float* gp = inptr(15 + half) + 8 * lane;
        *(u32x4*)(mx + 512 * half) = scale8(v, rstd, *(const f32x4*)gp, *(const f32x4*)(gp + 4));
    }
}

__device__ __forceinline__ void compress_block(unsigned char* ws, LAS unsigned char* L, int task, int wv) {
    const int tid = opaque_tid(wv), lane = tid & 63, wid = __builtin_amdgcn_readfirstlane(tid >> 6), fr = lane & 15, fq = lane >> 4;
    const int tc = task & 15, b = (task >> 4) & 7, kv = task >> 7;
    int c = 8 * tc + (fr >> 1); const int g = fr & 1; if (c > NCMP - 1) c = NCMP - 1;
    const bf16_t* arow = (const bf16_t*)(ws + WS_PROJ) + (size_t)(b * SEQ + 16 * c) * DINP + slot_base((kv ? S_VCMP : S_KCMP) + g) + 8 * fq;
    const float* pe = inptr(11) + kv * 2048 + 8 * fq;
    const bf16_t* w1t = (const bf16_t*)(ws + WS_W1T) + (size_t)kv * 128 * 2048 + (size_t)fr * 2048 + 8 * fq;
    f32x4 acc[8];
#pragma unroll
    for (int n = 0; n < 8; ++n) acc[n] = (f32x4){0.f, 0.f, 0.f, 0.f};
#pragma unroll 4
    for (int s8 = 0; s8 < 8; ++s8) {
        const int s = 8 * wid + s8, r = s >> 1, db = (s & 1) * 32;
        const bf16x8 araw = *(const bf16x8*)(arow + (size_t)r * DINP + 4 * db);
        const f32x4 pa = *(const f32x4*)(pe + r * 64 + db), pb = *(const f32x4*)(pe + r * 64 + db + 4);
        u32x4 aw; aw.x = pk2(bf2f((unsigned short)araw[0]) + pa[0], bf2f((unsigned short)araw[1]) + pa[1]); aw.y = pk2(bf2f((unsigned short)araw[2]) + pa[2], bf2f((unsigned short)araw[3]) + pa[3]);
        aw.z = pk2(bf2f((unsigned short)araw[4]) + pb[0], bf2f((unsigned short)araw[5]) + pb[1]); aw.w = pk2(bf2f((unsigned short)araw[6]) + pb[2], bf2f((unsigned short)araw[7]) + pb[3]);
        const bf16x8 a = __builtin_bit_cast(bf16x8, aw);
#pragma unroll
        for (int n = 0; n < 8; ++n) { const bf16x8 bb = *(const bf16x8*)(w1t + (size_t)(16 * n) * 2048 + 32 * s);
            acc[n] = __builtin_amdgcn_mfma_f32_16x16x32_bf16(a, bb, acc[n], 0, 0, 0); }
    }
    LAS float* part = (LAS float*)L;
#pragma unroll
    for (int n = 0; n < 8; ++n)
#pragma unroll
        for (int j = 0; j < 4; ++j) part[(wid * 16 + 4 * fq + j) * 128 + 16 * n + fr] = acc[n][j];
    __syncthreads();
    LAS bf16_t* hb_ = (LAS bf16_t*)(L + 65536);
#pragma unroll
    for (int e = 0; e < 4; ++e) { const int idx = tid + 512 * e; float v = 0.f;
#pragma unroll
        for (int w = 0; w < 8; ++w) v += part[w * 2048 + idx];
        hb_[idx] = (bf16_t)f2bf(v / (1.f + __expf(-v))); }
    __syncthreads();
    if (wid == 0) {
        const bf16_t* w2t = (const bf16_t*)(ws + WS_W2T) + kv * 64 * 128 + fr * 128 + 8 * fq;
        f32x4 o[4];
#pragma unroll
        for (int n = 0; n < 4; ++n) o[n] = (f32x4){0.f, 0.f, 0.f, 0.f};
#pragma unroll
        for (int ks = 0; ks < 4; ++ks) { const bf16x8 a = *(const LAS bf16x8*)(hb_ + fr * 128 + 32 * ks + 8 * fq);
#pragma unroll
            for (int n = 0; n < 4; ++n) { const bf16x8 bb = *(const bf16x8*)(w2t + (size_t)(16 * n) * 128 + 32 * ks); o[n] = __builtin_amdgcn_mfma_f32_16x16x32_bf16(a, bb, o[n], 0, 0, 0); } }
        bf16_t* dstb = (bf16_t*)(ws + (kv ? WS_VCMP : WS_KCMP)) + (size_t)b * 128 * 2 * 64;
        const float* kg = inptr(10);
#pragma unroll
        for (int j = 0; j < 4; ++j) { const int row = 4 * fq + j, cc = 8 * tc + (row >> 1), gg = row & 1;
            float sc = 1.f;
            if (kv == 0) { float ss = o[0][j] * o[0][j] + o[1][j] * o[1][j] + o[2][j] * o[2][j] + o[3][j] * o[3][j];
                ss += __shfl_xor(ss, 1); ss += __shfl_xor(ss, 2); ss += __shfl_xor(ss, 4); ss += __shfl_xor(ss, 8); sc = 1.f / sqrtf(ss * (1.f / 64) + EPS); }
#pragma unroll
            for (int n = 0; n < 4; ++n) { const int col = 16 * n + fr; float v = o[n][j] * sc; if (kv == 0) v *= kg[col]; if (cc >= NCMP) v = 0.f;
                dstb[((size_t)cc * 2 + gg) * 64 + col] = (bf16_t)f2bf(v); } }
    }
    __syncthreads();
}

namespace att {
typedef float f32x16 __attribute__((ext_vector_type(16)));
typedef short s16x4 __attribute__((ext_vector_type(4)));
typedef short v4i16_t __attribute__((ext_vector_type(4)));
typedef float f32x2_t __attribute__((ext_vector_type(2)));
typedef __bf16 bf16x2_t __attribute__((ext_vector_type(2)));
typedef const LAS unsigned char* lcp;
constexpr int NSLOT = 3;
constexpr int L_TB = 0, L_K = 4096, KSLOT = 12288, L_V = L_K + NSLOT * KSLOT, VSLOT = 8192, L_WSF = L_V + NSLOT * VSLOT, L_OST = L_WSF + 4096,
              L_IMP = L_OST + 32768, L_SELM = L_IMP + 32768, L_GATE = L_SELM + 256, L_SC = L_GATE + 3072, L_INVL = L_SC + 8192, L_END = L_INVL + 1024;
static_assert(L_V + NSLOT * VSLOT <= 65536, "LDS-DMA destinations stay below 64 KiB");
static_assert(L_END <= LDS_BST, "attention LDS map");
constexpr float THR = 8.0f;
__device__ __forceinline__ int crow(int r, int hi) { return (r & 3) + 8 * (r >> 2) + 4 * hi; }
__device__ __forceinline__ void glds16(const void* gsrc, unsigned lds_dst) { unsigned keep;
    asm volatile("s_mov_b32 %0, m0\n\ts_mov_b32 m0, %2\n\ts_nop 0\n\tglobal_load_lds_dwordx4 %1, off\n\ts_mov_b32 m0, %0" : "=&s"(keep) : "v"(gsrc), "s"(lds_dst) : "memory"); }
__device__ __forceinline__ unsigned cvtpk(float lo, float hi) { f32x2_t v = {lo, hi}; bf16x2_t b = __builtin_convertvector(v, bf16x2_t); return __builtin_bit_cast(unsigned, b); }
__device__ __forceinline__ s16x4 vtr(lcp p) { return __builtin_bit_cast(s16x4, __builtin_amdgcn_ds_read_tr16_b64_v4i16((LAS v4i16_t*)p)); }
__device__ __forceinline__ float lane_xor(float v, int lane, int x) { return __builtin_bit_cast(float, __builtin_amdgcn_ds_bpermute((lane ^ x) << 2, __builtin_bit_cast(int, v))); }
__device__ __forceinline__ unsigned lane_xor_u(unsigned v, int lane, int x) { return (unsigned)__builtin_amdgcn_ds_bpermute((lane ^ x) << 2, (int)v); }
__device__ __forceinline__ float swap_max(float m, int lane) { return __builtin_fmaxf(m, lane_xor(m, lane, 32)); }
__device__ __forceinline__ float swap_sum(float m, int lane) { return m + lane_xor(m, lane, 32); }
__device__ __forceinline__ float max3f(float a, float b, float c) { float r; asm("v_max3_f32 %0, %1, %2, %3" : "=v"(r) : "v"(a), "v"(b), "v"(c)); return r; }
__device__ __forceinline__ float max32(const f32x16& p0, const f32x16& p1) {
    float a = max3f(p0[0], p0[1], p1[0]), b = max3f(p0[2], p0[3], p1[1]); a = max3f(a, p1[2], p1[3]);
#pragma unroll
    for (int r = 4; r < 16; r += 4) { a = max3f(a, p0[r], p0[r + 1]); b = max3f(b, p0[r + 2], p0[r + 3]); a = max3f(a, p1[r], p1[r + 1]); b = max3f(b, p1[r + 2], p1[r + 3]); }
    return __builtin_fmaxf(a, b); }
__device__ __forceinline__ float max16(const f32x16& p) { float a = __builtin_fmaxf(p[0], p[1]), b = __builtin_fmaxf(p[2], p[3]);
#pragma unroll
    for (int r = 4; r < 16; r += 4) { a = __builtin_fmaxf(a, __builtin_fmaxf(p[r], p[r + 1])); b = __builtin_fmaxf(b, __builtin_fmaxf(p[r + 2], p[r + 3])); }
    return __builtin_fmaxf(a, b); }
__device__ __forceinline__ float sum16(const f32x16& p) { float a = p[0] + p[1], b = p[2] + p[3];
#pragma unroll
    for (int r = 4; r < 16; r += 4) { a += p[r] + p[r + 1]; b += p[r + 2] + p[r + 3]; }
    return a + b; }
#define ATT_BAR() asm volatile("s_waitcnt vmcnt(0) lgkmcnt(0)\n\ts_barrier" ::: "memory")

template <int DQ> __device__ __forceinline__ void qkt(f32x16& p0, f32x16& p1, lcp kslot, const bf16x8* qr, const f32x16& cinit, int r32, int hi) {
    lcp kb = kslot + hi * 1024 + r32 * 16;
    constexpr int NB = 2;
#pragma unroll
    for (int db = 0; db < DQ / 16; db += NB) {
        bf16x8 kf[2 * NB];
#pragma unroll
        for (int e = 0; e < NB; ++e) { kf[2 * e] = *(const LAS bf16x8*)(kb + (db + e) * 2048); kf[2 * e + 1] = *(const LAS bf16x8*)(kb + (db + e) * 2048 + 512); }
        __builtin_amdgcn_sched_barrier(0);
#pragma unroll
        for (int e = 0; e < NB; ++e) { const int d0 = db + e;
            if (d0 == 0) { p0 = __builtin_amdgcn_mfma_f32_32x32x16_bf16(kf[0], qr[0], cinit, 0, 0, 0); p1 = __builtin_amdgcn_mfma_f32_32x32x16_bf16(kf[1], qr[0], cinit, 0, 0, 0); }
            else { p0 = __builtin_amdgcn_mfma_f32_32x32x16_bf16(kf[2 * e], qr[d0], p0, 0, 0, 0); p1 = __builtin_amdgcn_mfma_f32_32x32x16_bf16(kf[2 * e + 1], qr[d0], p1, 0, 0, 0); }
        }
    }
}
__device__ __forceinline__ void vload_half(bf16x8 (&vf)[8], lcp vp, int d0) {
#pragma unroll
    for (int ks = 0; ks < 4; ++ks) {
        const s16x4 lo = vtr(vp + d0 * 4096 + ks * 1024), hh = vtr(vp + d0 * 4096 + ks * 1024 + 512);
        vf[d0 * 4 + ks] = (bf16x8){lo[0], lo[1], lo[2], lo[3], hh[0], hh[1], hh[2], hh[3]};
    }
    __builtin_amdgcn_sched_barrier(0);
}
__device__ __forceinline__ void vload(bf16x8 (&vf)[8], lcp vp) { vload_half(vf, vp, 0); vload_half(vf, vp, 1); }
__device__ __forceinline__ void pv_mma(f32x16 (&o)[2], const bf16x8 (&vf)[8], const f32x16& p0, const f32x16& p1) {
    u32x4 pw[4];
    pw[0] = (u32x4){cvtpk(p0[0], p0[1]), cvtpk(p0[2], p0[3]), cvtpk(p0[4], p0[5]), cvtpk(p0[6], p0[7])};
    pw[1] = (u32x4){cvtpk(p0[8], p0[9]), cvtpk(p0[10], p0[11]), cvtpk(p0[12], p0[13]), cvtpk(p0[14], p0[15])};
    pw[2] = (u32x4){cvtpk(p1[0], p1[1]), cvtpk(p1[2], p1[3]), cvtpk(p1[4], p1[5]), cvtpk(p1[6], p1[7])};
    pw[3] = (u32x4){cvtpk(p1[8], p1[9]), cvtpk(p1[10], p1[11]), cvtpk(p1[12], p1[13]), cvtpk(p1[14], p1[15])};
#pragma unroll
    for (int d0 = 0; d0 < 2; ++d0)
#pragma unroll
        for (int ks = 0; ks < 4; ++ks) o[d0] = __builtin_amdgcn_mfma_f32_32x32x16_bf16(__builtin_bit_cast(bf16x8, pw[ks]), vf[d0 * 4 + ks], o[d0], 0, 0, 0);
}
__device__ __forceinline__ void pv(f32x16 (&o)[2], lcp vp, const f32x16& p0, const f32x16& p1) { bf16x8 vf[8]; vload(vf, vp); pv_mma(o, vf, p0, p1); }
template <int DQ, bool SLOT = false, bool SLOTV = SLOT> __device__ __forceinline__ void dma_tile(unsigned lds0, const bf16_t* Kg, int kpitch, const bf16_t* Vg, int vpitch, int key0, int slot, int wid, int lane) {
    const bf16_t* ksrc = Kg + (size_t)(key0 + lane) * kpitch + (SLOT ? 128 * (wid >> 2) + 8 * (wid & 3) : wid * 8);
    glds16(ksrc, (unsigned)__builtin_amdgcn_readfirstlane(lds0 + L_K + slot * KSLOT + wid * 1024));
    if (DQ == 96) { if (wid < 4) glds16(ksrc + 64, (unsigned)__builtin_amdgcn_readfirstlane(lds0 + L_K + slot * KSLOT + (8 + wid) * 1024)); }
    const bf16_t* vsrc = Vg + (size_t)(key0 + 16 * (wid & 3) + (lane >> 2)) * vpitch + (wid >> 2) * (SLOTV ? 128 : 32) + (lane & 3) * 8;
    glds16(vsrc, (unsigned)__builtin_amdgcn_readfirstlane(lds0 + L_V + slot * VSLOT + wid * 1024));
}

template <int DQ, bool SLOT = false, bool SLOTV = SLOT, class Pol>
__device__ __forceinline__ void flash_loop(LAS unsigned char* L, const bf16_t* Kg, int kpitch, const bf16_t* Vg, int vpitch, const bf16x8* qr, const Pol& pol, f32x16 (&o)[2], float& l_out, int wid, int lane) {
    const int r32 = lane & 31, hi = lane >> 5;
    const unsigned lds0 = (unsigned)(uintptr_t)L;
    LAS float* wsf = (LAS float*)(L + L_WSF) + wid * 128;
    lcp vp0 = L + L_V + ((lane >> 4) & 1) * 32 + (lane & 3) * 8 + (4 * hi + ((lane & 15) >> 2)) * 64;
    float mhat = 0.f, l = 0.f;
    f32x16 negm;
#pragma unroll
    for (int r = 0; r < 16; ++r) { o[0][r] = 0.f; o[1][r] = 0.f; negm[r] = 0.f; }
    const int n = pol.ntiles;
    dma_tile<DQ, SLOT, SLOTV>(lds0, Kg, kpitch, Vg, vpitch, pol.key0(0), 0, wid, lane);
    if (n > 1) dma_tile<DQ, SLOT, SLOTV>(lds0, Kg, kpitch, Vg, vpitch, pol.key0(1), 1, wid, lane);
    int slot = 0, slot2 = 2;
    for (int i = 0; i < n; ++i) {
        if (i + 1 < n) { if (DQ == 96 && wid < 4) asm volatile("s_waitcnt vmcnt(3) lgkmcnt(0)\n\ts_barrier" ::: "memory"); else asm volatile("s_waitcnt vmcnt(2) lgkmcnt(0)\n\ts_barrier" ::: "memory"); }
        else ATT_BAR();
        if (i + 2 < n) dma_tile<DQ, SLOT, SLOTV>(lds0, Kg, kpitch, Vg, vpitch, pol.key0(i + 2), slot2, wid, lane);
        if (pol.active(i)) {
            f32x16 p0, p1;
            qkt<DQ>(p0, p1, L + L_K + slot * KSLOT, qr, negm, r32, hi);
            bf16x8 vf[8]; vload_half(vf, vp0 + slot * VSLOT, 0);
            pol.fix(p0, p1, i);
            asm volatile("s_nop 15\n\ts_nop 7" : "+v"(p0), "+v"(p1));
            const float rm = swap_max(max32(p0, p1), lane);
            const bool first = (i == 0);
            if (first || __any(rm > THR)) {
                float dl = first ? rm : __builtin_fmaxf(rm, 0.f);
                if (dl == -INFINITY) dl = 0.f;
                mhat += dl;
#pragma unroll
                for (int r = 0; r < 16; ++r) { p0[r] -= dl; p1[r] -= dl; negm[r] = -mhat; }
                if (!first) {
                    const float f = __builtin_amdgcn_exp2f(-dl); l *= f;
                    if (hi == 0) wsf[r32] = f;
#pragma unroll
                    for (int r = 0; r < 16; ++r) { const float fr_ = wsf[crow(r, hi)]; o[0][r] *= fr_; o[1][r] *= fr_; }
                }
            }
#pragma unroll
            for (int r = 0; r < 16; ++r) { p0[r] = __builtin_amdgcn_exp2f(p0[r]); p1[r] = __builtin_amdgcn_exp2f(p1[r]); }
            vload_half(vf, vp0 + slot * VSLOT, 1);
            l += sum16(p0) + sum16(p1);
            pv_mma(o, vf, p0, p1);
        }
        slot = (slot == NSLOT - 1) ? 0 : slot + 1; slot2 = (slot2 == NSLOT - 1) ? 0 : slot2 + 1;
    }
    ATT_BAR();
    l_out = swap_sum(l, lane);
}

__device__ __forceinline__ void acc_scaled(f32x16 (&oc)[2], const f32x16 (&o)[2], float rowscale, LAS float* wsf, int r32, int hi) {
    if (hi == 0) wsf[32 + r32] = rowscale;
#pragma unroll
    for (int r = 0; r < 16; ++r) { const float s = wsf[32 + crow(r, hi)]; oc[0][r] += s * o[0][r]; oc[1][r] += s * o[1][r]; }
}
__device__ __forceinline__ void park_store(const f32x16 (&oc)[2], LAS float* park, int lane) {
#pragma unroll
    for (int d0 = 0; d0 < 2; ++d0)
#pragma unroll
        for (int r = 0; r < 16; ++r) park[(d0 * 16 + r) * 64 + lane] = oc[d0][r];
}
template <bool FINAL> __device__ __forceinline__ void park_acc(f32x16 (&oc)[2], LAS float* park, const f32x16 (&o)[2], float rowscale, LAS float* wsf, int lane) {
    const int r32 = lane & 31, hi = lane >> 5;
    if (hi == 0) wsf[32 + r32] = rowscale;
#pragma unroll
    for (int r = 0; r < 16; ++r) { const float s = wsf[32 + crow(r, hi)];
#pragma unroll
        for (int d0 = 0; d0 < 2; ++d0) { const float v = park[(d0 * 16 + r) * 64 + lane] + s * o[d0][r]; if (FINAL) oc[d0][r] = v; else park[(d0 * 16 + r) * 64 + lane] = v; } }
}
__device__ __forceinline__ void store_tile(const f32x16 (&oc)[2], bf16_t* dst, int pitch, LAS unsigned char* L, int wid, int lane, float* ssq) {
    const int r32 = lane & 31, hi = lane >> 5;
    LAS bf16_t* stg = (LAS bf16_t*)(L + L_OST + wid * 8192);
#pragma unroll
    for (int r = 0; r < 16; ++r) { const int orow = crow(r, hi);
#pragma unroll
        for (int d0 = 0; d0 < 2; ++d0) stg[orow * 64 + d0 * 32 + r32] = (bf16_t)f2bf(oc[d0][r]); }
    asm volatile("s_waitcnt lgkmcnt(0)" ::: "memory");
#pragma unroll
    for (int i = 0; i < 4; ++i) { const int row = i * 8 + (lane >> 3), ch = lane & 7; const u32x4 v = *(const LAS u32x4*)(stg + row * 64 + ch * 8); *(u32x4*)(dst + (size_t)row * pitch + ch * 8) = v;
        float ss = sq8(__builtin_bit_cast(bf16x8, v)); ss += lane_xor(ss, lane, 1); ss += lane_xor(ss, lane, 2); ss += lane_xor(ss, lane, 4);
        if (ch == 0) __hip_atomic_fetch_add(ssq + 2 * row, ss, __ATOMIC_RELAXED, __HIP_MEMORY_SCOPE_AGENT); }
    asm volatile("s_waitcnt lgkmcnt(0)" ::: "memory");
}

struct PolMla { int ntiles, qw0, r32, hi;
    __device__ __forceinline__ int key0(int i) const { return 64 * i; }
    __device__ __forceinline__ bool active(int i) const { return 64 * i <= qw0 + 31; }
    __device__ __forceinline__ int nact() const { const int a = (qw0 + 31) / 64 + 1; return a < ntiles ? a : ntiles; }
    __device__ __forceinline__ void fix(f32x16& p0, f32x16& p1, int i) const {
        if (64 * i + 63 > qw0) { const int q = qw0 + r32, kb = 64 * i + 4 * hi;
#pragma unroll
            for (int r = 0; r < 16; ++r) { const int kv = kb + (r & 3) + 8 * (r >> 2); if (kv > q) p0[r] = -INFINITY; if (kv + 32 > q) p1[r] = -INFINITY; } }
    }
};
struct PolSel { int ntiles, qc, q, hi; unsigned selm; const LAS float* tbh;
    __device__ __forceinline__ int key0(int i) const { return 64 * (qc - i); }
    __device__ __forceinline__ bool active(int i) const { return __any((selm >> (qc - i)) & 1u) != 0; }
    __device__ __forceinline__ int nact() const { return ntiles; }
    __device__ __forceinline__ void fix(f32x16& p0, f32x16& p1, int i) const {
        const bool bit = ((selm >> (qc - i)) & 1u) != 0u;
        if (i <= 2) { const int kb = 64 * (qc - i) + 4 * hi;
#pragma unroll
            for (int r = 0; r < 16; ++r) { const int d0 = q - (kb + (r & 3) + 8 * (r >> 2)), d1 = d0 - 32;
                p0[r] = (d0 < 0) ? -INFINITY : p0[r] + tbh[d0 < 127 ? d0 : 127]; p1[r] = (d1 < 0) ? -INFINITY : p1[r] + tbh[d1 < 127 ? d1 : 127]; } }
        if (!bit) {
#pragma unroll
            for (int r = 0; r < 16; ++r) { p0[r] = -INFINITY; p1[r] = -INFINITY; } }
    }
};
struct PolWin { int ntiles, qc, q, hi; const LAS float* tbh;
    __device__ __forceinline__ int key0(int i) const { return 64 * (qc - i); }
    __device__ __forceinline__ bool active(int) const { return true; }
    __device__ __forceinline__ int nact() const { return ntiles; }
    __device__ __forceinline__ void fix(f32x16& p0, f32x16& p1, int i) const {
        if (i <= 2 || i == 8) { const int kb = 64 * (qc - i) + 4 * hi;
#pragma unroll
            for (int r = 0; r < 16; ++r) { const int d0 = q - (kb + (r & 3) + 8 * (r >> 2)), d1 = d0 - 32;
                const float b0 = (i <= 2) ? tbh[d0 < 0 ? 0 : (d0 < 127 ? d0 : 127)] : 0.f, b1 = (i <= 2) ? tbh[d1 < 0 ? 0 : (d1 < 127 ? d1 : 127)] : 0.f;
                p0[r] = (d0 < 0 || d0 >= 512) ? -INFINITY : p0[r] + b0; p1[r] = (d1 < 0 || d1 >= 512) ? -INFINITY : p1[r] + b1; } }
    }
};

__device__ __forceinline__ void mla_unit(unsigned char* ws, LAS unsigned char* L, int b, int h, int qb, int wv) {
    const int tid = opaque_tid(wv), lane = tid & 63, wid = __builtin_amdgcn_readfirstlane(tid >> 6);
    const int r32 = lane & 31, hi = lane >> 5;
    const size_t rowbase = (size_t)b * SEQ; const int qw0 = 256 * qb + 32 * wid;
    bf16x8 qr[6];
    { const bf16_t* Qw = (const bf16_t*)(ws + WS_QM) + (rowbase + qw0 + r32) * MQ + 96 * h + 8 * hi;
      bf16x8 raw[6]; float ss = 0.f;
#pragma unroll
      for (int d0 = 0; d0 < 6; ++d0) { raw[d0] = *(const bf16x8*)(Qw + 16 * d0); ss += sq8(raw[d0]); }
      ss += lane_xor(ss, lane, 32);
      const float rstd = QS_MLA / sqrtf(ss * (1.f / 96) + EPS);
      const float* qg = inptr(7) + 8 * hi;
#pragma unroll
      for (int d0 = 0; d0 < 4; ++d0) qr[d0] = __builtin_bit_cast(bf16x8, scale8(raw[d0], rstd, *(const f32x4*)(qg + 16 * d0), *(const f32x4*)(qg + 16 * d0 + 4)));
      float o1[8], o2[8]; const float posf = (float)(qw0 + r32);
#pragma unroll
      for (int j = 0; j < 8; ++j) { const int i = 8 * hi + j; const float inv = exp2f(-(float)i * (13.287712379549449f / 16.f)); float sn, cs; sincosf(posf * inv, &sn, &cs);
          const float n1 = bf2f((unsigned short)raw[4][j]) * rstd * qg[64 + j], n2 = bf2f((unsigned short)raw[5][j]) * rstd * qg[80 + j];
          o1[j] = n1 * cs - n2 * sn; o2[j] = n2 * cs + n1 * sn; }
      u32x4 w4, w5; w4.x = pk2(o1[0], o1[1]); w4.y = pk2(o1[2], o1[3]); w4.z = pk2(o1[4], o1[5]); w4.w = pk2(o1[6], o1[7]);
      w5.x = pk2(o2[0], o2[1]); w5.y = pk2(o2[2], o2[3]); w5.z = pk2(o2[4], o2[5]); w5.w = pk2(o2[6], o2[7]);
      qr[4] = __builtin_bit_cast(bf16x8, w4); qr[5] = __builtin_bit_cast(bf16x8, w5); }
    const bf16_t* Kg = (const bf16_t*)(ws + WS_KMLA) + rowbase * MQ + 96 * h;
    const bf16_t* Vg = (const bf16_t*)(ws + WS_KVM) + rowbase * MKV + slot_base(4 * (h >> 1) + 2 + (h & 1));
    PolMla pol{4 * qb + 4, qw0, r32, hi};
    f32x16 o[2]; float l;
    flash_loop<96, false, true>(L, Kg, MQ, Vg, MKV, qr, pol, o, l, wid, lane);
    LAS float* wsf = (LAS float*)(L + L_WSF) + wid * 128;
    f32x16 oc[2];
#pragma unroll
    for (int r = 0; r < 16; ++r) { oc[0][r] = 0.f; oc[1][r] = 0.f; }
    acc_scaled(oc, o, (l > 0.f) ? 1.f / l : 0.f, wsf, r32, hi);
    store_tile(oc, (bf16_t*)(ws + WS_MIX) + (rowbase + qw0) * DM + 64 * h, DM, L, wid, lane, (float*)(ws + WS_SSQM) + 2 * (rowbase + qw0));
}

__device__ __forceinline__ void nsa_unit(unsigned char* ws, LAS unsigned char* L, int b, int g, int qc, int wv) {
#define NSA_IDS() const int tid = opaque_tid(wv), lane = tid & 63, wid = __builtin_amdgcn_readfirstlane(tid >> 6); \
    const int r32 = lane & 31, hi = lane >> 5, rh = wid & 3, qh = wid >> 2, h = 4 * g + rh, qloc = 32 * qh + r32, q = q0 + qloc; \
    const unsigned lds0 = (unsigned)(uintptr_t)L; LAS float* wsf = (LAS float*)(L + L_WSF) + wid * 128; const LAS float* tbh = (const LAS float*)(L + L_TB) + h * 128; \
    LAS float* gate = (LAS float*)(L + L_GATE); (void)tid; (void)lane; (void)r32; (void)hi; (void)rh; (void)qh; (void)h; (void)qloc; (void)q; (void)lds0; (void)wsf; (void)tbh; (void)gate
    const size_t rowbase = (size_t)b * SEQ; const int q0 = 64 * qc;
    const bf16_t* pr = (const bf16_t*)(ws + WS_PROJ);
    bf16x8 qr[4];
    {
    NSA_IDS();
    for (int i = tid; i < 768; i += 512) { const int br = i >> 8, r = (i >> 6) & 3, qq = i & 63;
        const float x = bf2f(pr[(rowbase + q0 + qq) * DINP + P_GATE + 8 * br + 4 * g + r]); gate[i] = 1.f / (1.f + __expf(-x)); }
    { const bf16_t* Qw = pr + (rowbase + q) * DINP + slot_base(S_Q + h) + 8 * hi;
#pragma unroll
      for (int d0 = 0; d0 < 4; ++d0) qr[d0] = *(const bf16x8*)(Qw + 128 * (d0 >> 1) + 16 * (d0 & 1)); }
    }
    f32x16 oc[2];
#pragma unroll
    for (int r = 0; r < 16; ++r) { oc[0][r] = 0.f; oc[1][r] = 0.f; }
    {
        NSA_IDS();
        const bf16_t* Kg = (const bf16_t*)(ws + WS_KCMP) + ((size_t)b * 256 + g) * 64;
        const bf16_t* Vg = (const bf16_t*)(ws + WS_VCMP) + ((size_t)b * 256 + g) * 64;
        dma_tile<64>(lds0, Kg, 128, Vg, 128, 0, 0, wid, lane);
        dma_tile<64>(lds0, Kg, 128, Vg, 128, 64, 1, wid, lane);
        ATT_BAR();
        lcp vp0 = L + L_V + ((lane >> 4) & 1) * 32 + (lane & 3) * 8 + (4 * hi + ((lane & 15) >> 2)) * 64;
        LAS float* imp = (LAS float*)(L + L_IMP) + (rh * 64 + qloc) * 32;
        f32x16 o[2];
#pragma unroll
        for (int r = 0; r < 16; ++r) { o[0][r] = 0.f; o[1][r] = 0.f; }
        float m = -INFINITY, lsum = 0.f, prev_last = 0.f;
#pragma unroll 1
        for (int pass = 0; pass < 2; ++pass) {
#pragma unroll 1
            for (int T = 0; T < 2; ++T) {
                f32x16 a0, a1;
                { f32x16 zero;
#pragma unroll
                  for (int r = 0; r < 16; ++r) zero[r] = 0.f;
                  qkt<64>(a0, a1, L + L_K + T * KSLOT, qr, zero, r32, hi); }
#pragma unroll
                for (int r = 0; r < 16; ++r) { const int c = 64 * T + crow(r, hi);
                    { const int d = q - 16 * c - 31;        a0[r] = (d < 0) ? -INFINITY : a0[r] + tbh[d < 127 ? d : 127]; }
                    { const int d = q - 16 * (c + 32) - 31; a1[r] = (d < 0 || c + 32 >= NCMP) ? -INFINITY : a1[r] + tbh[d < 127 ? d : 127]; } }
                if (pass == 0) { m = __builtin_fmaxf(m, __builtin_fmaxf(max16(a0), max16(a1))); }
                else {
#pragma unroll
                    for (int r = 0; r < 16; ++r) { a0[r] = __builtin_amdgcn_exp2f(a0[r] - m); a1[r] = __builtin_amdgcn_exp2f(a1[r] - m); }
                    lsum += sum16(a0) + sum16(a1);
                    float own[8], car[8];
#pragma unroll
                    for (int a = 0; a < 4; ++a) {
                        own[a]     = a0[4 * a] + a0[4 * a + 1] + a0[4 * a + 2] + 0.5f * a0[4 * a + 3]; car[a]     = 0.5f * a0[4 * a + 3];
                        own[4 + a] = a1[4 * a] + a1[4 * a + 1] + a1[4 * a + 2] + 0.5f * a1[4 * a + 3]; car[4 + a] = 0.5f * a1[4 * a + 3]; }
#pragma unroll
                    for (int k = 0; k < 8; ++k) car[k] = lane_xor(car[k], lane, 32);
#pragma unroll
                    for (int k = 0; k < 8; ++k) { const float add = hi ? car[k] : (k >= 1 ? car[k - 1] : prev_last); imp[16 * T + 2 * k + hi] = own[k] + add; }
                    prev_last = car[7];
                    pv(o, vp0 + T * VSLOT, a0, a1);
                }
            }
            if (pass == 0) { m = swap_max(m, lane); if (m == -INFINITY) m = 0.f; }
        }
        lsum = swap_sum(lsum, lane);
        const float inv = (lsum > 0.f) ? 1.f / lsum : 0.f;
        if (hi == 0) ((LAS float*)(L + L_INVL))[rh * 64 + qloc] = inv;
        ATT_BAR();
        acc_scaled(oc, o, gate[(0 * 4 + rh) * 64 + qloc] * inv, wsf, r32, hi);
    }
    if (qc <= 15) {
        const int tid = opaque_tid(wv);
        if (tid < 64) ((LAS unsigned*)(L + L_SELM))[tid] = (qc == 31) ? 0xffffffffu : ((2u << qc) - 1u);
        ATT_BAR();
    } else {
        const int tid = opaque_tid(wv);
        const LAS float* imp = (const LAS float*)(L + L_IMP); LAS float* sc = (LAS float*)(L + L_SC);
        const int qq = tid >> 3, jj = tid & 7;
        const LAS float* il = (const LAS float*)(L + L_INVL);
        const float i0 = il[qq], i1 = il[64 + qq], i2 = il[128 + qq], i3 = il[192 + qq];
#pragma unroll
        for (int k = 0; k < 4; ++k) { const int j = jj + 8 * k;
            const float tot = (imp[(0 * 64 + qq) * 32 + j] * i0 + imp[(1 * 64 + qq) * 32 + j] * i1) + (imp[(2 * 64 + qq) * 32 + j] * i2 + imp[(3 * 64 + qq) * 32 + j] * i3);
            float s; if (j > qc) s = -INFINITY; else if (j == 0 || j == qc || j == qc - 1) s = 1e4f; else s = tot; sc[qq * 32 + j] = s; }
        ATT_BAR();
        f32x4 v[8];
#pragma unroll
        for (int k = 0; k < 8; ++k) v[k] = *(const LAS f32x4*)(sc + qq * 32 + 4 * k);
        unsigned bits = 0u;
#pragma unroll
        for (int k = 0; k < 4; ++k) { const int j = jj + 8 * k; const float me = sc[qq * 32 + j]; int rank = 0;
#pragma unroll
            for (int i = 0; i < 32; ++i) { const float si = v[i >> 2][i & 3]; rank += (si > me || (si == me && i < j)) ? 1 : 0; }
            if (rank < 16) bits |= 1u << j; }
        { const int lane = tid & 63; bits |= lane_xor_u(bits, lane, 1); bits |= lane_xor_u(bits, lane, 2); bits |= lane_xor_u(bits, lane, 4); }
        if (jj == 0) ((LAS unsigned*)(L + L_SELM))[qq] = bits;
        ATT_BAR();
    }
    { NSA_IDS(); park_store(oc, (LAS float*)(L + L_OST) + wid * 2048, lane); }
    {
        NSA_IDS();
        const unsigned selm = ((const LAS unsigned*)(L + L_SELM))[qloc];
        const bf16_t* Kg = pr + rowbase * DINP + slot_base(S_KSEL + g);
        const bf16_t* Vg = pr + rowbase * DINP + slot_base(S_VSEL + g);
        PolSel pol{qc + 1, qc, q, hi, selm, tbh};
        f32x16 o[2]; float l;
        flash_loop<64, true>(L, Kg, DINP, Vg, DINP, qr, pol, o, l, wid, lane);
        { f32x16 dummy[2]; park_acc<false>(dummy, (LAS float*)(L + L_OST) + wid * 2048, o, (l > 0.f) ? gate[(1 * 4 + rh) * 64 + qloc] / l : 0.f, wsf, lane); }
    }
    {
        NSA_IDS();
        const bf16_t* Kg = pr + rowbase * DINP + slot_base(S_KWIN + g);
        const bf16_t* Vg = pr + rowbase * DINP + slot_base(S_VWIN + g);
        PolWin pol{(qc < 8 ? qc : 8) + 1, qc, q, hi, tbh};
        f32x16 o[2]; float l;
        flash_loop<64, true>(L, Kg, DINP, Vg, DINP, qr, pol, o, l, wid, lane);
        f32x16 fin[2]; park_acc<true>(fin, (LAS float*)(L + L_OST) + wid * 2048, o, (l > 0.f) ? gate[(2 * 4 + rh) * 64 + qloc] / l : 0.f, wsf, lane);
        store_tile(fin, (bf16_t*)(ws + WS_MIX) + (rowbase + q0 + 32 * qh) * DM + 512 + 64 * h, DM, L, wid, lane, (float*)(ws + WS_SSQM) + 2 * (rowbase + q0 + 32 * qh) + 1);
    }
    ATT_BAR();
}
#undef ATT_BAR
#undef NSA_IDS
}

#define XB_TMO      128
#define XB_XCNT(j)  (256  + 64 * (j))
#define XB_XSUB(j)  (1280 + 64 * (j))
#define XB_XGEN(j)  (2304 + 64 * (j))
#define XB_TOP      3328
#define XB_TOPGEN   3392
#define XCD_BAR_WORDS 3456
#define XB_SPIN_CAP (1u << 18)

__device__ __forceinline__ unsigned xb_ld(unsigned* p)              { return __hip_atomic_load(p, __ATOMIC_RELAXED, __HIP_MEMORY_SCOPE_AGENT); }
__device__ __forceinline__ unsigned xb_add(unsigned* p, unsigned v) { return __hip_atomic_fetch_add(p, v, __ATOMIC_RELAXED, __HIP_MEMORY_SCOPE_AGENT); }
__device__ __forceinline__ unsigned xb_xcc_id() { return (unsigned)__builtin_amdgcn_s_getreg((3 << 11) | 20) & 0xFu; }
#define XB_SPIN(cond, bar) do { unsigned _sp = 0; while (cond) { __builtin_amdgcn_s_sleep(1); \
    if ((++_sp & 255u) == 0u) { if (xb_ld(&(bar)[XB_TMO])) break; if (_sp > XB_SPIN_CAP) { atomicAdd(&(bar)[XB_TMO], 1u); break; } } } } while (0)

struct XcdBarrier {
    unsigned* bar; unsigned x;
    volatile LAS unsigned* st;
};

__device__ __forceinline__ XcdBarrier xcd_barrier_post(unsigned* bar, volatile LAS unsigned* st) {
    XcdBarrier b; b.bar = bar; b.x = xb_xcc_id(); b.st = st;
    if (threadIdx.x == 0) (void)xb_add(&bar[XB_XCNT(b.x)], 1u);
    return b;
}
__device__ __forceinline__ void xcd_barrier_complete(unsigned* bar, unsigned x, unsigned& nloc, unsigned& nx) {
    const unsigned G = gridDim.x * gridDim.y * gridDim.z;
    unsigned sum, cnt, mine, sp = 0u;
    for (;;) {
        sum = 0u; cnt = 0u; mine = 0u;
#pragma unroll
        for (unsigned j = 0; j < 16; ++j) { const unsigned c = xb_ld(&bar[XB_XCNT(j)]); sum += c; cnt += (c > 0u) ? 1u : 0u; mine = (j == x) ? c : mine; }
        if (sum == G) break;
        __builtin_amdgcn_s_sleep(1);
        if ((++sp & 255u) == 0u) { if (xb_ld(&bar[XB_TMO])) break; if (sp > XB_SPIN_CAP) { atomicAdd(&bar[XB_TMO], 1u); break; } }
    }
    nloc = mine > 0u ? mine : 1u; nx = cnt > 0u ? cnt : 1u;
}

__device__ __forceinline__ void xcd_barrier(const XcdBarrier& b) {
    asm volatile("s_waitcnt vmcnt(0)" ::: "memory");
    __syncthreads();
    if (threadIdx.x == 0) {
        unsigned* bar = b.bar;
        __builtin_amdgcn_s_waitcnt(0);
        unsigned nloc = b.st[0], nx = b.st[1];
        if (nloc == 0u) { xcd_barrier_complete(bar, b.x, nloc, nx); b.st[0] = nloc; b.st[1] = nx; }
        const unsigned old = xb_add(&bar[XB_XSUB(b.x)], 1u);
        const unsigned gen = old / nloc;
        if (old + 1u == (gen + 1u) * nloc) {
            __builtin_amdgcn_fence(__ATOMIC_RELEASE, "agent");
            asm volatile("s_waitcnt vmcnt(0)" ::: "memory");
            const unsigned og = xb_add(&bar[XB_TOP], 1u);
            const unsigned tg = og / nx;
            if (og + 1u == (tg + 1u) * nx) xb_add(&bar[XB_TOPGEN], 1u);
            else XB_SPIN(xb_ld(&bar[XB_TOPGEN]) == tg, bar);
            __builtin_amdgcn_fence(__ATOMIC_ACQUIRE, "agent");
            xb_add(&bar[XB_XGEN(b.x)], 1u);
            asm volatile("s_waitcnt vmcnt(0)" ::: "memory");
        } else {
            XB_SPIN(xb_ld(&bar[XB_XGEN(b.x)]) == gen, bar);
            __builtin_amdgcn_fence(__ATOMIC_ACQUIRE, "agent");
            asm volatile("s_waitcnt vmcnt(0)" ::: "memory");
        }
    }
    __syncthreads();
}

__global__ void __launch_bounds__(512, 2) mega(Params p) {
    extern __shared__ __attribute__((aligned(16))) unsigned char lds[];
    const int G = gridDim.x, bid = blockIdx.x, NGW = G * NW;
    int wv = __builtin_amdgcn_readfirstlane((int)(threadIdx.x >> 6)); asm volatile("" : "+s"(wv));
#define PHASE_IDS() const int tid = opaque_tid(wv), lane = tid & 63, wave = __builtin_amdgcn_readfirstlane(tid >> 6), gw = bid * NW + wave; (void)tid; (void)lane; (void)gw
    unsigned char* ws = (unsigned char*)inptr(22);
    LAS unsigned char* L = (LAS unsigned char*)lds;
    volatile LAS unsigned* bst = (volatile LAS unsigned*)(L + LDS_BST);
    if (threadIdx.x < 4) bst[threadIdx.x] = 0u;
    __syncthreads();
    const XcdBarrier bar = xcd_barrier_post((unsigned*)(ws + WS_CTL), bst);
#if TS
    if (blockIdx.x == 0 && threadIdx.x == 0) ((unsigned long long*)(ws + 29 * MiB))[0] = __builtin_amdgcn_s_memrealtime();
#define STAMP(k) do { if (TS == (k) && blockIdx.x == 0 && threadIdx.x == 0) ((unsigned long long*)(ws + 29 * MiB))[1] = __builtin_amdgcn_s_memrealtime(); } while (0)
#else
#define STAMP(k) do {} while (0)
#endif

#if EXP == 5
    for (int e_ = 0; e_ < 2; ++e_)
#endif
    {
        PHASE_IDS();
        LAS float* scr = (LAS float*)(L + wave * 8704);
        constexpr int I0 = (1024 / 64) * (DINP / 32), I1 = (QR / 64) * (MQ / 32), I2 = (KVR / 64) * (MKV / 32), I3 = 16 * 32, I4 = 16 * (FF / 32), I5 = (FF / 64) * 32;
        constexpr int I6 = (2048 / 64) * (128 / 32), I7 = (128 / 64) * (64 / 32);
        constexpr int NIT = I0 + I1 + I2 + I3 + I4 + I5 + 2 * I6 + 2 * I7;
        for (int it = gw; it < NIT; it += NGW) {
            int r = it;
            if (r < I0) { p0_transpose_item(inptr(2), 1024, DIN, DINP, (bf16_t*)(ws + WS_WIN), scr, r, lane, inptr(1), 0, 1); continue; } r -= I0;
            if (r < I1) { p0_transpose_item(inptr(5), QR, MQ, MQ, (bf16_t*)(ws + WS_WUQ), scr, r, lane, inptr(3)); continue; } r -= I1;
            if (r < I2) { p0_transpose_item(inptr(6), KVR, MKV, MKV, (bf16_t*)(ws + WS_WUKV), scr, r, lane, inptr(4), 0, 2); continue; } r -= I2;
            if (r < I3) { const int k0_ = 64 * (r / 32); p0_transpose_item(inptr(17), 1024, 1024, 1024, (bf16_t*)(ws + WS_WO), scr, r, lane, k0_ < 512 ? inptr(15) : inptr(16) - 512); continue; } r -= I3;
            if (r < I4) { p0_transpose_item(inptr(19), 1024, FF, FF, (bf16_t*)(ws + WS_WUP), scr, r, lane, inptr(18)); continue; } r -= I4;
            if (r < I5) { p0_transpose_item(inptr(20), FF, 1024, 1024, (bf16_t*)(ws + WS_WDN), scr, r, lane, nullptr, LDH); continue; } r -= I5;
            if (r < 2 * I6) { const int kv = r / I6; p0_transpose_item(inptr(12) + (size_t)kv * 2048 * 128, 2048, 128, 128, (bf16_t*)(ws + WS_W1T) + (size_t)kv * 128 * 2048, scr, r % I6, lane); continue; } r -= 2 * I6;
            { const int kv = r / I7; p0_transpose_item(inptr(13) + kv * 128 * 64, 128, 64, 64, (bf16_t*)(ws + WS_W2T) + kv * 64 * 128, scr, r % I7, lane); }
        }
        for (int m = gw; m < M; m += 4 * NGW) rows_to_bf16_rstd<4>(inptr(0), (bf16_t*)(ws + WS_XB), (float*)(ws + WS_RS1), m, NGW, lane);
        for (int e = bid * 512 + tid; e < 2048 * 16; e += G * 512) { const int pos = e >> 4, i = e & 15; const float inv = exp2f(-(float)i * (13.287712379549449f / 16.f)); float sn, cs; sincosf((float)pos * inv, &sn, &cs);
            ((float*)(ws + WS_ROPE))[pos * 32 + i] = cs; ((float*)(ws + WS_ROPE))[pos * 32 + 16 + i] = sn; }
        for (int m = bid * 512 + tid; m < M; m += G * 512) { ((float*)(ws + WS_SSQ2))[m] = 0.f; ((float*)(ws + WS_RSQ))[m] = 0.f; ((float*)(ws + WS_RSKV))[m] = 0.f; ((float*)(ws + WS_SSQKR))[m] = 0.f; ((float*)(ws + WS_SSQM))[2 * m] = 0.f; ((float*)(ws + WS_SSQM))[2 * m + 1] = 0.f; }
    }
    xcd_barrier(bar);
    STAMP(1);
#if EXP == 1
    for (int e_ = 0; e_ < 10; ++e_) xcd_barrier(bar);
#endif
#if EXP == 10
    for (int e_ = 0; e_ < 2; ++e_)
#endif
    { pg8::Gemm g{(const bf16_t*)(ws + WS_XB), (const bf16_t*)(ws + WS_WIN), M, DINP, DM, DM, DM}; pg8::StaticOrder S; S.init(M, DINP, G, bid);
      PEpiProj E{(bf16_t*)(ws + WS_PROJ), DINP, (const float*)(ws + WS_RS1), (float*)(ws + WS_RSQ), (float*)(ws + WS_RSKV), (float*)(ws + WS_SSQKR), inptr(9), inptr(10), (const float*)(ws + WS_ROPE), inptr(8)}; pg8::gemm_phase<PEpiProj, pg8::StaticOrder, true, true>(L, g, S, E, wv); }
    xcd_barrier(bar);
    STAMP(2);
#if EXP == 3
    for (int e_ = 0; e_ < 2; ++e_)
#endif
    { PHASE_IDS();
      __syncthreads();
      for (int t = bid; t < 256; t += G) compress_block(ws, L, t, wv); }
#if EXP == 11
    for (int e_ = 0; e_ < 2; ++e_) {
#endif
    { pg8::Gemm g{(const bf16_t*)(ws + WS_PROJ) + P_HKV, (const bf16_t*)(ws + WS_WUKV), M, MKV, KVR, DINP, KVR}; pg8::StaticOrder S; S.init(M, MKV, G, bid);
      PEpiKV E{(bf16_t*)(ws + WS_KVM), (bf16_t*)(ws + WS_KMLA), (const bf16_t*)(ws + WS_PROJ), (const float*)(ws + WS_RSKV), (const float*)(ws + WS_SSQKR), (const float*)(ws + WS_ROPE), inptr(8)}; pg8::gemm_phase<PEpiKV, pg8::StaticOrder, true, true>(L, g, S, E, wv); }
    asm volatile("" : "+s"(wv));
    { pg8::Gemm g{(const bf16_t*)(ws + WS_PROJ) + P_HQ, (const bf16_t*)(ws + WS_WUQ), M, MQ, QR, DINP, QR}; pg8::StaticOrder S; S.init(M, MQ, G, bid);
      PEpiBf16<0> E{(bf16_t*)(ws + WS_QM), MQ, (const float*)(ws + WS_RSQ), 1.f / QR}; pg8::gemm_phase<PEpiBf16<0>, pg8::StaticOrder, true, false>(L, g, S, E, wv); }
#if EXP == 11
    }
#endif
    xcd_barrier(bar);
    STAMP(5);
#if EXP == 2
    for (int e_ = 0; e_ < 2; ++e_)
#endif
    {
        PHASE_IDS();
        LAS float* tb = (LAS float*)L;
        for (int i = tid; i < 8 * 128; i += 512) { const int h = i >> 7, n = i & 127; tb[i] = (inptr(14)[t5_bucket(n) * 8 + h] - inptr(14)[31 * 8 + h]) * LOG2E; }
        __syncthreads();
        const int vcu = (G % 8 == 0) ? (bid % 8) * (G / 8) + bid / 8 : bid;
        for (int pr_ = vcu; pr_ < 256; pr_ += G) {
            { const int bg = pr_ >> 4, s_ = pr_ & 15;
#pragma unroll 1
              for (int u_ = 0; u_ < (EXP == 8 ? 4 : 2); ++u_) att::nsa_unit(ws, L, bg >> 1, bg & 1, (u_ & 1) ? s_ : 31 - s_, wv);
            }
            { const int bh = pr_ >> 2, s_ = pr_ & 3;
#pragma unroll 1
              for (int u_ = 0; u_ < (EXP == 9 ? 4 : 2); ++u_) att::mla_unit(ws, L, bh >> 3, bh & 7, (u_ & 1) ? s_ : 7 - s_, wv);
            }
        }
    }
    xcd_barrier(bar);
    STAMP(7);
    { pg8::Gemm g{(const bf16_t*)(ws + WS_MIX), (const bf16_t*)(ws + WS_WO), M, DM, DM, DM, DM}; pg8::StaticOrder S; S.init(M, DM, G, bid);
      PEpiWo E{(const bf16_t*)(ws + WS_XB), (bf16_t*)(ws + WS_H2), (float*)(ws + WS_SSQ2), (const float*)(ws + WS_SSQM), DM}; pg8::gemm_phase<PEpiWo, pg8::StaticOrder, true, true>(L, g, S, E, wv); }
    xcd_barrier(bar);
    STAMP(9);
#if EXP == 4
    for (int e_ = 0; e_ < 2; ++e_)
#endif
    { pg8::Gemm g{(const bf16_t*)(ws + WS_H2), (const bf16_t*)(ws + WS_WUP), M, FF, DM, DM, DM}; pg8::StaticOrder S; S.init(M, FF, G, bid);
      PEpiBf16<2> E{(bf16_t*)(ws + WS_HID), LDH, (const float*)(ws + WS_SSQ2), 1.f / 1024}; pg8::gemm_phase<PEpiBf16<2>, pg8::StaticOrder, true, true>(L, g, S, E, wv); }
    xcd_barrier(bar);
    STAMP(10);
    { pg8::Gemm g{(const bf16_t*)(ws + WS_HID), (const bf16_t*)(ws + WS_WDN), M, DM, FF, LDH, LDH}; pg8::StaticOrder S; S.init(M, DM, G, bid);
      PEpiDown E{(const bf16_t*)(ws + WS_H2), ((float*)inptr(21)), DM}; pg8::gemm_phase<PEpiDown, pg8::StaticOrder, true, true>(L, g, S, E, wv); }
#if TS
    xcd_barrier(bar);
    if (blockIdx.x == 0 && threadIdx.x == 0) { const unsigned long long* tt = (const unsigned long long*)(ws + 29 * MiB); const float dlt = (TS == 100) ? 150.f : (float)(tt[1] - tt[0]) * (1.f / 256.f); ((float*)inptr(21))[0] += dlt; }
#endif
}

extern "C" void kernel_launch(void* const* d_in, const int* in_sizes, int n_in, void* d_out, int out_size,
                              void* d_ws, size_t ws_size, hipStream_t stream) {
    static int grid_blocks = 0;
    if (!grid_blocks) {
        int dev = 0, cus = 0, per_cu = 0;
        (void)hipGetDevice(&dev);
        (void)hipDeviceGetAttribute(&cus, hipDeviceAttributeMultiprocessorCount, dev);
        (void)hipFuncSetAttribute((const void*)mega, hipFuncAttributeMaxDynamicSharedMemorySize, LDS_BYTES);
        (void)hipOccupancyMaxActiveBlocksPerMultiprocessor(&per_cu, (const void*)mega, 512, LDS_BYTES);
        if (per_cu != 1) fprintf(stderr, "note: occupancy query reports %d blocks/CU; launching 1 per CU\n", per_cu);
        grid_blocks = cus;
        if (n_in != 21 || out_size != M * DM || ws_size < 256 * MiB) fprintf(stderr, "unexpected shapes: n_in %d out %d ws %zu\n", n_in, out_size, ws_size);
    }
    Params p{};
    for (int i = 0; i < 21; ++i) p.in[i] = (const float*)d_in[i];
    p.out = (float*)d_out; p.ws = (unsigned char*)d_ws;
    if (hipMemsetAsync((char*)d_ws + WS_CTL, 0, CTL_ZERO_BYTES, stream) != hipSuccess) { fprintf(stderr, "memset of the barrier words failed\n"); return; }
    hipLaunchKernelGGL(mega, dim3(grid_blocks), dim3(512), LDS_BYTES, stream, p);
    hipError_t e = hipPeekAtLastError();
    if (e != hipSuccess) fprintf(stderr, "launch failed: %s (grid %d)\n", hipGetErrorString(e), grid_blocks);
}
```

```cpp
#ifndef EXP
#define EXP 0
#endif
#ifndef TS
#define TS 0
#endif
#include <hip/hip_runtime.h>
#include <cstdio>
#include <cstdint>

#define LAS __attribute__((address_space(3)))
typedef unsigned short bf16_t;
typedef short bf16x8 __attribute__((ext_vector_type(8)));
typedef float f32x4 __attribute__((ext_vector_type(4)));
typedef unsigned u32x4 __attribute__((ext_vector_type(4)));
typedef unsigned u32x2 __attribute__((ext_vector_type(2)));

constexpr int BATCH = 8, SEQ = 2048, DM = 1024, M = BATCH * SEQ;
constexpr int DIN = 1976, DINP = 2048;
constexpr int C_HQ = 0, C_HKV = 384, C_HKR = 640, C_QB = 672, C_KVB = 1184, C_GATE = 1952;
constexpr int C_KCMP = C_KVB, C_VCMP = C_KVB + 128, C_KSEL = C_KVB + 256, C_VSEL = C_KVB + 384, C_KWIN = C_KVB + 512, C_VWIN = C_KVB + 640;
constexpr int P_HQ = 1280, P_HKV = 1664, P_HKR = 1920, P_GATE = 1952;
__host__ __device__ constexpr int slot_base(int s) { return 256 * (s >> 2) + 32 * (s & 3); }
constexpr int S_Q = 0, S_KCMP = 8, S_VCMP = 10, S_KSEL = 12, S_VSEL = 14, S_KWIN = 16, S_VWIN = 18;
constexpr int QR = 384, KVR = 256, MQ = 768, MKV = 1024, FF = 4096;
constexpr int LDH = FF + 64;
constexpr int NCMP = 127;
constexpr float EPS = 1e-6f;
constexpr float LOG2E = 1.4426950408889634f;
constexpr float QS_MLA = 0.10206207261596577f * LOG2E;
constexpr float QS_NSA = 0.125f * LOG2E;

constexpr size_t MiB = 1u << 20;
constexpr size_t WS_CTL = 0, CTL_ZERO_BYTES = 65536;
constexpr size_t WS_WIN = 1 * MiB, WS_WUQ = 5 * MiB, WS_WUKV = 6 * MiB, WS_WO = 7 * MiB, WS_WUP = 9 * MiB, WS_WDN = 17 * MiB;
constexpr size_t WS_KCMP = 26 * MiB, WS_VCMP = 26 * MiB + 512 * 1024;
constexpr size_t WS_W1T = 30 * MiB;
constexpr size_t WS_W2T = 27 * MiB;
constexpr size_t WS_RSQ = 28 * MiB, WS_RSKV = 28 * MiB + 65536, WS_SSQ2 = 28 * MiB + 131072, WS_SSQM = 28 * MiB + 262144, WS_RS1 = 28 * MiB + 262144 + 131072;
constexpr size_t WS_SSQKR = 28 * MiB + 524288;
constexpr size_t WS_ROPE = 29 * MiB + 65536;
constexpr size_t WS_XB = 32 * MiB;
constexpr size_t WS_DUMMY0 = 0;
constexpr size_t WS_HB = 32 * MiB;
constexpr size_t WS_MIX = 64 * MiB;
constexpr size_t WS_PROJ = 96 * MiB;
constexpr size_t WS_QM = 160 * MiB;
constexpr size_t WS_KVM = 184 * MiB;
constexpr size_t WS_KMLA = 216 * MiB;
constexpr size_t WS_QN = 208 * MiB;
constexpr size_t WS_KSEL = 240 * MiB;
constexpr size_t WS_KWIN = 244 * MiB;
constexpr size_t WS_HQN = 232 * MiB;
constexpr size_t WS_HKVN = 244 * MiB;
constexpr size_t WS_H2 = 224 * MiB;
constexpr size_t WS_HID = 32 * MiB;

constexpr int LDS_BYTES = 155648, LDS_BST = 154624;
constexpr int NW = 8;

struct Params {
    const float* in[21];
    float* out;
    unsigned char* ws;
};

typedef const float* cfptr_t;
__device__ __forceinline__ const float* inptr(int i) {
    const __attribute__((address_space(4))) char* ka = (const __attribute__((address_space(4))) char*)__builtin_amdgcn_kernarg_segment_ptr();
    int off = i * 8; asm volatile("" : "+s"(off));
    return *(const __attribute__((address_space(4))) cfptr_t*)(ka + off);
}
__device__ __forceinline__ unsigned f2bf(float f) { unsigned u = __builtin_bit_cast(unsigned, f); return (u + 0x7fffu + ((u >> 16) & 1u)) >> 16; }
__device__ __forceinline__ float bf2f(unsigned b) { return __builtin_bit_cast(float, b << 16); }
__device__ __forceinline__ unsigned pk2(float lo, float hi) { return f2bf(lo) | (f2bf(hi) << 16); }
__device__ __forceinline__ float wave_sum(float v) {
#pragma unroll
    for (int o = 1; o < 64; o <<= 1) v += __shfl_xor(v, o);
    return v;
}
__device__ __forceinline__ float wave_max(float v) {
#pragma unroll
    for (int o = 1; o < 64; o <<= 1) v = fmaxf(v, __shfl_xor(v, o));
    return v;
}
__device__ __forceinline__ int t5_bucket(int n) {
    if (n < 16) return n;
    int b = 16;
    b += (n >= 19); b += (n >= 21); b += (n >= 24); b += (n >= 27); b += (n >= 31); b += (n >= 35); b += (n >= 40); b += (n >= 46);
    b += (n >= 52); b += (n >= 59); b += (n >= 67); b += (n >= 77); b += (n >= 87); b += (n >= 99); b += (n >= 113);
    return b;
}

__device__ __forceinline__ void p0_transpose_item(const float* W, int K, int N, int Npad, bf16_t* WT, LAS float* scr, int item, int lane, const float* gk = nullptr, int ldw = 0, int projmap = 0) {
    const int nblk = Npad / 32, kb = item / nblk, nb = item % nblk, k0 = 64 * kb, n0 = 32 * nb;
    int nsrc = n0;
    if (projmap == 2) { const int pn_ = n0 >> 8, bj_ = (n0 >> 7) & 1, wc_ = (n0 >> 5) & 3; nsrc = (wc_ < 2 ? 128 * (2 * pn_ + wc_) : 128 * (2 * pn_ + wc_ - 2) + 64) + 32 * bj_; }
    else if (projmap) { if (n0 < 1280) { const int sl = 4 * (n0 >> 8) + ((n0 & 127) >> 5), e0 = 32 * ((n0 >> 7) & 1); nsrc = (sl < 8 ? C_QB + 64 * sl : C_KVB + 64 * (sl - 8)) + e0; }
                   else if (n0 < 1280 + 672) nsrc = n0 - 1280; else if (n0 == P_GATE) nsrc = C_GATE; else nsrc = N; }
    const int nn = nsrc + (lane & 31);
    float wv[32];
#pragma unroll
    for (int i = 0; i < 32; ++i) { const int kk = 2 * i + (lane >> 5); wv[i] = (nn < N) ? W[(size_t)(k0 + kk) * N + nn] : 0.f; }
#pragma unroll
    for (int i = 0; i < 32; ++i) { const int kk = 2 * i + (lane >> 5); const float gg = gk ? gk[k0 + kk] : 1.f; scr[kk * 33 + (lane & 31)] = wv[i] * gg; }
    asm volatile("s_waitcnt lgkmcnt(0)" ::: "memory");
    const int c = lane & 7;
#pragma unroll
    for (int j = 0; j < 4; ++j) { const int n = (lane >> 3) + 8 * j; const LAS float* s = scr + (8 * c) * 33 + n;
        u32x4 o; o.x = pk2(s[0 * 33], s[1 * 33]); o.y = pk2(s[2 * 33], s[3 * 33]); o.z = pk2(s[4 * 33], s[5 * 33]); o.w = pk2(s[6 * 33], s[7 * 33]);
        *(u32x4*)(WT + (size_t)(n0 + n) * (ldw ? ldw : K) + k0 + 8 * c) = o; }
    asm volatile("s_waitcnt lgkmcnt(0)" ::: "memory");
}
template <int NR>
__device__ __forceinline__ void rows_to_bf16_rstd(const float* x, bf16_t* o, float* rstd_out, int row0, int rstride, int lane) {
    f32x4 v[NR][4];
#pragma unroll
    for (int r = 0; r < NR; ++r) { const int rr = (row0 + r * rstride < M) ? row0 + r * rstride : row0; const f32x4* xr = (const f32x4*)(x + (size_t)rr * DM) + lane;
#pragma unroll
        for (int j = 0; j < 4; ++j) v[r][j] = xr[64 * j]; }
#pragma unroll
    for (int r = 0; r < NR; ++r) { if (row0 + r * rstride >= M) continue; float s = 0.f;
#pragma unroll
        for (int j = 0; j < 4; ++j) s += (v[r][j].x * v[r][j].x + v[r][j].y * v[r][j].y) + (v[r][j].z * v[r][j].z + v[r][j].w * v[r][j].w);
        s = wave_sum(s);
        if (lane == 0) rstd_out[row0 + r * rstride] = 1.f / sqrtf(s * (1.f / DM) + EPS);
        unsigned long long* o8 = (unsigned long long*)(o + (size_t)(row0 + r * rstride) * DM) + lane;
#pragma unroll
        for (int j = 0; j < 4; ++j) o8[64 * j] = (unsigned long long)pk2(v[r][j].x, v[r][j].y) | ((unsigned long long)pk2(v[r][j].z, v[r][j].w) << 32); }
}

__device__ __forceinline__ int opaque_tid(int wv) { int lane; asm volatile("v_mbcnt_lo_u32_b32 %0, -1, 0\n\tv_mbcnt_hi_u32_b32 %0, -1, %0" : "=v"(lane)); return (wv << 6) | lane; }
namespace pg8 {
#define PG8_LAS __attribute__((address_space(3)))
typedef unsigned short bf16_t;
typedef short bf16x8 __attribute__((ext_vector_type(8)));
typedef float f32x4 __attribute__((ext_vector_type(4)));
typedef unsigned u32x4 __attribute__((ext_vector_type(4)));
constexpr int BM = 256, BK = 64, HALF = 128, HTB = HALF * BK * 2  , STAGE_BYTES = 8 * HTB, NXCD = 8, WGM = 8;

__host__ __device__ __forceinline__ int lds_byte(int r, int c) { const int st = (r >> 4) * 2 + (c >> 5), rr = r & 15, cc = c & 31, ob = rr * 64 + cc * 2; return st * 1024 + (ob ^ (((ob >> 9) & 1) << 5)); }
__host__ __device__ __forceinline__ void stage_rc(int b, int& R, int& C) { const int st = b / 1024, sb = b % 1024, swz = sb ^ (((sb >> 9) & 1) << 5); R = (st >> 1) * 16 + swz / 64; C = (st & 1) * 32 + (swz % 64) / 2; }
__host__ __device__ __forceinline__ int perm32(int rho) { const int n = rho >> 4, i = rho & 15; return 8 * (i >> 2) + 4 * n + (i & 3); }

struct Unit { int pm, pn; };
struct Gemm { const bf16_t* A; const bf16_t* Bt; int M, N, K, lda, ldb; };

struct StaticOrder {
    int nM, nN, nwg, G, c;
    __host__ __device__ void init(int M, int N, int G_, int c_) { nM = M / BM; nN = N / BM; nwg = nM * nN; G = G_; c = c_; }
    __host__ __device__ bool next(int i, Unit& u) const {
        const long L = (long)i * G + c; if (L >= nwg) return false;
        int wgid = (int)L; { const int q = nwg / NXCD, r = nwg % NXCD, xcd = wgid % NXCD, off = wgid / NXCD; wgid = (xcd < r ? xcd * (q + 1) : r * (q + 1) + (xcd - r) * q) + off; }
        const int nig = WGM * nN, gid = wgid / nig, fm = gid * WGM, gsz = (nM - fm) < WGM ? (nM - fm) : WGM;
        u.pm = fm + ((wgid % nig) % gsz); u.pn = (wgid % nig) / gsz; return true;
    }
    __device__ __forceinline__ void a_ready(const Unit&) const {}
    __device__ __forceinline__ void done(const Unit&) const {}
};

template <class Epi, class Sched, bool ALIGN_EPI = false, bool SP2 = false>
__device__ __forceinline__ void gemm_phase(PG8_LAS unsigned char* lds, const Gemm g, const Sched& S, const Epi& E, int wv) {
    const int tid = opaque_tid(wv), wid = __builtin_amdgcn_readfirstlane(tid >> 6), lane = tid & 63, wr = wid >> 2, wc = wid & 3, fr = lane & 15, fq = lane >> 4;
    const int K = g.K, nt = K / BK;
    unsigned voffA[2], voffB[2];
#pragma unroll
    for (int i = 0; i < 2; ++i) { int R, C; stage_rc(tid * 16 + i * 8192, R, C); const int Rb = Epi::PERM ? ((R & ~31) + perm32(R & 31)) : R;
        voffA[i] = (unsigned)(R * g.lda + C) * 2u; voffB[i] = (unsigned)(Rb * g.ldb + C) * 2u; }
    const size_t kstep = (size_t)(BK * 2);
    const size_t hstepA = (size_t)HALF * g.lda * 2, hstepB = (size_t)HALF * g.ldb * 2;
    const size_t tstepA = 2 * hstepA, tstepB = 2 * hstepB;
    const unsigned ldsw = (unsigned)wid * 1024u;
    const int aoff = lds_byte(wr * 64 + fr, fq * 8), boff = lds_byte(wc * 32 + fr, fq * 8);
#define PG8_SA(b, h) (((b) * 2 + (h)) * HTB)
#define PG8_SB(b, h) ((4 + (b) * 2 + (h)) * HTB)
#define PG8_STAGE(bufoff, gbase, voff) do { _Pragma("unroll") for (int _i = 0; _i < 2; ++_i) \
        __builtin_amdgcn_global_load_lds((const unsigned*)((const char*)(gbase) + (voff)[_i]), (PG8_LAS unsigned*)(lds + (bufoff) + ldsw + _i * 8192), 16, 0, 0); } while (0)
#define PG8_LDA(dst, b, h) do { _Pragma("unroll") for (int m = 0; m < 4; ++m) _Pragma("unroll") for (int k = 0; k < 2; ++k) dst[m][k] = *(const PG8_LAS bf16x8*)(lds + PG8_SA(b, h) + aoff + m * 2048 + k * 1024); } while (0)
#define PG8_LDB(dst, b, h) do { _Pragma("unroll") for (int n = 0; n < 2; ++n) _Pragma("unroll") for (int k = 0; k < 2; ++k) dst[n][k] = *(const PG8_LAS bf16x8*)(lds + PG8_SB(b, h) + boff + n * 2048 + k * 1024); } while (0)
#define PG8_MMA(ai, bj, At, Bt) do { __builtin_amdgcn_s_setprio(1); _Pragma("unroll") for (int m = 0; m < 4; ++m) _Pragma("unroll") for (int n = 0; n < 2; ++n) _Pragma("unroll") for (int k = 0; k < 2; ++k) \
        acc[ai][bj][m][n] = __builtin_amdgcn_mfma_f32_16x16x32_bf16(Bt[n][k], At[m][k], acc[ai][bj][m][n], 0, 0, 0); __builtin_amdgcn_s_setprio(0); } while (0)
#define PG8_WAIT_V(n) asm volatile("s_waitcnt vmcnt(" #n ")" ::: "memory")
#define PG8_WAIT_L(n) asm volatile("s_waitcnt lgkmcnt(" #n ")" ::: "memory")
#define PG8_BAR __builtin_amdgcn_s_barrier()
#define PG8_SCHED __builtin_amdgcn_sched_barrier(0)
    Unit cur, nxt; int ui = 0;
    if (!S.next(0, cur)) return;
    f32x4 acc[2][2][4][2];
#pragma unroll
    for (int a = 0; a < 2; ++a)
#pragma unroll
        for (int b = 0; b < 2; ++b)
#pragma unroll
            for (int m = 0; m < 4; ++m)
#pragma unroll
                for (int n = 0; n < 2; ++n) acc[a][b][m][n] = (f32x4){0.f, 0.f, 0.f, 0.f};
    bf16x8 At[4][2], B0[2][2], B1[2][2];
    const char* cA = (const char*)g.A + (size_t)cur.pm * tstepA; const char* cB = (const char*)g.Bt + (size_t)cur.pn * tstepB;
    asm volatile("" : "+s"(cA), "+s"(cB));
    S.a_ready(cur);
    if constexpr (SP2) {
        PG8_STAGE(PG8_SB(0, 0), cB, voffB); PG8_STAGE(PG8_SB(0, 1), cB + hstepB, voffB); PG8_STAGE(PG8_SA(0, 0), cA, voffA); PG8_STAGE(PG8_SA(0, 1), cA + hstepA, voffA);
        if (wr == 1) PG8_BAR;
        PG8_WAIT_V(2); PG8_BAR;
        PG8_STAGE(PG8_SB(1, 0), cB + kstep, voffB); PG8_STAGE(PG8_SA(1, 0), cA + kstep, voffA); PG8_STAGE(PG8_SB(1, 1), cB + hstepB + kstep, voffB);
        PG8_WAIT_V(6); PG8_BAR;
    } else {
        PG8_STAGE(PG8_SB(0, 0), cB, voffB); PG8_STAGE(PG8_SA(0, 0), cA, voffA); PG8_STAGE(PG8_SB(0, 1), cB + hstepB, voffB); PG8_STAGE(PG8_SA(0, 1), cA + hstepA, voffA);
        if (wr == 1) PG8_BAR;
        PG8_WAIT_V(4); PG8_BAR;
        PG8_STAGE(PG8_SB(1, 0), cB + kstep, voffB); PG8_STAGE(PG8_SA(1, 0), cA + kstep, voffA); PG8_STAGE(PG8_SB(1, 1), cB + hstepB + kstep, voffB);
        PG8_WAIT_V(6); PG8_BAR;
    }
    for (;;) {
        const bool has_next = S.next(ui + 1, nxt);
        const char* nA = has_next ? (const char*)g.A + (size_t)nxt.pm * tstepA : cA; const char* nB = has_next ? (const char*)g.Bt + (size_t)nxt.pn * tstepB : cB;
        asm volatile("" : "+s"(nA), "+s"(nB));
        for (int t = 0; t < nt; t += 2) {
            if constexpr (Epi::MIDSCALE) { if (t == nt / 2) E.midscale(acc, cur, wr, fr); }
            const bool last = (t == nt - 2);
            const char* a1 = cA + (size_t)(t + 1) * kstep;
            const char* a2 = last ? nA : cA + (size_t)(t + 2) * kstep; const char* b2 = last ? nB : cB + (size_t)(t + 2) * kstep;
            const char* a3 = a2 + kstep; const char* b3 = b2 + kstep;
            asm volatile("" : "+s"(a1), "+s"(a2), "+s"(b2), "+s"(a3), "+s"(b3));
            if (last && has_next) S.a_ready(nxt);
            if constexpr (SP2) {
            PG8_LDB(B0, 0, 0); PG8_LDB(B1, 0, 1); PG8_SCHED; PG8_LDA(At, 0, 0); PG8_STAGE(PG8_SA(1, 1), a1 + hstepA, voffA);
            PG8_WAIT_V(8); PG8_WAIT_L(0); PG8_BAR; PG8_MMA(0, 0, At, B0); PG8_MMA(0, 1, At, B1); PG8_BAR; PG8_SCHED;
            PG8_LDA(At, 0, 1); PG8_STAGE(PG8_SB(0, 0), b2, voffB); PG8_STAGE(PG8_SB(0, 1), b2 + hstepB, voffB); PG8_STAGE(PG8_SA(0, 0), a2, voffA);
            PG8_WAIT_V(8); PG8_WAIT_L(0); PG8_BAR; PG8_MMA(1, 0, At, B0); PG8_MMA(1, 1, At, B1); PG8_BAR; PG8_SCHED;
            PG8_LDB(B0, 1, 0); PG8_LDB(B1, 1, 1); PG8_SCHED; PG8_LDA(At, 1, 0); PG8_STAGE(PG8_SA(0, 1), a2 + hstepA, voffA);
            PG8_WAIT_V(8); PG8_WAIT_L(0); PG8_BAR; PG8_MMA(0, 0, At, B0); PG8_MMA(0, 1, At, B1); PG8_BAR; PG8_SCHED;
            PG8_LDA(At, 1, 1); PG8_STAGE(PG8_SB(1, 0), b3, voffB); PG8_STAGE(PG8_SB(1, 1), b3 + hstepB, voffB); PG8_STAGE(PG8_SA(1, 0), a3, voffA);
            PG8_WAIT_V(8); PG8_WAIT_L(0); PG8_BAR; PG8_MMA(1, 0, At, B0); PG8_MMA(1, 1, At, B1); PG8_BAR; PG8_SCHED;
            } else {
            PG8_LDB(B0, 0, 0); PG8_SCHED; PG8_LDA(At, 0, 0); PG8_STAGE(PG8_SA(1, 1), a1 + hstepA, voffA);
            PG8_WAIT_L(8); PG8_BAR; PG8_WAIT_L(0); PG8_MMA(0, 0, At, B0); PG8_BAR; PG8_SCHED;
            PG8_LDB(B1, 0, 1); PG8_STAGE(PG8_SB(0, 0), b2, voffB);
            PG8_BAR; PG8_WAIT_L(0); PG8_MMA(0, 1, At, B1); PG8_BAR;
            PG8_LDA(At, 0, 1); PG8_STAGE(PG8_SA(0, 0), a2, voffA);
            PG8_BAR; PG8_WAIT_L(0); PG8_MMA(1, 0, At, B0); PG8_BAR; PG8_SCHED;
            PG8_STAGE(PG8_SB(0, 1), b2 + hstepB, voffB);
            PG8_WAIT_V(6); PG8_BAR; PG8_MMA(1, 1, At, B1); PG8_BAR;
            PG8_LDB(B0, 1, 0); PG8_SCHED; PG8_LDA(At, 1, 0); PG8_STAGE(PG8_SA(0, 1), a2 + hstepA, voffA);
            PG8_WAIT_L(8); PG8_BAR; PG8_WAIT_L(0); PG8_MMA(0, 0, At, B0); PG8_BAR; PG8_SCHED;
            PG8_LDB(B1, 1, 1); PG8_STAGE(PG8_SB(1, 0), b3, voffB);
            PG8_BAR; PG8_WAIT_L(0); PG8_MMA(0, 1, At, B1); PG8_BAR;
            PG8_LDA(At, 1, 1); PG8_STAGE(PG8_SA(1, 0), a3, voffA);
            PG8_BAR; PG8_WAIT_L(0); PG8_MMA(1, 0, At, B0); PG8_BAR; PG8_SCHED;
            PG8_STAGE(PG8_SB(1, 1), b3 + hstepB, voffB);
            PG8_WAIT_V(6); PG8_BAR; PG8_MMA(1, 1, At, B1); PG8_BAR;
            }
        }
        if constexpr (ALIGN_EPI) { if (wr == 0) PG8_BAR; }
        if constexpr (!Epi::AFTER_DRAIN) { const int l2_ = opaque_tid(wv) & 63; E(acc, cur, wr, wc, l2_ & 15, l2_ >> 4); S.done(cur); }
        if (!has_next) break;
#pragma unroll
        for (int a = 0; a < 2; ++a)
#pragma unroll
            for (int b = 0; b < 2; ++b)
#pragma unroll
                for (int m = 0; m < 4; ++m)
#pragma unroll
                    for (int n = 0; n < 2; ++n) acc[a][b][m][n] = (f32x4){0.f, 0.f, 0.f, 0.f};
        cur = nxt; cA = nA; cB = nB; ++ui;
        if constexpr (ALIGN_EPI) { if (wr == 1) PG8_BAR; }
    }
    PG8_WAIT_V(0);
    if constexpr (!ALIGN_EPI) { if (wr == 0) PG8_BAR; }
    PG8_BAR;
    if constexpr (Epi::AFTER_DRAIN) { E.fused(acc, cur, wr, wc, fr, fq, lds, wid, lane); S.done(cur); }
#undef PG8_SA
#undef PG8_SB
#undef PG8_STAGE
#undef PG8_LDA
#undef PG8_LDB
#undef PG8_MMA
#undef PG8_WAIT_V
#undef PG8_WAIT_L
#undef PG8_BAR
#undef PG8_SCHED
}
}

__device__ __forceinline__ unsigned cvt_pk_bf16(float lo, float hi) { unsigned r; asm volatile("v_cvt_pk_bf16_f32 %0, %1, %2" : "=v"(r) : "v"(lo), "v"(hi)); return r; }
template <int ACT> struct PEpiBf16 {
    static constexpr bool PERM = true, AFTER_DRAIN = false, MIDSCALE = false;
    bf16_t* O; int ldc; const float* rs; float invn;
    __device__ __forceinline__ void operator()(const f32x4 (&acc)[2][2][4][2], const pg8::Unit& u, int wr, int wc, int fr, int fq) const {
        const int row0 = u.pm * 256 + wr * 64 + fr, col0 = u.pn * 256 + wc * 32 + 8 * fq;
        float rsc[2][4];
#pragma unroll
        for (int ai = 0; ai < 2; ++ai)
#pragma unroll
            for (int m = 0; m < 4; ++m) rsc[ai][m] = rs ? rs[row0 + ai * 128 + m * 16] : 1.f;
        if (invn > 0.f) {
#pragma unroll
            for (int ai = 0; ai < 2; ++ai)
#pragma unroll
                for (int m = 0; m < 4; ++m) rsc[ai][m] = 1.f / sqrtf(rsc[ai][m] * invn + EPS); }
#pragma unroll
        for (int ai = 0; ai < 2; ++ai)
#pragma unroll
            for (int m = 0; m < 4; ++m) { bf16_t* rowp = O + (size_t)(row0 + ai * 128 + m * 16) * ldc + col0; const float sc_ = rsc[ai][m];
#pragma unroll
                for (int bj = 0; bj < 2; ++bj) { f32x4 v0 = acc[ai][bj][m][0] * sc_, v1 = acc[ai][bj][m][1] * sc_;
                    if (ACT == 2) {
#pragma unroll
                        for (int e = 0; e < 4; ++e) { const float a = fmaxf(v0[e], 0.f), b = fmaxf(v1[e], 0.f); v0[e] = a * a; v1[e] = b * b; } }
                    u32x4 w; w.x = cvt_pk_bf16(v0[0], v0[1]); w.y = cvt_pk_bf16(v0[2], v0[3]); w.z = cvt_pk_bf16(v1[0], v1[1]); w.w = cvt_pk_bf16(v1[2], v1[3]);
                    *(u32x4*)(rowp + bj * 128) = w; } }
    }
};
struct PEpiProj {
    static constexpr bool PERM = true, AFTER_DRAIN = false, MIDSCALE = false;
    bf16_t* O; int ldc; const float* rs1; float* ssq_q; float* ssq_kv; float* ssq_kr; const float* qgain; const float* kgain; const float* rope; const float* kgm;
    __device__ __forceinline__ void operator()(const f32x4 (&acc)[2][2][4][2], const pg8::Unit& u, int wr, int wc, int fr, int fq) const {
        const int row0 = u.pm * 256 + wr * 64 + fr, col0 = u.pn * 256 + wc * 32 + 8 * fq, lane = fq * 16 + fr;
        float rsc[2][4];
#pragma unroll
        for (int ai = 0; ai < 2; ++ai)
#pragma unroll
            for (int m = 0; m < 4; ++m) rsc[ai][m] = rs1[row0 + ai * 128 + m * 16];
        const int sl = 4 * u.pn + wc;
        int mode = 0; const float* g = nullptr; float gs = 1.f;
        if (u.pn < 5) { if (sl < 8) { mode = 1; g = qgain; gs = QS_NSA; } else if (sl == S_KSEL || sl == S_KSEL + 1) { mode = 1; g = kgain + 64; } else if (sl == S_KWIN || sl == S_KWIN + 1) { mode = 1; g = kgain + 128; } }
        f32x4 ga[2][2];
        if (mode == 1) {
#pragma unroll
            for (int bj = 0; bj < 2; ++bj) { ga[bj][0] = *(const f32x4*)(g + 32 * bj + 8 * fq) * gs; ga[bj][1] = *(const f32x4*)(g + 32 * bj + 8 * fq + 4) * gs; } }
#pragma unroll
        for (int ai = 0; ai < 2; ++ai)
#pragma unroll
            for (int m = 0; m < 4; ++m) { const int row = row0 + ai * 128 + m * 16; bf16_t* rowp = O + (size_t)row * ldc + col0; const float sc_ = rsc[ai][m];
                f32x4 v[2][2];
#pragma unroll
                for (int bj = 0; bj < 2; ++bj) { v[bj][0] = acc[ai][bj][m][0] * sc_; v[bj][1] = acc[ai][bj][m][1] * sc_; }
                if (mode == 1) {
                    float ss = 0.f;
#pragma unroll
                    for (int bj = 0; bj < 2; ++bj)
#pragma unroll
                        for (int n = 0; n < 2; ++n) ss += (v[bj][n][0] * v[bj][n][0] + v[bj][n][1] * v[bj][n][1]) + (v[bj][n][2] * v[bj][n][2] + v[bj][n][3] * v[bj][n][3]);
                    ss += __builtin_bit_cast(float, __builtin_amdgcn_ds_bpermute((lane ^ 16) << 2, __builtin_bit_cast(int, ss)));
                    ss += __builtin_bit_cast(float, __builtin_amdgcn_ds_bpermute((lane ^ 32) << 2, __builtin_bit_cast(int, ss)));
                    const float rstd = 1.f / sqrtf(ss * (1.f / 64) + EPS);
#pragma unroll
                    for (int bj = 0; bj < 2; ++bj) { v[bj][0] = v[bj][0] * rstd * ga[bj][0]; v[bj][1] = v[bj][1] * rstd * ga[bj][1]; }
                } else if (u.pn >= 5) {
#pragma unroll
                    for (int bj = 0; bj < 2; ++bj) { const int cb = u.pn * 256 + bj * 128;
                        float* dst = (cb < P_HKV) ? ssq_q : (cb < P_HKR ? ssq_kv : ((cb == P_HKR && wc == 0) ? ssq_kr : nullptr));
                        if (dst) { float ss = (v[bj][0][0] * v[bj][0][0] + v[bj][0][1] * v[bj][0][1]) + (v[bj][0][2] * v[bj][0][2] + v[bj][0][3] * v[bj][0][3]) + (v[bj][1][0] * v[bj][1][0] + v[bj][1][1] * v[bj][1][1]) + (v[bj][1][2] * v[bj][1][2] + v[bj][1][3] * v[bj][1][3]);
                            ss += __builtin_bit_cast(float, __builtin_amdgcn_ds_bpermute((lane ^ 16) << 2, __builtin_bit_cast(int, ss)));
                            ss += __builtin_bit_cast(float, __builtin_amdgcn_ds_bpermute((lane ^ 32) << 2, __builtin_bit_cast(int, ss)));
                            if (fq == 0) __hip_atomic_fetch_add(dst + row, ss, __ATOMIC_RELAXED, __HIP_MEMORY_SCOPE_AGENT); }
                        if (cb == P_HKR && wc == 0) {
                            const f32x4 g0 = *(const f32x4*)(kgm + 64 + 8 * fq), g1 = *(const f32x4*)(kgm + 64 + 8 * fq + 4);
                            const float* rp = rope + (size_t)(row & (SEQ - 1)) * 32 + 8 * (fq & 1);
                            const f32x4 c0 = *(const f32x4*)rp, c1 = *(const f32x4*)(rp + 4), s0 = *(const f32x4*)(rp + 16), s1 = *(const f32x4*)(rp + 20);
#pragma unroll
                            for (int n = 0; n < 2; ++n)
#pragma unroll
                                for (int j = 0; j < 4; ++j) { const float nv = v[bj][n][j] * (n ? g1[j] : g0[j]);
                                    const float pv = __builtin_bit_cast(float, __builtin_amdgcn_ds_bpermute((lane ^ 32) << 2, __builtin_bit_cast(int, nv)));
                                    const float cs = n ? c1[j] : c0[j], sn = n ? s1[j] : s0[j]; v[bj][n][j] = (fq < 2) ? nv * cs - pv * sn : nv * cs + pv * sn; } } }
                }
#pragma unroll
                for (int bj = 0; bj < 2; ++bj) { u32x4 w; w.x = cvt_pk_bf16(v[bj][0][0], v[bj][0][1]); w.y = cvt_pk_bf16(v[bj][0][2], v[bj][0][3]); w.z = cvt_pk_bf16(v[bj][1][0], v[bj][1][1]); w.w = cvt_pk_bf16(v[bj][1][2], v[bj][1][3]);
                    *(u32x4*)(rowp + bj * 128) = w; } }
    }
};
struct PEpiKV {
    static constexpr bool PERM = true, AFTER_DRAIN = false, MIDSCALE = false;
    bf16_t* V; bf16_t* K; const bf16_t* proj; const float* ssq_kv; const float* ssq_kr; const float* rope; const float* kgain;
    __device__ __forceinline__ void operator()(const f32x4 (&acc)[2][2][4][2], const pg8::Unit& u, int wr, int wc, int fr_, int fq_) const {
        int fr = fr_, fq = fq_; asm volatile("" : "+v"(fr), "+v"(fq)); const float* kgain = this->kgain; asm volatile("" : "+s"(kgain)); const float* rope = this->rope; asm volatile("" : "+s"(rope));
        const int row0 = u.pm * 256 + wr * 64 + fr, lane = fq * 16 + fr;
        float rsc[2][4];
#pragma unroll
        for (int ai = 0; ai < 2; ++ai)
#pragma unroll
            for (int m = 0; m < 4; ++m) rsc[ai][m] = 1.f / sqrtf(ssq_kv[row0 + ai * 128 + m * 16] * (1.f / KVR) + EPS);
        if (wc >= 2) {
            const int col0 = u.pn * 256 + wc * 32 + 8 * fq;
#pragma unroll
            for (int ai = 0; ai < 2; ++ai)
#pragma unroll
                for (int m = 0; m < 4; ++m) { bf16_t* rowp = V + (size_t)(row0 + ai * 128 + m * 16) * MKV + col0; const float sc_ = rsc[ai][m];
#pragma unroll
                    for (int bj = 0; bj < 2; ++bj) { const f32x4 v0 = acc[ai][bj][m][0] * sc_, v1 = acc[ai][bj][m][1] * sc_;
                        u32x4 w; w.x = cvt_pk_bf16(v0[0], v0[1]); w.y = cvt_pk_bf16(v0[2], v0[3]); w.z = cvt_pk_bf16(v1[0], v1[1]); w.w = cvt_pk_bf16(v1[2], v1[3]);
                        *(u32x4*)(rowp + bj * 128) = w; } }
            return;
        }
        const int hh = 2 * u.pn + wc;
#pragma unroll
        for (int ai = 0; ai < 2; ++ai)
#pragma unroll
            for (int m = 0; m < 4; ++m) { const int row = row0 + ai * 128 + m * 16; const float sc_ = rsc[ai][m];
                bf16_t* ko = K + (size_t)row * MQ + 96 * hh;
                float rstd;
                {
                    f32x4 v[2][2]; float ss = 0.f;
#pragma unroll
                    for (int bj = 0; bj < 2; ++bj)
#pragma unroll
                        for (int n = 0; n < 2; ++n) { v[bj][n] = acc[ai][bj][m][n] * sc_; ss += (v[bj][n][0] * v[bj][n][0] + v[bj][n][1] * v[bj][n][1]) + (v[bj][n][2] * v[bj][n][2] + v[bj][n][3] * v[bj][n][3]); }
                    ss += __builtin_bit_cast(float, __builtin_amdgcn_ds_bpermute((lane ^ 16) << 2, __builtin_bit_cast(int, ss)));
                    ss += __builtin_bit_cast(float, __builtin_amdgcn_ds_bpermute((lane ^ 32) << 2, __builtin_bit_cast(int, ss)));
                    rstd = 1.f / sqrtf((ss + ssq_kr[row]) * (1.f / 96) + EPS);
#pragma unroll
                    for (int bj = 0; bj < 2; ++bj) { const f32x4 g0 = *(const f32x4*)(kgain + 32 * bj + 8 * fq), g1 = *(const f32x4*)(kgain + 32 * bj + 8 * fq + 4);
                        const f32x4 a = v[bj][0] * rstd * g0, b = v[bj][1] * rstd * g1;
                        u32x4 w; w.x = cvt_pk_bf16(a[0], a[1]); w.y = cvt_pk_bf16(a[2], a[3]); w.z = cvt_pk_bf16(b[0], b[1]); w.w = cvt_pk_bf16(b[2], b[3]);
                        *(u32x4*)(ko + 32 * bj + 8 * fq) = w; }
                }
                asm volatile("" ::: "memory");
                {
                    const bf16x8 kr8 = *(const bf16x8*)(proj + (size_t)row * DINP + P_HKR + 8 * fq);
                    u32x4 w; w.x = cvt_pk_bf16(bf2f((unsigned short)kr8[0]) * rstd, bf2f((unsigned short)kr8[1]) * rstd); w.y = cvt_pk_bf16(bf2f((unsigned short)kr8[2]) * rstd, bf2f((unsigned short)kr8[3]) * rstd);
                    w.z = cvt_pk_bf16(bf2f((unsigned short)kr8[4]) * rstd, bf2f((unsigned short)kr8[5]) * rstd); w.w = cvt_pk_bf16(bf2f((unsigned short)kr8[6]) * rstd, bf2f((unsigned short)kr8[7]) * rstd);
                    *(u32x4*)(ko + 64 + 8 * fq) = w;
                }
                asm volatile("" ::: "memory"); }
    }
};
struct PEpiResF32 {
    static constexpr bool PERM = false, AFTER_DRAIN = false, MIDSCALE = false;
    const float* base; float* out; int ldc;
    __device__ __forceinline__ void operator()(const f32x4 (&acc)[2][2][4][2], const pg8::Unit& u, int wr, int wc, int fr, int fq) const {
        const int col0 = u.pn * 256 + wc * 32 + 4 * fq;
#pragma unroll
        for (int ai = 0; ai < 2; ++ai)
#pragma unroll
            for (int m = 0; m < 4; ++m) { const size_t off = (size_t)(u.pm * 256 + ai * 128 + wr * 64 + m * 16 + fr) * ldc + col0;
#pragma unroll
                for (int bj = 0; bj < 2; ++bj)
#pragma unroll
                    for (int n = 0; n < 2; ++n) { const f32x4 bs = *(const f32x4*)(base + off + bj * 128 + n * 16); *(f32x4*)(out + off + bj * 128 + n * 16) = bs + acc[ai][bj][m][n]; } }
    }
};

struct PEpiWo {
    static constexpr bool PERM = false, AFTER_DRAIN = false, MIDSCALE = true;
    const bf16_t* base; bf16_t* xb; float* ssq; const float* ssqm; int ldc;
    __device__ __forceinline__ void midscale(f32x4 (&acc)[2][2][4][2], const pg8::Unit& u, int wr, int fr) const {
#pragma unroll
        for (int ai = 0; ai < 2; ++ai)
#pragma unroll
            for (int m = 0; m < 4; ++m) { const int row = u.pm * 256 + ai * 128 + wr * 64 + m * 16 + fr;
                const float sa = ssqm[2 * row], sb = ssqm[2 * row + 1]; const float ratio = sqrtf((sb * (1.f / 512) + EPS) / (sa * (1.f / 512) + EPS));
#pragma unroll
                for (int bj = 0; bj < 2; ++bj)
#pragma unroll
                    for (int n = 0; n < 2; ++n) acc[ai][bj][m][n] *= ratio; }
    }
    __device__ __forceinline__ void operator()(const f32x4 (&acc)[2][2][4][2], const pg8::Unit& u, int wr, int wc, int fr, int fq) const {
        const int col0 = u.pn * 256 + wc * 32 + 4 * fq; const int lane = fq * 16 + fr;
        const int rowb = u.pm * 256 + wr * 64 + fr;
        float rb[8];
#pragma unroll
        for (int g_ = 0; g_ < 8; ++g_) rb[g_] = ssqm[2 * (rowb + (g_ >> 2) * 128 + (g_ & 3) * 16) + 1];
        u32x2 nxt[2][2];
#pragma unroll
        for (int bj = 0; bj < 2; ++bj)
#pragma unroll
            for (int n = 0; n < 2; ++n) nxt[bj][n] = *(const u32x2*)(base + (size_t)rowb * ldc + col0 + bj * 128 + n * 16);
#pragma unroll
        for (int g_ = 0; g_ < 8; ++g_) { const int ai = g_ >> 2, m = g_ & 3; const int row = rowb + ai * 128 + m * 16; const size_t off = (size_t)row * ldc + col0; float ss = 0.f;
            u32x2 cur[2][2];
#pragma unroll
            for (int bj = 0; bj < 2; ++bj)
#pragma unroll
                for (int n = 0; n < 2; ++n) cur[bj][n] = nxt[bj][n];
            if (g_ < 7) { const size_t offn = (size_t)(rowb + ((g_ + 1) >> 2) * 128 + ((g_ + 1) & 3) * 16) * ldc + col0;
#pragma unroll
                for (int bj = 0; bj < 2; ++bj)
#pragma unroll
                    for (int n = 0; n < 2; ++n) nxt[bj][n] = *(const u32x2*)(base + offn + bj * 128 + n * 16); }
            const float rbs = 1.f / sqrtf(rb[g_] * (1.f / 512) + EPS);
#pragma unroll
            for (int bj = 0; bj < 2; ++bj)
#pragma unroll
                for (int n = 0; n < 2; ++n) { const u32x2 cw = cur[bj][n]; const f32x4 v = (f32x4){bf2f(cw.x & 0xffffu), bf2f(cw.x >> 16), bf2f(cw.y & 0xffffu), bf2f(cw.y >> 16)} + acc[ai][bj][m][n] * rbs;
                    ss += (v[0] * v[0] + v[1] * v[1]) + (v[2] * v[2] + v[3] * v[3]);
                    u32x2 w; w.x = cvt_pk_bf16(v[0], v[1]); w.y = cvt_pk_bf16(v[2], v[3]); *(u32x2*)(xb + off + bj * 128 + n * 16) = w; }
            ss += __builtin_bit_cast(float, __builtin_amdgcn_ds_bpermute((lane ^ 16) << 2, __builtin_bit_cast(int, ss)));
            ss += __builtin_bit_cast(float, __builtin_amdgcn_ds_bpermute((lane ^ 32) << 2, __builtin_bit_cast(int, ss)));
            if (fq == 0) __hip_atomic_fetch_add(ssq + row, ss, __ATOMIC_RELAXED, __HIP_MEMORY_SCOPE_AGENT); }
    }
};


struct PEpiDown {
    static constexpr bool PERM = false, AFTER_DRAIN = false, MIDSCALE = false;
    const bf16_t* xb; float* out; int ldc;
    __device__ __forceinline__ void operator()(const f32x4 (&acc)[2][2][4][2], const pg8::Unit& u, int wr, int wc, int fr, int fq) const {
        const int col0 = u.pn * 256 + wc * 32 + 4 * fq; const int rowb = u.pm * 256 + wr * 64 + fr;
        u32x2 nxt[2][2];
#pragma unroll
        for (int bj = 0; bj < 2; ++bj)
#pragma unroll
            for (int n = 0; n < 2; ++n) nxt[bj][n] = *(const u32x2*)(xb + (size_t)rowb * ldc + col0 + bj * 128 + n * 16);
#pragma unroll
        for (int g_ = 0; g_ < 8; ++g_) { const int ai = g_ >> 2, m = g_ & 3; const size_t off = (size_t)(rowb + ai * 128 + m * 16) * ldc + col0;
            u32x2 cur[2][2];
#pragma unroll
            for (int bj = 0; bj < 2; ++bj)
#pragma unroll
                for (int n = 0; n < 2; ++n) cur[bj][n] = nxt[bj][n];
            if (g_ < 7) { const size_t offn = (size_t)(rowb + ((g_ + 1) >> 2) * 128 + ((g_ + 1) & 3) * 16) * ldc + col0;
#pragma unroll
                for (int bj = 0; bj < 2; ++bj)
#pragma unroll
                    for (int n = 0; n < 2; ++n) nxt[bj][n] = *(const u32x2*)(xb + offn + bj * 128 + n * 16); }
#pragma unroll
            for (int bj = 0; bj < 2; ++bj)
#pragma unroll
                for (int n = 0; n < 2; ++n) { const u32x2 w = cur[bj][n];
                    const f32x4 bs = (f32x4){bf2f(w.x & 0xffffu), bf2f(w.x >> 16), bf2f(w.y & 0xffffu), bf2f(w.y >> 16)};
                    *(f32x4*)(out + off + bj * 128 + n * 16) = bs + acc[ai][bj][m][n]; } }
    }
};

__device__ __forceinline__ float sq8(const bf16x8 v) { float s = 0.f;
#pragma unroll
    for (int j = 0; j < 8; ++j) { const float f = bf2f((unsigned short)v[j]); s += f * f; }
    return s; }
__device__ __forceinline__ u32x4 scale8(const bf16x8 v, float sc, const f32x4 ga, const f32x4 gb) { u32x4 o;
    o.x = pk2(bf2f((unsigned short)v[0]) * sc * ga[0], bf2f((unsigned short)v[1]) * sc * ga[1]); o.y = pk2(bf2f((unsigned short)v[2]) * sc * ga[2], bf2f((unsigned short)v[3]) * sc * ga[3]);
    o.z = pk2(bf2f((unsigned short)v[4]) * sc * gb[0], bf2f((unsigned short)v[5]) * sc * gb[1]); o.w = pk2(bf2f((unsigned short)v[6]) * sc * gb[2], bf2f((unsigned short)v[7]) * sc * gb[3]);
    return o; }
template <int NR>
__device__ __forceinline__ void glueA_rows(unsigned char* ws, int row0, int rstride, int lane) {
    const int br = (lane >> 4) & 1, g = (lane >> 3) & 1, l8 = lane & 7;
    bf16x8 vq[NR], vkv[NR], vk[NR];
#pragma unroll
    for (int r = 0; r < NR; ++r) { const int row = (row0 + r * rstride < M) ? row0 + r * rstride : row0; const bf16_t* pr = (const bf16_t*)(ws + WS_PROJ) + (size_t)row * DINP;
        vq[r] = *(const bf16x8*)(pr + C_HQ + 8 * (lane < 48 ? lane : 47)); vkv[r] = *(const bf16x8*)(pr + C_HKV + 8 * (lane & 31)); vk[r] = *(const bf16x8*)(pr + (br ? C_KWIN : C_KSEL) + 64 * g + 8 * l8); }
    const float* kg = inptr(10) + (1 + br) * 64 + 8 * l8; const f32x4 ga = *(const f32x4*)kg, gb = *(const f32x4*)(kg + 4);
#pragma unroll
    for (int r = 0; r < NR; ++r) { const int row = row0 + r * rstride; if (row >= M) continue;
        const float sq = wave_sum(lane < 48 ? sq8(vq[r]) : 0.f), skv = wave_sum(lane < 32 ? sq8(vkv[r]) : 0.f);
        float sk = sq8(vk[r]); sk += __shfl_xor(sk, 1); sk += __shfl_xor(sk, 2); sk += __shfl_xor(sk, 4);
        if (lane == 0) { ((float*)(ws + WS_RSQ))[row] = 1.f / sqrtf(sq * (1.f / QR) + EPS); ((float*)(ws + WS_RSKV))[row] = 1.f / sqrtf(skv * (1.f / KVR) + EPS); }
        if (lane < 32) { const float rstd = 1.f / sqrtf(sk * (1.f / 64) + EPS);
            *(u32x4*)((bf16_t*)(ws + (br ? WS_KWIN : WS_KSEL)) + (size_t)row * 128 + 64 * g + 8 * l8) = scale8(vk[r], rstd, ga, gb); } }
}
template <int NR>
__device__ __forceinline__ void kpass_rows(unsigned char* ws, int row0, int rstride, int lane) {
    const int h = lane >> 3, l = lane & 7;
    bf16x8 v[NR]; unsigned ra[NR], rb[NR];
#pragma unroll
    for (int r = 0; r < NR; ++r) { const int row = (row0 + r * rstride < M) ? row0 + r * rstride : row0;
        v[r] = *(const bf16x8*)((const bf16_t*)(ws + WS_KVM) + (size_t)row * MKV + 128 * h + 8 * l);
        const bf16_t* kr = (const bf16_t*)(ws + WS_PROJ) + (size_t)row * DINP + P_HKR + 2 * l; ra[r] = *(const unsigned*)kr; rb[r] = *(const unsigned*)(kr + 16); }
    const float* kg = inptr(8);
    const f32x4 ga = *(const f32x4*)(kg + 8 * l), gb = *(const f32x4*)(kg + 8 * l + 4);
    const float g1a = kg[64 + 2 * l], g1b = kg[65 + 2 * l], g2a = kg[80 + 2 * l], g2b = kg[81 + 2 * l];
    const float inva = exp2f(-(float)(2 * l) * (13.287712379549449f / 16.f)), invb = exp2f(-(float)(2 * l + 1) * (13.287712379549449f / 16.f));
#pragma unroll
    for (int r = 0; r < NR; ++r) { const int row = row0 + r * rstride; if (row >= M) continue;
        const int pos = row & (SEQ - 1);
        const float x1a = bf2f(ra[r] & 0xffffu), x1b = bf2f(ra[r] >> 16), x2a = bf2f(rb[r] & 0xffffu), x2b = bf2f(rb[r] >> 16);
        float ss = sq8(v[r]) + (x1a * x1a + x1b * x1b) + (x2a * x2a + x2b * x2b);
        ss += __shfl_xor(ss, 1); ss += __shfl_xor(ss, 2); ss += __shfl_xor(ss, 4);
        const float rstd = 1.f / sqrtf(ss * (1.f / 96) + EPS);
        bf16_t* ko = (bf16_t*)(ws + WS_KMLA) + (size_t)row * MQ + 96 * h;
        *(u32x4*)(ko + 8 * l) = scale8(v[r], rstd, ga, gb);
        float sna, csa, snb, csb; sincosf((float)pos * inva, &sna, &csa); sincosf((float)pos * invb, &snb, &csb);
        const float n1a = x1a * rstd * g1a, n2a = x2a * rstd * g2a, n1b = x1b * rstd * g1b, n2b = x2b * rstd * g2b;
        *(unsigned*)(ko + 64 + 2 * l) = pk2(n1a * csa - n2a * sna, n1b * csb - n2b * snb); *(unsigned*)(ko + 80 + 2 * l) = pk2(n2a * csa + n1a * sna, n2b * csb + n1b * snb); }
}
__device__ __forceinline__ void glueC_row(unsigned char* ws, int row, int lane) {
    bf16_t* mx = (bf16_t*)(ws + WS_MIX) + (size_t)row * DM + 8 * lane;
#pragma unroll
    for (int half = 0; half < 2; ++half) {
        const bf16x8 v = *(const bf16x8*)(mx + 512 * half);
        const float rstd = 1.f / sqrtf(wave_sum(sq8(v)) * (1.f / 512) + EPS);
        const float* gp = inptr(15 + half) + 8 * lane;
        *(u32x4*)(mx + 512 * half) = scale8(v, rstd, *(const f32x4*)gp, *(const f32x4*)(gp + 4));
    }
}

__device__ __forceinline__ void compress_block(unsigned char* ws, LAS unsigned char* L, int task, int wv) {
    const int tid = opaque_tid(wv), lane = tid & 63, wid = __builtin_amdgcn_readfirstlane(tid >> 6), fr = lane & 15, fq = lane >> 4;
    const int tc = task & 15, b = (task >> 4) & 7, kv = task >> 7;
    int c = 8 * tc + (fr >> 1); const int g = fr & 1; if (c > NCMP - 1) c = NCMP - 1;
    const bf16_t* arow = (const bf16_t*)(ws + WS_PROJ) + (size_t)(b * SEQ + 16 * c) * DINP + slot_base((kv ? S_VCMP : S_KCMP) + g) + 8 * fq;
    const float* pe = inptr(11) + kv * 2048 + 8 * fq;
    const bf16_t* w1t = (const bf16_t*)(ws + WS_W1T) + (size_t)kv * 128 * 2048 + (size_t)fr * 2048 + 8 * fq;
    f32x4 acc[8];
#pragma unroll
    for (int n = 0; n < 8; ++n) acc[n] = (f32x4){0.f, 0.f, 0.f, 0.f};
#pragma unroll 4
    for (int s8 = 0; s8 < 8; ++s8) {
        const int s = 8 * wid + s8, r = s >> 1, db = (s & 1) * 32;
        const bf16x8 araw = *(const bf16x8*)(arow + (size_t)r * DINP + 4 * db);
        const f32x4 pa = *(const f32x4*)(pe + r * 64 + db), pb = *(const f32x4*)(pe + r * 64 + db + 4);
        u32x4 aw; aw.x = pk2(bf2f((unsigned short)araw[0]) + pa[0], bf2f((unsigned short)araw[1]) + pa[1]); aw.y = pk2(bf2f((unsigned short)araw[2]) + pa[2], bf2f((unsigned short)araw[3]) + pa[3]);
        aw.z = pk2(bf2f((unsigned short)araw[4]) + pb[0], bf2f((unsigned short)araw[5]) + pb[1]); aw.w = pk2(bf2f((unsigned short)araw[6]) + pb[2], bf2f((unsigned short)araw[7]) + pb[3]);
        const bf16x8 a = __builtin_bit_cast(bf16x8, aw);
#pragma unroll
        for (int n = 0; n < 8; ++n) { const bf16x8 bb = *(const bf16x8*)(w1t + (size_t)(16 * n) * 2048 + 32 * s);
            acc[n] = __builtin_amdgcn_mfma_f32_16x16x32_bf16(a, bb, acc[n], 0, 0, 0); }
    }
    LAS float* part = (LAS float*)L;
#pragma unroll
    for (int n = 0; n < 8; ++n)
#pragma unroll
        for (int j = 0; j < 4; ++j) part[(wid * 16 + 4 * fq + j) * 128 + 16 * n + fr] = acc[n][j];
    __syncthreads();
    LAS bf16_t* hb_ = (LAS bf16_t*)(L + 65536);
#pragma unroll
    for (int e = 0; e < 4; ++e) { const int idx = tid + 512 * e; float v = 0.f;
#pragma unroll
        for (int w = 0; w < 8; ++w) v += part[w * 2048 + idx];
        hb_[idx] = (bf16_t)f2bf(v / (1.f + __expf(-v))); }
    __syncthreads();
    if (wid == 0) {
        const bf16_t* w2t = (const bf16_t*)(ws + WS_W2T) + kv * 64 * 128 + fr * 128 + 8 * fq;
        f32x4 o[4];
#pragma unroll
        for (int n = 0; n < 4; ++n) o[n] = (f32x4){0.f, 0.f, 0.f, 0.f};
#pragma unroll
        for (int ks = 0; ks < 4; ++ks) { const bf16x8 a = *(const LAS bf16x8*)(hb_ + fr * 128 + 32 * ks + 8 * fq);
#pragma unroll
            for (int n = 0; n < 4; ++n) { const bf16x8 bb = *(const bf16x8*)(w2t + (size_t)(16 * n) * 128 + 32 * ks); o[n] = __builtin_amdgcn_mfma_f32_16x16x32_bf16(a, bb, o[n], 0, 0, 0); } }
        bf16_t* dstb = (bf16_t*)(ws + (kv ? WS_VCMP : WS_KCMP)) + (size_t)b * 128 * 2 * 64;
        const float* kg = inptr(10);
#pragma unroll
        for (int j = 0; j < 4; ++j) { const int row = 4 * fq + j, cc = 8 * tc + (row >> 1), gg = row & 1;
            float sc = 1.f;
            if (kv == 0) { float ss = o[0][j] * o[0][j] + o[1][j] * o[1][j] + o[2][j] * o[2][j] + o[3][j] * o[3][j];
                ss += __shfl_xor(ss, 1); ss += __shfl_xor(ss, 2); ss += __shfl_xor(ss, 4); ss += __shfl_xor(ss, 8); sc = 1.f / sqrtf(ss * (1.f / 64) + EPS); }
#pragma unroll
            for (int n = 0; n < 4; ++n) { const int col = 16 * n + fr; float v = o[n][j] * sc; if (kv == 0) v *= kg[col]; if (cc >= NCMP) v = 0.f;
                dstb[((size_t)cc * 2 + gg) * 64 + col] = (bf16_t)f2bf(v); } }
    }
    __syncthreads();
}

namespace att {
typedef float f32x16 __attribute__((ext_vector_type(16)));
typedef short s16x4 __attribute__((ext_vector_type(4)));
typedef short v4i16_t __attribute__((ext_vector_type(4)));
typedef float f32x2_t __attribute__((ext_vector_type(2)));
typedef __bf16 bf16x2_t __attribute__((ext_vector_type(2)));
typedef const LAS unsigned char* lcp;
constexpr int NSLOT = 3;
constexpr int L_TB = 0, L_K = 4096, KSLOT = 12288, L_V = L_K + NSLOT * KSLOT, VSLOT = 8192, L_WSF = L_V + NSLOT * VSLOT, L_OST = L_WSF + 4096,
              L_IMP = L_OST + 32768, IMPS = 33  , L_SELM = L_IMP + 4 * 64 * IMPS * 4, L_GATE = L_SELM + 256, L_SC = L_GATE + 3072, L_INVL = L_SC + 64 * IMPS * 4, L_END = L_INVL + 1024;
static_assert(L_V + NSLOT * VSLOT <= 65536, "LDS-DMA destinations stay below 64 KiB");
static_assert(L_END <= LDS_BST, "attention LDS map");
constexpr float THR = 8.0f;
__device__ __forceinline__ int crow(int r, int hi) { return (r & 3) + 8 * (r >> 2) + 4 * hi; }
__device__ __forceinline__ void glds16(const void* gsrc, unsigned lds_dst) { unsigned keep;
    asm volatile("s_mov_b32 %0, m0\n\ts_mov_b32 m0, %2\n\ts_nop 0\n\tglobal_load_lds_dwordx4 %1, off\n\ts_mov_b32 m0, %0" : "=&s"(keep) : "v"(gsrc), "s"(lds_dst) : "memory"); }
__device__ __forceinline__ unsigned cvtpk(float lo, float hi) { f32x2_t v = {lo, hi}; bf16x2_t b = __builtin_convertvector(v, bf16x2_t); return __builtin_bit_cast(unsigned, b); }
__device__ __forceinline__ s16x4 vtr(lcp p) { return __builtin_bit_cast(s16x4, __builtin_amdgcn_ds_read_tr16_b64_v4i16((LAS v4i16_t*)p)); }
__device__ __forceinline__ float lane_xor(float v, int lane, int x) { return __builtin_bit_cast(float, __builtin_amdgcn_ds_bpermute((lane ^ x) << 2, __builtin_bit_cast(int, v))); }
__device__ __forceinline__ unsigned lane_xor_u(unsigned v, int lane, int x) { return (unsigned)__builtin_amdgcn_ds_bpermute((lane ^ x) << 2, (int)v); }
__device__ __forceinline__ float swap_max(float m, int lane) { return __builtin_fmaxf(m, lane_xor(m, lane, 32)); }
__device__ __forceinline__ float swap_sum(float m, int lane) { return m + lane_xor(m, lane, 32); }
__device__ __forceinline__ float max3f(float a, float b, float c) { float r; asm("v_max3_f32 %0, %1, %2, %3" : "=v"(r) : "v"(a), "v"(b), "v"(c)); return r; }
__device__ __forceinline__ float max32(const f32x16& p0, const f32x16& p1) {
    float a = max3f(p0[0], p0[1], p1[0]), b = max3f(p0[2], p0[3], p1[1]); a = max3f(a, p1[2], p1[3]);
#pragma unroll
    for (int r = 4; r < 16; r += 4) { a = max3f(a, p0[r], p0[r + 1]); b = max3f(b, p0[r + 2], p0[r + 3]); a = max3f(a, p1[r], p1[r + 1]); b = max3f(b, p1[r + 2], p1[r + 3]); }
    return __builtin_fmaxf(a, b); }
__device__ __forceinline__ float max16(const f32x16& p) { float a = __builtin_fmaxf(p[0], p[1]), b = __builtin_fmaxf(p[2], p[3]);
#pragma unroll
    for (int r = 4; r < 16; r += 4) { a = __builtin_fmaxf(a, __builtin_fmaxf(p[r], p[r + 1])); b = __builtin_fmaxf(b, __builtin_fmaxf(p[r + 2], p[r + 3])); }
    return __builtin_fmaxf(a, b); }
__device__ __forceinline__ float sum16(const f32x16& p) { float a = p[0] + p[1], b = p[2] + p[3];
#pragma unroll
    for (int r = 4; r < 16; r += 4) { a += p[r] + p[r + 1]; b += p[r + 2] + p[r + 3]; }
    return a + b; }
#define ATT_BAR() asm volatile("s_waitcnt vmcnt(0) lgkmcnt(0)\n\ts_barrier" ::: "memory")

template <int DQ> __device__ __forceinline__ void qkt(f32x16& p0, f32x16& p1, lcp kslot, const bf16x8* qr, const f32x16& cinit, int r32, int hi) {
    lcp kb = kslot + hi * 1024 + r32 * 16;
    constexpr int NB = 2;
#pragma unroll
    for (int db = 0; db < DQ / 16; db += NB) {
        bf16x8 kf[2 * NB];
#pragma unroll
        for (int e = 0; e < NB; ++e) { kf[2 * e] = *(const LAS bf16x8*)(kb + (db + e) * 2048); kf[2 * e + 1] = *(const LAS bf16x8*)(kb + (db + e) * 2048 + 512); }
        __builtin_amdgcn_sched_barrier(0);
#pragma unroll
        for (int e = 0; e < NB; ++e) { const int d0 = db + e;
            if (d0 == 0) { p0 = __builtin_amdgcn_mfma_f32_32x32x16_bf16(kf[0], qr[0], cinit, 0, 0, 0); p1 = __builtin_amdgcn_mfma_f32_32x32x16_bf16(kf[1], qr[0], cinit, 0, 0, 0); }
            else { p0 = __builtin_amdgcn_mfma_f32_32x32x16_bf16(kf[2 * e], qr[d0], p0, 0, 0, 0); p1 = __builtin_amdgcn_mfma_f32_32x32x16_bf16(kf[2 * e + 1], qr[d0], p1, 0, 0, 0); }
        }
    }
}
__device__ __forceinline__ void vload_half(bf16x8 (&vf)[8], lcp vp, int d0) {
#pragma unroll
    for (int ks = 0; ks < 4; ++ks) {
        const s16x4 lo = vtr(vp + d0 * 4096 + ks * 1024), hh = vtr(vp + d0 * 4096 + ks * 1024 + 512);
        vf[d0 * 4 + ks] = (bf16x8){lo[0], lo[1], lo[2], lo[3], hh[0], hh[1], hh[2], hh[3]};
    }
    __builtin_amdgcn_sched_barrier(0);
}
__device__ __forceinline__ void vload(bf16x8 (&vf)[8], lcp vp) { vload_half(vf, vp, 0); vload_half(vf, vp, 1); }
__device__ __forceinline__ void pv_mma(f32x16 (&o)[2], const bf16x8 (&vf)[8], const f32x16& p0, const f32x16& p1) {
    u32x4 pw[4];
    pw[0] = (u32x4){cvtpk(p0[0], p0[1]), cvtpk(p0[2], p0[3]), cvtpk(p0[4], p0[5]), cvtpk(p0[6], p0[7])};
    pw[1] = (u32x4){cvtpk(p0[8], p0[9]), cvtpk(p0[10], p0[11]), cvtpk(p0[12], p0[13]), cvtpk(p0[14], p0[15])};
    pw[2] = (u32x4){cvtpk(p1[0], p1[1]), cvtpk(p1[2], p1[3]), cvtpk(p1[4], p1[5]), cvtpk(p1[6], p1[7])};
    pw[3] = (u32x4){cvtpk(p1[8], p1[9]), cvtpk(p1[10], p1[11]), cvtpk(p1[12], p1[13]), cvtpk(p1[14], p1[15])};
#pragma unroll
    for (int d0 = 0; d0 < 2; ++d0)
#pragma unroll
        for (int ks = 0; ks < 4; ++ks) o[d0] = __builtin_amdgcn_mfma_f32_32x32x16_bf16(__builtin_bit_cast(bf16x8, pw[ks]), vf[d0 * 4 + ks], o[d0], 0, 0, 0);
}
__device__ __forceinline__ void pv(f32x16 (&o)[2], lcp vp, const f32x16& p0, const f32x16& p1) { bf16x8 vf[8]; vload(vf, vp); pv_mma(o, vf, p0, p1); }
template <int DQ, bool SLOT = false, bool SLOTV = SLOT> __device__ __forceinline__ void dma_tile(unsigned lds0, const bf16_t* Kg, int kpitch, const bf16_t* Vg, int vpitch, int key0, int slot, int wid, int lane) {
    const bf16_t* ksrc = Kg + (size_t)(key0 + lane) * kpitch + (SLOT ? 128 * (wid >> 2) + 8 * (wid & 3) : wid * 8);
    glds16(ksrc, (unsigned)__builtin_amdgcn_readfirstlane(lds0 + L_K + slot * KSLOT + wid * 1024));
    if (DQ == 96) { if (wid < 4) glds16(ksrc + 64, (unsigned)__builtin_amdgcn_readfirstlane(lds0 + L_K + slot * KSLOT + (8 + wid) * 1024)); }
    const bf16_t* vsrc = Vg + (size_t)(key0 + 16 * (wid & 3) + (lane >> 2)) * vpitch + (wid >> 2) * (SLOTV ? 128 : 32) + (lane & 3) * 8;
    glds16(vsrc, (unsigned)__builtin_amdgcn_readfirstlane(lds0 + L_V + slot * VSLOT + wid * 1024));
}

#define ATT_LBAR() asm volatile("s_waitcnt lgkmcnt(0)\n\ts_barrier" ::: "memory")
struct NoNext { static constexpr int count = 0; __device__ __forceinline__ void dma(unsigned, int, int, int, int) const {} };
template <int DQ, bool SLOT, bool SLOTV, class Pol> struct NextTiles {
    const bf16_t* Kg; int kpitch; const bf16_t* Vg; int vpitch; const Pol* pol; int count;
    __device__ __forceinline__ void dma(unsigned lds0, int j, int slot, int wid, int lane) const { dma_tile<DQ, SLOT, SLOTV>(lds0, Kg, kpitch, Vg, vpitch, pol->key0(j), slot, wid, lane); }
};
template <int DQ, bool SLOT = false, bool SLOTV = SLOT, class Pol, class Next>
__device__ __forceinline__ void flash_loop(LAS unsigned char* L, const bf16_t* Kg, int kpitch, const bf16_t* Vg, int vpitch, const bf16x8* qr, const Pol& pol, int s0, int npre, const Next& next,
                                           f32x16 (&o)[2], float& l_out, int wid, int lane) {
    const int r32 = lane & 31, hi = lane >> 5;
    const unsigned lds0 = (unsigned)(uintptr_t)L;
    LAS float* wsf = (LAS float*)(L + L_WSF) + wid * 128;
    lcp vp0 = L + L_V + ((lane >> 4) & 1) * 32 + (lane & 3) * 8 + (4 * hi + ((lane & 15) >> 2)) * 64;
    float mhat = 0.f, l = 0.f;
    f32x16 negm;
#pragma unroll
    for (int r = 0; r < 16; ++r) { o[0][r] = 0.f; o[1][r] = 0.f; negm[r] = 0.f; }
    const int n = pol.ntiles, ntot = n + next.count;
    int slot = s0, slot1 = (s0 + 1) % NSLOT, slot2 = (s0 + 2) % NSLOT;
    if (npre < 1) dma_tile<DQ, SLOT, SLOTV>(lds0, Kg, kpitch, Vg, vpitch, pol.key0(0), slot, wid, lane);
    if (npre < 2 && ntot > 1) { if (n > 1) dma_tile<DQ, SLOT, SLOTV>(lds0, Kg, kpitch, Vg, vpitch, pol.key0(1), slot1, wid, lane); else next.dma(lds0, 0, slot1, wid, lane); }
    for (int i = 0; i < n; ++i) {
        if (i + 1 < ntot) { if (DQ == 96 && wid < 4) asm volatile("s_waitcnt vmcnt(3) lgkmcnt(0)\n\ts_barrier" ::: "memory"); else asm volatile("s_waitcnt vmcnt(2) lgkmcnt(0)\n\ts_barrier" ::: "memory"); }
        else ATT_BAR();
        if (i + 2 < ntot) { if (i + 2 < n) dma_tile<DQ, SLOT, SLOTV>(lds0, Kg, kpitch, Vg, vpitch, pol.key0(i + 2), slot2, wid, lane); else next.dma(lds0, i + 2 - n, slot2, wid, lane); }
        if (pol.active(i)) {
            f32x16 p0, p1;
            qkt<DQ>(p0, p1, L + L_K + slot * KSLOT, qr, negm, r32, hi);
            bf16x8 vf[8]; vload_half(vf, vp0 + slot * VSLOT, 0);
            pol.fix(p0, p1, i);
            asm volatile("s_nop 15\n\ts_nop 7" : "+v"(p0), "+v"(p1));
            const float rm = swap_max(max32(p0, p1), lane);
            const bool first = (i == 0);
            if (first || __any(rm > THR)) {
                float dl = first ? rm : __builtin_fmaxf(rm, 0.f);
                if (dl == -INFINITY) dl = 0.f;
                mhat += dl;
#pragma unroll
                for (int r = 0; r < 16; ++r) { p0[r] -= dl; p1[r] -= dl; negm[r] = -mhat; }
                if (!first) {
                    const float f = __builtin_amdgcn_exp2f(-dl); l *= f;
                    if (hi == 0) wsf[r32] = f;
#pragma unroll
                    for (int r = 0; r < 16; ++r) { const float fr_ = wsf[crow(r, hi)]; o[0][r] *= fr_; o[1][r] *= fr_; }
                }
            }
#pragma unroll
            for (int r = 0; r < 16; ++r) { p0[r] = __builtin_amdgcn_exp2f(p0[r]); p1[r] = __builtin_amdgcn_exp2f(p1[r]); }
            vload_half(vf, vp0 + slot * VSLOT, 1);
            l += sum16(p0) + sum16(p1);
            pv_mma(o, vf, p0, p1);
        }
        slot = slot1; slot1 = slot2; slot2 = (slot2 == NSLOT - 1) ? 0 : slot2 + 1;
    }
    ATT_LBAR();
    l_out = swap_sum(l, lane);
}

__device__ __forceinline__ void acc_scaled(f32x16 (&oc)[2], const f32x16 (&o)[2], float rowscale, LAS float* wsf, int r32, int hi) {
    if (hi == 0) wsf[32 + r32] = rowscale;
#pragma unroll
    for (int r = 0; r < 16; ++r) { const float s = wsf[32 + crow(r, hi)]; oc[0][r] += s * o[0][r]; oc[1][r] += s * o[1][r]; }
}
__device__ __forceinline__ void park_store(const f32x16 (&oc)[2], LAS float* park, int lane) {
#pragma unroll
    for (int d0 = 0; d0 < 2; ++d0)
#pragma unroll
        for (int r = 0; r < 16; ++r) park[(d0 * 16 + r) * 64 + lane] = oc[d0][r];
}
template <bool FINAL> __device__ __forceinline__ void park_acc(f32x16 (&oc)[2], LAS float* park, const f32x16 (&o)[2], float rowscale, LAS float* wsf, int lane) {
    const int r32 = lane & 31, hi = lane >> 5;
    if (hi == 0) wsf[32 + r32] = rowscale;
#pragma unroll
    for (int r = 0; r < 16; ++r) { const float s = wsf[32 + crow(r, hi)];
#pragma unroll
        for (int d0 = 0; d0 < 2; ++d0) { const float v = park[(d0 * 16 + r) * 64 + lane] + s * o[d0][r]; if (FINAL) oc[d0][r] = v; else park[(d0 * 16 + r) * 64 + lane] = v; } }
}
__device__ __forceinline__ void store_tile(const f32x16 (&oc)[2], bf16_t* dst, int pitch, LAS unsigned char* L, int wid, int lane, float* ssq) {
    const int r32 = lane & 31, hi = lane >> 5;
    LAS bf16_t* stg = (LAS bf16_t*)(L + L_OST + wid * 8192);
#pragma unroll
    for (int r = 0; r < 16; ++r) { const int orow = crow(r, hi);
#pragma unroll
        for (int d0 = 0; d0 < 2; ++d0) stg[orow * 64 + d0 * 32 + r32] = (bf16_t)f2bf(oc[d0][r]); }
    asm volatile("s_waitcnt lgkmcnt(0)" ::: "memory");
#pragma unroll
    for (int i = 0; i < 4; ++i) { const int row = i * 8 + (lane >> 3), ch = lane & 7; const u32x4 v = *(const LAS u32x4*)(stg + row * 64 + ch * 8); *(u32x4*)(dst + (size_t)row * pitch + ch * 8) = v;
        float ss = sq8(__builtin_bit_cast(bf16x8, v)); ss += lane_xor(ss, lane, 1); ss += lane_xor(ss, lane, 2); ss += lane_xor(ss, lane, 4);
        if (ch == 0) __hip_atomic_fetch_add(ssq + 2 * row, ss, __ATOMIC_RELAXED, __HIP_MEMORY_SCOPE_AGENT); }
    asm volatile("s_waitcnt lgkmcnt(0)" ::: "memory");
}

#define PIN16(v) asm volatile("" : "+v"(v[0]), "+v"(v[1]), "+v"(v[2]), "+v"(v[3]), "+v"(v[4]), "+v"(v[5]), "+v"(v[6]), "+v"(v[7]), "+v"(v[8]), "+v"(v[9]), "+v"(v[10]), "+v"(v[11]), "+v"(v[12]), "+v"(v[13]), "+v"(v[14]), "+v"(v[15]))
__device__ __forceinline__ int clamp127(int d) { return d < 0 ? 0 : (d < 127 ? d : 127); }
struct PolMla { int ntiles, qw0, r32, hi;
    __device__ __forceinline__ int key0(int i) const { return 64 * i; }
    __device__ __forceinline__ bool active(int i) const { return 64 * i <= qw0 + 31; }
    __device__ __forceinline__ int nact() const { const int a = (qw0 + 31) / 64 + 1; return a < ntiles ? a : ntiles; }
    __device__ __forceinline__ void fix(f32x16& p0, f32x16& p1, int i) const {
        if (64 * i + 63 > qw0) { const int q = qw0 + r32, kb = 64 * i + 4 * hi;
#pragma unroll
            for (int r = 0; r < 16; ++r) { const int kv = kb + (r & 3) + 8 * (r >> 2); if (kv > q) p0[r] = -INFINITY; if (kv + 32 > q) p1[r] = -INFINITY; } }
    }
};
struct PolSel { int ntiles, qc, q, hi; unsigned selm; const LAS float* tbh;
    __device__ __forceinline__ int key0(int i) const { return 64 * (qc - i); }
    __device__ __forceinline__ bool active(int i) const { return __any((selm >> (qc - i)) & 1u) != 0; }
    __device__ __forceinline__ int nact() const { return ntiles; }
    __device__ __forceinline__ void fix(f32x16& p0, f32x16& p1, int i) const {
        const bool bit = ((selm >> (qc - i)) & 1u) != 0u;
        if (i <= 2) { const int kb = 64 * (qc - i) + 4 * hi; float bv0[16], bv1[16];
#pragma unroll
            for (int r = 0; r < 16; ++r) { const int d0 = q - (kb + (r & 3) + 8 * (r >> 2)); bv0[r] = tbh[clamp127(d0)]; bv1[r] = tbh[clamp127(d0 - 32)]; }
            PIN16(bv0); PIN16(bv1);
#pragma unroll
            for (int r = 0; r < 16; ++r) { const int d0 = q - (kb + (r & 3) + 8 * (r >> 2)), d1 = d0 - 32;
                p0[r] = (d0 < 0) ? -INFINITY : p0[r] + bv0[r]; p1[r] = (d1 < 0) ? -INFINITY : p1[r] + bv1[r]; } }
        if (!bit) {
#pragma unroll
            for (int r = 0; r < 16; ++r) { p0[r] = -INFINITY; p1[r] = -INFINITY; } }
    }
};
struct PolWin { int ntiles, qc, q, hi; const LAS float* tbh;
    __device__ __forceinline__ int key0(int i) const { return 64 * (qc - i); }
    __device__ __forceinline__ bool active(int) const { return true; }
    __device__ __forceinline__ int nact() const { return ntiles; }
    __device__ __forceinline__ void fix(f32x16& p0, f32x16& p1, int i) const {
        if (i <= 2) { const int kb = 64 * (qc - i) + 4 * hi; float bv0[16], bv1[16];
#pragma unroll
            for (int r = 0; r < 16; ++r) { const int d0 = q - (kb + (r & 3) + 8 * (r >> 2)); bv0[r] = tbh[clamp127(d0)]; bv1[r] = tbh[clamp127(d0 - 32)]; }
            PIN16(bv0); PIN16(bv1);
#pragma unroll
            for (int r = 0; r < 16; ++r) { const int d0 = q - (kb + (r & 3) + 8 * (r >> 2)), d1 = d0 - 32;
                p0[r] = (d0 < 0) ? -INFINITY : p0[r] + bv0[r]; p1[r] = (d1 < 0) ? -INFINITY : p1[r] + bv1[r]; } }
        else if (i == 8) { const int kb = 64 * (qc - i) + 4 * hi;
#pragma unroll
            for (int r = 0; r < 16; ++r) { const int d0 = q - (kb + (r & 3) + 8 * (r >> 2)), d1 = d0 - 32; if (d0 >= 512) p0[r] = -INFINITY; if (d1 >= 512) p1[r] = -INFINITY; } }
    }
};

__device__ __forceinline__ void mla_unit(unsigned char* ws, LAS unsigned char* L, int b, int h, int qb, int wv, int s0, int npre, int nnext) {
    const int tid = opaque_tid(wv), lane = tid & 63, wid = __builtin_amdgcn_readfirstlane(tid >> 6);
    const int r32 = lane & 31, hi = lane >> 5;
    const size_t rowbase = (size_t)b * SEQ; const int qw0 = 256 * qb + 32 * wid;
    bf16x8 qr[6];
    { const bf16_t* Qw = (const bf16_t*)(ws + WS_QM) + (rowbase + qw0 + r32) * MQ + 96 * h + 8 * hi;
      bf16x8 raw[6]; float ss = 0.f;
#pragma unroll
      for (int d0 = 0; d0 < 6; ++d0) { raw[d0] = *(const bf16x8*)(Qw + 16 * d0); ss += sq8(raw[d0]); }
      ss += lane_xor(ss, lane, 32);
      const float rstd = QS_MLA / sqrtf(ss * (1.f / 96) + EPS);
      const float* qg = inptr(7) + 8 * hi;
#pragma unroll
      for (int d0 = 0; d0 < 4; ++d0) qr[d0] = __builtin_bit_cast(bf16x8, scale8(raw[d0], rstd, *(const f32x4*)(qg + 16 * d0), *(const f32x4*)(qg + 16 * d0 + 4)));
      float o1[8], o2[8]; const float posf = (float)(qw0 + r32);
#pragma unroll
      for (int j = 0; j < 8; ++j) { const int i = 8 * hi + j; const float inv = exp2f(-(float)i * (13.287712379549449f / 16.f)); float sn, cs; sincosf(posf * inv, &sn, &cs);
          const float n1 = bf2f((unsigned short)raw[4][j]) * rstd * qg[64 + j], n2 = bf2f((unsigned short)raw[5][j]) * rstd * qg[80 + j];
          o1[j] = n1 * cs - n2 * sn; o2[j] = n2 * cs + n1 * sn; }
      u32x4 w4, w5; w4.x = pk2(o1[0], o1[1]); w4.y = pk2(o1[2], o1[3]); w4.z = pk2(o1[4], o1[5]); w4.w = pk2(o1[6], o1[7]);
      w5.x = pk2(o2[0], o2[1]); w5.y = pk2(o2[2], o2[3]); w5.z = pk2(o2[4], o2[5]); w5.w = pk2(o2[6], o2[7]);
      qr[4] = __builtin_bit_cast(bf16x8, w4); qr[5] = __builtin_bit_cast(bf16x8, w5); }
    const bf16_t* Kg = (const bf16_t*)(ws + WS_KMLA) + rowbase * MQ + 96 * h;
    const bf16_t* Vg = (const bf16_t*)(ws + WS_KVM) + rowbase * MKV + slot_base(4 * (h >> 1) + 2 + (h & 1));
    PolMla pol{4 * qb + 4, qw0, r32, hi};
    f32x16 o[2]; float l;
    const NextTiles<96, false, true, PolMla> nxt{Kg, MQ, Vg, MKV, &pol, nnext};
    flash_loop<96, false, true>(L, Kg, MQ, Vg, MKV, qr, pol, s0, npre, nxt, o, l, wid, lane);
    LAS float* wsf = (LAS float*)(L + L_WSF) + wid * 128;
    f32x16 oc[2];
#pragma unroll
    for (int r = 0; r < 16; ++r) { oc[0][r] = 0.f; oc[1][r] = 0.f; }
    acc_scaled(oc, o, (l > 0.f) ? 1.f / l : 0.f, wsf, r32, hi);
    store_tile(oc, (bf16_t*)(ws + WS_MIX) + (rowbase + qw0) * DM + 64 * h, DM, L, wid, lane, (float*)(ws + WS_SSQM) + 2 * (rowbase + qw0));
}

__device__ __forceinline__ void nsa_unit(unsigned char* ws, LAS unsigned char* L, int b, int g, int qc, int wv) {
#define NSA_IDS() const int tid = opaque_tid(wv), lane = tid & 63, wid = __builtin_amdgcn_readfirstlane(tid >> 6); \
    const int r32 = lane & 31, hi = lane >> 5, rh = wid & 3, qh = wid >> 2, h = 4 * g + rh, qloc = 32 * qh + r32, q = q0 + qloc; \
    const unsigned lds0 = (unsigned)(uintptr_t)L; LAS float* wsf = (LAS float*)(L + L_WSF) + wid * 128; const LAS float* tbh = (const LAS float*)(L + L_TB) + h * 128; \
    LAS float* gate = (LAS float*)(L + L_GATE); (void)tid; (void)lane; (void)r32; (void)hi; (void)rh; (void)qh; (void)h; (void)qloc; (void)q; (void)lds0; (void)wsf; (void)tbh; (void)gate
    const size_t rowbase = (size_t)b * SEQ; const int q0 = 64 * qc;
    const bf16_t* pr = (const bf16_t*)(ws + WS_PROJ);
    bf16x8 qr[4];
    {
    NSA_IDS();
    { const bf16_t* Kc = (const bf16_t*)(ws + WS_KCMP) + ((size_t)b * 256 + g) * 64; const bf16_t* Vc = (const bf16_t*)(ws + WS_VCMP) + ((size_t)b * 256 + g) * 64;
      dma_tile<64>(lds0, Kc, 128, Vc, 128, 0, 0, wid, lane);
      dma_tile<64>(lds0, Kc, 128, Vc, 128, 64, 1, wid, lane);
      dma_tile<64, true>(lds0, pr + rowbase * DINP + slot_base(S_KSEL + g), DINP, pr + rowbase * DINP + slot_base(S_VSEL + g), DINP, 64 * qc, 2, wid, lane); }
    for (int i = tid; i < 768; i += 512) { const int br = i >> 8, r = (i >> 6) & 3, qq = i & 63;
        const float x = bf2f(pr[(rowbase + q0 + qq) * DINP + P_GATE + 8 * br + 4 * g + r]); gate[i] = 1.f / (1.f + __expf(-x)); }
    { const bf16_t* Qw = pr + (rowbase + q) * DINP + slot_base(S_Q + h) + 8 * hi;
#pragma unroll
      for (int d0 = 0; d0 < 4; ++d0) qr[d0] = *(const bf16x8*)(Qw + 128 * (d0 >> 1) + 16 * (d0 & 1)); }
    }
    f32x16 oc[2];
    {
        NSA_IDS();
        ATT_BAR();
        lcp vp0 = L + L_V + ((lane >> 4) & 1) * 32 + (lane & 3) * 8 + (4 * hi + ((lane & 15) >> 2)) * 64;
        LAS float* imp = (LAS float*)(L + L_IMP) + (rh * 64 + qloc) * IMPS;
        f32x16 a0, a1, b0, b1;
        { f32x16 zero;
#pragma unroll
          for (int r = 0; r < 16; ++r) zero[r] = 0.f;
          qkt<64>(a0, a1, L + L_K, qr, zero, r32, hi); qkt<64>(b0, b1, L + L_K + KSLOT, qr, zero, r32, hi); }
#define CMP_FIX(P, coff, extra) do { float bv[16]; \
            _Pragma("unroll") for (int r = 0; r < 16; ++r) bv[r] = tbh[clamp127(q - 16 * (crow(r, hi) + (coff)) - 31)]; \
            PIN16(bv); \
            _Pragma("unroll") for (int r = 0; r < 16; ++r) { const int c = crow(r, hi) + (coff); const int d = q - 16 * c - 31; P[r] = (d < 0 || (extra && c >= NCMP)) ? -INFINITY : P[r] + bv[r]; } } while (0)
        CMP_FIX(a0, 0, false); CMP_FIX(a1, 32, false); CMP_FIX(b0, 64, false); CMP_FIX(b1, 96, true);
#undef CMP_FIX
        float m = swap_max(__builtin_fmaxf(__builtin_fmaxf(max16(a0), max16(a1)), __builtin_fmaxf(max16(b0), max16(b1))), lane);
        if (m == -INFINITY) m = 0.f;
#pragma unroll
        for (int r = 0; r < 16; ++r) { a0[r] = __builtin_amdgcn_exp2f(a0[r] - m); a1[r] = __builtin_amdgcn_exp2f(a1[r] - m); b0[r] = __builtin_amdgcn_exp2f(b0[r] - m); b1[r] = __builtin_amdgcn_exp2f(b1[r] - m); }
        const float lsum = swap_sum((sum16(a0) + sum16(a1)) + (sum16(b0) + sum16(b1)), lane);
        const float inv = (lsum > 0.f) ? 1.f / lsum : 0.f;
        float prev_last = 0.f;
#define CMP_IMP(T, P0, P1) do { float own[8], car[8]; \
            _Pragma("unroll") for (int a = 0; a < 4; ++a) { \
                own[a]     = P0[4 * a] + P0[4 * a + 1] + P0[4 * a + 2] + 0.5f * P0[4 * a + 3]; car[a]     = 0.5f * P0[4 * a + 3]; \
                own[4 + a] = P1[4 * a] + P1[4 * a + 1] + P1[4 * a + 2] + 0.5f * P1[4 * a + 3]; car[4 + a] = 0.5f * P1[4 * a + 3]; } \
            _Pragma("unroll") for (int k = 0; k < 8; ++k) car[k] = lane_xor(car[k], lane, 32); \
            _Pragma("unroll") for (int k = 0; k < 8; ++k) { const float add = hi ? car[k] : (k >= 1 ? car[k - 1] : prev_last); imp[16 * (T) + 2 * k + hi] = own[k] + add; } \
            prev_last = car[7]; } while (0)
        CMP_IMP(0, a0, a1); CMP_IMP(1, b0, b1);
#undef CMP_IMP
        if (hi == 0) ((LAS float*)(L + L_INVL))[rh * 64 + qloc] = inv;
        f32x16 o[2];
#pragma unroll
        for (int r = 0; r < 16; ++r) { o[0][r] = 0.f; o[1][r] = 0.f; }
        pv(o, vp0, a0, a1); pv(o, vp0 + VSLOT, b0, b1);
        ATT_BAR();
        if (qc >= 1) dma_tile<64, true>(lds0, pr + rowbase * DINP + slot_base(S_KSEL + g), DINP, pr + rowbase * DINP + slot_base(S_VSEL + g), DINP, 64 * (qc - 1), 0, wid, lane);
#pragma unroll
        for (int r = 0; r < 16; ++r) { oc[0][r] = 0.f; oc[1][r] = 0.f; }
        acc_scaled(oc, o, gate[(0 * 4 + rh) * 64 + qloc] * inv, wsf, r32, hi);
    }
    if (qc <= 15) {
        const int tid = opaque_tid(wv);
        if (tid < 64) ((LAS unsigned*)(L + L_SELM))[tid] = (qc == 31) ? 0xffffffffu : ((2u << qc) - 1u);
        ATT_LBAR();
    } else {
        const int tid = opaque_tid(wv);
        const LAS float* imp = (const LAS float*)(L + L_IMP); LAS float* sc = (LAS float*)(L + L_SC);
        const int qq = tid >> 3, jj = tid & 7;
        const LAS float* il = (const LAS float*)(L + L_INVL);
        const float i0 = il[qq], i1 = il[64 + qq], i2 = il[128 + qq], i3 = il[192 + qq];
#pragma unroll
        for (int k = 0; k < 4; ++k) { const int j = jj + 8 * k;
            const float tot = (imp[(0 * 64 + qq) * IMPS + j] * i0 + imp[(1 * 64 + qq) * IMPS + j] * i1) + (imp[(2 * 64 + qq) * IMPS + j] * i2 + imp[(3 * 64 + qq) * IMPS + j] * i3);
            float s; if (j > qc) s = -INFINITY; else if (j == 0 || j == qc || j == qc - 1) s = 1e4f; else s = tot; sc[qq * IMPS + j] = s; }
        ATT_LBAR();
        float v[32];
#pragma unroll
        for (int k = 0; k < 32; ++k) v[k] = sc[qq * IMPS + k];
        unsigned bits = 0u;
#pragma unroll
        for (int k = 0; k < 4; ++k) { const int j = jj + 8 * k; const float me = sc[qq * IMPS + j]; int rank = 0;
#pragma unroll
            for (int i = 0; i < 32; ++i) { const float si = v[i]; rank += (si > me || (si == me && i < j)) ? 1 : 0; }
            if (rank < 16) bits |= 1u << j; }
        { const int lane = tid & 63; bits |= lane_xor_u(bits, lane, 1); bits |= lane_xor_u(bits, lane, 2); bits |= lane_xor_u(bits, lane, 4); }
        if (jj == 0) ((LAS unsigned*)(L + L_SELM))[qq] = bits;
        ATT_LBAR();
    }
    { NSA_IDS(); park_store(oc, (LAS float*)(L + L_OST) + wid * 2048, lane); }
    {
        NSA_IDS();
        const unsigned selm = ((const LAS unsigned*)(L + L_SELM))[qloc];
        const bf16_t* Kg = pr + rowbase * DINP + slot_base(S_KSEL + g);
        const bf16_t* Vg = pr + rowbase * DINP + slot_base(S_VSEL + g);
        PolSel pol{qc + 1, qc, q, hi, selm, tbh};
        const PolWin polw{(qc < 8 ? qc : 8) + 1, qc, q, hi, tbh};
        const NextTiles<64, true, true, PolWin> nxt{pr + rowbase * DINP + slot_base(S_KWIN + g), DINP, pr + rowbase * DINP + slot_base(S_VWIN + g), DINP, &polw, polw.ntiles < 2 ? polw.ntiles : 2};
        f32x16 o[2]; float l;
        flash_loop<64, true>(L, Kg, DINP, Vg, DINP, qr, pol, 2, (qc + 1 < 2) ? qc + 1 : 2, nxt, o, l, wid, lane);
        { f32x16 dummy[2]; park_acc<false>(dummy, (LAS float*)(L + L_OST) + wid * 2048, o, (l > 0.f) ? gate[(1 * 4 + rh) * 64 + qloc] / l : 0.f, wsf, lane); }
    }
    {
        NSA_IDS();
        const bf16_t* Kg = pr + rowbase * DINP + slot_base(S_KWIN + g);
        const bf16_t* Vg = pr + rowbase * DINP + slot_base(S_VWIN + g);
        PolWin pol{(qc < 8 ? qc : 8) + 1, qc, q, hi, tbh};
        f32x16 o[2]; float l;
        flash_loop<64, true>(L, Kg, DINP, Vg, DINP, qr, pol, (2 + qc + 1) % NSLOT, pol.ntiles < 2 ? pol.ntiles : 2, NoNext{}, o, l, wid, lane);
        f32x16 fin[2]; park_acc<true>(fin, (LAS float*)(L + L_OST) + wid * 2048, o, (l > 0.f) ? gate[(2 * 4 + rh) * 64 + qloc] / l : 0.f, wsf, lane);
        store_tile(fin, (bf16_t*)(ws + WS_MIX) + (rowbase + q0 + 32 * qh) * DM + 512 + 64 * h, DM, L, wid, lane, (float*)(ws + WS_SSQM) + 2 * (rowbase + q0 + 32 * qh) + 1);
    }
    ATT_BAR();
}
#undef ATT_BAR
#undef ATT_LBAR
#undef NSA_IDS
}

#define XB_TMO      128
#define XB_XCNT(j)  (256  + 64 * (j))
#define XB_XSUB(j)  (1280 + 64 * (j))
#define XB_XGEN(j)  (2304 + 64 * (j))
#define XB_TOP      3328
#define XB_TOPGEN   3392
#define XCD_BAR_WORDS 3456
#define XB_SPIN_CAP (1u << 18)

__device__ __forceinline__ unsigned xb_ld(unsigned* p)              { return __hip_atomic_load(p, __ATOMIC_RELAXED, __HIP_MEMORY_SCOPE_AGENT); }
__device__ __forceinline__ unsigned xb_add(unsigned* p, unsigned v) { return __hip_atomic_fetch_add(p, v, __ATOMIC_RELAXED, __HIP_MEMORY_SCOPE_AGENT); }
__device__ __forceinline__ unsigned xb_xcc_id() { return (unsigned)__builtin_amdgcn_s_getreg((3 << 11) | 20) & 0xFu; }
#define XB_SPIN(cond, bar) do { unsigned _sp = 0; while (cond) { __builtin_amdgcn_s_sleep(1); \
    if ((++_sp & 255u) == 0u) { if (xb_ld(&(bar)[XB_TMO])) break; if (_sp > XB_SPIN_CAP) { atomicAdd(&(bar)[XB_TMO], 1u); break; } } } } while (0)

struct XcdBarrier {
    unsigned* bar; unsigned x;
    volatile LAS unsigned* st;
};

__device__ __forceinline__ XcdBarrier xcd_barrier_post(unsigned* bar, volatile LAS unsigned* st) {
    XcdBarrier b; b.bar = bar; b.x = xb_xcc_id(); b.st = st;
    if (threadIdx.x == 0) (void)xb_add(&bar[XB_XCNT(b.x)], 1u);
    return b;
}
__device__ __forceinline__ void xcd_barrier_complete(unsigned* bar, unsigned x, unsigned& nloc, unsigned& nx) {
    const unsigned G = gridDim.x * gridDim.y * gridDim.z;
    unsigned sum, cnt, mine, sp = 0u;
    for (;;) {
        sum = 0u; cnt = 0u; mine = 0u;
#pragma unroll
        for (unsigned j = 0; j < 16; ++j) { const unsigned c = xb_ld(&bar[XB_XCNT(j)]); sum += c; cnt += (c > 0u) ? 1u : 0u; mine = (j == x) ? c : mine; }
        if (sum == G) break;
        __builtin_amdgcn_s_sleep(1);
        if ((++sp & 255u) == 0u) { if (xb_ld(&bar[XB_TMO])) break; if (sp > XB_SPIN_CAP) { atomicAdd(&bar[XB_TMO], 1u); break; } }
    }
    nloc = mine > 0u ? mine : 1u; nx = cnt > 0u ? cnt : 1u;
}

__device__ __forceinline__ void xcd_barrier(const XcdBarrier& b) {
    asm volatile("s_waitcnt vmcnt(0)" ::: "memory");
    __syncthreads();
    if (threadIdx.x == 0) {
        unsigned* bar = b.bar;
        __builtin_amdgcn_s_waitcnt(0);
        unsigned nloc = b.st[0], nx = b.st[1];
        if (nloc == 0u) { xcd_barrier_complete(bar, b.x, nloc, nx); b.st[0] = nloc; b.st[1] = nx; }
        const unsigned old = xb_add(&bar[XB_XSUB(b.x)], 1u);
        const unsigned gen = old / nloc;
        if (old + 1u == (gen + 1u) * nloc) {
            __builtin_amdgcn_fence(__ATOMIC_RELEASE, "agent");
            asm volatile("s_waitcnt vmcnt(0)" ::: "memory");
            const unsigned og = xb_add(&bar[XB_TOP], 1u);
            const unsigned tg = og / nx;
            if (og + 1u == (tg + 1u) * nx) xb_add(&bar[XB_TOPGEN], 1u);
            else XB_SPIN(xb_ld(&bar[XB_TOPGEN]) == tg, bar);
            __builtin_amdgcn_fence(__ATOMIC_ACQUIRE, "agent");
            xb_add(&bar[XB_XGEN(b.x)], 1u);
            asm volatile("s_waitcnt vmcnt(0)" ::: "memory");
        } else {
            XB_SPIN(xb_ld(&bar[XB_XGEN(b.x)]) == gen, bar);
            __builtin_amdgcn_fence(__ATOMIC_ACQUIRE, "agent");
            asm volatile("s_waitcnt vmcnt(0)" ::: "memory");
        }
    }
    __syncthreads();
}

__global__ void __launch_bounds__(512, 2) mega(Params p) {
    extern __shared__ __attribute__((aligned(16))) unsigned char lds[];
    const int G = gridDim.x, bid = blockIdx.x, NGW = G * NW;
    int wv = __builtin_amdgcn_readfirstlane((int)(threadIdx.x >> 6)); asm volatile("" : "+s"(wv));
#define PHASE_IDS() const int tid = opaque_tid(wv), lane = tid & 63, wave = __builtin_amdgcn_readfirstlane(tid >> 6), gw = bid * NW + wave; (void)tid; (void)lane; (void)gw
    unsigned char* ws = (unsigned char*)inptr(22);
    LAS unsigned char* L = (LAS unsigned char*)lds;
    volatile LAS unsigned* bst = (volatile LAS unsigned*)(L + LDS_BST);
    if (threadIdx.x < 4) bst[threadIdx.x] = 0u;
    __syncthreads();
    const XcdBarrier bar = xcd_barrier_post((unsigned*)(ws + WS_CTL), bst);
#if TS
    if (blockIdx.x == 0 && threadIdx.x == 0) ((unsigned long long*)(ws + 29 * MiB))[0] = __builtin_amdgcn_s_memrealtime();
#define STAMP(k) do { if (TS == (k) && blockIdx.x == 0 && threadIdx.x == 0) ((unsigned long long*)(ws + 29 * MiB))[1] = __builtin_amdgcn_s_memrealtime(); } while (0)
#else
#define STAMP(k) do {} while (0)
#endif

#if EXP == 5
    for (int e_ = 0; e_ < 2; ++e_)
#endif
    {
        PHASE_IDS();
        LAS float* scr = (LAS float*)(L + wave * 8704);
        constexpr int I0 = (1024 / 64) * (DINP / 32), I1 = (QR / 64) * (MQ / 32), I2 = (KVR / 64) * (MKV / 32), I3 = 16 * 32, I4 = 16 * (FF / 32), I5 = (FF / 64) * 32;
        constexpr int I6 = (2048 / 64) * (128 / 32), I7 = (128 / 64) * (64 / 32);
        constexpr int NIT = I0 + I1 + I2 + I3 + I4 + I5 + 2 * I6 + 2 * I7;
        for (int it = gw; it < NIT; it += NGW) {
            int r = it;
            if (r < I0) { p0_transpose_item(inptr(2), 1024, DIN, DINP, (bf16_t*)(ws + WS_WIN), scr, r, lane, inptr(1), 0, 1); continue; } r -= I0;
            if (r < I1) { p0_transpose_item(inptr(5), QR, MQ, MQ, (bf16_t*)(ws + WS_WUQ), scr, r, lane, inptr(3)); continue; } r -= I1;
            if (r < I2) { p0_transpose_item(inptr(6), KVR, MKV, MKV, (bf16_t*)(ws + WS_WUKV), scr, r, lane, inptr(4), 0, 2); continue; } r -= I2;
            if (r < I3) { const int k0_ = 64 * (r / 32); p0_transpose_item(inptr(17), 1024, 1024, 1024, (bf16_t*)(ws + WS_WO), scr, r, lane, k0_ < 512 ? inptr(15) : inptr(16) - 512); continue; } r -= I3;
            if (r < I4) { p0_transpose_item(inptr(19), 1024, FF, FF, (bf16_t*)(ws + WS_WUP), scr, r, lane, inptr(18)); continue; } r -= I4;
            if (r < I5) { p0_transpose_item(inptr(20), FF, 1024, 1024, (bf16_t*)(ws + WS_WDN), scr, r, lane, nullptr, LDH); continue; } r -= I5;
            if (r < 2 * I6) { const int kv = r / I6; p0_transpose_item(inptr(12) + (size_t)kv * 2048 * 128, 2048, 128, 128, (bf16_t*)(ws + WS_W1T) + (size_t)kv * 128 * 2048, scr, r % I6, lane); continue; } r -= 2 * I6;
            { const int kv = r / I7; p0_transpose_item(inptr(13) + kv * 128 * 64, 128, 64, 64, (bf16_t*)(ws + WS_W2T) + kv * 64 * 128, scr, r % I7, lane); }
        }
        for (int m = gw; m < M; m += 4 * NGW) rows_to_bf16_rstd<4>(inptr(0), (bf16_t*)(ws + WS_XB), (float*)(ws + WS_RS1), m, NGW, lane);
        for (int e = bid * 512 + tid; e < 2048 * 16; e += G * 512) { const int pos = e >> 4, i = e & 15; const float inv = exp2f(-(float)i * (13.287712379549449f / 16.f)); float sn, cs; sincosf((float)pos * inv, &sn, &cs);
            ((float*)(ws + WS_ROPE))[pos * 32 + i] = cs; ((float*)(ws + WS_ROPE))[pos * 32 + 16 + i] = sn; }
        for (int m = bid * 512 + tid; m < M; m += G * 512) { ((float*)(ws + WS_SSQ2))[m] = 0.f; ((float*)(ws + WS_RSQ))[m] = 0.f; ((float*)(ws + WS_RSKV))[m] = 0.f; ((float*)(ws + WS_SSQKR))[m] = 0.f; ((float*)(ws + WS_SSQM))[2 * m] = 0.f; ((float*)(ws + WS_SSQM))[2 * m + 1] = 0.f; }
    }
    xcd_barrier(bar);
    STAMP(1);
#if EXP == 1
    for (int e_ = 0; e_ < 10; ++e_) xcd_barrier(bar);
#endif
#if EXP == 10
    for (int e_ = 0; e_ < 2; ++e_)
#endif
    { pg8::Gemm g{(const bf16_t*)(ws + WS_XB), (const bf16_t*)(ws + WS_WIN), M, DINP, DM, DM, DM}; pg8::StaticOrder S; S.init(M, DINP, G, bid);
      PEpiProj E{(bf16_t*)(ws + WS_PROJ), DINP, (const float*)(ws + WS_RS1), (float*)(ws + WS_RSQ), (float*)(ws + WS_RSKV), (float*)(ws + WS_SSQKR), inptr(9), inptr(10), (const float*)(ws + WS_ROPE), inptr(8)}; pg8::gemm_phase<PEpiProj, pg8::StaticOrder, true, true>(L, g, S, E, wv); }
    xcd_barrier(bar);
    STAMP(2);
#if EXP == 3
    for (int e_ = 0; e_ < 2; ++e_)
#endif
    { PHASE_IDS();
      __syncthreads();
      for (int t = bid; t < 256; t += G) compress_block(ws, L, t, wv); }
#if EXP == 11
    for (int e_ = 0; e_ < 2; ++e_) {
#endif
    { pg8::Gemm g{(const bf16_t*)(ws + WS_PROJ) + P_HKV, (const bf16_t*)(ws + WS_WUKV), M, MKV, KVR, DINP, KVR}; pg8::StaticOrder S; S.init(M, MKV, G, bid);
      PEpiKV E{(bf16_t*)(ws + WS_KVM), (bf16_t*)(ws + WS_KMLA), (const bf16_t*)(ws + WS_PROJ), (const float*)(ws + WS_RSKV), (const float*)(ws + WS_SSQKR), (const float*)(ws + WS_ROPE), inptr(8)}; pg8::gemm_phase<PEpiKV, pg8::StaticOrder, true, true>(L, g, S, E, wv); }
    asm volatile("" : "+s"(wv));
    { pg8::Gemm g{(const bf16_t*)(ws + WS_PROJ) + P_HQ, (const bf16_t*)(ws + WS_WUQ), M, MQ, QR, DINP, QR}; pg8::StaticOrder S; S.init(M, MQ, G, bid);
      PEpiBf16<0> E{(bf16_t*)(ws + WS_QM), MQ, (const float*)(ws + WS_RSQ), 1.f / QR}; pg8::gemm_phase<PEpiBf16<0>, pg8::StaticOrder, true, false>(L, g, S, E, wv); }
#if EXP == 11
    }
#endif
    xcd_barrier(bar);
    STAMP(5);
#if EXP == 2
    for (int e_ = 0; e_ < 2; ++e_)
#endif
    {
        PHASE_IDS();
        LAS float* tb = (LAS float*)L;
        for (int i = tid; i < 8 * 128; i += 512) { const int h = i >> 7, n = i & 127; tb[i] = (inptr(14)[t5_bucket(n) * 8 + h] - inptr(14)[31 * 8 + h]) * LOG2E; }
        __syncthreads();
        const int vcu = (G % 8 == 0) ? (bid % 8) * (G / 8) + bid / 8 : bid;
        for (int pr_ = vcu; pr_ < 256; pr_ += G) {
            { const int bg = pr_ >> 4, s_ = pr_ & 15;
#pragma unroll 1
              for (int u_ = 0; u_ < 2; ++u_) att::nsa_unit(ws, L, bg >> 1, bg & 1, (u_ & 1) ? s_ : 31 - s_, wv);
            }
            { const int bh = pr_ >> 2, s_ = pr_ & 3;
#pragma unroll 1
              for (int u_ = 0; u_ < 2; ++u_) att::mla_unit(ws, L, bh >> 3, bh & 7, u_ ? s_ : 7 - s_, wv, u_ ? (4 * (7 - s_) + 4) % att::NSLOT : 0, u_ ? 2 : 0, u_ ? 0 : 2);
            }
        }
    }
    xcd_barrier(bar);
    STAMP(7);
    { pg8::Gemm g{(const bf16_t*)(ws + WS_MIX), (const bf16_t*)(ws + WS_WO), M, DM, DM, DM, DM}; pg8::StaticOrder S; S.init(M, DM, G, bid);
      PEpiWo E{(const bf16_t*)(ws + WS_XB), (bf16_t*)(ws + WS_H2), (float*)(ws + WS_SSQ2), (const float*)(ws + WS_SSQM), DM}; pg8::gemm_phase<PEpiWo, pg8::StaticOrder, true, true>(L, g, S, E, wv); }
    xcd_barrier(bar);
    STAMP(9);
#if EXP == 4
    for (int e_ = 0; e_ < 2; ++e_)
#endif
    { pg8::Gemm g{(const bf16_t*)(ws + WS_H2), (const bf16_t*)(ws + WS_WUP), M, FF, DM, DM, DM}; pg8::StaticOrder S; S.init(M, FF, G, bid);
      PEpiBf16<2> E{(bf16_t*)(ws + WS_HID), LDH, (const float*)(ws + WS_SSQ2), 1.f / 1024}; pg8::gemm_phase<PEpiBf16<2>, pg8::StaticOrder, true, true>(L, g, S, E, wv); }
    xcd_barrier(bar);
    STAMP(10);
    { pg8::Gemm g{(const bf16_t*)(ws + WS_HID), (const bf16_t*)(ws + WS_WDN), M, DM, FF, LDH, LDH}; pg8::StaticOrder S; S.init(M, DM, G, bid);
      PEpiDown E{(const bf16_t*)(ws + WS_H2), ((float*)inptr(21)), DM}; pg8::gemm_phase<PEpiDown, pg8::StaticOrder, true, true>(L, g, S, E, wv); }
#if TS
    xcd_barrier(bar);
    if (blockIdx.x == 0 && threadIdx.x == 0) { const unsigned long long* tt = (const unsigned long long*)(ws + 29 * MiB); const float dlt = (TS == 100) ? 150.f : (float)(tt[1] - tt[0]) * (1.f / 256.f); ((float*)inptr(21))[0] += dlt; }
#endif
}

extern "C" void kernel_launch(void* const* d_in, const int* in_sizes, int n_in, void* d_out, int out_size,
                              void* d_ws, size_t ws_size, hipStream_t stream) {
    static int grid_blocks = 0;
    if (!grid_blocks) {
        int dev = 0, cus = 0, per_cu = 0;
        (void)hipGetDevice(&dev);
        (void)hipDeviceGetAttribute(&cus, hipDeviceAttributeMultiprocessorCount, dev);
        (void)hipFuncSetAttribute((const void*)mega, hipFuncAttributeMaxDynamicSharedMemorySize, LDS_BYTES);
        (void)hipOccupancyMaxActiveBlocksPerMultiprocessor(&per_cu, (const void*)mega, 512, LDS_BYTES);
        if (per_cu != 1) fprintf(stderr, "note: occupancy query reports %d blocks/CU; launching 1 per CU\n", per_cu);
        grid_blocks = cus;
        if (n_in != 21 || out_size != M * DM || ws_size < 256 * MiB) fprintf(stderr, "unexpected shapes: n_in %d out %d ws %zu\n", n_in, out_size, ws_size);
    }
    Params p{};
    for (int i = 0; i < 21; ++i) p.in[i] = (const float*)d_in[i];
    p.out = (float*)d_out; p.ws = (unsigned char*)d_ws;
    if (hipMemsetAsync((char*)d_ws + WS_CTL, 0, CTL_ZERO_BYTES, stream) != hipSuccess) { fprintf(stderr, "memset of the barrier words failed\n"); return; }
    hipLaunchKernelGGL(mega, dim3(grid_blocks), dim3(512), LDS_BYTES, stream, p);
    hipError_t e = hipPeekAtLastError();
    if (e != hipSuccess) fprintf(stderr, "launch failed: %s (grid %d)\n", hipGetErrorString(e), grid_blocks);
}
```

```cpp
#include <hip/hip_runtime.h>
#include <cstdio>
#include <cstdint>

#define LAS __attribute__((address_space(3)))
typedef unsigned short bf16_t;
typedef short bf16x8 __attribute__((ext_vector_type(8)));
typedef float f32x4 __attribute__((ext_vector_type(4)));
typedef unsigned u32x4 __attribute__((ext_vector_type(4)));
typedef unsigned u32x2 __attribute__((ext_vector_type(2)));

constexpr int BATCH = 8, SEQ = 2048, DM = 1024, M = BATCH * SEQ;
constexpr int DIN = 1976, DINP = 2048;
constexpr int C_HQ = 0, C_HKV = 384, C_HKR = 640, C_QB = 672, C_KVB = 1184, C_GATE = 1952;
constexpr int C_KCMP = C_KVB, C_VCMP = C_KVB + 128, C_KSEL = C_KVB + 256, C_VSEL = C_KVB + 384, C_KWIN = C_KVB + 512, C_VWIN = C_KVB + 640;
constexpr int P_HQ = 1280, P_HKV = 1664, P_HKR = 1920, P_GATE = 1952;
__host__ __device__ constexpr int slot_base(int s) { return 256 * (s >> 2) + 32 * (s & 3); }
constexpr int S_Q = 0, S_KCMP = 8, S_VCMP = 10, S_KSEL = 12, S_VSEL = 14, S_KWIN = 16, S_VWIN = 18;
constexpr int QR = 384, KVR = 256, MQ = 768, MKV = 1024, FF = 4096;
constexpr int LDH = FF + 64;
constexpr int NCMP = 127;
constexpr float EPS = 1e-6f;
constexpr float LOG2E = 1.4426950408889634f;
constexpr float QS_MLA = 0.10206207261596577f * LOG2E;
constexpr float QS_NSA = 0.125f * LOG2E;

constexpr size_t MiB = 1u << 20;
constexpr size_t WS_CTL = 0, CTL_ZERO_BYTES = 65536;
constexpr size_t WS_WIN = 1 * MiB, WS_WUQ = 5 * MiB, WS_WUKV = 6 * MiB, WS_WO = 7 * MiB, WS_WUP = 9 * MiB, WS_WDN = 17 * MiB;
constexpr size_t WS_KCMP = 26 * MiB, WS_VCMP = 26 * MiB + 512 * 1024;
constexpr size_t WS_W1T = 30 * MiB;
constexpr size_t WS_W2T = 27 * MiB;
constexpr size_t WS_RSQ = 28 * MiB, WS_RSKV = 28 * MiB + 65536, WS_SSQ2 = 28 * MiB + 131072, WS_SSQM = 28 * MiB + 262144, WS_RS1 = 28 * MiB + 262144 + 131072;
constexpr size_t WS_SSQKR = 28 * MiB + 524288;
constexpr size_t WS_ROPE = 29 * MiB + 65536;
constexpr size_t WS_XB = 32 * MiB;
constexpr size_t WS_DUMMY0 = 0;
constexpr size_t WS_HB = 32 * MiB;
constexpr size_t WS_MIX = 64 * MiB;
constexpr size_t WS_PROJ = 96 * MiB;
constexpr size_t WS_QM = 160 * MiB;
constexpr size_t WS_KVM = 184 * MiB;
constexpr size_t WS_KMLA = 216 * MiB;
constexpr size_t WS_QN = 208 * MiB;
constexpr size_t WS_KSEL = 240 * MiB;
constexpr size_t WS_KWIN = 244 * MiB;
constexpr size_t WS_HQN = 232 * MiB;
constexpr size_t WS_HKVN = 244 * MiB;
constexpr size_t WS_H2 = 224 * MiB;
constexpr size_t WS_HID = 32 * MiB;

constexpr int LDS_BYTES = 155648, LDS_BST = 154624;
constexpr int NW = 8;

struct Params {
    const float* in[21];
    float* out;
    unsigned char* ws;
};

typedef const float* cfptr_t;
__device__ __forceinline__ const float* inptr(int i) {
    const __attribute__((address_space(4))) char* ka = (const __attribute__((address_space(4))) char*)__builtin_amdgcn_kernarg_segment_ptr();
    int off = i * 8; asm volatile("" : "+s"(off));
    return *(const __attribute__((address_space(4))) cfptr_t*)(ka + off);
}
__device__ __forceinline__ unsigned f2bf(float f) { unsigned u = __builtin_bit_cast(unsigned, f); return (u + 0x7fffu + ((u >> 16) & 1u)) >> 16; }
__device__ __forceinline__ float bf2f(unsigned b) { return __builtin_bit_cast(float, b << 16); }
__device__ __forceinline__ unsigned pk2(float lo, float hi) { return f2bf(lo) | (f2bf(hi) << 16); }
__device__ __forceinline__ float wave_sum(float v) {
#pragma unroll
    for (int o = 1; o < 64; o <<= 1) v += __shfl_xor(v, o);
    return v;
}
__device__ __forceinline__ int t5_bucket(int n) {
    if (n < 16) return n;
    int b = 16;
    b += (n >= 19); b += (n >= 21); b += (n >= 24); b += (n >= 27); b += (n >= 31); b += (n >= 35); b += (n >= 40); b += (n >= 46);
    b += (n >= 52); b += (n >= 59); b += (n >= 67); b += (n >= 77); b += (n >= 87); b += (n >= 99); b += (n >= 113);
    return b;
}

__device__ __forceinline__ void p0_transpose_item(const float* W, int K, int N, int Npad, bf16_t* WT, LAS float* scr, int item, int lane, const float* gk = nullptr, int ldw = 0, int projmap = 0) {
    const int nblk = Npad / 32, kb = item / nblk, nb = item % nblk, k0 = 64 * kb, n0 = 32 * nb;
    int nsrc = n0;
    if (projmap == 2) { const int pn_ = n0 >> 8, bj_ = (n0 >> 7) & 1, wc_ = (n0 >> 5) & 3; nsrc = (wc_ < 2 ? 128 * (2 * pn_ + wc_) : 128 * (2 * pn_ + wc_ - 2) + 64) + 32 * bj_; }
    else if (projmap) { if (n0 < 1280) { const int sl = 4 * (n0 >> 8) + ((n0 & 127) >> 5), e0 = 32 * ((n0 >> 7) & 1); nsrc = (sl < 8 ? C_QB + 64 * sl : C_KVB + 64 * (sl - 8)) + e0; }
                   else if (n0 < 1280 + 672) nsrc = n0 - 1280; else if (n0 == P_GATE) nsrc = C_GATE; else nsrc = N; }
    const int nn = nsrc + (lane & 31);
    float wv[32];
#pragma unroll
    for (int i = 0; i < 32; ++i) { const int kk = 2 * i + (lane >> 5); wv[i] = (nn < N) ? W[(size_t)(k0 + kk) * N + nn] : 0.f; }
#pragma unroll
    for (int i = 0; i < 32; ++i) { const int kk = 2 * i + (lane >> 5); const float gg = gk ? gk[k0 + kk] : 1.f; scr[kk * 33 + (lane & 31)] = wv[i] * gg; }
    asm volatile("s_waitcnt lgkmcnt(0)" ::: "memory");
    const int c = lane & 7;
#pragma unroll
    for (int j = 0; j < 4; ++j) { const int n = (lane >> 3) + 8 * j; const LAS float* s = scr + (8 * c) * 33 + n;
        u32x4 o; o.x = pk2(s[0 * 33], s[1 * 33]); o.y = pk2(s[2 * 33], s[3 * 33]); o.z = pk2(s[4 * 33], s[5 * 33]); o.w = pk2(s[6 * 33], s[7 * 33]);
        *(u32x4*)(WT + (size_t)(n0 + n) * (ldw ? ldw : K) + k0 + 8 * c) = o; }
    asm volatile("s_waitcnt lgkmcnt(0)" ::: "memory");
}
template <int NR>
__device__ __forceinline__ void rows_to_bf16_rstd(const float* x, bf16_t* o, float* rstd_out, int row0, int rstride, int lane) {
    f32x4 v[NR][4];
#pragma unroll
    for (int r = 0; r < NR; ++r) { const int rr = (row0 + r * rstride < M) ? row0 + r * rstride : row0; const f32x4* xr = (const f32x4*)(x + (size_t)rr * DM) + lane;
#pragma unroll
        for (int j = 0; j < 4; ++j) v[r][j] = xr[64 * j]; }
#pragma unroll
    for (int r = 0; r < NR; ++r) { if (row0 + r * rstride >= M) continue; float s = 0.f;
#pragma unroll
        for (int j = 0; j < 4; ++j) s += (v[r][j].x * v[r][j].x + v[r][j].y * v[r][j].y) + (v[r][j].z * v[r][j].z + v[r][j].w * v[r][j].w);
        s = wave_sum(s);
        if (lane == 0) rstd_out[row0 + r * rstride] = 1.f / sqrtf(s * (1.f / DM) + EPS);
        unsigned long long* o8 = (unsigned long long*)(o + (size_t)(row0 + r * rstride) * DM) + lane;
#pragma unroll
        for (int j = 0; j < 4; ++j) o8[64 * j] = (unsigned long long)pk2(v[r][j].x, v[r][j].y) | ((unsigned long long)pk2(v[r][j].z, v[r][j].w) << 32); }
}

__device__ __forceinline__ int opaque_tid(int wv) { int lane; asm volatile("v_mbcnt_lo_u32_b32 %0, -1, 0\n\tv_mbcnt_hi_u32_b32 %0, -1, %0" : "=v"(lane)); return (wv << 6) | lane; }
namespace pg8 {
#define PG8_LAS __attribute__((address_space(3)))
typedef unsigned short bf16_t;
typedef short bf16x8 __attribute__((ext_vector_type(8)));
typedef float f32x4 __attribute__((ext_vector_type(4)));
typedef unsigned u32x4 __attribute__((ext_vector_type(4)));
constexpr int BM = 256, BK = 64, HALF = 128, HTB = HALF * BK * 2  , STAGE_BYTES = 8 * HTB, NXCD = 8, WGM = 8;

__host__ __device__ __forceinline__ int lds_byte(int r, int c) { const int st = (r >> 4) * 2 + (c >> 5), rr = r & 15, cc = c & 31, ob = rr * 64 + cc * 2; return st * 1024 + (ob ^ (((ob >> 9) & 1) << 5)); }
__host__ __device__ __forceinline__ void stage_rc(int b, int& R, int& C) { const int st = b / 1024, sb = b % 1024, swz = sb ^ (((sb >> 9) & 1) << 5); R = (st >> 1) * 16 + swz / 64; C = (st & 1) * 32 + (swz % 64) / 2; }
__host__ __device__ __forceinline__ int perm32(int rho) { const int n = rho >> 4, i = rho & 15; return 8 * (i >> 2) + 4 * n + (i & 3); }

struct Unit { int pm, pn; };
struct Gemm { const bf16_t* A; const bf16_t* Bt; int M, N, K, lda, ldb; };

struct StaticOrder {
    int nM, nN, nwg, G, c;
    __host__ __device__ void init(int M, int N, int G_, int c_) { nM = M / BM; nN = N / BM; nwg = nM * nN; G = G_; c = c_; }
    __host__ __device__ bool next(int i, Unit& u) const {
        const long L = (long)i * G + c; if (L >= nwg) return false;
        int wgid = (int)L; { const int q = nwg / NXCD, r = nwg % NXCD, xcd = wgid % NXCD, off = wgid / NXCD; wgid = (xcd < r ? xcd * (q + 1) : r * (q + 1) + (xcd - r) * q) + off; }
        const int nig = WGM * nN, gid = wgid / nig, fm = gid * WGM, gsz = (nM - fm) < WGM ? (nM - fm) : WGM;
        u.pm = fm + ((wgid % nig) % gsz); u.pn = (wgid % nig) / gsz; return true;
    }
    __device__ __forceinline__ void a_ready(const Unit&) const {}
    __device__ __forceinline__ void done(const Unit&) const {}
};

template <class Epi, class Sched, bool ALIGN_EPI = false, bool SP2 = false>
__device__ __forceinline__ void gemm_phase(PG8_LAS unsigned char* lds, const Gemm g, const Sched& S, const Epi& E, int wv) {
    const int tid = opaque_tid(wv), wid = __builtin_amdgcn_readfirstlane(tid >> 6), lane = tid & 63, wr = wid >> 2, wc = wid & 3, fr = lane & 15, fq = lane >> 4;
    const int K = g.K, nt = K / BK;
    unsigned voffA[2], voffB[2];
#pragma unroll
    for (int i = 0; i < 2; ++i) { int R, C; stage_rc(tid * 16 + i * 8192, R, C); const int Rb = Epi::PERM ? ((R & ~31) + perm32(R & 31)) : R;
        voffA[i] = (unsigned)(R * g.lda + C) * 2u; voffB[i] = (unsigned)(Rb * g.ldb + C) * 2u; }
    const size_t kstep = (size_t)(BK * 2);
    const size_t hstepA = (size_t)HALF * g.lda * 2, hstepB = (size_t)HALF * g.ldb * 2;
    const size_t tstepA = 2 * hstepA, tstepB = 2 * hstepB;
    const unsigned ldsw = (unsigned)wid * 1024u;
    const int aoff = lds_byte(wr * 64 + fr, fq * 8), boff = lds_byte(wc * 32 + fr, fq * 8);
#define PG8_SA(b, h) (((b) * 2 + (h)) * HTB)
#define PG8_SB(b, h) ((4 + (b) * 2 + (h)) * HTB)
#define PG8_STAGE(bufoff, gbase, voff) do { _Pragma("unroll") for (int _i = 0; _i < 2; ++_i) \
        __builtin_amdgcn_global_load_lds((const unsigned*)((const char*)(gbase) + (voff)[_i]), (PG8_LAS unsigned*)(lds + (bufoff) + ldsw + _i * 8192), 16, 0, 0); } while (0)
#define PG8_LDA(dst, b, h) do { _Pragma("unroll") for (int m = 0; m < 4; ++m) _Pragma("unroll") for (int k = 0; k < 2; ++k) dst[m][k] = *(const PG8_LAS bf16x8*)(lds + PG8_SA(b, h) + aoff + m * 2048 + k * 1024); } while (0)
#define PG8_LDB(dst, b, h) do { _Pragma("unroll") for (int n = 0; n < 2; ++n) _Pragma("unroll") for (int k = 0; k < 2; ++k) dst[n][k] = *(const PG8_LAS bf16x8*)(lds + PG8_SB(b, h) + boff + n * 2048 + k * 1024); } while (0)
#define PG8_MMA(ai, bj, At, Bt) do { __builtin_amdgcn_s_setprio(1); _Pragma("unroll") for (int m = 0; m < 4; ++m) _Pragma("unroll") for (int n = 0; n < 2; ++n) _Pragma("unroll") for (int k = 0; k < 2; ++k) \
        acc[ai][bj][m][n] = __builtin_amdgcn_mfma_f32_16x16x32_bf16(Bt[n][k], At[m][k], acc[ai][bj][m][n], 0, 0, 0); __builtin_amdgcn_s_setprio(0); } while (0)
#define PG8_WAIT_V(n) asm volatile("s_waitcnt vmcnt(" #n ")" ::: "memory")
#define PG8_WAIT_L(n) asm volatile("s_waitcnt lgkmcnt(" #n ")" ::: "memory")
#define PG8_BAR __builtin_amdgcn_s_barrier()
#define PG8_SCHED __builtin_amdgcn_sched_barrier(0)
    Unit cur, nxt; int ui = 0;
    if (!S.next(0, cur)) return;
    f32x4 acc[2][2][4][2];
#pragma unroll
    for (int a = 0; a < 2; ++a)
#pragma unroll
        for (int b = 0; b < 2; ++b)
#pragma unroll
            for (int m = 0; m < 4; ++m)
#pragma unroll
                for (int n = 0; n < 2; ++n) acc[a][b][m][n] = (f32x4){0.f, 0.f, 0.f, 0.f};
    bf16x8 At[4][2], B0[2][2], B1[2][2];
    const char* cA = (const char*)g.A + (size_t)cur.pm * tstepA; const char* cB = (const char*)g.Bt + (size_t)cur.pn * tstepB;
    asm volatile("" : "+s"(cA), "+s"(cB));
    S.a_ready(cur);
    if constexpr (SP2) {
        PG8_STAGE(PG8_SB(0, 0), cB, voffB); PG8_STAGE(PG8_SB(0, 1), cB + hstepB, voffB); PG8_STAGE(PG8_SA(0, 0), cA, voffA); PG8_STAGE(PG8_SA(0, 1), cA + hstepA, voffA);
        if (wr == 1) PG8_BAR;
        PG8_WAIT_V(2); PG8_BAR;
        PG8_STAGE(PG8_SB(1, 0), cB + kstep, voffB); PG8_STAGE(PG8_SA(1, 0), cA + kstep, voffA); PG8_STAGE(PG8_SB(1, 1), cB + hstepB + kstep, voffB);
        PG8_WAIT_V(6); PG8_BAR;
    } else {
        PG8_STAGE(PG8_SB(0, 0), cB, voffB); PG8_STAGE(PG8_SA(0, 0), cA, voffA); PG8_STAGE(PG8_SB(0, 1), cB + hstepB, voffB); PG8_STAGE(PG8_SA(0, 1), cA + hstepA, voffA);
        if (wr == 1) PG8_BAR;
        PG8_WAIT_V(4); PG8_BAR;
        PG8_STAGE(PG8_SB(1, 0), cB + kstep, voffB); PG8_STAGE(PG8_SA(1, 0), cA + kstep, voffA); PG8_STAGE(PG8_SB(1, 1), cB + hstepB + kstep, voffB);
        PG8_WAIT_V(6); PG8_BAR;
    }
    for (;;) {
        const bool has_next = S.next(ui + 1, nxt);
        const char* nA = has_next ? (const char*)g.A + (size_t)nxt.pm * tstepA : cA; const char* nB = has_next ? (const char*)g.Bt + (size_t)nxt.pn * tstepB : cB;
        asm volatile("" : "+s"(nA), "+s"(nB));
        for (int t = 0; t < nt; t += 2) {
            if constexpr (Epi::MIDSCALE) { if (t == nt / 2) E.midscale(acc, cur, wr, fr); }
            const bool last = (t == nt - 2);
            const char* a1 = cA + (size_t)(t + 1) * kstep;
            const char* a2 = last ? nA : cA + (size_t)(t + 2) * kstep; const char* b2 = last ? nB : cB + (size_t)(t + 2) * kstep;
            const char* a3 = a2 + kstep; const char* b3 = b2 + kstep;
            asm volatile("" : "+s"(a1), "+s"(a2), "+s"(b2), "+s"(a3), "+s"(b3));
            if (last && has_next) S.a_ready(nxt);
            if constexpr (SP2) {
            PG8_LDB(B0, 0, 0); PG8_LDB(B1, 0, 1); PG8_SCHED; PG8_LDA(At, 0, 0); PG8_STAGE(PG8_SA(1, 1), a1 + hstepA, voffA);
            PG8_WAIT_V(8); PG8_WAIT_L(0); PG8_BAR; PG8_MMA(0, 0, At, B0); PG8_MMA(0, 1, At, B1); PG8_BAR; PG8_SCHED;
            PG8_LDA(At, 0, 1); PG8_STAGE(PG8_SB(0, 0), b2, voffB); PG8_STAGE(PG8_SB(0, 1), b2 + hstepB, voffB); PG8_STAGE(PG8_SA(0, 0), a2, voffA);
            PG8_WAIT_V(8); PG8_WAIT_L(0); PG8_BAR; PG8_MMA(1, 0, At, B0); PG8_MMA(1, 1, At, B1); PG8_BAR; PG8_SCHED;
            PG8_LDB(B0, 1, 0); PG8_LDB(B1, 1, 1); PG8_SCHED; PG8_LDA(At, 1, 0); PG8_STAGE(PG8_SA(0, 1), a2 + hstepA, voffA);
            PG8_WAIT_V(8); PG8_WAIT_L(0); PG8_BAR; PG8_MMA(0, 0, At, B0); PG8_MMA(0, 1, At, B1); PG8_BAR; PG8_SCHED;
            PG8_LDA(At, 1, 1); PG8_STAGE(PG8_SB(1, 0), b3, voffB); PG8_STAGE(PG8_SB(1, 1), b3 + hstepB, voffB); PG8_STAGE(PG8_SA(1, 0), a3, voffA);
            PG8_WAIT_V(8); PG8_WAIT_L(0); PG8_BAR; PG8_MMA(1, 0, At, B0); PG8_MMA(1, 1, At, B1); PG8_BAR; PG8_SCHED;
            } else {
            PG8_LDB(B0, 0, 0); PG8_SCHED; PG8_LDA(At, 0, 0); PG8_STAGE(PG8_SA(1, 1), a1 + hstepA, voffA);
            PG8_WAIT_L(8); PG8_BAR; PG8_WAIT_L(0); PG8_MMA(0, 0, At, B0); PG8_BAR; PG8_SCHED;
            PG8_LDB(B1, 0, 1); PG8_STAGE(PG8_SB(0, 0), b2, voffB);
            PG8_BAR; PG8_WAIT_L(0); PG8_MMA(0, 1, At, B1); PG8_BAR;
            PG8_LDA(At, 0, 1); PG8_STAGE(PG8_SA(0, 0), a2, voffA);
            PG8_BAR; PG8_WAIT_L(0); PG8_MMA(1, 0, At, B0); PG8_BAR; PG8_SCHED;
            PG8_STAGE(PG8_SB(0, 1), b2 + hstepB, voffB);
            PG8_WAIT_V(6); PG8_BAR; PG8_MMA(1, 1, At, B1); PG8_BAR;
            PG8_LDB(B0, 1, 0); PG8_SCHED; PG8_LDA(At, 1, 0); PG8_STAGE(PG8_SA(0, 1), a2 + hstepA, voffA);
            PG8_WAIT_L(8); PG8_BAR; PG8_WAIT_L(0); PG8_MMA(0, 0, At, B0); PG8_BAR; PG8_SCHED;
            PG8_LDB(B1, 1, 1); PG8_STAGE(PG8_SB(1, 0), b3, voffB);
            PG8_BAR; PG8_WAIT_L(0); PG8_MMA(0, 1, At, B1); PG8_BAR;
            PG8_LDA(At, 1, 1); PG8_STAGE(PG8_SA(1, 0), a3, voffA);
            PG8_BAR; PG8_WAIT_L(0); PG8_MMA(1, 0, At, B0); PG8_BAR; PG8_SCHED;
            PG8_STAGE(PG8_SB(1, 1), b3 + hstepB, voffB);
            PG8_WAIT_V(6); PG8_BAR; PG8_MMA(1, 1, At, B1); PG8_BAR;
            }
        }
        if constexpr (ALIGN_EPI) { if (wr == 0) PG8_BAR; }
        if constexpr (!Epi::AFTER_DRAIN) { const int l2_ = opaque_tid(wv) & 63; E(acc, cur, wr, wc, l2_ & 15, l2_ >> 4); S.done(cur); }
        if (!has_next) break;
#pragma unroll
        for (int a = 0; a < 2; ++a)
#pragma unroll
            for (int b = 0; b < 2; ++b)
#pragma unroll
                for (int m = 0; m < 4; ++m)
#pragma unroll
                    for (int n = 0; n < 2; ++n) acc[a][b][m][n] = (f32x4){0.f, 0.f, 0.f, 0.f};
        cur = nxt; cA = nA; cB = nB; ++ui;
        if constexpr (ALIGN_EPI) { if (wr == 1) PG8_BAR; }
    }
    PG8_WAIT_V(0);
    if constexpr (!ALIGN_EPI) { if (wr == 0) PG8_BAR; }
    PG8_BAR;
    if constexpr (Epi::AFTER_DRAIN) { E.fused(acc, cur, wr, wc, fr, fq, lds, wid, lane); S.done(cur); }
#undef PG8_SA
#undef PG8_SB
#undef PG8_STAGE
#undef PG8_LDA
#undef PG8_LDB
#undef PG8_MMA
#undef PG8_WAIT_V
#undef PG8_WAIT_L
#undef PG8_BAR
#undef PG8_SCHED
}
}

__device__ __forceinline__ unsigned cvt_pk_bf16(float lo, float hi) { unsigned r; asm volatile("v_cvt_pk_bf16_f32 %0, %1, %2" : "=v"(r) : "v"(lo), "v"(hi)); return r; }
template <int ACT> struct PEpiBf16 {
    static constexpr bool PERM = true, AFTER_DRAIN = false, MIDSCALE = false;
    bf16_t* O; int ldc; const float* rs; float invn;
    __device__ __forceinline__ void operator()(const f32x4 (&acc)[2][2][4][2], const pg8::Unit& u, int wr, int wc, int fr, int fq) const {
        const int row0 = u.pm * 256 + wr * 64 + fr, col0 = u.pn * 256 + wc * 32 + 8 * fq;
        float rsc[2][4];
#pragma unroll
        for (int ai = 0; ai < 2; ++ai)
#pragma unroll
            for (int m = 0; m < 4; ++m) rsc[ai][m] = rs ? rs[row0 + ai * 128 + m * 16] : 1.f;
        if (invn > 0.f) {
#pragma unroll
            for (int ai = 0; ai < 2; ++ai)
#pragma unroll
                for (int m = 0; m < 4; ++m) rsc[ai][m] = 1.f / sqrtf(rsc[ai][m] * invn + EPS); }
#pragma unroll
        for (int ai = 0; ai < 2; ++ai)
#pragma unroll
            for (int m = 0; m < 4; ++m) { bf16_t* rowp = O + (size_t)(row0 + ai * 128 + m * 16) * ldc + col0; const float sc_ = rsc[ai][m];
#pragma unroll
                for (int bj = 0; bj < 2; ++bj) { f32x4 v0 = acc[ai][bj][m][0] * sc_, v1 = acc[ai][bj][m][1] * sc_;
                    if (ACT == 2) {
#pragma unroll
                        for (int e = 0; e < 4; ++e) { const float a = fmaxf(v0[e], 0.f), b = fmaxf(v1[e], 0.f); v0[e] = a * a; v1[e] = b * b; } }
                    u32x4 w; w.x = cvt_pk_bf16(v0[0], v0[1]); w.y = cvt_pk_bf16(v0[2], v0[3]); w.z = cvt_pk_bf16(v1[0], v1[1]); w.w = cvt_pk_bf16(v1[2], v1[3]);
                    *(u32x4*)(rowp + bj * 128) = w; } }
    }
};
struct PEpiProj {
    static constexpr bool PERM = true, AFTER_DRAIN = false, MIDSCALE = false;
    bf16_t* O; int ldc; const float* rs1; float* ssq_q; float* ssq_kv; float* ssq_kr; const float* qgain; const float* kgain; const float* rope; const float* kgm;
    __device__ __forceinline__ void operator()(const f32x4 (&acc)[2][2][4][2], const pg8::Unit& u, int wr, int wc, int fr, int fq) const {
        const int row0 = u.pm * 256 + wr * 64 + fr, col0 = u.pn * 256 + wc * 32 + 8 * fq, lane = fq * 16 + fr;
        float rsc[2][4];
#pragma unroll
        for (int ai = 0; ai < 2; ++ai)
#pragma unroll
            for (int m = 0; m < 4; ++m) rsc[ai][m] = rs1[row0 + ai * 128 + m * 16];
        const int sl = 4 * u.pn + wc;
        int mode = 0; const float* g = nullptr; float gs = 1.f;
        if (u.pn < 5) { if (sl < 8) { mode = 1; g = qgain; gs = QS_NSA; } else if (sl == S_KSEL || sl == S_KSEL + 1) { mode = 1; g = kgain + 64; } else if (sl == S_KWIN || sl == S_KWIN + 1) { mode = 1; g = kgain + 128; } }
        f32x4 ga[2][2];
        if (mode == 1) {
#pragma unroll
            for (int bj = 0; bj < 2; ++bj) { ga[bj][0] = *(const f32x4*)(g + 32 * bj + 8 * fq) * gs; ga[bj][1] = *(const f32x4*)(g + 32 * bj + 8 * fq + 4) * gs; } }
#pragma unroll
        for (int ai = 0; ai < 2; ++ai)
#pragma unroll
            for (int m = 0; m < 4; ++m) { const int row = row0 + ai * 128 + m * 16; bf16_t* rowp = O + (size_t)row * ldc + col0; const float sc_ = rsc[ai][m];
                f32x4 v[2][2];
#pragma unroll
                for (int bj = 0; bj < 2; ++bj) { v[bj][0] = acc[ai][bj][m][0] * sc_; v[bj][1] = acc[ai][bj][m][1] * sc_; }
                if (mode == 1) {
                    float ss = 0.f;
#pragma unroll
                    for (int bj = 0; bj < 2; ++bj)
#pragma unroll
                        for (int n = 0; n < 2; ++n) ss += (v[bj][n][0] * v[bj][n][0] + v[bj][n][1] * v[bj][n][1]) + (v[bj][n][2] * v[bj][n][2] + v[bj][n][3] * v[bj][n][3]);
                    ss += __builtin_bit_cast(float, __builtin_amdgcn_ds_bpermute((lane ^ 16) << 2, __builtin_bit_cast(int, ss)));
                    ss += __builtin_bit_cast(float, __builtin_amdgcn_ds_bpermute((lane ^ 32) << 2, __builtin_bit_cast(int, ss)));
                    const float rstd = 1.f / sqrtf(ss * (1.f / 64) + EPS);
#pragma unroll
                    for (int bj = 0; bj < 2; ++bj) { v[bj][0] = v[bj][0] * rstd * ga[bj][0]; v[bj][1] = v[bj][1] * rstd * ga[bj][1]; }
                } else if (u.pn >= 5) {
#pragma unroll
                    for (int bj = 0; bj < 2; ++bj) { const int cb = u.pn * 256 + bj * 128;
                        float* dst = (cb < P_HKV) ? ssq_q : (cb < P_HKR ? ssq_kv : ((cb == P_HKR && wc == 0) ? ssq_kr : nullptr));
                        if (dst) { float ss = (v[bj][0][0] * v[bj][0][0] + v[bj][0][1] * v[bj][0][1]) + (v[bj][0][2] * v[bj][0][2] + v[bj][0][3] * v[bj][0][3]) + (v[bj][1][0] * v[bj][1][0] + v[bj][1][1] * v[bj][1][1]) + (v[bj][1][2] * v[bj][1][2] + v[bj][1][3] * v[bj][1][3]);
                            ss += __builtin_bit_cast(float, __builtin_amdgcn_ds_bpermute((lane ^ 16) << 2, __builtin_bit_cast(int, ss)));
                            ss += __builtin_bit_cast(float, __builtin_amdgcn_ds_bpermute((lane ^ 32) << 2, __builtin_bit_cast(int, ss)));
                            if (fq == 0) __hip_atomic_fetch_add(dst + row, ss, __ATOMIC_RELAXED, __HIP_MEMORY_SCOPE_AGENT); }
                        if (cb == P_HKR && wc == 0) {
                            const f32x4 g0 = *(const f32x4*)(kgm + 64 + 8 * fq), g1 = *(const f32x4*)(kgm + 64 + 8 * fq + 4);
                            const float* rp = rope + (size_t)(row & (SEQ - 1)) * 32 + 8 * (fq & 1);
                            const f32x4 c0 = *(const f32x4*)rp, c1 = *(const f32x4*)(rp + 4), s0 = *(const f32x4*)(rp + 16), s1 = *(const f32x4*)(rp + 20);
#pragma unroll
                            for (int n = 0; n < 2; ++n)
#pragma unroll
                                for (int j = 0; j < 4; ++j) { const float nv = v[bj][n][j] * (n ? g1[j] : g0[j]);
                                    const float pv = __builtin_bit_cast(float, __builtin_amdgcn_ds_bpermute((lane ^ 32) << 2, __builtin_bit_cast(int, nv)));
                                    const float cs = n ? c1[j] : c0[j], sn = n ? s1[j] : s0[j]; v[bj][n][j] = (fq < 2) ? nv * cs - pv * sn : nv * cs + pv * sn; } } }
                }
#pragma unroll
                for (int bj = 0; bj < 2; ++bj) { u32x4 w; w.x = cvt_pk_bf16(v[bj][0][0], v[bj][0][1]); w.y = cvt_pk_bf16(v[bj][0][2], v[bj][0][3]); w.z = cvt_pk_bf16(v[bj][1][0], v[bj][1][1]); w.w = cvt_pk_bf16(v[bj][1][2], v[bj][1][3]);
                    *(u32x4*)(rowp + bj * 128) = w; } }
    }
};
struct PEpiKV {
    static constexpr bool PERM = true, AFTER_DRAIN = false, MIDSCALE = false;
    bf16_t* V; bf16_t* K; const bf16_t* proj; const float* ssq_kv; const float* ssq_kr; const float* rope; const float* kgain;
    __device__ __forceinline__ void operator()(const f32x4 (&acc)[2][2][4][2], const pg8::Unit& u, int wr, int wc, int fr_, int fq_) const {
        int fr = fr_, fq = fq_; asm volatile("" : "+v"(fr), "+v"(fq)); const float* kgain = this->kgain; asm volatile("" : "+s"(kgain)); const float* rope = this->rope; asm volatile("" : "+s"(rope));
        const int row0 = u.pm * 256 + wr * 64 + fr, lane = fq * 16 + fr;
        float rsc[2][4];
#pragma unroll
        for (int ai = 0; ai < 2; ++ai)
#pragma unroll
            for (int m = 0; m < 4; ++m) rsc[ai][m] = 1.f / sqrtf(ssq_kv[row0 + ai * 128 + m * 16] * (1.f / KVR) + EPS);
        if (wc >= 2) {
            const int col0 = u.pn * 256 + wc * 32 + 8 * fq;
#pragma unroll
            for (int ai = 0; ai < 2; ++ai)
#pragma unroll
                for (int m = 0; m < 4; ++m) { bf16_t* rowp = V + (size_t)(row0 + ai * 128 + m * 16) * MKV + col0; const float sc_ = rsc[ai][m];
#pragma unroll
                    for (int bj = 0; bj < 2; ++bj) { const f32x4 v0 = acc[ai][bj][m][0] * sc_, v1 = acc[ai][bj][m][1] * sc_;
                        u32x4 w; w.x = cvt_pk_bf16(v0[0], v0[1]); w.y = cvt_pk_bf16(v0[2], v0[3]); w.z = cvt_pk_bf16(v1[0], v1[1]); w.w = cvt_pk_bf16(v1[2], v1[3]);
                        *(u32x4*)(rowp + bj * 128) = w; } }
            return;
        }
        const int hh = 2 * u.pn + wc;
#pragma unroll
        for (int ai = 0; ai < 2; ++ai)
#pragma unroll
            for (int m = 0; m < 4; ++m) { const int row = row0 + ai * 128 + m * 16; const float sc_ = rsc[ai][m];
                bf16_t* ko = K + (size_t)row * MQ + 96 * hh;
                float rstd;
                {
                    f32x4 v[2][2]; float ss = 0.f;
#pragma unroll
                    for (int bj = 0; bj < 2; ++bj)
#pragma unroll
                        for (int n = 0; n < 2; ++n) { v[bj][n] = acc[ai][bj][m][n] * sc_; ss += (v[bj][n][0] * v[bj][n][0] + v[bj][n][1] * v[bj][n][1]) + (v[bj][n][2] * v[bj][n][2] + v[bj][n][3] * v[bj][n][3]); }
                    ss += __builtin_bit_cast(float, __builtin_amdgcn_ds_bpermute((lane ^ 16) << 2, __builtin_bit_cast(int, ss)));
                    ss += __builtin_bit_cast(float, __builtin_amdgcn_ds_bpermute((lane ^ 32) << 2, __builtin_bit_cast(int, ss)));
                    rstd = 1.f / sqrtf((ss + ssq_kr[row]) * (1.f / 96) + EPS);
#pragma unroll
                    for (int bj = 0; bj < 2; ++bj) { const f32x4 g0 = *(const f32x4*)(kgain + 32 * bj + 8 * fq), g1 = *(const f32x4*)(kgain + 32 * bj + 8 * fq + 4);
                        const f32x4 a = v[bj][0] * rstd * g0, b = v[bj][1] * rstd * g1;
                        u32x4 w; w.x = cvt_pk_bf16(a[0], a[1]); w.y = cvt_pk_bf16(a[2], a[3]); w.z = cvt_pk_bf16(b[0], b[1]); w.w = cvt_pk_bf16(b[2], b[3]);
                        *(u32x4*)(ko + 32 * bj + 8 * fq) = w; }
                }
                asm volatile("" ::: "memory");
                {
                    const bf16x8 kr8 = *(const bf16x8*)(proj + (size_t)row * DINP + P_HKR + 8 * fq);
                    u32x4 w; w.x = cvt_pk_bf16(bf2f((unsigned short)kr8[0]) * rstd, bf2f((unsigned short)kr8[1]) * rstd); w.y = cvt_pk_bf16(bf2f((unsigned short)kr8[2]) * rstd, bf2f((unsigned short)kr8[3]) * rstd);
                    w.z = cvt_pk_bf16(bf2f((unsigned short)kr8[4]) * rstd, bf2f((unsigned short)kr8[5]) * rstd); w.w = cvt_pk_bf16(bf2f((unsigned short)kr8[6]) * rstd, bf2f((unsigned short)kr8[7]) * rstd);
                    *(u32x4*)(ko + 64 + 8 * fq) = w;
                }
                asm volatile("" ::: "memory"); }
    }
};
struct PEpiWo {
    static constexpr bool PERM = false, AFTER_DRAIN = false, MIDSCALE = true;
    const bf16_t* base; bf16_t* xb; float* ssq; const float* ssqm; int ldc;
    __device__ __forceinline__ void midscale(f32x4 (&acc)[2][2][4][2], const pg8::Unit& u, int wr, int fr) const {
#pragma unroll
        for (int ai = 0; ai < 2; ++ai)
#pragma unroll
            for (int m = 0; m < 4; ++m) { const int row = u.pm * 256 + ai * 128 + wr * 64 + m * 16 + fr;
                const float sa = ssqm[2 * row], sb = ssqm[2 * row + 1]; const float ratio = sqrtf((sb * (1.f / 512) + EPS) / (sa * (1.f / 512) + EPS));
#pragma unroll
                for (int bj = 0; bj < 2; ++bj)
#pragma unroll
                    for (int n = 0; n < 2; ++n) acc[ai][bj][m][n] *= ratio; }
    }
    __device__ __forceinline__ void operator()(const f32x4 (&acc)[2][2][4][2], const pg8::Unit& u, int wr, int wc, int fr, int fq) const {
        const int col0 = u.pn * 256 + wc * 32 + 4 * fq; const int lane = fq * 16 + fr;
        const int rowb = u.pm * 256 + wr * 64 + fr;
        float rb[8];
#pragma unroll
        for (int g_ = 0; g_ < 8; ++g_) rb[g_] = ssqm[2 * (rowb + (g_ >> 2) * 128 + (g_ & 3) * 16) + 1];
        u32x2 nxt[2][2];
#pragma unroll
        for (int bj = 0; bj < 2; ++bj)
#pragma unroll
            for (int n = 0; n < 2; ++n) nxt[bj][n] = *(const u32x2*)(base + (size_t)rowb * ldc + col0 + bj * 128 + n * 16);
#pragma unroll
        for (int g_ = 0; g_ < 8; ++g_) { const int ai = g_ >> 2, m = g_ & 3; const int row = rowb + ai * 128 + m * 16; const size_t off = (size_t)row * ldc + col0; float ss = 0.f;
            u32x2 cur[2][2];
#pragma unroll
            for (int bj = 0; bj < 2; ++bj)
#pragma unroll
                for (int n = 0; n < 2; ++n) cur[bj][n] = nxt[bj][n];
            if (g_ < 7) { const size_t offn = (size_t)(rowb + ((g_ + 1) >> 2) * 128 + ((g_ + 1) & 3) * 16) * ldc + col0;
#pragma unroll
                for (int bj = 0; bj < 2; ++bj)
#pragma unroll
                    for (int n = 0; n < 2; ++n) nxt[bj][n] = *(const u32x2*)(base + offn + bj * 128 + n * 16); }
            const float rbs = 1.f / sqrtf(rb[g_] * (1.f / 512) + EPS);
#pragma unroll
            for (int bj = 0; bj < 2; ++bj)
#pragma unroll
                for (int n = 0; n < 2; ++n) { const u32x2 cw = cur[bj][n]; const f32x4 v = (f32x4){bf2f(cw.x & 0xffffu), bf2f(cw.x >> 16), bf2f(cw.y & 0xffffu), bf2f(cw.y >> 16)} + acc[ai][bj][m][n] * rbs;
                    ss += (v[0] * v[0] + v[1] * v[1]) + (v[2] * v[2] + v[3] * v[3]);
                    u32x2 w; w.x = cvt_pk_bf16(v[0], v[1]); w.y = cvt_pk_bf16(v[2], v[3]); *(u32x2*)(xb + off + bj * 128 + n * 16) = w; }
            ss += __builtin_bit_cast(float, __builtin_amdgcn_ds_bpermute((lane ^ 16) << 2, __builtin_bit_cast(int, ss)));
            ss += __builtin_bit_cast(float, __builtin_amdgcn_ds_bpermute((lane ^ 32) << 2, __builtin_bit_cast(int, ss)));
            if (fq == 0) __hip_atomic_fetch_add(ssq + row, ss, __ATOMIC_RELAXED, __HIP_MEMORY_SCOPE_AGENT); }
    }
};


struct PEpiDown {
    static constexpr bool PERM = false, AFTER_DRAIN = false, MIDSCALE = false;
    const bf16_t* xb; float* out; int ldc;
    __device__ __forceinline__ void operator()(const f32x4 (&acc)[2][2][4][2], const pg8::Unit& u, int wr, int wc, int fr, int fq) const {
        const int col0 = u.pn * 256 + wc * 32 + 4 * fq; const int rowb = u.pm * 256 + wr * 64 + fr;
        u32x2 nxt[2][2];
#pragma unroll
        for (int bj = 0; bj < 2; ++bj)
#pragma unroll
            for (int n = 0; n < 2; ++n) nxt[bj][n] = *(const u32x2*)(xb + (size_t)rowb * ldc + col0 + bj * 128 + n * 16);
#pragma unroll
        for (int g_ = 0; g_ < 8; ++g_) { const int ai = g_ >> 2, m = g_ & 3; const size_t off = (size_t)(rowb + ai * 128 + m * 16) * ldc + col0;
            u32x2 cur[2][2];
#pragma unroll
            for (int bj = 0; bj < 2; ++bj)
#pragma unroll
                for (int n = 0; n < 2; ++n) cur[bj][n] = nxt[bj][n];
            if (g_ < 7) { const size_t offn = (size_t)(rowb + ((g_ + 1) >> 2) * 128 + ((g_ + 1) & 3) * 16) * ldc + col0;
#pragma unroll
                for (int bj = 0; bj < 2; ++bj)
#pragma unroll
                    for (int n = 0; n < 2; ++n) nxt[bj][n] = *(const u32x2*)(xb + offn + bj * 128 + n * 16); }
#pragma unroll
            for (int bj = 0; bj < 2; ++bj)
#pragma unroll
                for (int n = 0; n < 2; ++n) { const u32x2 w = cur[bj][n];
                    const f32x4 bs = (f32x4){bf2f(w.x & 0xffffu), bf2f(w.x >> 16), bf2f(w.y & 0xffffu), bf2f(w.y >> 16)};
                    __builtin_nontemporal_store(bs + acc[ai][bj][m][n], (f32x4*)(out + off + bj * 128 + n * 16)); } }
    }
};

__device__ __forceinline__ float sq8(const bf16x8 v) { float s = 0.f;
#pragma unroll
    for (int j = 0; j < 8; ++j) { const float f = bf2f((unsigned short)v[j]); s += f * f; }
    return s; }
__device__ __forceinline__ u32x4 scale8(const bf16x8 v, float sc, const f32x4 ga, const f32x4 gb) { u32x4 o;
    o.x = pk2(bf2f((unsigned short)v[0]) * sc * ga[0], bf2f((unsigned short)v[1]) * sc * ga[1]); o.y = pk2(bf2f((unsigned short)v[2]) * sc * ga[2], bf2f((unsigned short)v[3]) * sc * ga[3]);
    o.z = pk2(bf2f((unsigned short)v[4]) * sc * gb[0], bf2f((unsigned short)v[5]) * sc * gb[1]); o.w = pk2(bf2f((unsigned short)v[6]) * sc * gb[2], bf2f((unsigned short)v[7]) * sc * gb[3]);
    return o; }

__device__ __forceinline__ void compress_block(unsigned char* ws, LAS unsigned char* L, int task, int wv) {
    const int tid = opaque_tid(wv), lane = tid & 63, wid = __builtin_amdgcn_readfirstlane(tid >> 6), fr = lane & 15, fq = lane >> 4;
    const int tc = task & 15, b = (task >> 4) & 7, kv = task >> 7;
    int c = 8 * tc + (fr >> 1); const int g = fr & 1; if (c > NCMP - 1) c = NCMP - 1;
    const bf16_t* arow = (const bf16_t*)(ws + WS_PROJ) + (size_t)(b * SEQ + 16 * c) * DINP + slot_base((kv ? S_VCMP : S_KCMP) + g) + 8 * fq;
    const float* pe = inptr(11) + kv * 2048 + 8 * fq;
    const bf16_t* w1t = (const bf16_t*)(ws + WS_W1T) + (size_t)kv * 128 * 2048 + (size_t)fr * 2048 + 8 * fq;
    f32x4 acc[8];
#pragma unroll
    for (int n = 0; n < 8; ++n) acc[n] = (f32x4){0.f, 0.f, 0.f, 0.f};
#pragma unroll 4
    for (int s8 = 0; s8 < 8; ++s8) {
        const int s = 8 * wid + s8, r = s >> 1, db = (s & 1) * 32;
        const bf16x8 araw = *(const bf16x8*)(arow + (size_t)r * DINP + 4 * db);
        const f32x4 pa = *(const f32x4*)(pe + r * 64 + db), pb = *(const f32x4*)(pe + r * 64 + db + 4);
        u32x4 aw; aw.x = pk2(bf2f((unsigned short)araw[0]) + pa[0], bf2f((unsigned short)araw[1]) + pa[1]); aw.y = pk2(bf2f((unsigned short)araw[2]) + pa[2], bf2f((unsigned short)araw[3]) + pa[3]);
        aw.z = pk2(bf2f((unsigned short)araw[4]) + pb[0], bf2f((unsigned short)araw[5]) + pb[1]); aw.w = pk2(bf2f((unsigned short)araw[6]) + pb[2], bf2f((unsigned short)araw[7]) + pb[3]);
        const bf16x8 a = __builtin_bit_cast(bf16x8, aw);
#pragma unroll
        for (int n = 0; n < 8; ++n) { const bf16x8 bb = *(const bf16x8*)(w1t + (size_t)(16 * n) * 2048 + 32 * s);
            acc[n] = __builtin_amdgcn_mfma_f32_16x16x32_bf16(a, bb, acc[n], 0, 0, 0); }
    }
    LAS float* part = (LAS float*)L;
#pragma unroll
    for (int n = 0; n < 8; ++n)
#pragma unroll
        for (int j = 0; j < 4; ++j) part[(wid * 16 + 4 * fq + j) * 128 + 16 * n + fr] = acc[n][j];
    __syncthreads();
    LAS bf16_t* hb_ = (LAS bf16_t*)(L + 65536);
#pragma unroll
    for (int e = 0; e < 4; ++e) { const int idx = tid + 512 * e; float v = 0.f;
#pragma unroll
        for (int w = 0; w < 8; ++w) v += part[w * 2048 + idx];
        hb_[idx] = (bf16_t)f2bf(v / (1.f + __expf(-v))); }
    __syncthreads();
    if (wid == 0) {
        const bf16_t* w2t = (const bf16_t*)(ws + WS_W2T) + kv * 64 * 128 + fr * 128 + 8 * fq;
        f32x4 o[4];
#pragma unroll
        for (int n = 0; n < 4; ++n) o[n] = (f32x4){0.f, 0.f, 0.f, 0.f};
#pragma unroll
        for (int ks = 0; ks < 4; ++ks) { const bf16x8 a = *(const LAS bf16x8*)(hb_ + fr * 128 + 32 * ks + 8 * fq);
#pragma unroll
            for (int n = 0; n < 4; ++n) { const bf16x8 bb = *(const bf16x8*)(w2t + (size_t)(16 * n) * 128 + 32 * ks); o[n] = __builtin_amdgcn_mfma_f32_16x16x32_bf16(a, bb, o[n], 0, 0, 0); } }
        bf16_t* dstb = (bf16_t*)(ws + (kv ? WS_VCMP : WS_KCMP)) + (size_t)b * 128 * 2 * 64;
        const float* kg = inptr(10);
#pragma unroll
        for (int j = 0; j < 4; ++j) { const int row = 4 * fq + j, cc = 8 * tc + (row >> 1), gg = row & 1;
            float sc = 1.f;
            if (kv == 0) { float ss = o[0][j] * o[0][j] + o[1][j] * o[1][j] + o[2][j] * o[2][j] + o[3][j] * o[3][j];
                ss += __shfl_xor(ss, 1); ss += __shfl_xor(ss, 2); ss += __shfl_xor(ss, 4); ss += __shfl_xor(ss, 8); sc = 1.f / sqrtf(ss * (1.f / 64) + EPS); }
#pragma unroll
            for (int n = 0; n < 4; ++n) { const int col = 16 * n + fr; float v = o[n][j] * sc; if (kv == 0) v *= kg[col]; if (cc >= NCMP) v = 0.f;
                dstb[((size_t)cc * 2 + gg) * 64 + col] = (bf16_t)f2bf(v); } }
    }
    __syncthreads();
}

namespace att {
typedef float f32x16 __attribute__((ext_vector_type(16)));
typedef short s16x4 __attribute__((ext_vector_type(4)));
typedef short v4i16_t __attribute__((ext_vector_type(4)));
typedef float f32x2_t __attribute__((ext_vector_type(2)));
typedef __bf16 bf16x2_t __attribute__((ext_vector_type(2)));
typedef const LAS unsigned char* lcp;
constexpr int NSLOT = 3;
constexpr int L_TB = 0, L_K = 4096, KSLOT = 12288, L_V = L_K + NSLOT * KSLOT, VSLOT = 8192, L_WSF = L_V + NSLOT * VSLOT, L_OST = L_WSF + 4096,
              L_IMP = L_OST + 32768, IMPS = 33  , L_SELM = L_IMP + 4 * 64 * IMPS * 4, L_GATE = L_SELM + 256, L_SC = L_GATE + 3072, L_INVL = L_SC + 64 * IMPS * 4, L_END = L_INVL + 1024;
static_assert(L_V + NSLOT * VSLOT <= 65536, "LDS-DMA destinations stay below 64 KiB");
static_assert(L_END <= LDS_BST, "attention LDS map");
constexpr float THR = 8.0f;
__device__ __forceinline__ int crow(int r, int hi) { return (r & 3) + 8 * (r >> 2) + 4 * hi; }
__device__ __forceinline__ void glds16(const void* gsrc, unsigned lds_dst) { unsigned keep;
    asm volatile("s_mov_b32 %0, m0\n\ts_mov_b32 m0, %2\n\ts_nop 0\n\tglobal_load_lds_dwordx4 %1, off\n\ts_mov_b32 m0, %0" : "=&s"(keep) : "v"(gsrc), "s"(lds_dst) : "memory"); }
__device__ __forceinline__ unsigned cvtpk(float lo, float hi) { f32x2_t v = {lo, hi}; bf16x2_t b = __builtin_convertvector(v, bf16x2_t); return __builtin_bit_cast(unsigned, b); }
__device__ __forceinline__ s16x4 vtr(lcp p) { return __builtin_bit_cast(s16x4, __builtin_amdgcn_ds_read_tr16_b64_v4i16((LAS v4i16_t*)p)); }
__device__ __forceinline__ float lane_xor(float v, int lane, int x) { return __builtin_bit_cast(float, __builtin_amdgcn_ds_bpermute((lane ^ x) << 2, __builtin_bit_cast(int, v))); }
__device__ __forceinline__ unsigned lane_xor_u(unsigned v, int lane, int x) { return (unsigned)__builtin_amdgcn_ds_bpermute((lane ^ x) << 2, (int)v); }
__device__ __forceinline__ float swap_max(float m, int lane) { return __builtin_fmaxf(m, lane_xor(m, lane, 32)); }
__device__ __forceinline__ float swap_sum(float m, int lane) { return m + lane_xor(m, lane, 32); }
__device__ __forceinline__ float max3f(float a, float b, float c) { float r; asm("v_max3_f32 %0, %1, %2, %3" : "=v"(r) : "v"(a), "v"(b), "v"(c)); return r; }
__device__ __forceinline__ float max32(const f32x16& p0, const f32x16& p1) {
    float a = max3f(p0[0], p0[1], p1[0]), b = max3f(p0[2], p0[3], p1[1]); a = max3f(a, p1[2], p1[3]);
#pragma unroll
    for (int r = 4; r < 16; r += 4) { a = max3f(a, p0[r], p0[r + 1]); b = max3f(b, p0[r + 2], p0[r + 3]); a = max3f(a, p1[r], p1[r + 1]); b = max3f(b, p1[r + 2], p1[r + 3]); }
    return __builtin_fmaxf(a, b); }
__device__ __forceinline__ float max16(const f32x16& p) { float a = __builtin_fmaxf(p[0], p[1]), b = __builtin_fmaxf(p[2], p[3]);
#pragma unroll
    for (int r = 4; r < 16; r += 4) { a = __builtin_fmaxf(a, __builtin_fmaxf(p[r], p[r + 1])); b = __builtin_fmaxf(b, __builtin_fmaxf(p[r + 2], p[r + 3])); }
    return __builtin_fmaxf(a, b); }
__device__ __forceinline__ float sum16(const f32x16& p) { float a = p[0] + p[1], b = p[2] + p[3];
#pragma unroll
    for (int r = 4; r < 16; r += 4) { a += p[r] + p[r + 1]; b += p[r + 2] + p[r + 3]; }
    return a + b; }
#define ATT_BAR() asm volatile("s_waitcnt vmcnt(0) lgkmcnt(0)\n\ts_barrier" ::: "memory")

template <int DQ> __device__ __forceinline__ void qkt(f32x16& p0, f32x16& p1, lcp kslot, const bf16x8* qr, const f32x16& cinit, int r32, int hi) {
    lcp kb = kslot + hi * 1024 + r32 * 16;
    constexpr int NB = 2;
#pragma unroll
    for (int db = 0; db < DQ / 16; db += NB) {
        bf16x8 kf[2 * NB];
#pragma unroll
        for (int e = 0; e < NB; ++e) { kf[2 * e] = *(const LAS bf16x8*)(kb + (db + e) * 2048); kf[2 * e + 1] = *(const LAS bf16x8*)(kb + (db + e) * 2048 + 512); }
        __builtin_amdgcn_sched_barrier(0);
#pragma unroll
        for (int e = 0; e < NB; ++e) { const int d0 = db + e;
            if (d0 == 0) { p0 = __builtin_amdgcn_mfma_f32_32x32x16_bf16(kf[0], qr[0], cinit, 0, 0, 0); p1 = __builtin_amdgcn_mfma_f32_32x32x16_bf16(kf[1], qr[0], cinit, 0, 0, 0); }
            else { p0 = __builtin_amdgcn_mfma_f32_32x32x16_bf16(kf[2 * e], qr[d0], p0, 0, 0, 0); p1 = __builtin_amdgcn_mfma_f32_32x32x16_bf16(kf[2 * e + 1], qr[d0], p1, 0, 0, 0); }
        }
    }
}
__device__ __forceinline__ void vload_half(bf16x8 (&vf)[8], lcp vp, int d0) {
#pragma unroll
    for (int ks = 0; ks < 4; ++ks) {
        const s16x4 lo = vtr(vp + d0 * 4096 + ks * 1024), hh = vtr(vp + d0 * 4096 + ks * 1024 + 512);
        vf[d0 * 4 + ks] = (bf16x8){lo[0], lo[1], lo[2], lo[3], hh[0], hh[1], hh[2], hh[3]};
    }
    __builtin_amdgcn_sched_barrier(0);
}
__device__ __forceinline__ void vload(bf16x8 (&vf)[8], lcp vp) { vload_half(vf, vp, 0); vload_half(vf, vp, 1); }
__device__ __forceinline__ void pv_mma(f32x16 (&o)[2], const bf16x8 (&vf)[8], const f32x16& p0, const f32x16& p1) {
    u32x4 pw[4];
    pw[0] = (u32x4){cvtpk(p0[0], p0[1]), cvtpk(p0[2], p0[3]), cvtpk(p0[4], p0[5]), cvtpk(p0[6], p0[7])};
    pw[1] = (u32x4){cvtpk(p0[8], p0[9]), cvtpk(p0[10], p0[11]), cvtpk(p0[12], p0[13]), cvtpk(p0[14], p0[15])};
    pw[2] = (u32x4){cvtpk(p1[0], p1[1]), cvtpk(p1[2], p1[3]), cvtpk(p1[4], p1[5]), cvtpk(p1[6], p1[7])};
    pw[3] = (u32x4){cvtpk(p1[8], p1[9]), cvtpk(p1[10], p1[11]), cvtpk(p1[12], p1[13]), cvtpk(p1[14], p1[15])};
#pragma unroll
    for (int d0 = 0; d0 < 2; ++d0)
#pragma unroll
        for (int ks = 0; ks < 4; ++ks) o[d0] = __builtin_amdgcn_mfma_f32_32x32x16_bf16(__builtin_bit_cast(bf16x8, pw[ks]), vf[d0 * 4 + ks], o[d0], 0, 0, 0);
}
__device__ __forceinline__ void pv(f32x16 (&o)[2], lcp vp, const f32x16& p0, const f32x16& p1) { bf16x8 vf[8]; vload(vf, vp); pv_mma(o, vf, p0, p1); }
template <int DQ, bool SLOT = false, bool SLOTV = SLOT> __device__ __forceinline__ void dma_tile(unsigned lds0, const bf16_t* Kg, int kpitch, const bf16_t* Vg, int vpitch, int key0, int slot, int wid, int lane) {
    const bf16_t* ksrc = Kg + (size_t)(key0 + lane) * kpitch + (SLOT ? 128 * (wid >> 2) + 8 * (wid & 3) : wid * 8);
    glds16(ksrc, (unsigned)__builtin_amdgcn_readfirstlane(lds0 + L_K + slot * KSLOT + wid * 1024));
    if (DQ == 96) { if (wid < 4) glds16(ksrc + 64, (unsigned)__builtin_amdgcn_readfirstlane(lds0 + L_K + slot * KSLOT + (8 + wid) * 1024)); }
    const bf16_t* vsrc = Vg + (size_t)(key0 + 16 * (wid & 3) + (lane >> 2)) * vpitch + (wid >> 2) * (SLOTV ? 128 : 32) + (lane & 3) * 8;
    glds16(vsrc, (unsigned)__builtin_amdgcn_readfirstlane(lds0 + L_V + slot * VSLOT + wid * 1024));
}

#define ATT_LBAR() asm volatile("s_waitcnt lgkmcnt(0)\n\ts_barrier" ::: "memory")
struct NoNext { static constexpr int count = 0; __device__ __forceinline__ void dma(unsigned, int, int, int, int) const {} };
template <int DQ, bool SLOT, bool SLOTV, class Pol> struct NextTiles {
    const bf16_t* Kg; int kpitch; const bf16_t* Vg; int vpitch; const Pol* pol; int count;
    __device__ __forceinline__ void dma(unsigned lds0, int j, int slot, int wid, int lane) const { dma_tile<DQ, SLOT, SLOTV>(lds0, Kg, kpitch, Vg, vpitch, pol->key0(j), slot, wid, lane); }
};
template <int DQ, bool SLOT = false, bool SLOTV = SLOT, class Pol, class Next>
__device__ __forceinline__ void flash_loop(LAS unsigned char* L, const bf16_t* Kg, int kpitch, const bf16_t* Vg, int vpitch, const bf16x8* qr, const Pol& pol, int s0, int npre, const Next& next,
                                           f32x16 (&o)[2], float& l_out, int wid, int lane) {
    const int r32 = lane & 31, hi = lane >> 5;
    const unsigned lds0 = (unsigned)(uintptr_t)L;
    LAS float* wsf = (LAS float*)(L + L_WSF) + wid * 128;
    lcp vp0 = L + L_V + ((lane >> 4) & 1) * 32 + (lane & 3) * 8 + (4 * hi + ((lane & 15) >> 2)) * 64;
    float mhat = 0.f, l = 0.f;
    f32x16 negm;
#pragma unroll
    for (int r = 0; r < 16; ++r) { o[0][r] = 0.f; o[1][r] = 0.f; negm[r] = 0.f; }
    const int n = pol.ntiles, ntot = n + next.count;
    int slot = s0, slot1 = (s0 + 1) % NSLOT, slot2 = (s0 + 2) % NSLOT;
    if (npre < 1) dma_tile<DQ, SLOT, SLOTV>(lds0, Kg, kpitch, Vg, vpitch, pol.key0(0), slot, wid, lane);
    if (npre < 2 && ntot > 1) { if (n > 1) dma_tile<DQ, SLOT, SLOTV>(lds0, Kg, kpitch, Vg, vpitch, pol.key0(1), slot1, wid, lane); else next.dma(lds0, 0, slot1, wid, lane); }
    for (int i = 0; i < n; ++i) {
        if (i + 1 < ntot) { if (DQ == 96 && wid < 4) asm volatile("s_waitcnt vmcnt(3) lgkmcnt(0)\n\ts_barrier" ::: "memory"); else asm volatile("s_waitcnt vmcnt(2) lgkmcnt(0)\n\ts_barrier" ::: "memory"); }
        else ATT_BAR();
        if (i + 2 < ntot) { if (i + 2 < n) dma_tile<DQ, SLOT, SLOTV>(lds0, Kg, kpitch, Vg, vpitch, pol.key0(i + 2), slot2, wid, lane); else next.dma(lds0, i + 2 - n, slot2, wid, lane); }
        if (pol.active(i)) {
            f32x16 p0, p1;
            qkt<DQ>(p0, p1, L + L_K + slot * KSLOT, qr, negm, r32, hi);
            bf16x8 vf[8]; vload_half(vf, vp0 + slot * VSLOT, 0);
            pol.fix(p0, p1, i);
            asm volatile("s_nop 15\n\ts_nop 7" : "+v"(p0), "+v"(p1));
            const float rm = swap_max(max32(p0, p1), lane);
            const bool first = (i == 0);
            if (first || __any(rm > THR)) {
                float dl = first ? rm : __builtin_fmaxf(rm, 0.f);
                if (dl == -INFINITY) dl = 0.f;
                mhat += dl;
#pragma unroll
                for (int r = 0; r < 16; ++r) { p0[r] -= dl; p1[r] -= dl; negm[r] = -mhat; }
                if (!first) {
                    const float f = __builtin_amdgcn_exp2f(-dl); l *= f;
                    if (hi == 0) wsf[r32] = f;
#pragma unroll
                    for (int r = 0; r < 16; ++r) { const float fr_ = wsf[crow(r, hi)]; o[0][r] *= fr_; o[1][r] *= fr_; }
                }
            }
#pragma unroll
            for (int r = 0; r < 16; ++r) { p0[r] = __builtin_amdgcn_exp2f(p0[r]); p1[r] = __builtin_amdgcn_exp2f(p1[r]); }
            vload_half(vf, vp0 + slot * VSLOT, 1);
            l += sum16(p0) + sum16(p1);
            pv_mma(o, vf, p0, p1);
        }
        slot = slot1; slot1 = slot2; slot2 = (slot2 == NSLOT - 1) ? 0 : slot2 + 1;
    }
    ATT_LBAR();
    l_out = swap_sum(l, lane);
}

__device__ __forceinline__ void acc_scaled(f32x16 (&oc)[2], const f32x16 (&o)[2], float rowscale, LAS float* wsf, int r32, int hi) {
    if (hi == 0) wsf[32 + r32] = rowscale;
#pragma unroll
    for (int r = 0; r < 16; ++r) { const float s = wsf[32 + crow(r, hi)]; oc[0][r] += s * o[0][r]; oc[1][r] += s * o[1][r]; }
}
__device__ __forceinline__ void park_store(const f32x16 (&oc)[2], LAS float* park, int lane) {
#pragma unroll
    for (int d0 = 0; d0 < 2; ++d0)
#pragma unroll
        for (int r = 0; r < 16; ++r) park[(d0 * 16 + r) * 64 + lane] = oc[d0][r];
}
template <bool FINAL> __device__ __forceinline__ void park_acc(f32x16 (&oc)[2], LAS float* park, const f32x16 (&o)[2], float rowscale, LAS float* wsf, int lane) {
    const int r32 = lane & 31, hi = lane >> 5;
    if (hi == 0) wsf[32 + r32] = rowscale;
#pragma unroll
    for (int r = 0; r < 16; ++r) { const float s = wsf[32 + crow(r, hi)];
#pragma unroll
        for (int d0 = 0; d0 < 2; ++d0) { const float v = park[(d0 * 16 + r) * 64 + lane] + s * o[d0][r]; if (FINAL) oc[d0][r] = v; else park[(d0 * 16 + r) * 64 + lane] = v; } }
}
__device__ __forceinline__ void store_tile(const f32x16 (&oc)[2], bf16_t* dst, int pitch, LAS unsigned char* L, int wid, int lane, float* ssq) {
    const int r32 = lane & 31, hi = lane >> 5;
    LAS bf16_t* stg = (LAS bf16_t*)(L + L_OST + wid * 8192);
#pragma unroll
    for (int r = 0; r < 16; ++r) { const int orow = crow(r, hi);
#pragma unroll
        for (int d0 = 0; d0 < 2; ++d0) stg[orow * 64 + d0 * 32 + r32] = (bf16_t)f2bf(oc[d0][r]); }
    asm volatile("s_waitcnt lgkmcnt(0)" ::: "memory");
#pragma unroll
    for (int i = 0; i < 4; ++i) { const int row = i * 8 + (lane >> 3), ch = lane & 7; const u32x4 v = *(const LAS u32x4*)(stg + row * 64 + ch * 8); *(u32x4*)(dst + (size_t)row * pitch + ch * 8) = v;
        float ss = sq8(__builtin_bit_cast(bf16x8, v)); ss += lane_xor(ss, lane, 1); ss += lane_xor(ss, lane, 2); ss += lane_xor(ss, lane, 4);
        if (ch == 0) __hip_atomic_fetch_add(ssq + 2 * row, ss, __ATOMIC_RELAXED, __HIP_MEMORY_SCOPE_AGENT); }
    asm volatile("s_waitcnt lgkmcnt(0)" ::: "memory");
}

#define PIN16(v) asm volatile("" : "+v"(v[0]), "+v"(v[1]), "+v"(v[2]), "+v"(v[3]), "+v"(v[4]), "+v"(v[5]), "+v"(v[6]), "+v"(v[7]), "+v"(v[8]), "+v"(v[9]), "+v"(v[10]), "+v"(v[11]), "+v"(v[12]), "+v"(v[13]), "+v"(v[14]), "+v"(v[15]))
__device__ __forceinline__ int clamp127(int d) { return d < 0 ? 0 : (d < 127 ? d : 127); }
struct PolMla { int ntiles, qw0, r32, hi;
    __device__ __forceinline__ int key0(int i) const { return 64 * i; }
    __device__ __forceinline__ bool active(int i) const { return 64 * i <= qw0 + 31; }
    __device__ __forceinline__ int nact() const { const int a = (qw0 + 31) / 64 + 1; return a < ntiles ? a : ntiles; }
    __device__ __forceinline__ void fix(f32x16& p0, f32x16& p1, int i) const {
        if (64 * i + 63 > qw0) { const int q = qw0 + r32, kb = 64 * i + 4 * hi;
#pragma unroll
            for (int r = 0; r < 16; ++r) { const int kv = kb + (r & 3) + 8 * (r >> 2); if (kv > q) p0[r] = -INFINITY; if (kv + 32 > q) p1[r] = -INFINITY; } }
    }
};
struct PolSel { int ntiles, qc, q, hi; unsigned selm; const LAS float* tbh;
    __device__ __forceinline__ int key0(int i) const { return 64 * (qc - i); }
    __device__ __forceinline__ bool active(int i) const { return __any((selm >> (qc - i)) & 1u) != 0; }
    __device__ __forceinline__ int nact() const { return ntiles; }
    __device__ __forceinline__ void fix(f32x16& p0, f32x16& p1, int i) const {
        const bool bit = ((selm >> (qc - i)) & 1u) != 0u;
        if (i <= 2) { const int kb = 64 * (qc - i) + 4 * hi; float bv0[16], bv1[16];
#pragma unroll
            for (int r = 0; r < 16; ++r) { const int d0 = q - (kb + (r & 3) + 8 * (r >> 2)); bv0[r] = tbh[clamp127(d0)]; bv1[r] = tbh[clamp127(d0 - 32)]; }
            PIN16(bv0); PIN16(bv1);
#pragma unroll
            for (int r = 0; r < 16; ++r) { const int d0 = q - (kb + (r & 3) + 8 * (r >> 2)), d1 = d0 - 32;
                p0[r] = (d0 < 0) ? -INFINITY : p0[r] + bv0[r]; p1[r] = (d1 < 0) ? -INFINITY : p1[r] + bv1[r]; } }
        if (!bit) {
#pragma unroll
            for (int r = 0; r < 16; ++r) { p0[r] = -INFINITY; p1[r] = -INFINITY; } }
    }
};
struct PolWin { int ntiles, qc, q, hi; const LAS float* tbh;
    __device__ __forceinline__ int key0(int i) const { return 64 * (qc - i); }
    __device__ __forceinline__ bool active(int) const { return true; }
    __device__ __forceinline__ int nact() const { return ntiles; }
    __device__ __forceinline__ void fix(f32x16& p0, f32x16& p1, int i) const {
        if (i <= 2) { const int kb = 64 * (qc - i) + 4 * hi; float bv0[16], bv1[16];
#pragma unroll
            for (int r = 0; r < 16; ++r) { const int d0 = q - (kb + (r & 3) + 8 * (r >> 2)); bv0[r] = tbh[clamp127(d0)]; bv1[r] = tbh[clamp127(d0 - 32)]; }
            PIN16(bv0); PIN16(bv1);
#pragma unroll
            for (int r = 0; r < 16; ++r) { const int d0 = q - (kb + (r & 3) + 8 * (r >> 2)), d1 = d0 - 32;
                p0[r] = (d0 < 0) ? -INFINITY : p0[r] + bv0[r]; p1[r] = (d1 < 0) ? -INFINITY : p1[r] + bv1[r]; } }
        else if (i == 8) { const int kb = 64 * (qc - i) + 4 * hi;
#pragma unroll
            for (int r = 0; r < 16; ++r) { const int d0 = q - (kb + (r & 3) + 8 * (r >> 2)), d1 = d0 - 32; if (d0 >= 512) p0[r] = -INFINITY; if (d1 >= 512) p1[r] = -INFINITY; } }
    }
};

__device__ __forceinline__ void mla_unit(unsigned char* ws, LAS unsigned char* L, int b, int h, int qb, int wv, int s0, int npre, int nnext) {
    const int tid = opaque_tid(wv), lane = tid & 63, wid = __builtin_amdgcn_readfirstlane(tid >> 6);
    const int r32 = lane & 31, hi = lane >> 5;
    const size_t rowbase = (size_t)b * SEQ; const int qw0 = 256 * qb + 32 * wid;
    bf16x8 qr[6];
    { const bf16_t* Qw = (const bf16_t*)(ws + WS_QM) + (rowbase + qw0 + r32) * MQ + 96 * h + 8 * hi;
      bf16x8 raw[6]; float ss = 0.f;
#pragma unroll
      for (int d0 = 0; d0 < 6; ++d0) { raw[d0] = *(const bf16x8*)(Qw + 16 * d0); ss += sq8(raw[d0]); }
      ss += lane_xor(ss, lane, 32);
      const float rstd = QS_MLA / sqrtf(ss * (1.f / 96) + EPS);
      const float* qg = inptr(7) + 8 * hi;
#pragma unroll
      for (int d0 = 0; d0 < 4; ++d0) qr[d0] = __builtin_bit_cast(bf16x8, scale8(raw[d0], rstd, *(const f32x4*)(qg + 16 * d0), *(const f32x4*)(qg + 16 * d0 + 4)));
      float o1[8], o2[8]; const float posf = (float)(qw0 + r32);
#pragma unroll
      for (int j = 0; j < 8; ++j) { const int i = 8 * hi + j; const float inv = exp2f(-(float)i * (13.287712379549449f / 16.f)); float sn, cs; sincosf(posf * inv, &sn, &cs);
          const float n1 = bf2f((unsigned short)raw[4][j]) * rstd * qg[64 + j], n2 = bf2f((unsigned short)raw[5][j]) * rstd * qg[80 + j];
          o1[j] = n1 * cs - n2 * sn; o2[j] = n2 * cs + n1 * sn; }
      u32x4 w4, w5; w4.x = pk2(o1[0], o1[1]); w4.y = pk2(o1[2], o1[3]); w4.z = pk2(o1[4], o1[5]); w4.w = pk2(o1[6], o1[7]);
      w5.x = pk2(o2[0], o2[1]); w5.y = pk2(o2[2], o2[3]); w5.z = pk2(o2[4], o2[5]); w5.w = pk2(o2[6], o2[7]);
      qr[4] = __builtin_bit_cast(bf16x8, w4); qr[5] = __builtin_bit_cast(bf16x8, w5); }
    const bf16_t* Kg = (const bf16_t*)(ws + WS_KMLA) + rowbase * MQ + 96 * h;
    const bf16_t* Vg = (const bf16_t*)(ws + WS_KVM) + rowbase * MKV + slot_base(4 * (h >> 1) + 2 + (h & 1));
    PolMla pol{4 * qb + 4, qw0, r32, hi};
    f32x16 o[2]; float l;
    const NextTiles<96, false, true, PolMla> nxt{Kg, MQ, Vg, MKV, &pol, nnext};
    flash_loop<96, false, true>(L, Kg, MQ, Vg, MKV, qr, pol, s0, npre, nxt, o, l, wid, lane);
    LAS float* wsf = (LAS float*)(L + L_WSF) + wid * 128;
    f32x16 oc[2];
#pragma unroll
    for (int r = 0; r < 16; ++r) { oc[0][r] = 0.f; oc[1][r] = 0.f; }
    acc_scaled(oc, o, (l > 0.f) ? 1.f / l : 0.f, wsf, r32, hi);
    store_tile(oc, (bf16_t*)(ws + WS_MIX) + (rowbase + qw0) * DM + 64 * h, DM, L, wid, lane, (float*)(ws + WS_SSQM) + 2 * (rowbase + qw0));
}

__device__ __forceinline__ void nsa_unit(unsigned char* ws, LAS unsigned char* L, int b, int g, int qc, int wv) {
#define NSA_IDS() const int tid = opaque_tid(wv), lane = tid & 63, wid = __builtin_amdgcn_readfirstlane(tid >> 6); \
    const int r32 = lane & 31, hi = lane >> 5, rh = wid & 3, qh = wid >> 2, h = 4 * g + rh, qloc = 32 * qh + r32, q = q0 + qloc; \
    const unsigned lds0 = (unsigned)(uintptr_t)L; LAS float* wsf = (LAS float*)(L + L_WSF) + wid * 128; const LAS float* tbh = (const LAS float*)(L + L_TB) + h * 128; \
    LAS float* gate = (LAS float*)(L + L_GATE); (void)tid; (void)lane; (void)r32; (void)hi; (void)rh; (void)qh; (void)h; (void)qloc; (void)q; (void)lds0; (void)wsf; (void)tbh; (void)gate
    const size_t rowbase = (size_t)b * SEQ; const int q0 = 64 * qc;
    const bf16_t* pr = (const bf16_t*)(ws + WS_PROJ);
    bf16x8 qr[4];
    {
    NSA_IDS();
    { const bf16_t* Kc = (const bf16_t*)(ws + WS_KCMP) + ((size_t)b * 256 + g) * 64; const bf16_t* Vc = (const bf16_t*)(ws + WS_VCMP) + ((size_t)b * 256 + g) * 64;
      dma_tile<64>(lds0, Kc, 128, Vc, 128, 0, 0, wid, lane);
      dma_tile<64>(lds0, Kc, 128, Vc, 128, 64, 1, wid, lane);
      dma_tile<64, true>(lds0, pr + rowbase * DINP + slot_base(S_KSEL + g), DINP, pr + rowbase * DINP + slot_base(S_VSEL + g), DINP, 64 * qc, 2, wid, lane); }
    for (int i = tid; i < 768; i += 512) { const int br = i >> 8, r = (i >> 6) & 3, qq = i & 63;
        const float x = bf2f(pr[(rowbase + q0 + qq) * DINP + P_GATE + 8 * br + 4 * g + r]); gate[i] = 1.f / (1.f + __expf(-x)); }
    { const bf16_t* Qw = pr + (rowbase + q) * DINP + slot_base(S_Q + h) + 8 * hi;
#pragma unroll
      for (int d0 = 0; d0 < 4; ++d0) qr[d0] = *(const bf16x8*)(Qw + 128 * (d0 >> 1) + 16 * (d0 & 1)); }
    }
    f32x16 oc[2];
    {
        NSA_IDS();
        ATT_BAR();
        lcp vp0 = L + L_V + ((lane >> 4) & 1) * 32 + (lane & 3) * 8 + (4 * hi + ((lane & 15) >> 2)) * 64;
        LAS float* imp = (LAS float*)(L + L_IMP) + (rh * 64 + qloc) * IMPS;
        f32x16 a0, a1, b0, b1;
        { f32x16 zero;
#pragma unroll
          for (int r = 0; r < 16; ++r) zero[r] = 0.f;
          qkt<64>(a0, a1, L + L_K, qr, zero, r32, hi); qkt<64>(b0, b1, L + L_K + KSLOT, qr, zero, r32, hi); }
#define CMP_FIX(P, coff, extra) do { float bv[16]; \
            _Pragma("unroll") for (int r = 0; r < 16; ++r) bv[r] = tbh[clamp127(q - 16 * (crow(r, hi) + (coff)) - 31)]; \
            PIN16(bv); \
            _Pragma("unroll") for (int r = 0; r < 16; ++r) { const int c = crow(r, hi) + (coff); const int d = q - 16 * c - 31; P[r] = (d < 0 || (extra && c >= NCMP)) ? -INFINITY : P[r] + bv[r]; } } while (0)
        CMP_FIX(a0, 0, false); CMP_FIX(a1, 32, false); CMP_FIX(b0, 64, false); CMP_FIX(b1, 96, true);
#undef CMP_FIX
        float m = swap_max(__builtin_fmaxf(__builtin_fmaxf(max16(a0), max16(a1)), __builtin_fmaxf(max16(b0), max16(b1))), lane);
        if (m == -INFINITY) m = 0.f;
#pragma unroll
        for (int r = 0; r < 16; ++r) { a0[r] = __builtin_amdgcn_exp2f(a0[r] - m); a1[r] = __builtin_amdgcn_exp2f(a1[r] - m); b0[r] = __builtin_amdgcn_exp2f(b0[r] - m); b1[r] = __builtin_amdgcn_exp2f(b1[r] - m); }
        const float lsum = swap_sum((sum16(a0) + sum16(a1)) + (sum16(b0) + sum16(b1)), lane);
        const float inv = (lsum > 0.f) ? 1.f / lsum : 0.f;
        float prev_last = 0.f;
#define CMP_IMP(T, P0, P1) do { float own[8], car[8]; \
            _Pragma("unroll") for (int a = 0; a < 4; ++a) { \
                own[a]     = P0[4 * a] + P0[4 * a + 1] + P0[4 * a + 2] + 0.5f * P0[4 * a + 3]; car[a]     = 0.5f * P0[4 * a + 3]; \
                own[4 + a] = P1[4 * a] + P1[4 * a + 1] + P1[4 * a + 2] + 0.5f * P1[4 * a + 3]; car[4 + a] = 0.5f * P1[4 * a + 3]; } \
            _Pragma("unroll") for (int k = 0; k < 8; ++k) car[k] = lane_xor(car[k], lane, 32); \
            _Pragma("unroll") for (int k = 0; k < 8; ++k) { const float add = hi ? car[k] : (k >= 1 ? car[k - 1] : prev_last); imp[16 * (T) + 2 * k + hi] = own[k] + add; } \
            prev_last = car[7]; } while (0)
        CMP_IMP(0, a0, a1); CMP_IMP(1, b0, b1);
#undef CMP_IMP
        if (hi == 0) ((LAS float*)(L + L_INVL))[rh * 64 + qloc] = inv;
        f32x16 o[2];
#pragma unroll
        for (int r = 0; r < 16; ++r) { o[0][r] = 0.f; o[1][r] = 0.f; }
        pv(o, vp0, a0, a1); pv(o, vp0 + VSLOT, b0, b1);
        ATT_BAR();
        if (qc >= 1) dma_tile<64, true>(lds0, pr + rowbase * DINP + slot_base(S_KSEL + g), DINP, pr + rowbase * DINP + slot_base(S_VSEL + g), DINP, 64 * (qc - 1), 0, wid, lane);
#pragma unroll
        for (int r = 0; r < 16; ++r) { oc[0][r] = 0.f; oc[1][r] = 0.f; }
        acc_scaled(oc, o, gate[(0 * 4 + rh) * 64 + qloc] * inv, wsf, r32, hi);
    }
    if (qc <= 15) {
        const int tid = opaque_tid(wv);
        if (tid < 64) ((LAS unsigned*)(L + L_SELM))[tid] = (qc == 31) ? 0xffffffffu : ((2u << qc) - 1u);
        ATT_LBAR();
    } else {
        const int tid = opaque_tid(wv);
        const LAS float* imp = (const LAS float*)(L + L_IMP); LAS float* sc = (LAS float*)(L + L_SC);
        const int qq = tid >> 3, jj = tid & 7;
        const LAS float* il = (const LAS float*)(L + L_INVL);
        const float i0 = il[qq], i1 = il[64 + qq], i2 = il[128 + qq], i3 = il[192 + qq];
#pragma unroll
        for (int k = 0; k < 4; ++k) { const int j = jj + 8 * k;
            const float tot = (imp[(0 * 64 + qq) * IMPS + j] * i0 + imp[(1 * 64 + qq) * IMPS + j] * i1) + (imp[(2 * 64 + qq) * IMPS + j] * i2 + imp[(3 * 64 + qq) * IMPS + j] * i3);
            float s; if (j > qc) s = -INFINITY; else if (j == 0 || j == qc || j == qc - 1) s = 1e4f; else s = tot; sc[qq * IMPS + j] = s; }
        ATT_LBAR();
        float v[32];
#pragma unroll
        for (int k = 0; k < 32; ++k) v[k] = sc[qq * IMPS + k];
        unsigned bits = 0u;
#pragma unroll
        for (int k = 0; k < 4; ++k) { const int j = jj + 8 * k; const float me = sc[qq * IMPS + j]; int rank = 0;
#pragma unroll
            for (int i = 0; i < 32; ++i) { const float si = v[i]; rank += (si > me || (si == me && i < j)) ? 1 : 0; }
            if (rank < 16) bits |= 1u << j; }
        { const int lane = tid & 63; bits |= lane_xor_u(bits, lane, 1); bits |= lane_xor_u(bits, lane, 2); bits |= lane_xor_u(bits, lane, 4); }
        if (jj == 0) ((LAS unsigned*)(L + L_SELM))[qq] = bits;
        ATT_LBAR();
    }
    { NSA_IDS(); park_store(oc, (LAS float*)(L + L_OST) + wid * 2048, lane); }
    {
        NSA_IDS();
        const unsigned selm = ((const LAS unsigned*)(L + L_SELM))[qloc];
        const bf16_t* Kg = pr + rowbase * DINP + slot_base(S_KSEL + g);
        const bf16_t* Vg = pr + rowbase * DINP + slot_base(S_VSEL + g);
        PolSel pol{qc + 1, qc, q, hi, selm, tbh};
        const PolWin polw{(qc < 8 ? qc : 8) + 1, qc, q, hi, tbh};
        const NextTiles<64, true, true, PolWin> nxt{pr + rowbase * DINP + slot_base(S_KWIN + g), DINP, pr + rowbase * DINP + slot_base(S_VWIN + g), DINP, &polw, polw.ntiles < 2 ? polw.ntiles : 2};
        f32x16 o[2]; float l;
        flash_loop<64, true>(L, Kg, DINP, Vg, DINP, qr, pol, 2, (qc + 1 < 2) ? qc + 1 : 2, nxt, o, l, wid, lane);
        { f32x16 dummy[2]; park_acc<false>(dummy, (LAS float*)(L + L_OST) + wid * 2048, o, (l > 0.f) ? gate[(1 * 4 + rh) * 64 + qloc] / l : 0.f, wsf, lane); }
    }
    {
        NSA_IDS();
        const bf16_t* Kg = pr + rowbase * DINP + slot_base(S_KWIN + g);
        const bf16_t* Vg = pr + rowbase * DINP + slot_base(S_VWIN + g);
        PolWin pol{(qc < 8 ? qc : 8) + 1, qc, q, hi, tbh};
        f32x16 o[2]; float l;
        flash_loop<64, true>(L, Kg, DINP, Vg, DINP, qr, pol, (2 + qc + 1) % NSLOT, pol.ntiles < 2 ? pol.ntiles : 2, NoNext{}, o, l, wid, lane);
        f32x16 fin[2]; park_acc<true>(fin, (LAS float*)(L + L_OST) + wid * 2048, o, (l > 0.f) ? gate[(2 * 4 + rh) * 64 + qloc] / l : 0.f, wsf, lane);
        store_tile(fin, (bf16_t*)(ws + WS_MIX) + (rowbase + q0 + 32 * qh) * DM + 512 + 64 * h, DM, L, wid, lane, (float*)(ws + WS_SSQM) + 2 * (rowbase + q0 + 32 * qh) + 1);
    }
    ATT_BAR();
}
#undef ATT_BAR
#undef ATT_LBAR
#undef NSA_IDS
}

#define XB_TMO      128
#define XB_XCNT(j)  (256  + 64 * (j))
#define XB_XSUB(j)  (1280 + 64 * (j))
#define XB_XGEN(j)  (2304 + 64 * (j))
#define XB_TOP      3328
#define XB_TOPGEN   3392
#define XCD_BAR_WORDS 3456
#define XB_SPIN_CAP (1u << 18)

__device__ __forceinline__ unsigned xb_ld(unsigned* p)              { return __hip_atomic_load(p, __ATOMIC_RELAXED, __HIP_MEMORY_SCOPE_AGENT); }
__device__ __forceinline__ unsigned xb_add(unsigned* p, unsigned v) { return __hip_atomic_fetch_add(p, v, __ATOMIC_RELAXED, __HIP_MEMORY_SCOPE_AGENT); }
__device__ __forceinline__ unsigned xb_xcc_id() { return (unsigned)__builtin_amdgcn_s_getreg((3 << 11) | 20) & 0xFu; }
#define XB_SPIN(cond, bar) do { unsigned _sp = 0; while (cond) { __builtin_amdgcn_s_sleep(1); \
    if ((++_sp & 255u) == 0u) { if (xb_ld(&(bar)[XB_TMO])) break; if (_sp > XB_SPIN_CAP) { atomicAdd(&(bar)[XB_TMO], 1u); break; } } } } while (0)

struct XcdBarrier {
    unsigned* bar; unsigned x;
    volatile LAS unsigned* st;
};

__device__ __forceinline__ XcdBarrier xcd_barrier_post(unsigned* bar, volatile LAS unsigned* st) {
    XcdBarrier b; b.bar = bar; b.x = xb_xcc_id(); b.st = st;
    if (threadIdx.x == 0) (void)xb_add(&bar[XB_XCNT(b.x)], 1u);
    return b;
}
__device__ __forceinline__ void xcd_barrier_complete(unsigned* bar, unsigned x, unsigned& nloc, unsigned& nx) {
    const unsigned G = gridDim.x * gridDim.y * gridDim.z;
    unsigned sum, cnt, mine, sp = 0u;
    for (;;) {
        sum = 0u; cnt = 0u; mine = 0u;
#pragma unroll
        for (unsigned j = 0; j < 16; ++j) { const unsigned c = xb_ld(&bar[XB_XCNT(j)]); sum += c; cnt += (c > 0u) ? 1u : 0u; mine = (j == x) ? c : mine; }
        if (sum == G) break;
        __builtin_amdgcn_s_sleep(1);
        if ((++sp & 255u) == 0u) { if (xb_ld(&bar[XB_TMO])) break; if (sp > XB_SPIN_CAP) { atomicAdd(&bar[XB_TMO], 1u); break; } }
    }
    nloc = mine > 0u ? mine : 1u; nx = cnt > 0u ? cnt : 1u;
}

__device__ __forceinline__ void xcd_barrier(const XcdBarrier& b) {
    asm volatile("s_waitcnt vmcnt(0)" ::: "memory");
    __syncthreads();
    if (threadIdx.x == 0) {
        unsigned* bar = b.bar;
        __builtin_amdgcn_s_waitcnt(0);
        unsigned nloc = b.st[0], nx = b.st[1];
        if (nloc == 0u) { xcd_barrier_complete(bar, b.x, nloc, nx); b.st[0] = nloc; b.st[1] = nx; }
        const unsigned old = xb_add(&bar[XB_XSUB(b.x)], 1u);
        const unsigned gen = old / nloc;
        if (old + 1u == (gen + 1u) * nloc) {
            __builtin_amdgcn_fence(__ATOMIC_RELEASE, "agent");
            asm volatile("s_waitcnt vmcnt(0)" ::: "memory");
            const unsigned og = xb_add(&bar[XB_TOP], 1u);
            const unsigned tg = og / nx;
            if (og + 1u == (tg + 1u) * nx) xb_add(&bar[XB_TOPGEN], 1u);
            else XB_SPIN(xb_ld(&bar[XB_TOPGEN]) == tg, bar);
            __builtin_amdgcn_fence(__ATOMIC_ACQUIRE, "agent");
            xb_add(&bar[XB_XGEN(b.x)], 1u);
            asm volatile("s_waitcnt vmcnt(0)" ::: "memory");
        } else {
            XB_SPIN(xb_ld(&bar[XB_XGEN(b.x)]) == gen, bar);
            __builtin_amdgcn_fence(__ATOMIC_ACQUIRE, "agent");
            asm volatile("s_waitcnt vmcnt(0)" ::: "memory");
        }
    }
    __syncthreads();
}

__global__ void __launch_bounds__(512, 2) mega(Params p) {
    extern __shared__ __attribute__((aligned(16))) unsigned char lds[];
    const int G = gridDim.x, bid = blockIdx.x, NGW = G * NW;
    int wv = __builtin_amdgcn_readfirstlane((int)(threadIdx.x >> 6)); asm volatile("" : "+s"(wv));
#define PHASE_IDS() const int tid = opaque_tid(wv), lane = tid & 63, wave = __builtin_amdgcn_readfirstlane(tid >> 6), gw = bid * NW + wave; (void)tid; (void)lane; (void)gw
    unsigned char* ws = (unsigned char*)inptr(22);
    LAS unsigned char* L = (LAS unsigned char*)lds;
    volatile LAS unsigned* bst = (volatile LAS unsigned*)(L + LDS_BST);
    if (threadIdx.x < 4) bst[threadIdx.x] = 0u;
    __syncthreads();
    const XcdBarrier bar = xcd_barrier_post((unsigned*)(ws + WS_CTL), bst);

    {
        PHASE_IDS();
        LAS float* scr = (LAS float*)(L + wave * 8704);
        constexpr int I0 = (1024 / 64) * (DINP / 32), I1 = (QR / 64) * (MQ / 32), I2 = (KVR / 64) * (MKV / 32), I3 = 16 * 32, I4 = 16 * (FF / 32), I5 = (FF / 64) * 32;
        constexpr int I6 = (2048 / 64) * (128 / 32), I7 = (128 / 64) * (64 / 32);
        constexpr int NIT = I0 + I1 + I2 + I3 + I4 + I5 + 2 * I6 + 2 * I7;
        for (int it = gw; it < NIT; it += NGW) {
            int r = it;
            if (r < I0) { p0_transpose_item(inptr(2), 1024, DIN, DINP, (bf16_t*)(ws + WS_WIN), scr, r, lane, inptr(1), 0, 1); continue; } r -= I0;
            if (r < I1) { p0_transpose_item(inptr(5), QR, MQ, MQ, (bf16_t*)(ws + WS_WUQ), scr, r, lane, inptr(3)); continue; } r -= I1;
            if (r < I2) { p0_transpose_item(inptr(6), KVR, MKV, MKV, (bf16_t*)(ws + WS_WUKV), scr, r, lane, inptr(4), 0, 2); continue; } r -= I2;
            if (r < I3) { const int k0_ = 64 * (r / 32); p0_transpose_item(inptr(17), 1024, 1024, 1024, (bf16_t*)(ws + WS_WO), scr, r, lane, k0_ < 512 ? inptr(15) : inptr(16) - 512); continue; } r -= I3;
            if (r < I4) { p0_transpose_item(inptr(19), 1024, FF, FF, (bf16_t*)(ws + WS_WUP), scr, r, lane, inptr(18)); continue; } r -= I4;
            if (r < I5) { p0_transpose_item(inptr(20), FF, 1024, 1024, (bf16_t*)(ws + WS_WDN), scr, r, lane, nullptr, LDH); continue; } r -= I5;
            if (r < 2 * I6) { const int kv = r / I6; p0_transpose_item(inptr(12) + (size_t)kv * 2048 * 128, 2048, 128, 128, (bf16_t*)(ws + WS_W1T) + (size_t)kv * 128 * 2048, scr, r % I6, lane); continue; } r -= 2 * I6;
            { const int kv = r / I7; p0_transpose_item(inptr(13) + kv * 128 * 64, 128, 64, 64, (bf16_t*)(ws + WS_W2T) + kv * 64 * 128, scr, r % I7, lane); }
        }
        for (int m = gw; m < M; m += 4 * NGW) rows_to_bf16_rstd<4>(inptr(0), (bf16_t*)(ws + WS_XB), (float*)(ws + WS_RS1), m, NGW, lane);
        for (int e = bid * 512 + tid; e < 2048 * 16; e += G * 512) { const int pos = e >> 4, i = e & 15; const float inv = exp2f(-(float)i * (13.287712379549449f / 16.f)); float sn, cs; sincosf((float)pos * inv, &sn, &cs);
            ((float*)(ws + WS_ROPE))[pos * 32 + i] = cs; ((float*)(ws + WS_ROPE))[pos * 32 + 16 + i] = sn; }
        for (int m = bid * 512 + tid; m < M; m += G * 512) { ((float*)(ws + WS_SSQ2))[m] = 0.f; ((float*)(ws + WS_RSQ))[m] = 0.f; ((float*)(ws + WS_RSKV))[m] = 0.f; ((float*)(ws + WS_SSQKR))[m] = 0.f; ((float*)(ws + WS_SSQM))[2 * m] = 0.f; ((float*)(ws + WS_SSQM))[2 * m + 1] = 0.f; }
    }
    xcd_barrier(bar);
    { pg8::Gemm g{(const bf16_t*)(ws + WS_XB), (const bf16_t*)(ws + WS_WIN), M, DINP, DM, DM, DM}; pg8::StaticOrder S; S.init(M, DINP, G, bid);
      PEpiProj E{(bf16_t*)(ws + WS_PROJ), DINP, (const float*)(ws + WS_RS1), (float*)(ws + WS_RSQ), (float*)(ws + WS_RSKV), (float*)(ws + WS_SSQKR), inptr(9), inptr(10), (const float*)(ws + WS_ROPE), inptr(8)}; pg8::gemm_phase<PEpiProj, pg8::StaticOrder, true, true>(L, g, S, E, wv); }
    xcd_barrier(bar);
    { PHASE_IDS();
      __syncthreads();
      for (int t = bid; t < 256; t += G) compress_block(ws, L, t, wv); }
    { pg8::Gemm g{(const bf16_t*)(ws + WS_PROJ) + P_HKV, (const bf16_t*)(ws + WS_WUKV), M, MKV, KVR, DINP, KVR}; pg8::StaticOrder S; S.init(M, MKV, G, bid);
      PEpiKV E{(bf16_t*)(ws + WS_KVM), (bf16_t*)(ws + WS_KMLA), (const bf16_t*)(ws + WS_PROJ), (const float*)(ws + WS_RSKV), (const float*)(ws + WS_SSQKR), (const float*)(ws + WS_ROPE), inptr(8)}; pg8::gemm_phase<PEpiKV, pg8::StaticOrder, true, true>(L, g, S, E, wv); }
    asm volatile("" : "+s"(wv));
    { pg8::Gemm g{(const bf16_t*)(ws + WS_PROJ) + P_HQ, (const bf16_t*)(ws + WS_WUQ), M, MQ, QR, DINP, QR}; pg8::StaticOrder S; S.init(M, MQ, G, bid);
      PEpiBf16<0> E{(bf16_t*)(ws + WS_QM), MQ, (const float*)(ws + WS_RSQ), 1.f / QR}; pg8::gemm_phase<PEpiBf16<0>, pg8::StaticOrder, true, false>(L, g, S, E, wv); }
    xcd_barrier(bar);
    {
        PHASE_IDS();
        LAS float* tb = (LAS float*)L;
        for (int i = tid; i < 8 * 128; i += 512) { const int h = i >> 7, n = i & 127; tb[i] = (inptr(14)[t5_bucket(n) * 8 + h] - inptr(14)[31 * 8 + h]) * LOG2E; }
        __syncthreads();
        const int vcu = (G % 8 == 0) ? (bid % 8) * (G / 8) + bid / 8 : bid;
        for (int pr_ = vcu; pr_ < 256; pr_ += G) {
            { const int bg = pr_ >> 4, s_ = pr_ & 15;
#pragma unroll 1
              for (int u_ = 0; u_ < 2; ++u_) att::nsa_unit(ws, L, bg >> 1, bg & 1, (u_ & 1) ? s_ : 31 - s_, wv);
            }
            { const int bh = pr_ >> 2, s_ = pr_ & 3;
#pragma unroll 1
              for (int u_ = 0; u_ < 2; ++u_) att::mla_unit(ws, L, bh >> 3, bh & 7, u_ ? s_ : 7 - s_, wv, u_ ? (4 * (7 - s_) + 4) % att::NSLOT : 0, u_ ? 2 : 0, u_ ? 0 : 2);
            }
        }
    }
    xcd_barrier(bar);
    { pg8::Gemm g{(const bf16_t*)(ws + WS_MIX), (const bf16_t*)(ws + WS_WO), M, DM, DM, DM, DM}; pg8::StaticOrder S; S.init(M, DM, G, bid);
      PEpiWo E{(const bf16_t*)(ws + WS_XB), (bf16_t*)(ws + WS_H2), (float*)(ws + WS_SSQ2), (const float*)(ws + WS_SSQM), DM}; pg8::gemm_phase<PEpiWo, pg8::StaticOrder, true, true>(L, g, S, E, wv); }
    xcd_barrier(bar);
    { pg8::Gemm g{(const bf16_t*)(ws + WS_H2), (const bf16_t*)(ws + WS_WUP), M, FF, DM, DM, DM}; pg8::StaticOrder S; S.init(M, FF, G, bid);
      PEpiBf16<2> E{(bf16_t*)(ws + WS_HID), LDH, (const float*)(ws + WS_SSQ2), 1.f / 1024}; pg8::gemm_phase<PEpiBf16<2>, pg8::StaticOrder, true, true>(L, g, S, E, wv); }
    xcd_barrier(bar);
    { pg8::Gemm g{(const bf16_t*)(ws + WS_HID), (const bf16_t*)(ws + WS_WDN), M, DM, FF, LDH, LDH}; pg8::StaticOrder S; S.init(M, DM, G, bid);
      PEpiDown E{(const bf16_t*)(ws + WS_H2), ((float*)inptr(21)), DM}; pg8::gemm_phase<PEpiDown, pg8::StaticOrder, true, true>(L, g, S, E, wv); }
}

extern "C" void kernel_launch(void* const* d_in, const int* in_sizes, int n_in, void* d_out, int out_size,
                              void* d_ws, size_t ws_size, hipStream_t stream) {
    static int grid_blocks = 0;
    if (!grid_blocks) {
        int dev = 0, cus = 0, per_cu = 0;
        (void)hipGetDevice(&dev);
        (void)hipDeviceGetAttribute(&cus, hipDeviceAttributeMultiprocessorCount, dev);
        (void)hipFuncSetAttribute((const void*)mega, hipFuncAttributeMaxDynamicSharedMemorySize, LDS_BYTES);
        (void)hipOccupancyMaxActiveBlocksPerMultiprocessor(&per_cu, (const void*)mega, 512, LDS_BYTES);
        if (per_cu != 1) fprintf(stderr, "note: occupancy query reports %d blocks/CU; launching 1 per CU\n", per_cu);
        grid_blocks = cus;
        if (n_in != 21 || out_size != M * DM || ws_size < 256 * MiB) fprintf(stderr, "unexpected shapes: n_in %d out %d ws %zu\n", n_in, out_size, ws_size);
    }
    Params p{};
    for (int i = 0; i < 21; ++i) p.in[i] = (const float*)d_in[i];
    p.out = (float*)d_out; p.ws = (unsigned char*)d_ws;
    if (hipMemsetAsync((char*)d_ws + WS_CTL, 0, CTL_ZERO_BYTES, stream) != hipSuccess) { fprintf(stderr, "memset of the barrier words failed\n"); return; }
    hipLaunchKernelGGL(mega, dim3(grid_blocks), dim3(512), LDS_BYTES, stream, p);
    hipError_t e = hipPeekAtLastError();
    if (e != hipSuccess) fprintf(stderr, "launch failed: %s (grid %d)\n", hipGetErrorString(e), grid_blocks);
}
```

```cpp
#include <hip/hip_runtime.h>
#include <cstdio>
#include <cstdint>

#define LAS __attribute__((address_space(3)))
typedef unsigned short bf16_t;
typedef short bf16x8 __attribute__((ext_vector_type(8)));
typedef float f32x4 __attribute__((ext_vector_type(4)));
typedef unsigned u32x4 __attribute__((ext_vector_type(4)));
typedef unsigned u32x2 __attribute__((ext_vector_type(2)));

constexpr int BATCH = 8, SEQ = 2048, DM = 1024, M = BATCH * SEQ;
constexpr int DIN = 1976, DINP = 2048;
constexpr int C_HQ = 0, C_HKV = 384, C_HKR = 640, C_QB = 672, C_KVB = 1184, C_GATE = 1952;
constexpr int C_KCMP = C_KVB, C_VCMP = C_KVB + 128, C_KSEL = C_KVB + 256, C_VSEL = C_KVB + 384, C_KWIN = C_KVB + 512, C_VWIN = C_KVB + 640;
constexpr int P_HQ = 1280, P_HKV = 1664, P_HKR = 1920, P_GATE = 1952;
__host__ __device__ constexpr int slot_base(int s) { return 256 * (s >> 2) + 32 * (s & 3); }
constexpr int S_Q = 0, S_KCMP = 8, S_VCMP = 10, S_KSEL = 12, S_VSEL = 14, S_KWIN = 16, S_VWIN = 18;
constexpr int QR = 384, KVR = 256, MQ = 768, MKV = 1024, FF = 4096;
constexpr int LDH = FF + 64;
constexpr int NCMP = 127;
constexpr float EPS = 1e-6f;
constexpr float LOG2E = 1.4426950408889634f;
constexpr float QS_MLA = 0.10206207261596577f * LOG2E;
constexpr float QS_NSA = 0.125f * LOG2E;

constexpr size_t MiB = 1u << 20;
constexpr size_t WS_CTL = 0, CTL_ZERO_BYTES = 65536;
constexpr size_t WS_WIN = 1 * MiB, WS_WUQ = 5 * MiB, WS_WUKV = 6 * MiB, WS_WO = 7 * MiB, WS_WUP = 9 * MiB, WS_WDN = 17 * MiB;
constexpr size_t WS_KCMP = 26 * MiB, WS_VCMP = 26 * MiB + 512 * 1024;
constexpr size_t WS_W1T = 30 * MiB;
constexpr size_t WS_W2T = 27 * MiB;
constexpr size_t WS_RSQ = 28 * MiB, WS_RSKV = 28 * MiB + 65536, WS_SSQ2 = 28 * MiB + 131072, WS_SSQM = 28 * MiB + 262144, WS_RS1 = 28 * MiB + 262144 + 131072;
constexpr size_t WS_SSQKR = 28 * MiB + 524288;
constexpr size_t WS_ROPE = 29 * MiB + 65536;
constexpr size_t WS_XB = 32 * MiB;
constexpr size_t WS_DUMMY0 = 0;
constexpr size_t WS_HB = 32 * MiB;
constexpr size_t WS_MIX = 64 * MiB;
constexpr size_t WS_PROJ = 96 * MiB;
constexpr size_t WS_QM = 160 * MiB;
constexpr size_t WS_KVM = 184 * MiB;
constexpr size_t WS_KMLA = 216 * MiB;
constexpr size_t WS_QN = 208 * MiB;
constexpr size_t WS_KSEL = 240 * MiB;
constexpr size_t WS_KWIN = 244 * MiB;
constexpr size_t WS_HQN = 232 * MiB;
constexpr size_t WS_HKVN = 244 * MiB;
constexpr size_t WS_H2 = 224 * MiB;
constexpr size_t WS_HID = 32 * MiB;

constexpr int LDS_BYTES = 155648, LDS_BST = 154624;
constexpr int NW = 8;

struct Params {
    const float* in[21];
    float* out;
    unsigned char* ws;
};

typedef const float* cfptr_t;
__device__ __forceinline__ const float* inptr(int i) {
    const __attribute__((address_space(4))) char* ka = (const __attribute__((address_space(4))) char*)__builtin_amdgcn_kernarg_segment_ptr();
    int off = i * 8; asm volatile("" : "+s"(off));
    return *(const __attribute__((address_space(4))) cfptr_t*)(ka + off);
}
__device__ __forceinline__ unsigned f2bf(float f) { unsigned u = __builtin_bit_cast(unsigned, f); return (u + 0x7fffu + ((u >> 16) & 1u)) >> 16; }
__device__ __forceinline__ float bf2f(unsigned b) { return __builtin_bit_cast(float, b << 16); }
__device__ __forceinline__ unsigned pk2(float lo, float hi) { return f2bf(lo) | (f2bf(hi) << 16); }
__device__ __forceinline__ float wave_sum(float v) {
#pragma unroll
    for (int o = 1; o < 64; o <<= 1) v += __shfl_xor(v, o);
    return v;
}
__device__ __forceinline__ int t5_bucket(int n) {
    if (n < 16) return n;
    int b = 16;
    b += (n >= 19); b += (n >= 21); b += (n >= 24); b += (n >= 27); b += (n >= 31); b += (n >= 35); b += (n >= 40); b += (n >= 46);
    b += (n >= 52); b += (n >= 59); b += (n >= 67); b += (n >= 77); b += (n >= 87); b += (n >= 99); b += (n >= 113);
    return b;
}

__device__ __forceinline__ void p0_transpose_item(const float* W, int K, int N, int Npad, bf16_t* WT, LAS float* scr, int item, int lane, const float* gk = nullptr, int ldw = 0, int projmap = 0) {
    const int nblk = Npad / 32, kb = item / nblk, nb = item % nblk, k0 = 64 * kb, n0 = 32 * nb;
    int nsrc = n0;
    if (projmap == 2) { const int pn_ = n0 >> 8, bj_ = (n0 >> 7) & 1, wc_ = (n0 >> 5) & 3; nsrc = (wc_ < 2 ? 128 * (2 * pn_ + wc_) : 128 * (2 * pn_ + wc_ - 2) + 64) + 32 * bj_; }
    else if (projmap) { if (n0 < 1280) { const int sl = 4 * (n0 >> 8) + ((n0 & 127) >> 5), e0 = 32 * ((n0 >> 7) & 1); nsrc = (sl < 8 ? C_QB + 64 * sl : C_KVB + 64 * (sl - 8)) + e0; }
                   else if (n0 < 1280 + 672) nsrc = n0 - 1280; else if (n0 == P_GATE) nsrc = C_GATE; else nsrc = N; }
    const int nn = nsrc + (lane & 31);
    float wv[32];
#pragma unroll
    for (int i = 0; i < 32; ++i) { const int kk = 2 * i + (lane >> 5); wv[i] = (nn < N) ? W[(size_t)(k0 + kk) * N + nn] : 0.f; }
#pragma unroll
    for (int i = 0; i < 32; ++i) { const int kk = 2 * i + (lane >> 5); const float gg = gk ? gk[k0 + kk] : 1.f; scr[kk * 33 + (lane & 31)] = wv[i] * gg; }
    asm volatile("s_waitcnt lgkmcnt(0)" ::: "memory");
    const int c = lane & 7;
#pragma unroll
    for (int j = 0; j < 4; ++j) { const int n = (lane >> 3) + 8 * j; const LAS float* s = scr + (8 * c) * 33 + n;
        u32x4 o; o.x = pk2(s[0 * 33], s[1 * 33]); o.y = pk2(s[2 * 33], s[3 * 33]); o.z = pk2(s[4 * 33], s[5 * 33]); o.w = pk2(s[6 * 33], s[7 * 33]);
        *(u32x4*)(WT + (size_t)(n0 + n) * (ldw ? ldw : K) + k0 + 8 * c) = o; }
    asm volatile("s_waitcnt lgkmcnt(0)" ::: "memory");
}
template <int NR>
__device__ __forceinline__ void rows_to_bf16_rstd(const float* x, bf16_t* o, float* rstd_out, int row0, int rstride, int lane) {
    f32x4 v[NR][4];
#pragma unroll
    for (int r = 0; r < NR; ++r) { const int rr = (row0 + r * rstride < M) ? row0 + r * rstride : row0; const f32x4* xr = (const f32x4*)(x + (size_t)rr * DM) + lane;
#pragma unroll
        for (int j = 0; j < 4; ++j) v[r][j] = xr[64 * j]; }
#pragma unroll
    for (int r = 0; r < NR; ++r) { if (row0 + r * rstride >= M) continue; float s = 0.f;
#pragma unroll
        for (int j = 0; j < 4; ++j) s += (v[r][j].x * v[r][j].x + v[r][j].y * v[r][j].y) + (v[r][j].z * v[r][j].z + v[r][j].w * v[r][j].w);
        s = wave_sum(s);
        if (lane == 0) rstd_out[row0 + r * rstride] = 1.f / sqrtf(s * (1.f / DM) + EPS);
        unsigned long long* o8 = (unsigned long long*)(o + (size_t)(row0 + r * rstride) * DM) + lane;
#pragma unroll
        for (int j = 0; j < 4; ++j) o8[64 * j] = (unsigned long long)pk2(v[r][j].x, v[r][j].y) | ((unsigned long long)pk2(v[r][j].z, v[r][j].w) << 32); }
}

__device__ __forceinline__ int opaque_tid(int wv) { int lane; asm volatile("v_mbcnt_lo_u32_b32 %0, -1, 0\n\tv_mbcnt_hi_u32_b32 %0, -1, %0" : "=v"(lane)); return (wv << 6) | lane; }
namespace pg8 {
#define PG8_LAS __attribute__((address_space(3)))
typedef unsigned short bf16_t;
typedef short bf16x8 __attribute__((ext_vector_type(8)));
typedef float f32x4 __attribute__((ext_vector_type(4)));
typedef unsigned u32x4 __attribute__((ext_vector_type(4)));
constexpr int BM = 256, BK = 64, HALF = 128, HTB = HALF * BK * 2  , STAGE_BYTES = 8 * HTB, NXCD = 8, WGM = 8;

__host__ __device__ __forceinline__ int lds_byte(int r, int c) { const int st = (r >> 4) * 2 + (c >> 5), rr = r & 15, cc = c & 31, ob = rr * 64 + cc * 2; return st * 1024 + (ob ^ (((ob >> 9) & 1) << 5)); }
__host__ __device__ __forceinline__ void stage_rc(int b, int& R, int& C) { const int st = b / 1024, sb = b % 1024, swz = sb ^ (((sb >> 9) & 1) << 5); R = (st >> 1) * 16 + swz / 64; C = (st & 1) * 32 + (swz % 64) / 2; }
__host__ __device__ __forceinline__ int perm32(int rho) { const int n = rho >> 4, i = rho & 15; return 8 * (i >> 2) + 4 * n + (i & 3); }

struct Unit { int pm, pn; };
struct Gemm { const bf16_t* A; const bf16_t* Bt; int M, N, K, lda, ldb; };

struct StaticOrder {
    int nM, nN, nwg, G, c;
    __host__ __device__ void init(int M, int N, int G_, int c_) { nM = M / BM; nN = N / BM; nwg = nM * nN; G = G_; c = c_; }
    __host__ __device__ bool next(int i, Unit& u) const {
        const long L = (long)i * G + c; if (L >= nwg) return false;
        int wgid = (int)L; { const int q = nwg / NXCD, r = nwg % NXCD, xcd = wgid % NXCD, off = wgid / NXCD; wgid = (xcd < r ? xcd * (q + 1) : r * (q + 1) + (xcd - r) * q) + off; }
        const int nig = WGM * nN, gid = wgid / nig, fm = gid * WGM, gsz = (nM - fm) < WGM ? (nM - fm) : WGM;
        u.pm = fm + ((wgid % nig) % gsz); u.pn = (wgid % nig) / gsz; return true;
    }
    __device__ __forceinline__ void a_ready(const Unit&) const {}
    __device__ __forceinline__ void done(const Unit&) const {}
};

template <class Epi, class Sched, bool ALIGN_EPI = false, bool SP2 = false>
__device__ __forceinline__ void gemm_phase(PG8_LAS unsigned char* lds, const Gemm g, const Sched& S, const Epi& E, int wv) {
    const int tid = opaque_tid(wv), wid = __builtin_amdgcn_readfirstlane(tid >> 6), lane = tid & 63, wr = wid >> 2, wc = wid & 3, fr = lane & 15, fq = lane >> 4;
    const int K = g.K, nt = K / BK;
    unsigned voffA[2], voffB[2];
#pragma unroll
    for (int i = 0; i < 2; ++i) { int R, C; stage_rc(tid * 16 + i * 8192, R, C); const int Rb = Epi::PERM ? ((R & ~31) + perm32(R & 31)) : R;
        voffA[i] = (unsigned)(R * g.lda + C) * 2u; voffB[i] = (unsigned)(Rb * g.ldb + C) * 2u; }
    const size_t kstep = (size_t)(BK * 2);
    const size_t hstepA = (size_t)HALF * g.lda * 2, hstepB = (size_t)HALF * g.ldb * 2;
    const size_t tstepA = 2 * hstepA, tstepB = 2 * hstepB;
    const unsigned ldsw = (unsigned)wid * 1024u;
    const int aoff = lds_byte(wr * 64 + fr, fq * 8), boff = lds_byte(wc * 32 + fr, fq * 8);
#define PG8_SA(b, h) (((b) * 2 + (h)) * HTB)
#define PG8_SB(b, h) ((4 + (b) * 2 + (h)) * HTB)
#define PG8_STAGE(bufoff, gbase, voff) do { _Pragma("unroll") for (int _i = 0; _i < 2; ++_i) \
        __builtin_amdgcn_global_load_lds((const unsigned*)((const char*)(gbase) + (voff)[_i]), (PG8_LAS unsigned*)(lds + (bufoff) + ldsw + _i * 8192), 16, 0, 0); } while (0)
#define PG8_LDA(dst, b, h) do { _Pragma("unroll") for (int m = 0; m < 4; ++m) _Pragma("unroll") for (int k = 0; k < 2; ++k) dst[m][k] = *(const PG8_LAS bf16x8*)(lds + PG8_SA(b, h) + aoff + m * 2048 + k * 1024); } while (0)
#define PG8_LDB(dst, b, h) do { _Pragma("unroll") for (int n = 0; n < 2; ++n) _Pragma("unroll") for (int k = 0; k < 2; ++k) dst[n][k] = *(const PG8_LAS bf16x8*)(lds + PG8_SB(b, h) + boff + n * 2048 + k * 1024); } while (0)
#define PG8_MMA(ai, bj, At, Bt) do { __builtin_amdgcn_s_setprio(1); _Pragma("unroll") for (int m = 0; m < 4; ++m) _Pragma("unroll") for (int n = 0; n < 2; ++n) _Pragma("unroll") for (int k = 0; k < 2; ++k) \
        acc[ai][bj][m][n] = __builtin_amdgcn_mfma_f32_16x16x32_bf16(Bt[n][k], At[m][k], acc[ai][bj][m][n], 0, 0, 0); __builtin_amdgcn_s_setprio(0); } while (0)
#define PG8_WAIT_V(n) asm volatile("s_waitcnt vmcnt(" #n ")" ::: "memory")
#define PG8_WAIT_L(n) asm volatile("s_waitcnt lgkmcnt(" #n ")" ::: "memory")
#define PG8_BAR __builtin_amdgcn_s_barrier()
#define PG8_SCHED __builtin_amdgcn_sched_barrier(0)
    Unit cur, nxt; int ui = 0;
    if (!S.next(0, cur)) return;
    f32x4 acc[2][2][4][2];
#pragma unroll
    for (int a = 0; a < 2; ++a)
#pragma unroll
        for (int b = 0; b < 2; ++b)
#pragma unroll
            for (int m = 0; m < 4; ++m)
#pragma unroll
                for (int n = 0; n < 2; ++n) acc[a][b][m][n] = (f32x4){0.f, 0.f, 0.f, 0.f};
    bf16x8 At[4][2], B0[2][2], B1[2][2];
    const char* cA = (const char*)g.A + (size_t)cur.pm * tstepA; const char* cB = (const char*)g.Bt + (size_t)cur.pn * tstepB;
    asm volatile("" : "+s"(cA), "+s"(cB));
    S.a_ready(cur);
    if constexpr (SP2) {
        PG8_STAGE(PG8_SB(0, 0), cB, voffB); PG8_STAGE(PG8_SB(0, 1), cB + hstepB, voffB); PG8_STAGE(PG8_SA(0, 0), cA, voffA); PG8_STAGE(PG8_SA(0, 1), cA + hstepA, voffA);
        if (wr == 1) PG8_BAR;
        PG8_WAIT_V(2); PG8_BAR;
        PG8_STAGE(PG8_SB(1, 0), cB + kstep, voffB); PG8_STAGE(PG8_SA(1, 0), cA + kstep, voffA); PG8_STAGE(PG8_SB(1, 1), cB + hstepB + kstep, voffB);
        PG8_WAIT_V(6); PG8_BAR;
    } else {
        PG8_STAGE(PG8_SB(0, 0), cB, voffB); PG8_STAGE(PG8_SA(0, 0), cA, voffA); PG8_STAGE(PG8_SB(0, 1), cB + hstepB, voffB); PG8_STAGE(PG8_SA(0, 1), cA + hstepA, voffA);
        if (wr == 1) PG8_BAR;
        PG8_WAIT_V(4); PG8_BAR;
        PG8_STAGE(PG8_SB(1, 0), cB + kstep, voffB); PG8_STAGE(PG8_SA(1, 0), cA + kstep, voffA); PG8_STAGE(PG8_SB(1, 1), cB + hstepB + kstep, voffB);
        PG8_WAIT_V(6); PG8_BAR;
    }
    for (;;) {
        const bool has_next = S.next(ui + 1, nxt);
        const char* nA = has_next ? (const char*)g.A + (size_t)nxt.pm * tstepA : cA; const char* nB = has_next ? (const char*)g.Bt + (size_t)nxt.pn * tstepB : cB;
        asm volatile("" : "+s"(nA), "+s"(nB));
        for (int t = 0; t < nt; t += 2) {
            if constexpr (Epi::MIDSCALE) { if (t == nt / 2) E.midscale(acc, cur, wr, fr); }
            const bool last = (t == nt - 2);
            const char* a1 = cA + (size_t)(t + 1) * kstep;
            const char* a2 = last ? nA : cA + (size_t)(t + 2) * kstep; const char* b2 = last ? nB : cB + (size_t)(t + 2) * kstep;
            const char* a3 = a2 + kstep; const char* b3 = b2 + kstep;
            asm volatile("" : "+s"(a1), "+s"(a2), "+s"(b2), "+s"(a3), "+s"(b3));
            if (last && has_next) S.a_ready(nxt);
            if constexpr (SP2) {
            PG8_LDB(B0, 0, 0); PG8_LDB(B1, 0, 1); PG8_SCHED; PG8_LDA(At, 0, 0); PG8_STAGE(PG8_SA(1, 1), a1 + hstepA, voffA);
            PG8_WAIT_V(8); PG8_WAIT_L(0); PG8_BAR; PG8_MMA(0, 0, At, B0); PG8_MMA(0, 1, At, B1); PG8_BAR; PG8_SCHED;
            PG8_LDA(At, 0, 1); PG8_STAGE(PG8_SB(0, 0), b2, voffB); PG8_STAGE(PG8_SB(0, 1), b2 + hstepB, voffB); PG8_STAGE(PG8_SA(0, 0), a2, voffA);
            PG8_WAIT_V(8); PG8_WAIT_L(0); PG8_BAR; PG8_MMA(1, 0, At, B0); PG8_MMA(1, 1, At, B1); PG8_BAR; PG8_SCHED;
            PG8_LDB(B0, 1, 0); PG8_LDB(B1, 1, 1); PG8_SCHED; PG8_LDA(At, 1, 0); PG8_STAGE(PG8_SA(0, 1), a2 + hstepA, voffA);
            PG8_WAIT_V(8); PG8_WAIT_L(0); PG8_BAR; PG8_MMA(0, 0, At, B0); PG8_MMA(0, 1, At, B1); PG8_BAR; PG8_SCHED;
            PG8_LDA(At, 1, 1); PG8_STAGE(PG8_SB(1, 0), b3, voffB); PG8_STAGE(PG8_SB(1, 1), b3 + hstepB, voffB); PG8_STAGE(PG8_SA(1, 0), a3, voffA);
            PG8_WAIT_V(8); PG8_WAIT_L(0); PG8_BAR; PG8_MMA(1, 0, At, B0); PG8_MMA(1, 1, At, B1); PG8_BAR; PG8_SCHED;
            } else {
            PG8_LDB(B0, 0, 0); PG8_SCHED; PG8_LDA(At, 0, 0); PG8_STAGE(PG8_SA(1, 1), a1 + hstepA, voffA);
            PG8_WAIT_L(8); PG8_BAR; PG8_WAIT_L(0); PG8_MMA(0, 0, At, B0); PG8_BAR; PG8_SCHED;
            PG8_LDB(B1, 0, 1); PG8_STAGE(PG8_SB(0, 0), b2, voffB);
            PG8_BAR; PG8_WAIT_L(0); PG8_MMA(0, 1, At, B1); PG8_BAR;
            PG8_LDA(At, 0, 1); PG8_STAGE(PG8_SA(0, 0), a2, voffA);
            PG8_BAR; PG8_WAIT_L(0); PG8_MMA(1, 0, At, B0); PG8_BAR; PG8_SCHED;
            PG8_STAGE(PG8_SB(0, 1), b2 + hstepB, voffB);
            PG8_WAIT_V(6); PG8_BAR; PG8_MMA(1, 1, At, B1); PG8_BAR;
            PG8_LDB(B0, 1, 0); PG8_SCHED; PG8_LDA(At, 1, 0); PG8_STAGE(PG8_SA(0, 1), a2 + hstepA, voffA);
            PG8_WAIT_L(8); PG8_BAR; PG8_WAIT_L(0); PG8_MMA(0, 0, At, B0); PG8_BAR; PG8_SCHED;
            PG8_LDB(B1, 1, 1); PG8_STAGE(PG8_SB(1, 0), b3, voffB);
            PG8_BAR; PG8_WAIT_L(0); PG8_MMA(0, 1, At, B1); PG8_BAR;
            PG8_LDA(At, 1, 1); PG8_STAGE(PG8_SA(1, 0), a3, voffA);
            PG8_BAR; PG8_WAIT_L(0); PG8_MMA(1, 0, At, B0); PG8_BAR; PG8_SCHED;
            PG8_STAGE(PG8_SB(1, 1), b3 + hstepB, voffB);
            PG8_WAIT_V(6); PG8_BAR; PG8_MMA(1, 1, At, B1); PG8_BAR;
            }
        }
        if constexpr (ALIGN_EPI) { if (wr == 0) PG8_BAR; }
        if constexpr (!Epi::AFTER_DRAIN) { const int l2_ = opaque_tid(wv) & 63; E(acc, cur, wr, wc, l2_ & 15, l2_ >> 4); S.done(cur); }
        if (!has_next) break;
#pragma unroll
        for (int a = 0; a < 2; ++a)
#pragma unroll
            for (int b = 0; b < 2; ++b)
#pragma unroll
                for (int m = 0; m < 4; ++m)
#pragma unroll
                    for (int n = 0; n < 2; ++n) acc[a][b][m][n] = (f32x4){0.f, 0.f, 0.f, 0.f};
        cur = nxt; cA = nA; cB = nB; ++ui;
        if constexpr (ALIGN_EPI) { if (wr == 1) PG8_BAR; }
    }
    PG8_WAIT_V(0);
    if constexpr (!ALIGN_EPI) { if (wr == 0) PG8_BAR; }
    PG8_BAR;
    if constexpr (Epi::AFTER_DRAIN) { E.fused(acc, cur, wr, wc, fr, fq, lds, wid, lane); S.done(cur); }
#undef PG8_SA
#undef PG8_SB
#undef PG8_STAGE
#undef PG8_LDA
#undef PG8_LDB
#undef PG8_MMA
#undef PG8_WAIT_V
#undef PG8_WAIT_L
#undef PG8_BAR
#undef PG8_SCHED
}
}

__device__ __forceinline__ unsigned cvt_pk_bf16(float lo, float hi) { unsigned r; asm volatile("v_cvt_pk_bf16_f32 %0, %1, %2" : "=v"(r) : "v"(lo), "v"(hi)); return r; }
template <int ACT> struct PEpiBf16 {
    static constexpr bool PERM = true, AFTER_DRAIN = false, MIDSCALE = false;
    bf16_t* O; int ldc; const float* rs; float invn;
    __device__ __forceinline__ void operator()(const f32x4 (&acc)[2][2][4][2], const pg8::Unit& u, int wr, int wc, int fr, int fq) const {
        const int row0 = u.pm * 256 + wr * 64 + fr, col0 = u.pn * 256 + wc * 32 + 8 * fq;
        float rsc[2][4];
#pragma unroll
        for (int ai = 0; ai < 2; ++ai)
#pragma unroll
            for (int m = 0; m < 4; ++m) rsc[ai][m] = rs ? rs[row0 + ai * 128 + m * 16] : 1.f;
        if (invn > 0.f) {
#pragma unroll
            for (int ai = 0; ai < 2; ++ai)
#pragma unroll
                for (int m = 0; m < 4; ++m) rsc[ai][m] = 1.f / sqrtf(rsc[ai][m] * invn + EPS); }
#pragma unroll
        for (int ai = 0; ai < 2; ++ai)
#pragma unroll
            for (int m = 0; m < 4; ++m) { bf16_t* rowp = O + (size_t)(row0 + ai * 128 + m * 16) * ldc + col0; const float sc_ = rsc[ai][m];
#pragma unroll
                for (int bj = 0; bj < 2; ++bj) { f32x4 v0 = acc[ai][bj][m][0] * sc_, v1 = acc[ai][bj][m][1] * sc_;
                    if (ACT == 2) {
#pragma unroll
                        for (int e = 0; e < 4; ++e) { const float a = fmaxf(v0[e], 0.f), b = fmaxf(v1[e], 0.f); v0[e] = a * a; v1[e] = b * b; } }
                    u32x4 w; w.x = cvt_pk_bf16(v0[0], v0[1]); w.y = cvt_pk_bf16(v0[2], v0[3]); w.z = cvt_pk_bf16(v1[0], v1[1]); w.w = cvt_pk_bf16(v1[2], v1[3]);
                    *(u32x4*)(rowp + bj * 128) = w; } }
    }
};
struct PEpiProj {
    static constexpr bool PERM = true, AFTER_DRAIN = false, MIDSCALE = false;
    bf16_t* O; int ldc; const float* rs1; float* ssq_q; float* ssq_kv; float* ssq_kr; const float* qgain; const float* kgain; const float* rope; const float* kgm;
    __device__ __forceinline__ void operator()(const f32x4 (&acc)[2][2][4][2], const pg8::Unit& u, int wr, int wc, int fr, int fq) const {
        const int row0 = u.pm * 256 + wr * 64 + fr, col0 = u.pn * 256 + wc * 32 + 8 * fq, lane = fq * 16 + fr;
        float rsc[2][4];
#pragma unroll
        for (int ai = 0; ai < 2; ++ai)
#pragma unroll
            for (int m = 0; m < 4; ++m) rsc[ai][m] = rs1[row0 + ai * 128 + m * 16];
        const int sl = 4 * u.pn + wc;
        int mode = 0; const float* g = nullptr; float gs = 1.f;
        if (u.pn < 5) { if (sl < 8) { mode = 1; g = qgain; gs = QS_NSA; } else if (sl == S_KSEL || sl == S_KSEL + 1) { mode = 1; g = kgain + 64; } else if (sl == S_KWIN || sl == S_KWIN + 1) { mode = 1; g = kgain + 128; } }
        f32x4 ga[2][2];
        if (mode == 1) {
#pragma unroll
            for (int bj = 0; bj < 2; ++bj) { ga[bj][0] = *(const f32x4*)(g + 32 * bj + 8 * fq) * gs; ga[bj][1] = *(const f32x4*)(g + 32 * bj + 8 * fq + 4) * gs; } }
#pragma unroll
        for (int ai = 0; ai < 2; ++ai)
#pragma unroll
            for (int m = 0; m < 4; ++m) { const int row = row0 + ai * 128 + m * 16; bf16_t* rowp = O + (size_t)row * ldc + col0; const float sc_ = rsc[ai][m];
                f32x4 v[2][2];
#pragma unroll
                for (int bj = 0; bj < 2; ++bj) { v[bj][0] = acc[ai][bj][m][0] * sc_; v[bj][1] = acc[ai][bj][m][1] * sc_; }
                if (mode == 1) {
                    float ss = 0.f;
#pragma unroll
                    for (int bj = 0; bj < 2; ++bj)
#pragma unroll
                        for (int n = 0; n < 2; ++n) ss += (v[bj][n][0] * v[bj][n][0] + v[bj][n][1] * v[bj][n][1]) + (v[bj][n][2] * v[bj][n][2] + v[bj][n][3] * v[bj][n][3]);
                    ss += __builtin_bit_cast(float, __builtin_amdgcn_ds_bpermute((lane ^ 16) << 2, __builtin_bit_cast(int, ss)));
                    ss += __builtin_bit_cast(float, __builtin_amdgcn_ds_bpermute((lane ^ 32) << 2, __builtin_bit_cast(int, ss)));
                    const float rstd = 1.f / sqrtf(ss * (1.f / 64) + EPS);
#pragma unroll
                    for (int bj = 0; bj < 2; ++bj) { v[bj][0] = v[bj][0] * rstd * ga[bj][0]; v[bj][1] = v[bj][1] * rstd * ga[bj][1]; }
                } else if (u.pn >= 5) {
#pragma unroll
                    for (int bj = 0; bj < 2; ++bj) { const int cb = u.pn * 256 + bj * 128;
                        float* dst = (cb < P_HKV) ? ssq_q : (cb < P_HKR ? ssq_kv : ((cb == P_HKR && wc == 0) ? ssq_kr : nullptr));
                        if (dst) { float ss = (v[bj][0][0] * v[bj][0][0] + v[bj][0][1] * v[bj][0][1]) + (v[bj][0][2] * v[bj][0][2] + v[bj][0][3] * v[bj][0][3]) + (v[bj][1][0] * v[bj][1][0] + v[bj][1][1] * v[bj][1][1]) + (v[bj][1][2] * v[bj][1][2] + v[bj][1][3] * v[bj][1][3]);
                            ss += __builtin_bit_cast(float, __builtin_amdgcn_ds_bpermute((lane ^ 16) << 2, __builtin_bit_cast(int, ss)));
                            ss += __builtin_bit_cast(float, __builtin_amdgcn_ds_bpermute((lane ^ 32) << 2, __builtin_bit_cast(int, ss)));
                            if (fq == 0) __hip_atomic_fetch_add(dst + row, ss, __ATOMIC_RELAXED, __HIP_MEMORY_SCOPE_AGENT); }
                        if (cb == P_HKR && wc == 0) {
                            const f32x4 g0 = *(const f32x4*)(kgm + 64 + 8 * fq), g1 = *(const f32x4*)(kgm + 64 + 8 * fq + 4);
                            const float* rp = rope + (size_t)(row & (SEQ - 1)) * 32 + 8 * (fq & 1);
                            const f32x4 c0 = *(const f32x4*)rp, c1 = *(const f32x4*)(rp + 4), s0 = *(const f32x4*)(rp + 16), s1 = *(const f32x4*)(rp + 20);
#pragma unroll
                            for (int n = 0; n < 2; ++n)
#pragma unroll
                                for (int j = 0; j < 4; ++j) { const float nv = v[bj][n][j] * (n ? g1[j] : g0[j]);
                                    const float pv = __builtin_bit_cast(float, __builtin_amdgcn_ds_bpermute((lane ^ 32) << 2, __builtin_bit_cast(int, nv)));
                                    const float cs = n ? c1[j] : c0[j], sn = n ? s1[j] : s0[j]; v[bj][n][j] = (fq < 2) ? nv * cs - pv * sn : nv * cs + pv * sn; } } }
                }
#pragma unroll
                for (int bj = 0; bj < 2; ++bj) { u32x4 w; w.x = cvt_pk_bf16(v[bj][0][0], v[bj][0][1]); w.y = cvt_pk_bf16(v[bj][0][2], v[bj][0][3]); w.z = cvt_pk_bf16(v[bj][1][0], v[bj][1][1]); w.w = cvt_pk_bf16(v[bj][1][2], v[bj][1][3]);
                    *(u32x4*)(rowp + bj * 128) = w; } }
    }
};
struct PEpiKV {
    static constexpr bool PERM = true, AFTER_DRAIN = false, MIDSCALE = false;
    bf16_t* V; bf16_t* K; const bf16_t* proj; const float* ssq_kv; const float* ssq_kr; const float* rope; const float* kgain;
    __device__ __forceinline__ void operator()(const f32x4 (&acc)[2][2][4][2], const pg8::Unit& u, int wr, int wc, int fr_, int fq_) const {
        int fr = fr_, fq = fq_; asm volatile("" : "+v"(fr), "+v"(fq)); const float* kgain = this->kgain; asm volatile("" : "+s"(kgain)); const float* rope = this->rope; asm volatile("" : "+s"(rope));
        const int row0 = u.pm * 256 + wr * 64 + fr, lane = fq * 16 + fr;
        float rsc[2][4];
#pragma unroll
        for (int ai = 0; ai < 2; ++ai)
#pragma unroll
            for (int m = 0; m < 4; ++m) rsc[ai][m] = 1.f / sqrtf(ssq_kv[row0 + ai * 128 + m * 16] * (1.f / KVR) + EPS);
        if (wc >= 2) {
            const int col0 = u.pn * 256 + wc * 32 + 8 * fq;
#pragma unroll
            for (int ai = 0; ai < 2; ++ai)
#pragma unroll
                for (int m = 0; m < 4; ++m) { bf16_t* rowp = V + (size_t)(row0 + ai * 128 + m * 16) * MKV + col0; const float sc_ = rsc[ai][m];
#pragma unroll
                    for (int bj = 0; bj < 2; ++bj) { const f32x4 v0 = acc[ai][bj][m][0] * sc_, v1 = acc[ai][bj][m][1] * sc_;
                        u32x4 w; w.x = cvt_pk_bf16(v0[0], v0[1]); w.y = cvt_pk_bf16(v0[2], v0[3]); w.z = cvt_pk_bf16(v1[0], v1[1]); w.w = cvt_pk_bf16(v1[2], v1[3]);
                        *(u32x4*)(rowp + bj * 128) = w; } }
            return;
        }
        const int hh = 2 * u.pn + wc;
#pragma unroll
        for (int ai = 0; ai < 2; ++ai)
#pragma unroll
            for (int m = 0; m < 4; ++m) { const int row = row0 + ai * 128 + m * 16; const float sc_ = rsc[ai][m];
                bf16_t* ko = K + (size_t)row * MQ + 96 * hh;
                float rstd;
                {
                    f32x4 v[2][2]; float ss = 0.f;
#pragma unroll
                    for (int bj = 0; bj < 2; ++bj)
#pragma unroll
                        for (int n = 0; n < 2; ++n) { v[bj][n] = acc[ai][bj][m][n] * sc_; ss += (v[bj][n][0] * v[bj][n][0] + v[bj][n][1] * v[bj][n][1]) + (v[bj][n][2] * v[bj][n][2] + v[bj][n][3] * v[bj][n][3]); }
                    ss += __builtin_bit_cast(float, __builtin_amdgcn_ds_bpermute((lane ^ 16) << 2, __builtin_bit_cast(int, ss)));
                    ss += __builtin_bit_cast(float, __builtin_amdgcn_ds_bpermute((lane ^ 32) << 2, __builtin_bit_cast(int, ss)));
                    rstd = 1.f / sqrtf((ss + ssq_kr[row]) * (1.f / 96) + EPS);
#pragma unroll
                    for (int bj = 0; bj < 2; ++bj) { const f32x4 g0 = *(const f32x4*)(kgain + 32 * bj + 8 * fq), g1 = *(const f32x4*)(kgain + 32 * bj + 8 * fq + 4);
                        const f32x4 a = v[bj][0] * rstd * g0, b = v[bj][1] * rstd * g1;
                        u32x4 w; w.x = cvt_pk_bf16(a[0], a[1]); w.y = cvt_pk_bf16(a[2], a[3]); w.z = cvt_pk_bf16(b[0], b[1]); w.w = cvt_pk_bf16(b[2], b[3]);
                        *(u32x4*)(ko + 32 * bj + 8 * fq) = w; }
                }
                asm volatile("" ::: "memory");
                {
                    const bf16x8 kr8 = *(const bf16x8*)(proj + (size_t)row * DINP + P_HKR + 8 * fq);
                    u32x4 w; w.x = cvt_pk_bf16(bf2f((unsigned short)kr8[0]) * rstd, bf2f((unsigned short)kr8[1]) * rstd); w.y = cvt_pk_bf16(bf2f((unsigned short)kr8[2]) * rstd, bf2f((unsigned short)kr8[3]) * rstd);
                    w.z = cvt_pk_bf16(bf2f((unsigned short)kr8[4]) * rstd, bf2f((unsigned short)kr8[5]) * rstd); w.w = cvt_pk_bf16(bf2f((unsigned short)kr8[6]) * rstd, bf2f((unsigned short)kr8[7]) * rstd);
                    *(u32x4*)(ko + 64 + 8 * fq) = w;
                }
                asm volatile("" ::: "memory"); }
    }
};
struct PEpiWo {
    static constexpr bool PERM = false, AFTER_DRAIN = false, MIDSCALE = true;
    const bf16_t* base; bf16_t* xb; float* ssq; const float* ssqm; int ldc;
    __device__ __forceinline__ void midscale(f32x4 (&acc)[2][2][4][2], const pg8::Unit& u, int wr, int fr) const {
#pragma unroll
        for (int ai = 0; ai < 2; ++ai)
#pragma unroll
            for (int m = 0; m < 4; ++m) { const int row = u.pm * 256 + ai * 128 + wr * 64 + m * 16 + fr;
                const float sa = ssqm[2 * row], sb = ssqm[2 * row + 1]; const float ratio = sqrtf((sb * (1.f / 512) + EPS) / (sa * (1.f / 512) + EPS));
#pragma unroll
                for (int bj = 0; bj < 2; ++bj)
#pragma unroll
                    for (int n = 0; n < 2; ++n) acc[ai][bj][m][n] *= ratio; }
    }
    __device__ __forceinline__ void operator()(const f32x4 (&acc)[2][2][4][2], const pg8::Unit& u, int wr, int wc, int fr, int fq) const {
        const int col0 = u.pn * 256 + wc * 32 + 4 * fq; const int lane = fq * 16 + fr;
        const int rowb = u.pm * 256 + wr * 64 + fr;
        float rb[8];
#pragma unroll
        for (int g_ = 0; g_ < 8; ++g_) rb[g_] = ssqm[2 * (rowb + (g_ >> 2) * 128 + (g_ & 3) * 16) + 1];
        u32x2 nxt[2][2];
#pragma unroll
        for (int bj = 0; bj < 2; ++bj)
#pragma unroll
            for (int n = 0; n < 2; ++n) nxt[bj][n] = *(const u32x2*)(base + (size_t)rowb * ldc + col0 + bj * 128 + n * 16);
#pragma unroll
        for (int g_ = 0; g_ < 8; ++g_) { const int ai = g_ >> 2, m = g_ & 3; const int row = rowb + ai * 128 + m * 16; const size_t off = (size_t)row * ldc + col0; float ss = 0.f;
            u32x2 cur[2][2];
#pragma unroll
            for (int bj = 0; bj < 2; ++bj)
#pragma unroll
                for (int n = 0; n < 2; ++n) cur[bj][n] = nxt[bj][n];
            if (g_ < 7) { const size_t offn = (size_t)(rowb + ((g_ + 1) >> 2) * 128 + ((g_ + 1) & 3) * 16) * ldc + col0;
#pragma unroll
                for (int bj = 0; bj < 2; ++bj)
#pragma unroll
                    for (int n = 0; n < 2; ++n) nxt[bj][n] = *(const u32x2*)(base + offn + bj * 128 + n * 16); }
            const float rbs = 1.f / sqrtf(rb[g_] * (1.f / 512) + EPS);
#pragma unroll
            for (int bj = 0; bj < 2; ++bj)
#pragma unroll
                for (int n = 0; n < 2; ++n) { const u32x2 cw = cur[bj][n]; const f32x4 v = (f32x4){bf2f(cw.x & 0xffffu), bf2f(cw.x >> 16), bf2f(cw.y & 0xffffu), bf2f(cw.y >> 16)} + acc[ai][bj][m][n] * rbs;
                    ss += (v[0] * v[0] + v[1] * v[1]) + (v[2] * v[2] + v[3] * v[3]);
                    u32x2 w; w.x = cvt_pk_bf16(v[0], v[1]); w.y = cvt_pk_bf16(v[2], v[3]); *(u32x2*)(xb + off + bj * 128 + n * 16) = w; }
            ss += __builtin_bit_cast(float, __builtin_amdgcn_ds_bpermute((lane ^ 16) << 2, __builtin_bit_cast(int, ss)));
            ss += __builtin_bit_cast(float, __builtin_amdgcn_ds_bpermute((lane ^ 32) << 2, __builtin_bit_cast(int, ss)));
            if (fq == 0) __hip_atomic_fetch_add(ssq + row, ss, __ATOMIC_RELAXED, __HIP_MEMORY_SCOPE_AGENT); }
    }
};


struct PEpiDown {
    static constexpr bool PERM = false, AFTER_DRAIN = false, MIDSCALE = false;
    const bf16_t* xb; float* out; int ldc;
    __device__ __forceinline__ void operator()(const f32x4 (&acc)[2][2][4][2], const pg8::Unit& u, int wr, int wc, int fr, int fq) const {
        const int col0 = u.pn * 256 + wc * 32 + 4 * fq; const int rowb = u.pm * 256 + wr * 64 + fr;
        u32x2 nxt[2][2];
#pragma unroll
        for (int bj = 0; bj < 2; ++bj)
#pragma unroll
            for (int n = 0; n < 2; ++n) nxt[bj][n] = *(const u32x2*)(xb + (size_t)rowb * ldc + col0 + bj * 128 + n * 16);
#pragma unroll
        for (int g_ = 0; g_ < 8; ++g_) { const int ai = g_ >> 2, m = g_ & 3; const size_t off = (size_t)(rowb + ai * 128 + m * 16) * ldc + col0;
            u32x2 cur[2][2];
#pragma unroll
            for (int bj = 0; bj < 2; ++bj)
#pragma unroll
                for (int n = 0; n < 2; ++n) cur[bj][n] = nxt[bj][n];
            if (g_ < 7) { const size_t offn = (size_t)(rowb + ((g_ + 1) >> 2) * 128 + ((g_ + 1) & 3) * 16) * ldc + col0;
#pragma unroll
                for (int bj = 0; bj < 2; ++bj)
#pragma unroll
                    for (int n = 0; n < 2; ++n) nxt[bj][n] = *(const u32x2*)(xb + offn + bj * 128 + n * 16); }
#pragma unroll
            for (int bj = 0; bj < 2; ++bj)
#pragma unroll
                for (int n = 0; n < 2; ++n) { const u32x2 w = cur[bj][n];
                    const f32x4 bs = (f32x4){bf2f(w.x & 0xffffu), bf2f(w.x >> 16), bf2f(w.y & 0xffffu), bf2f(w.y >> 16)};
                    __builtin_nontemporal_store(bs + acc[ai][bj][m][n], (f32x4*)(out + off + bj * 128 + n * 16)); } }
    }
};

__device__ __forceinline__ float sq8(const bf16x8 v) { float s = 0.f;
#pragma unroll
    for (int j = 0; j < 8; ++j) { const float f = bf2f((unsigned short)v[j]); s += f * f; }
    return s; }
__device__ __forceinline__ u32x4 scale8(const bf16x8 v, float sc, const f32x4 ga, const f32x4 gb) { u32x4 o;
    o.x = pk2(bf2f((unsigned short)v[0]) * sc * ga[0], bf2f((unsigned short)v[1]) * sc * ga[1]); o.y = pk2(bf2f((unsigned short)v[2]) * sc * ga[2], bf2f((unsigned short)v[3]) * sc * ga[3]);
    o.z = pk2(bf2f((unsigned short)v[4]) * sc * gb[0], bf2f((unsigned short)v[5]) * sc * gb[1]); o.w = pk2(bf2f((unsigned short)v[6]) * sc * gb[2], bf2f((unsigned short)v[7]) * sc * gb[3]);
    return o; }

__device__ __forceinline__ void compress_block(unsigned char* ws, LAS unsigned char* L, int task, int wv) {
    const int tid = opaque_tid(wv), lane = tid & 63, wid = __builtin_amdgcn_readfirstlane(tid >> 6), fr = lane & 15, fq = lane >> 4;
    const int tc = task & 15, b = (task >> 4) & 7, kv = task >> 7;
    int c = 8 * tc + (fr >> 1); const int g = fr & 1; if (c > NCMP - 1) c = NCMP - 1;
    const bf16_t* arow = (const bf16_t*)(ws + WS_PROJ) + (size_t)(b * SEQ + 16 * c) * DINP + slot_base((kv ? S_VCMP : S_KCMP) + g) + 8 * fq;
    const float* pe = inptr(11) + kv * 2048 + 8 * fq;
    const bf16_t* w1t = (const bf16_t*)(ws + WS_W1T) + (size_t)kv * 128 * 2048 + (size_t)fr * 2048 + 8 * fq;
    f32x4 acc[8];
#pragma unroll
    for (int n = 0; n < 8; ++n) acc[n] = (f32x4){0.f, 0.f, 0.f, 0.f};
#pragma unroll 4
    for (int s8 = 0; s8 < 8; ++s8) {
        const int s = 8 * wid + s8, r = s >> 1, db = (s & 1) * 32;
        const bf16x8 araw = *(const bf16x8*)(arow + (size_t)r * DINP + 4 * db);
        const f32x4 pa = *(const f32x4*)(pe + r * 64 + db), pb = *(const f32x4*)(pe + r * 64 + db + 4);
        u32x4 aw; aw.x = pk2(bf2f((unsigned short)araw[0]) + pa[0], bf2f((unsigned short)araw[1]) + pa[1]); aw.y = pk2(bf2f((unsigned short)araw[2]) + pa[2], bf2f((unsigned short)araw[3]) + pa[3]);
        aw.z = pk2(bf2f((unsigned short)araw[4]) + pb[0], bf2f((unsigned short)araw[5]) + pb[1]); aw.w = pk2(bf2f((unsigned short)araw[6]) + pb[2], bf2f((unsigned short)araw[7]) + pb[3]);
        const bf16x8 a = __builtin_bit_cast(bf16x8, aw);
#pragma unroll
        for (int n = 0; n < 8; ++n) { const bf16x8 bb = *(const bf16x8*)(w1t + (size_t)(16 * n) * 2048 + 32 * s);
            acc[n] = __builtin_amdgcn_mfma_f32_16x16x32_bf16(a, bb, acc[n], 0, 0, 0); }
    }
    LAS float* part = (LAS float*)L;
#pragma unroll
    for (int n = 0; n < 8; ++n)
#pragma unroll
        for (int j = 0; j < 4; ++j) part[(wid * 16 + 4 * fq + j) * 128 + 16 * n + fr] = acc[n][j];
    __syncthreads();
    LAS bf16_t* hb_ = (LAS bf16_t*)(L + 65536);
#pragma unroll
    for (int e = 0; e < 4; ++e) { const int idx = tid + 512 * e; float v = 0.f;
#pragma unroll
        for (int w = 0; w < 8; ++w) v += part[w * 2048 + idx];
        hb_[idx] = (bf16_t)f2bf(v / (1.f + __expf(-v))); }
    __syncthreads();
    if (wid == 0) {
        const bf16_t* w2t = (const bf16_t*)(ws + WS_W2T) + kv * 64 * 128 + fr * 128 + 8 * fq;
        f32x4 o[4];
#pragma unroll
        for (int n = 0; n < 4; ++n) o[n] = (f32x4){0.f, 0.f, 0.f, 0.f};
#pragma unroll
        for (int ks = 0; ks < 4; ++ks) { const bf16x8 a = *(const LAS bf16x8*)(hb_ + fr * 128 + 32 * ks + 8 * fq);
#pragma unroll
            for (int n = 0; n < 4; ++n) { const bf16x8 bb = *(const bf16x8*)(w2t + (size_t)(16 * n) * 128 + 32 * ks); o[n] = __builtin_amdgcn_mfma_f32_16x16x32_bf16(a, bb, o[n], 0, 0, 0); } }
        bf16_t* dstb = (bf16_t*)(ws + (kv ? WS_VCMP : WS_KCMP)) + (size_t)b * 128 * 2 * 64;
        const float* kg = inptr(10);
#pragma unroll
        for (int j = 0; j < 4; ++j) { const int row = 4 * fq + j, cc = 8 * tc + (row >> 1), gg = row & 1;
            float sc = 1.f;
            if (kv == 0) { float ss = o[0][j] * o[0][j] + o[1][j] * o[1][j] + o[2][j] * o[2][j] + o[3][j] * o[3][j];
                ss += __shfl_xor(ss, 1); ss += __shfl_xor(ss, 2); ss += __shfl_xor(ss, 4); ss += __shfl_xor(ss, 8); sc = 1.f / sqrtf(ss * (1.f / 64) + EPS); }
#pragma unroll
            for (int n = 0; n < 4; ++n) { const int col = 16 * n + fr; float v = o[n][j] * sc; if (kv == 0) v *= kg[col]; if (cc >= NCMP) v = 0.f;
                dstb[((size_t)cc * 2 + gg) * 64 + col] = (bf16_t)f2bf(v); } }
    }
    __syncthreads();
}

namespace att {
typedef float f32x16 __attribute__((ext_vector_type(16)));
typedef short s16x4 __attribute__((ext_vector_type(4)));
typedef short v4i16_t __attribute__((ext_vector_type(4)));
typedef float f32x2_t __attribute__((ext_vector_type(2)));
typedef __bf16 bf16x2_t __attribute__((ext_vector_type(2)));
typedef const LAS unsigned char* lcp;
constexpr int NSLOT = 3;
constexpr int L_TB = 0, L_K = 4096, KSLOT = 12288, L_V = L_K + NSLOT * KSLOT, VSLOT = 8192, L_WSF = L_V + NSLOT * VSLOT, L_OST = L_WSF + 4096,
              L_IMP = L_OST + 32768, IMPS = 33  , L_SELM = L_IMP + 4 * 64 * IMPS * 4, L_GATE = L_SELM + 256, L_SC = L_GATE + 3072, L_INVL = L_SC + 64 * IMPS * 4, L_END = L_INVL + 1024;
static_assert(L_V + NSLOT * VSLOT <= 65536, "LDS-DMA destinations stay below 64 KiB");
static_assert(L_END <= LDS_BST, "attention LDS map");
constexpr float THR = 8.0f;
__device__ __forceinline__ int crow(int r, int hi) { return (r & 3) + 8 * (r >> 2) + 4 * hi; }
__device__ __forceinline__ void glds16(const void* gsrc, unsigned lds_dst) { unsigned keep;
    asm volatile("s_mov_b32 %0, m0\n\ts_mov_b32 m0, %2\n\ts_nop 0\n\tglobal_load_lds_dwordx4 %1, off\n\ts_mov_b32 m0, %0" : "=&s"(keep) : "v"(gsrc), "s"(lds_dst) : "memory"); }
__device__ __forceinline__ unsigned cvtpk(float lo, float hi) { f32x2_t v = {lo, hi}; bf16x2_t b = __builtin_convertvector(v, bf16x2_t); return __builtin_bit_cast(unsigned, b); }
__device__ __forceinline__ s16x4 vtr(lcp p) { return __builtin_bit_cast(s16x4, __builtin_amdgcn_ds_read_tr16_b64_v4i16((LAS v4i16_t*)p)); }
__device__ __forceinline__ float lane_xor(float v, int lane, int x) { return __builtin_bit_cast(float, __builtin_amdgcn_ds_bpermute((lane ^ x) << 2, __builtin_bit_cast(int, v))); }
__device__ __forceinline__ unsigned lane_xor_u(unsigned v, int lane, int x) { return (unsigned)__builtin_amdgcn_ds_bpermute((lane ^ x) << 2, (int)v); }
__device__ __forceinline__ float swap_max(float m, int lane) { return __builtin_fmaxf(m, lane_xor(m, lane, 32)); }
__device__ __forceinline__ float swap_sum(float m, int lane) { return m + lane_xor(m, lane, 32); }
__device__ __forceinline__ float max3f(float a, float b, float c) { float r; asm("v_max3_f32 %0, %1, %2, %3" : "=v"(r) : "v"(a), "v"(b), "v"(c)); return r; }
__device__ __forceinline__ float max32(const f32x16& p0, const f32x16& p1) {
    float a = max3f(p0[0], p0[1], p1[0]), b = max3f(p0[2], p0[3], p1[1]); a = max3f(a, p1[2], p1[3]);
#pragma unroll
    for (int r = 4; r < 16; r += 4) { a = max3f(a, p0[r], p0[r + 1]); b = max3f(b, p0[r + 2], p0[r + 3]); a = max3f(a, p1[r], p1[r + 1]); b = max3f(b, p1[r + 2], p1[r + 3]); }
    return __builtin_fmaxf(a, b); }
__device__ __forceinline__ float max16(const f32x16& p) { float a = __builtin_fmaxf(p[0], p[1]), b = __builtin_fmaxf(p[2], p[3]);
#pragma unroll
    for (int r = 4; r < 16; r += 4) { a = __builtin_fmaxf(a, __builtin_fmaxf(p[r], p[r + 1])); b = __builtin_fmaxf(b, __builtin_fmaxf(p[r + 2], p[r + 3])); }
    return __builtin_fmaxf(a, b); }
__device__ __forceinline__ float sum16(const f32x16& p) { float a = p[0] + p[1], b = p[2] + p[3];
#pragma unroll
    for (int r = 4; r < 16; r += 4) { a += p[r] + p[r + 1]; b += p[r + 2] + p[r + 3]; }
    return a + b; }
#define ATT_BAR() asm volatile("s_waitcnt vmcnt(0) lgkmcnt(0)\n\ts_barrier" ::: "memory")

template <int DQ> __device__ __forceinline__ void qkt(f32x16& p0, f32x16& p1, lcp kslot, const bf16x8* qr, const f32x16& cinit, int r32, int hi) {
    lcp kb = kslot + hi * 1024 + r32 * 16;
    constexpr int NB = 2;
#pragma unroll
    for (int db = 0; db < DQ / 16; db += NB) {
        bf16x8 kf[2 * NB];
#pragma unroll
        for (int e = 0; e < NB; ++e) { kf[2 * e] = *(const LAS bf16x8*)(kb + (db + e) * 2048); kf[2 * e + 1] = *(const LAS bf16x8*)(kb + (db + e) * 2048 + 512); }
        __builtin_amdgcn_sched_barrier(0);
#pragma unroll
        for (int e = 0; e < NB; ++e) { const int d0 = db + e;
            if (d0 == 0) { p0 = __builtin_amdgcn_mfma_f32_32x32x16_bf16(kf[0], qr[0], cinit, 0, 0, 0); p1 = __builtin_amdgcn_mfma_f32_32x32x16_bf16(kf[1], qr[0], cinit, 0, 0, 0); }
            else { p0 = __builtin_amdgcn_mfma_f32_32x32x16_bf16(kf[2 * e], qr[d0], p0, 0, 0, 0); p1 = __builtin_amdgcn_mfma_f32_32x32x16_bf16(kf[2 * e + 1], qr[d0], p1, 0, 0, 0); }
        }
    }
}
__device__ __forceinline__ void vload_half(bf16x8 (&vf)[8], lcp vp, int d0) {
#pragma unroll
    for (int ks = 0; ks < 4; ++ks) {
        const s16x4 lo = vtr(vp + d0 * 4096 + ks * 1024), hh = vtr(vp + d0 * 4096 + ks * 1024 + 512);
        vf[d0 * 4 + ks] = (bf16x8){lo[0], lo[1], lo[2], lo[3], hh[0], hh[1], hh[2], hh[3]};
    }
    __builtin_amdgcn_sched_barrier(0);
}
__device__ __forceinline__ void vload(bf16x8 (&vf)[8], lcp vp) { vload_half(vf, vp, 0); vload_half(vf, vp, 1); }
__device__ __forceinline__ void pv_mma(f32x16 (&o)[2], const bf16x8 (&vf)[8], const f32x16& p0, const f32x16& p1) {
    u32x4 pw[4];
    pw[0] = (u32x4){cvtpk(p0[0], p0[1]), cvtpk(p0[2], p0[3]), cvtpk(p0[4], p0[5]), cvtpk(p0[6], p0[7])};
    pw[1] = (u32x4){cvtpk(p0[8], p0[9]), cvtpk(p0[10], p0[11]), cvtpk(p0[12], p0[13]), cvtpk(p0[14], p0[15])};
    pw[2] = (u32x4){cvtpk(p1[0], p1[1]), cvtpk(p1[2], p1[3]), cvtpk(p1[4], p1[5]), cvtpk(p1[6], p1[7])};
    pw[3] = (u32x4){cvtpk(p1[8], p1[9]), cvtpk(p1[10], p1[11]), cvtpk(p1[12], p1[13]), cvtpk(p1[14], p1[15])};
#pragma unroll
    for (int d0 = 0; d0 < 2; ++d0)
#pragma unroll
        for (int ks = 0; ks < 4; ++ks) o[d0] = __builtin_amdgcn_mfma_f32_32x32x16_bf16(__builtin_bit_cast(bf16x8, pw[ks]), vf[d0 * 4 + ks], o[d0], 0, 0, 0);
}
__device__ __forceinline__ void pv(f32x16 (&o)[2], lcp vp, const f32x16& p0, const f32x16& p1) { bf16x8 vf[8]; vload(vf, vp); pv_mma(o, vf, p0, p1); }
template <int DQ, bool SLOT = false, bool SLOTV = SLOT> __device__ __forceinline__ void dma_tile(unsigned lds0, const bf16_t* Kg, int kpitch, const bf16_t* Vg, int vpitch, int key0, int slot, int wid, int lane) {
    const bf16_t* ksrc = Kg + (size_t)(key0 + lane) * kpitch + (SLOT ? 128 * (wid >> 2) + 8 * (wid & 3) : wid * 8);
    glds16(ksrc, (unsigned)__builtin_amdgcn_readfirstlane(lds0 + L_K + slot * KSLOT + wid * 1024));
    if (DQ == 96) { if (wid < 4) glds16(ksrc + 64, (unsigned)__builtin_amdgcn_readfirstlane(lds0 + L_K + slot * KSLOT + (8 + wid) * 1024)); }
    const bf16_t* vsrc = Vg + (size_t)(key0 + 16 * (wid & 3) + (lane >> 2)) * vpitch + (wid >> 2) * (SLOTV ? 128 : 32) + (lane & 3) * 8;
    glds16(vsrc, (unsigned)__builtin_amdgcn_readfirstlane(lds0 + L_V + slot * VSLOT + wid * 1024));
}

#define ATT_LBAR() asm volatile("s_waitcnt lgkmcnt(0)\n\ts_barrier" ::: "memory")
struct NoNext { static constexpr int count = 0; __device__ __forceinline__ void dma(unsigned, int, int, int, int) const {} };
template <int DQ, bool SLOT, bool SLOTV, class Pol> struct NextTiles {
    const bf16_t* Kg; int kpitch; const bf16_t* Vg; int vpitch; const Pol* pol; int count;
    __device__ __forceinline__ void dma(unsigned lds0, int j, int slot, int wid, int lane) const { dma_tile<DQ, SLOT, SLOTV>(lds0, Kg, kpitch, Vg, vpitch, pol->key0(j), slot, wid, lane); }
};
template <int DQ, bool SLOT = false, bool SLOTV = SLOT, class Pol, class Next>
__device__ __forceinline__ void flash_loop(LAS unsigned char* L, const bf16_t* Kg, int kpitch, const bf16_t* Vg, int vpitch, const bf16x8* qr, const Pol& pol, int s0, int npre, const Next& next,
                                           f32x16 (&o)[2], float& l_out, int wid, int lane) {
    const int r32 = lane & 31, hi = lane >> 5;
    const unsigned lds0 = (unsigned)(uintptr_t)L;
    LAS float* wsf = (LAS float*)(L + L_WSF) + wid * 128;
    lcp vp0 = L + L_V + ((lane >> 4) & 1) * 32 + (lane & 3) * 8 + (4 * hi + ((lane & 15) >> 2)) * 64;
    float mhat = 0.f, l = 0.f;
    f32x16 negm;
#pragma unroll
    for (int r = 0; r < 16; ++r) { o[0][r] = 0.f; o[1][r] = 0.f; negm[r] = 0.f; }
    const int n = pol.ntiles, ntot = n + next.count;
    int slot = s0, slot1 = (s0 + 1) % NSLOT, slot2 = (s0 + 2) % NSLOT;
    if (npre < 1) dma_tile<DQ, SLOT, SLOTV>(lds0, Kg, kpitch, Vg, vpitch, pol.key0(0), slot, wid, lane);
    if (npre < 2 && ntot > 1) { if (n > 1) dma_tile<DQ, SLOT, SLOTV>(lds0, Kg, kpitch, Vg, vpitch, pol.key0(1), slot1, wid, lane); else next.dma(lds0, 0, slot1, wid, lane); }
    for (int i = 0; i < n; ++i) {
        if (i + 1 < ntot) { if (DQ == 96 && wid < 4) asm volatile("s_waitcnt vmcnt(3) lgkmcnt(0)\n\ts_barrier" ::: "memory"); else asm volatile("s_waitcnt vmcnt(2) lgkmcnt(0)\n\ts_barrier" ::: "memory"); }
        else ATT_BAR();
        if (i + 2 < ntot) { if (i + 2 < n) dma_tile<DQ, SLOT, SLOTV>(lds0, Kg, kpitch, Vg, vpitch, pol.key0(i + 2), slot2, wid, lane); else next.dma(lds0, i + 2 - n, slot2, wid, lane); }
        if (pol.active(i)) {
            f32x16 p0, p1;
            qkt<DQ>(p0, p1, L + L_K + slot * KSLOT, qr, negm, r32, hi);
            bf16x8 vf[8]; vload_half(vf, vp0 + slot * VSLOT, 0);
            pol.fix(p0, p1, i);
            asm volatile("s_nop 15\n\ts_nop 7" : "+v"(p0), "+v"(p1));
            const float rm = swap_max(max32(p0, p1), lane);
            const bool first = (i == 0);
            if (first || __any(rm > THR)) {
                float dl = first ? rm : __builtin_fmaxf(rm, 0.f);
                if (dl == -INFINITY) dl = 0.f;
                mhat += dl;
#pragma unroll
                for (int r = 0; r < 16; ++r) { p0[r] -= dl; p1[r] -= dl; negm[r] = -mhat; }
                if (!first) {
                    const float f = __builtin_amdgcn_exp2f(-dl); l *= f;
                    if (hi == 0) wsf[r32] = f;
#pragma unroll
                    for (int r = 0; r < 16; ++r) { const float fr_ = wsf[crow(r, hi)]; o[0][r] *= fr_; o[1][r] *= fr_; }
                }
            }
#pragma unroll
            for (int r = 0; r < 16; ++r) { p0[r] = __builtin_amdgcn_exp2f(p0[r]); p1[r] = __builtin_amdgcn_exp2f(p1[r]); }
            vload_half(vf, vp0 + slot * VSLOT, 1);
            l += sum16(p0) + sum16(p1);
            pv_mma(o, vf, p0, p1);
        }
        slot = slot1; slot1 = slot2; slot2 = (slot2 == NSLOT - 1) ? 0 : slot2 + 1;
    }
    ATT_LBAR();
    l_out = swap_sum(l, lane);
}

__device__ __forceinline__ void acc_scaled(f32x16 (&oc)[2], const f32x16 (&o)[2], float rowscale, LAS float* wsf, int r32, int hi) {
    if (hi == 0) wsf[32 + r32] = rowscale;
#pragma unroll
    for (int r = 0; r < 16; ++r) { const float s = wsf[32 + crow(r, hi)]; oc[0][r] += s * o[0][r]; oc[1][r] += s * o[1][r]; }
}
__device__ __forceinline__ void park_store(const f32x16 (&oc)[2], LAS float* park, int lane) {
#pragma unroll
    for (int d0 = 0; d0 < 2; ++d0)
#pragma unroll
        for (int r = 0; r < 16; ++r) park[(d0 * 16 + r) * 64 + lane] = oc[d0][r];
}
template <bool FINAL> __device__ __forceinline__ void park_acc(f32x16 (&oc)[2], LAS float* park, const f32x16 (&o)[2], float rowscale, LAS float* wsf, int lane) {
    const int r32 = lane & 31, hi = lane >> 5;
    if (hi == 0) wsf[32 + r32] = rowscale;
#pragma unroll
    for (int r = 0; r < 16; ++r) { const float s = wsf[32 + crow(r, hi)];
#pragma unroll
        for (int d0 = 0; d0 < 2; ++d0) { const float v = park[(d0 * 16 + r) * 64 + lane] + s * o[d0][r]; if (FINAL) oc[d0][r] = v; else park[(d0 * 16 + r) * 64 + lane] = v; } }
}
__device__ __forceinline__ void store_tile(const f32x16 (&oc)[2], bf16_t* dst, int pitch, LAS unsigned char* L, int wid, int lane, float* ssq) {
    const int r32 = lane & 31, hi = lane >> 5;
    LAS bf16_t* stg = (LAS bf16_t*)(L + L_OST + wid * 8192);
#pragma unroll
    for (int r = 0; r < 16; ++r) { const int orow = crow(r, hi);
#pragma unroll
        for (int d0 = 0; d0 < 2; ++d0) stg[orow * 64 + d0 * 32 + r32] = (bf16_t)f2bf(oc[d0][r]); }
    asm volatile("s_waitcnt lgkmcnt(0)" ::: "memory");
#pragma unroll
    for (int i = 0; i < 4; ++i) { const int row = i * 8 + (lane >> 3), ch = lane & 7; const u32x4 v = *(const LAS u32x4*)(stg + row * 64 + ch * 8); *(u32x4*)(dst + (size_t)row * pitch + ch * 8) = v;
        float ss = sq8(__builtin_bit_cast(bf16x8, v)); ss += lane_xor(ss, lane, 1); ss += lane_xor(ss, lane, 2); ss += lane_xor(ss, lane, 4);
        if (ch == 0) __hip_atomic_fetch_add(ssq + 2 * row, ss, __ATOMIC_RELAXED, __HIP_MEMORY_SCOPE_AGENT); }
    asm volatile("s_waitcnt lgkmcnt(0)" ::: "memory");
}

#define PIN16(v) asm volatile("" : "+v"(v[0]), "+v"(v[1]), "+v"(v[2]), "+v"(v[3]), "+v"(v[4]), "+v"(v[5]), "+v"(v[6]), "+v"(v[7]), "+v"(v[8]), "+v"(v[9]), "+v"(v[10]), "+v"(v[11]), "+v"(v[12]), "+v"(v[13]), "+v"(v[14]), "+v"(v[15]))
__device__ __forceinline__ int clamp127(int d) { return d < 0 ? 0 : (d < 127 ? d : 127); }
struct PolMla { int ntiles, qw0, r32, hi;
    __device__ __forceinline__ int key0(int i) const { return 64 * i; }
    __device__ __forceinline__ bool active(int i) const { return 64 * i <= qw0 + 31; }
    __device__ __forceinline__ int nact() const { const int a = (qw0 + 31) / 64 + 1; return a < ntiles ? a : ntiles; }
    __device__ __forceinline__ void fix(f32x16& p0, f32x16& p1, int i) const {
        if (64 * i + 63 > qw0) { const int q = qw0 + r32, kb = 64 * i + 4 * hi;
#pragma unroll
            for (int r = 0; r < 16; ++r) { const int kv = kb + (r & 3) + 8 * (r >> 2); if (kv > q) p0[r] = -INFINITY; if (kv + 32 > q) p1[r] = -INFINITY; } }
    }
};
struct PolSel { int ntiles, qc, q, hi; unsigned selm; const LAS float* tbh;
    __device__ __forceinline__ int key0(int i) const { return 64 * (qc - i); }
    __device__ __forceinline__ bool active(int i) const { return __any((selm >> (qc - i)) & 1u) != 0; }
    __device__ __forceinline__ int nact() const { return ntiles; }
    __device__ __forceinline__ void fix(f32x16& p0, f32x16& p1, int i) const {
        const bool bit = ((selm >> (qc - i)) & 1u) != 0u;
        if (i <= 2) { const int kb = 64 * (qc - i) + 4 * hi; float bv0[16], bv1[16];
#pragma unroll
            for (int r = 0; r < 16; ++r) { const int d0 = q - (kb + (r & 3) + 8 * (r >> 2)); bv0[r] = tbh[clamp127(d0)]; bv1[r] = tbh[clamp127(d0 - 32)]; }
            PIN16(bv0); PIN16(bv1);
#pragma unroll
            for (int r = 0; r < 16; ++r) { const int d0 = q - (kb + (r & 3) + 8 * (r >> 2)), d1 = d0 - 32;
                p0[r] = (d0 < 0) ? -INFINITY : p0[r] + bv0[r]; p1[r] = (d1 < 0) ? -INFINITY : p1[r] + bv1[r]; } }
        if (!bit) {
#pragma unroll
            for (int r = 0; r < 16; ++r) { p0[r] = -INFINITY; p1[r] = -INFINITY; } }
    }
};
struct PolWin { int ntiles, qc, q, hi; const LAS float* tbh;
    __device__ __forceinline__ int key0(int i) const { return 64 * (qc - i); }
    __device__ __forceinline__ bool active(int) const { return true; }
    __device__ __forceinline__ int nact() const { return ntiles; }
    __device__ __forceinline__ void fix(f32x16& p0, f32x16& p1, int i) const {
        if (i <= 2) { const int kb = 64 * (qc - i) + 4 * hi; float bv0[16], bv1[16];
#pragma unroll
            for (int r = 0; r < 16; ++r) { const int d0 = q - (kb + (r & 3) + 8 * (r >> 2)); bv0[r] = tbh[clamp127(d0)]; bv1[r] = tbh[clamp127(d0 - 32)]; }
            PIN16(bv0); PIN16(bv1);
#pragma unroll
            for (int r = 0; r < 16; ++r) { const int d0 = q - (kb + (r & 3) + 8 * (r >> 2)), d1 = d0 - 32;
                p0[r] = (d0 < 0) ? -INFINITY : p0[r] + bv0[r]; p1[r] = (d1 < 0) ? -INFINITY : p1[r] + bv1[r]; } }
        else if (i == 8) { const int kb = 64 * (qc - i) + 4 * hi;
#pragma unroll
            for (int r = 0; r < 16; ++r) { const int d0 = q - (kb + (r & 3) + 8 * (r >> 2)), d1 = d0 - 32; if (d0 >= 512) p0[r] = -INFINITY; if (d1 >= 512) p1[r] = -INFINITY; } }
    }
};

__device__ __forceinline__ void mla_unit(unsigned char* ws, LAS unsigned char* L, int b, int h, int qb, int wv, int s0, int npre, int nnext) {
    const int tid = opaque_tid(wv), lane = tid & 63, wid = __builtin_amdgcn_readfirstlane(tid >> 6);
    const int r32 = lane & 31, hi = lane >> 5;
    const size_t rowbase = (size_t)b * SEQ; const int qw0 = 256 * qb + 32 * wid;
    bf16x8 qr[6];
    { const bf16_t* Qw = (const bf16_t*)(ws + WS_QM) + (rowbase + qw0 + r32) * MQ + 96 * h + 8 * hi;
      bf16x8 raw[6]; float ss = 0.f;
#pragma unroll
      for (int d0 = 0; d0 < 6; ++d0) { raw[d0] = *(const bf16x8*)(Qw + 16 * d0); ss += sq8(raw[d0]); }
      ss += lane_xor(ss, lane, 32);
      const float rstd = QS_MLA / sqrtf(ss * (1.f / 96) + EPS);
      const float* qg = inptr(7) + 8 * hi;
#pragma unroll
      for (int d0 = 0; d0 < 4; ++d0) qr[d0] = __builtin_bit_cast(bf16x8, scale8(raw[d0], rstd, *(const f32x4*)(qg + 16 * d0), *(const f32x4*)(qg + 16 * d0 + 4)));
      float o1[8], o2[8]; const float posf = (float)(qw0 + r32);
#pragma unroll
      for (int j = 0; j < 8; ++j) { const int i = 8 * hi + j; const float inv = exp2f(-(float)i * (13.287712379549449f / 16.f)); float sn, cs; sincosf(posf * inv, &sn, &cs);
          const float n1 = bf2f((unsigned short)raw[4][j]) * rstd * qg[64 + j], n2 = bf2f((unsigned short)raw[5][j]) * rstd * qg[80 + j];
          o1[j] = n1 * cs - n2 * sn; o2[j] = n2 * cs + n1 * sn; }
      u32x4 w4, w5; w4.x = pk2(o1[0], o1[1]); w4.y = pk2(o1[2], o1[3]); w4.z = pk2(o1[4], o1[5]); w4.w = pk2(o1[6], o1[7]);
      w5.x = pk2(o2[0], o2[1]); w5.y = pk2(o2[2], o2[3]); w5.z = pk2(o2[4], o2[5]); w5.w = pk2(o2[6], o2[7]);
      qr[4] = __builtin_bit_cast(bf16x8, w4); qr[5] = __builtin_bit_cast(bf16x8, w5); }
    const bf16_t* Kg = (const bf16_t*)(ws + WS_KMLA) + rowbase * MQ + 96 * h;
    const bf16_t* Vg = (const bf16_t*)(ws + WS_KVM) + rowbase * MKV + slot_base(4 * (h >> 1) + 2 + (h & 1));
    PolMla pol{4 * qb + 4, qw0, r32, hi};
    f32x16 o[2]; float l;
    const NextTiles<96, false, true, PolMla> nxt{Kg, MQ, Vg, MKV, &pol, nnext};
    flash_loop<96, false, true>(L, Kg, MQ, Vg, MKV, qr, pol, s0, npre, nxt, o, l, wid, lane);
    LAS float* wsf = (LAS float*)(L + L_WSF) + wid * 128;
    f32x16 oc[2];
#pragma unroll
    for (int r = 0; r < 16; ++r) { oc[0][r] = 0.f; oc[1][r] = 0.f; }
    acc_scaled(oc, o, (l > 0.f) ? 1.f / l : 0.f, wsf, r32, hi);
    store_tile(oc, (bf16_t*)(ws + WS_MIX) + (rowbase + qw0) * DM + 64 * h, DM, L, wid, lane, (float*)(ws + WS_SSQM) + 2 * (rowbase + qw0));
}

__device__ __forceinline__ void nsa_unit(unsigned char* ws, LAS unsigned char* L, int b, int g, int qc, int wv) {
#define NSA_IDS() const int tid = opaque_tid(wv), lane = tid & 63, wid = __builtin_amdgcn_readfirstlane(tid >> 6); \
    const int r32 = lane & 31, hi = lane >> 5, rh = wid & 3, qh = wid >> 2, h = 4 * g + rh, qloc = 32 * qh + r32, q = q0 + qloc; \
    const unsigned lds0 = (unsigned)(uintptr_t)L; LAS float* wsf = (LAS float*)(L + L_WSF) + wid * 128; const LAS float* tbh = (const LAS float*)(L + L_TB) + h * 128; \
    LAS float* gate = (LAS float*)(L + L_GATE); (void)tid; (void)lane; (void)r32; (void)hi; (void)rh; (void)qh; (void)h; (void)qloc; (void)q; (void)lds0; (void)wsf; (void)tbh; (void)gate
    const size_t rowbase = (size_t)b * SEQ; const int q0 = 64 * qc;
    const bf16_t* pr = (const bf16_t*)(ws + WS_PROJ);
    bf16x8 qr[4];
    {
    NSA_IDS();
    { const bf16_t* Kc = (const bf16_t*)(ws + WS_KCMP) + ((size_t)b * 256 + g) * 64; const bf16_t* Vc = (const bf16_t*)(ws + WS_VCMP) + ((size_t)b * 256 + g) * 64;
      dma_tile<64>(lds0, Kc, 128, Vc, 128, 0, 0, wid, lane);
      dma_tile<64>(lds0, Kc, 128, Vc, 128, 64, 1, wid, lane);
      dma_tile<64, true>(lds0, pr + rowbase * DINP + slot_base(S_KSEL + g), DINP, pr + rowbase * DINP + slot_base(S_VSEL + g), DINP, 64 * qc, 2, wid, lane); }
    for (int i = tid; i < 768; i += 512) { const int br = i >> 8, r = (i >> 6) & 3, qq = i & 63;
        const float x = bf2f(pr[(rowbase + q0 + qq) * DINP + P_GATE + 8 * br + 4 * g + r]); gate[i] = 1.f / (1.f + __expf(-x)); }
    { const bf16_t* Qw = pr + (rowbase + q) * DINP + slot_base(S_Q + h) + 8 * hi;
#pragma unroll
      for (int d0 = 0; d0 < 4; ++d0) qr[d0] = *(const bf16x8*)(Qw + 128 * (d0 >> 1) + 16 * (d0 & 1)); }
    }
    f32x16 oc[2];
    {
        NSA_IDS();
        ATT_BAR();
        lcp vp0 = L + L_V + ((lane >> 4) & 1) * 32 + (lane & 3) * 8 + (4 * hi + ((lane & 15) >> 2)) * 64;
        LAS float* imp = (LAS float*)(L + L_IMP) + (rh * 64 + qloc) * IMPS;
        f32x16 a0, a1, b0, b1;
        { f32x16 zero;
#pragma unroll
          for (int r = 0; r < 16; ++r) zero[r] = 0.f;
          qkt<64>(a0, a1, L + L_K, qr, zero, r32, hi); qkt<64>(b0, b1, L + L_K + KSLOT, qr, zero, r32, hi); }
#define CMP_FIX(P, coff, extra) do { float bv[16]; \
            _Pragma("unroll") for (int r = 0; r < 16; ++r) bv[r] = tbh[clamp127(q - 16 * (crow(r, hi) + (coff)) - 31)]; \
            PIN16(bv); \
            _Pragma("unroll") for (int r = 0; r < 16; ++r) { const int c = crow(r, hi) + (coff); const int d = q - 16 * c - 31; P[r] = (d < 0 || (extra && c >= NCMP)) ? -INFINITY : P[r] + bv[r]; } } while (0)
        CMP_FIX(a0, 0, false); CMP_FIX(a1, 32, false); CMP_FIX(b0, 64, false); CMP_FIX(b1, 96, true);
#undef CMP_FIX
        float m = swap_max(__builtin_fmaxf(__builtin_fmaxf(max16(a0), max16(a1)), __builtin_fmaxf(max16(b0), max16(b1))), lane);
        if (m == -INFINITY) m = 0.f;
#pragma unroll
        for (int r = 0; r < 16; ++r) { a0[r] = __builtin_amdgcn_exp2f(a0[r] - m); a1[r] = __builtin_amdgcn_exp2f(a1[r] - m); b0[r] = __builtin_amdgcn_exp2f(b0[r] - m); b1[r] = __builtin_amdgcn_exp2f(b1[r] - m); }
        const float lsum = swap_sum((sum16(a0) + sum16(a1)) + (sum16(b0) + sum16(b1)), lane);
        const float inv = (lsum > 0.f) ? 1.f / lsum : 0.f;
        float prev_last = 0.f;
#define CMP_IMP(T, P0, P1) do { float own[8], car[8]; \
            _Pragma("unroll") for (int a = 0; a < 4; ++a) { \
                own[a]     = P0[4 * a] + P0[4 * a + 1] + P0[4 * a + 2] + 0.5f * P0[4 * a + 3]; car[a]     = 0.5f * P0[4 * a + 3]; \
                own[4 + a] = P1[4 * a] + P1[4 * a + 1] + P1[4 * a + 2] + 0.5f * P1[4 * a + 3]; car[4 + a] = 0.5f * P1[4 * a + 3]; } \
            _Pragma("unroll") for (int k = 0; k < 8; ++k) car[k] = lane_xor(car[k], lane, 32); \
            _Pragma("unroll") for (int k = 0; k < 8; ++k) { const float add = hi ? car[k] : (k >= 1 ? car[k - 1] : prev_last); imp[16 * (T) + 2 * k + hi] = own[k] + add; } \
            prev_last = car[7]; } while (0)
        CMP_IMP(0, a0, a1); CMP_IMP(1, b0, b1);
#undef CMP_IMP
        if (hi == 0) ((LAS float*)(L + L_INVL))[rh * 64 + qloc] = inv;
        f32x16 o[2];
#pragma unroll
        for (int r = 0; r < 16; ++r) { o[0][r] = 0.f; o[1][r] = 0.f; }
        pv(o, vp0, a0, a1); pv(o, vp0 + VSLOT, b0, b1);
        ATT_BAR();
        if (qc >= 1) dma_tile<64, true>(lds0, pr + rowbase * DINP + slot_base(S_KSEL + g), DINP, pr + rowbase * DINP + slot_base(S_VSEL + g), DINP, 64 * (qc - 1), 0, wid, lane);
#pragma unroll
        for (int r = 0; r < 16; ++r) { oc[0][r] = 0.f; oc[1][r] = 0.f; }
        acc_scaled(oc, o, gate[(0 * 4 + rh) * 64 + qloc] * inv, wsf, r32, hi);
    }
    if (qc <= 15) {
        const int tid = opaque_tid(wv);
        if (tid < 64) ((LAS unsigned*)(L + L_SELM))[tid] = (qc == 31) ? 0xffffffffu : ((2u << qc) - 1u);
        ATT_LBAR();
    } else {
        const int tid = opaque_tid(wv);
        const LAS float* imp = (const LAS float*)(L + L_IMP); LAS float* sc = (LAS float*)(L + L_SC);
        const int qq = tid >> 3, jj = tid & 7;
        const LAS float* il = (const LAS float*)(L + L_INVL);
        const float i0 = il[qq], i1 = il[64 + qq], i2 = il[128 + qq], i3 = il[192 + qq];
#pragma unroll
        for (int k = 0; k < 4; ++k) { const int j = jj + 8 * k;
            const float tot = (imp[(0 * 64 + qq) * IMPS + j] * i0 + imp[(1 * 64 + qq) * IMPS + j] * i1) + (imp[(2 * 64 + qq) * IMPS + j] * i2 + imp[(3 * 64 + qq) * IMPS + j] * i3);
            float s; if (j > qc) s = -INFINITY; else if (j == 0 || j == qc || j == qc - 1) s = 1e4f; else s = tot; sc[qq * IMPS + j] = s; }
        ATT_LBAR();
        float v[32];
#pragma unroll
        for (int k = 0; k < 32; ++k) v[k] = sc[qq * IMPS + k];
        unsigned bits = 0u;
#pragma unroll
        for (int k = 0; k < 4; ++k) { const int j = jj + 8 * k; const float me = sc[qq * IMPS + j]; int rank = 0;
#pragma unroll
            for (int i = 0; i < 32; ++i) { const float si = v[i]; rank += (si > me || (si == me && i < j)) ? 1 : 0; }
            if (rank < 16) bits |= 1u << j; }
        { const int lane = tid & 63; bits |= lane_xor_u(bits, lane, 1); bits |= lane_xor_u(bits, lane, 2); bits |= lane_xor_u(bits, lane, 4); }
        if (jj == 0) ((LAS unsigned*)(L + L_SELM))[qq] = bits;
        ATT_LBAR();
    }
    { NSA_IDS(); park_store(oc, (LAS float*)(L + L_OST) + wid * 2048, lane); }
    {
        NSA_IDS();
        const unsigned selm = ((const LAS unsigned*)(L + L_SELM))[qloc];
        const bf16_t* Kg = pr + rowbase * DINP + slot_base(S_KSEL + g);
        const bf16_t* Vg = pr + rowbase * DINP + slot_base(S_VSEL + g);
        PolSel pol{qc + 1, qc, q, hi, selm, tbh};
        const PolWin polw{(qc < 8 ? qc : 8) + 1, qc, q, hi, tbh};
        const NextTiles<64, true, true, PolWin> nxt{pr + rowbase * DINP + slot_base(S_KWIN + g), DINP, pr + rowbase * DINP + slot_base(S_VWIN + g), DINP, &polw, polw.ntiles < 2 ? polw.ntiles : 2};
        f32x16 o[2]; float l;
        flash_loop<64, true>(L, Kg, DINP, Vg, DINP, qr, pol, 2, (qc + 1 < 2) ? qc + 1 : 2, nxt, o, l, wid, lane);
        { f32x16 dummy[2]; park_acc<false>(dummy, (LAS float*)(L + L_OST) + wid * 2048, o, (l > 0.f) ? gate[(1 * 4 + rh) * 64 + qloc] / l : 0.f, wsf, lane); }
    }
    {
        NSA_IDS();
        const bf16_t* Kg = pr + rowbase * DINP + slot_base(S_KWIN + g);
        const bf16_t* Vg = pr + rowbase * DINP + slot_base(S_VWIN + g);
        PolWin pol{(qc < 8 ? qc : 8) + 1, qc, q, hi, tbh};
        f32x16 o[2]; float l;
        flash_loop<64, true>(L, Kg, DINP, Vg, DINP, qr, pol, (2 + qc + 1) % NSLOT, pol.ntiles < 2 ? pol.ntiles : 2, NoNext{}, o, l, wid, lane);
        f32x16 fin[2]; park_acc<true>(fin, (LAS float*)(L + L_OST) + wid * 2048, o, (l > 0.f) ? gate[(2 * 4 + rh) * 64 + qloc] / l : 0.f, wsf, lane);
        store_tile(fin, (bf16_t*)(ws + WS_MIX) + (rowbase + q0 + 32 * qh) * DM + 512 + 64 * h, DM, L, wid, lane, (float*)(ws + WS_SSQM) + 2 * (rowbase + q0 + 32 * qh) + 1);
    }
    ATT_BAR();
}
#undef ATT_BAR
#undef ATT_LBAR
#undef NSA_IDS
}

#define XB_TMO      128
#define XB_XCNT(j)  (256  + 64 * (j))
#define XB_XSUB(j)  (1280 + 64 * (j))
#define XB_XGEN(j)  (2304 + 64 * (j))
#define XB_TOP      3328
#define XB_TOPGEN   3392
#define XCD_BAR_WORDS 3456
#define XB_SPIN_CAP (1u << 18)

__device__ __forceinline__ unsigned xb_ld(unsigned* p)              { return __hip_atomic_load(p, __ATOMIC_RELAXED, __HIP_MEMORY_SCOPE_AGENT); }
__device__ __forceinline__ unsigned xb_add(unsigned* p, unsigned v) { return __hip_atomic_fetch_add(p, v, __ATOMIC_RELAXED, __HIP_MEMORY_SCOPE_AGENT); }
__device__ __forceinline__ unsigned xb_xcc_id() { return (unsigned)__builtin_amdgcn_s_getreg((3 << 11) | 20) & 0xFu; }
#define XB_SPIN(cond, bar) do { unsigned _sp = 0; while (cond) { __builtin_amdgcn_s_sleep(1); \
    if ((++_sp & 255u) == 0u) { if (xb_ld(&(bar)[XB_TMO])) break; if (_sp > XB_SPIN_CAP) { atomicAdd(&(bar)[XB_TMO], 1u); break; } } } } while (0)

struct XcdBarrier {
    unsigned* bar; unsigned x;
    volatile LAS unsigned* st;
};

__device__ __forceinline__ XcdBarrier xcd_barrier_post(unsigned* bar, volatile LAS unsigned* st) {
    XcdBarrier b; b.bar = bar; b.x = xb_xcc_id(); b.st = st;
    if (threadIdx.x == 0) (void)xb_add(&bar[XB_XCNT(b.x)], 1u);
    return b;
}
__device__ __forceinline__ void xcd_barrier_complete(unsigned* bar, unsigned x, unsigned& nloc, unsigned& nx) {
    const unsigned G = gridDim.x * gridDim.y * gridDim.z;
    unsigned sum, cnt, mine, sp = 0u;
    for (;;) {
        sum = 0u; cnt = 0u; mine = 0u;
#pragma unroll
        for (unsigned j = 0; j < 16; ++j) { const unsigned c = xb_ld(&bar[XB_XCNT(j)]); sum += c; cnt += (c > 0u) ? 1u : 0u; mine = (j == x) ? c : mine; }
        if (sum == G) break;
        __builtin_amdgcn_s_sleep(1);
        if ((++sp & 255u) == 0u) { if (xb_ld(&bar[XB_TMO])) break; if (sp > XB_SPIN_CAP) { atomicAdd(&bar[XB_TMO], 1u); break; } }
    }
    nloc = mine > 0u ? mine : 1u; nx = cnt > 0u ? cnt : 1u;
}

__device__ __forceinline__ void xcd_barrier(const XcdBarrier& b, const unsigned char* pf = nullptr, int nchunk = 0, int wv = 0) {
    asm volatile("s_waitcnt vmcnt(0)" ::: "memory");
    __syncthreads();
    if (pf != nullptr && wv >= 1 && wv <= 4) {
        const int t = opaque_tid(wv) - 64;
        const pg8::u32x4* src = (const pg8::u32x4*)pf + (size_t)(blockIdx.x & 255) * nchunk;
        pg8::u32x4 v[9];
#pragma unroll
        for (int i = 0; i < 9; ++i) { int c = i * 256 + t; c = c < nchunk ? c : nchunk - 1; v[i] = src[c]; }
        asm volatile("" :: "v"(v[0]), "v"(v[1]), "v"(v[2]), "v"(v[3]), "v"(v[4]), "v"(v[5]), "v"(v[6]), "v"(v[7]), "v"(v[8]));
    }
    if (threadIdx.x == 0) {
        unsigned* bar = b.bar;
        __builtin_amdgcn_s_waitcnt(0);
        unsigned nloc = b.st[0], nx = b.st[1];
        if (nloc == 0u) { xcd_barrier_complete(bar, b.x, nloc, nx); b.st[0] = nloc; b.st[1] = nx; }
        const unsigned old = xb_add(&bar[XB_XSUB(b.x)], 1u);
        const unsigned gen = old / nloc;
        if (old + 1u == (gen + 1u) * nloc) {
            __builtin_amdgcn_fence(__ATOMIC_RELEASE, "agent");
            asm volatile("s_waitcnt vmcnt(0)" ::: "memory");
            const unsigned og = xb_add(&bar[XB_TOP], 1u);
            const unsigned tg = og / nx;
            if (og + 1u == (tg + 1u) * nx) xb_add(&bar[XB_TOPGEN], 1u);
            else XB_SPIN(xb_ld(&bar[XB_TOPGEN]) == tg, bar);
            __builtin_amdgcn_fence(__ATOMIC_ACQUIRE, "agent");
            xb_add(&bar[XB_XGEN(b.x)], 1u);
            asm volatile("s_waitcnt vmcnt(0)" ::: "memory");
        } else {
            XB_SPIN(xb_ld(&bar[XB_XGEN(b.x)]) == gen, bar);
            __builtin_amdgcn_fence(__ATOMIC_ACQUIRE, "agent");
            asm volatile("s_waitcnt vmcnt(0)" ::: "memory");
        }
    }
    __syncthreads();
}

__global__ void __launch_bounds__(512, 2) mega(Params p) {
    extern __shared__ __attribute__((aligned(16))) unsigned char lds[];
    const int G = gridDim.x, bid = blockIdx.x, NGW = G * NW;
    int wv = __builtin_amdgcn_readfirstlane((int)(threadIdx.x >> 6)); asm volatile("" : "+s"(wv));
#define PHASE_IDS() const int tid = opaque_tid(wv), lane = tid & 63, wave = __builtin_amdgcn_readfirstlane(tid >> 6), gw = bid * NW + wave; (void)tid; (void)lane; (void)gw
    unsigned char* ws = (unsigned char*)inptr(22);
    LAS unsigned char* L = (LAS unsigned char*)lds;
    volatile LAS unsigned* bst = (volatile LAS unsigned*)(L + LDS_BST);
    if (threadIdx.x < 4) bst[threadIdx.x] = 0u;
    __syncthreads();
    const XcdBarrier bar = xcd_barrier_post((unsigned*)(ws + WS_CTL), bst);

    {
        PHASE_IDS();
        LAS float* scr = (LAS float*)(L + wave * 8704);
        constexpr int I0 = (1024 / 64) * (DINP / 32), I1 = (QR / 64) * (MQ / 32), I2 = (KVR / 64) * (MKV / 32), I3 = 16 * 32, I4 = 16 * (FF / 32), I5 = (FF / 64) * 32;
        constexpr int I6 = (2048 / 64) * (128 / 32), I7 = (128 / 64) * (64 / 32);
        constexpr int NIT = I0 + I1 + I2 + I3 + I4 + I5 + 2 * I6 + 2 * I7;
        for (int it = gw; it < NIT; it += NGW) {
            int r = it;
            if (r < I0) { p0_transpose_item(inptr(2), 1024, DIN, DINP, (bf16_t*)(ws + WS_WIN), scr, r, lane, inptr(1), 0, 1); continue; } r -= I0;
            if (r < I1) { p0_transpose_item(inptr(5), QR, MQ, MQ, (bf16_t*)(ws + WS_WUQ), scr, r, lane, inptr(3)); continue; } r -= I1;
            if (r < I2) { p0_transpose_item(inptr(6), KVR, MKV, MKV, (bf16_t*)(ws + WS_WUKV), scr, r, lane, inptr(4), 0, 2); continue; } r -= I2;
            if (r < I3) { const int k0_ = 64 * (r / 32); p0_transpose_item(inptr(17), 1024, 1024, 1024, (bf16_t*)(ws + WS_WO), scr, r, lane, k0_ < 512 ? inptr(15) : inptr(16) - 512); continue; } r -= I3;
            if (r < I4) { p0_transpose_item(inptr(19), 1024, FF, FF, (bf16_t*)(ws + WS_WUP), scr, r, lane, inptr(18)); continue; } r -= I4;
            if (r < I5) { p0_transpose_item(inptr(20), FF, 1024, 1024, (bf16_t*)(ws + WS_WDN), scr, r, lane, nullptr, LDH); continue; } r -= I5;
            if (r < 2 * I6) { const int kv = r / I6; p0_transpose_item(inptr(12) + (size_t)kv * 2048 * 128, 2048, 128, 128, (bf16_t*)(ws + WS_W1T) + (size_t)kv * 128 * 2048, scr, r % I6, lane); continue; } r -= 2 * I6;
            { const int kv = r / I7; p0_transpose_item(inptr(13) + kv * 128 * 64, 128, 64, 64, (bf16_t*)(ws + WS_W2T) + kv * 64 * 128, scr, r % I7, lane); }
        }
        for (int m = gw; m < M; m += 4 * NGW) rows_to_bf16_rstd<4>(inptr(0), (bf16_t*)(ws + WS_XB), (float*)(ws + WS_RS1), m, NGW, lane);
        for (int e = bid * 512 + tid; e < 2048 * 16; e += G * 512) { const int pos = e >> 4, i = e & 15; const float inv = exp2f(-(float)i * (13.287712379549449f / 16.f)); float sn, cs; sincosf((float)pos * inv, &sn, &cs);
            ((float*)(ws + WS_ROPE))[pos * 32 + i] = cs; ((float*)(ws + WS_ROPE))[pos * 32 + 16 + i] = sn; }
        for (int m = bid * 512 + tid; m < M; m += G * 512) { ((float*)(ws + WS_SSQ2))[m] = 0.f; ((float*)(ws + WS_RSQ))[m] = 0.f; ((float*)(ws + WS_RSKV))[m] = 0.f; ((float*)(ws + WS_SSQKR))[m] = 0.f; ((float*)(ws + WS_SSQM))[2 * m] = 0.f; ((float*)(ws + WS_SSQM))[2 * m + 1] = 0.f; }
    }
    xcd_barrier(bar);
    { pg8::Gemm g{(const bf16_t*)(ws + WS_XB), (const bf16_t*)(ws + WS_WIN), M, DINP, DM, DM, DM}; pg8::StaticOrder S; S.init(M, DINP, G, bid);
      PEpiProj E{(bf16_t*)(ws + WS_PROJ), DINP, (const float*)(ws + WS_RS1), (float*)(ws + WS_RSQ), (float*)(ws + WS_RSKV), (float*)(ws + WS_SSQKR), inptr(9), inptr(10), (const float*)(ws + WS_ROPE), inptr(8)}; pg8::gemm_phase<PEpiProj, pg8::StaticOrder, true, true>(L, g, S, E, wv); }
    xcd_barrier(bar);
    { PHASE_IDS();
      __syncthreads();
      for (int t = bid; t < 256; t += G) compress_block(ws, L, t, wv); }
    { pg8::Gemm g{(const bf16_t*)(ws + WS_PROJ) + P_HKV, (const bf16_t*)(ws + WS_WUKV), M, MKV, KVR, DINP, KVR}; pg8::StaticOrder S; S.init(M, MKV, G, bid);
      PEpiKV E{(bf16_t*)(ws + WS_KVM), (bf16_t*)(ws + WS_KMLA), (const bf16_t*)(ws + WS_PROJ), (const float*)(ws + WS_RSKV), (const float*)(ws + WS_SSQKR), (const float*)(ws + WS_ROPE), inptr(8)}; pg8::gemm_phase<PEpiKV, pg8::StaticOrder, true, true>(L, g, S, E, wv); }
    asm volatile("" : "+s"(wv));
    { pg8::Gemm g{(const bf16_t*)(ws + WS_PROJ) + P_HQ, (const bf16_t*)(ws + WS_WUQ), M, MQ, QR, DINP, QR}; pg8::StaticOrder S; S.init(M, MQ, G, bid);
      PEpiBf16<0> E{(bf16_t*)(ws + WS_QM), MQ, (const float*)(ws + WS_RSQ), 1.f / QR}; pg8::gemm_phase<PEpiBf16<0>, pg8::StaticOrder, true, false>(L, g, S, E, wv); }
    xcd_barrier(bar);
    {
        PHASE_IDS();
        LAS float* tb = (LAS float*)L;
        for (int i = tid; i < 8 * 128; i += 512) { const int h = i >> 7, n = i & 127; tb[i] = (inptr(14)[t5_bucket(n) * 8 + h] - inptr(14)[31 * 8 + h]) * LOG2E; }
        __syncthreads();
        const int vcu = (G % 8 == 0) ? (bid % 8) * (G / 8) + bid / 8 : bid;
        for (int pr_ = vcu; pr_ < 256; pr_ += G) {
            { const int bg = pr_ >> 4, s_ = pr_ & 15;
#pragma unroll 1
              for (int u_ = 0; u_ < 2; ++u_) att::nsa_unit(ws, L, bg >> 1, bg & 1, (u_ & 1) ? s_ : 31 - s_, wv);
            }
            { const int bh = pr_ >> 2, s_ = pr_ & 3;
#pragma unroll 1
              for (int u_ = 0; u_ < 2; ++u_) att::mla_unit(ws, L, bh >> 3, bh & 7, u_ ? s_ : 7 - s_, wv, u_ ? (4 * (7 - s_) + 4) % att::NSLOT : 0, u_ ? 2 : 0, u_ ? 0 : 2);
            }
        }
    }
    xcd_barrier(bar, ws + WS_WO, (int)((size_t)DM * DM * 2 / 16 / 256), wv);
    { pg8::Gemm g{(const bf16_t*)(ws + WS_MIX), (const bf16_t*)(ws + WS_WO), M, DM, DM, DM, DM}; pg8::StaticOrder S; S.init(M, DM, G, bid);
      PEpiWo E{(const bf16_t*)(ws + WS_XB), (bf16_t*)(ws + WS_H2), (float*)(ws + WS_SSQ2), (const float*)(ws + WS_SSQM), DM}; pg8::gemm_phase<PEpiWo, pg8::StaticOrder, true, true>(L, g, S, E, wv); }
    xcd_barrier(bar, ws + WS_WUP, (int)((size_t)FF * DM * 2 / 16 / 256), wv);
    { pg8::Gemm g{(const bf16_t*)(ws + WS_H2), (const bf16_t*)(ws + WS_WUP), M, FF, DM, DM, DM}; pg8::StaticOrder S; S.init(M, FF, G, bid);
      PEpiBf16<2> E{(bf16_t*)(ws + WS_HID), LDH, (const float*)(ws + WS_SSQ2), 1.f / 1024}; pg8::gemm_phase<PEpiBf16<2>, pg8::StaticOrder, true, true>(L, g, S, E, wv); }
    xcd_barrier(bar, ws + WS_WDN, (int)((size_t)DM * LDH * 2 / 16 / 256), wv);
    { pg8::Gemm g{(const bf16_t*)(ws + WS_HID), (const bf16_t*)(ws + WS_WDN), M, DM, FF, LDH, LDH}; pg8::StaticOrder S; S.init(M, DM, G, bid);
      PEpiDown E{(const bf16_t*)(ws + WS_H2), ((float*)inptr(21)), DM}; pg8::gemm_phase<PEpiDown, pg8::StaticOrder, true, true>(L, g, S, E, wv); }
}

extern "C" void kernel_launch(void* const* d_in, const int* in_sizes, int n_in, void* d_out, int out_size,
                              void* d_ws, size_t ws_size, hipStream_t stream) {
    static int grid_blocks = 0;
    if (!grid_blocks) {
        int dev = 0, cus = 0, per_cu = 0;
        (void)hipGetDevice(&dev);
        (void)hipDeviceGetAttribute(&cus, hipDeviceAttributeMultiprocessorCount, dev);
        (void)hipFuncSetAttribute((const void*)mega, hipFuncAttributeMaxDynamicSharedMemorySize, LDS_BYTES);
        (void)hipOccupancyMaxActiveBlocksPerMultiprocessor(&per_cu, (const void*)mega, 512, LDS_BYTES);
        if (per_cu != 1) fprintf(stderr, "note: occupancy query reports %d blocks/CU; launching 1 per CU\n", per_cu);
        grid_blocks = cus;
        if (n_in != 21 || out_size != M * DM || ws_size < 256 * MiB) fprintf(stderr, "unexpected shapes: n_in %d out %d ws %zu\n", n_in, out_size, ws_size);
    }
    Params p{};
    for (int i = 0; i < 21; ++i) p.in[i] = (const float*)d_in[i];
    p.out = (float*)d_out; p.ws = (unsigned char*)d_ws;
    if (hipMemsetAsync((char*)d_ws + WS_CTL, 0, CTL_ZERO_BYTES, stream) != hipSuccess) { fprintf(stderr, "memset of the barrier words failed\n"); return; }
    hipLaunchKernelGGL(mega, dim3(grid_blocks), dim3(512), LDS_BYTES, stream, p);
    hipError_t e = hipPeekAtLastError();
    if (e != hipSuccess) fprintf(stderr, "launch failed: %s (grid %d)\n", hipGetErrorString(e), grid_blocks);
}
```

```cpp
#include <hip/hip_runtime.h>
#include <cstdio>
#include <cstdint>

#define LAS __attribute__((address_space(3)))
typedef unsigned short bf16_t;
typedef short bf16x8 __attribute__((ext_vector_type(8)));
typedef float f32x4 __attribute__((ext_vector_type(4)));
typedef unsigned u32x4 __attribute__((ext_vector_type(4)));
typedef unsigned u32x2 __attribute__((ext_vector_type(2)));

constexpr int BATCH = 8, SEQ = 2048, DM = 1024, M = BATCH * SEQ;
constexpr int DIN = 1976, DINP = 2048;
constexpr int C_HQ = 0, C_HKV = 384, C_HKR = 640, C_QB = 672, C_KVB = 1184, C_GATE = 1952;
constexpr int C_KCMP = C_KVB, C_VCMP = C_KVB + 128, C_KSEL = C_KVB + 256, C_VSEL = C_KVB + 384, C_KWIN = C_KVB + 512, C_VWIN = C_KVB + 640;
constexpr int P_HQ = 1280, P_HKV = 1664, P_HKR = 1920, P_GATE = 1952;
__host__ __device__ constexpr int slot_base(int s) { return 256 * (s >> 2) + 32 * (s & 3); }
constexpr int S_Q = 0, S_KCMP = 8, S_VCMP = 10, S_KSEL = 12, S_VSEL = 14, S_KWIN = 16, S_VWIN = 18;
constexpr int QR = 384, KVR = 256, MQ = 768, MKV = 1024, FF = 4096;
constexpr int LDH = FF + 64;
constexpr int NCMP = 127;
constexpr float EPS = 1e-6f;
constexpr float LOG2E = 1.4426950408889634f;
constexpr float QS_MLA = 0.10206207261596577f * LOG2E;
constexpr float QS_NSA = 0.125f * LOG2E;

constexpr size_t MiB = 1u << 20;
constexpr size_t WS_CTL = 0, CTL_ZERO_BYTES = 65536;
constexpr size_t WS_WIN = 1 * MiB, WS_WUQ = 5 * MiB, WS_WUKV = 6 * MiB, WS_WO = 7 * MiB, WS_WUP = 9 * MiB, WS_WDN = 17 * MiB;
constexpr size_t WS_KCMP = 26 * MiB, WS_VCMP = 26 * MiB + 512 * 1024;
constexpr size_t WS_W1T = 30 * MiB;
constexpr size_t WS_W2T = 27 * MiB;
constexpr size_t WS_RSQ = 28 * MiB, WS_RSKV = 28 * MiB + 65536, WS_SSQ2 = 28 * MiB + 131072, WS_SSQM = 28 * MiB + 262144, WS_RS1 = 28 * MiB + 262144 + 131072;
constexpr size_t WS_SSQKR = 28 * MiB + 524288;
constexpr size_t WS_ROPE = 29 * MiB + 65536;
constexpr size_t WS_XB = 32 * MiB;
constexpr size_t WS_DUMMY0 = 0;
constexpr size_t WS_HB = 32 * MiB;
constexpr size_t WS_MIX = 64 * MiB;
constexpr size_t WS_PROJ = 96 * MiB;
constexpr size_t WS_QM = 160 * MiB;
constexpr size_t WS_KVM = 184 * MiB;
constexpr size_t WS_KMLA = 216 * MiB;
constexpr size_t WS_QN = 208 * MiB;
constexpr size_t WS_KSEL = 240 * MiB;
constexpr size_t WS_KWIN = 244 * MiB;
constexpr size_t WS_HQN = 232 * MiB;
constexpr size_t WS_HKVN = 244 * MiB;
constexpr size_t WS_H2 = 224 * MiB;
constexpr size_t WS_HID = 32 * MiB;

constexpr int LDS_BYTES = 155648, LDS_BST = 154624;
constexpr int NW = 8;

struct Params {
    const float* in[21];
    float* out;
    unsigned char* ws;
};

typedef const float* cfptr_t;
__device__ __forceinline__ const float* inptr(int i) {
    const __attribute__((address_space(4))) char* ka = (const __attribute__((address_space(4))) char*)__builtin_amdgcn_kernarg_segment_ptr();
    int off = i * 8; asm volatile("" : "+s"(off));
    return *(const __attribute__((address_space(4))) cfptr_t*)(ka + off);
}
template <class V> __device__ __forceinline__ void st16_wt(const void* sbase, unsigned voff, const V& v) { static_assert(sizeof(V) == 16, "16-byte vector"); asm volatile("global_store_dwordx4 %0, %1, %2 sc1\n\ts_nop 1" :: "v"(voff), "v"(v), "s"(sbase) : "memory"); }
__device__ __forceinline__ unsigned f2bf(float f) { unsigned u = __builtin_bit_cast(unsigned, f); return (u + 0x7fffu + ((u >> 16) & 1u)) >> 16; }
__device__ __forceinline__ float bf2f(unsigned b) { return __builtin_bit_cast(float, b << 16); }
__device__ __forceinline__ unsigned pk2(float lo, float hi) { return f2bf(lo) | (f2bf(hi) << 16); }
__device__ __forceinline__ float wave_sum(float v) {
#pragma unroll
    for (int o = 1; o < 64; o <<= 1) v += __shfl_xor(v, o);
    return v;
}
__device__ __forceinline__ int t5_bucket(int n) {
    if (n < 16) return n;
    int b = 16;
    b += (n >= 19); b += (n >= 21); b += (n >= 24); b += (n >= 27); b += (n >= 31); b += (n >= 35); b += (n >= 40); b += (n >= 46);
    b += (n >= 52); b += (n >= 59); b += (n >= 67); b += (n >= 77); b += (n >= 87); b += (n >= 99); b += (n >= 113);
    return b;
}

__device__ __forceinline__ void p0_transpose_item(const float* W, int K, int N, int Npad, bf16_t* WT, LAS float* scr, int item, int lane, const float* gk = nullptr, int ldw = 0, int projmap = 0) {
    const int nblk = Npad / 32, kb = item / nblk, nb = item % nblk, k0 = 64 * kb, n0 = 32 * nb;
    int nsrc = n0;
    if (projmap == 2) { const int pn_ = n0 >> 8, bj_ = (n0 >> 7) & 1, wc_ = (n0 >> 5) & 3; nsrc = (wc_ < 2 ? 128 * (2 * pn_ + wc_) : 128 * (2 * pn_ + wc_ - 2) + 64) + 32 * bj_; }
    else if (projmap) { if (n0 < 1280) { const int sl = 4 * (n0 >> 8) + ((n0 & 127) >> 5), e0 = 32 * ((n0 >> 7) & 1); nsrc = (sl < 8 ? C_QB + 64 * sl : C_KVB + 64 * (sl - 8)) + e0; }
                   else if (n0 < 1280 + 672) nsrc = n0 - 1280; else if (n0 == P_GATE) nsrc = C_GATE; else nsrc = N; }
    const int nn = nsrc + (lane & 31);
    float wv[32];
#pragma unroll
    for (int i = 0; i < 32; ++i) { const int kk = 2 * i + (lane >> 5); wv[i] = (nn < N) ? W[(size_t)(k0 + kk) * N + nn] : 0.f; }
#pragma unroll
    for (int i = 0; i < 32; ++i) { const int kk = 2 * i + (lane >> 5); const float gg = gk ? gk[k0 + kk] : 1.f; scr[kk * 33 + (lane & 31)] = wv[i] * gg; }
    asm volatile("s_waitcnt lgkmcnt(0)" ::: "memory");
    const int c = lane & 7;
#pragma unroll
    for (int j = 0; j < 4; ++j) { const int n = (lane >> 3) + 8 * j; const LAS float* s = scr + (8 * c) * 33 + n;
        u32x4 o; o.x = pk2(s[0 * 33], s[1 * 33]); o.y = pk2(s[2 * 33], s[3 * 33]); o.z = pk2(s[4 * 33], s[5 * 33]); o.w = pk2(s[6 * 33], s[7 * 33]);
        *(u32x4*)(WT + (size_t)(n0 + n) * (ldw ? ldw : K) + k0 + 8 * c) = o; }
    asm volatile("s_waitcnt lgkmcnt(0)" ::: "memory");
}
template <int NR>
__device__ __forceinline__ void rows_to_bf16_rstd(const float* x, bf16_t* o, float* rstd_out, int row0, int rstride, int lane) {
    f32x4 v[NR][4];
#pragma unroll
    for (int r = 0; r < NR; ++r) { const int rr = (row0 + r * rstride < M) ? row0 + r * rstride : row0; const f32x4* xr = (const f32x4*)(x + (size_t)rr * DM) + lane;
#pragma unroll
        for (int j = 0; j < 4; ++j) v[r][j] = xr[64 * j]; }
#pragma unroll
    for (int r = 0; r < NR; ++r) { if (row0 + r * rstride >= M) continue; float s = 0.f;
#pragma unroll
        for (int j = 0; j < 4; ++j) s += (v[r][j].x * v[r][j].x + v[r][j].y * v[r][j].y) + (v[r][j].z * v[r][j].z + v[r][j].w * v[r][j].w);
        s = wave_sum(s);
        if (lane == 0) rstd_out[row0 + r * rstride] = 1.f / sqrtf(s * (1.f / DM) + EPS);
        unsigned long long* o8 = (unsigned long long*)(o + (size_t)(row0 + r * rstride) * DM) + lane;
#pragma unroll
        for (int j = 0; j < 4; ++j) o8[64 * j] = (unsigned long long)pk2(v[r][j].x, v[r][j].y) | ((unsigned long long)pk2(v[r][j].z, v[r][j].w) << 32); }
}

__device__ __forceinline__ int opaque_tid(int wv) { int lane; asm volatile("v_mbcnt_lo_u32_b32 %0, -1, 0\n\tv_mbcnt_hi_u32_b32 %0, -1, %0" : "=v"(lane)); return (wv << 6) | lane; }
namespace pg8 {
#define PG8_LAS __attribute__((address_space(3)))
typedef unsigned short bf16_t;
typedef short bf16x8 __attribute__((ext_vector_type(8)));
typedef float f32x4 __attribute__((ext_vector_type(4)));
typedef unsigned u32x4 __attribute__((ext_vector_type(4)));
constexpr int BM = 256, BK = 64, HALF = 128, HTB = HALF * BK * 2  , STAGE_BYTES = 8 * HTB, NXCD = 8, WGM = 8;

__host__ __device__ __forceinline__ int lds_byte(int r, int c) { const int st = (r >> 4) * 2 + (c >> 5), rr = r & 15, cc = c & 31, ob = rr * 64 + cc * 2; return st * 1024 + (ob ^ (((ob >> 9) & 1) << 5)); }
__host__ __device__ __forceinline__ void stage_rc(int b, int& R, int& C) { const int st = b / 1024, sb = b % 1024, swz = sb ^ (((sb >> 9) & 1) << 5); R = (st >> 1) * 16 + swz / 64; C = (st & 1) * 32 + (swz % 64) / 2; }
__host__ __device__ __forceinline__ int perm32(int rho) { const int n = rho >> 4, i = rho & 15; return 8 * (i >> 2) + 4 * n + (i & 3); }

struct Unit { int pm, pn; };
struct Gemm { const bf16_t* A; const bf16_t* Bt; int M, N, K, lda, ldb; };

struct StaticOrder {
    int nM, nN, nwg, G, c;
    __host__ __device__ void init(int M, int N, int G_, int c_) { nM = M / BM; nN = N / BM; nwg = nM * nN; G = G_; c = c_; }
    __host__ __device__ bool next(int i, Unit& u) const {
        const long L = (long)i * G + c; if (L >= nwg) return false;
        int wgid = (int)L; { const int q = nwg / NXCD, r = nwg % NXCD, xcd = wgid % NXCD, off = wgid / NXCD; wgid = (xcd < r ? xcd * (q + 1) : r * (q + 1) + (xcd - r) * q) + off; }
        const int nig = WGM * nN, gid = wgid / nig, fm = gid * WGM, gsz = (nM - fm) < WGM ? (nM - fm) : WGM;
        u.pm = fm + ((wgid % nig) % gsz); u.pn = (wgid % nig) / gsz; return true;
    }
    __device__ __forceinline__ void a_ready(const Unit&) const {}
    __device__ __forceinline__ void done(const Unit&) const {}
};

template <class Epi, class Sched, bool ALIGN_EPI = false, bool SP2 = false>
__device__ __forceinline__ void gemm_phase(PG8_LAS unsigned char* lds, const Gemm g, const Sched& S, const Epi& E, int wv) {
    const int tid = opaque_tid(wv), wid = __builtin_amdgcn_readfirstlane(tid >> 6), lane = tid & 63, wr = wid >> 2, wc = wid & 3, fr = lane & 15, fq = lane >> 4;
    const int K = g.K, nt = K / BK;
    unsigned voffA[2], voffB[2];
#pragma unroll
    for (int i = 0; i < 2; ++i) { int R, C; stage_rc(tid * 16 + i * 8192, R, C); const int Rb = Epi::PERM ? ((R & ~31) + perm32(R & 31)) : R;
        voffA[i] = (unsigned)(R * g.lda + C) * 2u; voffB[i] = (unsigned)(Rb * g.ldb + C) * 2u; }
    const size_t kstep = (size_t)(BK * 2);
    const size_t hstepA = (size_t)HALF * g.lda * 2, hstepB = (size_t)HALF * g.ldb * 2;
    const size_t tstepA = 2 * hstepA, tstepB = 2 * hstepB;
    const unsigned ldsw = (unsigned)wid * 1024u;
    const int aoff = lds_byte(wr * 64 + fr, fq * 8), boff = lds_byte(wc * 32 + fr, fq * 8);
#define PG8_SA(b, h) (((b) * 2 + (h)) * HTB)
#define PG8_SB(b, h) ((4 + (b) * 2 + (h)) * HTB)
#define PG8_STAGE(bufoff, gbase, voff) do { _Pragma("unroll") for (int _i = 0; _i < 2; ++_i) \
        __builtin_amdgcn_global_load_lds((const unsigned*)((const char*)(gbase) + (voff)[_i]), (PG8_LAS unsigned*)(lds + (bufoff) + ldsw + _i * 8192), 16, 0, 0); } while (0)
#define PG8_LDA(dst, b, h) do { _Pragma("unroll") for (int m = 0; m < 4; ++m) _Pragma("unroll") for (int k = 0; k < 2; ++k) dst[m][k] = *(const PG8_LAS bf16x8*)(lds + PG8_SA(b, h) + aoff + m * 2048 + k * 1024); } while (0)
#define PG8_LDB(dst, b, h) do { _Pragma("unroll") for (int n = 0; n < 2; ++n) _Pragma("unroll") for (int k = 0; k < 2; ++k) dst[n][k] = *(const PG8_LAS bf16x8*)(lds + PG8_SB(b, h) + boff + n * 2048 + k * 1024); } while (0)
#define PG8_MMA(ai, bj, At, Bt) do { __builtin_amdgcn_s_setprio(1); _Pragma("unroll") for (int m = 0; m < 4; ++m) _Pragma("unroll") for (int n = 0; n < 2; ++n) _Pragma("unroll") for (int k = 0; k < 2; ++k) \
        acc[ai][bj][m][n] = __builtin_amdgcn_mfma_f32_16x16x32_bf16(Bt[n][k], At[m][k], acc[ai][bj][m][n], 0, 0, 0); __builtin_amdgcn_s_setprio(0); } while (0)
#define PG8_WAIT_V(n) asm volatile("s_waitcnt vmcnt(" #n ")" ::: "memory")
#define PG8_WAIT_L(n) asm volatile("s_waitcnt lgkmcnt(" #n ")" ::: "memory")
#define PG8_BAR __builtin_amdgcn_s_barrier()
#define PG8_SCHED __builtin_amdgcn_sched_barrier(0)
    Unit cur, nxt; int ui = 0;
    if (!S.next(0, cur)) return;
    f32x4 acc[2][2][4][2];
#pragma unroll
    for (int a = 0; a < 2; ++a)
#pragma unroll
        for (int b = 0; b < 2; ++b)
#pragma unroll
            for (int m = 0; m < 4; ++m)
#pragma unroll
                for (int n = 0; n < 2; ++n) acc[a][b][m][n] = (f32x4){0.f, 0.f, 0.f, 0.f};
    bf16x8 At[4][2], B0[2][2], B1[2][2];
    const char* cA = (const char*)g.A + (size_t)cur.pm * tstepA; const char* cB = (const char*)g.Bt + (size_t)cur.pn * tstepB;
    asm volatile("" : "+s"(cA), "+s"(cB));
    S.a_ready(cur);
    if constexpr (SP2) {
        PG8_STAGE(PG8_SB(0, 0), cB, voffB); PG8_STAGE(PG8_SB(0, 1), cB + hstepB, voffB); PG8_STAGE(PG8_SA(0, 0), cA, voffA); PG8_STAGE(PG8_SA(0, 1), cA + hstepA, voffA);
        if (wr == 1) PG8_BAR;
        PG8_WAIT_V(2); PG8_BAR;
        PG8_STAGE(PG8_SB(1, 0), cB + kstep, voffB); PG8_STAGE(PG8_SA(1, 0), cA + kstep, voffA); PG8_STAGE(PG8_SB(1, 1), cB + hstepB + kstep, voffB);
        PG8_WAIT_V(6); PG8_BAR;
    } else {
        PG8_STAGE(PG8_SB(0, 0), cB, voffB); PG8_STAGE(PG8_SA(0, 0), cA, voffA); PG8_STAGE(PG8_SB(0, 1), cB + hstepB, voffB); PG8_STAGE(PG8_SA(0, 1), cA + hstepA, voffA);
        if (wr == 1) PG8_BAR;
        PG8_WAIT_V(4); PG8_BAR;
        PG8_STAGE(PG8_SB(1, 0), cB + kstep, voffB); PG8_STAGE(PG8_SA(1, 0), cA + kstep, voffA); PG8_STAGE(PG8_SB(1, 1), cB + hstepB + kstep, voffB);
        PG8_WAIT_V(6); PG8_BAR;
    }
    for (;;) {
        const bool has_next = S.next(ui + 1, nxt);
        const char* nA = has_next ? (const char*)g.A + (size_t)nxt.pm * tstepA : cA; const char* nB = has_next ? (const char*)g.Bt + (size_t)nxt.pn * tstepB : cB;
        asm volatile("" : "+s"(nA), "+s"(nB));
        for (int t = 0; t < nt; t += 2) {
            if constexpr (Epi::MIDSCALE) { if (t == nt / 2) E.midscale(acc, cur, wr, fr); }
            const bool last = (t == nt - 2);
            const char* a1 = cA + (size_t)(t + 1) * kstep;
            const char* a2 = last ? nA : cA + (size_t)(t + 2) * kstep; const char* b2 = last ? nB : cB + (size_t)(t + 2) * kstep;
            const char* a3 = a2 + kstep; const char* b3 = b2 + kstep;
            asm volatile("" : "+s"(a1), "+s"(a2), "+s"(b2), "+s"(a3), "+s"(b3));
            if (last && has_next) S.a_ready(nxt);
            if constexpr (SP2) {
            PG8_LDB(B0, 0, 0); PG8_LDB(B1, 0, 1); PG8_SCHED; PG8_LDA(At, 0, 0); PG8_STAGE(PG8_SA(1, 1), a1 + hstepA, voffA);
            PG8_WAIT_V(8); PG8_WAIT_L(0); PG8_BAR; PG8_MMA(0, 0, At, B0); PG8_MMA(0, 1, At, B1); PG8_BAR; PG8_SCHED;
            PG8_LDA(At, 0, 1); PG8_STAGE(PG8_SB(0, 0), b2, voffB); PG8_STAGE(PG8_SB(0, 1), b2 + hstepB, voffB); PG8_STAGE(PG8_SA(0, 0), a2, voffA);
            PG8_WAIT_V(8); PG8_WAIT_L(0); PG8_BAR; PG8_MMA(1, 0, At, B0); PG8_MMA(1, 1, At, B1); PG8_BAR; PG8_SCHED;
            PG8_LDB(B0, 1, 0); PG8_LDB(B1, 1, 1); PG8_SCHED; PG8_LDA(At, 1, 0); PG8_STAGE(PG8_SA(0, 1), a2 + hstepA, voffA);
            PG8_WAIT_V(8); PG8_WAIT_L(0); PG8_BAR; PG8_MMA(0, 0, At, B0); PG8_MMA(0, 1, At, B1); PG8_BAR; PG8_SCHED;
            PG8_LDA(At, 1, 1); PG8_STAGE(PG8_SB(1, 0), b3, voffB); PG8_STAGE(PG8_SB(1, 1), b3 + hstepB, voffB); PG8_STAGE(PG8_SA(1, 0), a3, voffA);
            PG8_WAIT_V(8); PG8_WAIT_L(0); PG8_BAR; PG8_MMA(1, 0, At, B0); PG8_MMA(1, 1, At, B1); PG8_BAR; PG8_SCHED;
            } else {
            PG8_LDB(B0, 0, 0); PG8_SCHED; PG8_LDA(At, 0, 0); PG8_STAGE(PG8_SA(1, 1), a1 + hstepA, voffA);
            PG8_WAIT_L(8); PG8_BAR; PG8_WAIT_L(0); PG8_MMA(0, 0, At, B0); PG8_BAR; PG8_SCHED;
            PG8_LDB(B1, 0, 1); PG8_STAGE(PG8_SB(0, 0), b2, voffB);
            PG8_BAR; PG8_WAIT_L(0); PG8_MMA(0, 1, At, B1); PG8_BAR;
            PG8_LDA(At, 0, 1); PG8_STAGE(PG8_SA(0, 0), a2, voffA);
            PG8_BAR; PG8_WAIT_L(0); PG8_MMA(1, 0, At, B0); PG8_BAR; PG8_SCHED;
            PG8_STAGE(PG8_SB(0, 1), b2 + hstepB, voffB);
            PG8_WAIT_V(6); PG8_BAR; PG8_MMA(1, 1, At, B1); PG8_BAR;
            PG8_LDB(B0, 1, 0); PG8_SCHED; PG8_LDA(At, 1, 0); PG8_STAGE(PG8_SA(0, 1), a2 + hstepA, voffA);
            PG8_WAIT_L(8); PG8_BAR; PG8_WAIT_L(0); PG8_MMA(0, 0, At, B0); PG8_BAR; PG8_SCHED;
            PG8_LDB(B1, 1, 1); PG8_STAGE(PG8_SB(1, 0), b3, voffB);
            PG8_BAR; PG8_WAIT_L(0); PG8_MMA(0, 1, At, B1); PG8_BAR;
            PG8_LDA(At, 1, 1); PG8_STAGE(PG8_SA(1, 0), a3, voffA);
            PG8_BAR; PG8_WAIT_L(0); PG8_MMA(1, 0, At, B0); PG8_BAR; PG8_SCHED;
            PG8_STAGE(PG8_SB(1, 1), b3 + hstepB, voffB);
            PG8_WAIT_V(6); PG8_BAR; PG8_MMA(1, 1, At, B1); PG8_BAR;
            }
        }
        if constexpr (ALIGN_EPI) { if (wr == 0) PG8_BAR; }
        if constexpr (!Epi::AFTER_DRAIN) { const int l2_ = opaque_tid(wv) & 63; E(acc, cur, wr, wc, l2_ & 15, l2_ >> 4); S.done(cur); }
        if (!has_next) break;
#pragma unroll
        for (int a = 0; a < 2; ++a)
#pragma unroll
            for (int b = 0; b < 2; ++b)
#pragma unroll
                for (int m = 0; m < 4; ++m)
#pragma unroll
                    for (int n = 0; n < 2; ++n) acc[a][b][m][n] = (f32x4){0.f, 0.f, 0.f, 0.f};
        cur = nxt; cA = nA; cB = nB; ++ui;
        if constexpr (ALIGN_EPI) { if (wr == 1) PG8_BAR; }
    }
    PG8_WAIT_V(0);
    if constexpr (!ALIGN_EPI) { if (wr == 0) PG8_BAR; }
    PG8_BAR;
    if constexpr (Epi::AFTER_DRAIN) { E.fused(acc, cur, wr, wc, fr, fq, lds, wid, lane); S.done(cur); }
#undef PG8_SA
#undef PG8_SB
#undef PG8_STAGE
#undef PG8_LDA
#undef PG8_LDB
#undef PG8_MMA
#undef PG8_WAIT_V
#undef PG8_WAIT_L
#undef PG8_BAR
#undef PG8_SCHED
}
}

__device__ __forceinline__ unsigned cvt_pk_bf16(float lo, float hi) { unsigned r; asm volatile("v_cvt_pk_bf16_f32 %0, %1, %2" : "=v"(r) : "v"(lo), "v"(hi)); return r; }
template <int ACT> struct PEpiBf16 {
    static constexpr bool PERM = true, AFTER_DRAIN = false, MIDSCALE = false;
    bf16_t* O; int ldc; const float* rs; float invn;
    __device__ __forceinline__ void operator()(const f32x4 (&acc)[2][2][4][2], const pg8::Unit& u, int wr, int wc, int fr, int fq) const {
        const int row0 = u.pm * 256 + wr * 64 + fr, col0 = u.pn * 256 + wc * 32 + 8 * fq;
        float rsc[2][4];
#pragma unroll
        for (int ai = 0; ai < 2; ++ai)
#pragma unroll
            for (int m = 0; m < 4; ++m) rsc[ai][m] = rs ? rs[row0 + ai * 128 + m * 16] : 1.f;
        if (invn > 0.f) {
#pragma unroll
            for (int ai = 0; ai < 2; ++ai)
#pragma unroll
                for (int m = 0; m < 4; ++m) rsc[ai][m] = 1.f / sqrtf(rsc[ai][m] * invn + EPS); }
#pragma unroll
        for (int ai = 0; ai < 2; ++ai)
#pragma unroll
            for (int m = 0; m < 4; ++m) { const bf16_t* rowp = O + ((size_t)(u.pm * 256 + wr * 64 + ai * 128 + m * 16) * ldc + u.pn * 256 + wc * 32); const unsigned lo_ = (unsigned)(fr * ldc + 8 * fq) * 2u; const float sc_ = rsc[ai][m];
#pragma unroll
                for (int bj = 0; bj < 2; ++bj) { f32x4 v0 = acc[ai][bj][m][0] * sc_, v1 = acc[ai][bj][m][1] * sc_;
                    if (ACT == 2) {
#pragma unroll
                        for (int e = 0; e < 4; ++e) { const float a = fmaxf(v0[e], 0.f), b = fmaxf(v1[e], 0.f); v0[e] = a * a; v1[e] = b * b; } }
                    u32x4 w; w.x = cvt_pk_bf16(v0[0], v0[1]); w.y = cvt_pk_bf16(v0[2], v0[3]); w.z = cvt_pk_bf16(v1[0], v1[1]); w.w = cvt_pk_bf16(v1[2], v1[3]);
                    st16_wt(rowp + bj * 128, lo_, w); } }
    }
};
struct PEpiProj {
    static constexpr bool PERM = true, AFTER_DRAIN = false, MIDSCALE = false;
    bf16_t* O; int ldc; const float* rs1; float* ssq_q; float* ssq_kv; float* ssq_kr; const float* qgain; const float* kgain; const float* rope; const float* kgm;
    __device__ __forceinline__ void operator()(const f32x4 (&acc)[2][2][4][2], const pg8::Unit& u, int wr, int wc, int fr, int fq) const {
        const int row0 = u.pm * 256 + wr * 64 + fr, col0 = u.pn * 256 + wc * 32 + 8 * fq, lane = fq * 16 + fr;
        float rsc[2][4];
#pragma unroll
        for (int ai = 0; ai < 2; ++ai)
#pragma unroll
            for (int m = 0; m < 4; ++m) rsc[ai][m] = rs1[row0 + ai * 128 + m * 16];
        const int sl = 4 * u.pn + wc;
        int mode = 0; const float* g = nullptr; float gs = 1.f;
        if (u.pn < 5) { if (sl < 8) { mode = 1; g = qgain; gs = QS_NSA; } else if (sl == S_KSEL || sl == S_KSEL + 1) { mode = 1; g = kgain + 64; } else if (sl == S_KWIN || sl == S_KWIN + 1) { mode = 1; g = kgain + 128; } }
        f32x4 ga[2][2];
        if (mode == 1) {
#pragma unroll
            for (int bj = 0; bj < 2; ++bj) { ga[bj][0] = *(const f32x4*)(g + 32 * bj + 8 * fq) * gs; ga[bj][1] = *(const f32x4*)(g + 32 * bj + 8 * fq + 4) * gs; } }
#pragma unroll
        for (int ai = 0; ai < 2; ++ai)
#pragma unroll
            for (int m = 0; m < 4; ++m) { const int row = row0 + ai * 128 + m * 16; const bf16_t* rowp = O + ((size_t)(u.pm * 256 + wr * 64 + ai * 128 + m * 16) * ldc + u.pn * 256 + wc * 32); const unsigned lo_ = (unsigned)(fr * ldc + 8 * fq) * 2u; const float sc_ = rsc[ai][m];
                f32x4 v[2][2];
#pragma unroll
                for (int bj = 0; bj < 2; ++bj) { v[bj][0] = acc[ai][bj][m][0] * sc_; v[bj][1] = acc[ai][bj][m][1] * sc_; }
                if (mode == 1) {
                    float ss = 0.f;
#pragma unroll
                    for (int bj = 0; bj < 2; ++bj)
#pragma unroll
                        for (int n = 0; n < 2; ++n) ss += (v[bj][n][0] * v[bj][n][0] + v[bj][n][1] * v[bj][n][1]) + (v[bj][n][2] * v[bj][n][2] + v[bj][n][3] * v[bj][n][3]);
                    ss += __builtin_bit_cast(float, __builtin_amdgcn_ds_bpermute((lane ^ 16) << 2, __builtin_bit_cast(int, ss)));
                    ss += __builtin_bit_cast(float, __builtin_amdgcn_ds_bpermute((lane ^ 32) << 2, __builtin_bit_cast(int, ss)));
                    const float rstd = 1.f / sqrtf(ss * (1.f / 64) + EPS);
#pragma unroll
                    for (int bj = 0; bj < 2; ++bj) { v[bj][0] = v[bj][0] * rstd * ga[bj][0]; v[bj][1] = v[bj][1] * rstd * ga[bj][1]; }
                } else if (u.pn >= 5) {
#pragma unroll
                    for (int bj = 0; bj < 2; ++bj) { const int cb = u.pn * 256 + bj * 128;
                        float* dst = (cb < P_HKV) ? ssq_q : (cb < P_HKR ? ssq_kv : ((cb == P_HKR && wc == 0) ? ssq_kr : nullptr));
                        if (dst) { float ss = (v[bj][0][0] * v[bj][0][0] + v[bj][0][1] * v[bj][0][1]) + (v[bj][0][2] * v[bj][0][2] + v[bj][0][3] * v[bj][0][3]) + (v[bj][1][0] * v[bj][1][0] + v[bj][1][1] * v[bj][1][1]) + (v[bj][1][2] * v[bj][1][2] + v[bj][1][3] * v[bj][1][3]);
                            ss += __builtin_bit_cast(float, __builtin_amdgcn_ds_bpermute((lane ^ 16) << 2, __builtin_bit_cast(int, ss)));
                            ss += __builtin_bit_cast(float, __builtin_amdgcn_ds_bpermute((lane ^ 32) << 2, __builtin_bit_cast(int, ss)));
                            if (fq == 0) __hip_atomic_fetch_add(dst + row, ss, __ATOMIC_RELAXED, __HIP_MEMORY_SCOPE_AGENT); }
                        if (cb == P_HKR && wc == 0) {
                            const f32x4 g0 = *(const f32x4*)(kgm + 64 + 8 * fq), g1 = *(const f32x4*)(kgm + 64 + 8 * fq + 4);
                            const float* rp = rope + (size_t)(row & (SEQ - 1)) * 32 + 8 * (fq & 1);
                            const f32x4 c0 = *(const f32x4*)rp, c1 = *(const f32x4*)(rp + 4), s0 = *(const f32x4*)(rp + 16), s1 = *(const f32x4*)(rp + 20);
#pragma unroll
                            for (int n = 0; n < 2; ++n)
#pragma unroll
                                for (int j = 0; j < 4; ++j) { const float nv = v[bj][n][j] * (n ? g1[j] : g0[j]);
                                    const float pv = __builtin_bit_cast(float, __builtin_amdgcn_ds_bpermute((lane ^ 32) << 2, __builtin_bit_cast(int, nv)));
                                    const float cs = n ? c1[j] : c0[j], sn = n ? s1[j] : s0[j]; v[bj][n][j] = (fq < 2) ? nv * cs - pv * sn : nv * cs + pv * sn; } } }
                }
#pragma unroll
                for (int bj = 0; bj < 2; ++bj) { u32x4 w; w.x = cvt_pk_bf16(v[bj][0][0], v[bj][0][1]); w.y = cvt_pk_bf16(v[bj][0][2], v[bj][0][3]); w.z = cvt_pk_bf16(v[bj][1][0], v[bj][1][1]); w.w = cvt_pk_bf16(v[bj][1][2], v[bj][1][3]);
                    st16_wt(rowp + bj * 128, lo_, w); } }
    }
};
struct PEpiKV {
    static constexpr bool PERM = true, AFTER_DRAIN = false, MIDSCALE = false;
    bf16_t* V; bf16_t* K; const bf16_t* proj; const float* ssq_kv; const float* ssq_kr; const float* rope; const float* kgain;
    __device__ __forceinline__ void operator()(const f32x4 (&acc)[2][2][4][2], const pg8::Unit& u, int wr, int wc, int fr_, int fq_) const {
        int fr = fr_, fq = fq_; asm volatile("" : "+v"(fr), "+v"(fq)); const float* kgain = this->kgain; asm volatile("" : "+s"(kgain)); const float* rope = this->rope; asm volatile("" : "+s"(rope));
        const int row0 = u.pm * 256 + wr * 64 + fr, lane = fq * 16 + fr;
        float rsc[2][4];
#pragma unroll
        for (int ai = 0; ai < 2; ++ai)
#pragma unroll
            for (int m = 0; m < 4; ++m) rsc[ai][m] = 1.f / sqrtf(ssq_kv[row0 + ai * 128 + m * 16] * (1.f / KVR) + EPS);
        if (wc >= 2) {
            const int col0 = u.pn * 256 + wc * 32 + 8 * fq;
#pragma unroll
            for (int ai = 0; ai < 2; ++ai)
#pragma unroll
                for (int m = 0; m < 4; ++m) { bf16_t* rowp = V + (size_t)(row0 + ai * 128 + m * 16) * MKV + col0; const float sc_ = rsc[ai][m];
#pragma unroll
                    for (int bj = 0; bj < 2; ++bj) { const f32x4 v0 = acc[ai][bj][m][0] * sc_, v1 = acc[ai][bj][m][1] * sc_;
                        u32x4 w; w.x = cvt_pk_bf16(v0[0], v0[1]); w.y = cvt_pk_bf16(v0[2], v0[3]); w.z = cvt_pk_bf16(v1[0], v1[1]); w.w = cvt_pk_bf16(v1[2], v1[3]);
                        *(u32x4*)(rowp + bj * 128) = w; } }
            return;
        }
        const int hh = 2 * u.pn + wc;
#pragma unroll
        for (int ai = 0; ai < 2; ++ai)
#pragma unroll
            for (int m = 0; m < 4; ++m) { const int row = row0 + ai * 128 + m * 16; const float sc_ = rsc[ai][m];
                bf16_t* ko = K + (size_t)row * MQ + 96 * hh;
                float rstd;
                {
                    f32x4 v[2][2]; float ss = 0.f;
#pragma unroll
                    for (int bj = 0; bj < 2; ++bj)
#pragma unroll
                        for (int n = 0; n < 2; ++n) { v[bj][n] = acc[ai][bj][m][n] * sc_; ss += (v[bj][n][0] * v[bj][n][0] + v[bj][n][1] * v[bj][n][1]) + (v[bj][n][2] * v[bj][n][2] + v[bj][n][3] * v[bj][n][3]); }
                    ss += __builtin_bit_cast(float, __builtin_amdgcn_ds_bpermute((lane ^ 16) << 2, __builtin_bit_cast(int, ss)));
                    ss += __builtin_bit_cast(float, __builtin_amdgcn_ds_bpermute((lane ^ 32) << 2, __builtin_bit_cast(int, ss)));
                    rstd = 1.f / sqrtf((ss + ssq_kr[row]) * (1.f / 96) + EPS);
#pragma unroll
                    for (int bj = 0; bj < 2; ++bj) { const f32x4 g0 = *(const f32x4*)(kgain + 32 * bj + 8 * fq), g1 = *(const f32x4*)(kgain + 32 * bj + 8 * fq + 4);
                        const f32x4 a = v[bj][0] * rstd * g0, b = v[bj][1] * rstd * g1;
                        u32x4 w; w.x = cvt_pk_bf16(a[0], a[1]); w.y = cvt_pk_bf16(a[2], a[3]); w.z = cvt_pk_bf16(b[0], b[1]); w.w = cvt_pk_bf16(b[2], b[3]);
                        *(u32x4*)(ko + 32 * bj + 8 * fq) = w; }
                }
                asm volatile("" ::: "memory");
                {
                    const bf16x8 kr8 = *(const bf16x8*)(proj + (size_t)row * DINP + P_HKR + 8 * fq);
                    u32x4 w; w.x = cvt_pk_bf16(bf2f((unsigned short)kr8[0]) * rstd, bf2f((unsigned short)kr8[1]) * rstd); w.y = cvt_pk_bf16(bf2f((unsigned short)kr8[2]) * rstd, bf2f((unsigned short)kr8[3]) * rstd);
                    w.z = cvt_pk_bf16(bf2f((unsigned short)kr8[4]) * rstd, bf2f((unsigned short)kr8[5]) * rstd); w.w = cvt_pk_bf16(bf2f((unsigned short)kr8[6]) * rstd, bf2f((unsigned short)kr8[7]) * rstd);
                    *(u32x4*)(ko + 64 + 8 * fq) = w;
                }
                asm volatile("" ::: "memory"); }
    }
};
struct PEpiWo {
    static constexpr bool PERM = true, AFTER_DRAIN = false, MIDSCALE = true;
    const bf16_t* base; bf16_t* xb; float* ssq; const float* ssqm; int ldc;
    __device__ __forceinline__ void midscale(f32x4 (&acc)[2][2][4][2], const pg8::Unit& u, int wr, int fr) const {
#pragma unroll
        for (int ai = 0; ai < 2; ++ai)
#pragma unroll
            for (int m = 0; m < 4; ++m) { const int row = u.pm * 256 + ai * 128 + wr * 64 + m * 16 + fr;
                const float sa = ssqm[2 * row], sb = ssqm[2 * row + 1]; const float ratio = sqrtf((sb * (1.f / 512) + EPS) / (sa * (1.f / 512) + EPS));
#pragma unroll
                for (int bj = 0; bj < 2; ++bj)
#pragma unroll
                    for (int n = 0; n < 2; ++n) acc[ai][bj][m][n] *= ratio; }
    }
    __device__ __forceinline__ void operator()(const f32x4 (&acc)[2][2][4][2], const pg8::Unit& u, int wr, int wc, int fr, int fq) const {
        const int lane = fq * 16 + fr;
        const int rowb = u.pm * 256 + wr * 64 + fr;
        float rb[8];
#pragma unroll
        for (int g_ = 0; g_ < 8; ++g_) rb[g_] = ssqm[2 * (rowb + (g_ >> 2) * 128 + (g_ & 3) * 16) + 1];
        const size_t tile0 = (size_t)(u.pm * 256 + wr * 64) * ldc + u.pn * 256 + wc * 32;
        const unsigned lo_ = (unsigned)(fr * ldc + 8 * fq) * 2u;
        u32x4 nxt[2];
#pragma unroll
        for (int bj = 0; bj < 2; ++bj) nxt[bj] = *(const u32x4*)((const char*)(base + tile0 + bj * 128) + lo_);
#pragma unroll
        for (int g_ = 0; g_ < 8; ++g_) { const int ai = g_ >> 2, m = g_ & 3; const int row = rowb + ai * 128 + m * 16; const size_t roff = tile0 + (size_t)(ai * 128 + m * 16) * ldc; float ss = 0.f;
            u32x4 cur[2];
#pragma unroll
            for (int bj = 0; bj < 2; ++bj) cur[bj] = nxt[bj];
            if (g_ < 7) { const size_t roffn = tile0 + (size_t)(((g_ + 1) >> 2) * 128 + ((g_ + 1) & 3) * 16) * ldc;
#pragma unroll
                for (int bj = 0; bj < 2; ++bj) nxt[bj] = *(const u32x4*)((const char*)(base + roffn + bj * 128) + lo_); }
            const float rbs = 1.f / sqrtf(rb[g_] * (1.f / 512) + EPS);
#pragma unroll
            for (int bj = 0; bj < 2; ++bj) { const u32x4 cw = cur[bj];
                const f32x4 v0 = (f32x4){bf2f(cw.x & 0xffffu), bf2f(cw.x >> 16), bf2f(cw.y & 0xffffu), bf2f(cw.y >> 16)} + acc[ai][bj][m][0] * rbs;
                const f32x4 v1 = (f32x4){bf2f(cw.z & 0xffffu), bf2f(cw.z >> 16), bf2f(cw.w & 0xffffu), bf2f(cw.w >> 16)} + acc[ai][bj][m][1] * rbs;
                ss += ((v0[0] * v0[0] + v0[1] * v0[1]) + (v0[2] * v0[2] + v0[3] * v0[3])) + ((v1[0] * v1[0] + v1[1] * v1[1]) + (v1[2] * v1[2] + v1[3] * v1[3]));
                u32x4 w; w.x = cvt_pk_bf16(v0[0], v0[1]); w.y = cvt_pk_bf16(v0[2], v0[3]); w.z = cvt_pk_bf16(v1[0], v1[1]); w.w = cvt_pk_bf16(v1[2], v1[3]);
                st16_wt(xb + roff + bj * 128, lo_, w); }
            ss += __builtin_bit_cast(float, __builtin_amdgcn_ds_bpermute((lane ^ 16) << 2, __builtin_bit_cast(int, ss)));
            ss += __builtin_bit_cast(float, __builtin_amdgcn_ds_bpermute((lane ^ 32) << 2, __builtin_bit_cast(int, ss)));
            if (fq == 0) __hip_atomic_fetch_add(ssq + row, ss, __ATOMIC_RELAXED, __HIP_MEMORY_SCOPE_AGENT); }
    }
};


struct PEpiDown {
    static constexpr bool PERM = false, AFTER_DRAIN = false, MIDSCALE = false;
    const bf16_t* xb; float* out; int ldc;
    __device__ __forceinline__ void operator()(const f32x4 (&acc)[2][2][4][2], const pg8::Unit& u, int wr, int wc, int fr, int fq) const {
        const int col0 = u.pn * 256 + wc * 32 + 4 * fq; const int rowb = u.pm * 256 + wr * 64 + fr;
        u32x2 nxt[2][2];
#pragma unroll
        for (int bj = 0; bj < 2; ++bj)
#pragma unroll
            for (int n = 0; n < 2; ++n) nxt[bj][n] = *(const u32x2*)(xb + (size_t)rowb * ldc + col0 + bj * 128 + n * 16);
#pragma unroll
        for (int g_ = 0; g_ < 8; ++g_) { const int ai = g_ >> 2, m = g_ & 3; const size_t off = (size_t)(rowb + ai * 128 + m * 16) * ldc + col0;
            u32x2 cur[2][2];
#pragma unroll
            for (int bj = 0; bj < 2; ++bj)
#pragma unroll
                for (int n = 0; n < 2; ++n) cur[bj][n] = nxt[bj][n];
            if (g_ < 7) { const size_t offn = (size_t)(rowb + ((g_ + 1) >> 2) * 128 + ((g_ + 1) & 3) * 16) * ldc + col0;
#pragma unroll
                for (int bj = 0; bj < 2; ++bj)
#pragma unroll
                    for (int n = 0; n < 2; ++n) nxt[bj][n] = *(const u32x2*)(xb + offn + bj * 128 + n * 16); }
#pragma unroll
            for (int bj = 0; bj < 2; ++bj)
#pragma unroll
                for (int n = 0; n < 2; ++n) { const u32x2 w = cur[bj][n];
                    const f32x4 bs = (f32x4){bf2f(w.x & 0xffffu), bf2f(w.x >> 16), bf2f(w.y & 0xffffu), bf2f(w.y >> 16)};
                    __builtin_nontemporal_store(bs + acc[ai][bj][m][n], (f32x4*)(out + off + bj * 128 + n * 16)); } }
    }
};

__device__ __forceinline__ float sq8(const bf16x8 v) { float s = 0.f;
#pragma unroll
    for (int j = 0; j < 8; ++j) { const float f = bf2f((unsigned short)v[j]); s += f * f; }
    return s; }
__device__ __forceinline__ u32x4 scale8(const bf16x8 v, float sc, const f32x4 ga, const f32x4 gb) { u32x4 o;
    o.x = pk2(bf2f((unsigned short)v[0]) * sc * ga[0], bf2f((unsigned short)v[1]) * sc * ga[1]); o.y = pk2(bf2f((unsigned short)v[2]) * sc * ga[2], bf2f((unsigned short)v[3]) * sc * ga[3]);
    o.z = pk2(bf2f((unsigned short)v[4]) * sc * gb[0], bf2f((unsigned short)v[5]) * sc * gb[1]); o.w = pk2(bf2f((unsigned short)v[6]) * sc * gb[2], bf2f((unsigned short)v[7]) * sc * gb[3]);
    return o; }

__device__ __forceinline__ void compress_block(unsigned char* ws, LAS unsigned char* L, int task, int wv) {
    const int tid = opaque_tid(wv), lane = tid & 63, wid = __builtin_amdgcn_readfirstlane(tid >> 6), fr = lane & 15, fq = lane >> 4;
    const int tc = task & 15, b = (task >> 4) & 7, kv = task >> 7;
    int c = 8 * tc + (fr >> 1); const int g = fr & 1; if (c > NCMP - 1) c = NCMP - 1;
    const bf16_t* arow = (const bf16_t*)(ws + WS_PROJ) + (size_t)(b * SEQ + 16 * c) * DINP + slot_base((kv ? S_VCMP : S_KCMP) + g) + 8 * fq;
    const float* pe = inptr(11) + kv * 2048 + 8 * fq;
    const bf16_t* w1t = (const bf16_t*)(ws + WS_W1T) + (size_t)kv * 128 * 2048 + (size_t)fr * 2048 + 8 * fq;
    f32x4 acc[8];
#pragma unroll
    for (int n = 0; n < 8; ++n) acc[n] = (f32x4){0.f, 0.f, 0.f, 0.f};
#pragma unroll 4
    for (int s8 = 0; s8 < 8; ++s8) {
        const int s = 8 * wid + s8, r = s >> 1, db = (s & 1) * 32;
        const bf16x8 araw = *(const bf16x8*)(arow + (size_t)r * DINP + 4 * db);
        const f32x4 pa = *(const f32x4*)(pe + r * 64 + db), pb = *(const f32x4*)(pe + r * 64 + db + 4);
        u32x4 aw; aw.x = pk2(bf2f((unsigned short)araw[0]) + pa[0], bf2f((unsigned short)araw[1]) + pa[1]); aw.y = pk2(bf2f((unsigned short)araw[2]) + pa[2], bf2f((unsigned short)araw[3]) + pa[3]);
        aw.z = pk2(bf2f((unsigned short)araw[4]) + pb[0], bf2f((unsigned short)araw[5]) + pb[1]); aw.w = pk2(bf2f((unsigned short)araw[6]) + pb[2], bf2f((unsigned short)araw[7]) + pb[3]);
        const bf16x8 a = __builtin_bit_cast(bf16x8, aw);
#pragma unroll
        for (int n = 0; n < 8; ++n) { const bf16x8 bb = *(const bf16x8*)(w1t + (size_t)(16 * n) * 2048 + 32 * s);
            acc[n] = __builtin_amdgcn_mfma_f32_16x16x32_bf16(a, bb, acc[n], 0, 0, 0); }
    }
    LAS float* part = (LAS float*)L;
#pragma unroll
    for (int n = 0; n < 8; ++n)
#pragma unroll
        for (int j = 0; j < 4; ++j) part[(wid * 16 + 4 * fq + j) * 128 + 16 * n + fr] = acc[n][j];
    __syncthreads();
    LAS bf16_t* hb_ = (LAS bf16_t*)(L + 65536);
#pragma unroll
    for (int e = 0; e < 4; ++e) { const int idx = tid + 512 * e; float v = 0.f;
#pragma unroll
        for (int w = 0; w < 8; ++w) v += part[w * 2048 + idx];
        hb_[idx] = (bf16_t)f2bf(v / (1.f + __expf(-v))); }
    __syncthreads();
    if (wid == 0) {
        const bf16_t* w2t = (const bf16_t*)(ws + WS_W2T) + kv * 64 * 128 + fr * 128 + 8 * fq;
        f32x4 o[4];
#pragma unroll
        for (int n = 0; n < 4; ++n) o[n] = (f32x4){0.f, 0.f, 0.f, 0.f};
#pragma unroll
        for (int ks = 0; ks < 4; ++ks) { const bf16x8 a = *(const LAS bf16x8*)(hb_ + fr * 128 + 32 * ks + 8 * fq);
#pragma unroll
            for (int n = 0; n < 4; ++n) { const bf16x8 bb = *(const bf16x8*)(w2t + (size_t)(16 * n) * 128 + 32 * ks); o[n] = __builtin_amdgcn_mfma_f32_16x16x32_bf16(a, bb, o[n], 0, 0, 0); } }
        bf16_t* dstb = (bf16_t*)(ws + (kv ? WS_VCMP : WS_KCMP)) + (size_t)b * 128 * 2 * 64;
        const float* kg = inptr(10);
#pragma unroll
        for (int j = 0; j < 4; ++j) { const int row = 4 * fq + j, cc = 8 * tc + (row >> 1), gg = row & 1;
            float sc = 1.f;
            if (kv == 0) { float ss = o[0][j] * o[0][j] + o[1][j] * o[1][j] + o[2][j] * o[2][j] + o[3][j] * o[3][j];
                ss += __shfl_xor(ss, 1); ss += __shfl_xor(ss, 2); ss += __shfl_xor(ss, 4); ss += __shfl_xor(ss, 8); sc = 1.f / sqrtf(ss * (1.f / 64) + EPS); }
#pragma unroll
            for (int n = 0; n < 4; ++n) { const int col = 16 * n + fr; float v = o[n][j] * sc; if (kv == 0) v *= kg[col]; if (cc >= NCMP) v = 0.f;
                dstb[((size_t)cc * 2 + gg) * 64 + col] = (bf16_t)f2bf(v); } }
    }
    __syncthreads();
}

namespace att {
typedef float f32x16 __attribute__((ext_vector_type(16)));
typedef short s16x4 __attribute__((ext_vector_type(4)));
typedef short v4i16_t __attribute__((ext_vector_type(4)));
typedef float f32x2_t __attribute__((ext_vector_type(2)));
typedef __bf16 bf16x2_t __attribute__((ext_vector_type(2)));
typedef const LAS unsigned char* lcp;
constexpr int NSLOT = 3;
constexpr int L_TB = 0, L_K = 4096, KSLOT = 12288, L_V = L_K + NSLOT * KSLOT, VSLOT = 8192, L_WSF = L_V + NSLOT * VSLOT, L_OST = L_WSF + 4096,
              L_IMP = L_OST + 32768, IMPS = 33  , L_SELM = L_IMP + 4 * 64 * IMPS * 4, L_GATE = L_SELM + 256, L_SC = L_GATE + 3072, L_INVL = L_SC + 64 * IMPS * 4, L_END = L_INVL + 1024;
static_assert(L_V + NSLOT * VSLOT <= 65536, "LDS-DMA destinations stay below 64 KiB");
static_assert(L_END <= LDS_BST, "attention LDS map");
constexpr float THR = 8.0f;
__device__ __forceinline__ int crow(int r, int hi) { return (r & 3) + 8 * (r >> 2) + 4 * hi; }
__device__ __forceinline__ void glds16(const void* gsrc, unsigned lds_dst) { unsigned keep;
    asm volatile("s_mov_b32 %0, m0\n\ts_mov_b32 m0, %2\n\ts_nop 0\n\tglobal_load_lds_dwordx4 %1, off\n\ts_mov_b32 m0, %0" : "=&s"(keep) : "v"(gsrc), "s"(lds_dst) : "memory"); }
__device__ __forceinline__ unsigned cvtpk(float lo, float hi) { f32x2_t v = {lo, hi}; bf16x2_t b = __builtin_convertvector(v, bf16x2_t); return __builtin_bit_cast(unsigned, b); }
__device__ __forceinline__ s16x4 vtr(lcp p) { return __builtin_bit_cast(s16x4, __builtin_amdgcn_ds_read_tr16_b64_v4i16((LAS v4i16_t*)p)); }
__device__ __forceinline__ float lane_xor(float v, int lane, int x) { return __builtin_bit_cast(float, __builtin_amdgcn_ds_bpermute((lane ^ x) << 2, __builtin_bit_cast(int, v))); }
__device__ __forceinline__ unsigned lane_xor_u(unsigned v, int lane, int x) { return (unsigned)__builtin_amdgcn_ds_bpermute((lane ^ x) << 2, (int)v); }
__device__ __forceinline__ float swap_max(float m, int lane) { return __builtin_fmaxf(m, lane_xor(m, lane, 32)); }
__device__ __forceinline__ float swap_sum(float m, int lane) { return m + lane_xor(m, lane, 32); }
__device__ __forceinline__ float max3f(float a, float b, float c) { float r; asm("v_max3_f32 %0, %1, %2, %3" : "=v"(r) : "v"(a), "v"(b), "v"(c)); return r; }
__device__ __forceinline__ float max32(const f32x16& p0, const f32x16& p1) {
    float a = max3f(p0[0], p0[1], p1[0]), b = max3f(p0[2], p0[3], p1[1]); a = max3f(a, p1[2], p1[3]);
#pragma unroll
    for (int r = 4; r < 16; r += 4) { a = max3f(a, p0[r], p0[r + 1]); b = max3f(b, p0[r + 2], p0[r + 3]); a = max3f(a, p1[r], p1[r + 1]); b = max3f(b, p1[r + 2], p1[r + 3]); }
    return __builtin_fmaxf(a, b); }
__device__ __forceinline__ float max16(const f32x16& p) { float a = __builtin_fmaxf(p[0], p[1]), b = __builtin_fmaxf(p[2], p[3]);
#pragma unroll
    for (int r = 4; r < 16; r += 4) { a = __builtin_fmaxf(a, __builtin_fmaxf(p[r], p[r + 1])); b = __builtin_fmaxf(b, __builtin_fmaxf(p[r + 2], p[r + 3])); }
    return __builtin_fmaxf(a, b); }
__device__ __forceinline__ float sum16(const f32x16& p) { float a = p[0] + p[1], b = p[2] + p[3];
#pragma unroll
    for (int r = 4; r < 16; r += 4) { a += p[r] + p[r + 1]; b += p[r + 2] + p[r + 3]; }
    return a + b; }
#define ATT_BAR() asm volatile("s_waitcnt vmcnt(0) lgkmcnt(0)\n\ts_barrier" ::: "memory")

template <int DQ> __device__ __forceinline__ void qkt(f32x16& p0, f32x16& p1, lcp kslot, const bf16x8* qr, const f32x16& cinit, int r32, int hi) {
    lcp kb = kslot + hi * 1024 + r32 * 16;
    constexpr int NB = 2;
#pragma unroll
    for (int db = 0; db < DQ / 16; db += NB) {
        bf16x8 kf[2 * NB];
#pragma unroll
        for (int e = 0; e < NB; ++e) { kf[2 * e] = *(const LAS bf16x8*)(kb + (db + e) * 2048); kf[2 * e + 1] = *(const LAS bf16x8*)(kb + (db + e) * 2048 + 512); }
        __builtin_amdgcn_sched_barrier(0);
#pragma unroll
        for (int e = 0; e < NB; ++e) { const int d0 = db + e;
            if (d0 == 0) { p0 = __builtin_amdgcn_mfma_f32_32x32x16_bf16(kf[0], qr[0], cinit, 0, 0, 0); p1 = __builtin_amdgcn_mfma_f32_32x32x16_bf16(kf[1], qr[0], cinit, 0, 0, 0); }
            else { p0 = __builtin_amdgcn_mfma_f32_32x32x16_bf16(kf[2 * e], qr[d0], p0, 0, 0, 0); p1 = __builtin_amdgcn_mfma_f32_32x32x16_bf16(kf[2 * e + 1], qr[d0], p1, 0, 0, 0); }
        }
    }
}
__device__ __forceinline__ void vload_half(bf16x8 (&vf)[8], lcp vp, int d0) {
#pragma unroll
    for (int ks = 0; ks < 4; ++ks) {
        const s16x4 lo = vtr(vp + d0 * 4096 + ks * 1024), hh = vtr(vp + d0 * 4096 + ks * 1024 + 512);
        vf[d0 * 4 + ks] = (bf16x8){lo[0], lo[1], lo[2], lo[3], hh[0], hh[1], hh[2], hh[3]};
    }
    __builtin_amdgcn_sched_barrier(0);
}
__device__ __forceinline__ void vload(bf16x8 (&vf)[8], lcp vp) { vload_half(vf, vp, 0); vload_half(vf, vp, 1); }
__device__ __forceinline__ void pv_mma(f32x16 (&o)[2], const bf16x8 (&vf)[8], const f32x16& p0, const f32x16& p1) {
    u32x4 pw[4];
    pw[0] = (u32x4){cvtpk(p0[0], p0[1]), cvtpk(p0[2], p0[3]), cvtpk(p0[4], p0[5]), cvtpk(p0[6], p0[7])};
    pw[1] = (u32x4){cvtpk(p0[8], p0[9]), cvtpk(p0[10], p0[11]), cvtpk(p0[12], p0[13]), cvtpk(p0[14], p0[15])};
    pw[2] = (u32x4){cvtpk(p1[0], p1[1]), cvtpk(p1[2], p1[3]), cvtpk(p1[4], p1[5]), cvtpk(p1[6], p1[7])};
    pw[3] = (u32x4){cvtpk(p1[8], p1[9]), cvtpk(p1[10], p1[11]), cvtpk(p1[12], p1[13]), cvtpk(p1[14], p1[15])};
#pragma unroll
    for (int d0 = 0; d0 < 2; ++d0)
#pragma unroll
        for (int ks = 0; ks < 4; ++ks) o[d0] = __builtin_amdgcn_mfma_f32_32x32x16_bf16(__builtin_bit_cast(bf16x8, pw[ks]), vf[d0 * 4 + ks], o[d0], 0, 0, 0);
}
__device__ __forceinline__ void pv(f32x16 (&o)[2], lcp vp, const f32x16& p0, const f32x16& p1) { bf16x8 vf[8]; vload(vf, vp); pv_mma(o, vf, p0, p1); }
template <int DQ, bool SLOT = false, bool SLOTV = SLOT> __device__ __forceinline__ void dma_tile(unsigned lds0, const bf16_t* Kg, int kpitch, const bf16_t* Vg, int vpitch, int key0, int slot, int wid, int lane) {
    const bf16_t* ksrc = Kg + (size_t)(key0 + lane) * kpitch + (SLOT ? 128 * (wid >> 2) + 8 * (wid & 3) : wid * 8);
    glds16(ksrc, (unsigned)__builtin_amdgcn_readfirstlane(lds0 + L_K + slot * KSLOT + wid * 1024));
    if (DQ == 96) { if (wid < 4) glds16(ksrc + 64, (unsigned)__builtin_amdgcn_readfirstlane(lds0 + L_K + slot * KSLOT + (8 + wid) * 1024)); }
    const bf16_t* vsrc = Vg + (size_t)(key0 + 16 * (wid & 3) + (lane >> 2)) * vpitch + (wid >> 2) * (SLOTV ? 128 : 32) + (lane & 3) * 8;
    glds16(vsrc, (unsigned)__builtin_amdgcn_readfirstlane(lds0 + L_V + slot * VSLOT + wid * 1024));
}

#define ATT_LBAR() asm volatile("s_waitcnt lgkmcnt(0)\n\ts_barrier" ::: "memory")
struct NoNext { static constexpr int count = 0; __device__ __forceinline__ void dma(unsigned, int, int, int, int) const {} };
template <int DQ, bool SLOT, bool SLOTV, class Pol> struct NextTiles {
    const bf16_t* Kg; int kpitch; const bf16_t* Vg; int vpitch; const Pol* pol; int count;
    __device__ __forceinline__ void dma(unsigned lds0, int j, int slot, int wid, int lane) const { dma_tile<DQ, SLOT, SLOTV>(lds0, Kg, kpitch, Vg, vpitch, pol->key0(j), slot, wid, lane); }
};
template <int DQ, bool SLOT = false, bool SLOTV = SLOT, class Pol, class Next>
__device__ __forceinline__ void flash_loop(LAS unsigned char* L, const bf16_t* Kg, int kpitch, const bf16_t* Vg, int vpitch, const bf16x8* qr, const Pol& pol, int s0, int npre, const Next& next,
                                           f32x16 (&o)[2], float& l_out, int wid, int lane) {
    const int r32 = lane & 31, hi = lane >> 5;
    const unsigned lds0 = (unsigned)(uintptr_t)L;
    LAS float* wsf = (LAS float*)(L + L_WSF) + wid * 128;
    lcp vp0 = L + L_V + ((lane >> 4) & 1) * 32 + (lane & 3) * 8 + (4 * hi + ((lane & 15) >> 2)) * 64;
    float mhat = 0.f, l = 0.f;
    f32x16 negm;
#pragma unroll
    for (int r = 0; r < 16; ++r) { o[0][r] = 0.f; o[1][r] = 0.f; negm[r] = 0.f; }
    const int n = pol.ntiles, ntot = n + next.count;
    int slot = s0, slot1 = (s0 + 1) % NSLOT, slot2 = (s0 + 2) % NSLOT;
    if (npre < 1) dma_tile<DQ, SLOT, SLOTV>(lds0, Kg, kpitch, Vg, vpitch, pol.key0(0), slot, wid, lane);
    if (npre < 2 && ntot > 1) { if (n > 1) dma_tile<DQ, SLOT, SLOTV>(lds0, Kg, kpitch, Vg, vpitch, pol.key0(1), slot1, wid, lane); else next.dma(lds0, 0, slot1, wid, lane); }
    for (int i = 0; i < n; ++i) {
        if (i + 1 < ntot) { if (DQ == 96 && wid < 4) asm volatile("s_waitcnt vmcnt(3) lgkmcnt(0)\n\ts_barrier" ::: "memory"); else asm volatile("s_waitcnt vmcnt(2) lgkmcnt(0)\n\ts_barrier" ::: "memory"); }
        else ATT_BAR();
        if (i + 2 < ntot) { if (i + 2 < n) dma_tile<DQ, SLOT, SLOTV>(lds0, Kg, kpitch, Vg, vpitch, pol.key0(i + 2), slot2, wid, lane); else next.dma(lds0, i + 2 - n, slot2, wid, lane); }
        if (pol.active(i)) {
            f32x16 p0, p1;
            qkt<DQ>(p0, p1, L + L_K + slot * KSLOT, qr, negm, r32, hi);
            bf16x8 vf[8]; vload_half(vf, vp0 + slot * VSLOT, 0);
            pol.fix(p0, p1, i);
            asm volatile("s_nop 15\n\ts_nop 7" : "+v"(p0), "+v"(p1));
            const float rm = swap_max(max32(p0, p1), lane);
            const bool first = (i == 0);
            if (first || __any(rm > THR)) {
                float dl = first ? rm : __builtin_fmaxf(rm, 0.f);
                if (dl == -INFINITY) dl = 0.f;
                mhat += dl;
#pragma unroll
                for (int r = 0; r < 16; ++r) { p0[r] -= dl; p1[r] -= dl; negm[r] = -mhat; }
                if (!first) {
                    const float f = __builtin_amdgcn_exp2f(-dl); l *= f;
                    if (hi == 0) wsf[r32] = f;
#pragma unroll
                    for (int r = 0; r < 16; ++r) { const float fr_ = wsf[crow(r, hi)]; o[0][r] *= fr_; o[1][r] *= fr_; }
                }
            }
#pragma unroll
            for (int r = 0; r < 16; ++r) { p0[r] = __builtin_amdgcn_exp2f(p0[r]); p1[r] = __builtin_amdgcn_exp2f(p1[r]); }
            vload_half(vf, vp0 + slot * VSLOT, 1);
            l += sum16(p0) + sum16(p1);
            pv_mma(o, vf, p0, p1);
        }
        slot = slot1; slot1 = slot2; slot2 = (slot2 == NSLOT - 1) ? 0 : slot2 + 1;
    }
    ATT_LBAR();
    l_out = swap_sum(l, lane);
}

__device__ __forceinline__ void acc_scaled(f32x16 (&oc)[2], const f32x16 (&o)[2], float rowscale, LAS float* wsf, int r32, int hi) {
    if (hi == 0) wsf[32 + r32] = rowscale;
#pragma unroll
    for (int r = 0; r < 16; ++r) { const float s = wsf[32 + crow(r, hi)]; oc[0][r] += s * o[0][r]; oc[1][r] += s * o[1][r]; }
}
__device__ __forceinline__ void park_store(const f32x16 (&oc)[2], LAS float* park, int lane) {
#pragma unroll
    for (int d0 = 0; d0 < 2; ++d0)
#pragma unroll
        for (int r = 0; r < 16; ++r) park[(d0 * 16 + r) * 64 + lane] = oc[d0][r];
}
template <bool FINAL> __device__ __forceinline__ void park_acc(f32x16 (&oc)[2], LAS float* park, const f32x16 (&o)[2], float rowscale, LAS float* wsf, int lane) {
    const int r32 = lane & 31, hi = lane >> 5;
    if (hi == 0) wsf[32 + r32] = rowscale;
#pragma unroll
    for (int r = 0; r < 16; ++r) { const float s = wsf[32 + crow(r, hi)];
#pragma unroll
        for (int d0 = 0; d0 < 2; ++d0) { const float v = park[(d0 * 16 + r) * 64 + lane] + s * o[d0][r]; if (FINAL) oc[d0][r] = v; else park[(d0 * 16 + r) * 64 + lane] = v; } }
}
__device__ __forceinline__ void store_tile(const f32x16 (&oc)[2], bf16_t* dst, int pitch, LAS unsigned char* L, int wid, int lane, float* ssq) {
    const int r32 = lane & 31, hi = lane >> 5;
    LAS bf16_t* stg = (LAS bf16_t*)(L + L_OST + wid * 8192);
#pragma unroll
    for (int r = 0; r < 16; ++r) { const int orow = crow(r, hi);
#pragma unroll
        for (int d0 = 0; d0 < 2; ++d0) stg[orow * 64 + d0 * 32 + r32] = (bf16_t)f2bf(oc[d0][r]); }
    asm volatile("s_waitcnt lgkmcnt(0)" ::: "memory");
#pragma unroll
    for (int i = 0; i < 4; ++i) { const int row = i * 8 + (lane >> 3), ch = lane & 7; const u32x4 v = *(const LAS u32x4*)(stg + row * 64 + ch * 8); *(u32x4*)(dst + (size_t)row * pitch + ch * 8) = v;
        float ss = sq8(__builtin_bit_cast(bf16x8, v)); ss += lane_xor(ss, lane, 1); ss += lane_xor(ss, lane, 2); ss += lane_xor(ss, lane, 4);
        if (ch == 0) __hip_atomic_fetch_add(ssq + 2 * row, ss, __ATOMIC_RELAXED, __HIP_MEMORY_SCOPE_AGENT); }
    asm volatile("s_waitcnt lgkmcnt(0)" ::: "memory");
}

#define PIN16(v) asm volatile("" : "+v"(v[0]), "+v"(v[1]), "+v"(v[2]), "+v"(v[3]), "+v"(v[4]), "+v"(v[5]), "+v"(v[6]), "+v"(v[7]), "+v"(v[8]), "+v"(v[9]), "+v"(v[10]), "+v"(v[11]), "+v"(v[12]), "+v"(v[13]), "+v"(v[14]), "+v"(v[15]))
__device__ __forceinline__ int clamp127(int d) { return d < 0 ? 0 : (d < 127 ? d : 127); }
struct PolMla { int ntiles, qw0, r32, hi;
    __device__ __forceinline__ int key0(int i) const { return 64 * i; }
    __device__ __forceinline__ bool active(int i) const { return 64 * i <= qw0 + 31; }
    __device__ __forceinline__ int nact() const { const int a = (qw0 + 31) / 64 + 1; return a < ntiles ? a : ntiles; }
    __device__ __forceinline__ void fix(f32x16& p0, f32x16& p1, int i) const {
        if (64 * i + 63 > qw0) { const int q = qw0 + r32, kb = 64 * i + 4 * hi;
#pragma unroll
            for (int r = 0; r < 16; ++r) { const int kv = kb + (r & 3) + 8 * (r >> 2); if (kv > q) p0[r] = -INFINITY; if (kv + 32 > q) p1[r] = -INFINITY; } }
    }
};
struct PolSel { int ntiles, qc, q, hi; unsigned selm; const LAS float* tbh;
    __device__ __forceinline__ int key0(int i) const { return 64 * (qc - i); }
    __device__ __forceinline__ bool active(int i) const { return __any((selm >> (qc - i)) & 1u) != 0; }
    __device__ __forceinline__ int nact() const { return ntiles; }
    __device__ __forceinline__ void fix(f32x16& p0, f32x16& p1, int i) const {
        const bool bit = ((selm >> (qc - i)) & 1u) != 0u;
        if (i <= 2) { const int kb = 64 * (qc - i) + 4 * hi; float bv0[16], bv1[16];
#pragma unroll
            for (int r = 0; r < 16; ++r) { const int d0 = q - (kb + (r & 3) + 8 * (r >> 2)); bv0[r] = tbh[clamp127(d0)]; bv1[r] = tbh[clamp127(d0 - 32)]; }
            PIN16(bv0); PIN16(bv1);
#pragma unroll
            for (int r = 0; r < 16; ++r) { const int d0 = q - (kb + (r & 3) + 8 * (r >> 2)), d1 = d0 - 32;
                p0[r] = (d0 < 0) ? -INFINITY : p0[r] + bv0[r]; p1[r] = (d1 < 0) ? -INFINITY : p1[r] + bv1[r]; } }
        if (!bit) {
#pragma unroll
            for (int r = 0; r < 16; ++r) { p0[r] = -INFINITY; p1[r] = -INFINITY; } }
    }
};
struct PolWin { int ntiles, qc, q, hi; const LAS float* tbh;
    __device__ __forceinline__ int key0(int i) const { return 64 * (qc - i); }
    __device__ __forceinline__ bool active(int) const { return true; }
    __device__ __forceinline__ int nact() const { return ntiles; }
    __device__ __forceinline__ void fix(f32x16& p0, f32x16& p1, int i) const {
        if (i <= 2) { const int kb = 64 * (qc - i) + 4 * hi; float bv0[16], bv1[16];
#pragma unroll
            for (int r = 0; r < 16; ++r) { const int d0 = q - (kb + (r & 3) + 8 * (r >> 2)); bv0[r] = tbh[clamp127(d0)]; bv1[r] = tbh[clamp127(d0 - 32)]; }
            PIN16(bv0); PIN16(bv1);
#pragma unroll
            for (int r = 0; r < 16; ++r) { const int d0 = q - (kb + (r & 3) + 8 * (r >> 2)), d1 = d0 - 32;
                p0[r] = (d0 < 0) ? -INFINITY : p0[r] + bv0[r]; p1[r] = (d1 < 0) ? -INFINITY : p1[r] + bv1[r]; } }
        else if (i == 8) { const int kb = 64 * (qc - i) + 4 * hi;
#pragma unroll
            for (int r = 0; r < 16; ++r) { const int d0 = q - (kb + (r & 3) + 8 * (r >> 2)), d1 = d0 - 32; if (d0 >= 512) p0[r] = -INFINITY; if (d1 >= 512) p1[r] = -INFINITY; } }
    }
};

__device__ __forceinline__ void mla_unit(unsigned char* ws, LAS unsigned char* L, int b, int h, int qb, int wv, int s0, int npre, int nnext) {
    asm volatile("" : "+s"(ws));
    const int tid = opaque_tid(wv), lane = tid & 63, wid = __builtin_amdgcn_readfirstlane(tid >> 6);
    const int r32 = lane & 31, hi = lane >> 5;
    const size_t rowbase = (size_t)b * SEQ; const int qw0 = 256 * qb + 32 * wid;
    bf16x8 qr[6];
    { const bf16_t* Qw = (const bf16_t*)(ws + WS_QM) + (rowbase + qw0 + r32) * MQ + 96 * h + 8 * hi;
      bf16x8 raw[6]; float ss = 0.f;
#pragma unroll
      for (int d0 = 0; d0 < 6; ++d0) { raw[d0] = *(const bf16x8*)(Qw + 16 * d0); ss += sq8(raw[d0]); }
      ss += lane_xor(ss, lane, 32);
      const float rstd = QS_MLA / sqrtf(ss * (1.f / 96) + EPS);
      const float* qg = inptr(7) + 8 * hi;
#pragma unroll
      for (int d0 = 0; d0 < 4; ++d0) qr[d0] = __builtin_bit_cast(bf16x8, scale8(raw[d0], rstd, *(const f32x4*)(qg + 16 * d0), *(const f32x4*)(qg + 16 * d0 + 4)));
      float o1[8], o2[8]; const float posf = (float)(qw0 + r32);
#pragma unroll
      for (int j = 0; j < 8; ++j) { const int i = 8 * hi + j; const float inv = exp2f(-(float)i * (13.287712379549449f / 16.f)); float sn, cs; sincosf(posf * inv, &sn, &cs);
          const float n1 = bf2f((unsigned short)raw[4][j]) * rstd * qg[64 + j], n2 = bf2f((unsigned short)raw[5][j]) * rstd * qg[80 + j];
          o1[j] = n1 * cs - n2 * sn; o2[j] = n2 * cs + n1 * sn; }
      u32x4 w4, w5; w4.x = pk2(o1[0], o1[1]); w4.y = pk2(o1[2], o1[3]); w4.z = pk2(o1[4], o1[5]); w4.w = pk2(o1[6], o1[7]);
      w5.x = pk2(o2[0], o2[1]); w5.y = pk2(o2[2], o2[3]); w5.z = pk2(o2[4], o2[5]); w5.w = pk2(o2[6], o2[7]);
      qr[4] = __builtin_bit_cast(bf16x8, w4); qr[5] = __builtin_bit_cast(bf16x8, w5); }
    const bf16_t* Kg = (const bf16_t*)(ws + WS_KMLA) + rowbase * MQ + 96 * h;
    const bf16_t* Vg = (const bf16_t*)(ws + WS_KVM) + rowbase * MKV + slot_base(4 * (h >> 1) + 2 + (h & 1));
    PolMla pol{4 * qb + 4, qw0, r32, hi};
    f32x16 o[2]; float l;
    const NextTiles<96, false, true, PolMla> nxt{Kg, MQ, Vg, MKV, &pol, nnext};
    flash_loop<96, false, true>(L, Kg, MQ, Vg, MKV, qr, pol, s0, npre, nxt, o, l, wid, lane);
    LAS float* wsf = (LAS float*)(L + L_WSF) + wid * 128;
    f32x16 oc[2];
#pragma unroll
    for (int r = 0; r < 16; ++r) { oc[0][r] = 0.f; oc[1][r] = 0.f; }
    acc_scaled(oc, o, (l > 0.f) ? 1.f / l : 0.f, wsf, r32, hi);
    store_tile(oc, (bf16_t*)(ws + WS_MIX) + (rowbase + qw0) * DM + 64 * h, DM, L, wid, lane, (float*)(ws + WS_SSQM) + 2 * (rowbase + qw0));
}

__device__ __forceinline__ void nsa_unit(unsigned char* ws, LAS unsigned char* L, int b, int g, int qc, int wv) {
    asm volatile("" : "+s"(ws));
#define NSA_IDS() const int tid = opaque_tid(wv), lane = tid & 63, wid = __builtin_amdgcn_readfirstlane(tid >> 6); \
    const int r32 = lane & 31, hi = lane >> 5, rh = wid & 3, qh = wid >> 2, h = 4 * g + rh, qloc = 32 * qh + r32, q = q0 + qloc; \
    const unsigned lds0 = (unsigned)(uintptr_t)L; LAS float* wsf = (LAS float*)(L + L_WSF) + wid * 128; const LAS float* tbh = (const LAS float*)(L + L_TB) + h * 128; \
    LAS float* gate = (LAS float*)(L + L_GATE); (void)tid; (void)lane; (void)r32; (void)hi; (void)rh; (void)qh; (void)h; (void)qloc; (void)q; (void)lds0; (void)wsf; (void)tbh; (void)gate
    const size_t rowbase = (size_t)b * SEQ; const int q0 = 64 * qc;
    const bf16_t* pr = (const bf16_t*)(ws + WS_PROJ);
    bf16x8 qr[4];
    {
    NSA_IDS();
    { const bf16_t* Kc = (const bf16_t*)(ws + WS_KCMP) + ((size_t)b * 256 + g) * 64; const bf16_t* Vc = (const bf16_t*)(ws + WS_VCMP) + ((size_t)b * 256 + g) * 64;
      dma_tile<64>(lds0, Kc, 128, Vc, 128, 0, 0, wid, lane);
      dma_tile<64>(lds0, Kc, 128, Vc, 128, 64, 1, wid, lane);
      dma_tile<64, true>(lds0, pr + rowbase * DINP + slot_base(S_KSEL + g), DINP, pr + rowbase * DINP + slot_base(S_VSEL + g), DINP, 64 * qc, 2, wid, lane); }
    for (int i = tid; i < 768; i += 512) { const int br = i >> 8, r = (i >> 6) & 3, qq = i & 63;
        const float x = bf2f(pr[(rowbase + q0 + qq) * DINP + P_GATE + 8 * br + 4 * g + r]); gate[i] = 1.f / (1.f + __expf(-x)); }
    { const bf16_t* Qw = pr + (rowbase + q) * DINP + slot_base(S_Q + h) + 8 * hi;
#pragma unroll
      for (int d0 = 0; d0 < 4; ++d0) qr[d0] = *(const bf16x8*)(Qw + 128 * (d0 >> 1) + 16 * (d0 & 1)); }
    }
    f32x16 oc[2];
    {
        NSA_IDS();
        ATT_BAR();
        lcp vp0 = L + L_V + ((lane >> 4) & 1) * 32 + (lane & 3) * 8 + (4 * hi + ((lane & 15) >> 2)) * 64;
        LAS float* imp = (LAS float*)(L + L_IMP) + (rh * 64 + qloc) * IMPS;
        f32x16 a0, a1, b0, b1;
        { f32x16 zero;
#pragma unroll
          for (int r = 0; r < 16; ++r) zero[r] = 0.f;
          qkt<64>(a0, a1, L + L_K, qr, zero, r32, hi); qkt<64>(b0, b1, L + L_K + KSLOT, qr, zero, r32, hi); }
#define CMP_FIX(P, coff, extra) do { float bv[16]; \
            _Pragma("unroll") for (int r = 0; r < 16; ++r) bv[r] = tbh[clamp127(q - 16 * (crow(r, hi) + (coff)) - 31)]; \
            PIN16(bv); \
            _Pragma("unroll") for (int r = 0; r < 16; ++r) { const int c = crow(r, hi) + (coff); const int d = q - 16 * c - 31; P[r] = (d < 0 || (extra && c >= NCMP)) ? -INFINITY : P[r] + bv[r]; } } while (0)
        CMP_FIX(a0, 0, false); CMP_FIX(a1, 32, false); CMP_FIX(b0, 64, false); CMP_FIX(b1, 96, true);
#undef CMP_FIX
        float m = swap_max(__builtin_fmaxf(__builtin_fmaxf(max16(a0), max16(a1)), __builtin_fmaxf(max16(b0), max16(b1))), lane);
        if (m == -INFINITY) m = 0.f;
#pragma unroll
        for (int r = 0; r < 16; ++r) { a0[r] = __builtin_amdgcn_exp2f(a0[r] - m); a1[r] = __builtin_amdgcn_exp2f(a1[r] - m); b0[r] = __builtin_amdgcn_exp2f(b0[r] - m); b1[r] = __builtin_amdgcn_exp2f(b1[r] - m); }
        const float lsum = swap_sum((sum16(a0) + sum16(a1)) + (sum16(b0) + sum16(b1)), lane);
        const float inv = (lsum > 0.f) ? 1.f / lsum : 0.f;
        float prev_last = 0.f;
#define CMP_IMP(T, P0, P1) do { float own[8], car[8]; \
            _Pragma("unroll") for (int a = 0; a < 4; ++a) { \
                own[a]     = P0[4 * a] + P0[4 * a + 1] + P0[4 * a + 2] + 0.5f * P0[4 * a + 3]; car[a]     = 0.5f * P0[4 * a + 3]; \
                own[4 + a] = P1[4 * a] + P1[4 * a + 1] + P1[4 * a + 2] + 0.5f * P1[4 * a + 3]; car[4 + a] = 0.5f * P1[4 * a + 3]; } \
            _Pragma("unroll") for (int k = 0; k < 8; ++k) car[k] = lane_xor(car[k], lane, 32); \
            _Pragma("unroll") for (int k = 0; k < 8; ++k) { const float add = hi ? car[k] : (k >= 1 ? car[k - 1] : prev_last); imp[16 * (T) + 2 * k + hi] = own[k] + add; } \
            prev_last = car[7]; } while (0)
        CMP_IMP(0, a0, a1); CMP_IMP(1, b0, b1);
#undef CMP_IMP
        if (hi == 0) ((LAS float*)(L + L_INVL))[rh * 64 + qloc] = inv;
        f32x16 o[2];
#pragma unroll
        for (int r = 0; r < 16; ++r) { o[0][r] = 0.f; o[1][r] = 0.f; }
        pv(o, vp0, a0, a1); pv(o, vp0 + VSLOT, b0, b1);
        ATT_BAR();
        if (qc >= 1) dma_tile<64, true>(lds0, pr + rowbase * DINP + slot_base(S_KSEL + g), DINP, pr + rowbase * DINP + slot_base(S_VSEL + g), DINP, 64 * (qc - 1), 0, wid, lane);
#pragma unroll
        for (int r = 0; r < 16; ++r) { oc[0][r] = 0.f; oc[1][r] = 0.f; }
        acc_scaled(oc, o, gate[(0 * 4 + rh) * 64 + qloc] * inv, wsf, r32, hi);
    }
    if (qc <= 15) {
        const int tid = opaque_tid(wv);
        if (tid < 64) ((LAS unsigned*)(L + L_SELM))[tid] = (qc == 31) ? 0xffffffffu : ((2u << qc) - 1u);
        ATT_LBAR();
    } else {
        const int tid = opaque_tid(wv);
        const LAS float* imp = (const LAS float*)(L + L_IMP); LAS float* sc = (LAS float*)(L + L_SC);
        const int qq = tid >> 3, jj = tid & 7;
        const LAS float* il = (const LAS float*)(L + L_INVL);
        const float i0 = il[qq], i1 = il[64 + qq], i2 = il[128 + qq], i3 = il[192 + qq];
#pragma unroll
        for (int k = 0; k < 4; ++k) { const int j = jj + 8 * k;
            const float tot = (imp[(0 * 64 + qq) * IMPS + j] * i0 + imp[(1 * 64 + qq) * IMPS + j] * i1) + (imp[(2 * 64 + qq) * IMPS + j] * i2 + imp[(3 * 64 + qq) * IMPS + j] * i3);
            float s; if (j > qc) s = -INFINITY; else if (j == 0 || j == qc || j == qc - 1) s = 1e4f; else s = tot; sc[qq * IMPS + j] = s; }
        ATT_LBAR();
        float v[32];
#pragma unroll
        for (int k = 0; k < 32; ++k) v[k] = sc[qq * IMPS + k];
        unsigned bits = 0u;
#pragma unroll
        for (int k = 0; k < 4; ++k) { const int j = jj + 8 * k; const float me = sc[qq * IMPS + j]; int rank = 0;
#pragma unroll
            for (int i = 0; i < 32; ++i) { const float si = v[i]; rank += (si > me || (si == me && i < j)) ? 1 : 0; }
            if (rank < 16) bits |= 1u << j; }
        { const int lane = tid & 63; bits |= lane_xor_u(bits, lane, 1); bits |= lane_xor_u(bits, lane, 2); bits |= lane_xor_u(bits, lane, 4); }
        if (jj == 0) ((LAS unsigned*)(L + L_SELM))[qq] = bits;
        ATT_LBAR();
    }
    { NSA_IDS(); park_store(oc, (LAS float*)(L + L_OST) + wid * 2048, lane); }
    {
        NSA_IDS();
        const unsigned selm = ((const LAS unsigned*)(L + L_SELM))[qloc];
        const bf16_t* Kg = pr + rowbase * DINP + slot_base(S_KSEL + g);
        const bf16_t* Vg = pr + rowbase * DINP + slot_base(S_VSEL + g);
        PolSel pol{qc + 1, qc, q, hi, selm, tbh};
        const PolWin polw{(qc < 8 ? qc : 8) + 1, qc, q, hi, tbh};
        const NextTiles<64, true, true, PolWin> nxt{pr + rowbase * DINP + slot_base(S_KWIN + g), DINP, pr + rowbase * DINP + slot_base(S_VWIN + g), DINP, &polw, polw.ntiles < 2 ? polw.ntiles : 2};
        f32x16 o[2]; float l;
        flash_loop<64, true>(L, Kg, DINP, Vg, DINP, qr, pol, 2, (qc + 1 < 2) ? qc + 1 : 2, nxt, o, l, wid, lane);
        { f32x16 dummy[2]; park_acc<false>(dummy, (LAS float*)(L + L_OST) + wid * 2048, o, (l > 0.f) ? gate[(1 * 4 + rh) * 64 + qloc] / l : 0.f, wsf, lane); }
    }
    {
        NSA_IDS();
        const bf16_t* Kg = pr + rowbase * DINP + slot_base(S_KWIN + g);
        const bf16_t* Vg = pr + rowbase * DINP + slot_base(S_VWIN + g);
        PolWin pol{(qc < 8 ? qc : 8) + 1, qc, q, hi, tbh};
        f32x16 o[2]; float l;
        flash_loop<64, true>(L, Kg, DINP, Vg, DINP, qr, pol, (2 + qc + 1) % NSLOT, pol.ntiles < 2 ? pol.ntiles : 2, NoNext{}, o, l, wid, lane);
        f32x16 fin[2]; park_acc<true>(fin, (LAS float*)(L + L_OST) + wid * 2048, o, (l > 0.f) ? gate[(2 * 4 + rh) * 64 + qloc] / l : 0.f, wsf, lane);
        store_tile(fin, (bf16_t*)(ws + WS_MIX) + (rowbase + q0 + 32 * qh) * DM + 512 + 64 * h, DM, L, wid, lane, (float*)(ws + WS_SSQM) + 2 * (rowbase + q0 + 32 * qh) + 1);
    }
    ATT_BAR();
}
#undef ATT_BAR
#undef ATT_LBAR
#undef NSA_IDS
}

#define XB_TMO      128
#define XB_XCNT(j)  (256  + 64 * (j))
#define XB_XSUB(j)  (1280 + 64 * (j))
#define XB_XGEN(j)  (2304 + 64 * (j))
#define XB_TOP      3328
#define XB_TOPGEN   3392
#define XCD_BAR_WORDS 3456
#define XB_SPIN_CAP (1u << 18)

__device__ __forceinline__ unsigned xb_ld(unsigned* p)              { return __hip_atomic_load(p, __ATOMIC_RELAXED, __HIP_MEMORY_SCOPE_AGENT); }
__device__ __forceinline__ unsigned xb_add(unsigned* p, unsigned v) { return __hip_atomic_fetch_add(p, v, __ATOMIC_RELAXED, __HIP_MEMORY_SCOPE_AGENT); }
__device__ __forceinline__ unsigned xb_xcc_id() { return (unsigned)__builtin_amdgcn_s_getreg((3 << 11) | 20) & 0xFu; }
#define XB_SPIN(cond, bar) do { unsigned _sp = 0; while (cond) { __builtin_amdgcn_s_sleep(1); \
    if ((++_sp & 255u) == 0u) { if (xb_ld(&(bar)[XB_TMO])) break; if (_sp > XB_SPIN_CAP) { atomicAdd(&(bar)[XB_TMO], 1u); break; } } } } while (0)

struct XcdBarrier {
    unsigned* bar; unsigned x;
    volatile LAS unsigned* st;
};

__device__ __forceinline__ XcdBarrier xcd_barrier_post(unsigned* bar, volatile LAS unsigned* st) {
    XcdBarrier b; b.bar = bar; b.x = xb_xcc_id(); b.st = st;
    if (threadIdx.x == 0) (void)xb_add(&bar[XB_XCNT(b.x)], 1u);
    return b;
}
__device__ __forceinline__ void xcd_barrier_complete(unsigned* bar, unsigned x, unsigned& nloc, unsigned& nx) {
    const unsigned G = gridDim.x * gridDim.y * gridDim.z;
    unsigned sum, cnt, mine, sp = 0u;
    for (;;) {
        sum = 0u; cnt = 0u; mine = 0u;
#pragma unroll
        for (unsigned j = 0; j < 16; ++j) { const unsigned c = xb_ld(&bar[XB_XCNT(j)]); sum += c; cnt += (c > 0u) ? 1u : 0u; mine = (j == x) ? c : mine; }
        if (sum == G) break;
        __builtin_amdgcn_s_sleep(1);
        if ((++sp & 255u) == 0u) { if (xb_ld(&bar[XB_TMO])) break; if (sp > XB_SPIN_CAP) { atomicAdd(&bar[XB_TMO], 1u); break; } }
    }
    nloc = mine > 0u ? mine : 1u; nx = cnt > 0u ? cnt : 1u;
}

__device__ __forceinline__ void xcd_barrier(const XcdBarrier& b, const unsigned char* pf = nullptr, int nchunk = 0, int wv = 0) {
    asm volatile("s_waitcnt vmcnt(0)" ::: "memory");
    __syncthreads();
    if (pf != nullptr && wv >= 1 && wv <= 4) {
        const int t = opaque_tid(wv) - 64;
        const pg8::u32x4* src = (const pg8::u32x4*)pf + (size_t)(blockIdx.x & 255) * nchunk;
        pg8::u32x4 v[9];
#pragma unroll
        for (int i = 0; i < 9; ++i) { int c = i * 256 + t; c = c < nchunk ? c : nchunk - 1; v[i] = src[c]; }
        asm volatile("" :: "v"(v[0]), "v"(v[1]), "v"(v[2]), "v"(v[3]), "v"(v[4]), "v"(v[5]), "v"(v[6]), "v"(v[7]), "v"(v[8]));
    }
    if (threadIdx.x == 0) {
        unsigned* bar = b.bar;
        __builtin_amdgcn_s_waitcnt(0);
        unsigned nloc = b.st[0], nx = b.st[1];
        if (nloc == 0u) { xcd_barrier_complete(bar, b.x, nloc, nx); b.st[0] = nloc; b.st[1] = nx; }
        const unsigned old = xb_add(&bar[XB_XSUB(b.x)], 1u);
        const unsigned gen = old / nloc;
        if (old + 1u == (gen + 1u) * nloc) {
            __builtin_amdgcn_fence(__ATOMIC_RELEASE, "agent");
            asm volatile("s_waitcnt vmcnt(0)" ::: "memory");
            const unsigned og = xb_add(&bar[XB_TOP], 1u);
            const unsigned tg = og / nx;
            if (og + 1u == (tg + 1u) * nx) xb_add(&bar[XB_TOPGEN], 1u);
            else XB_SPIN(xb_ld(&bar[XB_TOPGEN]) == tg, bar);
            __builtin_amdgcn_fence(__ATOMIC_ACQUIRE, "agent");
            xb_add(&bar[XB_XGEN(b.x)], 1u);
            asm volatile("s_waitcnt vmcnt(0)" ::: "memory");
        } else {
            XB_SPIN(xb_ld(&bar[XB_XGEN(b.x)]) == gen, bar);
            __builtin_amdgcn_fence(__ATOMIC_ACQUIRE, "agent");
            asm volatile("s_waitcnt vmcnt(0)" ::: "memory");
        }
    }
    __syncthreads();
}

__device__ __forceinline__ void group_sync(unsigned* ctl, unsigned* cnt, unsigned* cnt2, const unsigned char* pf = nullptr, int nchunk = 0, int wv = 0) {
    asm volatile("s_waitcnt vmcnt(0)" ::: "memory");
    __syncthreads();
    if (pf != nullptr && wv >= 1 && wv <= 4) {
        const int t = opaque_tid(wv) - 64;
        const pg8::u32x4* src = (const pg8::u32x4*)pf + (size_t)(blockIdx.x & 255) * nchunk;
        pg8::u32x4 v[9];
#pragma unroll
        for (int i = 0; i < 9; ++i) { int c = i * 256 + t; c = c < nchunk ? c : nchunk - 1; v[i] = src[c]; }
        asm volatile("" :: "v"(v[0]), "v"(v[1]), "v"(v[2]), "v"(v[3]), "v"(v[4]), "v"(v[5]), "v"(v[6]), "v"(v[7]), "v"(v[8]));
    }
    if (threadIdx.x == 0) {
        (void)xb_add(cnt, 1u);
        XB_SPIN(xb_ld(cnt) < 4u, ctl);
        if (cnt2 != nullptr) XB_SPIN(xb_ld(cnt2) < 4u, ctl);
        __builtin_amdgcn_fence(__ATOMIC_ACQUIRE, "agent");
        asm volatile("s_waitcnt vmcnt(0)" ::: "memory");
    }
    __syncthreads();
}

__global__ void __launch_bounds__(512, 2) mega(Params p) {
    extern __shared__ __attribute__((aligned(16))) unsigned char lds[];
    const int G = gridDim.x, bid = blockIdx.x, NGW = G * NW;
    int wv = __builtin_amdgcn_readfirstlane((int)(threadIdx.x >> 6)); asm volatile("" : "+s"(wv));
#define PHASE_IDS() const int tid = opaque_tid(wv), lane = tid & 63, wave = __builtin_amdgcn_readfirstlane(tid >> 6), gw = bid * NW + wave; (void)tid; (void)lane; (void)gw
    unsigned char* ws = (unsigned char*)inptr(22);
    LAS unsigned char* L = (LAS unsigned char*)lds;
    volatile LAS unsigned* bst = (volatile LAS unsigned*)(L + LDS_BST);
    if (threadIdx.x < 4) bst[threadIdx.x] = 0u;
    __syncthreads();
    (void)xcd_barrier_post((unsigned*)(ws + WS_CTL), bst);
#define bar (XcdBarrier{(unsigned*)((unsigned char*)inptr(22) + WS_CTL), xb_xcc_id(), (volatile LAS unsigned*)((LAS unsigned char*)lds + LDS_BST)})

    {
        PHASE_IDS();
        LAS float* scr = (LAS float*)(L + wave * 8704);
        constexpr int I0 = (1024 / 64) * (DINP / 32), I1 = (QR / 64) * (MQ / 32), I2 = (KVR / 64) * (MKV / 32), I3 = 16 * 32, I4 = 16 * (FF / 32), I5 = (FF / 64) * 32;
        constexpr int I6 = (2048 / 64) * (128 / 32), I7 = (128 / 64) * (64 / 32);
        constexpr int NIT = I0 + I1 + I2 + I3 + I4 + I5 + 2 * I6 + 2 * I7;
        for (int it = gw; it < NIT; it += NGW) {
            int r = it;
            if (r < I0) { p0_transpose_item(inptr(2), 1024, DIN, DINP, (bf16_t*)(ws + WS_WIN), scr, r, lane, inptr(1), 0, 1); continue; } r -= I0;
            if (r < I1) { p0_transpose_item(inptr(5), QR, MQ, MQ, (bf16_t*)(ws + WS_WUQ), scr, r, lane, inptr(3)); continue; } r -= I1;
            if (r < I2) { p0_transpose_item(inptr(6), KVR, MKV, MKV, (bf16_t*)(ws + WS_WUKV), scr, r, lane, inptr(4), 0, 2); continue; } r -= I2;
            if (r < I3) { const int k0_ = 64 * (r / 32); p0_transpose_item(inptr(17), 1024, 1024, 1024, (bf16_t*)(ws + WS_WO), scr, r, lane, k0_ < 512 ? inptr(15) : inptr(16) - 512); continue; } r -= I3;
            if (r < I4) { p0_transpose_item(inptr(19), 1024, FF, FF, (bf16_t*)(ws + WS_WUP), scr, r, lane, inptr(18)); continue; } r -= I4;
            if (r < I5) { p0_transpose_item(inptr(20), FF, 1024, 1024, (bf16_t*)(ws + WS_WDN), scr, r, lane, nullptr, LDH); continue; } r -= I5;
            if (r < 2 * I6) { const int kv = r / I6; p0_transpose_item(inptr(12) + (size_t)kv * 2048 * 128, 2048, 128, 128, (bf16_t*)(ws + WS_W1T) + (size_t)kv * 128 * 2048, scr, r % I6, lane); continue; } r -= 2 * I6;
            { const int kv = r / I7; p0_transpose_item(inptr(13) + kv * 128 * 64, 128, 64, 64, (bf16_t*)(ws + WS_W2T) + kv * 64 * 128, scr, r % I7, lane); }
        }
        for (int m = gw; m < M; m += 4 * NGW) rows_to_bf16_rstd<4>(inptr(0), (bf16_t*)(ws + WS_XB), (float*)(ws + WS_RS1), m, NGW, lane);
        for (int e = bid * 512 + tid; e < 2048 * 16; e += G * 512) { const int pos = e >> 4, i = e & 15; const float inv = exp2f(-(float)i * (13.287712379549449f / 16.f)); float sn, cs; sincosf((float)pos * inv, &sn, &cs);
            ((float*)(ws + WS_ROPE))[pos * 32 + i] = cs; ((float*)(ws + WS_ROPE))[pos * 32 + 16 + i] = sn; }
        for (int m = bid * 512 + tid; m < M; m += G * 512) { ((float*)(ws + WS_SSQ2))[m] = 0.f; ((float*)(ws + WS_RSQ))[m] = 0.f; ((float*)(ws + WS_RSKV))[m] = 0.f; ((float*)(ws + WS_SSQKR))[m] = 0.f; ((float*)(ws + WS_SSQM))[2 * m] = 0.f; ((float*)(ws + WS_SSQM))[2 * m + 1] = 0.f; }
    }
    xcd_barrier(bar);
    { pg8::Gemm g{(const bf16_t*)(ws + WS_XB), (const bf16_t*)(ws + WS_WIN), M, DINP, DM, DM, DM}; pg8::StaticOrder S; S.init(M, DINP, G, bid);
      PEpiProj E{(bf16_t*)(ws + WS_PROJ), DINP, (const float*)(ws + WS_RS1), (float*)(ws + WS_RSQ), (float*)(ws + WS_RSKV), (float*)(ws + WS_SSQKR), inptr(9), inptr(10), (const float*)(ws + WS_ROPE), inptr(8)}; pg8::gemm_phase<PEpiProj, pg8::StaticOrder, true, true>(L, g, S, E, wv); }
#define GCNT(sp, pm) ((unsigned*)((unsigned char*)inptr(22) + WS_CTL) + 4096 + ((sp) * 64 + (pm)) * 16)
    if (G == 256) { const int x_ = bid & 7, jj_ = (bid >> 3) & 7, k_ = bid >> 6;
        group_sync((unsigned*)((unsigned char*)inptr(22) + WS_CTL), GCNT(0, 8 * x_ + jj_), ((k_ & 1) && jj_ < 7) ? GCNT(0, 8 * x_ + jj_ + 1) : nullptr); }
    else xcd_barrier(bar);
    { PHASE_IDS();
      __syncthreads();
      if (G == 256) { const int x_ = bid & 7, jj_ = (bid >> 3) & 7, k_ = bid >> 6; compress_block(ws, L, (2 * jj_ + (k_ & 1)) | (x_ << 4) | ((k_ >> 1) << 7), wv); }
      else for (int t = bid; t < 256; t += G) compress_block(ws, L, t, wv); }
    { pg8::Gemm g{(const bf16_t*)(ws + WS_PROJ) + P_HKV, (const bf16_t*)(ws + WS_WUKV), M, MKV, KVR, DINP, KVR}; pg8::StaticOrder S; S.init(M, MKV, G, bid);
      PEpiKV E{(bf16_t*)(ws + WS_KVM), (bf16_t*)(ws + WS_KMLA), (const bf16_t*)(ws + WS_PROJ), (const float*)(ws + WS_RSKV), (const float*)(ws + WS_SSQKR), (const float*)(ws + WS_ROPE), inptr(8)}; pg8::gemm_phase<PEpiKV, pg8::StaticOrder, true, true>(L, g, S, E, wv); }
    asm volatile("" : "+s"(wv));
    { pg8::Gemm g{(const bf16_t*)(ws + WS_PROJ) + P_HQ, (const bf16_t*)(ws + WS_WUQ), M, MQ, QR, DINP, QR}; pg8::StaticOrder S; S.init(M, MQ, G, bid);
      PEpiBf16<0> E{(bf16_t*)(ws + WS_QM), MQ, (const float*)(ws + WS_RSQ), 1.f / QR}; pg8::gemm_phase<PEpiBf16<0>, pg8::StaticOrder, true, false>(L, g, S, E, wv); }
    xcd_barrier(bar);
    {
        PHASE_IDS();
        LAS float* tb = (LAS float*)L;
        for (int i = tid; i < 8 * 128; i += 512) { const int h = i >> 7, n = i & 127; tb[i] = (inptr(14)[t5_bucket(n) * 8 + h] - inptr(14)[31 * 8 + h]) * LOG2E; }
        __syncthreads();
        const int vcu = (G % 8 == 0) ? (bid % 8) * (G / 8) + bid / 8 : bid;
        for (int pr_ = vcu; pr_ < 256; pr_ += G) {
            { const int bg = pr_ >> 4, s_ = pr_ & 15;
#pragma unroll 1
              for (int u_ = 0; u_ < 2; ++u_) att::nsa_unit(ws, L, bg >> 1, bg & 1, (u_ & 1) ? s_ : 31 - s_, wv);
            }
            { const int bh = pr_ >> 2, s_ = pr_ & 3;
#pragma unroll 1
              for (int u_ = 0; u_ < 2; ++u_) att::mla_unit(ws, L, bh >> 3, bh & 7, u_ ? s_ : 7 - s_, wv, u_ ? (4 * (7 - s_) + 4) % att::NSLOT : 0, u_ ? 2 : 0, u_ ? 0 : 2);
            }
        }
    }
    xcd_barrier(bar, ws + WS_WO, (int)((size_t)DM * DM * 2 / 16 / 256), wv);
    { pg8::Gemm g{(const bf16_t*)(ws + WS_MIX), (const bf16_t*)(ws + WS_WO), M, DM, DM, DM, DM}; pg8::StaticOrder S; S.init(M, DM, G, bid);
      PEpiWo E{(const bf16_t*)(ws + WS_XB), (bf16_t*)(ws + WS_H2), (float*)(ws + WS_SSQ2), (const float*)(ws + WS_SSQM), DM}; pg8::gemm_phase<PEpiWo, pg8::StaticOrder, true, true>(L, g, S, E, wv); }
    if (G == 256) group_sync((unsigned*)((unsigned char*)inptr(22) + WS_CTL), GCNT(1, 8 * (bid & 7) + ((bid >> 3) & 7)), nullptr, ws + WS_WUP, (int)((size_t)FF * DM * 2 / 16 / 256), wv);
    else xcd_barrier(bar, ws + WS_WUP, (int)((size_t)FF * DM * 2 / 16 / 256), wv);
    { pg8::Gemm g{(const bf16_t*)(ws + WS_H2), (const bf16_t*)(ws + WS_WUP), M, FF, DM, DM, DM}; pg8::StaticOrder S; S.init(M, FF, G, bid);
      PEpiBf16<2> E{(bf16_t*)(ws + WS_HID), LDH, (const float*)(ws + WS_SSQ2), 1.f / 1024}; pg8::gemm_phase<PEpiBf16<2>, pg8::StaticOrder, true, true>(L, g, S, E, wv); }
    if (G == 256) group_sync((unsigned*)((unsigned char*)inptr(22) + WS_CTL), GCNT(2, 8 * (bid & 7) + ((bid >> 3) & 7)), nullptr, ws + WS_WDN, (int)((size_t)DM * LDH * 2 / 16 / 256), wv);
    else xcd_barrier(bar, ws + WS_WDN, (int)((size_t)DM * LDH * 2 / 16 / 256), wv);
    { pg8::Gemm g{(const bf16_t*)(ws + WS_HID), (const bf16_t*)(ws + WS_WDN), M, DM, FF, LDH, LDH}; pg8::StaticOrder S; S.init(M, DM, G, bid);
      PEpiDown E{(const bf16_t*)(ws + WS_H2), ((float*)inptr(21)), DM}; pg8::gemm_phase<PEpiDown, pg8::StaticOrder, true, true>(L, g, S, E, wv); }
#undef bar
}

extern "C" void kernel_launch(void* const* d_in, const int* in_sizes, int n_in, void* d_out, int out_size,
                              void* d_ws, size_t ws_size, hipStream_t stream) {
    static int grid_blocks = 0;
    if (!grid_blocks) {
        int dev = 0, cus = 0, per_cu = 0;
        (void)hipGetDevice(&dev);
        (void)hipDeviceGetAttribute(&cus, hipDeviceAttributeMultiprocessorCount, dev);
        (void)hipFuncSetAttribute((const void*)mega, hipFuncAttributeMaxDynamicSharedMemorySize, LDS_BYTES);
        (void)hipOccupancyMaxActiveBlocksPerMultiprocessor(&per_cu, (const void*)mega, 512, LDS_BYTES);
        if (per_cu != 1) fprintf(stderr, "note: occupancy query reports %d blocks/CU; launching 1 per CU\n", per_cu);
        grid_blocks = cus;
        if (n_in != 21 || out_size != M * DM || ws_size < 256 * MiB) fprintf(stderr, "unexpected shapes: n_in %d out %d ws %zu\n", n_in, out_size, ws_size);
    }
    Params p{};
    for (int i = 0; i < 21; ++i) p.in[i] = (const float*)d_in[i];
    p.out = (float*)d_out; p.ws = (unsigned char*)d_ws;
    if (hipMemsetAsync((char*)d_ws + WS_CTL, 0, CTL_ZERO_BYTES, stream) != hipSuccess) { fprintf(stderr, "memset of the barrier words failed\n"); return; }
    hipLaunchKernelGGL(mega, dim3(grid_blocks), dim3(512), LDS_BYTES, stream, p);
    hipError_t e = hipPeekAtLastError();
    if (e != hipSuccess) fprintf(stderr, "launch failed: %s (grid %d)\n", hipGetErrorString(e), grid_blocks);
}
```

```cpp
#include <hip/hip_runtime.h>
#include <cstdio>
#include <cstdint>

#define LAS __attribute__((address_space(3)))
typedef unsigned short bf16_t;
typedef short bf16x8 __attribute__((ext_vector_type(8)));
typedef float f32x4 __attribute__((ext_vector_type(4)));
typedef unsigned u32x4 __attribute__((ext_vector_type(4)));
typedef unsigned u32x2 __attribute__((ext_vector_type(2)));

constexpr int BATCH = 8, SEQ = 2048, DM = 1024, M = BATCH * SEQ;
constexpr int DIN = 1976, DINP = 2048;
constexpr int C_HQ = 0, C_HKV = 384, C_HKR = 640, C_QB = 672, C_KVB = 1184, C_GATE = 1952;
constexpr int C_KCMP = C_KVB, C_VCMP = C_KVB + 128, C_KSEL = C_KVB + 256, C_VSEL = C_KVB + 384, C_KWIN = C_KVB + 512, C_VWIN = C_KVB + 640;
constexpr int P_HQ = 1280, P_HKV = 1664, P_HKR = 1920, P_GATE = 1952;
__host__ __device__ constexpr int slot_base(int s) { return 256 * (s >> 2) + 32 * (s & 3); }
constexpr int S_Q = 0, S_KCMP = 8, S_VCMP = 10, S_KSEL = 12, S_VSEL = 14, S_KWIN = 16, S_VWIN = 18;
constexpr int QR = 384, KVR = 256, MQ = 768, MKV = 1024, FF = 4096;
constexpr int LDH = FF + 64;
constexpr int NCMP = 127;
constexpr float EPS = 1e-6f;
constexpr float LOG2E = 1.4426950408889634f;
constexpr float QS_MLA = 0.10206207261596577f * LOG2E;
constexpr float QS_NSA = 0.125f * LOG2E;

constexpr size_t MiB = 1u << 20;
constexpr size_t WS_CTL = 0, CTL_ZERO_BYTES = 65536;
constexpr size_t WS_WIN = 1 * MiB, WS_WUQ = 5 * MiB, WS_WUKV = 6 * MiB, WS_WO = 7 * MiB, WS_WUP = 9 * MiB, WS_WDN = 17 * MiB;
constexpr size_t WS_KCMP = 26 * MiB, WS_VCMP = 26 * MiB + 512 * 1024;
constexpr size_t WS_W1T = 30 * MiB;
constexpr size_t WS_W2T = 27 * MiB;
constexpr size_t WS_RSQ = 28 * MiB, WS_RSKV = 28 * MiB + 65536, WS_SSQ2 = 28 * MiB + 131072, WS_SSQM = 28 * MiB + 262144, WS_RS1 = 28 * MiB + 262144 + 131072;
constexpr size_t WS_SSQKR = 28 * MiB + 524288;
constexpr size_t WS_ROPE = 29 * MiB + 65536;
constexpr size_t WS_XB = 32 * MiB;
constexpr size_t WS_DUMMY0 = 0;
constexpr size_t WS_HB = 32 * MiB;
constexpr size_t WS_MIX = 64 * MiB;
constexpr size_t WS_PROJ = 96 * MiB;
constexpr size_t WS_QM = 160 * MiB;
constexpr size_t WS_KVM = 184 * MiB;
constexpr size_t WS_KMLA = 216 * MiB;
constexpr size_t WS_QN = 208 * MiB;
constexpr size_t WS_KSEL = 240 * MiB;
constexpr size_t WS_KWIN = 244 * MiB;
constexpr size_t WS_HQN = 232 * MiB;
constexpr size_t WS_HKVN = 244 * MiB;
constexpr size_t WS_H2 = 224 * MiB;
constexpr size_t WS_HID = 32 * MiB;

constexpr int LDS_BYTES = 155648, LDS_BST = 154624;
constexpr int NW = 8;

struct Params {
    const float* in[21];
    float* out;
    unsigned char* ws;
};

typedef const float* cfptr_t;
__device__ __forceinline__ const float* inptr(int i) {
    const __attribute__((address_space(4))) char* ka = (const __attribute__((address_space(4))) char*)__builtin_amdgcn_kernarg_segment_ptr();
    int off = i * 8; asm volatile("" : "+s"(off));
    return *(const __attribute__((address_space(4))) cfptr_t*)(ka + off);
}
template <class V> __device__ __forceinline__ void st16_wt(const void* sbase, unsigned voff, const V& v) { static_assert(sizeof(V) == 16, "16-byte vector"); asm volatile("global_store_dwordx4 %0, %1, %2 sc1\n\ts_nop 1" :: "v"(voff), "v"(v), "s"(sbase) : "memory"); }
__device__ __forceinline__ unsigned f2bf(float f) { unsigned u = __builtin_bit_cast(unsigned, f); return (u + 0x7fffu + ((u >> 16) & 1u)) >> 16; }
__device__ __forceinline__ float bf2f(unsigned b) { return __builtin_bit_cast(float, b << 16); }
__device__ __forceinline__ unsigned pk2(float lo, float hi) { return f2bf(lo) | (f2bf(hi) << 16); }
__device__ __forceinline__ float wave_sum(float v) {
#pragma unroll
    for (int o = 1; o < 64; o <<= 1) v += __shfl_xor(v, o);
    return v;
}
__device__ __forceinline__ int t5_bucket(int n) {
    if (n < 16) return n;
    int b = 16;
    b += (n >= 19); b += (n >= 21); b += (n >= 24); b += (n >= 27); b += (n >= 31); b += (n >= 35); b += (n >= 40); b += (n >= 46);
    b += (n >= 52); b += (n >= 59); b += (n >= 67); b += (n >= 77); b += (n >= 87); b += (n >= 99); b += (n >= 113);
    return b;
}

__device__ __forceinline__ void p0_transpose_item(const float* W, int K, int N, int Npad, bf16_t* WT, LAS float* scr, int item, int lane, const float* gk = nullptr, int ldw = 0, int projmap = 0) {
    const int nblk = Npad / 32, kb = item / nblk, nb = item % nblk, k0 = 64 * kb, n0 = 32 * nb;
    int nsrc = n0;
    if (projmap == 2) { const int pn_ = n0 >> 8, bj_ = (n0 >> 7) & 1, wc_ = (n0 >> 5) & 3; nsrc = (wc_ < 2 ? 128 * (2 * pn_ + wc_) : 128 * (2 * pn_ + wc_ - 2) + 64) + 32 * bj_; }
    else if (projmap) { if (n0 < 1280) { const int sl = 4 * (n0 >> 8) + ((n0 & 127) >> 5), e0 = 32 * ((n0 >> 7) & 1); nsrc = (sl < 8 ? C_QB + 64 * sl : C_KVB + 64 * (sl - 8)) + e0; }
                   else if (n0 < 1280 + 672) nsrc = n0 - 1280; else if (n0 == P_GATE) nsrc = C_GATE; else nsrc = N; }
    const int nn = nsrc + (lane & 31);
    float wv[32];
#pragma unroll
    for (int i = 0; i < 32; ++i) { const int kk = 2 * i + (lane >> 5); wv[i] = (nn < N) ? W[(size_t)(k0 + kk) * N + nn] : 0.f; }
#pragma unroll
    for (int i = 0; i < 32; ++i) { const int kk = 2 * i + (lane >> 5); const float gg = gk ? gk[k0 + kk] : 1.f; scr[kk * 33 + (lane & 31)] = wv[i] * gg; }
    asm volatile("s_waitcnt lgkmcnt(0)" ::: "memory");
    const int c = lane & 7;
#pragma unroll
    for (int j = 0; j < 4; ++j) { const int n = (lane >> 3) + 8 * j; const LAS float* s = scr + (8 * c) * 33 + n;
        u32x4 o; o.x = pk2(s[0 * 33], s[1 * 33]); o.y = pk2(s[2 * 33], s[3 * 33]); o.z = pk2(s[4 * 33], s[5 * 33]); o.w = pk2(s[6 * 33], s[7 * 33]);
        *(u32x4*)(WT + (size_t)(n0 + n) * (ldw ? ldw : K) + k0 + 8 * c) = o; }
    asm volatile("s_waitcnt lgkmcnt(0)" ::: "memory");
}
template <int NR>
__device__ __forceinline__ void rows_to_bf16_rstd(const float* x, bf16_t* o, float* rstd_out, int row0, int rstride, int lane) {
    f32x4 v[NR][4];
#pragma unroll
    for (int r = 0; r < NR; ++r) { const int rr = (row0 + r * rstride < M) ? row0 + r * rstride : row0; const f32x4* xr = (const f32x4*)(x + (size_t)rr * DM) + lane;
#pragma unroll
        for (int j = 0; j < 4; ++j) v[r][j] = xr[64 * j]; }
#pragma unroll
    for (int r = 0; r < NR; ++r) { if (row0 + r * rstride >= M) continue; float s = 0.f;
#pragma unroll
        for (int j = 0; j < 4; ++j) s += (v[r][j].x * v[r][j].x + v[r][j].y * v[r][j].y) + (v[r][j].z * v[r][j].z + v[r][j].w * v[r][j].w);
        s = wave_sum(s);
        if (lane == 0) rstd_out[row0 + r * rstride] = 1.f / sqrtf(s * (1.f / DM) + EPS);
        unsigned long long* o8 = (unsigned long long*)(o + (size_t)(row0 + r * rstride) * DM) + lane;
#pragma unroll
        for (int j = 0; j < 4; ++j) o8[64 * j] = (unsigned long long)pk2(v[r][j].x, v[r][j].y) | ((unsigned long long)pk2(v[r][j].z, v[r][j].w) << 32); }
}

__device__ __forceinline__ int opaque_tid(int wv) { int lane; asm volatile("v_mbcnt_lo_u32_b32 %0, -1, 0\n\tv_mbcnt_hi_u32_b32 %0, -1, %0" : "=v"(lane)); return (wv << 6) | lane; }
namespace pg8 {
#define PG8_LAS __attribute__((address_space(3)))
typedef unsigned short bf16_t;
typedef short bf16x8 __attribute__((ext_vector_type(8)));
typedef float f32x4 __attribute__((ext_vector_type(4)));
typedef unsigned u32x4 __attribute__((ext_vector_type(4)));
constexpr int BM = 256, BK = 64, HALF = 128, HTB = HALF * BK * 2  , STAGE_BYTES = 8 * HTB, NXCD = 8, WGM = 8;

__host__ __device__ __forceinline__ int lds_byte(int r, int c) { const int st = (r >> 4) * 2 + (c >> 5), rr = r & 15, cc = c & 31, ob = rr * 64 + cc * 2; return st * 1024 + (ob ^ (((ob >> 9) & 1) << 5)); }
__host__ __device__ __forceinline__ void stage_rc(int b, int& R, int& C) { const int st = b / 1024, sb = b % 1024, swz = sb ^ (((sb >> 9) & 1) << 5); R = (st >> 1) * 16 + swz / 64; C = (st & 1) * 32 + (swz % 64) / 2; }
__host__ __device__ __forceinline__ int perm32(int rho) { const int n = rho >> 4, i = rho & 15; return 8 * (i >> 2) + 4 * n + (i & 3); }

struct Unit { int pm, pn; };
struct Gemm { const bf16_t* A; const bf16_t* Bt; int M, N, K, lda, ldb; };

struct StaticOrder {
    int nM, nN, nwg, G, c;
    __host__ __device__ void init(int M, int N, int G_, int c_) { nM = M / BM; nN = N / BM; nwg = nM * nN; G = G_; c = c_; }
    __host__ __device__ bool next(int i, Unit& u) const {
        const long L = (long)i * G + c; if (L >= nwg) return false;
        int wgid = (int)L; { const int q = nwg / NXCD, r = nwg % NXCD, xcd = wgid % NXCD, off = wgid / NXCD; wgid = (xcd < r ? xcd * (q + 1) : r * (q + 1) + (xcd - r) * q) + off; }
        const int nig = WGM * nN, gid = wgid / nig, fm = gid * WGM, gsz = (nM - fm) < WGM ? (nM - fm) : WGM;
        u.pm = fm + ((wgid % nig) % gsz); u.pn = (wgid % nig) / gsz; return true;
    }
    __device__ __forceinline__ void a_ready(const Unit&) const {}
    __device__ __forceinline__ void done(const Unit&) const {}
};

template <class Epi, class Sched, bool ALIGN_EPI = false, bool SP2 = false>
__device__ __forceinline__ void gemm_phase(PG8_LAS unsigned char* lds, const Gemm g, const Sched& S, const Epi& E, int wv) {
    const int tid = opaque_tid(wv), wid = __builtin_amdgcn_readfirstlane(tid >> 6), lane = tid & 63, wr = wid >> 2, wc = wid & 3, fr = lane & 15, fq = lane >> 4;
    const int K = g.K, nt = K / BK;
    unsigned voffA[2], voffB[2];
#pragma unroll
    for (int i = 0; i < 2; ++i) { int R, C; stage_rc(tid * 16 + i * 8192, R, C); const int Rb = Epi::PERM ? ((R & ~31) + perm32(R & 31)) : R;
        voffA[i] = (unsigned)(R * g.lda + C) * 2u; voffB[i] = (unsigned)(Rb * g.ldb + C) * 2u; }
    const size_t kstep = (size_t)(BK * 2);
    const size_t hstepA = (size_t)HALF * g.lda * 2, hstepB = (size_t)HALF * g.ldb * 2;
    const size_t tstepA = 2 * hstepA, tstepB = 2 * hstepB;
    const unsigned ldsw = (unsigned)wid * 1024u;
    const int aoff = lds_byte(wr * 64 + fr, fq * 8), boff = lds_byte(wc * 32 + fr, fq * 8);
#define PG8_SA(b, h) (((b) * 2 + (h)) * HTB)
#define PG8_SB(b, h) ((4 + (b) * 2 + (h)) * HTB)
#define PG8_STAGE(bufoff, gbase, voff) do { _Pragma("unroll") for (int _i = 0; _i < 2; ++_i) \
        __builtin_amdgcn_global_load_lds((const unsigned*)((const char*)(gbase) + (voff)[_i]), (PG8_LAS unsigned*)(lds + (bufoff) + ldsw + _i * 8192), 16, 0, 0); } while (0)
#define PG8_LDA(dst, b, h) do { _Pragma("unroll") for (int m = 0; m < 4; ++m) _Pragma("unroll") for (int k = 0; k < 2; ++k) dst[m][k] = *(const PG8_LAS bf16x8*)(lds + PG8_SA(b, h) + aoff + m * 2048 + k * 1024); } while (0)
#define PG8_LDB(dst, b, h) do { _Pragma("unroll") for (int n = 0; n < 2; ++n) _Pragma("unroll") for (int k = 0; k < 2; ++k) dst[n][k] = *(const PG8_LAS bf16x8*)(lds + PG8_SB(b, h) + boff + n * 2048 + k * 1024); } while (0)
#define PG8_MMA(ai, bj, At, Bt) do { __builtin_amdgcn_s_setprio(1); _Pragma("unroll") for (int m = 0; m < 4; ++m) _Pragma("unroll") for (int n = 0; n < 2; ++n) _Pragma("unroll") for (int k = 0; k < 2; ++k) \
        acc[ai][bj][m][n] = __builtin_amdgcn_mfma_f32_16x16x32_bf16(Bt[n][k], At[m][k], acc[ai][bj][m][n], 0, 0, 0); __builtin_amdgcn_s_setprio(0); } while (0)
#define PG8_WAIT_V(n) asm volatile("s_waitcnt vmcnt(" #n ")" ::: "memory")
#define PG8_WAIT_L(n) asm volatile("s_waitcnt lgkmcnt(" #n ")" ::: "memory")
#define PG8_BAR __builtin_amdgcn_s_barrier()
#define PG8_SCHED __builtin_amdgcn_sched_barrier(0)
    Unit cur, nxt; int ui = 0;
    if (!S.next(0, cur)) return;
    f32x4 acc[2][2][4][2];
#pragma unroll
    for (int a = 0; a < 2; ++a)
#pragma unroll
        for (int b = 0; b < 2; ++b)
#pragma unroll
            for (int m = 0; m < 4; ++m)
#pragma unroll
                for (int n = 0; n < 2; ++n) acc[a][b][m][n] = (f32x4){0.f, 0.f, 0.f, 0.f};
    bf16x8 At[4][2], B0[2][2], B1[2][2];
    const char* cA = (const char*)g.A + (size_t)cur.pm * tstepA; const char* cB = (const char*)g.Bt + (size_t)cur.pn * tstepB;
    asm volatile("" : "+s"(cA), "+s"(cB));
    S.a_ready(cur);
    if constexpr (SP2) {
        PG8_STAGE(PG8_SB(0, 0), cB, voffB); PG8_STAGE(PG8_SB(0, 1), cB + hstepB, voffB); PG8_STAGE(PG8_SA(0, 0), cA, voffA); PG8_STAGE(PG8_SA(0, 1), cA + hstepA, voffA);
        if (wr == 1) PG8_BAR;
        PG8_WAIT_V(2); PG8_BAR;
        PG8_STAGE(PG8_SB(1, 0), cB + kstep, voffB); PG8_STAGE(PG8_SA(1, 0), cA + kstep, voffA); PG8_STAGE(PG8_SB(1, 1), cB + hstepB + kstep, voffB);
        PG8_WAIT_V(6); PG8_BAR;
    } else {
        PG8_STAGE(PG8_SB(0, 0), cB, voffB); PG8_STAGE(PG8_SA(0, 0), cA, voffA); PG8_STAGE(PG8_SB(0, 1), cB + hstepB, voffB); PG8_STAGE(PG8_SA(0, 1), cA + hstepA, voffA);
        if (wr == 1) PG8_BAR;
        PG8_WAIT_V(4); PG8_BAR;
        PG8_STAGE(PG8_SB(1, 0), cB + kstep, voffB); PG8_STAGE(PG8_SA(1, 0), cA + kstep, voffA); PG8_STAGE(PG8_SB(1, 1), cB + hstepB + kstep, voffB);
        PG8_WAIT_V(6); PG8_BAR;
    }
    for (;;) {
        const bool has_next = S.next(ui + 1, nxt);
        const char* nA = has_next ? (const char*)g.A + (size_t)nxt.pm * tstepA : cA; const char* nB = has_next ? (const char*)g.Bt + (size_t)nxt.pn * tstepB : cB;
        asm volatile("" : "+s"(nA), "+s"(nB));
        for (int t = 0; t < nt; t += 2) {
            if constexpr (Epi::MIDSCALE) { if (t == nt / 2) E.midscale(acc, cur, wr, fr); }
            const bool last = (t == nt - 2);
            const char* a1 = cA + (size_t)(t + 1) * kstep;
            const char* a2 = last ? nA : cA + (size_t)(t + 2) * kstep; const char* b2 = last ? nB : cB + (size_t)(t + 2) * kstep;
            const char* a3 = a2 + kstep; const char* b3 = b2 + kstep;
            asm volatile("" : "+s"(a1), "+s"(a2), "+s"(b2), "+s"(a3), "+s"(b3));
            if (last && has_next) S.a_ready(nxt);
            if constexpr (SP2) {
            PG8_LDB(B0, 0, 0); PG8_LDB(B1, 0, 1); PG8_SCHED; PG8_LDA(At, 0, 0); PG8_STAGE(PG8_SA(1, 1), a1 + hstepA, voffA);
            PG8_WAIT_V(8); PG8_WAIT_L(0); PG8_BAR; PG8_MMA(0, 0, At, B0); PG8_MMA(0, 1, At, B1); PG8_BAR; PG8_SCHED;
            PG8_LDA(At, 0, 1); PG8_STAGE(PG8_SB(0, 0), b2, voffB); PG8_STAGE(PG8_SB(0, 1), b2 + hstepB, voffB); PG8_STAGE(PG8_SA(0, 0), a2, voffA);
            PG8_WAIT_V(8); PG8_WAIT_L(0); PG8_BAR; PG8_MMA(1, 0, At, B0); PG8_MMA(1, 1, At, B1); PG8_BAR; PG8_SCHED;
            PG8_LDB(B0, 1, 0); PG8_LDB(B1, 1, 1); PG8_SCHED; PG8_LDA(At, 1, 0); PG8_STAGE(PG8_SA(0, 1), a2 + hstepA, voffA);
            PG8_WAIT_V(8); PG8_WAIT_L(0); PG8_BAR; PG8_MMA(0, 0, At, B0); PG8_MMA(0, 1, At, B1); PG8_BAR; PG8_SCHED;
            PG8_LDA(At, 1, 1); PG8_STAGE(PG8_SB(1, 0), b3, voffB); PG8_STAGE(PG8_SB(1, 1), b3 + hstepB, voffB); PG8_STAGE(PG8_SA(1, 0), a3, voffA);
            PG8_WAIT_V(8); PG8_WAIT_L(0); PG8_BAR; PG8_MMA(1, 0, At, B0); PG8_MMA(1, 1, At, B1); PG8_BAR; PG8_SCHED;
            } else {
            PG8_LDB(B0, 0, 0); PG8_SCHED; PG8_LDA(At, 0, 0); PG8_STAGE(PG8_SA(1, 1), a1 + hstepA, voffA);
            PG8_WAIT_L(8); PG8_BAR; PG8_WAIT_L(0); PG8_MMA(0, 0, At, B0); PG8_BAR; PG8_SCHED;
            PG8_LDB(B1, 0, 1); PG8_STAGE(PG8_SB(0, 0), b2, voffB);
            PG8_BAR; PG8_WAIT_L(0); PG8_MMA(0, 1, At, B1); PG8_BAR;
            PG8_LDA(At, 0, 1); PG8_STAGE(PG8_SA(0, 0), a2, voffA);
            PG8_BAR; PG8_WAIT_L(0); PG8_MMA(1, 0, At, B0); PG8_BAR; PG8_SCHED;
            PG8_STAGE(PG8_SB(0, 1), b2 + hstepB, voffB);
            PG8_WAIT_V(6); PG8_BAR; PG8_MMA(1, 1, At, B1); PG8_BAR;
            PG8_LDB(B0, 1, 0); PG8_SCHED; PG8_LDA(At, 1, 0); PG8_STAGE(PG8_SA(0, 1), a2 + hstepA, voffA);
            PG8_WAIT_L(8); PG8_BAR; PG8_WAIT_L(0); PG8_MMA(0, 0, At, B0); PG8_BAR; PG8_SCHED;
            PG8_LDB(B1, 1, 1); PG8_STAGE(PG8_SB(1, 0), b3, voffB);
            PG8_BAR; PG8_WAIT_L(0); PG8_MMA(0, 1, At, B1); PG8_BAR;
            PG8_LDA(At, 1, 1); PG8_STAGE(PG8_SA(1, 0), a3, voffA);
            PG8_BAR; PG8_WAIT_L(0); PG8_MMA(1, 0, At, B0); PG8_BAR; PG8_SCHED;
            PG8_STAGE(PG8_SB(1, 1), b3 + hstepB, voffB);
            PG8_WAIT_V(6); PG8_BAR; PG8_MMA(1, 1, At, B1); PG8_BAR;
            }
        }
        if constexpr (ALIGN_EPI) { if (wr == 0) PG8_BAR; }
        if constexpr (!Epi::AFTER_DRAIN) { const int l2_ = opaque_tid(wv) & 63; E(acc, cur, wr, wc, l2_ & 15, l2_ >> 4); S.done(cur); }
        if (!has_next) break;
#pragma unroll
        for (int a = 0; a < 2; ++a)
#pragma unroll
            for (int b = 0; b < 2; ++b)
#pragma unroll
                for (int m = 0; m < 4; ++m)
#pragma unroll
                    for (int n = 0; n < 2; ++n) acc[a][b][m][n] = (f32x4){0.f, 0.f, 0.f, 0.f};
        cur = nxt; cA = nA; cB = nB; ++ui;
        if constexpr (ALIGN_EPI) { if (wr == 1) PG8_BAR; }
    }
    PG8_WAIT_V(0);
    if constexpr (!ALIGN_EPI) { if (wr == 0) PG8_BAR; }
    PG8_BAR;
    if constexpr (Epi::AFTER_DRAIN) { E.fused(acc, cur, wr, wc, fr, fq, lds, wid, lane); S.done(cur); }
#undef PG8_SA
#undef PG8_SB
#undef PG8_STAGE
#undef PG8_LDA
#undef PG8_LDB
#undef PG8_MMA
#undef PG8_WAIT_V
#undef PG8_WAIT_L
#undef PG8_BAR
#undef PG8_SCHED
}
}

__device__ __forceinline__ unsigned cvt_pk_bf16(float lo, float hi) { unsigned r; asm volatile("v_cvt_pk_bf16_f32 %0, %1, %2" : "=v"(r) : "v"(lo), "v"(hi)); return r; }
template <int ACT> struct PEpiBf16 {
    static constexpr bool PERM = true, AFTER_DRAIN = false, MIDSCALE = false;
    bf16_t* O; int ldc; const float* rs; float invn;
    __device__ __forceinline__ void operator()(const f32x4 (&acc)[2][2][4][2], const pg8::Unit& u, int wr, int wc, int fr, int fq) const {
        const int row0 = u.pm * 256 + wr * 64 + fr, col0 = u.pn * 256 + wc * 32 + 8 * fq;
        float rsc[2][4];
#pragma unroll
        for (int ai = 0; ai < 2; ++ai)
#pragma unroll
            for (int m = 0; m < 4; ++m) rsc[ai][m] = rs ? rs[row0 + ai * 128 + m * 16] : 1.f;
        if (invn > 0.f) {
#pragma unroll
            for (int ai = 0; ai < 2; ++ai)
#pragma unroll
                for (int m = 0; m < 4; ++m) rsc[ai][m] = 1.f / sqrtf(rsc[ai][m] * invn + EPS); }
#pragma unroll
        for (int ai = 0; ai < 2; ++ai)
#pragma unroll
            for (int m = 0; m < 4; ++m) { const bf16_t* rowp = O + ((size_t)(u.pm * 256 + wr * 64 + ai * 128 + m * 16) * ldc + u.pn * 256 + wc * 32); const unsigned lo_ = (unsigned)(fr * ldc + 8 * fq) * 2u; const float sc_ = rsc[ai][m];
#pragma unroll
                for (int bj = 0; bj < 2; ++bj) { f32x4 v0 = acc[ai][bj][m][0] * sc_, v1 = acc[ai][bj][m][1] * sc_;
                    if (ACT == 2) {
#pragma unroll
                        for (int e = 0; e < 4; ++e) { const float a = fmaxf(v0[e], 0.f), b = fmaxf(v1[e], 0.f); v0[e] = a * a; v1[e] = b * b; } }
                    u32x4 w; w.x = cvt_pk_bf16(v0[0], v0[1]); w.y = cvt_pk_bf16(v0[2], v0[3]); w.z = cvt_pk_bf16(v1[0], v1[1]); w.w = cvt_pk_bf16(v1[2], v1[3]);
                    st16_wt(rowp + bj * 128, lo_, w); } }
    }
};
struct PEpiProj {
    static constexpr bool PERM = true, AFTER_DRAIN = false, MIDSCALE = false;
    bf16_t* O; int ldc; const float* rs1; float* ssq_q; float* ssq_kv; float* ssq_kr; const float* qgain; const float* kgain; const float* rope; const float* kgm;
    __device__ __forceinline__ void operator()(const f32x4 (&acc)[2][2][4][2], const pg8::Unit& u, int wr, int wc, int fr, int fq) const {
        const int row0 = u.pm * 256 + wr * 64 + fr, col0 = u.pn * 256 + wc * 32 + 8 * fq, lane = fq * 16 + fr;
        float rsc[2][4];
#pragma unroll
        for (int ai = 0; ai < 2; ++ai)
#pragma unroll
            for (int m = 0; m < 4; ++m) rsc[ai][m] = rs1[row0 + ai * 128 + m * 16];
        const int sl = 4 * u.pn + wc;
        int mode = 0; const float* g = nullptr; float gs = 1.f;
        if (u.pn < 5) { if (sl < 8) { mode = 1; g = qgain; gs = QS_NSA; } else if (sl == S_KSEL || sl == S_KSEL + 1) { mode = 1; g = kgain + 64; } else if (sl == S_KWIN || sl == S_KWIN + 1) { mode = 1; g = kgain + 128; } }
        f32x4 ga[2][2];
        if (mode == 1) {
#pragma unroll
            for (int bj = 0; bj < 2; ++bj) { ga[bj][0] = *(const f32x4*)(g + 32 * bj + 8 * fq) * gs; ga[bj][1] = *(const f32x4*)(g + 32 * bj + 8 * fq + 4) * gs; } }
#pragma unroll
        for (int ai = 0; ai < 2; ++ai)
#pragma unroll
            for (int m = 0; m < 4; ++m) { const int row = row0 + ai * 128 + m * 16; const bf16_t* rowp = O + ((size_t)(u.pm * 256 + wr * 64 + ai * 128 + m * 16) * ldc + u.pn * 256 + wc * 32); const unsigned lo_ = (unsigned)(fr * ldc + 8 * fq) * 2u; const float sc_ = rsc[ai][m];
                f32x4 v[2][2];
#pragma unroll
                for (int bj = 0; bj < 2; ++bj) { v[bj][0] = acc[ai][bj][m][0] * sc_; v[bj][1] = acc[ai][bj][m][1] * sc_; }
                if (mode == 1) {
                    float ss = 0.f;
#pragma unroll
                    for (int bj = 0; bj < 2; ++bj)
#pragma unroll
                        for (int n = 0; n < 2; ++n) ss += (v[bj][n][0] * v[bj][n][0] + v[bj][n][1] * v[bj][n][1]) + (v[bj][n][2] * v[bj][n][2] + v[bj][n][3] * v[bj][n][3]);
                    ss += __builtin_bit_cast(float, __builtin_amdgcn_ds_bpermute((lane ^ 16) << 2, __builtin_bit_cast(int, ss)));
                    ss += __builtin_bit_cast(float, __builtin_amdgcn_ds_bpermute((lane ^ 32) << 2, __builtin_bit_cast(int, ss)));
                    const float rstd = 1.f / sqrtf(ss * (1.f / 64) + EPS);
#pragma unroll
                    for (int bj = 0; bj < 2; ++bj) { v[bj][0] = v[bj][0] * rstd * ga[bj][0]; v[bj][1] = v[bj][1] * rstd * ga[bj][1]; }
                } else if (u.pn >= 5) {
#pragma unroll
                    for (int bj = 0; bj < 2; ++bj) { const int cb = u.pn * 256 + bj * 128;
                        float* dst = (cb < P_HKV) ? ssq_q : (cb < P_HKR ? ssq_kv : ((cb == P_HKR && wc == 0) ? ssq_kr : nullptr));
                        if (dst) { float ss = (v[bj][0][0] * v[bj][0][0] + v[bj][0][1] * v[bj][0][1]) + (v[bj][0][2] * v[bj][0][2] + v[bj][0][3] * v[bj][0][3]) + (v[bj][1][0] * v[bj][1][0] + v[bj][1][1] * v[bj][1][1]) + (v[bj][1][2] * v[bj][1][2] + v[bj][1][3] * v[bj][1][3]);
                            ss += __builtin_bit_cast(float, __builtin_amdgcn_ds_bpermute((lane ^ 16) << 2, __builtin_bit_cast(int, ss)));
                            ss += __builtin_bit_cast(float, __builtin_amdgcn_ds_bpermute((lane ^ 32) << 2, __builtin_bit_cast(int, ss)));
                            if (fq == 0) __hip_atomic_fetch_add(dst + row, ss, __ATOMIC_RELAXED, __HIP_MEMORY_SCOPE_AGENT); }
                        if (cb == P_HKR && wc == 0) {
                            const f32x4 g0 = *(const f32x4*)(kgm + 64 + 8 * fq), g1 = *(const f32x4*)(kgm + 64 + 8 * fq + 4);
                            const float* rp = rope + (size_t)(row & (SEQ - 1)) * 32 + 8 * (fq & 1);
                            const f32x4 c0 = *(const f32x4*)rp, c1 = *(const f32x4*)(rp + 4), s0 = *(const f32x4*)(rp + 16), s1 = *(const f32x4*)(rp + 20);
#pragma unroll
                            for (int n = 0; n < 2; ++n)
#pragma unroll
                                for (int j = 0; j < 4; ++j) { const float nv = v[bj][n][j] * (n ? g1[j] : g0[j]);
                                    const float pv = __builtin_bit_cast(float, __builtin_amdgcn_ds_bpermute((lane ^ 32) << 2, __builtin_bit_cast(int, nv)));
                                    const float cs = n ? c1[j] : c0[j], sn = n ? s1[j] : s0[j]; v[bj][n][j] = (fq < 2) ? nv * cs - pv * sn : nv * cs + pv * sn; } } }
                }
#pragma unroll
                for (int bj = 0; bj < 2; ++bj) { u32x4 w; w.x = cvt_pk_bf16(v[bj][0][0], v[bj][0][1]); w.y = cvt_pk_bf16(v[bj][0][2], v[bj][0][3]); w.z = cvt_pk_bf16(v[bj][1][0], v[bj][1][1]); w.w = cvt_pk_bf16(v[bj][1][2], v[bj][1][3]);
                    st16_wt(rowp + bj * 128, lo_, w); } }
    }
};
struct PEpiKV {
    static constexpr bool PERM = true, AFTER_DRAIN = false, MIDSCALE = false;
    bf16_t* V; bf16_t* K; const bf16_t* proj; const float* ssq_kv; const float* ssq_kr; const float* rope; const float* kgain;
    __device__ __forceinline__ void operator()(const f32x4 (&acc)[2][2][4][2], const pg8::Unit& u, int wr, int wc, int fr_, int fq_) const {
        int fr = fr_, fq = fq_; asm volatile("" : "+v"(fr), "+v"(fq)); const float* kgain = this->kgain; asm volatile("" : "+s"(kgain)); const float* rope = this->rope; asm volatile("" : "+s"(rope));
        const int row0 = u.pm * 256 + wr * 64 + fr, lane = fq * 16 + fr;
        float rsc[2][4];
#pragma unroll
        for (int ai = 0; ai < 2; ++ai)
#pragma unroll
            for (int m = 0; m < 4; ++m) rsc[ai][m] = 1.f / sqrtf(ssq_kv[row0 + ai * 128 + m * 16] * (1.f / KVR) + EPS);
        if (wc >= 2) {
            const int col0 = u.pn * 256 + wc * 32 + 8 * fq;
#pragma unroll
            for (int ai = 0; ai < 2; ++ai)
#pragma unroll
                for (int m = 0; m < 4; ++m) { const bf16_t* rowp = V + ((size_t)(u.pm * 256 + wr * 64 + ai * 128 + m * 16) * MKV + u.pn * 256 + wc * 32); const unsigned lo_ = (unsigned)(fr * MKV + 8 * fq) * 2u; const float sc_ = rsc[ai][m];
#pragma unroll
                    for (int bj = 0; bj < 2; ++bj) { const f32x4 v0 = acc[ai][bj][m][0] * sc_, v1 = acc[ai][bj][m][1] * sc_;
                        u32x4 w; w.x = cvt_pk_bf16(v0[0], v0[1]); w.y = cvt_pk_bf16(v0[2], v0[3]); w.z = cvt_pk_bf16(v1[0], v1[1]); w.w = cvt_pk_bf16(v1[2], v1[3]);
                        st16_wt(rowp + bj * 128, lo_, w); } }
            return;
        }
        const int hh = 2 * u.pn + wc;
#pragma unroll
        for (int ai = 0; ai < 2; ++ai)
#pragma unroll
            for (int m = 0; m < 4; ++m) { const int row = row0 + ai * 128 + m * 16; const float sc_ = rsc[ai][m];
                const bf16_t* ko = K + ((size_t)(u.pm * 256 + wr * 64 + ai * 128 + m * 16) * MQ + 96 * hh); const unsigned lo_ = (unsigned)(fr * MQ + 8 * fq) * 2u;
                float rstd;
                {
                    f32x4 v[2][2]; float ss = 0.f;
#pragma unroll
                    for (int bj = 0; bj < 2; ++bj)
#pragma unroll
                        for (int n = 0; n < 2; ++n) { v[bj][n] = acc[ai][bj][m][n] * sc_; ss += (v[bj][n][0] * v[bj][n][0] + v[bj][n][1] * v[bj][n][1]) + (v[bj][n][2] * v[bj][n][2] + v[bj][n][3] * v[bj][n][3]); }
                    ss += __builtin_bit_cast(float, __builtin_amdgcn_ds_bpermute((lane ^ 16) << 2, __builtin_bit_cast(int, ss)));
                    ss += __builtin_bit_cast(float, __builtin_amdgcn_ds_bpermute((lane ^ 32) << 2, __builtin_bit_cast(int, ss)));
                    rstd = 1.f / sqrtf((ss + ssq_kr[row]) * (1.f / 96) + EPS);
#pragma unroll
                    for (int bj = 0; bj < 2; ++bj) { const f32x4 g0 = *(const f32x4*)(kgain + 32 * bj + 8 * fq), g1 = *(const f32x4*)(kgain + 32 * bj + 8 * fq + 4);
                        const f32x4 a = v[bj][0] * rstd * g0, b = v[bj][1] * rstd * g1;
                        u32x4 w; w.x = cvt_pk_bf16(a[0], a[1]); w.y = cvt_pk_bf16(a[2], a[3]); w.z = cvt_pk_bf16(b[0], b[1]); w.w = cvt_pk_bf16(b[2], b[3]);
                        st16_wt(ko + 32 * bj, lo_, w); }
                }
                asm volatile("" ::: "memory");
                {
                    const bf16x8 kr8 = *(const bf16x8*)(proj + (size_t)row * DINP + P_HKR + 8 * fq);
                    u32x4 w; w.x = cvt_pk_bf16(bf2f((unsigned short)kr8[0]) * rstd, bf2f((unsigned short)kr8[1]) * rstd); w.y = cvt_pk_bf16(bf2f((unsigned short)kr8[2]) * rstd, bf2f((unsigned short)kr8[3]) * rstd);
                    w.z = cvt_pk_bf16(bf2f((unsigned short)kr8[4]) * rstd, bf2f((unsigned short)kr8[5]) * rstd); w.w = cvt_pk_bf16(bf2f((unsigned short)kr8[6]) * rstd, bf2f((unsigned short)kr8[7]) * rstd);
                    st16_wt(ko + 64, lo_, w);
                }
                asm volatile("" ::: "memory"); }
    }
};
struct PEpiWo {
    static constexpr bool PERM = true, AFTER_DRAIN = false, MIDSCALE = true;
    const bf16_t* base; bf16_t* xb; float* ssq; const float* ssqm; int ldc;
    __device__ __forceinline__ void midscale(f32x4 (&acc)[2][2][4][2], const pg8::Unit& u, int wr, int fr) const {
#pragma unroll
        for (int ai = 0; ai < 2; ++ai)
#pragma unroll
            for (int m = 0; m < 4; ++m) { const int row = u.pm * 256 + ai * 128 + wr * 64 + m * 16 + fr;
                const float sa = ssqm[2 * row], sb = ssqm[2 * row + 1]; const float ratio = sqrtf((sb * (1.f / 512) + EPS) / (sa * (1.f / 512) + EPS));
#pragma unroll
                for (int bj = 0; bj < 2; ++bj)
#pragma unroll
                    for (int n = 0; n < 2; ++n) acc[ai][bj][m][n] *= ratio; }
    }
    __device__ __forceinline__ void operator()(const f32x4 (&acc)[2][2][4][2], const pg8::Unit& u, int wr, int wc, int fr, int fq) const {
        const int lane = fq * 16 + fr;
        const int rowb = u.pm * 256 + wr * 64 + fr;
        float rb[8];
#pragma unroll
        for (int g_ = 0; g_ < 8; ++g_) rb[g_] = ssqm[2 * (rowb + (g_ >> 2) * 128 + (g_ & 3) * 16) + 1];
        const size_t tile0 = (size_t)(u.pm * 256 + wr * 64) * ldc + u.pn * 256 + wc * 32;
        const unsigned lo_ = (unsigned)(fr * ldc + 8 * fq) * 2u;
        u32x4 nxt[2];
#pragma unroll
        for (int bj = 0; bj < 2; ++bj) nxt[bj] = *(const u32x4*)((const char*)(base + tile0 + bj * 128) + lo_);
#pragma unroll
        for (int g_ = 0; g_ < 8; ++g_) { const int ai = g_ >> 2, m = g_ & 3; const int row = rowb + ai * 128 + m * 16; const size_t roff = tile0 + (size_t)(ai * 128 + m * 16) * ldc; float ss = 0.f;
            u32x4 cur[2];
#pragma unroll
            for (int bj = 0; bj < 2; ++bj) cur[bj] = nxt[bj];
            if (g_ < 7) { const size_t roffn = tile0 + (size_t)(((g_ + 1) >> 2) * 128 + ((g_ + 1) & 3) * 16) * ldc;
#pragma unroll
                for (int bj = 0; bj < 2; ++bj) nxt[bj] = *(const u32x4*)((const char*)(base + roffn + bj * 128) + lo_); }
            const float rbs = 1.f / sqrtf(rb[g_] * (1.f / 512) + EPS);
#pragma unroll
            for (int bj = 0; bj < 2; ++bj) { const u32x4 cw = cur[bj];
                const f32x4 v0 = (f32x4){bf2f(cw.x & 0xffffu), bf2f(cw.x >> 16), bf2f(cw.y & 0xffffu), bf2f(cw.y >> 16)} + acc[ai][bj][m][0] * rbs;
                const f32x4 v1 = (f32x4){bf2f(cw.z & 0xffffu), bf2f(cw.z >> 16), bf2f(cw.w & 0xffffu), bf2f(cw.w >> 16)} + acc[ai][bj][m][1] * rbs;
                ss += ((v0[0] * v0[0] + v0[1] * v0[1]) + (v0[2] * v0[2] + v0[3] * v0[3])) + ((v1[0] * v1[0] + v1[1] * v1[1]) + (v1[2] * v1[2] + v1[3] * v1[3]));
                u32x4 w; w.x = cvt_pk_bf16(v0[0], v0[1]); w.y = cvt_pk_bf16(v0[2], v0[3]); w.z = cvt_pk_bf16(v1[0], v1[1]); w.w = cvt_pk_bf16(v1[2], v1[3]);
                st16_wt(xb + roff + bj * 128, lo_, w); }
            ss += __builtin_bit_cast(float, __builtin_amdgcn_ds_bpermute((lane ^ 16) << 2, __builtin_bit_cast(int, ss)));
            ss += __builtin_bit_cast(float, __builtin_amdgcn_ds_bpermute((lane ^ 32) << 2, __builtin_bit_cast(int, ss)));
            if (fq == 0) __hip_atomic_fetch_add(ssq + row, ss, __ATOMIC_RELAXED, __HIP_MEMORY_SCOPE_AGENT); }
    }
};


struct PEpiDown {
    static constexpr bool PERM = false, AFTER_DRAIN = false, MIDSCALE = false;
    const bf16_t* xb; float* out; int ldc;
    __device__ __forceinline__ void operator()(const f32x4 (&acc)[2][2][4][2], const pg8::Unit& u, int wr, int wc, int fr, int fq) const {
        const int col0 = u.pn * 256 + wc * 32 + 4 * fq; const int rowb = u.pm * 256 + wr * 64 + fr;
        u32x2 nxt[2][2];
#pragma unroll
        for (int bj = 0; bj < 2; ++bj)
#pragma unroll
            for (int n = 0; n < 2; ++n) nxt[bj][n] = *(const u32x2*)(xb + (size_t)rowb * ldc + col0 + bj * 128 + n * 16);
#pragma unroll
        for (int g_ = 0; g_ < 8; ++g_) { const int ai = g_ >> 2, m = g_ & 3; const size_t off = (size_t)(rowb + ai * 128 + m * 16) * ldc + col0;
            u32x2 cur[2][2];
#pragma unroll
            for (int bj = 0; bj < 2; ++bj)
#pragma unroll
                for (int n = 0; n < 2; ++n) cur[bj][n] = nxt[bj][n];
            if (g_ < 7) { const size_t offn = (size_t)(rowb + ((g_ + 1) >> 2) * 128 + ((g_ + 1) & 3) * 16) * ldc + col0;
#pragma unroll
                for (int bj = 0; bj < 2; ++bj)
#pragma unroll
                    for (int n = 0; n < 2; ++n) nxt[bj][n] = *(const u32x2*)(xb + offn + bj * 128 + n * 16); }
#pragma unroll
            for (int bj = 0; bj < 2; ++bj)
#pragma unroll
                for (int n = 0; n < 2; ++n) { const u32x2 w = cur[bj][n];
                    const f32x4 bs = (f32x4){bf2f(w.x & 0xffffu), bf2f(w.x >> 16), bf2f(w.y & 0xffffu), bf2f(w.y >> 16)};
                    __builtin_nontemporal_store(bs + acc[ai][bj][m][n], (f32x4*)(out + off + bj * 128 + n * 16)); } }
    }
};

__device__ __forceinline__ float sq8(const bf16x8 v) { float s = 0.f;
#pragma unroll
    for (int j = 0; j < 8; ++j) { const float f = bf2f((unsigned short)v[j]); s += f * f; }
    return s; }
__device__ __forceinline__ u32x4 scale8(const bf16x8 v, float sc, const f32x4 ga, const f32x4 gb) { u32x4 o;
    o.x = pk2(bf2f((unsigned short)v[0]) * sc * ga[0], bf2f((unsigned short)v[1]) * sc * ga[1]); o.y = pk2(bf2f((unsigned short)v[2]) * sc * ga[2], bf2f((unsigned short)v[3]) * sc * ga[3]);
    o.z = pk2(bf2f((unsigned short)v[4]) * sc * gb[0], bf2f((unsigned short)v[5]) * sc * gb[1]); o.w = pk2(bf2f((unsigned short)v[6]) * sc * gb[2], bf2f((unsigned short)v[7]) * sc * gb[3]);
    return o; }

__device__ __forceinline__ void compress_block(unsigned char* ws, LAS unsigned char* L, int task, int wv) {
    const int tid = opaque_tid(wv), lane = tid & 63, wid = __builtin_amdgcn_readfirstlane(tid >> 6), fr = lane & 15, fq = lane >> 4;
    const int tc = task & 15, b = (task >> 4) & 7, kv = task >> 7;
    int c = 8 * tc + (fr >> 1); const int g = fr & 1; if (c > NCMP - 1) c = NCMP - 1;
    const bf16_t* arow = (const bf16_t*)(ws + WS_PROJ) + (size_t)(b * SEQ + 16 * c) * DINP + slot_base((kv ? S_VCMP : S_KCMP) + g) + 8 * fq;
    const float* pe = inptr(11) + kv * 2048 + 8 * fq;
    const bf16_t* w1t = (const bf16_t*)(ws + WS_W1T) + (size_t)kv * 128 * 2048 + (size_t)fr * 2048 + 8 * fq;
    f32x4 acc[8];
#pragma unroll
    for (int n = 0; n < 8; ++n) acc[n] = (f32x4){0.f, 0.f, 0.f, 0.f};
#pragma unroll 4
    for (int s8 = 0; s8 < 8; ++s8) {
        const int s = 8 * wid + s8, r = s >> 1, db = (s & 1) * 32;
        const bf16x8 araw = *(const bf16x8*)(arow + (size_t)r * DINP + 4 * db);
        const f32x4 pa = *(const f32x4*)(pe + r * 64 + db), pb = *(const f32x4*)(pe + r * 64 + db + 4);
        u32x4 aw; aw.x = pk2(bf2f((unsigned short)araw[0]) + pa[0], bf2f((unsigned short)araw[1]) + pa[1]); aw.y = pk2(bf2f((unsigned short)araw[2]) + pa[2], bf2f((unsigned short)araw[3]) + pa[3]);
        aw.z = pk2(bf2f((unsigned short)araw[4]) + pb[0], bf2f((unsigned short)araw[5]) + pb[1]); aw.w = pk2(bf2f((unsigned short)araw[6]) + pb[2], bf2f((unsigned short)araw[7]) + pb[3]);
        const bf16x8 a = __builtin_bit_cast(bf16x8, aw);
#pragma unroll
        for (int n = 0; n < 8; ++n) { const bf16x8 bb = *(const bf16x8*)(w1t + (size_t)(16 * n) * 2048 + 32 * s);
            acc[n] = __builtin_amdgcn_mfma_f32_16x16x32_bf16(a, bb, acc[n], 0, 0, 0); }
    }
    LAS float* part = (LAS float*)L;
#pragma unroll
    for (int n = 0; n < 8; ++n)
#pragma unroll
        for (int j = 0; j < 4; ++j) part[(wid * 16 + 4 * fq + j) * 128 + 16 * n + fr] = acc[n][j];
    __syncthreads();
    LAS bf16_t* hb_ = (LAS bf16_t*)(L + 65536);
#pragma unroll
    for (int e = 0; e < 4; ++e) { const int idx = tid + 512 * e; float v = 0.f;
#pragma unroll
        for (int w = 0; w < 8; ++w) v += part[w * 2048 + idx];
        hb_[idx] = (bf16_t)f2bf(v / (1.f + __expf(-v))); }
    __syncthreads();
    if (wid == 0) {
        const bf16_t* w2t = (const bf16_t*)(ws + WS_W2T) + kv * 64 * 128 + fr * 128 + 8 * fq;
        f32x4 o[4];
#pragma unroll
        for (int n = 0; n < 4; ++n) o[n] = (f32x4){0.f, 0.f, 0.f, 0.f};
#pragma unroll
        for (int ks = 0; ks < 4; ++ks) { const bf16x8 a = *(const LAS bf16x8*)(hb_ + fr * 128 + 32 * ks + 8 * fq);
#pragma unroll
            for (int n = 0; n < 4; ++n) { const bf16x8 bb = *(const bf16x8*)(w2t + (size_t)(16 * n) * 128 + 32 * ks); o[n] = __builtin_amdgcn_mfma_f32_16x16x32_bf16(a, bb, o[n], 0, 0, 0); } }
        bf16_t* dstb = (bf16_t*)(ws + (kv ? WS_VCMP : WS_KCMP)) + (size_t)b * 128 * 2 * 64;
        const float* kg = inptr(10);
#pragma unroll
        for (int j = 0; j < 4; ++j) { const int row = 4 * fq + j, cc = 8 * tc + (row >> 1), gg = row & 1;
            float sc = 1.f;
            if (kv == 0) { float ss = o[0][j] * o[0][j] + o[1][j] * o[1][j] + o[2][j] * o[2][j] + o[3][j] * o[3][j];
                ss += __shfl_xor(ss, 1); ss += __shfl_xor(ss, 2); ss += __shfl_xor(ss, 4); ss += __shfl_xor(ss, 8); sc = 1.f / sqrtf(ss * (1.f / 64) + EPS); }
#pragma unroll
            for (int n = 0; n < 4; ++n) { const int col = 16 * n + fr; float v = o[n][j] * sc; if (kv == 0) v *= kg[col]; if (cc >= NCMP) v = 0.f;
                dstb[((size_t)cc * 2 + gg) * 64 + col] = (bf16_t)f2bf(v); } }
    }
    __syncthreads();
}

namespace att {
typedef float f32x16 __attribute__((ext_vector_type(16)));
typedef short s16x4 __attribute__((ext_vector_type(4)));
typedef short v4i16_t __attribute__((ext_vector_type(4)));
typedef float f32x2_t __attribute__((ext_vector_type(2)));
typedef __bf16 bf16x2_t __attribute__((ext_vector_type(2)));
typedef const LAS unsigned char* lcp;
constexpr int NSLOT = 3;
constexpr int L_TB = 0, L_K = 4096, KSLOT = 12288, L_V = L_K + NSLOT * KSLOT, VSLOT = 8192, L_WSF = L_V + NSLOT * VSLOT, L_OST = L_WSF + 4096,
              L_IMP = L_OST + 32768, IMPS = 33  , L_SELM = L_IMP + 4 * 64 * IMPS * 4, L_GATE = L_SELM + 256, L_SC = L_GATE + 3072, L_INVL = L_SC + 64 * IMPS * 4, L_END = L_INVL + 1024;
static_assert(L_V + NSLOT * VSLOT <= 65536, "LDS-DMA destinations stay below 64 KiB");
static_assert(L_END <= LDS_BST, "attention LDS map");
constexpr float THR = 8.0f;
__device__ __forceinline__ int crow(int r, int hi) { return (r & 3) + 8 * (r >> 2) + 4 * hi; }
__device__ __forceinline__ void glds16(const void* gsrc, unsigned lds_dst) { unsigned keep;
    asm volatile("s_mov_b32 %0, m0\n\ts_mov_b32 m0, %2\n\ts_nop 0\n\tglobal_load_lds_dwordx4 %1, off\n\ts_mov_b32 m0, %0" : "=&s"(keep) : "v"(gsrc), "s"(lds_dst) : "memory"); }
__device__ __forceinline__ unsigned cvtpk(float lo, float hi) { f32x2_t v = {lo, hi}; bf16x2_t b = __builtin_convertvector(v, bf16x2_t); return __builtin_bit_cast(unsigned, b); }
__device__ __forceinline__ s16x4 vtr(lcp p) { return __builtin_bit_cast(s16x4, __builtin_amdgcn_ds_read_tr16_b64_v4i16((LAS v4i16_t*)p)); }
__device__ __forceinline__ float lane_xor(float v, int lane, int x) { return __builtin_bit_cast(float, __builtin_amdgcn_ds_bpermute((lane ^ x) << 2, __builtin_bit_cast(int, v))); }
__device__ __forceinline__ unsigned lane_xor_u(unsigned v, int lane, int x) { return (unsigned)__builtin_amdgcn_ds_bpermute((lane ^ x) << 2, (int)v); }
__device__ __forceinline__ float swap_max(float m, int lane) { return __builtin_fmaxf(m, lane_xor(m, lane, 32)); }
__device__ __forceinline__ float swap_sum(float m, int lane) { return m + lane_xor(m, lane, 32); }
__device__ __forceinline__ float max3f(float a, float b, float c) { float r; asm("v_max3_f32 %0, %1, %2, %3" : "=v"(r) : "v"(a), "v"(b), "v"(c)); return r; }
__device__ __forceinline__ float max32(const f32x16& p0, const f32x16& p1) {
    float a = max3f(p0[0], p0[1], p1[0]), b = max3f(p0[2], p0[3], p1[1]); a = max3f(a, p1[2], p1[3]);
#pragma unroll
    for (int r = 4; r < 16; r += 4) { a = max3f(a, p0[r], p0[r + 1]); b = max3f(b, p0[r + 2], p0[r + 3]); a = max3f(a, p1[r], p1[r + 1]); b = max3f(b, p1[r + 2], p1[r + 3]); }
    return __builtin_fmaxf(a, b); }
__device__ __forceinline__ float max16(const f32x16& p) { float a = __builtin_fmaxf(p[0], p[1]), b = __builtin_fmaxf(p[2], p[3]);
#pragma unroll
    for (int r = 4; r < 16; r += 4) { a = __builtin_fmaxf(a, __builtin_fmaxf(p[r], p[r + 1])); b = __builtin_fmaxf(b, __builtin_fmaxf(p[r + 2], p[r + 3])); }
    return __builtin_fmaxf(a, b); }
__device__ __forceinline__ float sum16(const f32x16& p) { float a = p[0] + p[1], b = p[2] + p[3];
#pragma unroll
    for (int r = 4; r < 16; r += 4) { a += p[r] + p[r + 1]; b += p[r + 2] + p[r + 3]; }
    return a + b; }
#define ATT_BAR() asm volatile("s_waitcnt vmcnt(0) lgkmcnt(0)\n\ts_barrier" ::: "memory")

template <int DQ> __device__ __forceinline__ void qkt(f32x16& p0, f32x16& p1, lcp kslot, const bf16x8* qr, const f32x16& cinit, int r32, int hi) {
    lcp kb = kslot + hi * 1024 + r32 * 16;
    constexpr int NB = 2;
#pragma unroll
    for (int db = 0; db < DQ / 16; db += NB) {
        bf16x8 kf[2 * NB];
#pragma unroll
        for (int e = 0; e < NB; ++e) { kf[2 * e] = *(const LAS bf16x8*)(kb + (db + e) * 2048); kf[2 * e + 1] = *(const LAS bf16x8*)(kb + (db + e) * 2048 + 512); }
        __builtin_amdgcn_sched_barrier(0);
#pragma unroll
        for (int e = 0; e < NB; ++e) { const int d0 = db + e;
            if (d0 == 0) { p0 = __builtin_amdgcn_mfma_f32_32x32x16_bf16(kf[0], qr[0], cinit, 0, 0, 0); p1 = __builtin_amdgcn_mfma_f32_32x32x16_bf16(kf[1], qr[0], cinit, 0, 0, 0); }
            else { p0 = __builtin_amdgcn_mfma_f32_32x32x16_bf16(kf[2 * e], qr[d0], p0, 0, 0, 0); p1 = __builtin_amdgcn_mfma_f32_32x32x16_bf16(kf[2 * e + 1], qr[d0], p1, 0, 0, 0); }
        }
    }
}
__device__ __forceinline__ void vload_half(bf16x8 (&vf)[8], lcp vp, int d0) {
#pragma unroll
    for (int ks = 0; ks < 4; ++ks) {
        const s16x4 lo = vtr(vp + d0 * 4096 + ks * 1024), hh = vtr(vp + d0 * 4096 + ks * 1024 + 512);
        vf[d0 * 4 + ks] = (bf16x8){lo[0], lo[1], lo[2], lo[3], hh[0], hh[1], hh[2], hh[3]};
    }
    __builtin_amdgcn_sched_barrier(0);
}
__device__ __forceinline__ void vload(bf16x8 (&vf)[8], lcp vp) { vload_half(vf, vp, 0); vload_half(vf, vp, 1); }
__device__ __forceinline__ void pv_mma(f32x16 (&o)[2], const bf16x8 (&vf)[8], const f32x16& p0, const f32x16& p1) {
    u32x4 pw[4];
    pw[0] = (u32x4){cvtpk(p0[0], p0[1]), cvtpk(p0[2], p0[3]), cvtpk(p0[4], p0[5]), cvtpk(p0[6], p0[7])};
    pw[1] = (u32x4){cvtpk(p0[8], p0[9]), cvtpk(p0[10], p0[11]), cvtpk(p0[12], p0[13]), cvtpk(p0[14], p0[15])};
    pw[2] = (u32x4){cvtpk(p1[0], p1[1]), cvtpk(p1[2], p1[3]), cvtpk(p1[4], p1[5]), cvtpk(p1[6], p1[7])};
    pw[3] = (u32x4){cvtpk(p1[8], p1[9]), cvtpk(p1[10], p1[11]), cvtpk(p1[12], p1[13]), cvtpk(p1[14], p1[15])};
#pragma unroll
    for (int d0 = 0; d0 < 2; ++d0)
#pragma unroll
        for (int ks = 0; ks < 4; ++ks) o[d0] = __builtin_amdgcn_mfma_f32_32x32x16_bf16(__builtin_bit_cast(bf16x8, pw[ks]), vf[d0 * 4 + ks], o[d0], 0, 0, 0);
}
__device__ __forceinline__ void pv(f32x16 (&o)[2], lcp vp, const f32x16& p0, const f32x16& p1) { bf16x8 vf[8]; vload(vf, vp); pv_mma(o, vf, p0, p1); }
template <int DQ, bool SLOT = false, bool SLOTV = SLOT> __device__ __forceinline__ void dma_tile(unsigned lds0, const bf16_t* Kg, int kpitch, const bf16_t* Vg, int vpitch, int key0, int slot, int wid, int lane) {
    const bf16_t* ksrc = Kg + (size_t)(key0 + lane) * kpitch + (SLOT ? 128 * (wid >> 2) + 8 * (wid & 3) : wid * 8);
    glds16(ksrc, (unsigned)__builtin_amdgcn_readfirstlane(lds0 + L_K + slot * KSLOT + wid * 1024));
    if (DQ == 96) { if (wid < 4) glds16(ksrc + 64, (unsigned)__builtin_amdgcn_readfirstlane(lds0 + L_K + slot * KSLOT + (8 + wid) * 1024)); }
    const bf16_t* vsrc = Vg + (size_t)(key0 + 16 * (wid & 3) + (lane >> 2)) * vpitch + (wid >> 2) * (SLOTV ? 128 : 32) + (lane & 3) * 8;
    glds16(vsrc, (unsigned)__builtin_amdgcn_readfirstlane(lds0 + L_V + slot * VSLOT + wid * 1024));
}

#define ATT_LBAR() asm volatile("s_waitcnt lgkmcnt(0)\n\ts_barrier" ::: "memory")
struct NoNext { static constexpr int count = 0; __device__ __forceinline__ void dma(unsigned, int, int, int, int) const {} };
template <int DQ, bool SLOT, bool SLOTV, class Pol> struct NextTiles {
    const bf16_t* Kg; int kpitch; const bf16_t* Vg; int vpitch; const Pol* pol; int count;
    __device__ __forceinline__ void dma(unsigned lds0, int j, int slot, int wid, int lane) const { dma_tile<DQ, SLOT, SLOTV>(lds0, Kg, kpitch, Vg, vpitch, pol->key0(j), slot, wid, lane); }
};
template <int DQ, bool SLOT = false, bool SLOTV = SLOT, class Pol, class Next>
__device__ __forceinline__ void flash_loop(LAS unsigned char* L, const bf16_t* Kg, int kpitch, const bf16_t* Vg, int vpitch, const bf16x8* qr, const Pol& pol, int s0, int npre, const Next& next,
                                           f32x16 (&o)[2], float& l_out, int wid, int lane) {
    const int r32 = lane & 31, hi = lane >> 5;
    const unsigned lds0 = (unsigned)(uintptr_t)L;
    LAS float* wsf = (LAS float*)(L + L_WSF) + wid * 128;
    lcp vp0 = L + L_V + ((lane >> 4) & 1) * 32 + (lane & 3) * 8 + (4 * hi + ((lane & 15) >> 2)) * 64;
    float mhat = 0.f, l = 0.f;
    f32x16 negm;
#pragma unroll
    for (int r = 0; r < 16; ++r) { o[0][r] = 0.f; o[1][r] = 0.f; negm[r] = 0.f; }
    const int n = pol.ntiles, ntot = n + next.count;
    int slot = s0, slot1 = (s0 + 1) % NSLOT, slot2 = (s0 + 2) % NSLOT;
    if (npre < 1) dma_tile<DQ, SLOT, SLOTV>(lds0, Kg, kpitch, Vg, vpitch, pol.key0(0), slot, wid, lane);
    if (npre < 2 && ntot > 1) { if (n > 1) dma_tile<DQ, SLOT, SLOTV>(lds0, Kg, kpitch, Vg, vpitch, pol.key0(1), slot1, wid, lane); else next.dma(lds0, 0, slot1, wid, lane); }
    for (int i = 0; i < n; ++i) {
        if (i + 1 < ntot) { if (DQ == 96 && wid < 4) asm volatile("s_waitcnt vmcnt(3) lgkmcnt(0)\n\ts_barrier" ::: "memory"); else asm volatile("s_waitcnt vmcnt(2) lgkmcnt(0)\n\ts_barrier" ::: "memory"); }
        else ATT_BAR();
        if (i + 2 < ntot) { if (i + 2 < n) dma_tile<DQ, SLOT, SLOTV>(lds0, Kg, kpitch, Vg, vpitch, pol.key0(i + 2), slot2, wid, lane); else next.dma(lds0, i + 2 - n, slot2, wid, lane); }
        if (pol.active(i)) {
            f32x16 p0, p1;
            qkt<DQ>(p0, p1, L + L_K + slot * KSLOT, qr, negm, r32, hi);
            bf16x8 vf[8]; vload_half(vf, vp0 + slot * VSLOT, 0);
            pol.fix(p0, p1, i);
            asm volatile("s_nop 15\n\ts_nop 7" : "+v"(p0), "+v"(p1));
            const float rm = swap_max(max32(p0, p1), lane);
            const bool first = (i == 0);
            if (first || __any(rm > THR)) {
                float dl = first ? rm : __builtin_fmaxf(rm, 0.f);
                if (dl == -INFINITY) dl = 0.f;
                mhat += dl;
#pragma unroll
                for (int r = 0; r < 16; ++r) { p0[r] -= dl; p1[r] -= dl; negm[r] = -mhat; }
                if (!first) {
                    const float f = __builtin_amdgcn_exp2f(-dl); l *= f;
                    if (hi == 0) wsf[r32] = f;
#pragma unroll
                    for (int r = 0; r < 16; ++r) { const float fr_ = wsf[crow(r, hi)]; o[0][r] *= fr_; o[1][r] *= fr_; }
                }
            }
#pragma unroll
            for (int r = 0; r < 16; ++r) { p0[r] = __builtin_amdgcn_exp2f(p0[r]); p1[r] = __builtin_amdgcn_exp2f(p1[r]); }
            vload_half(vf, vp0 + slot * VSLOT, 1);
            l += sum16(p0) + sum16(p1);
            pv_mma(o, vf, p0, p1);
        }
        slot = slot1; slot1 = slot2; slot2 = (slot2 == NSLOT - 1) ? 0 : slot2 + 1;
    }
    ATT_LBAR();
    l_out = swap_sum(l, lane);
}

__device__ __forceinline__ void acc_scaled(f32x16 (&oc)[2], const f32x16 (&o)[2], float rowscale, LAS float* wsf, int r32, int hi) {
    if (hi == 0) wsf[32 + r32] = rowscale;
#pragma unroll
    for (int r = 0; r < 16; ++r) { const float s = wsf[32 + crow(r, hi)]; oc[0][r] += s * o[0][r]; oc[1][r] += s * o[1][r]; }
}
__device__ __forceinline__ void park_store(const f32x16 (&oc)[2], LAS float* park, int lane) {
#pragma unroll
    for (int d0 = 0; d0 < 2; ++d0)
#pragma unroll
        for (int r = 0; r < 16; ++r) park[(d0 * 16 + r) * 64 + lane] = oc[d0][r];
}
template <bool FINAL> __device__ __forceinline__ void park_acc(f32x16 (&oc)[2], LAS float* park, const f32x16 (&o)[2], float rowscale, LAS float* wsf, int lane) {
    const int r32 = lane & 31, hi = lane >> 5;
    if (hi == 0) wsf[32 + r32] = rowscale;
#pragma unroll
    for (int r = 0; r < 16; ++r) { const float s = wsf[32 + crow(r, hi)];
#pragma unroll
        for (int d0 = 0; d0 < 2; ++d0) { const float v = park[(d0 * 16 + r) * 64 + lane] + s * o[d0][r]; if (FINAL) oc[d0][r] = v; else park[(d0 * 16 + r) * 64 + lane] = v; } }
}
__device__ __forceinline__ void store_tile(const f32x16 (&oc)[2], bf16_t* dst, int pitch, LAS unsigned char* L, int wid, int lane, float* ssq) {
    const int r32 = lane & 31, hi = lane >> 5;
    LAS bf16_t* stg = (LAS bf16_t*)(L + L_OST + wid * 8192);
#pragma unroll
    for (int r = 0; r < 16; ++r) { const int orow = crow(r, hi);
#pragma unroll
        for (int d0 = 0; d0 < 2; ++d0) stg[orow * 64 + d0 * 32 + r32] = (bf16_t)f2bf(oc[d0][r]); }
    asm volatile("s_waitcnt lgkmcnt(0)" ::: "memory");
#pragma unroll
    for (int i = 0; i < 4; ++i) { const int row = i * 8 + (lane >> 3), ch = lane & 7; const u32x4 v = *(const LAS u32x4*)(stg + row * 64 + ch * 8); st16_wt(dst + (size_t)(i * 8) * pitch, (unsigned)((lane >> 3) * pitch + ch * 8) * 2u, v);
        float ss = sq8(__builtin_bit_cast(bf16x8, v)); ss += lane_xor(ss, lane, 1); ss += lane_xor(ss, lane, 2); ss += lane_xor(ss, lane, 4);
        if (ch == 0) __hip_atomic_fetch_add(ssq + 2 * row, ss, __ATOMIC_RELAXED, __HIP_MEMORY_SCOPE_AGENT); }
    asm volatile("s_waitcnt lgkmcnt(0)" ::: "memory");
}

#define PIN16(v) asm volatile("" : "+v"(v[0]), "+v"(v[1]), "+v"(v[2]), "+v"(v[3]), "+v"(v[4]), "+v"(v[5]), "+v"(v[6]), "+v"(v[7]), "+v"(v[8]), "+v"(v[9]), "+v"(v[10]), "+v"(v[11]), "+v"(v[12]), "+v"(v[13]), "+v"(v[14]), "+v"(v[15]))
__device__ __forceinline__ int clamp127(int d) { return d < 0 ? 0 : (d < 127 ? d : 127); }
struct PolMla { int ntiles, qw0, r32, hi;
    __device__ __forceinline__ int key0(int i) const { return 64 * i; }
    __device__ __forceinline__ bool active(int i) const { return 64 * i <= qw0 + 31; }
    __device__ __forceinline__ int nact() const { const int a = (qw0 + 31) / 64 + 1; return a < ntiles ? a : ntiles; }
    __device__ __forceinline__ void fix(f32x16& p0, f32x16& p1, int i) const {
        if (64 * i + 63 > qw0) { const int q = qw0 + r32, kb = 64 * i + 4 * hi;
#pragma unroll
            for (int r = 0; r < 16; ++r) { const int kv = kb + (r & 3) + 8 * (r >> 2); if (kv > q) p0[r] = -INFINITY; if (kv + 32 > q) p1[r] = -INFINITY; } }
    }
};
struct PolSel { int ntiles, qc, q, hi; unsigned selm; const LAS float* tbh;
    __device__ __forceinline__ int key0(int i) const { return 64 * (qc - i); }
    __device__ __forceinline__ bool active(int i) const { return __any((selm >> (qc - i)) & 1u) != 0; }
    __device__ __forceinline__ int nact() const { return ntiles; }
    __device__ __forceinline__ void fix(f32x16& p0, f32x16& p1, int i) const {
        const bool bit = ((selm >> (qc - i)) & 1u) != 0u;
        if (i <= 2) { const int kb = 64 * (qc - i) + 4 * hi; float bv0[16], bv1[16];
#pragma unroll
            for (int r = 0; r < 16; ++r) { const int d0 = q - (kb + (r & 3) + 8 * (r >> 2)); bv0[r] = tbh[clamp127(d0)]; bv1[r] = tbh[clamp127(d0 - 32)]; }
            PIN16(bv0); PIN16(bv1);
#pragma unroll
            for (int r = 0; r < 16; ++r) { const int d0 = q - (kb + (r & 3) + 8 * (r >> 2)), d1 = d0 - 32;
                p0[r] = (d0 < 0) ? -INFINITY : p0[r] + bv0[r]; p1[r] = (d1 < 0) ? -INFINITY : p1[r] + bv1[r]; } }
        if (!bit) {
#pragma unroll
            for (int r = 0; r < 16; ++r) { p0[r] = -INFINITY; p1[r] = -INFINITY; } }
    }
};
struct PolWin { int ntiles, qc, q, hi; const LAS float* tbh;
    __device__ __forceinline__ int key0(int i) const { return 64 * (qc - i); }
    __device__ __forceinline__ bool active(int) const { return true; }
    __device__ __forceinline__ int nact() const { return ntiles; }
    __device__ __forceinline__ void fix(f32x16& p0, f32x16& p1, int i) const {
        if (i <= 2) { const int kb = 64 * (qc - i) + 4 * hi; float bv0[16], bv1[16];
#pragma unroll
            for (int r = 0; r < 16; ++r) { const int d0 = q - (kb + (r & 3) + 8 * (r >> 2)); bv0[r] = tbh[clamp127(d0)]; bv1[r] = tbh[clamp127(d0 - 32)]; }
            PIN16(bv0); PIN16(bv1);
#pragma unroll
            for (int r = 0; r < 16; ++r) { const int d0 = q - (kb + (r & 3) + 8 * (r >> 2)), d1 = d0 - 32;
                p0[r] = (d0 < 0) ? -INFINITY : p0[r] + bv0[r]; p1[r] = (d1 < 0) ? -INFINITY : p1[r] + bv1[r]; } }
        else if (i == 8) { const int kb = 64 * (qc - i) + 4 * hi;
#pragma unroll
            for (int r = 0; r < 16; ++r) { const int d0 = q - (kb + (r & 3) + 8 * (r >> 2)), d1 = d0 - 32; if (d0 >= 512) p0[r] = -INFINITY; if (d1 >= 512) p1[r] = -INFINITY; } }
    }
};

__device__ __forceinline__ void mla_unit(unsigned char* ws, LAS unsigned char* L, int b, int h, int qb, int wv, int s0, int npre, int nnext) {
    asm volatile("" : "+s"(ws));
    const int tid = opaque_tid(wv), lane = tid & 63, wid = __builtin_amdgcn_readfirstlane(tid >> 6);
    const int r32 = lane & 31, hi = lane >> 5;
    const size_t rowbase = (size_t)b * SEQ; const int qw0 = 256 * qb + 32 * wid;
    bf16x8 qr[6];
    { const bf16_t* Qw = (const bf16_t*)(ws + WS_QM) + (rowbase + qw0 + r32) * MQ + 96 * h + 8 * hi;
      bf16x8 raw[6]; float ss = 0.f;
#pragma unroll
      for (int d0 = 0; d0 < 6; ++d0) { raw[d0] = *(const bf16x8*)(Qw + 16 * d0); ss += sq8(raw[d0]); }
      ss += lane_xor(ss, lane, 32);
      const float rstd = QS_MLA / sqrtf(ss * (1.f / 96) + EPS);
      const float* qg = inptr(7) + 8 * hi;
#pragma unroll
      for (int d0 = 0; d0 < 4; ++d0) qr[d0] = __builtin_bit_cast(bf16x8, scale8(raw[d0], rstd, *(const f32x4*)(qg + 16 * d0), *(const f32x4*)(qg + 16 * d0 + 4)));
      float o1[8], o2[8]; const float posf = (float)(qw0 + r32);
#pragma unroll
      for (int j = 0; j < 8; ++j) { const int i = 8 * hi + j; const float inv = exp2f(-(float)i * (13.287712379549449f / 16.f)); float sn, cs; sincosf(posf * inv, &sn, &cs);
          const float n1 = bf2f((unsigned short)raw[4][j]) * rstd * qg[64 + j], n2 = bf2f((unsigned short)raw[5][j]) * rstd * qg[80 + j];
          o1[j] = n1 * cs - n2 * sn; o2[j] = n2 * cs + n1 * sn; }
      u32x4 w4, w5; w4.x = pk2(o1[0], o1[1]); w4.y = pk2(o1[2], o1[3]); w4.z = pk2(o1[4], o1[5]); w4.w = pk2(o1[6], o1[7]);
      w5.x = pk2(o2[0], o2[1]); w5.y = pk2(o2[2], o2[3]); w5.z = pk2(o2[4], o2[5]); w5.w = pk2(o2[6], o2[7]);
      qr[4] = __builtin_bit_cast(bf16x8, w4); qr[5] = __builtin_bit_cast(bf16x8, w5); }
    const bf16_t* Kg = (const bf16_t*)(ws + WS_KMLA) + rowbase * MQ + 96 * h;
    const bf16_t* Vg = (const bf16_t*)(ws + WS_KVM) + rowbase * MKV + slot_base(4 * (h >> 1) + 2 + (h & 1));
    PolMla pol{4 * qb + 4, qw0, r32, hi};
    f32x16 o[2]; float l;
    const NextTiles<96, false, true, PolMla> nxt{Kg, MQ, Vg, MKV, &pol, nnext};
    flash_loop<96, false, true>(L, Kg, MQ, Vg, MKV, qr, pol, s0, npre, nxt, o, l, wid, lane);
    LAS float* wsf = (LAS float*)(L + L_WSF) + wid * 128;
    f32x16 oc[2];
#pragma unroll
    for (int r = 0; r < 16; ++r) { oc[0][r] = 0.f; oc[1][r] = 0.f; }
    acc_scaled(oc, o, (l > 0.f) ? 1.f / l : 0.f, wsf, r32, hi);
    store_tile(oc, (bf16_t*)(ws + WS_MIX) + (rowbase + qw0) * DM + 64 * h, DM, L, wid, lane, (float*)(ws + WS_SSQM) + 2 * (rowbase + qw0));
}

__device__ __forceinline__ void nsa_unit(unsigned char* ws, LAS unsigned char* L, int b, int g, int qc, int wv) {
    asm volatile("" : "+s"(ws));
#define NSA_IDS() const int tid = opaque_tid(wv), lane = tid & 63, wid = __builtin_amdgcn_readfirstlane(tid >> 6); \
    const int r32 = lane & 31, hi = lane >> 5, rh = wid & 3, qh = wid >> 2, h = 4 * g + rh, qloc = 32 * qh + r32, q = q0 + qloc; \
    const unsigned lds0 = (unsigned)(uintptr_t)L; LAS float* wsf = (LAS float*)(L + L_WSF) + wid * 128; const LAS float* tbh = (const LAS float*)(L + L_TB) + h * 128; \
    LAS float* gate = (LAS float*)(L + L_GATE); (void)tid; (void)lane; (void)r32; (void)hi; (void)rh; (void)qh; (void)h; (void)qloc; (void)q; (void)lds0; (void)wsf; (void)tbh; (void)gate
    const size_t rowbase = (size_t)b * SEQ; const int q0 = 64 * qc;
    const bf16_t* pr = (const bf16_t*)(ws + WS_PROJ);
    bf16x8 qr[4];
    {
    NSA_IDS();
    { const bf16_t* Kc = (const bf16_t*)(ws + WS_KCMP) + ((size_t)b * 256 + g) * 64; const bf16_t* Vc = (const bf16_t*)(ws + WS_VCMP) + ((size_t)b * 256 + g) * 64;
      dma_tile<64>(lds0, Kc, 128, Vc, 128, 0, 0, wid, lane);
      dma_tile<64>(lds0, Kc, 128, Vc, 128, 64, 1, wid, lane);
      dma_tile<64, true>(lds0, pr + rowbase * DINP + slot_base(S_KSEL + g), DINP, pr + rowbase * DINP + slot_base(S_VSEL + g), DINP, 64 * qc, 2, wid, lane); }
    for (int i = tid; i < 768; i += 512) { const int br = i >> 8, r = (i >> 6) & 3, qq = i & 63;
        const float x = bf2f(pr[(rowbase + q0 + qq) * DINP + P_GATE + 8 * br + 4 * g + r]); gate[i] = 1.f / (1.f + __expf(-x)); }
    { const bf16_t* Qw = pr + (rowbase + q) * DINP + slot_base(S_Q + h) + 8 * hi;
#pragma unroll
      for (int d0 = 0; d0 < 4; ++d0) qr[d0] = *(const bf16x8*)(Qw + 128 * (d0 >> 1) + 16 * (d0 & 1)); }
    }
    f32x16 oc[2];
    {
        NSA_IDS();
        ATT_BAR();
        lcp vp0 = L + L_V + ((lane >> 4) & 1) * 32 + (lane & 3) * 8 + (4 * hi + ((lane & 15) >> 2)) * 64;
        LAS float* imp = (LAS float*)(L + L_IMP) + (rh * 64 + qloc) * IMPS;
        f32x16 a0, a1, b0, b1;
        { f32x16 zero;
#pragma unroll
          for (int r = 0; r < 16; ++r) zero[r] = 0.f;
          qkt<64>(a0, a1, L + L_K, qr, zero, r32, hi); qkt<64>(b0, b1, L + L_K + KSLOT, qr, zero, r32, hi); }
#define CMP_FIX(P, coff, extra) do { float bv[16]; \
            _Pragma("unroll") for (int r = 0; r < 16; ++r) bv[r] = tbh[clamp127(q - 16 * (crow(r, hi) + (coff)) - 31)]; \
            PIN16(bv); \
            _Pragma("unroll") for (int r = 0; r < 16; ++r) { const int c = crow(r, hi) + (coff); const int d = q - 16 * c - 31; P[r] = (d < 0 || (extra && c >= NCMP)) ? -INFINITY : P[r] + bv[r]; } } while (0)
        CMP_FIX(a0, 0, false); CMP_FIX(a1, 32, false); CMP_FIX(b0, 64, false); CMP_FIX(b1, 96, true);
#undef CMP_FIX
        float m = swap_max(__builtin_fmaxf(__builtin_fmaxf(max16(a0), max16(a1)), __builtin_fmaxf(max16(b0), max16(b1))), lane);
        if (m == -INFINITY) m = 0.f;
#pragma unroll
        for (int r = 0; r < 16; ++r) { a0[r] = __builtin_amdgcn_exp2f(a0[r] - m); a1[r] = __builtin_amdgcn_exp2f(a1[r] - m); b0[r] = __builtin_amdgcn_exp2f(b0[r] - m); b1[r] = __builtin_amdgcn_exp2f(b1[r] - m); }
        const float lsum = swap_sum((sum16(a0) + sum16(a1)) + (sum16(b0) + sum16(b1)), lane);
        const float inv = (lsum > 0.f) ? 1.f / lsum : 0.f;
        float prev_last = 0.f;
#define CMP_IMP(T, P0, P1) do { float own[8], car[8]; \
            _Pragma("unroll") for (int a = 0; a < 4; ++a) { \
                own[a]     = P0[4 * a] + P0[4 * a + 1] + P0[4 * a + 2] + 0.5f * P0[4 * a + 3]; car[a]     = 0.5f * P0[4 * a + 3]; \
                own[4 + a] = P1[4 * a] + P1[4 * a + 1] + P1[4 * a + 2] + 0.5f * P1[4 * a + 3]; car[4 + a] = 0.5f * P1[4 * a + 3]; } \
            _Pragma("unroll") for (int k = 0; k < 8; ++k) car[k] = lane_xor(car[k], lane, 32); \
            _Pragma("unroll") for (int k = 0; k < 8; ++k) { const float add = hi ? car[k] : (k >= 1 ? car[k - 1] : prev_last); imp[16 * (T) + 2 * k + hi] = own[k] + add; } \
            prev_last = car[7]; } while (0)
        CMP_IMP(0, a0, a1); CMP_IMP(1, b0, b1);
#undef CMP_IMP
        if (hi == 0) ((LAS float*)(L + L_INVL))[rh * 64 + qloc] = inv;
        f32x16 o[2];
#pragma unroll
        for (int r = 0; r < 16; ++r) { o[0][r] = 0.f; o[1][r] = 0.f; }
        pv(o, vp0, a0, a1); pv(o, vp0 + VSLOT, b0, b1);
        ATT_BAR();
        if (qc >= 1) dma_tile<64, true>(lds0, pr + rowbase * DINP + slot_base(S_KSEL + g), DINP, pr + rowbase * DINP + slot_base(S_VSEL + g), DINP, 64 * (qc - 1), 0, wid, lane);
#pragma unroll
        for (int r = 0; r < 16; ++r) { oc[0][r] = 0.f; oc[1][r] = 0.f; }
        acc_scaled(oc, o, gate[(0 * 4 + rh) * 64 + qloc] * inv, wsf, r32, hi);
    }
    if (qc <= 15) {
        const int tid = opaque_tid(wv);
        if (tid < 64) ((LAS unsigned*)(L + L_SELM))[tid] = (qc == 31) ? 0xffffffffu : ((2u << qc) - 1u);
        ATT_LBAR();
    } else {
        const int tid = opaque_tid(wv);
        const LAS float* imp = (const LAS float*)(L + L_IMP); LAS float* sc = (LAS float*)(L + L_SC);
        const int qq = tid >> 3, jj = tid & 7;
        const LAS float* il = (const LAS float*)(L + L_INVL);
        const float i0 = il[qq], i1 = il[64 + qq], i2 = il[128 + qq], i3 = il[192 + qq];
#pragma unroll
        for (int k = 0; k < 4; ++k) { const int j = jj + 8 * k;
            const float tot = (imp[(0 * 64 + qq) * IMPS + j] * i0 + imp[(1 * 64 + qq) * IMPS + j] * i1) + (imp[(2 * 64 + qq) * IMPS + j] * i2 + imp[(3 * 64 + qq) * IMPS + j] * i3);
            float s; if (j > qc) s = -INFINITY; else if (j == 0 || j == qc || j == qc - 1) s = 1e4f; else s = tot; sc[qq * IMPS + j] = s; }
        ATT_LBAR();
        float v[32];
#pragma unroll
        for (int k = 0; k < 32; ++k) v[k] = sc[qq * IMPS + k];
        unsigned bits = 0u;
#pragma unroll
        for (int k = 0; k < 4; ++k) { const int j = jj + 8 * k; const float me = sc[qq * IMPS + j]; int rank = 0;
#pragma unroll
            for (int i = 0; i < 32; ++i) { const float si = v[i]; rank += (si > me || (si == me && i < j)) ? 1 : 0; }
            if (rank < 16) bits |= 1u << j; }
        { const int lane = tid & 63; bits |= lane_xor_u(bits, lane, 1); bits |= lane_xor_u(bits, lane, 2); bits |= lane_xor_u(bits, lane, 4); }
        if (jj == 0) ((LAS unsigned*)(L + L_SELM))[qq] = bits;
        ATT_LBAR();
    }
    { NSA_IDS(); park_store(oc, (LAS float*)(L + L_OST) + wid * 2048, lane); }
    {
        NSA_IDS();
        const unsigned selm = ((const LAS unsigned*)(L + L_SELM))[qloc];
        const bf16_t* Kg = pr + rowbase * DINP + slot_base(S_KSEL + g);
        const bf16_t* Vg = pr + rowbase * DINP + slot_base(S_VSEL + g);
        PolSel pol{qc + 1, qc, q, hi, selm, tbh};
        const PolWin polw{(qc < 8 ? qc : 8) + 1, qc, q, hi, tbh};
        const NextTiles<64, true, true, PolWin> nxt{pr + rowbase * DINP + slot_base(S_KWIN + g), DINP, pr + rowbase * DINP + slot_base(S_VWIN + g), DINP, &polw, polw.ntiles < 2 ? polw.ntiles : 2};
        f32x16 o[2]; float l;
        flash_loop<64, true>(L, Kg, DINP, Vg, DINP, qr, pol, 2, (qc + 1 < 2) ? qc + 1 : 2, nxt, o, l, wid, lane);
        { f32x16 dummy[2]; park_acc<false>(dummy, (LAS float*)(L + L_OST) + wid * 2048, o, (l > 0.f) ? gate[(1 * 4 + rh) * 64 + qloc] / l : 0.f, wsf, lane); }
    }
    {
        NSA_IDS();
        const bf16_t* Kg = pr + rowbase * DINP + slot_base(S_KWIN + g);
        const bf16_t* Vg = pr + rowbase * DINP + slot_base(S_VWIN + g);
        PolWin pol{(qc < 8 ? qc : 8) + 1, qc, q, hi, tbh};
        f32x16 o[2]; float l;
        flash_loop<64, true>(L, Kg, DINP, Vg, DINP, qr, pol, (2 + qc + 1) % NSLOT, pol.ntiles < 2 ? pol.ntiles : 2, NoNext{}, o, l, wid, lane);
        f32x16 fin[2]; park_acc<true>(fin, (LAS float*)(L + L_OST) + wid * 2048, o, (l > 0.f) ? gate[(2 * 4 + rh) * 64 + qloc] / l : 0.f, wsf, lane);
        store_tile(fin, (bf16_t*)(ws + WS_MIX) + (rowbase + q0 + 32 * qh) * DM + 512 + 64 * h, DM, L, wid, lane, (float*)(ws + WS_SSQM) + 2 * (rowbase + q0 + 32 * qh) + 1);
    }
    ATT_BAR();
}
#undef ATT_BAR
#undef ATT_LBAR
#undef NSA_IDS
}

#define XB_TMO      128
#define XB_XCNT(j)  (256  + 64 * (j))
#define XB_XSUB(j)  (1280 + 64 * (j))
#define XB_XGEN(j)  (2304 + 64 * (j))
#define XB_TOP      3328
#define XB_TOPGEN   3392
#define XCD_BAR_WORDS 3456
#define XB_SPIN_CAP (1u << 18)

__device__ __forceinline__ unsigned xb_ld(unsigned* p)              { return __hip_atomic_load(p, __ATOMIC_RELAXED, __HIP_MEMORY_SCOPE_AGENT); }
__device__ __forceinline__ unsigned xb_add(unsigned* p, unsigned v) { return __hip_atomic_fetch_add(p, v, __ATOMIC_RELAXED, __HIP_MEMORY_SCOPE_AGENT); }
__device__ __forceinline__ unsigned xb_xcc_id() { return (unsigned)__builtin_amdgcn_s_getreg((3 << 11) | 20) & 0xFu; }
#define XB_SPIN(cond, bar) do { unsigned _sp = 0; while (cond) { __builtin_amdgcn_s_sleep(1); \
    if ((++_sp & 255u) == 0u) { if (xb_ld(&(bar)[XB_TMO])) break; if (_sp > XB_SPIN_CAP) { atomicAdd(&(bar)[XB_TMO], 1u); break; } } } } while (0)

struct XcdBarrier {
    unsigned* bar; unsigned x;
    volatile LAS unsigned* st;
};

__device__ __forceinline__ XcdBarrier xcd_barrier_post(unsigned* bar, volatile LAS unsigned* st) {
    XcdBarrier b; b.bar = bar; b.x = xb_xcc_id(); b.st = st;
    if (threadIdx.x == 0) (void)xb_add(&bar[XB_XCNT(b.x)], 1u);
    return b;
}
__device__ __forceinline__ void xcd_barrier_complete(unsigned* bar, unsigned x, unsigned& nloc, unsigned& nx) {
    const unsigned G = gridDim.x * gridDim.y * gridDim.z;
    unsigned sum, cnt, mine, sp = 0u;
    for (;;) {
        sum = 0u; cnt = 0u; mine = 0u;
#pragma unroll
        for (unsigned j = 0; j < 16; ++j) { const unsigned c = xb_ld(&bar[XB_XCNT(j)]); sum += c; cnt += (c > 0u) ? 1u : 0u; mine = (j == x) ? c : mine; }
        if (sum == G) break;
        __builtin_amdgcn_s_sleep(1);
        if ((++sp & 255u) == 0u) { if (xb_ld(&bar[XB_TMO])) break; if (sp > XB_SPIN_CAP) { atomicAdd(&bar[XB_TMO], 1u); break; } }
    }
    nloc = mine > 0u ? mine : 1u; nx = cnt > 0u ? cnt : 1u;
}

__device__ __forceinline__ void xcd_barrier(const XcdBarrier& b, const unsigned char* pf = nullptr, int nchunk = 0, int wv = 0) {
    asm volatile("s_waitcnt vmcnt(0)" ::: "memory");
    __syncthreads();
    if (pf != nullptr && wv >= 1 && wv <= 4) {
        const int t = opaque_tid(wv) - 64;
        const pg8::u32x4* src = (const pg8::u32x4*)pf + (size_t)(blockIdx.x & 255) * nchunk;
        pg8::u32x4 v[9];
#pragma unroll
        for (int i = 0; i < 9; ++i) { int c = i * 256 + t; c = c < nchunk ? c : nchunk - 1; v[i] = src[c]; }
        asm volatile("" :: "v"(v[0]), "v"(v[1]), "v"(v[2]), "v"(v[3]), "v"(v[4]), "v"(v[5]), "v"(v[6]), "v"(v[7]), "v"(v[8]));
    }
    if (threadIdx.x == 0) {
        unsigned* bar = b.bar;
        __builtin_amdgcn_s_waitcnt(0);
        unsigned nloc = b.st[0], nx = b.st[1];
        if (nloc == 0u) { xcd_barrier_complete(bar, b.x, nloc, nx); b.st[0] = nloc; b.st[1] = nx; }
        const unsigned old = xb_add(&bar[XB_XSUB(b.x)], 1u);
        const unsigned gen = old / nloc;
        if (old + 1u == (gen + 1u) * nloc) {
            __builtin_amdgcn_fence(__ATOMIC_RELEASE, "agent");
            asm volatile("s_waitcnt vmcnt(0)" ::: "memory");
            const unsigned og = xb_add(&bar[XB_TOP], 1u);
            const unsigned tg = og / nx;
            if (og + 1u == (tg + 1u) * nx) xb_add(&bar[XB_TOPGEN], 1u);
            else XB_SPIN(xb_ld(&bar[XB_TOPGEN]) == tg, bar);
            __builtin_amdgcn_fence(__ATOMIC_ACQUIRE, "agent");
            xb_add(&bar[XB_XGEN(b.x)], 1u);
            asm volatile("s_waitcnt vmcnt(0)" ::: "memory");
        } else {
            XB_SPIN(xb_ld(&bar[XB_XGEN(b.x)]) == gen, bar);
            __builtin_amdgcn_fence(__ATOMIC_ACQUIRE, "agent");
            asm volatile("s_waitcnt vmcnt(0)" ::: "memory");
        }
    }
    __syncthreads();
}

template <bool RELEASE = false>
__device__ __forceinline__ void group_sync(unsigned* ctl, unsigned* a0, unsigned* a1, unsigned* a2, unsigned* a3, unsigned* w0, unsigned t0, unsigned* w1, unsigned t1, const unsigned char* pf = nullptr, int nchunk = 0, int wv = 0) {
    asm volatile("s_waitcnt vmcnt(0)" ::: "memory");
    __syncthreads();
    if (pf != nullptr && wv >= 1 && wv <= 4) {
        const int t = opaque_tid(wv) - 64;
        const pg8::u32x4* src = (const pg8::u32x4*)pf + (size_t)(blockIdx.x & 255) * nchunk;
        pg8::u32x4 v[9];
#pragma unroll
        for (int i = 0; i < 9; ++i) { int c = i * 256 + t; c = c < nchunk ? c : nchunk - 1; v[i] = src[c]; }
        asm volatile("" :: "v"(v[0]), "v"(v[1]), "v"(v[2]), "v"(v[3]), "v"(v[4]), "v"(v[5]), "v"(v[6]), "v"(v[7]), "v"(v[8]));
    }
    if (threadIdx.x == 0) {
        if (RELEASE) { __builtin_amdgcn_fence(__ATOMIC_RELEASE, "agent"); asm volatile("s_waitcnt vmcnt(0)" ::: "memory"); }
        (void)xb_add(a0, 1u); if (a1) (void)xb_add(a1, 1u); if (a2) (void)xb_add(a2, 1u); if (a3) (void)xb_add(a3, 1u);
        XB_SPIN(xb_ld(w0) < t0, ctl);
        if (w1 != nullptr) XB_SPIN(xb_ld(w1) < t1, ctl);
        __builtin_amdgcn_fence(__ATOMIC_ACQUIRE, "agent");
        asm volatile("s_waitcnt vmcnt(0)" ::: "memory");
    }
    __syncthreads();
}

__global__ void __launch_bounds__(512, 2) mega(Params p) {
    extern __shared__ __attribute__((aligned(16))) unsigned char lds[];
    const int G = gridDim.x, bid = blockIdx.x, NGW = G * NW;
    int wv = __builtin_amdgcn_readfirstlane((int)(threadIdx.x >> 6)); asm volatile("" : "+s"(wv));
#define PHASE_IDS() const int tid = opaque_tid(wv), lane = tid & 63, wave = __builtin_amdgcn_readfirstlane(tid >> 6), gw = bid * NW + wave; (void)tid; (void)lane; (void)gw
    unsigned char* ws = (unsigned char*)inptr(22);
    LAS unsigned char* L = (LAS unsigned char*)lds;
    volatile LAS unsigned* bst = (volatile LAS unsigned*)(L + LDS_BST);
    if (threadIdx.x < 4) bst[threadIdx.x] = 0u;
    __syncthreads();
    (void)xcd_barrier_post((unsigned*)(ws + WS_CTL), bst);
#define bar (XcdBarrier{(unsigned*)((unsigned char*)inptr(22) + WS_CTL), xb_xcc_id(), (volatile LAS unsigned*)((LAS unsigned char*)lds + LDS_BST)})

    {
        PHASE_IDS();
        LAS float* scr = (LAS float*)(L + wave * 8704);
        constexpr int I0 = (1024 / 64) * (DINP / 32), I1 = (QR / 64) * (MQ / 32), I2 = (KVR / 64) * (MKV / 32), I3 = 16 * 32, I4 = 16 * (FF / 32), I5 = (FF / 64) * 32;
        constexpr int I6 = (2048 / 64) * (128 / 32), I7 = (128 / 64) * (64 / 32);
        constexpr int NIT = I0 + I1 + I2 + I3 + I4 + I5 + 2 * I6 + 2 * I7;
        for (int it = gw; it < NIT; it += NGW) {
            int r = it;
            if (r < I0) { p0_transpose_item(inptr(2), 1024, DIN, DINP, (bf16_t*)(ws + WS_WIN), scr, r, lane, inptr(1), 0, 1); continue; } r -= I0;
            if (r < I1) { p0_transpose_item(inptr(5), QR, MQ, MQ, (bf16_t*)(ws + WS_WUQ), scr, r, lane, inptr(3)); continue; } r -= I1;
            if (r < I2) { p0_transpose_item(inptr(6), KVR, MKV, MKV, (bf16_t*)(ws + WS_WUKV), scr, r, lane, inptr(4), 0, 2); continue; } r -= I2;
            if (r < I3) { const int k0_ = 64 * (r / 32); p0_transpose_item(inptr(17), 1024, 1024, 1024, (bf16_t*)(ws + WS_WO), scr, r, lane, k0_ < 512 ? inptr(15) : inptr(16) - 512); continue; } r -= I3;
            if (r < I4) { p0_transpose_item(inptr(19), 1024, FF, FF, (bf16_t*)(ws + WS_WUP), scr, r, lane, inptr(18)); continue; } r -= I4;
            if (r < I5) { p0_transpose_item(inptr(20), FF, 1024, 1024, (bf16_t*)(ws + WS_WDN), scr, r, lane, nullptr, LDH); continue; } r -= I5;
            if (r < 2 * I6) { const int kv = r / I6; p0_transpose_item(inptr(12) + (size_t)kv * 2048 * 128, 2048, 128, 128, (bf16_t*)(ws + WS_W1T) + (size_t)kv * 128 * 2048, scr, r % I6, lane); continue; } r -= 2 * I6;
            { const int kv = r / I7; p0_transpose_item(inptr(13) + kv * 128 * 64, 128, 64, 64, (bf16_t*)(ws + WS_W2T) + kv * 64 * 128, scr, r % I7, lane); }
        }
        for (int m = gw; m < M; m += 4 * NGW) rows_to_bf16_rstd<4>(inptr(0), (bf16_t*)(ws + WS_XB), (float*)(ws + WS_RS1), m, NGW, lane);
        for (int e = bid * 512 + tid; e < 2048 * 16; e += G * 512) { const int pos = e >> 4, i = e & 15; const float inv = exp2f(-(float)i * (13.287712379549449f / 16.f)); float sn, cs; sincosf((float)pos * inv, &sn, &cs);
            ((float*)(ws + WS_ROPE))[pos * 32 + i] = cs; ((float*)(ws + WS_ROPE))[pos * 32 + 16 + i] = sn; }
        for (int m = bid * 512 + tid; m < M; m += G * 512) { ((float*)(ws + WS_SSQ2))[m] = 0.f; ((float*)(ws + WS_RSQ))[m] = 0.f; ((float*)(ws + WS_RSKV))[m] = 0.f; ((float*)(ws + WS_SSQKR))[m] = 0.f; ((float*)(ws + WS_SSQM))[2 * m] = 0.f; ((float*)(ws + WS_SSQM))[2 * m + 1] = 0.f; }
    }
    xcd_barrier(bar);
    { pg8::Gemm g{(const bf16_t*)(ws + WS_XB), (const bf16_t*)(ws + WS_WIN), M, DINP, DM, DM, DM}; pg8::StaticOrder S; S.init(M, DINP, G, bid);
      PEpiProj E{(bf16_t*)(ws + WS_PROJ), DINP, (const float*)(ws + WS_RS1), (float*)(ws + WS_RSQ), (float*)(ws + WS_RSKV), (float*)(ws + WS_SSQKR), inptr(9), inptr(10), (const float*)(ws + WS_ROPE), inptr(8)}; pg8::gemm_phase<PEpiProj, pg8::StaticOrder, true, true>(L, g, S, E, wv); }
#define GCTL ((unsigned*)((unsigned char*)inptr(22) + WS_CTL))
#define GCNT(sp, pm) (GCTL + 4096 + ((sp) * 64 + (pm)) * 16)
    if (G == 256) { const int x_ = bid & 7, jj_ = (bid >> 3) & 7, k_ = bid >> 6;
        unsigned* c_ = GCNT(0, 8 * x_ + jj_); group_sync(GCTL, c_, nullptr, nullptr, nullptr, c_, 4u, ((k_ & 1) && jj_ < 7) ? GCNT(0, 8 * x_ + jj_ + 1) : nullptr, 4u); }
    else xcd_barrier(bar);
    { PHASE_IDS();
      __syncthreads();
      if (G == 256) { const int x_ = bid & 7, jj_ = (bid >> 3) & 7, k_ = bid >> 6; compress_block(ws, L, (2 * jj_ + (k_ & 1)) | (x_ << 4) | ((k_ >> 1) << 7), wv); }
      else for (int t = bid; t < 256; t += G) compress_block(ws, L, t, wv); }
    { pg8::Gemm g{(const bf16_t*)(ws + WS_PROJ) + P_HKV, (const bf16_t*)(ws + WS_WUKV), M, MKV, KVR, DINP, KVR}; pg8::StaticOrder S; S.init(M, MKV, G, bid);
      PEpiKV E{(bf16_t*)(ws + WS_KVM), (bf16_t*)(ws + WS_KMLA), (const bf16_t*)(ws + WS_PROJ), (const float*)(ws + WS_RSKV), (const float*)(ws + WS_SSQKR), (const float*)(ws + WS_ROPE), inptr(8)}; pg8::gemm_phase<PEpiKV, pg8::StaticOrder, true, true>(L, g, S, E, wv); }
    asm volatile("" : "+s"(wv));
    { pg8::Gemm g{(const bf16_t*)(ws + WS_PROJ) + P_HQ, (const bf16_t*)(ws + WS_WUQ), M, MQ, QR, DINP, QR}; pg8::StaticOrder S; S.init(M, MQ, G, bid);
      PEpiBf16<0> E{(bf16_t*)(ws + WS_QM), MQ, (const float*)(ws + WS_RSQ), 1.f / QR}; pg8::gemm_phase<PEpiBf16<0>, pg8::StaticOrder, true, false>(L, g, S, E, wv); }
    if (G == 256) { unsigned* c_ = GCNT(3, bid & 7); group_sync<true>(GCTL, c_, nullptr, nullptr, nullptr, c_, 32u, nullptr, 0u); }
    else xcd_barrier(bar);
    {
        PHASE_IDS();
        LAS float* tb = (LAS float*)L;
        for (int i = tid; i < 8 * 128; i += 512) { const int h = i >> 7, n = i & 127; tb[i] = (inptr(14)[t5_bucket(n) * 8 + h] - inptr(14)[31 * 8 + h]) * LOG2E; }
        __syncthreads();
        const int vcu = (G % 8 == 0) ? (bid % 8) * (G / 8) + bid / 8 : bid;
        for (int pr_ = vcu; pr_ < 256; pr_ += G) {
            { const int bg = pr_ >> 4, s_ = pr_ & 15;
#pragma unroll 1
              for (int u_ = 0; u_ < 2; ++u_) att::nsa_unit(ws, L, bg >> 1, bg & 1, (u_ & 1) ? s_ : 31 - s_, wv);
            }
            { const int bh = pr_ >> 2, s_ = pr_ & 3;
#pragma unroll 1
              for (int u_ = 0; u_ < 2; ++u_) att::mla_unit(ws, L, bh >> 3, bh & 7, u_ ? s_ : 7 - s_, wv, u_ ? (4 * (7 - s_) + 4) % att::NSLOT : 0, u_ ? 2 : 0, u_ ? 0 : 2);
            }
        }
    }
    if (G == 256) { const int x_ = bid & 7, j_ = bid >> 3, sn_ = j_ & 15, sm_ = j_ & 3;
        group_sync(GCTL, GCNT(4, 8 * x_ + ((31 - sn_) >> 2)), GCNT(4, 8 * x_ + (sn_ >> 2)), GCNT(4, 8 * x_ + 7 - sm_), GCNT(4, 8 * x_ + sm_), GCNT(4, 8 * x_ + (j_ & 7)), 16u, nullptr, 0u, ws + WS_WO, (int)((size_t)DM * DM * 2 / 16 / 256), wv); }
    else xcd_barrier(bar, ws + WS_WO, (int)((size_t)DM * DM * 2 / 16 / 256), wv);
    { pg8::Gemm g{(const bf16_t*)(ws + WS_MIX), (const bf16_t*)(ws + WS_WO), M, DM, DM, DM, DM}; pg8::StaticOrder S; S.init(M, DM, G, bid);
      PEpiWo E{(const bf16_t*)(ws + WS_XB), (bf16_t*)(ws + WS_H2), (float*)(ws + WS_SSQ2), (const float*)(ws + WS_SSQM), DM}; pg8::gemm_phase<PEpiWo, pg8::StaticOrder, true, true>(L, g, S, E, wv); }
    if (G == 256) { unsigned* c_ = GCNT(1, 8 * (bid & 7) + ((bid >> 3) & 7)); group_sync(GCTL, c_, nullptr, nullptr, nullptr, c_, 4u, nullptr, 0u, ws + WS_WUP, (int)((size_t)FF * DM * 2 / 16 / 256), wv); }
    else xcd_barrier(bar, ws + WS_WUP, (int)((size_t)FF * DM * 2 / 16 / 256), wv);
    { pg8::Gemm g{(const bf16_t*)(ws + WS_H2), (const bf16_t*)(ws + WS_WUP), M, FF, DM, DM, DM}; pg8::StaticOrder S; S.init(M, FF, G, bid);
      PEpiBf16<2> E{(bf16_t*)(ws + WS_HID), LDH, (const float*)(ws + WS_SSQ2), 1.f / 1024}; pg8::gemm_phase<PEpiBf16<2>, pg8::StaticOrder, true, true>(L, g, S, E, wv); }
    if (G == 256) { unsigned* c_ = GCNT(2, 8 * (bid & 7) + ((bid >> 3) & 7)); group_sync(GCTL, c_, nullptr, nullptr, nullptr, c_, 4u, nullptr, 0u, ws + WS_WDN, (int)((size_t)DM * LDH * 2 / 16 / 256), wv); }
    else xcd_barrier(bar, ws + WS_WDN, (int)((size_t)DM * LDH * 2 / 16 / 256), wv);
    { pg8::Gemm g{(const bf16_t*)(ws + WS_HID), (const bf16_t*)(ws + WS_WDN), M, DM, FF, LDH, LDH}; pg8::StaticOrder S; S.init(M, DM, G, bid);
      PEpiDown E{(const bf16_t*)(ws + WS_H2), ((float*)inptr(21)), DM}; pg8::gemm_phase<PEpiDown, pg8::StaticOrder, true, true>(L, g, S, E, wv); }
#undef bar
}

extern "C" void kernel_launch(void* const* d_in, const int* in_sizes, int n_in, void* d_out, int out_size,
                              void* d_ws, size_t ws_size, hipStream_t stream) {
    static int grid_blocks = 0;
    if (!grid_blocks) {
        int dev = 0, cus = 0, per_cu = 0;
        (void)hipGetDevice(&dev);
        (void)hipDeviceGetAttribute(&cus, hipDeviceAttributeMultiprocessorCount, dev);
        (void)hipFuncSetAttribute((const void*)mega, hipFuncAttributeMaxDynamicSharedMemorySize, LDS_BYTES);
        (void)hipOccupancyMaxActiveBlocksPerMultiprocessor(&per_cu, (const void*)mega, 512, LDS_BYTES);
        if (per_cu != 1) fprintf(stderr, "note: occupancy query reports %d blocks/CU; launching 1 per CU\n", per_cu);
        grid_blocks = cus;
        if (n_in != 21 || out_size != M * DM || ws_size < 256 * MiB) fprintf(stderr, "unexpected shapes: n_in %d out %d ws %zu\n", n_in, out_size, ws_size);
    }
    Params p{};
    for (int i = 0; i < 21; ++i) p.in[i] = (const float*)d_in[i];
    p.out = (float*)d_out; p.ws = (unsigned char*)d_ws;
    if (hipMemsetAsync((char*)d_ws + WS_CTL, 0, CTL_ZERO_BYTES, stream) != hipSuccess) { fprintf(stderr, "memset of the barrier words failed\n"); return; }
    hipLaunchKernelGGL(mega, dim3(grid_blocks), dim3(512), LDS_BYTES, stream, p);
    hipError_t e = hipPeekAtLastError();
    if (e != hipSuccess) fprintf(stderr, "launch failed: %s (grid %d)\n", hipGetErrorString(e), grid_blocks);
}
```

```cpp
#include <hip/hip_runtime.h>
#include <cstdio>
#include <cstdint>

#define LAS __attribute__((address_space(3)))
typedef unsigned short bf16_t;
typedef short bf16x8 __attribute__((ext_vector_type(8)));
typedef float f32x4 __attribute__((ext_vector_type(4)));
typedef unsigned u32x4 __attribute__((ext_vector_type(4)));
typedef unsigned u32x2 __attribute__((ext_vector_type(2)));

constexpr int BATCH = 8, SEQ = 2048, DM = 1024, M = BATCH * SEQ;
constexpr int DIN = 1976, DINP = 2048;
constexpr int C_HQ = 0, C_HKV = 384, C_HKR = 640, C_QB = 672, C_KVB = 1184, C_GATE = 1952;
constexpr int C_KCMP = C_KVB, C_VCMP = C_KVB + 128, C_KSEL = C_KVB + 256, C_VSEL = C_KVB + 384, C_KWIN = C_KVB + 512, C_VWIN = C_KVB + 640;
constexpr int P_HQ = 1280, P_HKV = 1664, P_HKR = 1920, P_GATE = 1952;
__host__ __device__ constexpr int slot_base(int s) { return 256 * (s >> 2) + 32 * (s & 3); }
constexpr int S_Q = 0, S_KCMP = 8, S_VCMP = 10, S_KSEL = 12, S_VSEL = 14, S_KWIN = 16, S_VWIN = 18;
constexpr int QR = 384, KVR = 256, MQ = 768, MKV = 1024, FF = 4096;
constexpr int LDH = FF + 64;
constexpr int NCMP = 127;
constexpr float EPS = 1e-6f;
constexpr float LOG2E = 1.4426950408889634f;
constexpr float QS_MLA = 0.10206207261596577f * LOG2E;
constexpr float QS_NSA = 0.125f * LOG2E;

constexpr size_t MiB = 1u << 20;
constexpr size_t WS_CTL = 0, CTL_ZERO_BYTES = 65536;
constexpr size_t WS_WIN = 1 * MiB, WS_WUQ = 5 * MiB, WS_WUKV = 6 * MiB, WS_WO = 7 * MiB, WS_WUP = 9 * MiB, WS_WDN = 17 * MiB;
constexpr size_t WS_KCMP = 26 * MiB, WS_VCMP = 26 * MiB + 512 * 1024;
constexpr size_t WS_W1T = 30 * MiB;
constexpr size_t WS_W2T = 27 * MiB;
constexpr size_t WS_RSQ = 28 * MiB, WS_RSKV = 28 * MiB + 65536, WS_SSQ2 = 28 * MiB + 131072, WS_SSQM = 28 * MiB + 262144, WS_RS1 = 28 * MiB + 262144 + 131072;
constexpr size_t WS_SSQKR = 28 * MiB + 524288;
constexpr size_t WS_ROPE = 29 * MiB + 65536;
constexpr size_t WS_XB = 32 * MiB;
constexpr size_t WS_DUMMY0 = 0;
constexpr size_t WS_HB = 32 * MiB;
constexpr size_t WS_MIX = 64 * MiB;
constexpr size_t WS_PROJ = 96 * MiB;
constexpr size_t WS_QM = 160 * MiB;
constexpr size_t WS_KVM = 184 * MiB;
constexpr size_t WS_KMLA = 216 * MiB;
constexpr size_t WS_QN = 208 * MiB;
constexpr size_t WS_KSEL = 240 * MiB;
constexpr size_t WS_KWIN = 244 * MiB;
constexpr size_t WS_HQN = 232 * MiB;
constexpr size_t WS_HKVN = 244 * MiB;
constexpr size_t WS_H2 = 224 * MiB;
constexpr size_t WS_HID = 32 * MiB;

constexpr int LDS_BYTES = 155648, LDS_BST = 154624;
constexpr int NW = 8;

struct Params {
    const float* in[21];
    float* out;
    unsigned char* ws;
};

typedef const float* cfptr_t;
__device__ __forceinline__ const float* inptr(int i) {
    const __attribute__((address_space(4))) char* ka = (const __attribute__((address_space(4))) char*)__builtin_amdgcn_kernarg_segment_ptr();
    int off = i * 8; asm volatile("" : "+s"(off));
    return *(const __attribute__((address_space(4))) cfptr_t*)(ka + off);
}
template <class V> __device__ __forceinline__ void st16_wt(const void* sbase, unsigned voff, const V& v) { static_assert(sizeof(V) == 16, "16-byte vector"); asm volatile("global_store_dwordx4 %0, %1, %2 sc1\n\ts_nop 1" :: "v"(voff), "v"(v), "s"(sbase) : "memory"); }
__device__ __forceinline__ unsigned f2bf(float f) { unsigned u = __builtin_bit_cast(unsigned, f); return (u + 0x7fffu + ((u >> 16) & 1u)) >> 16; }
__device__ __forceinline__ float bf2f(unsigned b) { return __builtin_bit_cast(float, b << 16); }
__device__ __forceinline__ unsigned pk2(float lo, float hi) { return f2bf(lo) | (f2bf(hi) << 16); }
__device__ __forceinline__ float wave_sum(float v) {
#pragma unroll
    for (int o = 1; o < 64; o <<= 1) v += __shfl_xor(v, o);
    return v;
}
__device__ __forceinline__ int t5_bucket(int n) {
    if (n < 16) return n;
    int b = 16;
    b += (n >= 19); b += (n >= 21); b += (n >= 24); b += (n >= 27); b += (n >= 31); b += (n >= 35); b += (n >= 40); b += (n >= 46);
    b += (n >= 52); b += (n >= 59); b += (n >= 67); b += (n >= 77); b += (n >= 87); b += (n >= 99); b += (n >= 113);
    return b;
}

__device__ __forceinline__ void p0_transpose_item(const float* W, int K, int N, int Npad, bf16_t* WT, LAS float* scr, int item, int lane, const float* gk = nullptr, int ldw = 0, int projmap = 0) {
    const int nblk = Npad / 32, kb = item / nblk, nb = item % nblk, k0 = 64 * kb, n0 = 32 * nb;
    int nsrc = n0;
    if (projmap == 2) { const int pn_ = n0 >> 8, bj_ = (n0 >> 7) & 1, wc_ = (n0 >> 5) & 3; nsrc = (wc_ < 2 ? 128 * (2 * pn_ + wc_) : 128 * (2 * pn_ + wc_ - 2) + 64) + 32 * bj_; }
    else if (projmap) { if (n0 < 1280) { const int sl = 4 * (n0 >> 8) + ((n0 & 127) >> 5), e0 = 32 * ((n0 >> 7) & 1); nsrc = (sl < 8 ? C_QB + 64 * sl : C_KVB + 64 * (sl - 8)) + e0; }
                   else if (n0 < 1280 + 672) nsrc = n0 - 1280; else if (n0 == P_GATE) nsrc = C_GATE; else nsrc = N; }
    const int nn = nsrc + (lane & 31);
    float wv[32];
#pragma unroll
    for (int i = 0; i < 32; ++i) { const int kk = 2 * i + (lane >> 5); wv[i] = (nn < N) ? W[(size_t)(k0 + kk) * N + nn] : 0.f; }
#pragma unroll
    for (int i = 0; i < 32; ++i) { const int kk = 2 * i + (lane >> 5); const float gg = gk ? gk[k0 + kk] : 1.f; scr[kk * 33 + (lane & 31)] = wv[i] * gg; }
    asm volatile("s_waitcnt lgkmcnt(0)" ::: "memory");
    const int c = lane & 7;
#pragma unroll
    for (int j = 0; j < 4; ++j) { const int n = (lane >> 3) + 8 * j; const LAS float* s = scr + (8 * c) * 33 + n;
        u32x4 o; o.x = pk2(s[0 * 33], s[1 * 33]); o.y = pk2(s[2 * 33], s[3 * 33]); o.z = pk2(s[4 * 33], s[5 * 33]); o.w = pk2(s[6 * 33], s[7 * 33]);
        *(u32x4*)(WT + (size_t)(n0 + n) * (ldw ? ldw : K) + k0 + 8 * c) = o; }
    asm volatile("s_waitcnt lgkmcnt(0)" ::: "memory");
}
template <int NR>
__device__ __forceinline__ void rows_to_bf16_rstd(const float* x, bf16_t* o, float* rstd_out, int row0, int rstride, int lane) {
    f32x4 v[NR][4];
#pragma unroll
    for (int r = 0; r < NR; ++r) { const int rr = (row0 + r * rstride < M) ? row0 + r * rstride : row0; const f32x4* xr = (const f32x4*)(x + (size_t)rr * DM) + lane;
#pragma unroll
        for (int j = 0; j < 4; ++j) v[r][j] = xr[64 * j]; }
#pragma unroll
    for (int r = 0; r < NR; ++r) { if (row0 + r * rstride >= M) continue; float s = 0.f;
#pragma unroll
        for (int j = 0; j < 4; ++j) s += (v[r][j].x * v[r][j].x + v[r][j].y * v[r][j].y) + (v[r][j].z * v[r][j].z + v[r][j].w * v[r][j].w);
        s = wave_sum(s);
        if (lane == 0) rstd_out[row0 + r * rstride] = 1.f / sqrtf(s * (1.f / DM) + EPS);
        unsigned long long* o8 = (unsigned long long*)(o + (size_t)(row0 + r * rstride) * DM) + lane;
#pragma unroll
        for (int j = 0; j < 4; ++j) o8[64 * j] = (unsigned long long)pk2(v[r][j].x, v[r][j].y) | ((unsigned long long)pk2(v[r][j].z, v[r][j].w) << 32); }
}

__device__ __forceinline__ int opaque_tid(int wv) { int lane; asm volatile("v_mbcnt_lo_u32_b32 %0, -1, 0\n\tv_mbcnt_hi_u32_b32 %0, -1, %0" : "=v"(lane)); return (wv << 6) | lane; }
namespace pg8 {
#define PG8_LAS __attribute__((address_space(3)))
typedef unsigned short bf16_t;
typedef short bf16x8 __attribute__((ext_vector_type(8)));
typedef float f32x4 __attribute__((ext_vector_type(4)));
typedef unsigned u32x4 __attribute__((ext_vector_type(4)));
constexpr int BM = 256, BK = 64, HALF = 128, HTB = HALF * BK * 2  , STAGE_BYTES = 8 * HTB, NXCD = 8, WGM = 8;

__host__ __device__ __forceinline__ int lds_byte(int r, int c) { const int st = (r >> 4) * 2 + (c >> 5), rr = r & 15, cc = c & 31, ob = rr * 64 + cc * 2; return st * 1024 + (ob ^ (((ob >> 9) & 1) << 5)); }
__host__ __device__ __forceinline__ void stage_rc(int b, int& R, int& C) { const int st = b / 1024, sb = b % 1024, swz = sb ^ (((sb >> 9) & 1) << 5); R = (st >> 1) * 16 + swz / 64; C = (st & 1) * 32 + (swz % 64) / 2; }
__host__ __device__ __forceinline__ int perm32(int rho) { const int n = rho >> 4, i = rho & 15; return 8 * (i >> 2) + 4 * n + (i & 3); }

struct Unit { int pm, pn; };
struct Gemm { const bf16_t* A; const bf16_t* Bt; int M, N, K, lda, ldb; };

struct StaticOrder {
    int nM, nN, nwg, G, c;
    __host__ __device__ void init(int M, int N, int G_, int c_) { nM = M / BM; nN = N / BM; nwg = nM * nN; G = G_; c = c_; }
    __host__ __device__ bool next(int i, Unit& u) const {
        const long L = (long)i * G + c; if (L >= nwg) return false;
        int wgid = (int)L; { const int q = nwg / NXCD, r = nwg % NXCD, xcd = wgid % NXCD, off = wgid / NXCD; wgid = (xcd < r ? xcd * (q + 1) : r * (q + 1) + (xcd - r) * q) + off; }
        const int nig = WGM * nN, gid = wgid / nig, fm = gid * WGM, gsz = (nM - fm) < WGM ? (nM - fm) : WGM;
        u.pm = fm + ((wgid % nig) % gsz); u.pn = (wgid % nig) / gsz; return true;
    }
    __device__ __forceinline__ void a_ready(const Unit&) const {}
    __device__ __forceinline__ void done(const Unit&) const {}
};

template <class Epi, class Sched, bool ALIGN_EPI = false, bool SP2 = false>
__device__ __forceinline__ void gemm_phase(PG8_LAS unsigned char* lds, const Gemm g, const Sched& S, const Epi& E, int wv) {
    const int tid = opaque_tid(wv), wid = __builtin_amdgcn_readfirstlane(tid >> 6), lane = tid & 63, wr = wid >> 2, wc = wid & 3, fr = lane & 15, fq = lane >> 4;
    const int K = g.K, nt = K / BK;
    unsigned voffA[2], voffB[2];
#pragma unroll
    for (int i = 0; i < 2; ++i) { int R, C; stage_rc(tid * 16 + i * 8192, R, C); const int Rb = Epi::PERM ? ((R & ~31) + perm32(R & 31)) : R;
        voffA[i] = (unsigned)(R * g.lda + C) * 2u; voffB[i] = (unsigned)(Rb * g.ldb + C) * 2u; }
    const size_t kstep = (size_t)(BK * 2);
    const size_t hstepA = (size_t)HALF * g.lda * 2, hstepB = (size_t)HALF * g.ldb * 2;
    const size_t tstepA = 2 * hstepA, tstepB = 2 * hstepB;
    const unsigned ldsw = (unsigned)wid * 1024u;
    const int aoff = lds_byte(wr * 64 + fr, fq * 8), boff = lds_byte(wc * 32 + fr, fq * 8);
#define PG8_SA(b, h) (((b) * 2 + (h)) * HTB)
#define PG8_SB(b, h) ((4 + (b) * 2 + (h)) * HTB)
#define PG8_STAGE(bufoff, gbase, voff) do { _Pragma("unroll") for (int _i = 0; _i < 2; ++_i) \
        __builtin_amdgcn_global_load_lds((const unsigned*)((const char*)(gbase) + (voff)[_i]), (PG8_LAS unsigned*)(lds + (bufoff) + ldsw + _i * 8192), 16, 0, 0); } while (0)
#define PG8_LDA(dst, b, h) do { _Pragma("unroll") for (int m = 0; m < 4; ++m) _Pragma("unroll") for (int k = 0; k < 2; ++k) dst[m][k] = *(const PG8_LAS bf16x8*)(lds + PG8_SA(b, h) + aoff + m * 2048 + k * 1024); } while (0)
#define PG8_LDB(dst, b, h) do { _Pragma("unroll") for (int n = 0; n < 2; ++n) _Pragma("unroll") for (int k = 0; k < 2; ++k) dst[n][k] = *(const PG8_LAS bf16x8*)(lds + PG8_SB(b, h) + boff + n * 2048 + k * 1024); } while (0)
#define PG8_MMA(ai, bj, At, Bt) do { __builtin_amdgcn_s_setprio(1); _Pragma("unroll") for (int m = 0; m < 4; ++m) _Pragma("unroll") for (int n = 0; n < 2; ++n) _Pragma("unroll") for (int k = 0; k < 2; ++k) \
        acc[ai][bj][m][n] = __builtin_amdgcn_mfma_f32_16x16x32_bf16(Bt[n][k], At[m][k], acc[ai][bj][m][n], 0, 0, 0); __builtin_amdgcn_s_setprio(0); } while (0)
#define PG8_WAIT_V(n) asm volatile("s_waitcnt vmcnt(" #n ")" ::: "memory")
#define PG8_WAIT_L(n) asm volatile("s_waitcnt lgkmcnt(" #n ")" ::: "memory")
#define PG8_BAR __builtin_amdgcn_s_barrier()
#define PG8_SCHED __builtin_amdgcn_sched_barrier(0)
    Unit cur, nxt; int ui = 0;
    if (!S.next(0, cur)) return;
    f32x4 acc[2][2][4][2];
#pragma unroll
    for (int a = 0; a < 2; ++a)
#pragma unroll
        for (int b = 0; b < 2; ++b)
#pragma unroll
            for (int m = 0; m < 4; ++m)
#pragma unroll
                for (int n = 0; n < 2; ++n) acc[a][b][m][n] = (f32x4){0.f, 0.f, 0.f, 0.f};
    bf16x8 At[4][2], B0[2][2], B1[2][2];
    const char* cA = (const char*)g.A + (size_t)cur.pm * tstepA; const char* cB = (const char*)g.Bt + (size_t)cur.pn * tstepB;
    asm volatile("" : "+s"(cA), "+s"(cB));
    S.a_ready(cur);
    if constexpr (SP2) {
        PG8_STAGE(PG8_SB(0, 0), cB, voffB); PG8_STAGE(PG8_SB(0, 1), cB + hstepB, voffB); PG8_STAGE(PG8_SA(0, 0), cA, voffA); PG8_STAGE(PG8_SA(0, 1), cA + hstepA, voffA);
        if (wr == 1) PG8_BAR;
        PG8_WAIT_V(2); PG8_BAR;
        PG8_STAGE(PG8_SB(1, 0), cB + kstep, voffB); PG8_STAGE(PG8_SA(1, 0), cA + kstep, voffA); PG8_STAGE(PG8_SB(1, 1), cB + hstepB + kstep, voffB);
        PG8_WAIT_V(6); PG8_BAR;
    } else {
        PG8_STAGE(PG8_SB(0, 0), cB, voffB); PG8_STAGE(PG8_SA(0, 0), cA, voffA); PG8_STAGE(PG8_SB(0, 1), cB + hstepB, voffB); PG8_STAGE(PG8_SA(0, 1), cA + hstepA, voffA);
        if (wr == 1) PG8_BAR;
        PG8_WAIT_V(4); PG8_BAR;
        PG8_STAGE(PG8_SB(1, 0), cB + kstep, voffB); PG8_STAGE(PG8_SA(1, 0), cA + kstep, voffA); PG8_STAGE(PG8_SB(1, 1), cB + hstepB + kstep, voffB);
        PG8_WAIT_V(6); PG8_BAR;
    }
    for (;;) {
        const bool has_next = S.next(ui + 1, nxt);
        const char* nA = has_next ? (const char*)g.A + (size_t)nxt.pm * tstepA : cA; const char* nB = has_next ? (const char*)g.Bt + (size_t)nxt.pn * tstepB : cB;
        asm volatile("" : "+s"(nA), "+s"(nB));
        for (int t = 0; t < nt; t += 2) {
            if constexpr (Epi::MIDSCALE) { if (t == nt / 2) E.midscale(acc, cur, wr, fr); }
            const bool last = (t == nt - 2);
            const char* a1 = cA + (size_t)(t + 1) * kstep;
            const char* a2 = last ? nA : cA + (size_t)(t + 2) * kstep; const char* b2 = last ? nB : cB + (size_t)(t + 2) * kstep;
            const char* a3 = a2 + kstep; const char* b3 = b2 + kstep;
            asm volatile("" : "+s"(a1), "+s"(a2), "+s"(b2), "+s"(a3), "+s"(b3));
            if (last && has_next) S.a_ready(nxt);
            if constexpr (SP2) {
            PG8_LDB(B0, 0, 0); PG8_LDB(B1, 0, 1); PG8_SCHED; PG8_LDA(At, 0, 0); PG8_STAGE(PG8_SA(1, 1), a1 + hstepA, voffA);
            PG8_WAIT_V(8); PG8_WAIT_L(0); PG8_BAR; PG8_MMA(0, 0, At, B0); PG8_MMA(0, 1, At, B1); PG8_BAR; PG8_SCHED;
            PG8_LDA(At, 0, 1); PG8_STAGE(PG8_SB(0, 0), b2, voffB); PG8_STAGE(PG8_SB(0, 1), b2 + hstepB, voffB); PG8_STAGE(PG8_SA(0, 0), a2, voffA);
            PG8_WAIT_V(8); PG8_WAIT_L(0); PG8_BAR; PG8_MMA(1, 0, At, B0); PG8_MMA(1, 1, At, B1); PG8_BAR; PG8_SCHED;
            PG8_LDB(B0, 1, 0); PG8_LDB(B1, 1, 1); PG8_SCHED; PG8_LDA(At, 1, 0); PG8_STAGE(PG8_SA(0, 1), a2 + hstepA, voffA);
            PG8_WAIT_V(8); PG8_WAIT_L(0); PG8_BAR; PG8_MMA(0, 0, At, B0); PG8_MMA(0, 1, At, B1); PG8_BAR; PG8_SCHED;
            PG8_LDA(At, 1, 1); PG8_STAGE(PG8_SB(1, 0), b3, voffB); PG8_STAGE(PG8_SB(1, 1), b3 + hstepB, voffB); PG8_STAGE(PG8_SA(1, 0), a3, voffA);
            PG8_WAIT_V(8); PG8_WAIT_L(0); PG8_BAR; PG8_MMA(1, 0, At, B0); PG8_MMA(1, 1, At, B1); PG8_BAR; PG8_SCHED;
            } else {
            PG8_LDB(B0, 0, 0); PG8_SCHED; PG8_LDA(At, 0, 0); PG8_STAGE(PG8_SA(1, 1), a1 + hstepA, voffA);
            PG8_WAIT_L(8); PG8_BAR; PG8_WAIT_L(0); PG8_MMA(0, 0, At, B0); PG8_BAR; PG8_SCHED;
            PG8_LDB(B1, 0, 1); PG8_STAGE(PG8_SB(0, 0), b2, voffB);
            PG8_BAR; PG8_WAIT_L(0); PG8_MMA(0, 1, At, B1); PG8_BAR;
            PG8_LDA(At, 0, 1); PG8_STAGE(PG8_SA(0, 0), a2, voffA);
            PG8_BAR; PG8_WAIT_L(0); PG8_MMA(1, 0, At, B0); PG8_BAR; PG8_SCHED;
            PG8_STAGE(PG8_SB(0, 1), b2 + hstepB, voffB);
            PG8_WAIT_V(6); PG8_BAR; PG8_MMA(1, 1, At, B1); PG8_BAR;
            PG8_LDB(B0, 1, 0); PG8_SCHED; PG8_LDA(At, 1, 0); PG8_STAGE(PG8_SA(0, 1), a2 + hstepA, voffA);
            PG8_WAIT_L(8); PG8_BAR; PG8_WAIT_L(0); PG8_MMA(0, 0, At, B0); PG8_BAR; PG8_SCHED;
            PG8_LDB(B1, 1, 1); PG8_STAGE(PG8_SB(1, 0), b3, voffB);
            PG8_BAR; PG8_WAIT_L(0); PG8_MMA(0, 1, At, B1); PG8_BAR;
            PG8_LDA(At, 1, 1); PG8_STAGE(PG8_SA(1, 0), a3, voffA);
            PG8_BAR; PG8_WAIT_L(0); PG8_MMA(1, 0, At, B0); PG8_BAR; PG8_SCHED;
            PG8_STAGE(PG8_SB(1, 1), b3 + hstepB, voffB);
            PG8_WAIT_V(6); PG8_BAR; PG8_MMA(1, 1, At, B1); PG8_BAR;
            }
        }
        if constexpr (ALIGN_EPI) { if (wr == 0) PG8_BAR; }
        if constexpr (!Epi::AFTER_DRAIN) { const int l2_ = opaque_tid(wv) & 63; E(acc, cur, wr, wc, l2_ & 15, l2_ >> 4); S.done(cur); }
        if (!has_next) break;
#pragma unroll
        for (int a = 0; a < 2; ++a)
#pragma unroll
            for (int b = 0; b < 2; ++b)
#pragma unroll
                for (int m = 0; m < 4; ++m)
#pragma unroll
                    for (int n = 0; n < 2; ++n) acc[a][b][m][n] = (f32x4){0.f, 0.f, 0.f, 0.f};
        cur = nxt; cA = nA; cB = nB; ++ui;
        if constexpr (ALIGN_EPI) { if (wr == 1) PG8_BAR; }
    }
    PG8_WAIT_V(0);
    if constexpr (!ALIGN_EPI) { if (wr == 0) PG8_BAR; }
    PG8_BAR;
    if constexpr (Epi::AFTER_DRAIN) { E.fused(acc, cur, wr, wc, fr, fq, lds, wid, lane); S.done(cur); }
#undef PG8_SA
#undef PG8_SB
#undef PG8_STAGE
#undef PG8_LDA
#undef PG8_LDB
#undef PG8_MMA
#undef PG8_WAIT_V
#undef PG8_WAIT_L
#undef PG8_BAR
#undef PG8_SCHED
}
}

__device__ __forceinline__ unsigned cvt_pk_bf16(float lo, float hi) { unsigned r; asm volatile("v_cvt_pk_bf16_f32 %0, %1, %2" : "=v"(r) : "v"(lo), "v"(hi)); return r; }
template <int ACT> struct PEpiBf16 {
    static constexpr bool PERM = true, AFTER_DRAIN = false, MIDSCALE = false;
    bf16_t* O; int ldc; const float* rs; float invn;
    __device__ __forceinline__ void operator()(const f32x4 (&acc)[2][2][4][2], const pg8::Unit& u, int wr, int wc, int fr, int fq) const {
        const int row0 = u.pm * 256 + wr * 64 + fr, col0 = u.pn * 256 + wc * 32 + 8 * fq;
        float rsc[2][4];
#pragma unroll
        for (int ai = 0; ai < 2; ++ai)
#pragma unroll
            for (int m = 0; m < 4; ++m) rsc[ai][m] = rs ? rs[row0 + ai * 128 + m * 16] : 1.f;
        if (invn > 0.f) {
#pragma unroll
            for (int ai = 0; ai < 2; ++ai)
#pragma unroll
                for (int m = 0; m < 4; ++m) rsc[ai][m] = 1.f / sqrtf(rsc[ai][m] * invn + EPS); }
#pragma unroll
        for (int ai = 0; ai < 2; ++ai)
#pragma unroll
            for (int m = 0; m < 4; ++m) { const bf16_t* rowp = O + ((size_t)(u.pm * 256 + wr * 64 + ai * 128 + m * 16) * ldc + u.pn * 256 + wc * 32); const unsigned lo_ = (unsigned)(fr * ldc + 8 * fq) * 2u; const float sc_ = rsc[ai][m];
#pragma unroll
                for (int bj = 0; bj < 2; ++bj) { f32x4 v0 = acc[ai][bj][m][0] * sc_, v1 = acc[ai][bj][m][1] * sc_;
                    if (ACT == 2) {
#pragma unroll
                        for (int e = 0; e < 4; ++e) { const float a = fmaxf(v0[e], 0.f), b = fmaxf(v1[e], 0.f); v0[e] = a * a; v1[e] = b * b; } }
                    u32x4 w; w.x = cvt_pk_bf16(v0[0], v0[1]); w.y = cvt_pk_bf16(v0[2], v0[3]); w.z = cvt_pk_bf16(v1[0], v1[1]); w.w = cvt_pk_bf16(v1[2], v1[3]);
                    st16_wt(rowp + bj * 128, lo_, w); } }
    }
};
struct PEpiProj {
    static constexpr bool PERM = true, AFTER_DRAIN = false, MIDSCALE = false;
    bf16_t* O; int ldc; const float* rs1; float* ssq_q; float* ssq_kv; float* ssq_kr; const float* qgain; const float* kgain; const float* rope; const float* kgm;
    __device__ __forceinline__ void operator()(const f32x4 (&acc)[2][2][4][2], const pg8::Unit& u, int wr, int wc, int fr, int fq) const {
        const int row0 = u.pm * 256 + wr * 64 + fr, col0 = u.pn * 256 + wc * 32 + 8 * fq, lane = fq * 16 + fr;
        float rsc[2][4];
#pragma unroll
        for (int ai = 0; ai < 2; ++ai)
#pragma unroll
            for (int m = 0; m < 4; ++m) rsc[ai][m] = rs1[row0 + ai * 128 + m * 16];
        const int sl = 4 * u.pn + wc;
        int mode = 0; const float* g = nullptr; float gs = 1.f;
        if (u.pn < 5) { if (sl < 8) { mode = 1; g = qgain; gs = QS_NSA; } else if (sl == S_KSEL || sl == S_KSEL + 1) { mode = 1; g = kgain + 64; } else if (sl == S_KWIN || sl == S_KWIN + 1) { mode = 1; g = kgain + 128; } }
        f32x4 ga[2][2];
        if (mode == 1) {
#pragma unroll
            for (int bj = 0; bj < 2; ++bj) { ga[bj][0] = *(const f32x4*)(g + 32 * bj + 8 * fq) * gs; ga[bj][1] = *(const f32x4*)(g + 32 * bj + 8 * fq + 4) * gs; } }
#pragma unroll
        for (int ai = 0; ai < 2; ++ai)
#pragma unroll
            for (int m = 0; m < 4; ++m) { const int row = row0 + ai * 128 + m * 16; const bf16_t* rowp = O + ((size_t)(u.pm * 256 + wr * 64 + ai * 128 + m * 16) * ldc + u.pn * 256 + wc * 32); const unsigned lo_ = (unsigned)(fr * ldc + 8 * fq) * 2u; const float sc_ = rsc[ai][m];
                f32x4 v[2][2];
#pragma unroll
                for (int bj = 0; bj < 2; ++bj) { v[bj][0] = acc[ai][bj][m][0] * sc_; v[bj][1] = acc[ai][bj][m][1] * sc_; }
                if (mode == 1) {
                    float ss = 0.f;
#pragma unroll
                    for (int bj = 0; bj < 2; ++bj)
#pragma unroll
                        for (int n = 0; n < 2; ++n) ss += (v[bj][n][0] * v[bj][n][0] + v[bj][n][1] * v[bj][n][1]) + (v[bj][n][2] * v[bj][n][2] + v[bj][n][3] * v[bj][n][3]);
                    ss += __builtin_bit_cast(float, __builtin_amdgcn_ds_bpermute((lane ^ 16) << 2, __builtin_bit_cast(int, ss)));
                    ss += __builtin_bit_cast(float, __builtin_amdgcn_ds_bpermute((lane ^ 32) << 2, __builtin_bit_cast(int, ss)));
                    const float rstd = 1.f / sqrtf(ss * (1.f / 64) + EPS);
#pragma unroll
                    for (int bj = 0; bj < 2; ++bj) { v[bj][0] = v[bj][0] * rstd * ga[bj][0]; v[bj][1] = v[bj][1] * rstd * ga[bj][1]; }
                } else if (u.pn >= 5) {
#pragma unroll
                    for (int bj = 0; bj < 2; ++bj) { const int cb = u.pn * 256 + bj * 128;
                        float* dst = (cb < P_HKV) ? ssq_q : (cb < P_HKR ? ssq_kv : ((cb == P_HKR && wc == 0) ? ssq_kr : nullptr));
                        if (dst) { float ss = (v[bj][0][0] * v[bj][0][0] + v[bj][0][1] * v[bj][0][1]) + (v[bj][0][2] * v[bj][0][2] + v[bj][0][3] * v[bj][0][3]) + (v[bj][1][0] * v[bj][1][0] + v[bj][1][1] * v[bj][1][1]) + (v[bj][1][2] * v[bj][1][2] + v[bj][1][3] * v[bj][1][3]);
                            ss += __builtin_bit_cast(float, __builtin_amdgcn_ds_bpermute((lane ^ 16) << 2, __builtin_bit_cast(int, ss)));
                            ss += __builtin_bit_cast(float, __builtin_amdgcn_ds_bpermute((lane ^ 32) << 2, __builtin_bit_cast(int, ss)));
                            if (fq == 0) __hip_atomic_fetch_add(dst + row, ss, __ATOMIC_RELAXED, __HIP_MEMORY_SCOPE_AGENT); }
                        if (cb == P_HKR && wc == 0) {
                            const f32x4 g0 = *(const f32x4*)(kgm + 64 + 8 * fq), g1 = *(const f32x4*)(kgm + 64 + 8 * fq + 4);
                            const float* rp = rope + (size_t)(row & (SEQ - 1)) * 32 + 8 * (fq & 1);
                            const f32x4 c0 = *(const f32x4*)rp, c1 = *(const f32x4*)(rp + 4), s0 = *(const f32x4*)(rp + 16), s1 = *(const f32x4*)(rp + 20);
#pragma unroll
                            for (int n = 0; n < 2; ++n)
#pragma unroll
                                for (int j = 0; j < 4; ++j) { const float nv = v[bj][n][j] * (n ? g1[j] : g0[j]);
                                    const float pv = __builtin_bit_cast(float, __builtin_amdgcn_ds_bpermute((lane ^ 32) << 2, __builtin_bit_cast(int, nv)));
                                    const float cs = n ? c1[j] : c0[j], sn = n ? s1[j] : s0[j]; v[bj][n][j] = (fq < 2) ? nv * cs - pv * sn : nv * cs + pv * sn; } } }
                }
#pragma unroll
                for (int bj = 0; bj < 2; ++bj) { u32x4 w; w.x = cvt_pk_bf16(v[bj][0][0], v[bj][0][1]); w.y = cvt_pk_bf16(v[bj][0][2], v[bj][0][3]); w.z = cvt_pk_bf16(v[bj][1][0], v[bj][1][1]); w.w = cvt_pk_bf16(v[bj][1][2], v[bj][1][3]);
                    st16_wt(rowp + bj * 128, lo_, w); } }
    }
};
struct PEpiKV {
    static constexpr bool PERM = true, AFTER_DRAIN = false, MIDSCALE = false;
    bf16_t* V; bf16_t* K; const bf16_t* proj; const float* ssq_kv; const float* ssq_kr; const float* rope; const float* kgain;
    __device__ __forceinline__ void operator()(const f32x4 (&acc)[2][2][4][2], const pg8::Unit& u, int wr, int wc, int fr_, int fq_) const {
        int fr = fr_, fq = fq_; asm volatile("" : "+v"(fr), "+v"(fq)); const float* kgain = this->kgain; asm volatile("" : "+s"(kgain)); const float* rope = this->rope; asm volatile("" : "+s"(rope));
        const int row0 = u.pm * 256 + wr * 64 + fr, lane = fq * 16 + fr;
        float rsc[2][4];
#pragma unroll
        for (int ai = 0; ai < 2; ++ai)
#pragma unroll
            for (int m = 0; m < 4; ++m) rsc[ai][m] = 1.f / sqrtf(ssq_kv[row0 + ai * 128 + m * 16] * (1.f / KVR) + EPS);
        if (wc >= 2) {
            const int col0 = u.pn * 256 + wc * 32 + 8 * fq;
#pragma unroll
            for (int ai = 0; ai < 2; ++ai)
#pragma unroll
                for (int m = 0; m < 4; ++m) { const bf16_t* rowp = V + ((size_t)(u.pm * 256 + wr * 64 + ai * 128 + m * 16) * MKV + u.pn * 256 + wc * 32); const unsigned lo_ = (unsigned)(fr * MKV + 8 * fq) * 2u; const float sc_ = rsc[ai][m];
#pragma unroll
                    for (int bj = 0; bj < 2; ++bj) { const f32x4 v0 = acc[ai][bj][m][0] * sc_, v1 = acc[ai][bj][m][1] * sc_;
                        u32x4 w; w.x = cvt_pk_bf16(v0[0], v0[1]); w.y = cvt_pk_bf16(v0[2], v0[3]); w.z = cvt_pk_bf16(v1[0], v1[1]); w.w = cvt_pk_bf16(v1[2], v1[3]);
                        st16_wt(rowp + bj * 128, lo_, w); } }
            return;
        }
        const int hh = 2 * u.pn + wc;
#pragma unroll
        for (int ai = 0; ai < 2; ++ai)
#pragma unroll
            for (int m = 0; m < 4; ++m) { const int row = row0 + ai * 128 + m * 16; const float sc_ = rsc[ai][m];
                const bf16_t* ko = K + ((size_t)(u.pm * 256 + wr * 64 + ai * 128 + m * 16) * MQ + 96 * hh); const unsigned lo_ = (unsigned)(fr * MQ + 8 * fq) * 2u;
                float rstd;
                {
                    f32x4 v[2][2]; float ss = 0.f;
#pragma unroll
                    for (int bj = 0; bj < 2; ++bj)
#pragma unroll
                        for (int n = 0; n < 2; ++n) { v[bj][n] = acc[ai][bj][m][n] * sc_; ss += (v[bj][n][0] * v[bj][n][0] + v[bj][n][1] * v[bj][n][1]) + (v[bj][n][2] * v[bj][n][2] + v[bj][n][3] * v[bj][n][3]); }
                    ss += __builtin_bit_cast(float, __builtin_amdgcn_ds_bpermute((lane ^ 16) << 2, __builtin_bit_cast(int, ss)));
                    ss += __builtin_bit_cast(float, __builtin_amdgcn_ds_bpermute((lane ^ 32) << 2, __builtin_bit_cast(int, ss)));
                    rstd = 1.f / sqrtf((ss + ssq_kr[row]) * (1.f / 96) + EPS);
#pragma unroll
                    for (int bj = 0; bj < 2; ++bj) { const f32x4 g0 = *(const f32x4*)(kgain + 32 * bj + 8 * fq), g1 = *(const f32x4*)(kgain + 32 * bj + 8 * fq + 4);
                        const f32x4 a = v[bj][0] * rstd * g0, b = v[bj][1] * rstd * g1;
                        u32x4 w; w.x = cvt_pk_bf16(a[0], a[1]); w.y = cvt_pk_bf16(a[2], a[3]); w.z = cvt_pk_bf16(b[0], b[1]); w.w = cvt_pk_bf16(b[2], b[3]);
                        st16_wt(ko + 32 * bj, lo_, w); }
                }
                asm volatile("" ::: "memory");
                {
                    const bf16x8 kr8 = *(const bf16x8*)(proj + (size_t)row * DINP + P_HKR + 8 * fq);
                    u32x4 w; w.x = cvt_pk_bf16(bf2f((unsigned short)kr8[0]) * rstd, bf2f((unsigned short)kr8[1]) * rstd); w.y = cvt_pk_bf16(bf2f((unsigned short)kr8[2]) * rstd, bf2f((unsigned short)kr8[3]) * rstd);
                    w.z = cvt_pk_bf16(bf2f((unsigned short)kr8[4]) * rstd, bf2f((unsigned short)kr8[5]) * rstd); w.w = cvt_pk_bf16(bf2f((unsigned short)kr8[6]) * rstd, bf2f((unsigned short)kr8[7]) * rstd);
                    st16_wt(ko + 64, lo_, w);
                }
                asm volatile("" ::: "memory"); }
    }
};
struct PEpiWo {
    static constexpr bool PERM = true, AFTER_DRAIN = false, MIDSCALE = true;
    const bf16_t* base; bf16_t* xb; float* ssq; const float* ssqm; int ldc;
    __device__ __forceinline__ void midscale(f32x4 (&acc)[2][2][4][2], const pg8::Unit& u, int wr, int fr) const {
#pragma unroll
        for (int ai = 0; ai < 2; ++ai)
#pragma unroll
            for (int m = 0; m < 4; ++m) { const int row = u.pm * 256 + ai * 128 + wr * 64 + m * 16 + fr;
                const float sa = ssqm[2 * row], sb = ssqm[2 * row + 1]; const float ratio = sqrtf((sb * (1.f / 512) + EPS) / (sa * (1.f / 512) + EPS));
#pragma unroll
                for (int bj = 0; bj < 2; ++bj)
#pragma unroll
                    for (int n = 0; n < 2; ++n) acc[ai][bj][m][n] *= ratio; }
    }
    __device__ __forceinline__ void operator()(const f32x4 (&acc)[2][2][4][2], const pg8::Unit& u, int wr, int wc, int fr, int fq) const {
        const int lane = fq * 16 + fr;
        const int rowb = u.pm * 256 + wr * 64 + fr;
        float rb[8];
#pragma unroll
        for (int g_ = 0; g_ < 8; ++g_) rb[g_] = ssqm[2 * (rowb + (g_ >> 2) * 128 + (g_ & 3) * 16) + 1];
        const size_t tile0 = (size_t)(u.pm * 256 + wr * 64) * ldc + u.pn * 256 + wc * 32;
        const unsigned lo_ = (unsigned)(fr * ldc + 8 * fq) * 2u;
        u32x4 nxt[2];
#pragma unroll
        for (int bj = 0; bj < 2; ++bj) nxt[bj] = *(const u32x4*)((const char*)(base + tile0 + bj * 128) + lo_);
#pragma unroll
        for (int g_ = 0; g_ < 8; ++g_) { const int ai = g_ >> 2, m = g_ & 3; const int row = rowb + ai * 128 + m * 16; const size_t roff = tile0 + (size_t)(ai * 128 + m * 16) * ldc; float ss = 0.f;
            u32x4 cur[2];
#pragma unroll
            for (int bj = 0; bj < 2; ++bj) cur[bj] = nxt[bj];
            if (g_ < 7) { const size_t roffn = tile0 + (size_t)(((g_ + 1) >> 2) * 128 + ((g_ + 1) & 3) * 16) * ldc;
#pragma unroll
                for (int bj = 0; bj < 2; ++bj) nxt[bj] = *(const u32x4*)((const char*)(base + roffn + bj * 128) + lo_); }
            const float rbs = 1.f / sqrtf(rb[g_] * (1.f / 512) + EPS);
#pragma unroll
            for (int bj = 0; bj < 2; ++bj) { const u32x4 cw = cur[bj];
                const f32x4 v0 = (f32x4){bf2f(cw.x & 0xffffu), bf2f(cw.x >> 16), bf2f(cw.y & 0xffffu), bf2f(cw.y >> 16)} + acc[ai][bj][m][0] * rbs;
                const f32x4 v1 = (f32x4){bf2f(cw.z & 0xffffu), bf2f(cw.z >> 16), bf2f(cw.w & 0xffffu), bf2f(cw.w >> 16)} + acc[ai][bj][m][1] * rbs;
                ss += ((v0[0] * v0[0] + v0[1] * v0[1]) + (v0[2] * v0[2] + v0[3] * v0[3])) + ((v1[0] * v1[0] + v1[1] * v1[1]) + (v1[2] * v1[2] + v1[3] * v1[3]));
                u32x4 w; w.x = cvt_pk_bf16(v0[0], v0[1]); w.y = cvt_pk_bf16(v0[2], v0[3]); w.z = cvt_pk_bf16(v1[0], v1[1]); w.w = cvt_pk_bf16(v1[2], v1[3]);
                st16_wt(xb + roff + bj * 128, lo_, w); }
            ss += __builtin_bit_cast(float, __builtin_amdgcn_ds_bpermute((lane ^ 16) << 2, __builtin_bit_cast(int, ss)));
            ss += __builtin_bit_cast(float, __builtin_amdgcn_ds_bpermute((lane ^ 32) << 2, __builtin_bit_cast(int, ss)));
            if (fq == 0) __hip_atomic_fetch_add(ssq + row, ss, __ATOMIC_RELAXED, __HIP_MEMORY_SCOPE_AGENT); }
    }
};


struct PEpiDown {
    static constexpr bool PERM = false, AFTER_DRAIN = false, MIDSCALE = false;
    const bf16_t* xb; float* out; int ldc;
    __device__ __forceinline__ void operator()(const f32x4 (&acc)[2][2][4][2], const pg8::Unit& u, int wr, int wc, int fr, int fq) const {
        const int col0 = u.pn * 256 + wc * 32 + 4 * fq; const int rowb = u.pm * 256 + wr * 64 + fr;
        u32x2 nxt[2][2];
#pragma unroll
        for (int bj = 0; bj < 2; ++bj)
#pragma unroll
            for (int n = 0; n < 2; ++n) nxt[bj][n] = *(const u32x2*)(xb + (size_t)rowb * ldc + col0 + bj * 128 + n * 16);
#pragma unroll
        for (int g_ = 0; g_ < 8; ++g_) { const int ai = g_ >> 2, m = g_ & 3; const size_t off = (size_t)(rowb + ai * 128 + m * 16) * ldc + col0;
            u32x2 cur[2][2];
#pragma unroll
            for (int bj = 0; bj < 2; ++bj)
#pragma unroll
                for (int n = 0; n < 2; ++n) cur[bj][n] = nxt[bj][n];
            if (g_ < 7) { const size_t offn = (size_t)(rowb + ((g_ + 1) >> 2) * 128 + ((g_ + 1) & 3) * 16) * ldc + col0;
#pragma unroll
                for (int bj = 0; bj < 2; ++bj)
#pragma unroll
                    for (int n = 0; n < 2; ++n) nxt[bj][n] = *(const u32x2*)(xb + offn + bj * 128 + n * 16); }
#pragma unroll
            for (int bj = 0; bj < 2; ++bj)
#pragma unroll
                for (int n = 0; n < 2; ++n) { const u32x2 w = cur[bj][n];
                    const f32x4 bs = (f32x4){bf2f(w.x & 0xffffu), bf2f(w.x >> 16), bf2f(w.y & 0xffffu), bf2f(w.y >> 16)};
                    __builtin_nontemporal_store(bs + acc[ai][bj][m][n], (f32x4*)(out + off + bj * 128 + n * 16)); } }
    }
};

__device__ __forceinline__ float sq8(const bf16x8 v) { float s = 0.f;
#pragma unroll
    for (int j = 0; j < 8; ++j) { const float f = bf2f((unsigned short)v[j]); s += f * f; }
    return s; }
__device__ __forceinline__ u32x4 scale8(const bf16x8 v, float sc, const f32x4 ga, const f32x4 gb) { u32x4 o;
    o.x = pk2(bf2f((unsigned short)v[0]) * sc * ga[0], bf2f((unsigned short)v[1]) * sc * ga[1]); o.y = pk2(bf2f((unsigned short)v[2]) * sc * ga[2], bf2f((unsigned short)v[3]) * sc * ga[3]);
    o.z = pk2(bf2f((unsigned short)v[4]) * sc * gb[0], bf2f((unsigned short)v[5]) * sc * gb[1]); o.w = pk2(bf2f((unsigned short)v[6]) * sc * gb[2], bf2f((unsigned short)v[7]) * sc * gb[3]);
    return o; }

__device__ __forceinline__ void compress_block(unsigned char* ws, LAS unsigned char* L, int task, int wv) {
    const int tid = opaque_tid(wv), lane = tid & 63, wid = __builtin_amdgcn_readfirstlane(tid >> 6), fr = lane & 15, fq = lane >> 4;
    const int tc = task & 15, b = (task >> 4) & 7, kv = task >> 7;
    int c = 8 * tc + (fr >> 1); const int g = fr & 1; if (c > NCMP - 1) c = NCMP - 1;
    const bf16_t* arow = (const bf16_t*)(ws + WS_PROJ) + (size_t)(b * SEQ + 16 * c) * DINP + slot_base((kv ? S_VCMP : S_KCMP) + g) + 8 * fq;
    const bf16_t* w1t = (const bf16_t*)(ws + WS_W1T) + (size_t)kv * 128 * 2048 + (size_t)fr * 2048 + 8 * fq;
    bf16x8 araw[8];
#pragma unroll
    for (int s8 = 0; s8 < 8; ++s8) { const int s = 8 * wid + s8, r = s >> 1, db = (s & 1) * 32; araw[s8] = *(const bf16x8*)(arow + (size_t)r * DINP + 4 * db); }
    LAS float* pel = (LAS float*)(L + 98304);
    *(LAS f32x4*)(pel + 4 * tid) = *(const f32x4*)(inptr(11) + kv * 2048 + 4 * tid);
    f32x4 acc[8];
#pragma unroll
    for (int n = 0; n < 8; ++n) acc[n] = (f32x4){0.f, 0.f, 0.f, 0.f};
    bf16x8 bq[2][16];
#define CB_LOADQ(buf, q) do { _Pragma("unroll") for (int e = 0; e < 2; ++e) { const int s = 8 * wid + 2 * (q) + e; \
        _Pragma("unroll") for (int n = 0; n < 8; ++n) bq[buf][e * 8 + n] = *(const bf16x8*)(w1t + (size_t)(16 * n) * 2048 + 32 * s); } __builtin_amdgcn_sched_barrier(0); } while (0)
#define CB_COMPQ(buf, q) do { _Pragma("unroll") for (int e = 0; e < 2; ++e) { const int s8 = 2 * (q) + e, s = 8 * wid + s8, r = s >> 1, db = (s & 1) * 32; \
        const f32x4 pa = *(const LAS f32x4*)(pel + r * 64 + db + 8 * fq), pb = *(const LAS f32x4*)(pel + r * 64 + db + 8 * fq + 4); const bf16x8 ar = araw[s8]; \
        u32x4 aw; aw.x = pk2(bf2f((unsigned short)ar[0]) + pa[0], bf2f((unsigned short)ar[1]) + pa[1]); aw.y = pk2(bf2f((unsigned short)ar[2]) + pa[2], bf2f((unsigned short)ar[3]) + pa[3]); \
        aw.z = pk2(bf2f((unsigned short)ar[4]) + pb[0], bf2f((unsigned short)ar[5]) + pb[1]); aw.w = pk2(bf2f((unsigned short)ar[6]) + pb[2], bf2f((unsigned short)ar[7]) + pb[3]); \
        const bf16x8 a = __builtin_bit_cast(bf16x8, aw); \
        _Pragma("unroll") for (int n = 0; n < 8; ++n) acc[n] = __builtin_amdgcn_mfma_f32_16x16x32_bf16(a, bq[buf][e * 8 + n], acc[n], 0, 0, 0); } __builtin_amdgcn_sched_barrier(0); } while (0)
    CB_LOADQ(0, 0); CB_LOADQ(1, 1);
    __syncthreads();
    CB_COMPQ(0, 0); CB_LOADQ(0, 2); CB_COMPQ(1, 1); CB_LOADQ(1, 3); CB_COMPQ(0, 2); CB_COMPQ(1, 3);
#undef CB_LOADQ
#undef CB_COMPQ
    bf16x8 w2f[16]; float kgv[4];
    if (wid == 0) { const bf16_t* w2t = (const bf16_t*)(ws + WS_W2T) + kv * 64 * 128 + fr * 128 + 8 * fq; const float* kg = inptr(10);
#pragma unroll
        for (int ks = 0; ks < 4; ++ks)
#pragma unroll
            for (int n = 0; n < 4; ++n) w2f[ks * 4 + n] = *(const bf16x8*)(w2t + (size_t)(16 * n) * 128 + 32 * ks);
#pragma unroll
        for (int n = 0; n < 4; ++n) kgv[n] = kg[16 * n + fr]; }
    LAS float* part = (LAS float*)L;
#pragma unroll
    for (int n = 0; n < 8; ++n)
#pragma unroll
        for (int j = 0; j < 4; ++j) part[(wid * 16 + 4 * fq + j) * 128 + 16 * n + fr] = acc[n][j];
    __syncthreads();
    LAS bf16_t* hb_ = (LAS bf16_t*)(L + 65536);
#pragma unroll
    for (int e = 0; e < 4; ++e) { const int idx = tid + 512 * e; float v = 0.f;
#pragma unroll
        for (int w = 0; w < 8; ++w) v += part[w * 2048 + idx];
        hb_[idx] = (bf16_t)f2bf(v / (1.f + __expf(-v))); }
    __syncthreads();
    if (wid == 0) {
        f32x4 o[4];
#pragma unroll
        for (int n = 0; n < 4; ++n) o[n] = (f32x4){0.f, 0.f, 0.f, 0.f};
#pragma unroll
        for (int ks = 0; ks < 4; ++ks) { const bf16x8 a = *(const LAS bf16x8*)(hb_ + fr * 128 + 32 * ks + 8 * fq);
#pragma unroll
            for (int n = 0; n < 4; ++n) o[n] = __builtin_amdgcn_mfma_f32_16x16x32_bf16(a, w2f[ks * 4 + n], o[n], 0, 0, 0); }
        bf16_t* dstb = (bf16_t*)(ws + (kv ? WS_VCMP : WS_KCMP)) + (size_t)b * 128 * 2 * 64;
#pragma unroll
        for (int j = 0; j < 4; ++j) { const int row = 4 * fq + j, cc = 8 * tc + (row >> 1), gg = row & 1;
            float sc = 1.f;
            if (kv == 0) { float ss = o[0][j] * o[0][j] + o[1][j] * o[1][j] + o[2][j] * o[2][j] + o[3][j] * o[3][j];
                ss += __shfl_xor(ss, 1); ss += __shfl_xor(ss, 2); ss += __shfl_xor(ss, 4); ss += __shfl_xor(ss, 8); sc = 1.f / sqrtf(ss * (1.f / 64) + EPS); }
#pragma unroll
            for (int n = 0; n < 4; ++n) { const int col = 16 * n + fr; float v = o[n][j] * sc; if (kv == 0) v *= kgv[n]; if (cc >= NCMP) v = 0.f;
                dstb[((size_t)cc * 2 + gg) * 64 + col] = (bf16_t)f2bf(v); } }
    }
    __syncthreads();
}

namespace att {
typedef float f32x16 __attribute__((ext_vector_type(16)));
typedef short s16x4 __attribute__((ext_vector_type(4)));
typedef short v4i16_t __attribute__((ext_vector_type(4)));
typedef float f32x2_t __attribute__((ext_vector_type(2)));
typedef __bf16 bf16x2_t __attribute__((ext_vector_type(2)));
typedef const LAS unsigned char* lcp;
constexpr int NSLOT = 3;
constexpr int L_TB = 0, L_K = 4096, KSLOT = 12288, L_V = L_K + NSLOT * KSLOT, VSLOT = 8192, L_WSF = L_V + NSLOT * VSLOT, L_OST = L_WSF + 4096,
              L_IMP = L_OST + 32768, IMPS = 33  , L_SELM = L_IMP + 4 * 64 * IMPS * 4, L_GATE = L_SELM + 256, L_SC = L_GATE + 3072, L_INVL = L_SC + 64 * IMPS * 4, L_END = L_INVL + 1024;
static_assert(L_V + NSLOT * VSLOT <= 65536, "LDS-DMA destinations stay below 64 KiB");
static_assert(L_END <= LDS_BST, "attention LDS map");
constexpr float THR = 8.0f;
__device__ __forceinline__ int crow(int r, int hi) { return (r & 3) + 8 * (r >> 2) + 4 * hi; }
__device__ __forceinline__ void glds16(const void* gsrc, unsigned lds_dst) { unsigned keep;
    asm volatile("s_mov_b32 %0, m0\n\ts_mov_b32 m0, %2\n\ts_nop 0\n\tglobal_load_lds_dwordx4 %1, off\n\ts_mov_b32 m0, %0" : "=&s"(keep) : "v"(gsrc), "s"(lds_dst) : "memory"); }
__device__ __forceinline__ unsigned cvtpk(float lo, float hi) { f32x2_t v = {lo, hi}; bf16x2_t b = __builtin_convertvector(v, bf16x2_t); return __builtin_bit_cast(unsigned, b); }
__device__ __forceinline__ s16x4 vtr(lcp p) { return __builtin_bit_cast(s16x4, __builtin_amdgcn_ds_read_tr16_b64_v4i16((LAS v4i16_t*)p)); }
__device__ __forceinline__ float lane_xor(float v, int lane, int x) { return __builtin_bit_cast(float, __builtin_amdgcn_ds_bpermute((lane ^ x) << 2, __builtin_bit_cast(int, v))); }
__device__ __forceinline__ unsigned lane_xor_u(unsigned v, int lane, int x) { return (unsigned)__builtin_amdgcn_ds_bpermute((lane ^ x) << 2, (int)v); }
__device__ __forceinline__ float swap_max(float m, int lane) { return __builtin_fmaxf(m, lane_xor(m, lane, 32)); }
__device__ __forceinline__ float swap_sum(float m, int lane) { return m + lane_xor(m, lane, 32); }
__device__ __forceinline__ float max3f(float a, float b, float c) { float r; asm("v_max3_f32 %0, %1, %2, %3" : "=v"(r) : "v"(a), "v"(b), "v"(c)); return r; }
__device__ __forceinline__ float max32(const f32x16& p0, const f32x16& p1) {
    float a = max3f(p0[0], p0[1], p1[0]), b = max3f(p0[2], p0[3], p1[1]); a = max3f(a, p1[2], p1[3]);
#pragma unroll
    for (int r = 4; r < 16; r += 4) { a = max3f(a, p0[r], p0[r + 1]); b = max3f(b, p0[r + 2], p0[r + 3]); a = max3f(a, p1[r], p1[r + 1]); b = max3f(b, p1[r + 2], p1[r + 3]); }
    return __builtin_fmaxf(a, b); }
__device__ __forceinline__ float max16(const f32x16& p) { float a = __builtin_fmaxf(p[0], p[1]), b = __builtin_fmaxf(p[2], p[3]);
#pragma unroll
    for (int r = 4; r < 16; r += 4) { a = __builtin_fmaxf(a, __builtin_fmaxf(p[r], p[r + 1])); b = __builtin_fmaxf(b, __builtin_fmaxf(p[r + 2], p[r + 3])); }
    return __builtin_fmaxf(a, b); }
__device__ __forceinline__ float sum16(const f32x16& p) { float a = p[0] + p[1], b = p[2] + p[3];
#pragma unroll
    for (int r = 4; r < 16; r += 4) { a += p[r] + p[r + 1]; b += p[r + 2] + p[r + 3]; }
    return a + b; }
#define ATT_BAR() asm volatile("s_waitcnt vmcnt(0) lgkmcnt(0)\n\ts_barrier" ::: "memory")

template <int DQ> __device__ __forceinline__ void qkt(f32x16& p0, f32x16& p1, lcp kslot, const bf16x8* qr, const f32x16& cinit, int r32, int hi) {
    lcp kb = kslot + hi * 1024 + r32 * 16;
    constexpr int NB = 2;
#pragma unroll
    for (int db = 0; db < DQ / 16; db += NB) {
        bf16x8 kf[2 * NB];
#pragma unroll
        for (int e = 0; e < NB; ++e) { kf[2 * e] = *(const LAS bf16x8*)(kb + (db + e) * 2048); kf[2 * e + 1] = *(const LAS bf16x8*)(kb + (db + e) * 2048 + 512); }
        __builtin_amdgcn_sched_barrier(0);
#pragma unroll
        for (int e = 0; e < NB; ++e) { const int d0 = db + e;
            if (d0 == 0) { p0 = __builtin_amdgcn_mfma_f32_32x32x16_bf16(kf[0], qr[0], cinit, 0, 0, 0); p1 = __builtin_amdgcn_mfma_f32_32x32x16_bf16(kf[1], qr[0], cinit, 0, 0, 0); }
            else { p0 = __builtin_amdgcn_mfma_f32_32x32x16_bf16(kf[2 * e], qr[d0], p0, 0, 0, 0); p1 = __builtin_amdgcn_mfma_f32_32x32x16_bf16(kf[2 * e + 1], qr[d0], p1, 0, 0, 0); }
        }
    }
}
__device__ __forceinline__ void vload_half(bf16x8 (&vf)[8], lcp vp, int d0) {
#pragma unroll
    for (int ks = 0; ks < 4; ++ks) {
        const s16x4 lo = vtr(vp + d0 * 4096 + ks * 1024), hh = vtr(vp + d0 * 4096 + ks * 1024 + 512);
        vf[d0 * 4 + ks] = (bf16x8){lo[0], lo[1], lo[2], lo[3], hh[0], hh[1], hh[2], hh[3]};
    }
    __builtin_amdgcn_sched_barrier(0);
}
__device__ __forceinline__ void vload(bf16x8 (&vf)[8], lcp vp) { vload_half(vf, vp, 0); vload_half(vf, vp, 1); }
__device__ __forceinline__ void pv_mma(f32x16 (&o)[2], const bf16x8 (&vf)[8], const f32x16& p0, const f32x16& p1) {
    u32x4 pw[4];
    pw[0] = (u32x4){cvtpk(p0[0], p0[1]), cvtpk(p0[2], p0[3]), cvtpk(p0[4], p0[5]), cvtpk(p0[6], p0[7])};
    pw[1] = (u32x4){cvtpk(p0[8], p0[9]), cvtpk(p0[10], p0[11]), cvtpk(p0[12], p0[13]), cvtpk(p0[14], p0[15])};
    pw[2] = (u32x4){cvtpk(p1[0], p1[1]), cvtpk(p1[2], p1[3]), cvtpk(p1[4], p1[5]), cvtpk(p1[6], p1[7])};
    pw[3] = (u32x4){cvtpk(p1[8], p1[9]), cvtpk(p1[10], p1[11]), cvtpk(p1[12], p1[13]), cvtpk(p1[14], p1[15])};
#pragma unroll
    for (int d0 = 0; d0 < 2; ++d0)
#pragma unroll
        for (int ks = 0; ks < 4; ++ks) o[d0] = __builtin_amdgcn_mfma_f32_32x32x16_bf16(__builtin_bit_cast(bf16x8, pw[ks]), vf[d0 * 4 + ks], o[d0], 0, 0, 0);
}
__device__ __forceinline__ void pv(f32x16 (&o)[2], lcp vp, const f32x16& p0, const f32x16& p1) { bf16x8 vf[8]; vload(vf, vp); pv_mma(o, vf, p0, p1); }
template <int DQ, bool SLOT = false, bool SLOTV = SLOT> __device__ __forceinline__ void dma_tile(unsigned lds0, const bf16_t* Kg, int kpitch, const bf16_t* Vg, int vpitch, int key0, int slot, int wid, int lane) {
    const bf16_t* ksrc = Kg + (size_t)(key0 + lane) * kpitch + (SLOT ? 128 * (wid >> 2) + 8 * (wid & 3) : wid * 8);
    glds16(ksrc, (unsigned)__builtin_amdgcn_readfirstlane(lds0 + L_K + slot * KSLOT + wid * 1024));
    if (DQ == 96) { if (wid < 4) glds16(ksrc + 64, (unsigned)__builtin_amdgcn_readfirstlane(lds0 + L_K + slot * KSLOT + (8 + wid) * 1024)); }
    const bf16_t* vsrc = Vg + (size_t)(key0 + 16 * (wid & 3) + (lane >> 2)) * vpitch + (wid >> 2) * (SLOTV ? 128 : 32) + (lane & 3) * 8;
    glds16(vsrc, (unsigned)__builtin_amdgcn_readfirstlane(lds0 + L_V + slot * VSLOT + wid * 1024));
}

#define ATT_LBAR() asm volatile("s_waitcnt lgkmcnt(0)\n\ts_barrier" ::: "memory")
struct NoNext { static constexpr int count = 0; __device__ __forceinline__ void dma(unsigned, int, int, int, int) const {} };
template <int DQ, bool SLOT, bool SLOTV, class Pol> struct NextTiles {
    const bf16_t* Kg; int kpitch; const bf16_t* Vg; int vpitch; const Pol* pol; int count;
    __device__ __forceinline__ void dma(unsigned lds0, int j, int slot, int wid, int lane) const { dma_tile<DQ, SLOT, SLOTV>(lds0, Kg, kpitch, Vg, vpitch, pol->key0(j), slot, wid, lane); }
};
template <int DQ, bool SLOT = false, bool SLOTV = SLOT, class Pol, class Next>
__device__ __forceinline__ void flash_loop(LAS unsigned char* L, const bf16_t* Kg, int kpitch, const bf16_t* Vg, int vpitch, const bf16x8* qr, const Pol& pol, int s0, int npre, const Next& next,
                                           f32x16 (&o)[2], float& l_out, int wid, int lane) {
    const int r32 = lane & 31, hi = lane >> 5;
    const unsigned lds0 = (unsigned)(uintptr_t)L;
    LAS float* wsf = (LAS float*)(L + L_WSF) + wid * 128;
    lcp vp0 = L + L_V + ((lane >> 4) & 1) * 32 + (lane & 3) * 8 + (4 * hi + ((lane & 15) >> 2)) * 64;
    float mhat = 0.f, l = 0.f;
    f32x16 negm;
#pragma unroll
    for (int r = 0; r < 16; ++r) { o[0][r] = 0.f; o[1][r] = 0.f; negm[r] = 0.f; }
    const int n = pol.ntiles, ntot = n + next.count;
    int slot = s0, slot1 = (s0 + 1) % NSLOT, slot2 = (s0 + 2) % NSLOT;
    if (npre < 1) dma_tile<DQ, SLOT, SLOTV>(lds0, Kg, kpitch, Vg, vpitch, pol.key0(0), slot, wid, lane);
    if (npre < 2 && ntot > 1) { if (n > 1) dma_tile<DQ, SLOT, SLOTV>(lds0, Kg, kpitch, Vg, vpitch, pol.key0(1), slot1, wid, lane); else next.dma(lds0, 0, slot1, wid, lane); }
    for (int i = 0; i < n; ++i) {
        if (i + 1 < ntot) { if (DQ == 96 && wid < 4) asm volatile("s_waitcnt vmcnt(3) lgkmcnt(0)\n\ts_barrier" ::: "memory"); else asm volatile("s_waitcnt vmcnt(2) lgkmcnt(0)\n\ts_barrier" ::: "memory"); }
        else ATT_BAR();
        if (i + 2 < ntot) { if (i + 2 < n) dma_tile<DQ, SLOT, SLOTV>(lds0, Kg, kpitch, Vg, vpitch, pol.key0(i + 2), slot2, wid, lane); else next.dma(lds0, i + 2 - n, slot2, wid, lane); }
        if (pol.active(i)) {
            f32x16 p0, p1;
            qkt<DQ>(p0, p1, L + L_K + slot * KSLOT, qr, negm, r32, hi);
            bf16x8 vf[8]; vload_half(vf, vp0 + slot * VSLOT, 0);
            pol.fix(p0, p1, i);
            asm volatile("s_nop 15\n\ts_nop 7" : "+v"(p0), "+v"(p1));
            const float rm = swap_max(max32(p0, p1), lane);
            const bool first = (i == 0);
            if (first || __any(rm > THR)) {
                float dl = first ? rm : __builtin_fmaxf(rm, 0.f);
                if (dl == -INFINITY) dl = 0.f;
                mhat += dl;
#pragma unroll
                for (int r = 0; r < 16; ++r) { p0[r] -= dl; p1[r] -= dl; negm[r] = -mhat; }
                if (!first) {
                    const float f = __builtin_amdgcn_exp2f(-dl); l *= f;
                    if (hi == 0) wsf[r32] = f;
#pragma unroll
                    for (int r = 0; r < 16; ++r) { const float fr_ = wsf[crow(r, hi)]; o[0][r] *= fr_; o[1][r] *= fr_; }
                }
            }
#pragma unroll
            for (int r = 0; r < 16; ++r) { p0[r] = __builtin_amdgcn_exp2f(p0[r]); p1[r] = __builtin_amdgcn_exp2f(p1[r]); }
            vload_half(vf, vp0 + slot * VSLOT, 1);
            l += sum16(p0) + sum16(p1);
            pv_mma(o, vf, p0, p1);
        }
        slot = slot1; slot1 = slot2; slot2 = (slot2 == NSLOT - 1) ? 0 : slot2 + 1;
    }
    ATT_LBAR();
    l_out = swap_sum(l, lane);
}

__device__ __forceinline__ void acc_scaled(f32x16 (&oc)[2], const f32x16 (&o)[2], float rowscale, LAS float* wsf, int r32, int hi) {
    if (hi == 0) wsf[32 + r32] = rowscale;
#pragma unroll
    for (int r = 0; r < 16; ++r) { const float s = wsf[32 + crow(r, hi)]; oc[0][r] += s * o[0][r]; oc[1][r] += s * o[1][r]; }
}
__device__ __forceinline__ void park_store(const f32x16 (&oc)[2], LAS float* park, int lane) {
#pragma unroll
    for (int d0 = 0; d0 < 2; ++d0)
#pragma unroll
        for (int r = 0; r < 16; ++r) park[(d0 * 16 + r) * 64 + lane] = oc[d0][r];
}
template <bool FINAL> __device__ __forceinline__ void park_acc(f32x16 (&oc)[2], LAS float* park, const f32x16 (&o)[2], float rowscale, LAS float* wsf, int lane) {
    const int r32 = lane & 31, hi = lane >> 5;
    if (hi == 0) wsf[32 + r32] = rowscale;
#pragma unroll
    for (int r = 0; r < 16; ++r) { const float s = wsf[32 + crow(r, hi)];
#pragma unroll
        for (int d0 = 0; d0 < 2; ++d0) { const float v = park[(d0 * 16 + r) * 64 + lane] + s * o[d0][r]; if (FINAL) oc[d0][r] = v; else park[(d0 * 16 + r) * 64 + lane] = v; } }
}
__device__ __forceinline__ void store_tile(const f32x16 (&oc)[2], bf16_t* dst, int pitch, LAS unsigned char* L, int wid, int lane, float* ssq) {
    const int r32 = lane & 31, hi = lane >> 5;
    LAS bf16_t* stg = (LAS bf16_t*)(L + L_OST + wid * 8192);
#pragma unroll
    for (int r = 0; r < 16; ++r) { const int orow = crow(r, hi);
#pragma unroll
        for (int d0 = 0; d0 < 2; ++d0) stg[orow * 64 + d0 * 32 + r32] = (bf16_t)f2bf(oc[d0][r]); }
    asm volatile("s_waitcnt lgkmcnt(0)" ::: "memory");
#pragma unroll
    for (int i = 0; i < 4; ++i) { const int row = i * 8 + (lane >> 3), ch = lane & 7; const u32x4 v = *(const LAS u32x4*)(stg + row * 64 + ch * 8); st16_wt(dst + (size_t)(i * 8) * pitch, (unsigned)((lane >> 3) * pitch + ch * 8) * 2u, v);
        float ss = sq8(__builtin_bit_cast(bf16x8, v)); ss += lane_xor(ss, lane, 1); ss += lane_xor(ss, lane, 2); ss += lane_xor(ss, lane, 4);
        if (ch == 0) __hip_atomic_fetch_add(ssq + 2 * row, ss, __ATOMIC_RELAXED, __HIP_MEMORY_SCOPE_AGENT); }
    asm volatile("s_waitcnt lgkmcnt(0)" ::: "memory");
}

#define PIN16(v) asm volatile("" : "+v"(v[0]), "+v"(v[1]), "+v"(v[2]), "+v"(v[3]), "+v"(v[4]), "+v"(v[5]), "+v"(v[6]), "+v"(v[7]), "+v"(v[8]), "+v"(v[9]), "+v"(v[10]), "+v"(v[11]), "+v"(v[12]), "+v"(v[13]), "+v"(v[14]), "+v"(v[15]))
__device__ __forceinline__ int clamp127(int d) { return d < 0 ? 0 : (d < 127 ? d : 127); }
struct PolMla { int ntiles, qw0, r32, hi;
    __device__ __forceinline__ int key0(int i) const { return 64 * i; }
    __device__ __forceinline__ bool active(int i) const { return 64 * i <= qw0 + 31; }
    __device__ __forceinline__ int nact() const { const int a = (qw0 + 31) / 64 + 1; return a < ntiles ? a : ntiles; }
    __device__ __forceinline__ void fix(f32x16& p0, f32x16& p1, int i) const {
        if (64 * i + 63 > qw0) { const int q = qw0 + r32, kb = 64 * i + 4 * hi;
#pragma unroll
            for (int r = 0; r < 16; ++r) { const int kv = kb + (r & 3) + 8 * (r >> 2); if (kv > q) p0[r] = -INFINITY; if (kv + 32 > q) p1[r] = -INFINITY; } }
    }
};
struct PolSel { int ntiles, qc, q, hi; unsigned selm; const LAS float* tbh;
    __device__ __forceinline__ int key0(int i) const { return 64 * (qc - i); }
    __device__ __forceinline__ bool active(int i) const { return __any((selm >> (qc - i)) & 1u) != 0; }
    __device__ __forceinline__ int nact() const { return ntiles; }
    __device__ __forceinline__ void fix(f32x16& p0, f32x16& p1, int i) const {
        const bool bit = ((selm >> (qc - i)) & 1u) != 0u;
        if (i <= 2) { const int kb = 64 * (qc - i) + 4 * hi; float bv0[16], bv1[16];
#pragma unroll
            for (int r = 0; r < 16; ++r) { const int d0 = q - (kb + (r & 3) + 8 * (r >> 2)); bv0[r] = tbh[clamp127(d0)]; bv1[r] = tbh[clamp127(d0 - 32)]; }
            PIN16(bv0); PIN16(bv1);
#pragma unroll
            for (int r = 0; r < 16; ++r) { const int d0 = q - (kb + (r & 3) + 8 * (r >> 2)), d1 = d0 - 32;
                p0[r] = (d0 < 0) ? -INFINITY : p0[r] + bv0[r]; p1[r] = (d1 < 0) ? -INFINITY : p1[r] + bv1[r]; } }
        if (!bit) {
#pragma unroll
            for (int r = 0; r < 16; ++r) { p0[r] = -INFINITY; p1[r] = -INFINITY; } }
    }
};
struct PolWin { int ntiles, qc, q, hi; const LAS float* tbh;
    __device__ __forceinline__ int key0(int i) const { return 64 * (qc - i); }
    __device__ __forceinline__ bool active(int) const { return true; }
    __device__ __forceinline__ int nact() const { return ntiles; }
    __device__ __forceinline__ void fix(f32x16& p0, f32x16& p1, int i) const {
        if (i <= 2) { const int kb = 64 * (qc - i) + 4 * hi; float bv0[16], bv1[16];
#pragma unroll
            for (int r = 0; r < 16; ++r) { const int d0 = q - (kb + (r & 3) + 8 * (r >> 2)); bv0[r] = tbh[clamp127(d0)]; bv1[r] = tbh[clamp127(d0 - 32)]; }
            PIN16(bv0); PIN16(bv1);
#pragma unroll
            for (int r = 0; r < 16; ++r) { const int d0 = q - (kb + (r & 3) + 8 * (r >> 2)), d1 = d0 - 32;
                p0[r] = (d0 < 0) ? -INFINITY : p0[r] + bv0[r]; p1[r] = (d1 < 0) ? -INFINITY : p1[r] + bv1[r]; } }
        else if (i == 8) { const int kb = 64 * (qc - i) + 4 * hi;
#pragma unroll
            for (int r = 0; r < 16; ++r) { const int d0 = q - (kb + (r & 3) + 8 * (r >> 2)), d1 = d0 - 32; if (d0 >= 512) p0[r] = -INFINITY; if (d1 >= 512) p1[r] = -INFINITY; } }
    }
};

__device__ __forceinline__ void mla_unit(unsigned char* ws, LAS unsigned char* L, int b, int h, int qb, int wv, int s0, int npre, int nnext) {
    asm volatile("" : "+s"(ws));
    const int tid = opaque_tid(wv), lane = tid & 63, wid = __builtin_amdgcn_readfirstlane(tid >> 6);
    const int r32 = lane & 31, hi = lane >> 5;
    const size_t rowbase = (size_t)b * SEQ; const int qw0 = 256 * qb + 32 * wid;
    bf16x8 qr[6];
    { const bf16_t* Qw = (const bf16_t*)(ws + WS_QM) + (rowbase + qw0 + r32) * MQ + 96 * h + 8 * hi;
      bf16x8 raw[6]; float ss = 0.f;
#pragma unroll
      for (int d0 = 0; d0 < 6; ++d0) { raw[d0] = *(const bf16x8*)(Qw + 16 * d0); ss += sq8(raw[d0]); }
      ss += lane_xor(ss, lane, 32);
      const float rstd = QS_MLA / sqrtf(ss * (1.f / 96) + EPS);
      const float* qg = inptr(7) + 8 * hi;
#pragma unroll
      for (int d0 = 0; d0 < 4; ++d0) qr[d0] = __builtin_bit_cast(bf16x8, scale8(raw[d0], rstd, *(const f32x4*)(qg + 16 * d0), *(const f32x4*)(qg + 16 * d0 + 4)));
      float o1[8], o2[8]; const float posf = (float)(qw0 + r32);
#pragma unroll
      for (int j = 0; j < 8; ++j) { const int i = 8 * hi + j; const float inv = exp2f(-(float)i * (13.287712379549449f / 16.f)); float sn, cs; sincosf(posf * inv, &sn, &cs);
          const float n1 = bf2f((unsigned short)raw[4][j]) * rstd * qg[64 + j], n2 = bf2f((unsigned short)raw[5][j]) * rstd * qg[80 + j];
          o1[j] = n1 * cs - n2 * sn; o2[j] = n2 * cs + n1 * sn; }
      u32x4 w4, w5; w4.x = pk2(o1[0], o1[1]); w4.y = pk2(o1[2], o1[3]); w4.z = pk2(o1[4], o1[5]); w4.w = pk2(o1[6], o1[7]);
      w5.x = pk2(o2[0], o2[1]); w5.y = pk2(o2[2], o2[3]); w5.z = pk2(o2[4], o2[5]); w5.w = pk2(o2[6], o2[7]);
      qr[4] = __builtin_bit_cast(bf16x8, w4); qr[5] = __builtin_bit_cast(bf16x8, w5); }
    const bf16_t* Kg = (const bf16_t*)(ws + WS_KMLA) + rowbase * MQ + 96 * h;
    const bf16_t* Vg = (const bf16_t*)(ws + WS_KVM) + rowbase * MKV + slot_base(4 * (h >> 1) + 2 + (h & 1));
    PolMla pol{4 * qb + 4, qw0, r32, hi};
    f32x16 o[2]; float l;
    const NextTiles<96, false, true, PolMla> nxt{Kg, MQ, Vg, MKV, &pol, nnext};
    flash_loop<96, false, true>(L, Kg, MQ, Vg, MKV, qr, pol, s0, npre, nxt, o, l, wid, lane);
    LAS float* wsf = (LAS float*)(L + L_WSF) + wid * 128;
    f32x16 oc[2];
#pragma unroll
    for (int r = 0; r < 16; ++r) { oc[0][r] = 0.f; oc[1][r] = 0.f; }
    acc_scaled(oc, o, (l > 0.f) ? 1.f / l : 0.f, wsf, r32, hi);
    store_tile(oc, (bf16_t*)(ws + WS_MIX) + (rowbase + qw0) * DM + 64 * h, DM, L, wid, lane, (float*)(ws + WS_SSQM) + 2 * (rowbase + qw0));
}

__device__ __forceinline__ void nsa_unit(unsigned char* ws, LAS unsigned char* L, int b, int g, int qc, int wv) {
    asm volatile("" : "+s"(ws));
#define NSA_IDS() const int tid = opaque_tid(wv), lane = tid & 63, wid = __builtin_amdgcn_readfirstlane(tid >> 6); \
    const int r32 = lane & 31, hi = lane >> 5, rh = wid & 3, qh = wid >> 2, h = 4 * g + rh, qloc = 32 * qh + r32, q = q0 + qloc; \
    const unsigned lds0 = (unsigned)(uintptr_t)L; LAS float* wsf = (LAS float*)(L + L_WSF) + wid * 128; const LAS float* tbh = (const LAS float*)(L + L_TB) + h * 128; \
    LAS float* gate = (LAS float*)(L + L_GATE); (void)tid; (void)lane; (void)r32; (void)hi; (void)rh; (void)qh; (void)h; (void)qloc; (void)q; (void)lds0; (void)wsf; (void)tbh; (void)gate
    const size_t rowbase = (size_t)b * SEQ; const int q0 = 64 * qc;
    const bf16_t* pr = (const bf16_t*)(ws + WS_PROJ);
    bf16x8 qr[4];
    {
    NSA_IDS();
    { const bf16_t* Kc = (const bf16_t*)(ws + WS_KCMP) + ((size_t)b * 256 + g) * 64; const bf16_t* Vc = (const bf16_t*)(ws + WS_VCMP) + ((size_t)b * 256 + g) * 64;
      dma_tile<64>(lds0, Kc, 128, Vc, 128, 0, 0, wid, lane);
      dma_tile<64>(lds0, Kc, 128, Vc, 128, 64, 1, wid, lane);
      dma_tile<64, true>(lds0, pr + rowbase * DINP + slot_base(S_KSEL + g), DINP, pr + rowbase * DINP + slot_base(S_VSEL + g), DINP, 64 * qc, 2, wid, lane); }
    for (int i = tid; i < 768; i += 512) { const int br = i >> 8, r = (i >> 6) & 3, qq = i & 63;
        const float x = bf2f(pr[(rowbase + q0 + qq) * DINP + P_GATE + 8 * br + 4 * g + r]); gate[i] = 1.f / (1.f + __expf(-x)); }
    { const bf16_t* Qw = pr + (rowbase + q) * DINP + slot_base(S_Q + h) + 8 * hi;
#pragma unroll
      for (int d0 = 0; d0 < 4; ++d0) qr[d0] = *(const bf16x8*)(Qw + 128 * (d0 >> 1) + 16 * (d0 & 1)); }
    }
    f32x16 oc[2];
    {
        NSA_IDS();
        ATT_BAR();
        lcp vp0 = L + L_V + ((lane >> 4) & 1) * 32 + (lane & 3) * 8 + (4 * hi + ((lane & 15) >> 2)) * 64;
        LAS float* imp = (LAS float*)(L + L_IMP) + (rh * 64 + qloc) * IMPS;
        f32x16 a0, a1, b0, b1;
        { f32x16 zero;
#pragma unroll
          for (int r = 0; r < 16; ++r) zero[r] = 0.f;
          qkt<64>(a0, a1, L + L_K, qr, zero, r32, hi); qkt<64>(b0, b1, L + L_K + KSLOT, qr, zero, r32, hi); }
#define CMP_FIX(P, coff, extra) do { float bv[16]; \
            _Pragma("unroll") for (int r = 0; r < 16; ++r) bv[r] = tbh[clamp127(q - 16 * (crow(r, hi) + (coff)) - 31)]; \
            PIN16(bv); \
            _Pragma("unroll") for (int r = 0; r < 16; ++r) { const int c = crow(r, hi) + (coff); const int d = q - 16 * c - 31; P[r] = (d < 0 || (extra && c >= NCMP)) ? -INFINITY : P[r] + bv[r]; } } while (0)
        CMP_FIX(a0, 0, false); CMP_FIX(a1, 32, false); CMP_FIX(b0, 64, false); CMP_FIX(b1, 96, true);
#undef CMP_FIX
        float m = swap_max(__builtin_fmaxf(__builtin_fmaxf(max16(a0), max16(a1)), __builtin_fmaxf(max16(b0), max16(b1))), lane);
        if (m == -INFINITY) m = 0.f;
#pragma unroll
        for (int r = 0; r < 16; ++r) { a0[r] = __builtin_amdgcn_exp2f(a0[r] - m); a1[r] = __builtin_amdgcn_exp2f(a1[r] - m); b0[r] = __builtin_amdgcn_exp2f(b0[r] - m); b1[r] = __builtin_amdgcn_exp2f(b1[r] - m); }
        const float lsum = swap_sum((sum16(a0) + sum16(a1)) + (sum16(b0) + sum16(b1)), lane);
        const float inv = (lsum > 0.f) ? 1.f / lsum : 0.f;
        float prev_last = 0.f;
#define CMP_IMP(T, P0, P1) do { float own[8], car[8]; \
            _Pragma("unroll") for (int a = 0; a < 4; ++a) { \
                own[a]     = P0[4 * a] + P0[4 * a + 1] + P0[4 * a + 2] + 0.5f * P0[4 * a + 3]; car[a]     = 0.5f * P0[4 * a + 3]; \
                own[4 + a] = P1[4 * a] + P1[4 * a + 1] + P1[4 * a + 2] + 0.5f * P1[4 * a + 3]; car[4 + a] = 0.5f * P1[4 * a + 3]; } \
            _Pragma("unroll") for (int k = 0; k < 8; ++k) car[k] = lane_xor(car[k], lane, 32); \
            _Pragma("unroll") for (int k = 0; k < 8; ++k) { const float add = hi ? car[k] : (k >= 1 ? car[k - 1] : prev_last); imp[16 * (T) + 2 * k + hi] = own[k] + add; } \
            prev_last = car[7]; } while (0)
        CMP_IMP(0, a0, a1); CMP_IMP(1, b0, b1);
#undef CMP_IMP
        if (hi == 0) ((LAS float*)(L + L_INVL))[rh * 64 + qloc] = inv;
        f32x16 o[2];
#pragma unroll
        for (int r = 0; r < 16; ++r) { o[0][r] = 0.f; o[1][r] = 0.f; }
        pv(o, vp0, a0, a1); pv(o, vp0 + VSLOT, b0, b1);
        ATT_BAR();
        if (qc >= 1) dma_tile<64, true>(lds0, pr + rowbase * DINP + slot_base(S_KSEL + g), DINP, pr + rowbase * DINP + slot_base(S_VSEL + g), DINP, 64 * (qc - 1), 0, wid, lane);
#pragma unroll
        for (int r = 0; r < 16; ++r) { oc[0][r] = 0.f; oc[1][r] = 0.f; }
        acc_scaled(oc, o, gate[(0 * 4 + rh) * 64 + qloc] * inv, wsf, r32, hi);
    }
    if (qc <= 15) {
        const int tid = opaque_tid(wv);
        if (tid < 64) ((LAS unsigned*)(L + L_SELM))[tid] = (qc == 31) ? 0xffffffffu : ((2u << qc) - 1u);
        ATT_LBAR();
    } else {
        const int tid = opaque_tid(wv);
        const LAS float* imp = (const LAS float*)(L + L_IMP); LAS float* sc = (LAS float*)(L + L_SC);
        const int qq = tid >> 3, jj = tid & 7;
        const LAS float* il = (const LAS float*)(L + L_INVL);
        const float i0 = il[qq], i1 = il[64 + qq], i2 = il[128 + qq], i3 = il[192 + qq];
#pragma unroll
        for (int k = 0; k < 4; ++k) { const int j = jj + 8 * k;
            const float tot = (imp[(0 * 64 + qq) * IMPS + j] * i0 + imp[(1 * 64 + qq) * IMPS + j] * i1) + (imp[(2 * 64 + qq) * IMPS + j] * i2 + imp[(3 * 64 + qq) * IMPS + j] * i3);
            float s; if (j > qc) s = -INFINITY; else if (j == 0 || j == qc || j == qc - 1) s = 1e4f; else s = tot; sc[qq * IMPS + j] = s; }
        ATT_LBAR();
        float v[32];
#pragma unroll
        for (int k = 0; k < 32; ++k) v[k] = sc[qq * IMPS + k];
        unsigned bits = 0u;
#pragma unroll
        for (int k = 0; k < 4; ++k) { const int j = jj + 8 * k; const float me = sc[qq * IMPS + j]; int rank = 0;
#pragma unroll
            for (int i = 0; i < 32; ++i) { const float si = v[i]; rank += (si > me || (si == me && i < j)) ? 1 : 0; }
            if (rank < 16) bits |= 1u << j; }
        { const int lane = tid & 63; bits |= lane_xor_u(bits, lane, 1); bits |= lane_xor_u(bits, lane, 2); bits |= lane_xor_u(bits, lane, 4); }
        if (jj == 0) ((LAS unsigned*)(L + L_SELM))[qq] = bits;
        ATT_LBAR();
    }
    { NSA_IDS(); park_store(oc, (LAS float*)(L + L_OST) + wid * 2048, lane); }
    {
        NSA_IDS();
        const unsigned selm = ((const LAS unsigned*)(L + L_SELM))[qloc];
        const bf16_t* Kg = pr + rowbase * DINP + slot_base(S_KSEL + g);
        const bf16_t* Vg = pr + rowbase * DINP + slot_base(S_VSEL + g);
        PolSel pol{qc + 1, qc, q, hi, selm, tbh};
        const PolWin polw{(qc < 8 ? qc : 8) + 1, qc, q, hi, tbh};
        const NextTiles<64, true, true, PolWin> nxt{pr + rowbase * DINP + slot_base(S_KWIN + g), DINP, pr + rowbase * DINP + slot_base(S_VWIN + g), DINP, &polw, polw.ntiles < 2 ? polw.ntiles : 2};
        f32x16 o[2]; float l;
        flash_loop<64, true>(L, Kg, DINP, Vg, DINP, qr, pol, 2, (qc + 1 < 2) ? qc + 1 : 2, nxt, o, l, wid, lane);
        { f32x16 dummy[2]; park_acc<false>(dummy, (LAS float*)(L + L_OST) + wid * 2048, o, (l > 0.f) ? gate[(1 * 4 + rh) * 64 + qloc] / l : 0.f, wsf, lane); }
    }
    {
        NSA_IDS();
        const bf16_t* Kg = pr + rowbase * DINP + slot_base(S_KWIN + g);
        const bf16_t* Vg = pr + rowbase * DINP + slot_base(S_VWIN + g);
        PolWin pol{(qc < 8 ? qc : 8) + 1, qc, q, hi, tbh};
        f32x16 o[2]; float l;
        flash_loop<64, true>(L, Kg, DINP, Vg, DINP, qr, pol, (2 + qc + 1) % NSLOT, pol.ntiles < 2 ? pol.ntiles : 2, NoNext{}, o, l, wid, lane);
        f32x16 fin[2]; park_acc<true>(fin, (LAS float*)(L + L_OST) + wid * 2048, o, (l > 0.f) ? gate[(2 * 4 + rh) * 64 + qloc] / l : 0.f, wsf, lane);
        store_tile(fin, (bf16_t*)(ws + WS_MIX) + (rowbase + q0 + 32 * qh) * DM + 512 + 64 * h, DM, L, wid, lane, (float*)(ws + WS_SSQM) + 2 * (rowbase + q0 + 32 * qh) + 1);
    }
    ATT_BAR();
}
#undef ATT_BAR
#undef ATT_LBAR
#undef NSA_IDS
}

#define XB_TMO      128
#define XB_XCNT(j)  (256  + 64 * (j))
#define XB_XSUB(j)  (1280 + 64 * (j))
#define XB_XGEN(j)  (2304 + 64 * (j))
#define XB_TOP      3328
#define XB_TOPGEN   3392
#define XCD_BAR_WORDS 3456
#define XB_SPIN_CAP (1u << 18)

__device__ __forceinline__ unsigned xb_ld(unsigned* p)              { return __hip_atomic_load(p, __ATOMIC_RELAXED, __HIP_MEMORY_SCOPE_AGENT); }
__device__ __forceinline__ unsigned xb_add(unsigned* p, unsigned v) { return __hip_atomic_fetch_add(p, v, __ATOMIC_RELAXED, __HIP_MEMORY_SCOPE_AGENT); }
__device__ __forceinline__ unsigned xb_xcc_id() { return (unsigned)__builtin_amdgcn_s_getreg((3 << 11) | 20) & 0xFu; }
#define XB_SPIN(cond, bar) do { unsigned _sp = 0; while (cond) { __builtin_amdgcn_s_sleep(1); \
    if ((++_sp & 255u) == 0u) { if (xb_ld(&(bar)[XB_TMO])) break; if (_sp > XB_SPIN_CAP) { atomicAdd(&(bar)[XB_TMO], 1u); break; } } } } while (0)

struct XcdBarrier {
    unsigned* bar; unsigned x;
    volatile LAS unsigned* st;
};

__device__ __forceinline__ XcdBarrier xcd_barrier_post(unsigned* bar, volatile LAS unsigned* st) {
    XcdBarrier b; b.bar = bar; b.x = xb_xcc_id(); b.st = st;
    if (threadIdx.x == 0) (void)xb_add(&bar[XB_XCNT(b.x)], 1u);
    return b;
}
__device__ __forceinline__ void xcd_barrier_complete(unsigned* bar, unsigned x, unsigned& nloc, unsigned& nx) {
    const unsigned G = gridDim.x * gridDim.y * gridDim.z;
    unsigned sum, cnt, mine, sp = 0u;
    for (;;) {
        sum = 0u; cnt = 0u; mine = 0u;
#pragma unroll
        for (unsigned j = 0; j < 16; ++j) { const unsigned c = xb_ld(&bar[XB_XCNT(j)]); sum += c; cnt += (c > 0u) ? 1u : 0u; mine = (j == x) ? c : mine; }
        if (sum == G) break;
        __builtin_amdgcn_s_sleep(1);
        if ((++sp & 255u) == 0u) { if (xb_ld(&bar[XB_TMO])) break; if (sp > XB_SPIN_CAP) { atomicAdd(&bar[XB_TMO], 1u); break; } }
    }
    nloc = mine > 0u ? mine : 1u; nx = cnt > 0u ? cnt : 1u;
}

__device__ __forceinline__ void xcd_barrier(const XcdBarrier& b, const unsigned char* pf = nullptr, int nchunk = 0, int wv = 0) {
    asm volatile("s_waitcnt vmcnt(0)" ::: "memory");
    __syncthreads();
    if (pf != nullptr && wv >= 1 && wv <= 4) {
        const int t = opaque_tid(wv) - 64;
        const pg8::u32x4* src = (const pg8::u32x4*)pf + (size_t)(blockIdx.x & 255) * nchunk;
        pg8::u32x4 v[9];
#pragma unroll
        for (int i = 0; i < 9; ++i) { int c = i * 256 + t; c = c < nchunk ? c : nchunk - 1; v[i] = src[c]; }
        asm volatile("" :: "v"(v[0]), "v"(v[1]), "v"(v[2]), "v"(v[3]), "v"(v[4]), "v"(v[5]), "v"(v[6]), "v"(v[7]), "v"(v[8]));
    }
    if (threadIdx.x == 0) {
        unsigned* bar = b.bar;
        __builtin_amdgcn_s_waitcnt(0);
        unsigned nloc = b.st[0], nx = b.st[1];
        if (nloc == 0u) { xcd_barrier_complete(bar, b.x, nloc, nx); b.st[0] = nloc; b.st[1] = nx; }
        const unsigned old = xb_add(&bar[XB_XSUB(b.x)], 1u);
        const unsigned gen = old / nloc;
        if (old + 1u == (gen + 1u) * nloc) {
            __builtin_amdgcn_fence(__ATOMIC_RELEASE, "agent");
            asm volatile("s_waitcnt vmcnt(0)" ::: "memory");
            const unsigned og = xb_add(&bar[XB_TOP], 1u);
            const unsigned tg = og / nx;
            if (og + 1u == (tg + 1u) * nx) xb_add(&bar[XB_TOPGEN], 1u);
            else XB_SPIN(xb_ld(&bar[XB_TOPGEN]) == tg, bar);
            __builtin_amdgcn_fence(__ATOMIC_ACQUIRE, "agent");
            xb_add(&bar[XB_XGEN(b.x)], 1u);
            asm volatile("s_waitcnt vmcnt(0)" ::: "memory");
        } else {
            XB_SPIN(xb_ld(&bar[XB_XGEN(b.x)]) == gen, bar);
            __builtin_amdgcn_fence(__ATOMIC_ACQUIRE, "agent");
            asm volatile("s_waitcnt vmcnt(0)" ::: "memory");
        }
    }
    __syncthreads();
}

template <bool RELEASE = false>
__device__ __forceinline__ void group_sync(unsigned* ctl, unsigned* a0, unsigned* a1, unsigned* a2, unsigned* a3, unsigned* w0, unsigned t0, unsigned* w1, unsigned t1, const unsigned char* pf = nullptr, int nchunk = 0, int wv = 0) {
    asm volatile("s_waitcnt vmcnt(0)" ::: "memory");
    __syncthreads();
    if (pf != nullptr && wv >= 1 && wv <= 4) {
        const int t = opaque_tid(wv) - 64;
        const pg8::u32x4* src = (const pg8::u32x4*)pf + (size_t)(blockIdx.x & 255) * nchunk;
        pg8::u32x4 v[9];
#pragma unroll
        for (int i = 0; i < 9; ++i) { int c = i * 256 + t; c = c < nchunk ? c : nchunk - 1; v[i] = src[c]; }
        asm volatile("" :: "v"(v[0]), "v"(v[1]), "v"(v[2]), "v"(v[3]), "v"(v[4]), "v"(v[5]), "v"(v[6]), "v"(v[7]), "v"(v[8]));
    }
    if (threadIdx.x == 0) {
        if (RELEASE) { __builtin_amdgcn_fence(__ATOMIC_RELEASE, "agent"); asm volatile("s_waitcnt vmcnt(0)" ::: "memory"); }
        (void)xb_add(a0, 1u); if (a1) (void)xb_add(a1, 1u); if (a2) (void)xb_add(a2, 1u); if (a3) (void)xb_add(a3, 1u);
        XB_SPIN(xb_ld(w0) < t0, ctl);
        if (w1 != nullptr) XB_SPIN(xb_ld(w1) < t1, ctl);
        __builtin_amdgcn_fence(__ATOMIC_ACQUIRE, "agent");
        asm volatile("s_waitcnt vmcnt(0)" ::: "memory");
    }
    __syncthreads();
}

__global__ void __launch_bounds__(512, 2) mega(Params p) {
    extern __shared__ __attribute__((aligned(16))) unsigned char lds[];
    const int G = gridDim.x, bid = blockIdx.x, NGW = G * NW;
    int wv = __builtin_amdgcn_readfirstlane((int)(threadIdx.x >> 6)); asm volatile("" : "+s"(wv));
#define PHASE_IDS() const int tid = opaque_tid(wv), lane = tid & 63, wave = __builtin_amdgcn_readfirstlane(tid >> 6), gw = bid * NW + wave; (void)tid; (void)lane; (void)gw
    unsigned char* ws = (unsigned char*)inptr(22);
    LAS unsigned char* L = (LAS unsigned char*)lds;
    volatile LAS unsigned* bst = (volatile LAS unsigned*)(L + LDS_BST);
    if (threadIdx.x < 4) bst[threadIdx.x] = 0u;
    __syncthreads();
    (void)xcd_barrier_post((unsigned*)(ws + WS_CTL), bst);
#define bar (XcdBarrier{(unsigned*)((unsigned char*)inptr(22) + WS_CTL), xb_xcc_id(), (volatile LAS unsigned*)((LAS unsigned char*)lds + LDS_BST)})

    {
        PHASE_IDS();
        LAS float* scr = (LAS float*)(L + wave * 8704);
        constexpr int I0 = (1024 / 64) * (DINP / 32), I1 = (QR / 64) * (MQ / 32), I2 = (KVR / 64) * (MKV / 32), I3 = 16 * 32, I4 = 16 * (FF / 32), I5 = (FF / 64) * 32;
        constexpr int I6 = (2048 / 64) * (128 / 32), I7 = (128 / 64) * (64 / 32);
        constexpr int NIT = I0 + I1 + I2 + I3 + I4 + I5 + 2 * I6 + 2 * I7;
        for (int it = gw; it < NIT; it += NGW) {
            int r = it;
            if (r < I0) { p0_transpose_item(inptr(2), 1024, DIN, DINP, (bf16_t*)(ws + WS_WIN), scr, r, lane, inptr(1), 0, 1); continue; } r -= I0;
            if (r < I1) { p0_transpose_item(inptr(5), QR, MQ, MQ, (bf16_t*)(ws + WS_WUQ), scr, r, lane, inptr(3)); continue; } r -= I1;
            if (r < I2) { p0_transpose_item(inptr(6), KVR, MKV, MKV, (bf16_t*)(ws + WS_WUKV), scr, r, lane, inptr(4), 0, 2); continue; } r -= I2;
            if (r < I3) { const int k0_ = 64 * (r / 32); p0_transpose_item(inptr(17), 1024, 1024, 1024, (bf16_t*)(ws + WS_WO), scr, r, lane, k0_ < 512 ? inptr(15) : inptr(16) - 512); continue; } r -= I3;
            if (r < I4) { p0_transpose_item(inptr(19), 1024, FF, FF, (bf16_t*)(ws + WS_WUP), scr, r, lane, inptr(18)); continue; } r -= I4;
            if (r < I5) { p0_transpose_item(inptr(20), FF, 1024, 1024, (bf16_t*)(ws + WS_WDN), scr, r, lane, nullptr, LDH); continue; } r -= I5;
            if (r < 2 * I6) { const int kv = r / I6; p0_transpose_item(inptr(12) + (size_t)kv * 2048 * 128, 2048, 128, 128, (bf16_t*)(ws + WS_W1T) + (size_t)kv * 128 * 2048, scr, r % I6, lane); continue; } r -= 2 * I6;
            { const int kv = r / I7; p0_transpose_item(inptr(13) + kv * 128 * 64, 128, 64, 64, (bf16_t*)(ws + WS_W2T) + kv * 64 * 128, scr, r % I7, lane); }
        }
        for (int m = gw; m < M; m += 4 * NGW) rows_to_bf16_rstd<4>(inptr(0), (bf16_t*)(ws + WS_XB), (float*)(ws + WS_RS1), m, NGW, lane);
        for (int e = bid * 512 + tid; e < 2048 * 16; e += G * 512) { const int pos = e >> 4, i = e & 15; const float inv = exp2f(-(float)i * (13.287712379549449f / 16.f)); float sn, cs; sincosf((float)pos * inv, &sn, &cs);
            ((float*)(ws + WS_ROPE))[pos * 32 + i] = cs; ((float*)(ws + WS_ROPE))[pos * 32 + 16 + i] = sn; }
        for (int m = bid * 512 + tid; m < M; m += G * 512) { ((float*)(ws + WS_SSQ2))[m] = 0.f; ((float*)(ws + WS_RSQ))[m] = 0.f; ((float*)(ws + WS_RSKV))[m] = 0.f; ((float*)(ws + WS_SSQKR))[m] = 0.f; ((float*)(ws + WS_SSQM))[2 * m] = 0.f; ((float*)(ws + WS_SSQM))[2 * m + 1] = 0.f; }
    }
    xcd_barrier(bar);
    { pg8::Gemm g{(const bf16_t*)(ws + WS_XB), (const bf16_t*)(ws + WS_WIN), M, DINP, DM, DM, DM}; pg8::StaticOrder S; S.init(M, DINP, G, bid);
      PEpiProj E{(bf16_t*)(ws + WS_PROJ), DINP, (const float*)(ws + WS_RS1), (float*)(ws + WS_RSQ), (float*)(ws + WS_RSKV), (float*)(ws + WS_SSQKR), inptr(9), inptr(10), (const float*)(ws + WS_ROPE), inptr(8)}; pg8::gemm_phase<PEpiProj, pg8::StaticOrder, true, true>(L, g, S, E, wv); }
#define GCTL ((unsigned*)((unsigned char*)inptr(22) + WS_CTL))
#define GCNT(sp, pm) (GCTL + 4096 + ((sp) * 64 + (pm)) * 16)
    if (G == 256) { const int x_ = bid & 7, jj_ = (bid >> 3) & 7, k_ = bid >> 6;
        unsigned* c_ = GCNT(0, 8 * x_ + jj_); group_sync(GCTL, c_, nullptr, nullptr, nullptr, c_, 4u, ((k_ & 1) && jj_ < 7) ? GCNT(0, 8 * x_ + jj_ + 1) : nullptr, 4u); }
    else xcd_barrier(bar);
    { PHASE_IDS();
      __syncthreads();
      if (G == 256) { const int x_ = bid & 7, jj_ = (bid >> 3) & 7, k_ = bid >> 6; compress_block(ws, L, (2 * jj_ + (k_ & 1)) | (x_ << 4) | ((k_ >> 1) << 7), wv); }
      else for (int t = bid; t < 256; t += G) compress_block(ws, L, t, wv); }
    { pg8::Gemm g{(const bf16_t*)(ws + WS_PROJ) + P_HKV, (const bf16_t*)(ws + WS_WUKV), M, MKV, KVR, DINP, KVR}; pg8::StaticOrder S; S.init(M, MKV, G, bid);
      PEpiKV E{(bf16_t*)(ws + WS_KVM), (bf16_t*)(ws + WS_KMLA), (const bf16_t*)(ws + WS_PROJ), (const float*)(ws + WS_RSKV), (const float*)(ws + WS_SSQKR), (const float*)(ws + WS_ROPE), inptr(8)}; pg8::gemm_phase<PEpiKV, pg8::StaticOrder, true, true>(L, g, S, E, wv); }
    asm volatile("" : "+s"(wv));
    { pg8::Gemm g{(const bf16_t*)(ws + WS_PROJ) + P_HQ, (const bf16_t*)(ws + WS_WUQ), M, MQ, QR, DINP, QR}; pg8::StaticOrder S; S.init(M, MQ, G, bid);
      PEpiBf16<0> E{(bf16_t*)(ws + WS_QM), MQ, (const float*)(ws + WS_RSQ), 1.f / QR}; pg8::gemm_phase<PEpiBf16<0>, pg8::StaticOrder, true, false>(L, g, S, E, wv); }
    if (G == 256) { unsigned* c_ = GCNT(3, bid & 7); group_sync<true>(GCTL, c_, nullptr, nullptr, nullptr, c_, 32u, nullptr, 0u); }
    else xcd_barrier(bar);
    {
        PHASE_IDS();
        LAS float* tb = (LAS float*)L;
        for (int i = tid; i < 8 * 128; i += 512) { const int h = i >> 7, n = i & 127; tb[i] = (inptr(14)[t5_bucket(n) * 8 + h] - inptr(14)[31 * 8 + h]) * LOG2E; }
        __syncthreads();
        const int vcu = (G % 8 == 0) ? (bid % 8) * (G / 8) + bid / 8 : bid;
        for (int pr_ = vcu; pr_ < 256; pr_ += G) {
            { const int bg = pr_ >> 4, s_ = pr_ & 15;
#pragma unroll 1
              for (int u_ = 0; u_ < 2; ++u_) att::nsa_unit(ws, L, bg >> 1, bg & 1, (u_ & 1) ? s_ : 31 - s_, wv);
            }
            { const int bh = pr_ >> 2, s_ = pr_ & 3;
#pragma unroll 1
              for (int u_ = 0; u_ < 2; ++u_) att::mla_unit(ws, L, bh >> 3, bh & 7, u_ ? s_ : 7 - s_, wv, u_ ? (4 * (7 - s_) + 4) % att::NSLOT : 0, u_ ? 2 : 0, u_ ? 0 : 2);
            }
        }
    }
    if (G == 256) { const int x_ = bid & 7, j_ = bid >> 3, sn_ = j_ & 15, sm_ = j_ & 3;
        group_sync(GCTL, GCNT(4, 8 * x_ + ((31 - sn_) >> 2)), GCNT(4, 8 * x_ + (sn_ >> 2)), GCNT(4, 8 * x_ + 7 - sm_), GCNT(4, 8 * x_ + sm_), GCNT(4, 8 * x_ + (j_ & 7)), 16u, nullptr, 0u, ws + WS_WO, (int)((size_t)DM * DM * 2 / 16 / 256), wv); }
    else xcd_barrier(bar, ws + WS_WO, (int)((size_t)DM * DM * 2 / 16 / 256), wv);
    { pg8::Gemm g{(const bf16_t*)(ws + WS_MIX), (const bf16_t*)(ws + WS_WO), M, DM, DM, DM, DM}; pg8::StaticOrder S; S.init(M, DM, G, bid);
      PEpiWo E{(const bf16_t*)(ws + WS_XB), (bf16_t*)(ws + WS_H2), (float*)(ws + WS_SSQ2), (const float*)(ws + WS_SSQM), DM}; pg8::gemm_phase<PEpiWo, pg8::StaticOrder, true, true>(L, g, S, E, wv); }
    if (G == 256) { unsigned* c_ = GCNT(1, 8 * (bid & 7) + ((bid >> 3) & 7)); group_sync(GCTL, c_, nullptr, nullptr, nullptr, c_, 4u, nullptr, 0u, ws + WS_WUP, (int)((size_t)FF * DM * 2 / 16 / 256), wv); }
    else xcd_barrier(bar, ws + WS_WUP, (int)((size_t)FF * DM * 2 / 16 / 256), wv);
    { pg8::Gemm g{(const bf16_t*)(ws + WS_H2), (const bf16_t*)(ws + WS_WUP), M, FF, DM, DM, DM}; pg8::StaticOrder S; S.init(M, FF, G, bid);
      PEpiBf16<2> E{(bf16_t*)(ws + WS_HID), LDH, (const float*)(ws + WS_SSQ2), 1.f / 1024}; pg8::gemm_phase<PEpiBf16<2>, pg8::StaticOrder, true, true>(L, g, S, E, wv); }
    if (G == 256) { unsigned* c_ = GCNT(2, 8 * (bid & 7) + ((bid >> 3) & 7)); group_sync(GCTL, c_, nullptr, nullptr, nullptr, c_, 4u, nullptr, 0u, ws + WS_WDN, (int)((size_t)DM * LDH * 2 / 16 / 256), wv); }
    else xcd_barrier(bar, ws + WS_WDN, (int)((size_t)DM * LDH * 2 / 16 / 256), wv);
    { pg8::Gemm g{(const bf16_t*)(ws + WS_HID), (const bf16_t*)(ws + WS_WDN), M, DM, FF, LDH, LDH}; pg8::StaticOrder S; S.init(M, DM, G, bid);
      PEpiDown E{(const bf16_t*)(ws + WS_H2), ((float*)inptr(21)), DM}; pg8::gemm_phase<PEpiDown, pg8::StaticOrder, true, true>(L, g, S, E, wv); }
#undef bar
}

extern "C" void kernel_launch(void* const* d_in, const int* in_sizes, int n_in, void* d_out, int out_size,
                              void* d_ws, size_t ws_size, hipStream_t stream) {
    static int grid_blocks = 0;
    if (!grid_blocks) {
        int dev = 0, cus = 0, per_cu = 0;
        (void)hipGetDevice(&dev);
        (void)hipDeviceGetAttribute(&cus, hipDeviceAttributeMultiprocessorCount, dev);
        (void)hipFuncSetAttribute((const void*)mega, hipFuncAttributeMaxDynamicSharedMemorySize, LDS_BYTES);
        (void)hipOccupancyMaxActiveBlocksPerMultiprocessor(&per_cu, (const void*)mega, 512, LDS_BYTES);
        if (per_cu != 1) fprintf(stderr, "note: occupancy query reports %d blocks/CU; launching 1 per CU\n", per_cu);
        grid_blocks = cus;
        if (n_in != 21 || out_size != M * DM || ws_size < 256 * MiB) fprintf(stderr, "unexpected shapes: n_in %d out %d ws %zu\n", n_in, out_size, ws_size);
    }
    Params p{};
    for (int i = 0; i < 21; ++i) p.in[i] = (const float*)d_in[i];
    p.out = (float*)d_out; p.ws = (unsigned char*)d_ws;
    if (hipMemsetAsync((char*)d_ws + WS_CTL, 0, CTL_ZERO_BYTES, stream) != hipSuccess) { fprintf(stderr, "memset of the barrier words failed\n"); return; }
    hipLaunchKernelGGL(mega, dim3(grid_blocks), dim3(512), LDS_BYTES, stream, p);
    hipError_t e = hipPeekAtLastError();
    if (e != hipSuccess) fprintf(stderr, "launch failed: %s (grid %d)\n", hipGetErrorString(e), grid_blocks);
}
```

```cpp
#include <hip/hip_runtime.h>
#include <cstdio>
#include <cstdint>

#define LAS __attribute__((address_space(3)))
typedef unsigned short bf16_t;
typedef short bf16x8 __attribute__((ext_vector_type(8)));
typedef float f32x4 __attribute__((ext_vector_type(4)));
typedef unsigned u32x4 __attribute__((ext_vector_type(4)));
typedef unsigned u32x2 __attribute__((ext_vector_type(2)));

constexpr int BATCH = 8, SEQ = 2048, DM = 1024, M = BATCH * SEQ;
constexpr int DIN = 1976, DINP = 2048;
constexpr int C_HQ = 0, C_HKV = 384, C_HKR = 640, C_QB = 672, C_KVB = 1184, C_GATE = 1952;
constexpr int C_KCMP = C_KVB, C_VCMP = C_KVB + 128, C_KSEL = C_KVB + 256, C_VSEL = C_KVB + 384, C_KWIN = C_KVB + 512, C_VWIN = C_KVB + 640;
constexpr int P_HQ = 1280, P_HKV = 1664, P_HKR = 1920, P_GATE = 1952;
__host__ __device__ constexpr int slot_base(int s) { return 256 * (s >> 2) + 32 * (s & 3); }
constexpr int S_Q = 0, S_KCMP = 8, S_VCMP = 10, S_KSEL = 12, S_VSEL = 14, S_KWIN = 16, S_VWIN = 18;
constexpr int QR = 384, KVR = 256, MQ = 768, MKV = 1024, FF = 4096;
constexpr int LDH = FF + 64;
constexpr int NCMP = 127;
constexpr float EPS = 1e-6f;
constexpr float LOG2E = 1.4426950408889634f;
constexpr float QS_MLA = 0.10206207261596577f * LOG2E;
constexpr float QS_NSA = 0.125f * LOG2E;

constexpr size_t MiB = 1u << 20;
constexpr size_t WS_CTL = 0, CTL_ZERO_BYTES = 65536;
constexpr size_t WS_WIN = 1 * MiB, WS_WUQ = 5 * MiB, WS_WUKV = 6 * MiB, WS_WO = 7 * MiB, WS_WUP = 9 * MiB, WS_WDN = 17 * MiB;
constexpr size_t WS_KCMP = 26 * MiB, WS_VCMP = 26 * MiB + 512 * 1024;
constexpr size_t WS_W1T = 30 * MiB;
constexpr size_t WS_W2T = 27 * MiB;
constexpr size_t WS_RSQ = 28 * MiB, WS_RSKV = 28 * MiB + 65536, WS_SSQ2 = 28 * MiB + 131072, WS_SSQM = 28 * MiB + 262144, WS_RS1 = 28 * MiB + 262144 + 131072;
constexpr size_t WS_SSQKR = 28 * MiB + 524288;
constexpr size_t WS_ROPE = 29 * MiB + 65536;
constexpr size_t WS_XB = 32 * MiB;
constexpr size_t WS_DUMMY0 = 0;
constexpr size_t WS_HB = 32 * MiB;
constexpr size_t WS_MIX = 64 * MiB;
constexpr size_t WS_PROJ = 96 * MiB;
constexpr size_t WS_QM = 160 * MiB;
constexpr size_t WS_KVM = 184 * MiB;
constexpr size_t WS_KMLA = 216 * MiB;
constexpr size_t WS_QN = 208 * MiB;
constexpr size_t WS_KSEL = 240 * MiB;
constexpr size_t WS_KWIN = 244 * MiB;
constexpr size_t WS_HQN = 232 * MiB;
constexpr size_t WS_HKVN = 244 * MiB;
constexpr size_t WS_H2 = 224 * MiB;
constexpr size_t WS_HID = 32 * MiB;

constexpr int LDS_BYTES = 155648, LDS_BST = 154624;
constexpr int NW = 8;

struct Params {
    const float* in[21];
    float* out;
    unsigned char* ws;
};

typedef const float* cfptr_t;
__device__ __forceinline__ const float* inptr(int i) {
    const __attribute__((address_space(4))) char* ka = (const __attribute__((address_space(4))) char*)__builtin_amdgcn_kernarg_segment_ptr();
    int off = i * 8; asm volatile("" : "+s"(off));
    return *(const __attribute__((address_space(4))) cfptr_t*)(ka + off);
}
template <class V> __device__ __forceinline__ void st16_wt(const void* sbase, unsigned voff, const V& v) { static_assert(sizeof(V) == 16, "16-byte vector"); asm volatile("global_store_dwordx4 %0, %1, %2 sc1\n\ts_nop 1" :: "v"(voff), "v"(v), "s"(sbase) : "memory"); }
__device__ __forceinline__ unsigned f2bf(float f) { unsigned u = __builtin_bit_cast(unsigned, f); return (u + 0x7fffu + ((u >> 16) & 1u)) >> 16; }
__device__ __forceinline__ float bf2f(unsigned b) { return __builtin_bit_cast(float, b << 16); }
__device__ __forceinline__ unsigned pk2(float lo, float hi) { return f2bf(lo) | (f2bf(hi) << 16); }
__device__ __forceinline__ float wave_sum(float v) {
#pragma unroll
    for (int o = 1; o < 64; o <<= 1) v += __shfl_xor(v, o);
    return v;
}
__device__ __forceinline__ int t5_bucket(int n) {
    if (n < 16) return n;
    int b = 16;
    b += (n >= 19); b += (n >= 21); b += (n >= 24); b += (n >= 27); b += (n >= 31); b += (n >= 35); b += (n >= 40); b += (n >= 46);
    b += (n >= 52); b += (n >= 59); b += (n >= 67); b += (n >= 77); b += (n >= 87); b += (n >= 99); b += (n >= 113);
    return b;
}

__device__ __forceinline__ void p0_transpose_item(const float* W, int K, int N, int Npad, bf16_t* WT, LAS float* scr, int item, int lane, const float* gk = nullptr, int ldw = 0, int projmap = 0) {
    const int nblk = Npad / 32, kb = item / nblk, nb = item % nblk, k0 = 64 * kb, n0 = 32 * nb;
    int nsrc = n0;
    if (projmap == 2) { const int pn_ = n0 >> 8, bj_ = (n0 >> 7) & 1, wc_ = (n0 >> 5) & 3; nsrc = (wc_ < 2 ? 128 * (2 * pn_ + wc_) : 128 * (2 * pn_ + wc_ - 2) + 64) + 32 * bj_; }
    else if (projmap) { if (n0 < 1280) { const int sl = 4 * (n0 >> 8) + ((n0 & 127) >> 5), e0 = 32 * ((n0 >> 7) & 1); nsrc = (sl < 8 ? C_QB + 64 * sl : C_KVB + 64 * (sl - 8)) + e0; }
                   else if (n0 < 1280 + 672) nsrc = n0 - 1280; else if (n0 == P_GATE) nsrc = C_GATE; else nsrc = N; }
    const int nn = nsrc + (lane & 31);
    float wv[32];
#pragma unroll
    for (int i = 0; i < 32; ++i) { const int kk = 2 * i + (lane >> 5); wv[i] = (nn < N) ? W[(size_t)(k0 + kk) * N + nn] : 0.f; }
#pragma unroll
    for (int i = 0; i < 32; ++i) { const int kk = 2 * i + (lane >> 5); const float gg = gk ? gk[k0 + kk] : 1.f; scr[kk * 33 + (lane & 31)] = wv[i] * gg; }
    asm volatile("s_waitcnt lgkmcnt(0)" ::: "memory");
    const int c = lane & 7;
#pragma unroll
    for (int j = 0; j < 4; ++j) { const int n = (lane >> 3) + 8 * j; const LAS float* s = scr + (8 * c) * 33 + n;
        u32x4 o; o.x = pk2(s[0 * 33], s[1 * 33]); o.y = pk2(s[2 * 33], s[3 * 33]); o.z = pk2(s[4 * 33], s[5 * 33]); o.w = pk2(s[6 * 33], s[7 * 33]);
        *(u32x4*)(WT + (size_t)(n0 + n) * (ldw ? ldw : K) + k0 + 8 * c) = o; }
    asm volatile("s_waitcnt lgkmcnt(0)" ::: "memory");
}
template <int NR>
__device__ __forceinline__ void rows_to_bf16_rstd(const float* x, bf16_t* o, float* rstd_out, int row0, int rstride, int lane) {
    f32x4 v[NR][4];
#pragma unroll
    for (int r = 0; r < NR; ++r) { const int rr = (row0 + r * rstride < M) ? row0 + r * rstride : row0; const f32x4* xr = (const f32x4*)(x + (size_t)rr * DM) + lane;
#pragma unroll
        for (int j = 0; j < 4; ++j) v[r][j] = xr[64 * j]; }
#pragma unroll
    for (int r = 0; r < NR; ++r) { if (row0 + r * rstride >= M) continue; float s = 0.f;
#pragma unroll
        for (int j = 0; j < 4; ++j) s += (v[r][j].x * v[r][j].x + v[r][j].y * v[r][j].y) + (v[r][j].z * v[r][j].z + v[r][j].w * v[r][j].w);
        s = wave_sum(s);
        if (lane == 0) rstd_out[row0 + r * rstride] = 1.f / sqrtf(s * (1.f / DM) + EPS);
        unsigned long long* o8 = (unsigned long long*)(o + (size_t)(row0 + r * rstride) * DM) + lane;
#pragma unroll
        for (int j = 0; j < 4; ++j) o8[64 * j] = (unsigned long long)pk2(v[r][j].x, v[r][j].y) | ((unsigned long long)pk2(v[r][j].z, v[r][j].w) << 32); }
}

__device__ __forceinline__ int opaque_tid(int wv) { int lane; asm volatile("v_mbcnt_lo_u32_b32 %0, -1, 0\n\tv_mbcnt_hi_u32_b32 %0, -1, %0" : "=v"(lane)); return (wv << 6) | lane; }
namespace pg8 {
#define PG8_LAS __attribute__((address_space(3)))
typedef unsigned short bf16_t;
typedef short bf16x8 __attribute__((ext_vector_type(8)));
typedef float f32x4 __attribute__((ext_vector_type(4)));
typedef unsigned u32x4 __attribute__((ext_vector_type(4)));
constexpr int BM = 256, BK = 64, HALF = 128, HTB = HALF * BK * 2  , STAGE_BYTES = 8 * HTB, NXCD = 8, WGM = 8;

__host__ __device__ __forceinline__ int lds_byte(int r, int c) { const int st = (r >> 4) * 2 + (c >> 5), rr = r & 15, cc = c & 31, ob = rr * 64 + cc * 2; return st * 1024 + (ob ^ (((ob >> 9) & 1) << 5)); }
__host__ __device__ __forceinline__ void stage_rc(int b, int& R, int& C) { const int st = b / 1024, sb = b % 1024, swz = sb ^ (((sb >> 9) & 1) << 5); R = (st >> 1) * 16 + swz / 64; C = (st & 1) * 32 + (swz % 64) / 2; }
__host__ __device__ __forceinline__ int perm32(int rho) { const int n = rho >> 4, i = rho & 15; return 8 * (i >> 2) + 4 * n + (i & 3); }

struct Unit { int pm, pn; };
struct Gemm { const bf16_t* A; const bf16_t* Bt; int M, N, K, lda, ldb; };

struct StaticOrder {
    int nM, nN, nwg, G, c;
    __host__ __device__ void init(int M, int N, int G_, int c_) { nM = M / BM; nN = N / BM; nwg = nM * nN; G = G_; c = c_; }
    __host__ __device__ bool next(int i, Unit& u) const {
        const long L = (long)i * G + c; if (L >= nwg) return false;
        int wgid = (int)L; { const int q = nwg / NXCD, r = nwg % NXCD, xcd = wgid % NXCD, off = wgid / NXCD; wgid = (xcd < r ? xcd * (q + 1) : r * (q + 1) + (xcd - r) * q) + off; }
        const int nig = WGM * nN, gid = wgid / nig, fm = gid * WGM, gsz = (nM - fm) < WGM ? (nM - fm) : WGM;
        u.pm = fm + ((wgid % nig) % gsz); u.pn = (wgid % nig) / gsz; return true;
    }
    __device__ __forceinline__ void a_ready(const Unit&) const {}
    __device__ __forceinline__ void done(const Unit&) const {}
};

template <class Epi, class Sched, bool ALIGN_EPI = false, bool SP2 = false>
__device__ __forceinline__ void gemm_phase(PG8_LAS unsigned char* lds, const Gemm g, const Sched& S, const Epi& E, int wv) {
    const int tid = opaque_tid(wv), wid = __builtin_amdgcn_readfirstlane(tid >> 6), lane = tid & 63, wr = wid >> 2, wc = wid & 3, fr = lane & 15, fq = lane >> 4;
    const int K = g.K, nt = K / BK;
    unsigned voffA[2], voffB[2];
#pragma unroll
    for (int i = 0; i < 2; ++i) { int R, C; stage_rc(tid * 16 + i * 8192, R, C); const int Rb = Epi::PERM ? ((R & ~31) + perm32(R & 31)) : R;
        voffA[i] = (unsigned)(R * g.lda + C) * 2u; voffB[i] = (unsigned)(Rb * g.ldb + C) * 2u; }
    const size_t kstep = (size_t)(BK * 2);
    const size_t hstepA = (size_t)HALF * g.lda * 2, hstepB = (size_t)HALF * g.ldb * 2;
    const size_t tstepA = 2 * hstepA, tstepB = 2 * hstepB;
    const unsigned ldsw = (unsigned)wid * 1024u;
    const int aoff = lds_byte(wr * 64 + fr, fq * 8), boff = lds_byte(wc * 32 + fr, fq * 8);
#define PG8_SA(b, h) (((b) * 2 + (h)) * HTB)
#define PG8_SB(b, h) ((4 + (b) * 2 + (h)) * HTB)
#define PG8_STAGE(bufoff, gbase, voff) do { _Pragma("unroll") for (int _i = 0; _i < 2; ++_i) \
        __builtin_amdgcn_global_load_lds((const unsigned*)((const char*)(gbase) + (voff)[_i]), (PG8_LAS unsigned*)(lds + (bufoff) + ldsw + _i * 8192), 16, 0, 0); } while (0)
#define PG8_LDA(dst, b, h) do { _Pragma("unroll") for (int m = 0; m < 4; ++m) _Pragma("unroll") for (int k = 0; k < 2; ++k) dst[m][k] = *(const PG8_LAS bf16x8*)(lds + PG8_SA(b, h) + aoff + m * 2048 + k * 1024); } while (0)
#define PG8_LDB(dst, b, h) do { _Pragma("unroll") for (int n = 0; n < 2; ++n) _Pragma("unroll") for (int k = 0; k < 2; ++k) dst[n][k] = *(const PG8_LAS bf16x8*)(lds + PG8_SB(b, h) + boff + n * 2048 + k * 1024); } while (0)
#define PG8_MMA(ai, bj, At, Bt) do { __builtin_amdgcn_s_setprio(1); _Pragma("unroll") for (int m = 0; m < 4; ++m) _Pragma("unroll") for (int n = 0; n < 2; ++n) _Pragma("unroll") for (int k = 0; k < 2; ++k) \
        acc[ai][bj][m][n] = __builtin_amdgcn_mfma_f32_16x16x32_bf16(Bt[n][k], At[m][k], acc[ai][bj][m][n], 0, 0, 0); __builtin_amdgcn_s_setprio(0); } while (0)
#define PG8_WAIT_V(n) asm volatile("s_waitcnt vmcnt(" #n ")" ::: "memory")
#define PG8_WAIT_L(n) asm volatile("s_waitcnt lgkmcnt(" #n ")" ::: "memory")
#define PG8_BAR __builtin_amdgcn_s_barrier()
#define PG8_SCHED __builtin_amdgcn_sched_barrier(0)
    Unit cur, nxt; int ui = 0;
    if (!S.next(0, cur)) return;
    f32x4 acc[2][2][4][2];
#pragma unroll
    for (int a = 0; a < 2; ++a)
#pragma unroll
        for (int b = 0; b < 2; ++b)
#pragma unroll
            for (int m = 0; m < 4; ++m)
#pragma unroll
                for (int n = 0; n < 2; ++n) acc[a][b][m][n] = (f32x4){0.f, 0.f, 0.f, 0.f};
    bf16x8 At[4][2], B0[2][2], B1[2][2];
    const char* cA = (const char*)g.A + (size_t)cur.pm * tstepA; const char* cB = (const char*)g.Bt + (size_t)cur.pn * tstepB;
    asm volatile("" : "+s"(cA), "+s"(cB));
    S.a_ready(cur);
    if constexpr (SP2) {
        PG8_STAGE(PG8_SB(0, 0), cB, voffB); PG8_STAGE(PG8_SB(0, 1), cB + hstepB, voffB); PG8_STAGE(PG8_SA(0, 0), cA, voffA); PG8_STAGE(PG8_SA(0, 1), cA + hstepA, voffA);
        if (wr == 1) PG8_BAR;
        PG8_WAIT_V(2); PG8_BAR;
        PG8_STAGE(PG8_SB(1, 0), cB + kstep, voffB); PG8_STAGE(PG8_SA(1, 0), cA + kstep, voffA); PG8_STAGE(PG8_SB(1, 1), cB + hstepB + kstep, voffB);
        PG8_WAIT_V(6); PG8_BAR;
    } else {
        PG8_STAGE(PG8_SB(0, 0), cB, voffB); PG8_STAGE(PG8_SA(0, 0), cA, voffA); PG8_STAGE(PG8_SB(0, 1), cB + hstepB, voffB); PG8_STAGE(PG8_SA(0, 1), cA + hstepA, voffA);
        if (wr == 1) PG8_BAR;
        PG8_WAIT_V(4); PG8_BAR;
        PG8_STAGE(PG8_SB(1, 0), cB + kstep, voffB); PG8_STAGE(PG8_SA(1, 0), cA + kstep, voffA); PG8_STAGE(PG8_SB(1, 1), cB + hstepB + kstep, voffB);
        PG8_WAIT_V(6); PG8_BAR;
    }
    for (;;) {
        const bool has_next = S.next(ui + 1, nxt);
        const char* nA = has_next ? (const char*)g.A + (size_t)nxt.pm * tstepA : cA; const char* nB = has_next ? (const char*)g.Bt + (size_t)nxt.pn * tstepB : cB;
        asm volatile("" : "+s"(nA), "+s"(nB));
        for (int t = 0; t < nt; t += 2) {
            if constexpr (Epi::MIDSCALE) { if (t == nt / 2) E.midscale(acc, cur, wr, fr); }
            const bool last = (t == nt - 2);
            const char* a1 = cA + (size_t)(t + 1) * kstep;
            const char* a2 = last ? nA : cA + (size_t)(t + 2) * kstep; const char* b2 = last ? nB : cB + (size_t)(t + 2) * kstep;
            const char* a3 = a2 + kstep; const char* b3 = b2 + kstep;
            asm volatile("" : "+s"(a1), "+s"(a2), "+s"(b2), "+s"(a3), "+s"(b3));
            if (last && has_next) S.a_ready(nxt);
            if constexpr (SP2) {
            PG8_LDB(B0, 0, 0); PG8_LDB(B1, 0, 1); PG8_SCHED; PG8_LDA(At, 0, 0); PG8_STAGE(PG8_SA(1, 1), a1 + hstepA, voffA);
            PG8_WAIT_V(8); PG8_WAIT_L(0); PG8_BAR; PG8_MMA(0, 0, At, B0); PG8_MMA(0, 1, At, B1); PG8_BAR; PG8_SCHED;
            PG8_LDA(At, 0, 1); PG8_STAGE(PG8_SB(0, 0), b2, voffB); PG8_STAGE(PG8_SB(0, 1), b2 + hstepB, voffB); PG8_STAGE(PG8_SA(0, 0), a2, voffA);
            PG8_WAIT_V(8); PG8_WAIT_L(0); PG8_BAR; PG8_MMA(1, 0, At, B0); PG8_MMA(1, 1, At, B1); PG8_BAR; PG8_SCHED;
            PG8_LDB(B0, 1, 0); PG8_LDB(B1, 1, 1); PG8_SCHED; PG8_LDA(At, 1, 0); PG8_STAGE(PG8_SA(0, 1), a2 + hstepA, voffA);
            PG8_WAIT_V(8); PG8_WAIT_L(0); PG8_BAR; PG8_MMA(0, 0, At, B0); PG8_MMA(0, 1, At, B1); PG8_BAR; PG8_SCHED;
            PG8_LDA(At, 1, 1); PG8_STAGE(PG8_SB(1, 0), b3, voffB); PG8_STAGE(PG8_SB(1, 1), b3 + hstepB, voffB); PG8_STAGE(PG8_SA(1, 0), a3, voffA);
            PG8_WAIT_V(8); PG8_WAIT_L(0); PG8_BAR; PG8_MMA(1, 0, At, B0); PG8_MMA(1, 1, At, B1); PG8_BAR; PG8_SCHED;
            } else {
            PG8_LDB(B0, 0, 0); PG8_SCHED; PG8_LDA(At, 0, 0); PG8_STAGE(PG8_SA(1, 1), a1 + hstepA, voffA);
            PG8_WAIT_L(8); PG8_BAR; PG8_WAIT_L(0); PG8_MMA(0, 0, At, B0); PG8_BAR; PG8_SCHED;
            PG8_LDB(B1, 0, 1); PG8_STAGE(PG8_SB(0, 0), b2, voffB);
            PG8_BAR; PG8_WAIT_L(0); PG8_MMA(0, 1, At, B1); PG8_BAR;
            PG8_LDA(At, 0, 1); PG8_STAGE(PG8_SA(0, 0), a2, voffA);
            PG8_BAR; PG8_WAIT_L(0); PG8_MMA(1, 0, At, B0); PG8_BAR; PG8_SCHED;
            PG8_STAGE(PG8_SB(0, 1), b2 + hstepB, voffB);
            PG8_WAIT_V(6); PG8_BAR; PG8_MMA(1, 1, At, B1); PG8_BAR;
            PG8_LDB(B0, 1, 0); PG8_SCHED; PG8_LDA(At, 1, 0); PG8_STAGE(PG8_SA(0, 1), a2 + hstepA, voffA);
            PG8_WAIT_L(8); PG8_BAR; PG8_WAIT_L(0); PG8_MMA(0, 0, At, B0); PG8_BAR; PG8_SCHED;
            PG8_LDB(B1, 1, 1); PG8_STAGE(PG8_SB(1, 0), b3, voffB);
            PG8_BAR; PG8_WAIT_L(0); PG8_MMA(0, 1, At, B1); PG8_BAR;
            PG8_LDA(At, 1, 1); PG8_STAGE(PG8_SA(1, 0), a3, voffA);
            PG8_BAR; PG8_WAIT_L(0); PG8_MMA(1, 0, At, B0); PG8_BAR; PG8_SCHED;
            PG8_STAGE(PG8_SB(1, 1), b3 + hstepB, voffB);
            PG8_WAIT_V(6); PG8_BAR; PG8_MMA(1, 1, At, B1); PG8_BAR;
            }
        }
        if constexpr (ALIGN_EPI) { if (wr == 0) PG8_BAR; }
        if constexpr (!Epi::AFTER_DRAIN) { const int l2_ = opaque_tid(wv) & 63; E(acc, cur, wr, wc, l2_ & 15, l2_ >> 4); S.done(cur); }
        if (!has_next) break;
#pragma unroll
        for (int a = 0; a < 2; ++a)
#pragma unroll
            for (int b = 0; b < 2; ++b)
#pragma unroll
                for (int m = 0; m < 4; ++m)
#pragma unroll
                    for (int n = 0; n < 2; ++n) acc[a][b][m][n] = (f32x4){0.f, 0.f, 0.f, 0.f};
        cur = nxt; cA = nA; cB = nB; ++ui;
        if constexpr (ALIGN_EPI) { if (wr == 1) PG8_BAR; }
    }
    PG8_WAIT_V(0);
    if constexpr (!ALIGN_EPI) { if (wr == 0) PG8_BAR; }
    PG8_BAR;
    if constexpr (Epi::AFTER_DRAIN) { E.fused(acc, cur, wr, wc, fr, fq, lds, wid, lane); S.done(cur); }
#undef PG8_SA
#undef PG8_SB
#undef PG8_STAGE
#undef PG8_LDA
#undef PG8_LDB
#undef PG8_MMA
#undef PG8_WAIT_V
#undef PG8_WAIT_L
#undef PG8_BAR
#undef PG8_SCHED
}
}

__device__ __forceinline__ unsigned cvt_pk_bf16(float lo, float hi) { unsigned r; asm volatile("v_cvt_pk_bf16_f32 %0, %1, %2" : "=v"(r) : "v"(lo), "v"(hi)); return r; }
template <int ACT> struct PEpiBf16 {
    static constexpr bool PERM = true, AFTER_DRAIN = false, MIDSCALE = false;
    bf16_t* O; int ldc; const float* rs; float invn;
    __device__ __forceinline__ void operator()(const f32x4 (&acc)[2][2][4][2], const pg8::Unit& u, int wr, int wc, int fr, int fq) const {
        const int row0 = u.pm * 256 + wr * 64 + fr, col0 = u.pn * 256 + wc * 32 + 8 * fq;
        float rsc[2][4];
#pragma unroll
        for (int ai = 0; ai < 2; ++ai)
#pragma unroll
            for (int m = 0; m < 4; ++m) rsc[ai][m] = rs ? rs[row0 + ai * 128 + m * 16] : 1.f;
        if (invn > 0.f) {
#pragma unroll
            for (int ai = 0; ai < 2; ++ai)
#pragma unroll
                for (int m = 0; m < 4; ++m) rsc[ai][m] = 1.f / sqrtf(rsc[ai][m] * invn + EPS); }
#pragma unroll
        for (int ai = 0; ai < 2; ++ai)
#pragma unroll
            for (int m = 0; m < 4; ++m) { const bf16_t* rowp = O + ((size_t)(u.pm * 256 + wr * 64 + ai * 128 + m * 16) * ldc + u.pn * 256 + wc * 32); const unsigned lo_ = (unsigned)(fr * ldc + 8 * fq) * 2u; const float sc_ = rsc[ai][m];
#pragma unroll
                for (int bj = 0; bj < 2; ++bj) { f32x4 v0 = acc[ai][bj][m][0] * sc_, v1 = acc[ai][bj][m][1] * sc_;
                    if (ACT == 2) {
#pragma unroll
                        for (int e = 0; e < 4; ++e) { const float a = fmaxf(v0[e], 0.f), b = fmaxf(v1[e], 0.f); v0[e] = a * a; v1[e] = b * b; } }
                    u32x4 w; w.x = cvt_pk_bf16(v0[0], v0[1]); w.y = cvt_pk_bf16(v0[2], v0[3]); w.z = cvt_pk_bf16(v1[0], v1[1]); w.w = cvt_pk_bf16(v1[2], v1[3]);
                    st16_wt(rowp + bj * 128, lo_, w); } }
    }
};
struct PEpiProj {
    static constexpr bool PERM = true, AFTER_DRAIN = false, MIDSCALE = false;
    bf16_t* O; int ldc; const float* rs1; float* ssq_q; float* ssq_kv; float* ssq_kr; const float* qgain; const float* kgain; const float* rope; const float* kgm;
    __device__ __forceinline__ void operator()(const f32x4 (&acc)[2][2][4][2], const pg8::Unit& u, int wr, int wc, int fr, int fq) const {
        const int row0 = u.pm * 256 + wr * 64 + fr, col0 = u.pn * 256 + wc * 32 + 8 * fq, lane = fq * 16 + fr;
        float rsc[2][4];
#pragma unroll
        for (int ai = 0; ai < 2; ++ai)
#pragma unroll
            for (int m = 0; m < 4; ++m) rsc[ai][m] = rs1[row0 + ai * 128 + m * 16];
        const int sl = 4 * u.pn + wc;
        int mode = 0; const float* g = nullptr; float gs = 1.f;
        if (u.pn < 5) { if (sl < 8) { mode = 1; g = qgain; gs = QS_NSA; } else if (sl == S_KSEL || sl == S_KSEL + 1) { mode = 1; g = kgain + 64; } else if (sl == S_KWIN || sl == S_KWIN + 1) { mode = 1; g = kgain + 128; } }
        f32x4 ga[2][2];
        if (mode == 1) {
#pragma unroll
            for (int bj = 0; bj < 2; ++bj) { ga[bj][0] = *(const f32x4*)(g + 32 * bj + 8 * fq) * gs; ga[bj][1] = *(const f32x4*)(g + 32 * bj + 8 * fq + 4) * gs; } }
#pragma unroll
        for (int ai = 0; ai < 2; ++ai)
#pragma unroll
            for (int m = 0; m < 4; ++m) { const int row = row0 + ai * 128 + m * 16; const bf16_t* rowp = O + ((size_t)(u.pm * 256 + wr * 64 + ai * 128 + m * 16) * ldc + u.pn * 256 + wc * 32); const unsigned lo_ = (unsigned)(fr * ldc + 8 * fq) * 2u; const float sc_ = rsc[ai][m];
                f32x4 v[2][2];
#pragma unroll
                for (int bj = 0; bj < 2; ++bj) { v[bj][0] = acc[ai][bj][m][0] * sc_; v[bj][1] = acc[ai][bj][m][1] * sc_; }
                if (mode == 1) {
                    float ss = 0.f;
#pragma unroll
                    for (int bj = 0; bj < 2; ++bj)
#pragma unroll
                        for (int n = 0; n < 2; ++n) ss += (v[bj][n][0] * v[bj][n][0] + v[bj][n][1] * v[bj][n][1]) + (v[bj][n][2] * v[bj][n][2] + v[bj][n][3] * v[bj][n][3]);
                    ss += __builtin_bit_cast(float, __builtin_amdgcn_ds_bpermute((lane ^ 16) << 2, __builtin_bit_cast(int, ss)));
                    ss += __builtin_bit_cast(float, __builtin_amdgcn_ds_bpermute((lane ^ 32) << 2, __builtin_bit_cast(int, ss)));
                    const float rstd = 1.f / sqrtf(ss * (1.f / 64) + EPS);
#pragma unroll
                    for (int bj = 0; bj < 2; ++bj) { v[bj][0] = v[bj][0] * rstd * ga[bj][0]; v[bj][1] = v[bj][1] * rstd * ga[bj][1]; }
                } else if (u.pn >= 5) {
#pragma unroll
                    for (int bj = 0; bj < 2; ++bj) { const int cb = u.pn * 256 + bj * 128;
                        float* dst = (cb < P_HKV) ? ssq_q : (cb < P_HKR ? ssq_kv : ((cb == P_HKR && wc == 0) ? ssq_kr : nullptr));
                        if (dst) { float ss = (v[bj][0][0] * v[bj][0][0] + v[bj][0][1] * v[bj][0][1]) + (v[bj][0][2] * v[bj][0][2] + v[bj][0][3] * v[bj][0][3]) + (v[bj][1][0] * v[bj][1][0] + v[bj][1][1] * v[bj][1][1]) + (v[bj][1][2] * v[bj][1][2] + v[bj][1][3] * v[bj][1][3]);
                            ss += __builtin_bit_cast(float, __builtin_amdgcn_ds_bpermute((lane ^ 16) << 2, __builtin_bit_cast(int, ss)));
                            ss += __builtin_bit_cast(float, __builtin_amdgcn_ds_bpermute((lane ^ 32) << 2, __builtin_bit_cast(int, ss)));
                            if (fq == 0) __hip_atomic_fetch_add(dst + row, ss, __ATOMIC_RELAXED, __HIP_MEMORY_SCOPE_AGENT); }
                        if (cb == P_HKR && wc == 0) {
                            const f32x4 g0 = *(const f32x4*)(kgm + 64 + 8 * fq), g1 = *(const f32x4*)(kgm + 64 + 8 * fq + 4);
                            const float* rp = rope + (size_t)(row & (SEQ - 1)) * 32 + 8 * (fq & 1);
                            const f32x4 c0 = *(const f32x4*)rp, c1 = *(const f32x4*)(rp + 4), s0 = *(const f32x4*)(rp + 16), s1 = *(const f32x4*)(rp + 20);
#pragma unroll
                            for (int n = 0; n < 2; ++n)
#pragma unroll
                                for (int j = 0; j < 4; ++j) { const float nv = v[bj][n][j] * (n ? g1[j] : g0[j]);
                                    const float pv = __builtin_bit_cast(float, __builtin_amdgcn_ds_bpermute((lane ^ 32) << 2, __builtin_bit_cast(int, nv)));
                                    const float cs = n ? c1[j] : c0[j], sn = n ? s1[j] : s0[j]; v[bj][n][j] = (fq < 2) ? nv * cs - pv * sn : nv * cs + pv * sn; } } }
                }
#pragma unroll
                for (int bj = 0; bj < 2; ++bj) { u32x4 w; w.x = cvt_pk_bf16(v[bj][0][0], v[bj][0][1]); w.y = cvt_pk_bf16(v[bj][0][2], v[bj][0][3]); w.z = cvt_pk_bf16(v[bj][1][0], v[bj][1][1]); w.w = cvt_pk_bf16(v[bj][1][2], v[bj][1][3]);
                    st16_wt(rowp + bj * 128, lo_, w); } }
    }
};
struct PEpiKV {
    static constexpr bool PERM = true, AFTER_DRAIN = false, MIDSCALE = false;
    bf16_t* V; bf16_t* K; const bf16_t* proj; const float* ssq_kv; const float* ssq_kr; const float* rope; const float* kgain;
    __device__ __forceinline__ void operator()(const f32x4 (&acc)[2][2][4][2], const pg8::Unit& u, int wr, int wc, int fr_, int fq_) const {
        int fr = fr_, fq = fq_; asm volatile("" : "+v"(fr), "+v"(fq)); const float* kgain = this->kgain; asm volatile("" : "+s"(kgain)); const float* rope = this->rope; asm volatile("" : "+s"(rope));
        const int row0 = u.pm * 256 + wr * 64 + fr, lane = fq * 16 + fr;
        float rsc[2][4];
#pragma unroll
        for (int ai = 0; ai < 2; ++ai)
#pragma unroll
            for (int m = 0; m < 4; ++m) rsc[ai][m] = 1.f / sqrtf(ssq_kv[row0 + ai * 128 + m * 16] * (1.f / KVR) + EPS);
        if (wc >= 2) {
            const int col0 = u.pn * 256 + wc * 32 + 8 * fq;
#pragma unroll
            for (int ai = 0; ai < 2; ++ai)
#pragma unroll
                for (int m = 0; m < 4; ++m) { const bf16_t* rowp = V + ((size_t)(u.pm * 256 + wr * 64 + ai * 128 + m * 16) * MKV + u.pn * 256 + wc * 32); const unsigned lo_ = (unsigned)(fr * MKV + 8 * fq) * 2u; const float sc_ = rsc[ai][m];
#pragma unroll
                    for (int bj = 0; bj < 2; ++bj) { const f32x4 v0 = acc[ai][bj][m][0] * sc_, v1 = acc[ai][bj][m][1] * sc_;
                        u32x4 w; w.x = cvt_pk_bf16(v0[0], v0[1]); w.y = cvt_pk_bf16(v0[2], v0[3]); w.z = cvt_pk_bf16(v1[0], v1[1]); w.w = cvt_pk_bf16(v1[2], v1[3]);
                        st16_wt(rowp + bj * 128, lo_, w); } }
            return;
        }
        const int hh = 2 * u.pn + wc;
#pragma unroll
        for (int ai = 0; ai < 2; ++ai)
#pragma unroll
            for (int m = 0; m < 4; ++m) { const int row = row0 + ai * 128 + m * 16; const float sc_ = rsc[ai][m];
                const bf16_t* ko = K + ((size_t)(u.pm * 256 + wr * 64 + ai * 128 + m * 16) * MQ + 96 * hh); const unsigned lo_ = (unsigned)(fr * MQ + 8 * fq) * 2u;
                float rstd;
                {
                    f32x4 v[2][2]; float ss = 0.f;
#pragma unroll
                    for (int bj = 0; bj < 2; ++bj)
#pragma unroll
                        for (int n = 0; n < 2; ++n) { v[bj][n] = acc[ai][bj][m][n] * sc_; ss += (v[bj][n][0] * v[bj][n][0] + v[bj][n][1] * v[bj][n][1]) + (v[bj][n][2] * v[bj][n][2] + v[bj][n][3] * v[bj][n][3]); }
                    ss += __builtin_bit_cast(float, __builtin_amdgcn_ds_bpermute((lane ^ 16) << 2, __builtin_bit_cast(int, ss)));
                    ss += __builtin_bit_cast(float, __builtin_amdgcn_ds_bpermute((lane ^ 32) << 2, __builtin_bit_cast(int, ss)));
                    rstd = 1.f / sqrtf((ss + ssq_kr[row]) * (1.f / 96) + EPS);
#pragma unroll
                    for (int bj = 0; bj < 2; ++bj) { const f32x4 g0 = *(const f32x4*)(kgain + 32 * bj + 8 * fq), g1 = *(const f32x4*)(kgain + 32 * bj + 8 * fq + 4);
                        const f32x4 a = v[bj][0] * rstd * g0, b = v[bj][1] * rstd * g1;
                        u32x4 w; w.x = cvt_pk_bf16(a[0], a[1]); w.y = cvt_pk_bf16(a[2], a[3]); w.z = cvt_pk_bf16(b[0], b[1]); w.w = cvt_pk_bf16(b[2], b[3]);
                        st16_wt(ko + 32 * bj, lo_, w); }
                }
                asm volatile("" ::: "memory");
                {
                    const bf16x8 kr8 = *(const bf16x8*)(proj + (size_t)row * DINP + P_HKR + 8 * fq);
                    u32x4 w; w.x = cvt_pk_bf16(bf2f((unsigned short)kr8[0]) * rstd, bf2f((unsigned short)kr8[1]) * rstd); w.y = cvt_pk_bf16(bf2f((unsigned short)kr8[2]) * rstd, bf2f((unsigned short)kr8[3]) * rstd);
                    w.z = cvt_pk_bf16(bf2f((unsigned short)kr8[4]) * rstd, bf2f((unsigned short)kr8[5]) * rstd); w.w = cvt_pk_bf16(bf2f((unsigned short)kr8[6]) * rstd, bf2f((unsigned short)kr8[7]) * rstd);
                    st16_wt(ko + 64, lo_, w);
                }
                asm volatile("" ::: "memory"); }
    }
};
struct PEpiWo {
    static constexpr bool PERM = true, AFTER_DRAIN = false, MIDSCALE = true;
    const bf16_t* base; bf16_t* xb; float* ssq; const float* ssqm; int ldc;
    __device__ __forceinline__ void midscale(f32x4 (&acc)[2][2][4][2], const pg8::Unit& u, int wr, int fr) const {
#pragma unroll
        for (int ai = 0; ai < 2; ++ai)
#pragma unroll
            for (int m = 0; m < 4; ++m) { const int row = u.pm * 256 + ai * 128 + wr * 64 + m * 16 + fr;
                const float sa = ssqm[2 * row], sb = ssqm[2 * row + 1]; const float ratio = sqrtf((sb * (1.f / 512) + EPS) / (sa * (1.f / 512) + EPS));
#pragma unroll
                for (int bj = 0; bj < 2; ++bj)
#pragma unroll
                    for (int n = 0; n < 2; ++n) acc[ai][bj][m][n] *= ratio; }
    }
    __device__ __forceinline__ void operator()(const f32x4 (&acc)[2][2][4][2], const pg8::Unit& u, int wr, int wc, int fr, int fq) const {
        const int lane = fq * 16 + fr;
        const int rowb = u.pm * 256 + wr * 64 + fr;
        float rb[8];
#pragma unroll
        for (int g_ = 0; g_ < 8; ++g_) rb[g_] = ssqm[2 * (rowb + (g_ >> 2) * 128 + (g_ & 3) * 16) + 1];
        const size_t tile0 = (size_t)(u.pm * 256 + wr * 64) * ldc + u.pn * 256 + wc * 32;
        const unsigned lo_ = (unsigned)(fr * ldc + 8 * fq) * 2u;
        u32x4 nxt[2];
#pragma unroll
        for (int bj = 0; bj < 2; ++bj) nxt[bj] = *(const u32x4*)((const char*)(base + tile0 + bj * 128) + lo_);
#pragma unroll
        for (int g_ = 0; g_ < 8; ++g_) { const int ai = g_ >> 2, m = g_ & 3; const int row = rowb + ai * 128 + m * 16; const size_t roff = tile0 + (size_t)(ai * 128 + m * 16) * ldc; float ss = 0.f;
            u32x4 cur[2];
#pragma unroll
            for (int bj = 0; bj < 2; ++bj) cur[bj] = nxt[bj];
            if (g_ < 7) { const size_t roffn = tile0 + (size_t)(((g_ + 1) >> 2) * 128 + ((g_ + 1) & 3) * 16) * ldc;
#pragma unroll
                for (int bj = 0; bj < 2; ++bj) nxt[bj] = *(const u32x4*)((const char*)(base + roffn + bj * 128) + lo_); }
            const float rbs = 1.f / sqrtf(rb[g_] * (1.f / 512) + EPS);
#pragma unroll
            for (int bj = 0; bj < 2; ++bj) { const u32x4 cw = cur[bj];
                const f32x4 v0 = (f32x4){bf2f(cw.x & 0xffffu), bf2f(cw.x >> 16), bf2f(cw.y & 0xffffu), bf2f(cw.y >> 16)} + acc[ai][bj][m][0] * rbs;
                const f32x4 v1 = (f32x4){bf2f(cw.z & 0xffffu), bf2f(cw.z >> 16), bf2f(cw.w & 0xffffu), bf2f(cw.w >> 16)} + acc[ai][bj][m][1] * rbs;
                ss += ((v0[0] * v0[0] + v0[1] * v0[1]) + (v0[2] * v0[2] + v0[3] * v0[3])) + ((v1[0] * v1[0] + v1[1] * v1[1]) + (v1[2] * v1[2] + v1[3] * v1[3]));
                u32x4 w; w.x = cvt_pk_bf16(v0[0], v0[1]); w.y = cvt_pk_bf16(v0[2], v0[3]); w.z = cvt_pk_bf16(v1[0], v1[1]); w.w = cvt_pk_bf16(v1[2], v1[3]);
                st16_wt(xb + roff + bj * 128, lo_, w); }
            ss += __builtin_bit_cast(float, __builtin_amdgcn_ds_bpermute((lane ^ 16) << 2, __builtin_bit_cast(int, ss)));
            ss += __builtin_bit_cast(float, __builtin_amdgcn_ds_bpermute((lane ^ 32) << 2, __builtin_bit_cast(int, ss)));
            if (fq == 0) __hip_atomic_fetch_add(ssq + row, ss, __ATOMIC_RELAXED, __HIP_MEMORY_SCOPE_AGENT); }
    }
};


struct PEpiDown {
    static constexpr bool PERM = false, AFTER_DRAIN = false, MIDSCALE = false;
    const bf16_t* xb; float* out; int ldc;
    __device__ __forceinline__ void operator()(const f32x4 (&acc)[2][2][4][2], const pg8::Unit& u, int wr, int wc, int fr, int fq) const {
        const int col0 = u.pn * 256 + wc * 32 + 4 * fq; const int rowb = u.pm * 256 + wr * 64 + fr;
        u32x2 nxt[2][2];
#pragma unroll
        for (int bj = 0; bj < 2; ++bj)
#pragma unroll
            for (int n = 0; n < 2; ++n) nxt[bj][n] = *(const u32x2*)(xb + (size_t)rowb * ldc + col0 + bj * 128 + n * 16);
#pragma unroll
        for (int g_ = 0; g_ < 8; ++g_) { const int ai = g_ >> 2, m = g_ & 3; const size_t off = (size_t)(rowb + ai * 128 + m * 16) * ldc + col0;
            u32x2 cur[2][2];
#pragma unroll
            for (int bj = 0; bj < 2; ++bj)
#pragma unroll
                for (int n = 0; n < 2; ++n) cur[bj][n] = nxt[bj][n];
            if (g_ < 7) { const size_t offn = (size_t)(rowb + ((g_ + 1) >> 2) * 128 + ((g_ + 1) & 3) * 16) * ldc + col0;
#pragma unroll
                for (int bj = 0; bj < 2; ++bj)
#pragma unroll
                    for (int n = 0; n < 2; ++n) nxt[bj][n] = *(const u32x2*)(xb + offn + bj * 128 + n * 16); }
#pragma unroll
            for (int bj = 0; bj < 2; ++bj)
#pragma unroll
                for (int n = 0; n < 2; ++n) { const u32x2 w = cur[bj][n];
                    const f32x4 bs = (f32x4){bf2f(w.x & 0xffffu), bf2f(w.x >> 16), bf2f(w.y & 0xffffu), bf2f(w.y >> 16)};
                    __builtin_nontemporal_store(bs + acc[ai][bj][m][n], (f32x4*)(out + off + bj * 128 + n * 16)); } }
    }
};

__device__ __forceinline__ float sq8(const bf16x8 v) { float s = 0.f;
#pragma unroll
    for (int j = 0; j < 8; ++j) { const float f = bf2f((unsigned short)v[j]); s += f * f; }
    return s; }
__device__ __forceinline__ u32x4 scale8(const bf16x8 v, float sc, const f32x4 ga, const f32x4 gb) { u32x4 o;
    o.x = pk2(bf2f((unsigned short)v[0]) * sc * ga[0], bf2f((unsigned short)v[1]) * sc * ga[1]); o.y = pk2(bf2f((unsigned short)v[2]) * sc * ga[2], bf2f((unsigned short)v[3]) * sc * ga[3]);
    o.z = pk2(bf2f((unsigned short)v[4]) * sc * gb[0], bf2f((unsigned short)v[5]) * sc * gb[1]); o.w = pk2(bf2f((unsigned short)v[6]) * sc * gb[2], bf2f((unsigned short)v[7]) * sc * gb[3]);
    return o; }

__device__ __forceinline__ void compress_block(unsigned char* ws, LAS unsigned char* L, int task, int wv) {
    const int tid = opaque_tid(wv), lane = tid & 63, wid = __builtin_amdgcn_readfirstlane(tid >> 6), fr = lane & 15, fq = lane >> 4;
    const int tc = task & 15, b = (task >> 4) & 7, kv = task >> 7;
    int c = 8 * tc + (fr >> 1); const int g = fr & 1; if (c > NCMP - 1) c = NCMP - 1;
    const bf16_t* arow = (const bf16_t*)(ws + WS_PROJ) + (size_t)(b * SEQ + 16 * c) * DINP + slot_base((kv ? S_VCMP : S_KCMP) + g) + 8 * fq;
    const float* pe = inptr(11) + kv * 2048 + 8 * fq;
    const bf16_t* w1t = (const bf16_t*)(ws + WS_W1T) + (size_t)kv * 128 * 2048 + (size_t)fr * 2048 + 8 * fq;
    f32x4 acc[8];
#pragma unroll
    for (int n = 0; n < 8; ++n) acc[n] = (f32x4){0.f, 0.f, 0.f, 0.f};
#pragma unroll 4
    for (int s8 = 0; s8 < 8; ++s8) {
        const int s = 8 * wid + s8, r = s >> 1, db = (s & 1) * 32;
        const bf16x8 araw = *(const bf16x8*)(arow + (size_t)r * DINP + 4 * db);
        const f32x4 pa = *(const f32x4*)(pe + r * 64 + db), pb = *(const f32x4*)(pe + r * 64 + db + 4);
        u32x4 aw; aw.x = pk2(bf2f((unsigned short)araw[0]) + pa[0], bf2f((unsigned short)araw[1]) + pa[1]); aw.y = pk2(bf2f((unsigned short)araw[2]) + pa[2], bf2f((unsigned short)araw[3]) + pa[3]);
        aw.z = pk2(bf2f((unsigned short)araw[4]) + pb[0], bf2f((unsigned short)araw[5]) + pb[1]); aw.w = pk2(bf2f((unsigned short)araw[6]) + pb[2], bf2f((unsigned short)araw[7]) + pb[3]);
        const bf16x8 a = __builtin_bit_cast(bf16x8, aw);
#pragma unroll
        for (int n = 0; n < 8; ++n) { const bf16x8 bb = *(const bf16x8*)(w1t + (size_t)(16 * n) * 2048 + 32 * s);
            acc[n] = __builtin_amdgcn_mfma_f32_16x16x32_bf16(a, bb, acc[n], 0, 0, 0); }
    }
    LAS float* part = (LAS float*)L;
#pragma unroll
    for (int n = 0; n < 8; ++n)
#pragma unroll
        for (int j = 0; j < 4; ++j) part[(wid * 16 + 4 * fq + j) * 128 + 16 * n + fr] = acc[n][j];
    __syncthreads();
    LAS bf16_t* hb_ = (LAS bf16_t*)(L + 65536);
#pragma unroll
    for (int e = 0; e < 4; ++e) { const int idx = tid + 512 * e; float v = 0.f;
#pragma unroll
        for (int w = 0; w < 8; ++w) v += part[w * 2048 + idx];
        hb_[idx] = (bf16_t)f2bf(v / (1.f + __expf(-v))); }
    __syncthreads();
    if (wid == 0) {
        const bf16_t* w2t = (const bf16_t*)(ws + WS_W2T) + kv * 64 * 128 + fr * 128 + 8 * fq;
        f32x4 o[4];
#pragma unroll
        for (int n = 0; n < 4; ++n) o[n] = (f32x4){0.f, 0.f, 0.f, 0.f};
#pragma unroll
        for (int ks = 0; ks < 4; ++ks) { const bf16x8 a = *(const LAS bf16x8*)(hb_ + fr * 128 + 32 * ks + 8 * fq);
#pragma unroll
            for (int n = 0; n < 4; ++n) { const bf16x8 bb = *(const bf16x8*)(w2t + (size_t)(16 * n) * 128 + 32 * ks); o[n] = __builtin_amdgcn_mfma_f32_16x16x32_bf16(a, bb, o[n], 0, 0, 0); } }
        bf16_t* dstb = (bf16_t*)(ws + (kv ? WS_VCMP : WS_KCMP)) + (size_t)b * 128 * 2 * 64;
        const float* kg = inptr(10);
#pragma unroll
        for (int j = 0; j < 4; ++j) { const int row = 4 * fq + j, cc = 8 * tc + (row >> 1), gg = row & 1;
            float sc = 1.f;
            if (kv == 0) { float ss = o[0][j] * o[0][j] + o[1][j] * o[1][j] + o[2][j] * o[2][j] + o[3][j] * o[3][j];
                ss += __shfl_xor(ss, 1); ss += __shfl_xor(ss, 2); ss += __shfl_xor(ss, 4); ss += __shfl_xor(ss, 8); sc = 1.f / sqrtf(ss * (1.f / 64) + EPS); }
#pragma unroll
            for (int n = 0; n < 4; ++n) { const int col = 16 * n + fr; float v = o[n][j] * sc; if (kv == 0) v *= kg[col]; if (cc >= NCMP) v = 0.f;
                dstb[((size_t)cc * 2 + gg) * 64 + col] = (bf16_t)f2bf(v); } }
    }
    __syncthreads();
}

namespace att {
typedef float f32x16 __attribute__((ext_vector_type(16)));
typedef short s16x4 __attribute__((ext_vector_type(4)));
typedef short v4i16_t __attribute__((ext_vector_type(4)));
typedef float f32x2_t __attribute__((ext_vector_type(2)));
typedef __bf16 bf16x2_t __attribute__((ext_vector_type(2)));
typedef const LAS unsigned char* lcp;
constexpr int NSLOT = 3;
constexpr int L_TB = 0, L_K = 4096, KSLOT = 12288, L_V = L_K + NSLOT * KSLOT, VSLOT = 8192, L_WSF = L_V + NSLOT * VSLOT, L_OST = L_WSF + 4096,
              L_IMP = L_OST + 32768, IMPS = 33  , L_SELM = L_IMP + 4 * 64 * IMPS * 4, L_GATE = L_SELM + 256, L_SC = L_GATE + 3072, L_INVL = L_SC + 64 * IMPS * 4, L_END = L_INVL + 1024;
static_assert(L_V + NSLOT * VSLOT <= 65536, "LDS-DMA destinations stay below 64 KiB");
static_assert(L_END <= LDS_BST, "attention LDS map");
constexpr float THR = 8.0f;
__device__ __forceinline__ int crow(int r, int hi) { return (r & 3) + 8 * (r >> 2) + 4 * hi; }
__device__ __forceinline__ void glds16(const void* gsrc, unsigned lds_dst) { unsigned keep;
    asm volatile("s_mov_b32 %0, m0\n\ts_mov_b32 m0, %2\n\ts_nop 0\n\tglobal_load_lds_dwordx4 %1, off\n\ts_mov_b32 m0, %0" : "=&s"(keep) : "v"(gsrc), "s"(lds_dst) : "memory"); }
__device__ __forceinline__ unsigned cvtpk(float lo, float hi) { f32x2_t v = {lo, hi}; bf16x2_t b = __builtin_convertvector(v, bf16x2_t); return __builtin_bit_cast(unsigned, b); }
__device__ __forceinline__ s16x4 vtr(lcp p) { return __builtin_bit_cast(s16x4, __builtin_amdgcn_ds_read_tr16_b64_v4i16((LAS v4i16_t*)p)); }
__device__ __forceinline__ float lane_xor(float v, int lane, int x) { return __builtin_bit_cast(float, __builtin_amdgcn_ds_bpermute((lane ^ x) << 2, __builtin_bit_cast(int, v))); }
__device__ __forceinline__ unsigned lane_xor_u(unsigned v, int lane, int x) { return (unsigned)__builtin_amdgcn_ds_bpermute((lane ^ x) << 2, (int)v); }
__device__ __forceinline__ float swap_max(float m, int lane) { return __builtin_fmaxf(m, lane_xor(m, lane, 32)); }
__device__ __forceinline__ float swap_sum(float m, int lane) { return m + lane_xor(m, lane, 32); }
__device__ __forceinline__ float max3f(float a, float b, float c) { float r; asm("v_max3_f32 %0, %1, %2, %3" : "=v"(r) : "v"(a), "v"(b), "v"(c)); return r; }
__device__ __forceinline__ float max32(const f32x16& p0, const f32x16& p1) {
    float a = max3f(p0[0], p0[1], p1[0]), b = max3f(p0[2], p0[3], p1[1]); a = max3f(a, p1[2], p1[3]);
#pragma unroll
    for (int r = 4; r < 16; r += 4) { a = max3f(a, p0[r], p0[r + 1]); b = max3f(b, p0[r + 2], p0[r + 3]); a = max3f(a, p1[r], p1[r + 1]); b = max3f(b, p1[r + 2], p1[r + 3]); }
    return __builtin_fmaxf(a, b); }
__device__ __forceinline__ float max16(const f32x16& p) { float a = __builtin_fmaxf(p[0], p[1]), b = __builtin_fmaxf(p[2], p[3]);
#pragma unroll
    for (int r = 4; r < 16; r += 4) { a = __builtin_fmaxf(a, __builtin_fmaxf(p[r], p[r + 1])); b = __builtin_fmaxf(b, __builtin_fmaxf(p[r + 2], p[r + 3])); }
    return __builtin_fmaxf(a, b); }
__device__ __forceinline__ float sum16(const f32x16& p) { float a = p[0] + p[1], b = p[2] + p[3];
#pragma unroll
    for (int r = 4; r < 16; r += 4) { a += p[r] + p[r + 1]; b += p[r + 2] + p[r + 3]; }
    return a + b; }
#define ATT_BAR() asm volatile("s_waitcnt vmcnt(0) lgkmcnt(0)\n\ts_barrier" ::: "memory")

template <int DQ> __device__ __forceinline__ void qkt(f32x16& p0, f32x16& p1, lcp kslot, const bf16x8* qr, const f32x16& cinit, int r32, int hi) {
    lcp kb = kslot + hi * 1024 + r32 * 16;
    constexpr int NB = (DQ == 96) ? 3 : 4;
#pragma unroll
    for (int db = 0; db < DQ / 16; db += NB) {
        bf16x8 kf[2 * NB];
#pragma unroll
        for (int e = 0; e < NB; ++e) { kf[2 * e] = *(const LAS bf16x8*)(kb + (db + e) * 2048); kf[2 * e + 1] = *(const LAS bf16x8*)(kb + (db + e) * 2048 + 512); }
        __builtin_amdgcn_sched_barrier(0);
#pragma unroll
        for (int e = 0; e < NB; ++e) { const int d0 = db + e;
            if (d0 == 0) { p0 = __builtin_amdgcn_mfma_f32_32x32x16_bf16(kf[0], qr[0], cinit, 0, 0, 0); p1 = __builtin_amdgcn_mfma_f32_32x32x16_bf16(kf[1], qr[0], cinit, 0, 0, 0); }
            else { p0 = __builtin_amdgcn_mfma_f32_32x32x16_bf16(kf[2 * e], qr[d0], p0, 0, 0, 0); p1 = __builtin_amdgcn_mfma_f32_32x32x16_bf16(kf[2 * e + 1], qr[d0], p1, 0, 0, 0); }
        }
    }
}
__device__ __forceinline__ void vload_half(bf16x8 (&vf)[8], lcp vp, int d0) {
#pragma unroll
    for (int ks = 0; ks < 4; ++ks) {
        const s16x4 lo = vtr(vp + d0 * 4096 + ks * 1024), hh = vtr(vp + d0 * 4096 + ks * 1024 + 512);
        vf[d0 * 4 + ks] = (bf16x8){lo[0], lo[1], lo[2], lo[3], hh[0], hh[1], hh[2], hh[3]};
    }
    __builtin_amdgcn_sched_barrier(0);
}
__device__ __forceinline__ void vload(bf16x8 (&vf)[8], lcp vp) { vload_half(vf, vp, 0); vload_half(vf, vp, 1); }
__device__ __forceinline__ void pv_mma(f32x16 (&o)[2], const bf16x8 (&vf)[8], const f32x16& p0, const f32x16& p1) {
    u32x4 pw[4];
    pw[0] = (u32x4){cvtpk(p0[0], p0[1]), cvtpk(p0[2], p0[3]), cvtpk(p0[4], p0[5]), cvtpk(p0[6], p0[7])};
    pw[1] = (u32x4){cvtpk(p0[8], p0[9]), cvtpk(p0[10], p0[11]), cvtpk(p0[12], p0[13]), cvtpk(p0[14], p0[15])};
    pw[2] = (u32x4){cvtpk(p1[0], p1[1]), cvtpk(p1[2], p1[3]), cvtpk(p1[4], p1[5]), cvtpk(p1[6], p1[7])};
    pw[3] = (u32x4){cvtpk(p1[8], p1[9]), cvtpk(p1[10], p1[11]), cvtpk(p1[12], p1[13]), cvtpk(p1[14], p1[15])};
#pragma unroll
    for (int d0 = 0; d0 < 2; ++d0)
#pragma unroll
        for (int ks = 0; ks < 4; ++ks) o[d0] = __builtin_amdgcn_mfma_f32_32x32x16_bf16(__builtin_bit_cast(bf16x8, pw[ks]), vf[d0 * 4 + ks], o[d0], 0, 0, 0);
}
__device__ __forceinline__ void pv(f32x16 (&o)[2], lcp vp, const f32x16& p0, const f32x16& p1) { bf16x8 vf[8]; vload(vf, vp); pv_mma(o, vf, p0, p1); }
template <int DQ, bool SLOT = false, bool SLOTV = SLOT> __device__ __forceinline__ void dma_tile(unsigned lds0, const bf16_t* Kg, int kpitch, const bf16_t* Vg, int vpitch, int key0, int slot, int wid, int lane) {
    const bf16_t* ksrc = Kg + (size_t)(key0 + lane) * kpitch + (SLOT ? 128 * (wid >> 2) + 8 * (wid & 3) : wid * 8);
    glds16(ksrc, (unsigned)__builtin_amdgcn_readfirstlane(lds0 + L_K + slot * KSLOT + wid * 1024));
    if (DQ == 96) { if (wid < 4) glds16(ksrc + 64, (unsigned)__builtin_amdgcn_readfirstlane(lds0 + L_K + slot * KSLOT + (8 + wid) * 1024)); }
    const bf16_t* vsrc = Vg + (size_t)(key0 + 16 * (wid & 3) + (lane >> 2)) * vpitch + (wid >> 2) * (SLOTV ? 128 : 32) + (lane & 3) * 8;
    glds16(vsrc, (unsigned)__builtin_amdgcn_readfirstlane(lds0 + L_V + slot * VSLOT + wid * 1024));
}

#define ATT_LBAR() asm volatile("s_waitcnt lgkmcnt(0)\n\ts_barrier" ::: "memory")
struct NoNext { static constexpr int count = 0; __device__ __forceinline__ void dma(unsigned, int, int, int, int) const {} };
template <int DQ, bool SLOT, bool SLOTV, class Pol> struct NextTiles {
    const bf16_t* Kg; int kpitch; const bf16_t* Vg; int vpitch; const Pol* pol; int count;
    __device__ __forceinline__ void dma(unsigned lds0, int j, int slot, int wid, int lane) const { dma_tile<DQ, SLOT, SLOTV>(lds0, Kg, kpitch, Vg, vpitch, pol->key0(j), slot, wid, lane); }
};
template <int DQ, bool SLOT = false, bool SLOTV = SLOT, class Pol, class Next>
__device__ __forceinline__ void flash_loop(LAS unsigned char* L, const bf16_t* Kg, int kpitch, const bf16_t* Vg, int vpitch, const bf16x8* qr, const Pol& pol, int s0, int npre, const Next& next,
                                           f32x16 (&o)[2], float& l_out, int wid, int lane) {
    const int r32 = lane & 31, hi = lane >> 5;
    const unsigned lds0 = (unsigned)(uintptr_t)L;
    LAS float* wsf = (LAS float*)(L + L_WSF) + wid * 128;
    lcp vp0 = L + L_V + ((lane >> 4) & 1) * 32 + (lane & 3) * 8 + (4 * hi + ((lane & 15) >> 2)) * 64;
    float mhat = 0.f, l = 0.f;
    f32x16 negm;
#pragma unroll
    for (int r = 0; r < 16; ++r) { o[0][r] = 0.f; o[1][r] = 0.f; negm[r] = 0.f; }
    const int n = pol.ntiles, ntot = n + next.count;
    int slot = s0, slot1 = (s0 + 1) % NSLOT, slot2 = (s0 + 2) % NSLOT;
    if (npre < 1) dma_tile<DQ, SLOT, SLOTV>(lds0, Kg, kpitch, Vg, vpitch, pol.key0(0), slot, wid, lane);
    if (npre < 2 && ntot > 1) { if (n > 1) dma_tile<DQ, SLOT, SLOTV>(lds0, Kg, kpitch, Vg, vpitch, pol.key0(1), slot1, wid, lane); else next.dma(lds0, 0, slot1, wid, lane); }
    for (int i = 0; i < n; ++i) {
        if (i + 1 < ntot) { if (DQ == 96 && wid < 4) asm volatile("s_waitcnt vmcnt(3) lgkmcnt(0)\n\ts_barrier" ::: "memory"); else asm volatile("s_waitcnt vmcnt(2) lgkmcnt(0)\n\ts_barrier" ::: "memory"); }
        else ATT_BAR();
        if (i + 2 < ntot) { if (i + 2 < n) dma_tile<DQ, SLOT, SLOTV>(lds0, Kg, kpitch, Vg, vpitch, pol.key0(i + 2), slot2, wid, lane); else next.dma(lds0, i + 2 - n, slot2, wid, lane); }
        if (pol.active(i)) {
            f32x16 p0, p1;
            qkt<DQ>(p0, p1, L + L_K + slot * KSLOT, qr, negm, r32, hi);
            bf16x8 vf[8]; vload_half(vf, vp0 + slot * VSLOT, 0);
            pol.fix(p0, p1, i);
            asm volatile("s_nop 15\n\ts_nop 7" : "+v"(p0), "+v"(p1));
            const float rm = swap_max(max32(p0, p1), lane);
            const bool first = (i == 0);
            if (first || __any(rm > THR)) {
                float dl = first ? rm : __builtin_fmaxf(rm, 0.f);
                if (dl == -INFINITY) dl = 0.f;
                mhat += dl;
#pragma unroll
                for (int r = 0; r < 16; ++r) { p0[r] -= dl; p1[r] -= dl; negm[r] = -mhat; }
                if (!first) {
                    const float f = __builtin_amdgcn_exp2f(-dl); l *= f;
                    if (hi == 0) wsf[r32] = f;
#pragma unroll
                    for (int r = 0; r < 16; ++r) { const float fr_ = wsf[crow(r, hi)]; o[0][r] *= fr_; o[1][r] *= fr_; }
                }
            }
#pragma unroll
            for (int r = 0; r < 16; ++r) { p0[r] = __builtin_amdgcn_exp2f(p0[r]); p1[r] = __builtin_amdgcn_exp2f(p1[r]); }
            vload_half(vf, vp0 + slot * VSLOT, 1);
            l += sum16(p0) + sum16(p1);
            pv_mma(o, vf, p0, p1);
        }
        slot = slot1; slot1 = slot2; slot2 = (slot2 == NSLOT - 1) ? 0 : slot2 + 1;
    }
    ATT_LBAR();
    l_out = swap_sum(l, lane);
}

__device__ __forceinline__ void acc_scaled(f32x16 (&oc)[2], const f32x16 (&o)[2], float rowscale, LAS float* wsf, int r32, int hi) {
    if (hi == 0) wsf[32 + r32] = rowscale;
#pragma unroll
    for (int r = 0; r < 16; ++r) { const float s = wsf[32 + crow(r, hi)]; oc[0][r] += s * o[0][r]; oc[1][r] += s * o[1][r]; }
}
__device__ __forceinline__ void park_store(const f32x16 (&oc)[2], LAS float* park, int lane) {
#pragma unroll
    for (int d0 = 0; d0 < 2; ++d0)
#pragma unroll
        for (int r = 0; r < 16; ++r) park[(d0 * 16 + r) * 64 + lane] = oc[d0][r];
}
template <bool FINAL> __device__ __forceinline__ void park_acc(f32x16 (&oc)[2], LAS float* park, const f32x16 (&o)[2], float rowscale, LAS float* wsf, int lane) {
    const int r32 = lane & 31, hi = lane >> 5;
    if (hi == 0) wsf[32 + r32] = rowscale;
#pragma unroll
    for (int r = 0; r < 16; ++r) { const float s = wsf[32 + crow(r, hi)];
#pragma unroll
        for (int d0 = 0; d0 < 2; ++d0) { const float v = park[(d0 * 16 + r) * 64 + lane] + s * o[d0][r]; if (FINAL) oc[d0][r] = v; else park[(d0 * 16 + r) * 64 + lane] = v; } }
}
__device__ __forceinline__ void store_tile(const f32x16 (&oc)[2], bf16_t* dst, int pitch, LAS unsigned char* L, int wid, int lane, float* ssq) {
    const int r32 = lane & 31, hi = lane >> 5;
    LAS bf16_t* stg = (LAS bf16_t*)(L + L_OST + wid * 8192);
#pragma unroll
    for (int r = 0; r < 16; ++r) { const int orow = crow(r, hi);
#pragma unroll
        for (int d0 = 0; d0 < 2; ++d0) stg[orow * 64 + d0 * 32 + r32] = (bf16_t)f2bf(oc[d0][r]); }
    asm volatile("s_waitcnt lgkmcnt(0)" ::: "memory");
#pragma unroll
    for (int i = 0; i < 4; ++i) { const int row = i * 8 + (lane >> 3), ch = lane & 7; const u32x4 v = *(const LAS u32x4*)(stg + row * 64 + ch * 8); st16_wt(dst + (size_t)(i * 8) * pitch, (unsigned)((lane >> 3) * pitch + ch * 8) * 2u, v);
        float ss = sq8(__builtin_bit_cast(bf16x8, v)); ss += lane_xor(ss, lane, 1); ss += lane_xor(ss, lane, 2); ss += lane_xor(ss, lane, 4);
        if (ch == 0) __hip_atomic_fetch_add(ssq + 2 * row, ss, __ATOMIC_RELAXED, __HIP_MEMORY_SCOPE_AGENT); }
    asm volatile("s_waitcnt lgkmcnt(0)" ::: "memory");
}

#define PIN16(v) asm volatile("" : "+v"(v[0]), "+v"(v[1]), "+v"(v[2]), "+v"(v[3]), "+v"(v[4]), "+v"(v[5]), "+v"(v[6]), "+v"(v[7]), "+v"(v[8]), "+v"(v[9]), "+v"(v[10]), "+v"(v[11]), "+v"(v[12]), "+v"(v[13]), "+v"(v[14]), "+v"(v[15]))
__device__ __forceinline__ int clamp127(int d) { return d < 0 ? 0 : (d < 127 ? d : 127); }
struct PolMla { int ntiles, qw0, r32, hi;
    __device__ __forceinline__ int key0(int i) const { return 64 * i; }
    __device__ __forceinline__ bool active(int i) const { return 64 * i <= qw0 + 31; }
    __device__ __forceinline__ int nact() const { const int a = (qw0 + 31) / 64 + 1; return a < ntiles ? a : ntiles; }
    __device__ __forceinline__ void fix(f32x16& p0, f32x16& p1, int i) const {
        if (64 * i + 63 > qw0) { const int q = qw0 + r32, kb = 64 * i + 4 * hi;
#pragma unroll
            for (int r = 0; r < 16; ++r) { const int kv = kb + (r & 3) + 8 * (r >> 2); if (kv > q) p0[r] = -INFINITY; if (kv + 32 > q) p1[r] = -INFINITY; } }
    }
};
struct PolSel { int ntiles, qc, q, hi; unsigned selm; const LAS float* tbh;
    __device__ __forceinline__ int key0(int i) const { return 64 * (qc - i); }
    __device__ __forceinline__ bool active(int i) const { return __any((selm >> (qc - i)) & 1u) != 0; }
    __device__ __forceinline__ int nact() const { return ntiles; }
    __device__ __forceinline__ void fix(f32x16& p0, f32x16& p1, int i) const {
        const bool bit = ((selm >> (qc - i)) & 1u) != 0u;
        if (i <= 2) { const int kb = 64 * (qc - i) + 4 * hi; float bv0[16], bv1[16];
#pragma unroll
            for (int r = 0; r < 16; ++r) { const int d0 = q - (kb + (r & 3) + 8 * (r >> 2)); bv0[r] = tbh[clamp127(d0)]; bv1[r] = tbh[clamp127(d0 - 32)]; }
            PIN16(bv0); PIN16(bv1);
#pragma unroll
            for (int r = 0; r < 16; ++r) { const int d0 = q - (kb + (r & 3) + 8 * (r >> 2)), d1 = d0 - 32;
                p0[r] = (d0 < 0) ? -INFINITY : p0[r] + bv0[r]; p1[r] = (d1 < 0) ? -INFINITY : p1[r] + bv1[r]; } }
        if (!bit) {
#pragma unroll
            for (int r = 0; r < 16; ++r) { p0[r] = -INFINITY; p1[r] = -INFINITY; } }
    }
};
struct PolWin { int ntiles, qc, q, hi; const LAS float* tbh;
    __device__ __forceinline__ int key0(int i) const { return 64 * (qc - i); }
    __device__ __forceinline__ bool active(int) const { return true; }
    __device__ __forceinline__ int nact() const { return ntiles; }
    __device__ __forceinline__ void fix(f32x16& p0, f32x16& p1, int i) const {
        if (i <= 2) { const int kb = 64 * (qc - i) + 4 * hi; float bv0[16], bv1[16];
#pragma unroll
            for (int r = 0; r < 16; ++r) { const int d0 = q - (kb + (r & 3) + 8 * (r >> 2)); bv0[r] = tbh[clamp127(d0)]; bv1[r] = tbh[clamp127(d0 - 32)]; }
            PIN16(bv0); PIN16(bv1);
#pragma unroll
            for (int r = 0; r < 16; ++r) { const int d0 = q - (kb + (r & 3) + 8 * (r >> 2)), d1 = d0 - 32;
                p0[r] = (d0 < 0) ? -INFINITY : p0[r] + bv0[r]; p1[r] = (d1 < 0) ? -INFINITY : p1[r] + bv1[r]; } }
        else if (i == 8) { const int kb = 64 * (qc - i) + 4 * hi;
#pragma unroll
            for (int r = 0; r < 16; ++r) { const int d0 = q - (kb + (r & 3) + 8 * (r >> 2)), d1 = d0 - 32; if (d0 >= 512) p0[r] = -INFINITY; if (d1 >= 512) p1[r] = -INFINITY; } }
    }
};

__device__ __forceinline__ void mla_unit(unsigned char* ws, LAS unsigned char* L, int b, int h, int qb, int wv, int s0, int npre, int nnext) {
    asm volatile("" : "+s"(ws));
    const int tid = opaque_tid(wv), lane = tid & 63, wid = __builtin_amdgcn_readfirstlane(tid >> 6);
    const int r32 = lane & 31, hi = lane >> 5;
    const size_t rowbase = (size_t)b * SEQ; const int qw0 = 256 * qb + 32 * wid;
    bf16x8 qr[6];
    { const bf16_t* Qw = (const bf16_t*)(ws + WS_QM) + (rowbase + qw0 + r32) * MQ + 96 * h + 8 * hi;
      bf16x8 raw[6]; float ss = 0.f;
#pragma unroll
      for (int d0 = 0; d0 < 6; ++d0) { raw[d0] = *(const bf16x8*)(Qw + 16 * d0); ss += sq8(raw[d0]); }
      ss += lane_xor(ss, lane, 32);
      const float rstd = QS_MLA / sqrtf(ss * (1.f / 96) + EPS);
      const float* qg = inptr(7) + 8 * hi;
#pragma unroll
      for (int d0 = 0; d0 < 4; ++d0) qr[d0] = __builtin_bit_cast(bf16x8, scale8(raw[d0], rstd, *(const f32x4*)(qg + 16 * d0), *(const f32x4*)(qg + 16 * d0 + 4)));
      float o1[8], o2[8]; const float posf = (float)(qw0 + r32);
#pragma unroll
      for (int j = 0; j < 8; ++j) { const int i = 8 * hi + j; const float inv = exp2f(-(float)i * (13.287712379549449f / 16.f)); float sn, cs; sincosf(posf * inv, &sn, &cs);
          const float n1 = bf2f((unsigned short)raw[4][j]) * rstd * qg[64 + j], n2 = bf2f((unsigned short)raw[5][j]) * rstd * qg[80 + j];
          o1[j] = n1 * cs - n2 * sn; o2[j] = n2 * cs + n1 * sn; }
      u32x4 w4, w5; w4.x = pk2(o1[0], o1[1]); w4.y = pk2(o1[2], o1[3]); w4.z = pk2(o1[4], o1[5]); w4.w = pk2(o1[6], o1[7]);
      w5.x = pk2(o2[0], o2[1]); w5.y = pk2(o2[2], o2[3]); w5.z = pk2(o2[4], o2[5]); w5.w = pk2(o2[6], o2[7]);
      qr[4] = __builtin_bit_cast(bf16x8, w4); qr[5] = __builtin_bit_cast(bf16x8, w5); }
    const bf16_t* Kg = (const bf16_t*)(ws + WS_KMLA) + rowbase * MQ + 96 * h;
    const bf16_t* Vg = (const bf16_t*)(ws + WS_KVM) + rowbase * MKV + slot_base(4 * (h >> 1) + 2 + (h & 1));
    PolMla pol{4 * qb + 4, qw0, r32, hi};
    f32x16 o[2]; float l;
    const NextTiles<96, false, true, PolMla> nxt{Kg, MQ, Vg, MKV, &pol, nnext};
    flash_loop<96, false, true>(L, Kg, MQ, Vg, MKV, qr, pol, s0, npre, nxt, o, l, wid, lane);
    LAS float* wsf = (LAS float*)(L + L_WSF) + wid * 128;
    f32x16 oc[2];
#pragma unroll
    for (int r = 0; r < 16; ++r) { oc[0][r] = 0.f; oc[1][r] = 0.f; }
    acc_scaled(oc, o, (l > 0.f) ? 1.f / l : 0.f, wsf, r32, hi);
    store_tile(oc, (bf16_t*)(ws + WS_MIX) + (rowbase + qw0) * DM + 64 * h, DM, L, wid, lane, (float*)(ws + WS_SSQM) + 2 * (rowbase + qw0));
}

__device__ __forceinline__ void nsa_unit(unsigned char* ws, LAS unsigned char* L, int b, int g, int qc, int wv) {
    asm volatile("" : "+s"(ws));
#define NSA_IDS() const int tid = opaque_tid(wv), lane = tid & 63, wid = __builtin_amdgcn_readfirstlane(tid >> 6); \
    const int r32 = lane & 31, hi = lane >> 5, rh = wid & 3, qh = wid >> 2, h = 4 * g + rh, qloc = 32 * qh + r32, q = q0 + qloc; \
    const unsigned lds0 = (unsigned)(uintptr_t)L; LAS float* wsf = (LAS float*)(L + L_WSF) + wid * 128; const LAS float* tbh = (const LAS float*)(L + L_TB) + h * 128; \
    LAS float* gate = (LAS float*)(L + L_GATE); (void)tid; (void)lane; (void)r32; (void)hi; (void)rh; (void)qh; (void)h; (void)qloc; (void)q; (void)lds0; (void)wsf; (void)tbh; (void)gate
    const size_t rowbase = (size_t)b * SEQ; const int q0 = 64 * qc;
    const bf16_t* pr = (const bf16_t*)(ws + WS_PROJ);
    bf16x8 qr[4];
    {
    NSA_IDS();
    { const bf16_t* Kc = (const bf16_t*)(ws + WS_KCMP) + ((size_t)b * 256 + g) * 64; const bf16_t* Vc = (const bf16_t*)(ws + WS_VCMP) + ((size_t)b * 256 + g) * 64;
      dma_tile<64>(lds0, Kc, 128, Vc, 128, 0, 0, wid, lane);
      dma_tile<64>(lds0, Kc, 128, Vc, 128, 64, 1, wid, lane);
      dma_tile<64, true>(lds0, pr + rowbase * DINP + slot_base(S_KSEL + g), DINP, pr + rowbase * DINP + slot_base(S_VSEL + g), DINP, 64 * qc, 2, wid, lane); }
    for (int i = tid; i < 768; i += 512) { const int br = i >> 8, r = (i >> 6) & 3, qq = i & 63;
        const float x = bf2f(pr[(rowbase + q0 + qq) * DINP + P_GATE + 8 * br + 4 * g + r]); gate[i] = 1.f / (1.f + __expf(-x)); }
    { const bf16_t* Qw = pr + (rowbase + q) * DINP + slot_base(S_Q + h) + 8 * hi;
#pragma unroll
      for (int d0 = 0; d0 < 4; ++d0) qr[d0] = *(const bf16x8*)(Qw + 128 * (d0 >> 1) + 16 * (d0 & 1)); }
    }
    f32x16 oc[2];
    {
        NSA_IDS();
        ATT_BAR();
        lcp vp0 = L + L_V + ((lane >> 4) & 1) * 32 + (lane & 3) * 8 + (4 * hi + ((lane & 15) >> 2)) * 64;
        LAS float* imp = (LAS float*)(L + L_IMP) + (rh * 64 + qloc) * IMPS;
        f32x16 a0, a1, b0, b1;
        { f32x16 zero;
#pragma unroll
          for (int r = 0; r < 16; ++r) zero[r] = 0.f;
          qkt<64>(a0, a1, L + L_K, qr, zero, r32, hi); qkt<64>(b0, b1, L + L_K + KSLOT, qr, zero, r32, hi); }
#define CMP_FIX(P, coff, extra) do { float bv[16]; \
            _Pragma("unroll") for (int r = 0; r < 16; ++r) bv[r] = tbh[clamp127(q - 16 * (crow(r, hi) + (coff)) - 31)]; \
            PIN16(bv); \
            _Pragma("unroll") for (int r = 0; r < 16; ++r) { const int c = crow(r, hi) + (coff); const int d = q - 16 * c - 31; P[r] = (d < 0 || (extra && c >= NCMP)) ? -INFINITY : P[r] + bv[r]; } } while (0)
        CMP_FIX(a0, 0, false); CMP_FIX(a1, 32, false); CMP_FIX(b0, 64, false); CMP_FIX(b1, 96, true);
#undef CMP_FIX
        float m = swap_max(__builtin_fmaxf(__builtin_fmaxf(max16(a0), max16(a1)), __builtin_fmaxf(max16(b0), max16(b1))), lane);
        if (m == -INFINITY) m = 0.f;
#pragma unroll
        for (int r = 0; r < 16; ++r) { a0[r] = __builtin_amdgcn_exp2f(a0[r] - m); a1[r] = __builtin_amdgcn_exp2f(a1[r] - m); b0[r] = __builtin_amdgcn_exp2f(b0[r] - m); b1[r] = __builtin_amdgcn_exp2f(b1[r] - m); }
        const float lsum = swap_sum((sum16(a0) + sum16(a1)) + (sum16(b0) + sum16(b1)), lane);
        const float inv = (lsum > 0.f) ? 1.f / lsum : 0.f;
        float prev_last = 0.f;
#define CMP_IMP(T, P0, P1) do { float own[8], car[8]; \
            _Pragma("unroll") for (int a = 0; a < 4; ++a) { \
                own[a]     = P0[4 * a] + P0[4 * a + 1] + P0[4 * a + 2] + 0.5f * P0[4 * a + 3]; car[a]     = 0.5f * P0[4 * a + 3]; \
                own[4 + a] = P1[4 * a] + P1[4 * a + 1] + P1[4 * a + 2] + 0.5f * P1[4 * a + 3]; car[4 + a] = 0.5f * P1[4 * a + 3]; } \
            _Pragma("unroll") for (int k = 0; k < 8; ++k) car[k] = lane_xor(car[k], lane, 32); \
            _Pragma("unroll") for (int k = 0; k < 8; ++k) { const float add = hi ? car[k] : (k >= 1 ? car[k - 1] : prev_last); imp[16 * (T) + 2 * k + hi] = own[k] + add; } \
            prev_last = car[7]; } while (0)
        CMP_IMP(0, a0, a1); CMP_IMP(1, b0, b1);
#undef CMP_IMP
        if (hi == 0) ((LAS float*)(L + L_INVL))[rh * 64 + qloc] = inv;
        f32x16 o[2];
#pragma unroll
        for (int r = 0; r < 16; ++r) { o[0][r] = 0.f; o[1][r] = 0.f; }
        pv(o, vp0, a0, a1); pv(o, vp0 + VSLOT, b0, b1);
        ATT_BAR();
        if (qc >= 1) dma_tile<64, true>(lds0, pr + rowbase * DINP + slot_base(S_KSEL + g), DINP, pr + rowbase * DINP + slot_base(S_VSEL + g), DINP, 64 * (qc - 1), 0, wid, lane);
#pragma unroll
        for (int r = 0; r < 16; ++r) { oc[0][r] = 0.f; oc[1][r] = 0.f; }
        acc_scaled(oc, o, gate[(0 * 4 + rh) * 64 + qloc] * inv, wsf, r32, hi);
    }
    if (qc <= 15) {
        const int tid = opaque_tid(wv);
        if (tid < 64) ((LAS unsigned*)(L + L_SELM))[tid] = (qc == 31) ? 0xffffffffu : ((2u << qc) - 1u);
        ATT_LBAR();
    } else {
        const int tid = opaque_tid(wv);
        const LAS float* imp = (const LAS float*)(L + L_IMP); LAS float* sc = (LAS float*)(L + L_SC);
        const int qq = tid >> 3, jj = tid & 7;
        const LAS float* il = (const LAS float*)(L + L_INVL);
        const float i0 = il[qq], i1 = il[64 + qq], i2 = il[128 + qq], i3 = il[192 + qq];
#pragma unroll
        for (int k = 0; k < 4; ++k) { const int j = jj + 8 * k;
            const float tot = (imp[(0 * 64 + qq) * IMPS + j] * i0 + imp[(1 * 64 + qq) * IMPS + j] * i1) + (imp[(2 * 64 + qq) * IMPS + j] * i2 + imp[(3 * 64 + qq) * IMPS + j] * i3);
            float s; if (j > qc) s = -INFINITY; else if (j == 0 || j == qc || j == qc - 1) s = 1e4f; else s = tot; sc[qq * IMPS + j] = s; }
        ATT_LBAR();
        float v[32];
#pragma unroll
        for (int k = 0; k < 32; ++k) v[k] = sc[qq * IMPS + k];
        unsigned bits = 0u;
#pragma unroll
        for (int k = 0; k < 4; ++k) { const int j = jj + 8 * k; const float me = sc[qq * IMPS + j]; int rank = 0;
#pragma unroll
            for (int i = 0; i < 32; ++i) { const float si = v[i]; rank += (si > me || (si == me && i < j)) ? 1 : 0; }
            if (rank < 16) bits |= 1u << j; }
        { const int lane = tid & 63; bits |= lane_xor_u(bits, lane, 1); bits |= lane_xor_u(bits, lane, 2); bits |= lane_xor_u(bits, lane, 4); }
        if (jj == 0) ((LAS unsigned*)(L + L_SELM))[qq] = bits;
        ATT_LBAR();
    }
    { NSA_IDS(); park_store(oc, (LAS float*)(L + L_OST) + wid * 2048, lane); }
    {
        NSA_IDS();
        const unsigned selm = ((const LAS unsigned*)(L + L_SELM))[qloc];
        const bf16_t* Kg = pr + rowbase * DINP + slot_base(S_KSEL + g);
        const bf16_t* Vg = pr + rowbase * DINP + slot_base(S_VSEL + g);
        PolSel pol{qc + 1, qc, q, hi, selm, tbh};
        const PolWin polw{(qc < 8 ? qc : 8) + 1, qc, q, hi, tbh};
        const NextTiles<64, true, true, PolWin> nxt{pr + rowbase * DINP + slot_base(S_KWIN + g), DINP, pr + rowbase * DINP + slot_base(S_VWIN + g), DINP, &polw, polw.ntiles < 2 ? polw.ntiles : 2};
        f32x16 o[2]; float l;
        flash_loop<64, true>(L, Kg, DINP, Vg, DINP, qr, pol, 2, (qc + 1 < 2) ? qc + 1 : 2, nxt, o, l, wid, lane);
        { f32x16 dummy[2]; park_acc<false>(dummy, (LAS float*)(L + L_OST) + wid * 2048, o, (l > 0.f) ? gate[(1 * 4 + rh) * 64 + qloc] / l : 0.f, wsf, lane); }
    }
    {
        NSA_IDS();
        const bf16_t* Kg = pr + rowbase * DINP + slot_base(S_KWIN + g);
        const bf16_t* Vg = pr + rowbase * DINP + slot_base(S_VWIN + g);
        PolWin pol{(qc < 8 ? qc : 8) + 1, qc, q, hi, tbh};
        f32x16 o[2]; float l;
        flash_loop<64, true>(L, Kg, DINP, Vg, DINP, qr, pol, (2 + qc + 1) % NSLOT, pol.ntiles < 2 ? pol.ntiles : 2, NoNext{}, o, l, wid, lane);
        f32x16 fin[2]; park_acc<true>(fin, (LAS float*)(L + L_OST) + wid * 2048, o, (l > 0.f) ? gate[(2 * 4 + rh) * 64 + qloc] / l : 0.f, wsf, lane);
        store_tile(fin, (bf16_t*)(ws + WS_MIX) + (rowbase + q0 + 32 * qh) * DM + 512 + 64 * h, DM, L, wid, lane, (float*)(ws + WS_SSQM) + 2 * (rowbase + q0 + 32 * qh) + 1);
    }
    ATT_BAR();
}
#undef ATT_BAR
#undef ATT_LBAR
#undef NSA_IDS
}

#define XB_TMO      128
#define XB_XCNT(j)  (256  + 64 * (j))
#define XB_XSUB(j)  (1280 + 64 * (j))
#define XB_XGEN(j)  (2304 + 64 * (j))
#define XB_TOP      3328
#define XB_TOPGEN   3392
#define XCD_BAR_WORDS 3456
#define XB_SPIN_CAP (1u << 18)

__device__ __forceinline__ unsigned xb_ld(unsigned* p)              { return __hip_atomic_load(p, __ATOMIC_RELAXED, __HIP_MEMORY_SCOPE_AGENT); }
__device__ __forceinline__ unsigned xb_add(unsigned* p, unsigned v) { return __hip_atomic_fetch_add(p, v, __ATOMIC_RELAXED, __HIP_MEMORY_SCOPE_AGENT); }
__device__ __forceinline__ unsigned xb_xcc_id() { return (unsigned)__builtin_amdgcn_s_getreg((3 << 11) | 20) & 0xFu; }
#define XB_SPIN(cond, bar) do { unsigned _sp = 0; while (cond) { __builtin_amdgcn_s_sleep(1); \
    if ((++_sp & 255u) == 0u) { if (xb_ld(&(bar)[XB_TMO])) break; if (_sp > XB_SPIN_CAP) { atomicAdd(&(bar)[XB_TMO], 1u); break; } } } } while (0)

struct XcdBarrier {
    unsigned* bar; unsigned x;
    volatile LAS unsigned* st;
};

__device__ __forceinline__ XcdBarrier xcd_barrier_post(unsigned* bar, volatile LAS unsigned* st) {
    XcdBarrier b; b.bar = bar; b.x = xb_xcc_id(); b.st = st;
    if (threadIdx.x == 0) (void)xb_add(&bar[XB_XCNT(b.x)], 1u);
    return b;
}
__device__ __forceinline__ void xcd_barrier_complete(unsigned* bar, unsigned x, unsigned& nloc, unsigned& nx) {
    const unsigned G = gridDim.x * gridDim.y * gridDim.z;
    unsigned sum, cnt, mine, sp = 0u;
    for (;;) {
        sum = 0u; cnt = 0u; mine = 0u;
#pragma unroll
        for (unsigned j = 0; j < 16; ++j) { const unsigned c = xb_ld(&bar[XB_XCNT(j)]); sum += c; cnt += (c > 0u) ? 1u : 0u; mine = (j == x) ? c : mine; }
        if (sum == G) break;
        __builtin_amdgcn_s_sleep(1);
        if ((++sp & 255u) == 0u) { if (xb_ld(&bar[XB_TMO])) break; if (sp > XB_SPIN_CAP) { atomicAdd(&bar[XB_TMO], 1u); break; } }
    }
    nloc = mine > 0u ? mine : 1u; nx = cnt > 0u ? cnt : 1u;
}

__device__ __forceinline__ void xcd_barrier(const XcdBarrier& b, const unsigned char* pf = nullptr, int nchunk = 0, int wv = 0) {
    asm volatile("s_waitcnt vmcnt(0)" ::: "memory");
    __syncthreads();
    if (pf != nullptr && wv >= 1 && wv <= 4) {
        const int t = opaque_tid(wv) - 64;
        const pg8::u32x4* src = (const pg8::u32x4*)pf + (size_t)(blockIdx.x & 255) * nchunk;
        pg8::u32x4 v[9];
#pragma unroll
        for (int i = 0; i < 9; ++i) { int c = i * 256 + t; c = c < nchunk ? c : nchunk - 1; v[i] = src[c]; }
        asm volatile("" :: "v"(v[0]), "v"(v[1]), "v"(v[2]), "v"(v[3]), "v"(v[4]), "v"(v[5]), "v"(v[6]), "v"(v[7]), "v"(v[8]));
    }
    if (threadIdx.x == 0) {
        unsigned* bar = b.bar;
        __builtin_amdgcn_s_waitcnt(0);
        unsigned nloc = b.st[0], nx = b.st[1];
        if (nloc == 0u) { xcd_barrier_complete(bar, b.x, nloc, nx); b.st[0] = nloc; b.st[1] = nx; }
        const unsigned old = xb_add(&bar[XB_XSUB(b.x)], 1u);
        const unsigned gen = old / nloc;
        if (old + 1u == (gen + 1u) * nloc) {
            __builtin_amdgcn_fence(__ATOMIC_RELEASE, "agent");
            asm volatile("s_waitcnt vmcnt(0)" ::: "memory");
            const unsigned og = xb_add(&bar[XB_TOP], 1u);
            const unsigned tg = og / nx;
            if (og + 1u == (tg + 1u) * nx) xb_add(&bar[XB_TOPGEN], 1u);
            else XB_SPIN(xb_ld(&bar[XB_TOPGEN]) == tg, bar);
            __builtin_amdgcn_fence(__ATOMIC_ACQUIRE, "agent");
            xb_add(&bar[XB_XGEN(b.x)], 1u);
            asm volatile("s_waitcnt vmcnt(0)" ::: "memory");
        } else {
            XB_SPIN(xb_ld(&bar[XB_XGEN(b.x)]) == gen, bar);
            __builtin_amdgcn_fence(__ATOMIC_ACQUIRE, "agent");
            asm volatile("s_waitcnt vmcnt(0)" ::: "memory");
        }
    }
    __syncthreads();
}

template <bool RELEASE = false>
__device__ __forceinline__ void group_sync(unsigned* ctl, unsigned* a0, unsigned* a1, unsigned* a2, unsigned* a3, unsigned* w0, unsigned t0, unsigned* w1, unsigned t1, const unsigned char* pf = nullptr, int nchunk = 0, int wv = 0) {
    asm volatile("s_waitcnt vmcnt(0)" ::: "memory");
    __syncthreads();
    if (pf != nullptr && wv >= 1 && wv <= 4) {
        const int t = opaque_tid(wv) - 64;
        const pg8::u32x4* src = (const pg8::u32x4*)pf + (size_t)(blockIdx.x & 255) * nchunk;
        pg8::u32x4 v[9];
#pragma unroll
        for (int i = 0; i < 9; ++i) { int c = i * 256 + t; c = c < nchunk ? c : nchunk - 1; v[i] = src[c]; }
        asm volatile("" :: "v"(v[0]), "v"(v[1]), "v"(v[2]), "v"(v[3]), "v"(v[4]), "v"(v[5]), "v"(v[6]), "v"(v[7]), "v"(v[8]));
    }
    if (threadIdx.x == 0) {
        if (RELEASE) { __builtin_amdgcn_fence(__ATOMIC_RELEASE, "agent"); asm volatile("s_waitcnt vmcnt(0)" ::: "memory"); }
        (void)xb_add(a0, 1u); if (a1) (void)xb_add(a1, 1u); if (a2) (void)xb_add(a2, 1u); if (a3) (void)xb_add(a3, 1u);
        XB_SPIN(xb_ld(w0) < t0, ctl);
        if (w1 != nullptr) XB_SPIN(xb_ld(w1) < t1, ctl);
        __builtin_amdgcn_fence(__ATOMIC_ACQUIRE, "agent");
        asm volatile("s_waitcnt vmcnt(0)" ::: "memory");
    }
    __syncthreads();
}

__global__ void __launch_bounds__(512, 2) mega(Params p) {
    extern __shared__ __attribute__((aligned(16))) unsigned char lds[];
    const int G = gridDim.x, bid = blockIdx.x, NGW = G * NW;
    int wv = __builtin_amdgcn_readfirstlane((int)(threadIdx.x >> 6)); asm volatile("" : "+s"(wv));
#define PHASE_IDS() const int tid = opaque_tid(wv), lane = tid & 63, wave = __builtin_amdgcn_readfirstlane(tid >> 6), gw = bid * NW + wave; (void)tid; (void)lane; (void)gw
    unsigned char* ws = (unsigned char*)inptr(22);
    LAS unsigned char* L = (LAS unsigned char*)lds;
    volatile LAS unsigned* bst = (volatile LAS unsigned*)(L + LDS_BST);
    if (threadIdx.x < 4) bst[threadIdx.x] = 0u;
    __syncthreads();
    (void)xcd_barrier_post((unsigned*)(ws + WS_CTL), bst);
#define bar (XcdBarrier{(unsigned*)((unsigned char*)inptr(22) + WS_CTL), xb_xcc_id(), (volatile LAS unsigned*)((LAS unsigned char*)lds + LDS_BST)})

    {
        PHASE_IDS();
        LAS float* scr = (LAS float*)(L + wave * 8704);
        constexpr int I0 = (1024 / 64) * (DINP / 32), I1 = (QR / 64) * (MQ / 32), I2 = (KVR / 64) * (MKV / 32), I3 = 16 * 32, I4 = 16 * (FF / 32), I5 = (FF / 64) * 32;
        constexpr int I6 = (2048 / 64) * (128 / 32), I7 = (128 / 64) * (64 / 32);
        constexpr int NIT = I0 + I1 + I2 + I3 + I4 + I5 + 2 * I6 + 2 * I7;
        for (int it = gw; it < NIT; it += NGW) {
            int r = it;
            if (r < I0) { p0_transpose_item(inptr(2), 1024, DIN, DINP, (bf16_t*)(ws + WS_WIN), scr, r, lane, inptr(1), 0, 1); continue; } r -= I0;
            if (r < I1) { p0_transpose_item(inptr(5), QR, MQ, MQ, (bf16_t*)(ws + WS_WUQ), scr, r, lane, inptr(3)); continue; } r -= I1;
            if (r < I2) { p0_transpose_item(inptr(6), KVR, MKV, MKV, (bf16_t*)(ws + WS_WUKV), scr, r, lane, inptr(4), 0, 2); continue; } r -= I2;
            if (r < I3) { const int k0_ = 64 * (r / 32); p0_transpose_item(inptr(17), 1024, 1024, 1024, (bf16_t*)(ws + WS_WO), scr, r, lane, k0_ < 512 ? inptr(15) : inptr(16) - 512); continue; } r -= I3;
            if (r < I4) { p0_transpose_item(inptr(19), 1024, FF, FF, (bf16_t*)(ws + WS_WUP), scr, r, lane, inptr(18)); continue; } r -= I4;
            if (r < I5) { p0_transpose_item(inptr(20), FF, 1024, 1024, (bf16_t*)(ws + WS_WDN), scr, r, lane, nullptr, LDH); continue; } r -= I5;
            if (r < 2 * I6) { const int kv = r / I6; p0_transpose_item(inptr(12) + (size_t)kv * 2048 * 128, 2048, 128, 128, (bf16_t*)(ws + WS_W1T) + (size_t)kv * 128 * 2048, scr, r % I6, lane); continue; } r -= 2 * I6;
            { const int kv = r / I7; p0_transpose_item(inptr(13) + kv * 128 * 64, 128, 64, 64, (bf16_t*)(ws + WS_W2T) + kv * 64 * 128, scr, r % I7, lane); }
        }
        for (int m = gw; m < M; m += 4 * NGW) rows_to_bf16_rstd<4>(inptr(0), (bf16_t*)(ws + WS_XB), (float*)(ws + WS_RS1), m, NGW, lane);
        for (int e = bid * 512 + tid; e < 2048 * 16; e += G * 512) { const int pos = e >> 4, i = e & 15; const float inv = exp2f(-(float)i * (13.287712379549449f / 16.f)); float sn, cs; sincosf((float)pos * inv, &sn, &cs);
            ((float*)(ws + WS_ROPE))[pos * 32 + i] = cs; ((float*)(ws + WS_ROPE))[pos * 32 + 16 + i] = sn; }
        for (int m = bid * 512 + tid; m < M; m += G * 512) { ((float*)(ws + WS_SSQ2))[m] = 0.f; ((float*)(ws + WS_RSQ))[m] = 0.f; ((float*)(ws + WS_RSKV))[m] = 0.f; ((float*)(ws + WS_SSQKR))[m] = 0.f; ((float*)(ws + WS_SSQM))[2 * m] = 0.f; ((float*)(ws + WS_SSQM))[2 * m + 1] = 0.f; }
    }
    xcd_barrier(bar);
    { pg8::Gemm g{(const bf16_t*)(ws + WS_XB), (const bf16_t*)(ws + WS_WIN), M, DINP, DM, DM, DM}; pg8::StaticOrder S; S.init(M, DINP, G, bid);
      PEpiProj E{(bf16_t*)(ws + WS_PROJ), DINP, (const float*)(ws + WS_RS1), (float*)(ws + WS_RSQ), (float*)(ws + WS_RSKV), (float*)(ws + WS_SSQKR), inptr(9), inptr(10), (const float*)(ws + WS_ROPE), inptr(8)}; pg8::gemm_phase<PEpiProj, pg8::StaticOrder, true, true>(L, g, S, E, wv); }
#define GCTL ((unsigned*)((unsigned char*)inptr(22) + WS_CTL))
#define GCNT(sp, pm) (GCTL + 4096 + ((sp) * 64 + (pm)) * 16)
    if (G == 256) { const int x_ = bid & 7, jj_ = (bid >> 3) & 7, k_ = bid >> 6;
        unsigned* c_ = GCNT(0, 8 * x_ + jj_); group_sync(GCTL, c_, nullptr, nullptr, nullptr, c_, 4u, ((k_ & 1) && jj_ < 7) ? GCNT(0, 8 * x_ + jj_ + 1) : nullptr, 4u); }
    else xcd_barrier(bar);
    { PHASE_IDS();
      __syncthreads();
      if (G == 256) { const int x_ = bid & 7, jj_ = (bid >> 3) & 7, k_ = bid >> 6; compress_block(ws, L, (2 * jj_ + (k_ & 1)) | (x_ << 4) | ((k_ >> 1) << 7), wv); }
      else for (int t = bid; t < 256; t += G) compress_block(ws, L, t, wv); }
    { pg8::Gemm g{(const bf16_t*)(ws + WS_PROJ) + P_HKV, (const bf16_t*)(ws + WS_WUKV), M, MKV, KVR, DINP, KVR}; pg8::StaticOrder S; S.init(M, MKV, G, bid);
      PEpiKV E{(bf16_t*)(ws + WS_KVM), (bf16_t*)(ws + WS_KMLA), (const bf16_t*)(ws + WS_PROJ), (const float*)(ws + WS_RSKV), (const float*)(ws + WS_SSQKR), (const float*)(ws + WS_ROPE), inptr(8)}; pg8::gemm_phase<PEpiKV, pg8::StaticOrder, true, true>(L, g, S, E, wv); }
    asm volatile("" : "+s"(wv));
    { pg8::Gemm g{(const bf16_t*)(ws + WS_PROJ) + P_HQ, (const bf16_t*)(ws + WS_WUQ), M, MQ, QR, DINP, QR}; pg8::StaticOrder S; S.init(M, MQ, G, bid);
      PEpiBf16<0> E{(bf16_t*)(ws + WS_QM), MQ, (const float*)(ws + WS_RSQ), 1.f / QR}; pg8::gemm_phase<PEpiBf16<0>, pg8::StaticOrder, true, false>(L, g, S, E, wv); }
    if (G == 256) { unsigned* c_ = GCNT(3, bid & 7); group_sync<true>(GCTL, c_, nullptr, nullptr, nullptr, c_, 32u, nullptr, 0u); }
    else xcd_barrier(bar);
    {
        PHASE_IDS();
        LAS float* tb = (LAS float*)L;
        for (int i = tid; i < 8 * 128; i += 512) { const int h = i >> 7, n = i & 127; tb[i] = (inptr(14)[t5_bucket(n) * 8 + h] - inptr(14)[31 * 8 + h]) * LOG2E; }
        __syncthreads();
        const int vcu = (G % 8 == 0) ? (bid % 8) * (G / 8) + bid / 8 : bid;
        for (int pr_ = vcu; pr_ < 256; pr_ += G) {
            { const int bg = pr_ >> 4, s_ = pr_ & 15;
#pragma unroll 1
              for (int u_ = 0; u_ < 2; ++u_) att::nsa_unit(ws, L, bg >> 1, bg & 1, (u_ & 1) ? s_ : 31 - s_, wv);
            }
            { const int bh = pr_ >> 2, s_ = pr_ & 3;
#pragma unroll 1
              for (int u_ = 0; u_ < 2; ++u_) att::mla_unit(ws, L, bh >> 3, bh & 7, u_ ? s_ : 7 - s_, wv, u_ ? (4 * (7 - s_) + 4) % att::NSLOT : 0, u_ ? 2 : 0, u_ ? 0 : 2);
            }
        }
    }
    if (G == 256) { const int x_ = bid & 7, j_ = bid >> 3, sn_ = j_ & 15, sm_ = j_ & 3;
        group_sync(GCTL, GCNT(4, 8 * x_ + ((31 - sn_) >> 2)), GCNT(4, 8 * x_ + (sn_ >> 2)), GCNT(4, 8 * x_ + 7 - sm_), GCNT(4, 8 * x_ + sm_), GCNT(4, 8 * x_ + (j_ & 7)), 16u, nullptr, 0u, ws + WS_WO, (int)((size_t)DM * DM * 2 / 16 / 256), wv); }
    else xcd_barrier(bar, ws + WS_WO, (int)((size_t)DM * DM * 2 / 16 / 256), wv);
    { pg8::Gemm g{(const bf16_t*)(ws + WS_MIX), (const bf16_t*)(ws + WS_WO), M, DM, DM, DM, DM}; pg8::StaticOrder S; S.init(M, DM, G, bid);
      PEpiWo E{(const bf16_t*)(ws + WS_XB), (bf16_t*)(ws + WS_H2), (float*)(ws + WS_SSQ2), (const float*)(ws + WS_SSQM), DM}; pg8::gemm_phase<PEpiWo, pg8::StaticOrder, true, true>(L, g, S, E, wv); }
    if (G == 256) { unsigned* c_ = GCNT(1, 8 * (bid & 7) + ((bid >> 3) & 7)); group_sync(GCTL, c_, nullptr, nullptr, nullptr, c_, 4u, nullptr, 0u, ws + WS_WUP, (int)((size_t)FF * DM * 2 / 16 / 256), wv); }
    else xcd_barrier(bar, ws + WS_WUP, (int)((size_t)FF * DM * 2 / 16 / 256), wv);
    { pg8::Gemm g{(const bf16_t*)(ws + WS_H2), (const bf16_t*)(ws + WS_WUP), M, FF, DM, DM, DM}; pg8::StaticOrder S; S.init(M, FF, G, bid);
      PEpiBf16<2> E{(bf16_t*)(ws + WS_HID), LDH, (const float*)(ws + WS_SSQ2), 1.f / 1024}; pg8::gemm_phase<PEpiBf16<2>, pg8::StaticOrder, true, true>(L, g, S, E, wv); }
    if (G == 256) { unsigned* c_ = GCNT(2, 8 * (bid & 7) + ((bid >> 3) & 7)); group_sync(GCTL, c_, nullptr, nullptr, nullptr, c_, 4u, nullptr, 0u, ws + WS_WDN, (int)((size_t)DM * LDH * 2 / 16 / 256), wv); }
    else xcd_barrier(bar, ws + WS_WDN, (int)((size_t)DM * LDH * 2 / 16 / 256), wv);
    { pg8::Gemm g{(const bf16_t*)(ws + WS_HID), (const bf16_t*)(ws + WS_WDN), M, DM, FF, LDH, LDH}; pg8::StaticOrder S; S.init(M, DM, G, bid);
      PEpiDown E{(const bf16_t*)(ws + WS_H2), ((float*)inptr(21)), DM}; pg8::gemm_phase<PEpiDown, pg8::StaticOrder, true, true>(L, g, S, E, wv); }
#undef bar
}

extern "C" void kernel_launch(void* const* d_in, const int* in_sizes, int n_in, void* d_out, int out_size,
                              void* d_ws, size_t ws_size, hipStream_t stream) {
    static int grid_blocks = 0;
    if (!grid_blocks) {
        int dev = 0, cus = 0, per_cu = 0;
        (void)hipGetDevice(&dev);
        (void)hipDeviceGetAttribute(&cus, hipDeviceAttributeMultiprocessorCount, dev);
        (void)hipFuncSetAttribute((const void*)mega, hipFuncAttributeMaxDynamicSharedMemorySize, LDS_BYTES);
        (void)hipOccupancyMaxActiveBlocksPerMultiprocessor(&per_cu, (const void*)mega, 512, LDS_BYTES);
        if (per_cu != 1) fprintf(stderr, "note: occupancy query reports %d blocks/CU; launching 1 per CU\n", per_cu);
        grid_blocks = cus;
        if (n_in != 21 || out_size != M * DM || ws_size < 256 * MiB) fprintf(stderr, "unexpected shapes: n_in %d out %d ws %zu\n", n_in, out_size, ws_size);
    }
    Params p{};
    for (int i = 0; i < 21; ++i) p.in[i] = (const float*)d_in[i];
    p.out = (float*)d_out; p.ws = (unsigned char*)d_ws;
    if (hipMemsetAsync((char*)d_ws + WS_CTL, 0, CTL_ZERO_BYTES, stream) != hipSuccess) { fprintf(stderr, "memset of the barrier words failed\n"); return; }
    hipLaunchKernelGGL(mega, dim3(grid_blocks), dim3(512), LDS_BYTES, stream, p);
    hipError_t e = hipPeekAtLastError();
    if (e != hipSuccess) fprintf(stderr, "launch failed: %s (grid %d)\n", hipGetErrorString(e), grid_blocks);
}
```

```cpp
#include <hip/hip_runtime.h>
#include <cstdio>
#include <cstdint>

#define LAS __attribute__((address_space(3)))
typedef unsigned short bf16_t;
typedef short bf16x8 __attribute__((ext_vector_type(8)));
typedef float f32x4 __attribute__((ext_vector_type(4)));
typedef unsigned u32x4 __attribute__((ext_vector_type(4)));
typedef unsigned u32x2 __attribute__((ext_vector_type(2)));

constexpr int BATCH = 8, SEQ = 2048, DM = 1024, M = BATCH * SEQ;
constexpr int DIN = 1976, DINP = 2048;
constexpr int C_HQ = 0, C_HKV = 384, C_HKR = 640, C_QB = 672, C_KVB = 1184, C_GATE = 1952;
constexpr int C_KCMP = C_KVB, C_VCMP = C_KVB + 128, C_KSEL = C_KVB + 256, C_VSEL = C_KVB + 384, C_KWIN = C_KVB + 512, C_VWIN = C_KVB + 640;
constexpr int P_HQ = 1280, P_HKV = 1664, P_HKR = 1920, P_GATE = 1952;
__host__ __device__ constexpr int slot_base(int s) { return 256 * (s >> 2) + 32 * (s & 3); }
constexpr int S_Q = 0, S_KCMP = 8, S_VCMP = 10, S_KSEL = 12, S_VSEL = 14, S_KWIN = 16, S_VWIN = 18;
constexpr int QR = 384, KVR = 256, MQ = 768, MKV = 1024, FF = 4096;
constexpr int LDH = FF + 64;
constexpr int NCMP = 127;
constexpr float EPS = 1e-6f;
constexpr float LOG2E = 1.4426950408889634f;
constexpr float QS_MLA = 0.10206207261596577f * LOG2E;
constexpr float QS_NSA = 0.125f * LOG2E;

constexpr size_t MiB = 1u << 20;
constexpr size_t WS_CTL = 0, CTL_ZERO_BYTES = 65536;
constexpr size_t WS_WIN = 1 * MiB, WS_WUQ = 5 * MiB, WS_WUKV = 6 * MiB, WS_WO = 7 * MiB, WS_WUP = 9 * MiB, WS_WDN = 17 * MiB;
constexpr size_t WS_KCMP = 26 * MiB, WS_VCMP = 26 * MiB + 512 * 1024;
constexpr size_t WS_W1T = 30 * MiB;
constexpr size_t WS_W2T = 27 * MiB;
constexpr size_t WS_RSQ = 28 * MiB, WS_RSKV = 28 * MiB + 65536, WS_SSQ2 = 28 * MiB + 131072, WS_SSQM = 28 * MiB + 262144, WS_RS1 = 28 * MiB + 262144 + 131072;
constexpr size_t WS_SSQKR = 28 * MiB + 524288;
constexpr size_t WS_ROPE = 29 * MiB + 65536;
constexpr size_t WS_XB = 32 * MiB;
constexpr size_t WS_DUMMY0 = 0;
constexpr size_t WS_HB = 32 * MiB;
constexpr size_t WS_MIX = 64 * MiB;
constexpr size_t WS_PROJ = 96 * MiB;
constexpr size_t WS_QM = 160 * MiB;
constexpr size_t WS_KVM = 184 * MiB;
constexpr size_t WS_KMLA = 216 * MiB;
constexpr size_t WS_QN = 208 * MiB;
constexpr size_t WS_KSEL = 240 * MiB;
constexpr size_t WS_KWIN = 244 * MiB;
constexpr size_t WS_HQN = 232 * MiB;
constexpr size_t WS_HKVN = 244 * MiB;
constexpr size_t WS_H2 = 224 * MiB;
constexpr size_t WS_HID = 32 * MiB;

constexpr int LDS_BYTES = 155648, LDS_BST = 154624;
constexpr int NW = 8;

struct Params {
    const float* in[21];
    float* out;
    unsigned char* ws;
};

typedef const float* cfptr_t;
__device__ __forceinline__ const float* inptr(int i) {
    const __attribute__((address_space(4))) char* ka = (const __attribute__((address_space(4))) char*)__builtin_amdgcn_kernarg_segment_ptr();
    int off = i * 8; asm volatile("" : "+s"(off));
    return *(const __attribute__((address_space(4))) cfptr_t*)(ka + off);
}
template <class V> __device__ __forceinline__ void st16_wt(const void* sbase, unsigned voff, const V& v) { static_assert(sizeof(V) == 16, "16-byte vector"); asm volatile("global_store_dwordx4 %0, %1, %2 sc1\n\ts_nop 1" :: "v"(voff), "v"(v), "s"(sbase) : "memory"); }
__device__ __forceinline__ unsigned f2bf(float f) { unsigned u = __builtin_bit_cast(unsigned, f); return (u + 0x7fffu + ((u >> 16) & 1u)) >> 16; }
__device__ __forceinline__ float bf2f(unsigned b) { return __builtin_bit_cast(float, b << 16); }
__device__ __forceinline__ unsigned pk2(float lo, float hi) { return f2bf(lo) | (f2bf(hi) << 16); }
__device__ __forceinline__ float wave_sum(float v) {
#pragma unroll
    for (int o = 1; o < 64; o <<= 1) v += __shfl_xor(v, o);
    return v;
}
__device__ __forceinline__ int t5_bucket(int n) {
    if (n < 16) return n;
    int b = 16;
    b += (n >= 19); b += (n >= 21); b += (n >= 24); b += (n >= 27); b += (n >= 31); b += (n >= 35); b += (n >= 40); b += (n >= 46);
    b += (n >= 52); b += (n >= 59); b += (n >= 67); b += (n >= 77); b += (n >= 87); b += (n >= 99); b += (n >= 113);
    return b;
}

__device__ __forceinline__ void p0_transpose_item(const float* W, int K, int N, int Npad, bf16_t* WT, LAS float* scr, int item, int lane, const float* gk = nullptr, int ldw = 0, int projmap = 0) {
    const int nblk = Npad / 32, kb = item / nblk, nb = item % nblk, k0 = 64 * kb, n0 = 32 * nb;
    int nsrc = n0;
    if (projmap == 2) { const int pn_ = n0 >> 8, bj_ = (n0 >> 7) & 1, wc_ = (n0 >> 5) & 3; nsrc = (wc_ < 2 ? 128 * (2 * pn_ + wc_) : 128 * (2 * pn_ + wc_ - 2) + 64) + 32 * bj_; }
    else if (projmap == 1) { if (n0 < 1280) { const int sl = 4 * (n0 >> 8) + ((n0 & 127) >> 5), e0 = 32 * ((n0 >> 7) & 1); nsrc = (sl < 8 ? C_QB + 64 * sl : C_KVB + 64 * (sl - 8)) + e0; }
                   else if (n0 < 1280 + 672) nsrc = n0 - 1280; else if (n0 == P_GATE) nsrc = C_GATE; else nsrc = N; }
    const int nn = nsrc + (lane & 31);
    float wv[32];
#pragma unroll
    for (int i = 0; i < 32; ++i) { const int kk = 2 * i + (lane >> 5); wv[i] = (nn < N) ? W[(size_t)(k0 + kk) * N + nn] : 0.f; }
#pragma unroll
    for (int i = 0; i < 32; ++i) { const int kk = 2 * i + (lane >> 5); const float gg = gk ? gk[k0 + kk] : 1.f; scr[kk * 33 + (lane & 31)] = wv[i] * gg; }
    asm volatile("s_waitcnt lgkmcnt(0)" ::: "memory");
    const int c = lane & 7;
#pragma unroll
    for (int j = 0; j < 4; ++j) { const int n = (lane >> 3) + 8 * j; const LAS float* s = scr + (8 * c) * 33 + n;
        u32x4 o; o.x = pk2(s[0 * 33], s[1 * 33]); o.y = pk2(s[2 * 33], s[3 * 33]); o.z = pk2(s[4 * 33], s[5 * 33]); o.w = pk2(s[6 * 33], s[7 * 33]);
        if (projmap == 3) { const int nn_ = n0 + n, k_ = k0 + 8 * c;
            *(u32x4*)(WT + ((size_t)(((k_ >> 5) * (Npad >> 4) + (nn_ >> 4)) * 64 + ((k_ >> 3) & 3) * 16 + (nn_ & 15))) * 8) = o; }
        else *(u32x4*)(WT + (size_t)(n0 + n) * (ldw ? ldw : K) + k0 + 8 * c) = o; }
    asm volatile("s_waitcnt lgkmcnt(0)" ::: "memory");
}
template <int NR>
__device__ __forceinline__ void rows_to_bf16_rstd(const float* x, bf16_t* o, float* rstd_out, int row0, int rstride, int lane) {
    f32x4 v[NR][4];
#pragma unroll
    for (int r = 0; r < NR; ++r) { const int rr = (row0 + r * rstride < M) ? row0 + r * rstride : row0; const f32x4* xr = (const f32x4*)(x + (size_t)rr * DM) + lane;
#pragma unroll
        for (int j = 0; j < 4; ++j) v[r][j] = xr[64 * j]; }
#pragma unroll
    for (int r = 0; r < NR; ++r) { if (row0 + r * rstride >= M) continue; float s = 0.f;
#pragma unroll
        for (int j = 0; j < 4; ++j) s += (v[r][j].x * v[r][j].x + v[r][j].y * v[r][j].y) + (v[r][j].z * v[r][j].z + v[r][j].w * v[r][j].w);
        s = wave_sum(s);
        if (lane == 0) rstd_out[row0 + r * rstride] = 1.f / sqrtf(s * (1.f / DM) + EPS);
        unsigned long long* o8 = (unsigned long long*)(o + (size_t)(row0 + r * rstride) * DM) + lane;
#pragma unroll
        for (int j = 0; j < 4; ++j) o8[64 * j] = (unsigned long long)pk2(v[r][j].x, v[r][j].y) | ((unsigned long long)pk2(v[r][j].z, v[r][j].w) << 32); }
}

__device__ __forceinline__ int opaque_tid(int wv) { int lane; asm volatile("v_mbcnt_lo_u32_b32 %0, -1, 0\n\tv_mbcnt_hi_u32_b32 %0, -1, %0" : "=v"(lane)); return (wv << 6) | lane; }
namespace pg8 {
#define PG8_LAS __attribute__((address_space(3)))
typedef unsigned short bf16_t;
typedef short bf16x8 __attribute__((ext_vector_type(8)));
typedef float f32x4 __attribute__((ext_vector_type(4)));
typedef unsigned u32x4 __attribute__((ext_vector_type(4)));
constexpr int BM = 256, BK = 64, HALF = 128, HTB = HALF * BK * 2  , STAGE_BYTES = 8 * HTB, NXCD = 8, WGM = 8;

__host__ __device__ __forceinline__ int lds_byte(int r, int c) { const int st = (r >> 4) * 2 + (c >> 5), rr = r & 15, cc = c & 31, ob = rr * 64 + cc * 2; return st * 1024 + (ob ^ (((ob >> 9) & 1) << 5)); }
__host__ __device__ __forceinline__ void stage_rc(int b, int& R, int& C) { const int st = b / 1024, sb = b % 1024, swz = sb ^ (((sb >> 9) & 1) << 5); R = (st >> 1) * 16 + swz / 64; C = (st & 1) * 32 + (swz % 64) / 2; }
__host__ __device__ __forceinline__ int perm32(int rho) { const int n = rho >> 4, i = rho & 15; return 8 * (i >> 2) + 4 * n + (i & 3); }

struct Unit { int pm, pn; };
struct Gemm { const bf16_t* A; const bf16_t* Bt; int M, N, K, lda, ldb; };

struct StaticOrder {
    int nM, nN, nwg, G, c;
    __host__ __device__ void init(int M, int N, int G_, int c_) { nM = M / BM; nN = N / BM; nwg = nM * nN; G = G_; c = c_; }
    __host__ __device__ bool next(int i, Unit& u) const {
        const long L = (long)i * G + c; if (L >= nwg) return false;
        int wgid = (int)L; { const int q = nwg / NXCD, r = nwg % NXCD, xcd = wgid % NXCD, off = wgid / NXCD; wgid = (xcd < r ? xcd * (q + 1) : r * (q + 1) + (xcd - r) * q) + off; }
        const int nig = WGM * nN, gid = wgid / nig, fm = gid * WGM, gsz = (nM - fm) < WGM ? (nM - fm) : WGM;
        u.pm = fm + ((wgid % nig) % gsz); u.pn = (wgid % nig) / gsz; return true;
    }
    __device__ __forceinline__ void a_ready(const Unit&) const {}
    __device__ __forceinline__ void done(const Unit&) const {}
};

template <class Epi, class Sched, bool ALIGN_EPI = false, bool SP2 = false>
__device__ __forceinline__ void gemm_phase(PG8_LAS unsigned char* lds, const Gemm g, const Sched& S, const Epi& E, int wv) {
    const int tid = opaque_tid(wv), wid = __builtin_amdgcn_readfirstlane(tid >> 6), lane = tid & 63, wr = wid >> 2, wc = wid & 3, fr = lane & 15, fq = lane >> 4;
    const int K = g.K, nt = K / BK;
    unsigned voffA[2], voffB[2];
#pragma unroll
    for (int i = 0; i < 2; ++i) { int R, C; stage_rc(tid * 16 + i * 8192, R, C); const int Rb = Epi::PERM ? ((R & ~31) + perm32(R & 31)) : R;
        voffA[i] = (unsigned)(R * g.lda + C) * 2u; voffB[i] = (unsigned)(Rb * g.ldb + C) * 2u; }
    const size_t kstep = (size_t)(BK * 2);
    const size_t hstepA = (size_t)HALF * g.lda * 2, hstepB = (size_t)HALF * g.ldb * 2;
    const size_t tstepA = 2 * hstepA, tstepB = 2 * hstepB;
    const unsigned ldsw = (unsigned)wid * 1024u;
    const int aoff = lds_byte(wr * 64 + fr, fq * 8), boff = lds_byte(wc * 32 + fr, fq * 8);
#define PG8_SA(b, h) (((b) * 2 + (h)) * HTB)
#define PG8_SB(b, h) ((4 + (b) * 2 + (h)) * HTB)
#define PG8_STAGE(bufoff, gbase, voff) do { _Pragma("unroll") for (int _i = 0; _i < 2; ++_i) \
        __builtin_amdgcn_global_load_lds((const unsigned*)((const char*)(gbase) + (voff)[_i]), (PG8_LAS unsigned*)(lds + (bufoff) + ldsw + _i * 8192), 16, 0, 0); } while (0)
#define PG8_LDA(dst, b, h) do { _Pragma("unroll") for (int m = 0; m < 4; ++m) _Pragma("unroll") for (int k = 0; k < 2; ++k) dst[m][k] = *(const PG8_LAS bf16x8*)(lds + PG8_SA(b, h) + aoff + m * 2048 + k * 1024); } while (0)
#define PG8_LDB(dst, b, h) do { _Pragma("unroll") for (int n = 0; n < 2; ++n) _Pragma("unroll") for (int k = 0; k < 2; ++k) dst[n][k] = *(const PG8_LAS bf16x8*)(lds + PG8_SB(b, h) + boff + n * 2048 + k * 1024); } while (0)
#define PG8_MMA(ai, bj, At, Bt) do { __builtin_amdgcn_s_setprio(1); _Pragma("unroll") for (int m = 0; m < 4; ++m) _Pragma("unroll") for (int n = 0; n < 2; ++n) _Pragma("unroll") for (int k = 0; k < 2; ++k) \
        acc[ai][bj][m][n] = __builtin_amdgcn_mfma_f32_16x16x32_bf16(Bt[n][k], At[m][k], acc[ai][bj][m][n], 0, 0, 0); __builtin_amdgcn_s_setprio(0); } while (0)
#define PG8_WAIT_V(n) asm volatile("s_waitcnt vmcnt(" #n ")" ::: "memory")
#define PG8_WAIT_L(n) asm volatile("s_waitcnt lgkmcnt(" #n ")" ::: "memory")
#define PG8_BAR __builtin_amdgcn_s_barrier()
#define PG8_SCHED __builtin_amdgcn_sched_barrier(0)
    Unit cur, nxt; int ui = 0;
    if (!S.next(0, cur)) return;
    f32x4 acc[2][2][4][2];
#pragma unroll
    for (int a = 0; a < 2; ++a)
#pragma unroll
        for (int b = 0; b < 2; ++b)
#pragma unroll
            for (int m = 0; m < 4; ++m)
#pragma unroll
                for (int n = 0; n < 2; ++n) acc[a][b][m][n] = (f32x4){0.f, 0.f, 0.f, 0.f};
    bf16x8 At[4][2], B0[2][2], B1[2][2];
    const char* cA = (const char*)g.A + (size_t)cur.pm * tstepA; const char* cB = (const char*)g.Bt + (size_t)cur.pn * tstepB;
    asm volatile("" : "+s"(cA), "+s"(cB));
    S.a_ready(cur);
    if constexpr (SP2) {
        PG8_STAGE(PG8_SB(0, 0), cB, voffB); PG8_STAGE(PG8_SB(0, 1), cB + hstepB, voffB); PG8_STAGE(PG8_SA(0, 0), cA, voffA); PG8_STAGE(PG8_SA(0, 1), cA + hstepA, voffA);
        if (wr == 1) PG8_BAR;
        PG8_WAIT_V(2); PG8_BAR;
        PG8_STAGE(PG8_SB(1, 0), cB + kstep, voffB); PG8_STAGE(PG8_SA(1, 0), cA + kstep, voffA); PG8_STAGE(PG8_SB(1, 1), cB + hstepB + kstep, voffB);
        PG8_WAIT_V(6); PG8_BAR;
    } else {
        PG8_STAGE(PG8_SB(0, 0), cB, voffB); PG8_STAGE(PG8_SA(0, 0), cA, voffA); PG8_STAGE(PG8_SB(0, 1), cB + hstepB, voffB); PG8_STAGE(PG8_SA(0, 1), cA + hstepA, voffA);
        if (wr == 1) PG8_BAR;
        PG8_WAIT_V(4); PG8_BAR;
        PG8_STAGE(PG8_SB(1, 0), cB + kstep, voffB); PG8_STAGE(PG8_SA(1, 0), cA + kstep, voffA); PG8_STAGE(PG8_SB(1, 1), cB + hstepB + kstep, voffB);
        PG8_WAIT_V(6); PG8_BAR;
    }
    for (;;) {
        const bool has_next = S.next(ui + 1, nxt);
        const char* nA = has_next ? (const char*)g.A + (size_t)nxt.pm * tstepA : cA; const char* nB = has_next ? (const char*)g.Bt + (size_t)nxt.pn * tstepB : cB;
        asm volatile("" : "+s"(nA), "+s"(nB));
        for (int t = 0; t < nt; t += 2) {
            if constexpr (Epi::MIDSCALE) { if (t == nt / 2) E.midscale(acc, cur, wr, fr); }
            const bool last = (t == nt - 2);
            const char* a1 = cA + (size_t)(t + 1) * kstep;
            const char* a2 = last ? nA : cA + (size_t)(t + 2) * kstep; const char* b2 = last ? nB : cB + (size_t)(t + 2) * kstep;
            const char* a3 = a2 + kstep; const char* b3 = b2 + kstep;
            asm volatile("" : "+s"(a1), "+s"(a2), "+s"(b2), "+s"(a3), "+s"(b3));
            if (last && has_next) S.a_ready(nxt);
            if constexpr (SP2) {
            PG8_LDB(B0, 0, 0); PG8_LDB(B1, 0, 1); PG8_SCHED; PG8_LDA(At, 0, 0); PG8_STAGE(PG8_SA(1, 1), a1 + hstepA, voffA);
            PG8_WAIT_V(8); PG8_WAIT_L(0); PG8_BAR; PG8_MMA(0, 0, At, B0); PG8_MMA(0, 1, At, B1); PG8_BAR; PG8_SCHED;
            PG8_LDA(At, 0, 1); PG8_STAGE(PG8_SB(0, 0), b2, voffB); PG8_STAGE(PG8_SB(0, 1), b2 + hstepB, voffB); PG8_STAGE(PG8_SA(0, 0), a2, voffA);
            PG8_WAIT_V(8); PG8_WAIT_L(0); PG8_BAR; PG8_MMA(1, 0, At, B0); PG8_MMA(1, 1, At, B1); PG8_BAR; PG8_SCHED;
            PG8_LDB(B0, 1, 0); PG8_LDB(B1, 1, 1); PG8_SCHED; PG8_LDA(At, 1, 0); PG8_STAGE(PG8_SA(0, 1), a2 + hstepA, voffA);
            PG8_WAIT_V(8); PG8_WAIT_L(0); PG8_BAR; PG8_MMA(0, 0, At, B0); PG8_MMA(0, 1, At, B1); PG8_BAR; PG8_SCHED;
            PG8_LDA(At, 1, 1); PG8_STAGE(PG8_SB(1, 0), b3, voffB); PG8_STAGE(PG8_SB(1, 1), b3 + hstepB, voffB); PG8_STAGE(PG8_SA(1, 0), a3, voffA);
            PG8_WAIT_V(8); PG8_WAIT_L(0); PG8_BAR; PG8_MMA(1, 0, At, B0); PG8_MMA(1, 1, At, B1); PG8_BAR; PG8_SCHED;
            } else {
            PG8_LDB(B0, 0, 0); PG8_SCHED; PG8_LDA(At, 0, 0); PG8_STAGE(PG8_SA(1, 1), a1 + hstepA, voffA);
            PG8_WAIT_L(8); PG8_BAR; PG8_WAIT_L(0); PG8_MMA(0, 0, At, B0); PG8_BAR; PG8_SCHED;
            PG8_LDB(B1, 0, 1); PG8_STAGE(PG8_SB(0, 0), b2, voffB);
            PG8_BAR; PG8_WAIT_L(0); PG8_MMA(0, 1, At, B1); PG8_BAR;
            PG8_LDA(At, 0, 1); PG8_STAGE(PG8_SA(0, 0), a2, voffA);
            PG8_BAR; PG8_WAIT_L(0); PG8_MMA(1, 0, At, B0); PG8_BAR; PG8_SCHED;
            PG8_STAGE(PG8_SB(0, 1), b2 + hstepB, voffB);
            PG8_WAIT_V(6); PG8_BAR; PG8_MMA(1, 1, At, B1); PG8_BAR;
            PG8_LDB(B0, 1, 0); PG8_SCHED; PG8_LDA(At, 1, 0); PG8_STAGE(PG8_SA(0, 1), a2 + hstepA, voffA);
            PG8_WAIT_L(8); PG8_BAR; PG8_WAIT_L(0); PG8_MMA(0, 0, At, B0); PG8_BAR; PG8_SCHED;
            PG8_LDB(B1, 1, 1); PG8_STAGE(PG8_SB(1, 0), b3, voffB);
            PG8_BAR; PG8_WAIT_L(0); PG8_MMA(0, 1, At, B1); PG8_BAR;
            PG8_LDA(At, 1, 1); PG8_STAGE(PG8_SA(1, 0), a3, voffA);
            PG8_BAR; PG8_WAIT_L(0); PG8_MMA(1, 0, At, B0); PG8_BAR; PG8_SCHED;
            PG8_STAGE(PG8_SB(1, 1), b3 + hstepB, voffB);
            PG8_WAIT_V(6); PG8_BAR; PG8_MMA(1, 1, At, B1); PG8_BAR;
            }
        }
        if constexpr (ALIGN_EPI) { if (wr == 0) PG8_BAR; }
        if constexpr (!Epi::AFTER_DRAIN) { const int l2_ = opaque_tid(wv) & 63; E(acc, cur, wr, wc, l2_ & 15, l2_ >> 4); S.done(cur); }
        if (!has_next) break;
#pragma unroll
        for (int a = 0; a < 2; ++a)
#pragma unroll
            for (int b = 0; b < 2; ++b)
#pragma unroll
                for (int m = 0; m < 4; ++m)
#pragma unroll
                    for (int n = 0; n < 2; ++n) acc[a][b][m][n] = (f32x4){0.f, 0.f, 0.f, 0.f};
        cur = nxt; cA = nA; cB = nB; ++ui;
        if constexpr (ALIGN_EPI) { if (wr == 1) PG8_BAR; }
    }
    PG8_WAIT_V(0);
    if constexpr (!ALIGN_EPI) { if (wr == 0) PG8_BAR; }
    PG8_BAR;
    if constexpr (Epi::AFTER_DRAIN) { E.fused(acc, cur, wr, wc, fr, fq, lds, wid, lane); S.done(cur); }
#undef PG8_SA
#undef PG8_SB
#undef PG8_STAGE
#undef PG8_LDA
#undef PG8_LDB
#undef PG8_MMA
#undef PG8_WAIT_V
#undef PG8_WAIT_L
#undef PG8_BAR
#undef PG8_SCHED
}
}

__device__ __forceinline__ unsigned cvt_pk_bf16(float lo, float hi) { unsigned r; asm volatile("v_cvt_pk_bf16_f32 %0, %1, %2" : "=v"(r) : "v"(lo), "v"(hi)); return r; }
template <int ACT> struct PEpiBf16 {
    static constexpr bool PERM = true, AFTER_DRAIN = false, MIDSCALE = false;
    bf16_t* O; int ldc; const float* rs; float invn;
    __device__ __forceinline__ void operator()(const f32x4 (&acc)[2][2][4][2], const pg8::Unit& u, int wr, int wc, int fr, int fq) const {
        const int row0 = u.pm * 256 + wr * 64 + fr, col0 = u.pn * 256 + wc * 32 + 8 * fq;
        float rsc[2][4];
#pragma unroll
        for (int ai = 0; ai < 2; ++ai)
#pragma unroll
            for (int m = 0; m < 4; ++m) rsc[ai][m] = rs ? rs[row0 + ai * 128 + m * 16] : 1.f;
        if (invn > 0.f) {
#pragma unroll
            for (int ai = 0; ai < 2; ++ai)
#pragma unroll
                for (int m = 0; m < 4; ++m) rsc[ai][m] = 1.f / sqrtf(rsc[ai][m] * invn + EPS); }
#pragma unroll
        for (int ai = 0; ai < 2; ++ai)
#pragma unroll
            for (int m = 0; m < 4; ++m) { const bf16_t* rowp = O + ((size_t)(u.pm * 256 + wr * 64 + ai * 128 + m * 16) * ldc + u.pn * 256 + wc * 32); const unsigned lo_ = (unsigned)(fr * ldc + 8 * fq) * 2u; const float sc_ = rsc[ai][m];
#pragma unroll
                for (int bj = 0; bj < 2; ++bj) { f32x4 v0 = acc[ai][bj][m][0] * sc_, v1 = acc[ai][bj][m][1] * sc_;
                    if (ACT == 2) {
#pragma unroll
                        for (int e = 0; e < 4; ++e) { const float a = fmaxf(v0[e], 0.f), b = fmaxf(v1[e], 0.f); v0[e] = a * a; v1[e] = b * b; } }
                    u32x4 w; w.x = cvt_pk_bf16(v0[0], v0[1]); w.y = cvt_pk_bf16(v0[2], v0[3]); w.z = cvt_pk_bf16(v1[0], v1[1]); w.w = cvt_pk_bf16(v1[2], v1[3]);
                    st16_wt(rowp + bj * 128, lo_, w); } }
    }
};
struct PEpiProj {
    static constexpr bool PERM = true, AFTER_DRAIN = false, MIDSCALE = false;
    bf16_t* O; int ldc; const float* rs1; float* ssq_q; float* ssq_kv; float* ssq_kr; const float* qgain; const float* kgain; const float* rope; const float* kgm;
    __device__ __forceinline__ void operator()(const f32x4 (&acc)[2][2][4][2], const pg8::Unit& u, int wr, int wc, int fr, int fq) const {
        const int row0 = u.pm * 256 + wr * 64 + fr, col0 = u.pn * 256 + wc * 32 + 8 * fq, lane = fq * 16 + fr;
        float rsc[2][4];
#pragma unroll
        for (int ai = 0; ai < 2; ++ai)
#pragma unroll
            for (int m = 0; m < 4; ++m) rsc[ai][m] = rs1[row0 + ai * 128 + m * 16];
        const int sl = 4 * u.pn + wc;
        int mode = 0; const float* g = nullptr; float gs = 1.f;
        if (u.pn < 5) { if (sl < 8) { mode = 1; g = qgain; gs = QS_NSA; } else if (sl == S_KSEL || sl == S_KSEL + 1) { mode = 1; g = kgain + 64; } else if (sl == S_KWIN || sl == S_KWIN + 1) { mode = 1; g = kgain + 128; } }
        f32x4 ga[2][2];
        if (mode == 1) {
#pragma unroll
            for (int bj = 0; bj < 2; ++bj) { ga[bj][0] = *(const f32x4*)(g + 32 * bj + 8 * fq) * gs; ga[bj][1] = *(const f32x4*)(g + 32 * bj + 8 * fq + 4) * gs; } }
#pragma unroll
        for (int ai = 0; ai < 2; ++ai)
#pragma unroll
            for (int m = 0; m < 4; ++m) { const int row = row0 + ai * 128 + m * 16; const bf16_t* rowp = O + ((size_t)(u.pm * 256 + wr * 64 + ai * 128 + m * 16) * ldc + u.pn * 256 + wc * 32); const unsigned lo_ = (unsigned)(fr * ldc + 8 * fq) * 2u; const float sc_ = rsc[ai][m];
                f32x4 v[2][2];
#pragma unroll
                for (int bj = 0; bj < 2; ++bj) { v[bj][0] = acc[ai][bj][m][0] * sc_; v[bj][1] = acc[ai][bj][m][1] * sc_; }
                if (mode == 1) {
                    float ss = 0.f;
#pragma unroll
                    for (int bj = 0; bj < 2; ++bj)
#pragma unroll
                        for (int n = 0; n < 2; ++n) ss += (v[bj][n][0] * v[bj][n][0] + v[bj][n][1] * v[bj][n][1]) + (v[bj][n][2] * v[bj][n][2] + v[bj][n][3] * v[bj][n][3]);
                    ss += __builtin_bit_cast(float, __builtin_amdgcn_ds_bpermute((lane ^ 16) << 2, __builtin_bit_cast(int, ss)));
                    ss += __builtin_bit_cast(float, __builtin_amdgcn_ds_bpermute((lane ^ 32) << 2, __builtin_bit_cast(int, ss)));
                    const float rstd = 1.f / sqrtf(ss * (1.f / 64) + EPS);
#pragma unroll
                    for (int bj = 0; bj < 2; ++bj) { v[bj][0] = v[bj][0] * rstd * ga[bj][0]; v[bj][1] = v[bj][1] * rstd * ga[bj][1]; }
                } else if (u.pn >= 5) {
#pragma unroll
                    for (int bj = 0; bj < 2; ++bj) { const int cb = u.pn * 256 + bj * 128;
                        float* dst = (cb < P_HKV) ? ssq_q : (cb < P_HKR ? ssq_kv : ((cb == P_HKR && wc == 0) ? ssq_kr : nullptr));
                        if (dst) { float ss = (v[bj][0][0] * v[bj][0][0] + v[bj][0][1] * v[bj][0][1]) + (v[bj][0][2] * v[bj][0][2] + v[bj][0][3] * v[bj][0][3]) + (v[bj][1][0] * v[bj][1][0] + v[bj][1][1] * v[bj][1][1]) + (v[bj][1][2] * v[bj][1][2] + v[bj][1][3] * v[bj][1][3]);
                            ss += __builtin_bit_cast(float, __builtin_amdgcn_ds_bpermute((lane ^ 16) << 2, __builtin_bit_cast(int, ss)));
                            ss += __builtin_bit_cast(float, __builtin_amdgcn_ds_bpermute((lane ^ 32) << 2, __builtin_bit_cast(int, ss)));
                            if (fq == 0) __hip_atomic_fetch_add(dst + row, ss, __ATOMIC_RELAXED, __HIP_MEMORY_SCOPE_AGENT); }
                        if (cb == P_HKR && wc == 0) {
                            const f32x4 g0 = *(const f32x4*)(kgm + 64 + 8 * fq), g1 = *(const f32x4*)(kgm + 64 + 8 * fq + 4);
                            const float* rp = rope + (size_t)(row & (SEQ - 1)) * 32 + 8 * (fq & 1);
                            const f32x4 c0 = *(const f32x4*)rp, c1 = *(const f32x4*)(rp + 4), s0 = *(const f32x4*)(rp + 16), s1 = *(const f32x4*)(rp + 20);
#pragma unroll
                            for (int n = 0; n < 2; ++n)
#pragma unroll
                                for (int j = 0; j < 4; ++j) { const float nv = v[bj][n][j] * (n ? g1[j] : g0[j]);
                                    const float pv = __builtin_bit_cast(float, __builtin_amdgcn_ds_bpermute((lane ^ 32) << 2, __builtin_bit_cast(int, nv)));
                                    const float cs = n ? c1[j] : c0[j], sn = n ? s1[j] : s0[j]; v[bj][n][j] = (fq < 2) ? nv * cs - pv * sn : nv * cs + pv * sn; } } }
                }
#pragma unroll
                for (int bj = 0; bj < 2; ++bj) { u32x4 w; w.x = cvt_pk_bf16(v[bj][0][0], v[bj][0][1]); w.y = cvt_pk_bf16(v[bj][0][2], v[bj][0][3]); w.z = cvt_pk_bf16(v[bj][1][0], v[bj][1][1]); w.w = cvt_pk_bf16(v[bj][1][2], v[bj][1][3]);
                    st16_wt(rowp + bj * 128, lo_, w); } }
    }
};
struct PEpiKV {
    static constexpr bool PERM = true, AFTER_DRAIN = false, MIDSCALE = false;
    bf16_t* V; bf16_t* K; const bf16_t* proj; const float* ssq_kv; const float* ssq_kr; const float* rope; const float* kgain;
    __device__ __forceinline__ void operator()(const f32x4 (&acc)[2][2][4][2], const pg8::Unit& u, int wr, int wc, int fr_, int fq_) const {
        int fr = fr_, fq = fq_; asm volatile("" : "+v"(fr), "+v"(fq)); const float* kgain = this->kgain; asm volatile("" : "+s"(kgain)); const float* rope = this->rope; asm volatile("" : "+s"(rope));
        const int row0 = u.pm * 256 + wr * 64 + fr, lane = fq * 16 + fr;
        float rsc[2][4];
#pragma unroll
        for (int ai = 0; ai < 2; ++ai)
#pragma unroll
            for (int m = 0; m < 4; ++m) rsc[ai][m] = 1.f / sqrtf(ssq_kv[row0 + ai * 128 + m * 16] * (1.f / KVR) + EPS);
        if (wc >= 2) {
            const int col0 = u.pn * 256 + wc * 32 + 8 * fq;
#pragma unroll
            for (int ai = 0; ai < 2; ++ai)
#pragma unroll
                for (int m = 0; m < 4; ++m) { const bf16_t* rowp = V + ((size_t)(u.pm * 256 + wr * 64 + ai * 128 + m * 16) * MKV + u.pn * 256 + wc * 32); const unsigned lo_ = (unsigned)(fr * MKV + 8 * fq) * 2u; const float sc_ = rsc[ai][m];
#pragma unroll
                    for (int bj = 0; bj < 2; ++bj) { const f32x4 v0 = acc[ai][bj][m][0] * sc_, v1 = acc[ai][bj][m][1] * sc_;
                        u32x4 w; w.x = cvt_pk_bf16(v0[0], v0[1]); w.y = cvt_pk_bf16(v0[2], v0[3]); w.z = cvt_pk_bf16(v1[0], v1[1]); w.w = cvt_pk_bf16(v1[2], v1[3]);
                        st16_wt(rowp + bj * 128, lo_, w); } }
            return;
        }
        const int hh = 2 * u.pn + wc;
#pragma unroll
        for (int ai = 0; ai < 2; ++ai)
#pragma unroll
            for (int m = 0; m < 4; ++m) { const int row = row0 + ai * 128 + m * 16; const float sc_ = rsc[ai][m];
                const bf16_t* ko = K + ((size_t)(u.pm * 256 + wr * 64 + ai * 128 + m * 16) * MQ + 96 * hh); const unsigned lo_ = (unsigned)(fr * MQ + 8 * fq) * 2u;
                float rstd;
                {
                    f32x4 v[2][2]; float ss = 0.f;
#pragma unroll
                    for (int bj = 0; bj < 2; ++bj)
#pragma unroll
                        for (int n = 0; n < 2; ++n) { v[bj][n] = acc[ai][bj][m][n] * sc_; ss += (v[bj][n][0] * v[bj][n][0] + v[bj][n][1] * v[bj][n][1]) + (v[bj][n][2] * v[bj][n][2] + v[bj][n][3] * v[bj][n][3]); }
                    ss += __builtin_bit_cast(float, __builtin_amdgcn_ds_bpermute((lane ^ 16) << 2, __builtin_bit_cast(int, ss)));
                    ss += __builtin_bit_cast(float, __builtin_amdgcn_ds_bpermute((lane ^ 32) << 2, __builtin_bit_cast(int, ss)));
                    rstd = 1.f / sqrtf((ss + ssq_kr[row]) * (1.f / 96) + EPS);
#pragma unroll
                    for (int bj = 0; bj < 2; ++bj) { const f32x4 g0 = *(const f32x4*)(kgain + 32 * bj + 8 * fq), g1 = *(const f32x4*)(kgain + 32 * bj + 8 * fq + 4);
                        const f32x4 a = v[bj][0] * rstd * g0, b = v[bj][1] * rstd * g1;
                        u32x4 w; w.x = cvt_pk_bf16(a[0], a[1]); w.y = cvt_pk_bf16(a[2], a[3]); w.z = cvt_pk_bf16(b[0], b[1]); w.w = cvt_pk_bf16(b[2], b[3]);
                        st16_wt(ko + 32 * bj, lo_, w); }
                }
                asm volatile("" ::: "memory");
                {
                    const bf16x8 kr8 = *(const bf16x8*)(proj + (size_t)row * DINP + P_HKR + 8 * fq);
                    u32x4 w; w.x = cvt_pk_bf16(bf2f((unsigned short)kr8[0]) * rstd, bf2f((unsigned short)kr8[1]) * rstd); w.y = cvt_pk_bf16(bf2f((unsigned short)kr8[2]) * rstd, bf2f((unsigned short)kr8[3]) * rstd);
                    w.z = cvt_pk_bf16(bf2f((unsigned short)kr8[4]) * rstd, bf2f((unsigned short)kr8[5]) * rstd); w.w = cvt_pk_bf16(bf2f((unsigned short)kr8[6]) * rstd, bf2f((unsigned short)kr8[7]) * rstd);
                    st16_wt(ko + 64, lo_, w);
                }
                asm volatile("" ::: "memory"); }
    }
};
struct PEpiWo {
    static constexpr bool PERM = true, AFTER_DRAIN = false, MIDSCALE = true;
    const bf16_t* base; bf16_t* xb; float* ssq; const float* ssqm; int ldc;
    __device__ __forceinline__ void midscale(f32x4 (&acc)[2][2][4][2], const pg8::Unit& u, int wr, int fr) const {
#pragma unroll
        for (int ai = 0; ai < 2; ++ai)
#pragma unroll
            for (int m = 0; m < 4; ++m) { const int row = u.pm * 256 + ai * 128 + wr * 64 + m * 16 + fr;
                const float sa = ssqm[2 * row], sb = ssqm[2 * row + 1]; const float ratio = sqrtf((sb * (1.f / 512) + EPS) / (sa * (1.f / 512) + EPS));
#pragma unroll
                for (int bj = 0; bj < 2; ++bj)
#pragma unroll
                    for (int n = 0; n < 2; ++n) acc[ai][bj][m][n] *= ratio; }
    }
    __device__ __forceinline__ void operator()(const f32x4 (&acc)[2][2][4][2], const pg8::Unit& u, int wr, int wc, int fr, int fq) const {
        const int lane = fq * 16 + fr;
        const int rowb = u.pm * 256 + wr * 64 + fr;
        float rb[8];
#pragma unroll
        for (int g_ = 0; g_ < 8; ++g_) rb[g_] = ssqm[2 * (rowb + (g_ >> 2) * 128 + (g_ & 3) * 16) + 1];
        const size_t tile0 = (size_t)(u.pm * 256 + wr * 64) * ldc + u.pn * 256 + wc * 32;
        const unsigned lo_ = (unsigned)(fr * ldc + 8 * fq) * 2u;
        u32x4 nxt[2];
#pragma unroll
        for (int bj = 0; bj < 2; ++bj) nxt[bj] = *(const u32x4*)((const char*)(base + tile0 + bj * 128) + lo_);
#pragma unroll
        for (int g_ = 0; g_ < 8; ++g_) { const int ai = g_ >> 2, m = g_ & 3; const int row = rowb + ai * 128 + m * 16; const size_t roff = tile0 + (size_t)(ai * 128 + m * 16) * ldc; float ss = 0.f;
            u32x4 cur[2];
#pragma unroll
            for (int bj = 0; bj < 2; ++bj) cur[bj] = nxt[bj];
            if (g_ < 7) { const size_t roffn = tile0 + (size_t)(((g_ + 1) >> 2) * 128 + ((g_ + 1) & 3) * 16) * ldc;
#pragma unroll
                for (int bj = 0; bj < 2; ++bj) nxt[bj] = *(const u32x4*)((const char*)(base + roffn + bj * 128) + lo_); }
            const float rbs = 1.f / sqrtf(rb[g_] * (1.f / 512) + EPS);
#pragma unroll
            for (int bj = 0; bj < 2; ++bj) { const u32x4 cw = cur[bj];
                const f32x4 v0 = (f32x4){bf2f(cw.x & 0xffffu), bf2f(cw.x >> 16), bf2f(cw.y & 0xffffu), bf2f(cw.y >> 16)} + acc[ai][bj][m][0] * rbs;
                const f32x4 v1 = (f32x4){bf2f(cw.z & 0xffffu), bf2f(cw.z >> 16), bf2f(cw.w & 0xffffu), bf2f(cw.w >> 16)} + acc[ai][bj][m][1] * rbs;
                ss += ((v0[0] * v0[0] + v0[1] * v0[1]) + (v0[2] * v0[2] + v0[3] * v0[3])) + ((v1[0] * v1[0] + v1[1] * v1[1]) + (v1[2] * v1[2] + v1[3] * v1[3]));
                u32x4 w; w.x = cvt_pk_bf16(v0[0], v0[1]); w.y = cvt_pk_bf16(v0[2], v0[3]); w.z = cvt_pk_bf16(v1[0], v1[1]); w.w = cvt_pk_bf16(v1[2], v1[3]);
                st16_wt(xb + roff + bj * 128, lo_, w); }
            ss += __builtin_bit_cast(float, __builtin_amdgcn_ds_bpermute((lane ^ 16) << 2, __builtin_bit_cast(int, ss)));
            ss += __builtin_bit_cast(float, __builtin_amdgcn_ds_bpermute((lane ^ 32) << 2, __builtin_bit_cast(int, ss)));
            if (fq == 0) __hip_atomic_fetch_add(ssq + row, ss, __ATOMIC_RELAXED, __HIP_MEMORY_SCOPE_AGENT); }
    }
};


struct PEpiDown {
    static constexpr bool PERM = false, AFTER_DRAIN = false, MIDSCALE = false;
    const bf16_t* xb; float* out; int ldc;
    __device__ __forceinline__ void operator()(const f32x4 (&acc)[2][2][4][2], const pg8::Unit& u, int wr, int wc, int fr, int fq) const {
        const int col0 = u.pn * 256 + wc * 32 + 4 * fq; const int rowb = u.pm * 256 + wr * 64 + fr;
        u32x2 nxt[2][2];
#pragma unroll
        for (int bj = 0; bj < 2; ++bj)
#pragma unroll
            for (int n = 0; n < 2; ++n) nxt[bj][n] = *(const u32x2*)(xb + (size_t)rowb * ldc + col0 + bj * 128 + n * 16);
#pragma unroll
        for (int g_ = 0; g_ < 8; ++g_) { const int ai = g_ >> 2, m = g_ & 3; const size_t off = (size_t)(rowb + ai * 128 + m * 16) * ldc + col0;
            u32x2 cur[2][2];
#pragma unroll
            for (int bj = 0; bj < 2; ++bj)
#pragma unroll
                for (int n = 0; n < 2; ++n) cur[bj][n] = nxt[bj][n];
            if (g_ < 7) { const size_t offn = (size_t)(rowb + ((g_ + 1) >> 2) * 128 + ((g_ + 1) & 3) * 16) * ldc + col0;
#pragma unroll
                for (int bj = 0; bj < 2; ++bj)
#pragma unroll
                    for (int n = 0; n < 2; ++n) nxt[bj][n] = *(const u32x2*)(xb + offn + bj * 128 + n * 16); }
#pragma unroll
            for (int bj = 0; bj < 2; ++bj)
#pragma unroll
                for (int n = 0; n < 2; ++n) { const u32x2 w = cur[bj][n];
                    const f32x4 bs = (f32x4){bf2f(w.x & 0xffffu), bf2f(w.x >> 16), bf2f(w.y & 0xffffu), bf2f(w.y >> 16)};
                    __builtin_nontemporal_store(bs + acc[ai][bj][m][n], (f32x4*)(out + off + bj * 128 + n * 16)); } }
    }
};

__device__ __forceinline__ float sq8(const bf16x8 v) { float s = 0.f;
#pragma unroll
    for (int j = 0; j < 8; ++j) { const float f = bf2f((unsigned short)v[j]); s += f * f; }
    return s; }
__device__ __forceinline__ u32x4 scale8(const bf16x8 v, float sc, const f32x4 ga, const f32x4 gb) { u32x4 o;
    o.x = pk2(bf2f((unsigned short)v[0]) * sc * ga[0], bf2f((unsigned short)v[1]) * sc * ga[1]); o.y = pk2(bf2f((unsigned short)v[2]) * sc * ga[2], bf2f((unsigned short)v[3]) * sc * ga[3]);
    o.z = pk2(bf2f((unsigned short)v[4]) * sc * gb[0], bf2f((unsigned short)v[5]) * sc * gb[1]); o.w = pk2(bf2f((unsigned short)v[6]) * sc * gb[2], bf2f((unsigned short)v[7]) * sc * gb[3]);
    return o; }

__device__ __forceinline__ void compress_block(unsigned char* ws, LAS unsigned char* L, int task, int wv) {
    const int tid = opaque_tid(wv), lane = tid & 63, wid = __builtin_amdgcn_readfirstlane(tid >> 6), fr = lane & 15, fq = lane >> 4;
    const int tc = task & 15, b = (task >> 4) & 7, kv = task >> 7;
    int c = 8 * tc + (fr >> 1); const int g = fr & 1; if (c > NCMP - 1) c = NCMP - 1;
    const bf16_t* arow = (const bf16_t*)(ws + WS_PROJ) + (size_t)(b * SEQ + 16 * c) * DINP + slot_base((kv ? S_VCMP : S_KCMP) + g) + 8 * fq;
    const float* pe = inptr(11) + kv * 2048 + 8 * fq;
    const bf16_t* w1t = (const bf16_t*)(ws + WS_W1T) + (size_t)kv * 128 * 2048 + 8 * lane;
    f32x4 acc[8];
#pragma unroll
    for (int n = 0; n < 8; ++n) acc[n] = (f32x4){0.f, 0.f, 0.f, 0.f};
#pragma unroll 4
    for (int s8 = 0; s8 < 8; ++s8) {
        const int s = 8 * wid + s8, r = s >> 1, db = (s & 1) * 32;
        const bf16x8 araw = *(const bf16x8*)(arow + (size_t)r * DINP + 4 * db);
        const f32x4 pa = *(const f32x4*)(pe + r * 64 + db), pb = *(const f32x4*)(pe + r * 64 + db + 4);
        u32x4 aw; aw.x = pk2(bf2f((unsigned short)araw[0]) + pa[0], bf2f((unsigned short)araw[1]) + pa[1]); aw.y = pk2(bf2f((unsigned short)araw[2]) + pa[2], bf2f((unsigned short)araw[3]) + pa[3]);
        aw.z = pk2(bf2f((unsigned short)araw[4]) + pb[0], bf2f((unsigned short)araw[5]) + pb[1]); aw.w = pk2(bf2f((unsigned short)araw[6]) + pb[2], bf2f((unsigned short)araw[7]) + pb[3]);
        const bf16x8 a = __builtin_bit_cast(bf16x8, aw);
#pragma unroll
        for (int n = 0; n < 8; ++n) { const bf16x8 bb = *(const bf16x8*)(w1t + (size_t)(s * 8 + n) * 512);
            acc[n] = __builtin_amdgcn_mfma_f32_16x16x32_bf16(a, bb, acc[n], 0, 0, 0); }
    }
    LAS float* part = (LAS float*)L;
#pragma unroll
    for (int n = 0; n < 8; ++n)
#pragma unroll
        for (int j = 0; j < 4; ++j) part[(wid * 16 + 4 * fq + j) * 128 + 16 * n + fr] = acc[n][j];
    __syncthreads();
    LAS bf16_t* hb_ = (LAS bf16_t*)(L + 65536);
#pragma unroll
    for (int e = 0; e < 4; ++e) { const int idx = tid + 512 * e; float v = 0.f;
#pragma unroll
        for (int w = 0; w < 8; ++w) v += part[w * 2048 + idx];
        hb_[idx] = (bf16_t)f2bf(v / (1.f + __expf(-v))); }
    __syncthreads();
    if (wid == 0) {
        const bf16_t* w2t = (const bf16_t*)(ws + WS_W2T) + kv * 64 * 128 + fr * 128 + 8 * fq;
        f32x4 o[4];
#pragma unroll
        for (int n = 0; n < 4; ++n) o[n] = (f32x4){0.f, 0.f, 0.f, 0.f};
#pragma unroll
        for (int ks = 0; ks < 4; ++ks) { const bf16x8 a = *(const LAS bf16x8*)(hb_ + fr * 128 + 32 * ks + 8 * fq);
#pragma unroll
            for (int n = 0; n < 4; ++n) { const bf16x8 bb = *(const bf16x8*)(w2t + (size_t)(16 * n) * 128 + 32 * ks); o[n] = __builtin_amdgcn_mfma_f32_16x16x32_bf16(a, bb, o[n], 0, 0, 0); } }
        bf16_t* dstb = (bf16_t*)(ws + (kv ? WS_VCMP : WS_KCMP)) + (size_t)b * 128 * 2 * 64;
        const float* kg = inptr(10);
#pragma unroll
        for (int j = 0; j < 4; ++j) { const int row = 4 * fq + j, cc = 8 * tc + (row >> 1), gg = row & 1;
            float sc = 1.f;
            if (kv == 0) { float ss = o[0][j] * o[0][j] + o[1][j] * o[1][j] + o[2][j] * o[2][j] + o[3][j] * o[3][j];
                ss += __shfl_xor(ss, 1); ss += __shfl_xor(ss, 2); ss += __shfl_xor(ss, 4); ss += __shfl_xor(ss, 8); sc = 1.f / sqrtf(ss * (1.f / 64) + EPS); }
#pragma unroll
            for (int n = 0; n < 4; ++n) { const int col = 16 * n + fr; float v = o[n][j] * sc; if (kv == 0) v *= kg[col]; if (cc >= NCMP) v = 0.f;
                dstb[((size_t)cc * 2 + gg) * 64 + col] = (bf16_t)f2bf(v); } }
    }
    __syncthreads();
}

namespace att {
typedef float f32x16 __attribute__((ext_vector_type(16)));
typedef short s16x4 __attribute__((ext_vector_type(4)));
typedef short v4i16_t __attribute__((ext_vector_type(4)));
typedef float f32x2_t __attribute__((ext_vector_type(2)));
typedef __bf16 bf16x2_t __attribute__((ext_vector_type(2)));
typedef const LAS unsigned char* lcp;
constexpr int NSLOT = 3;
constexpr int L_TB = 0, L_K = 4096, KSLOT = 12288, L_V = L_K + NSLOT * KSLOT, VSLOT = 8192, L_WSF = L_V + NSLOT * VSLOT, L_OST = L_WSF + 4096,
              L_IMP = L_OST + 32768, IMPS = 33  , L_SELM = L_IMP + 4 * 64 * IMPS * 4, L_GATE = L_SELM + 256, L_SC = L_GATE + 3072, L_INVL = L_SC + 64 * IMPS * 4, L_END = L_INVL + 1024;
static_assert(L_V + NSLOT * VSLOT <= 65536, "LDS-DMA destinations stay below 64 KiB");
static_assert(L_END <= LDS_BST, "attention LDS map");
constexpr float THR = 8.0f;
__device__ __forceinline__ int crow(int r, int hi) { return (r & 3) + 8 * (r >> 2) + 4 * hi; }
__device__ __forceinline__ void glds16(const void* gsrc, unsigned lds_dst) { unsigned keep;
    asm volatile("s_mov_b32 %0, m0\n\ts_mov_b32 m0, %2\n\ts_nop 0\n\tglobal_load_lds_dwordx4 %1, off\n\ts_mov_b32 m0, %0" : "=&s"(keep) : "v"(gsrc), "s"(lds_dst) : "memory"); }
__device__ __forceinline__ unsigned cvtpk(float lo, float hi) { f32x2_t v = {lo, hi}; bf16x2_t b = __builtin_convertvector(v, bf16x2_t); return __builtin_bit_cast(unsigned, b); }
__device__ __forceinline__ s16x4 vtr(lcp p) { return __builtin_bit_cast(s16x4, __builtin_amdgcn_ds_read_tr16_b64_v4i16((LAS v4i16_t*)p)); }
__device__ __forceinline__ float lane_xor(float v, int lane, int x) { return __builtin_bit_cast(float, __builtin_amdgcn_ds_bpermute((lane ^ x) << 2, __builtin_bit_cast(int, v))); }
__device__ __forceinline__ unsigned lane_xor_u(unsigned v, int lane, int x) { return (unsigned)__builtin_amdgcn_ds_bpermute((lane ^ x) << 2, (int)v); }
__device__ __forceinline__ float swap_max(float m, int lane) { return __builtin_fmaxf(m, lane_xor(m, lane, 32)); }
__device__ __forceinline__ float swap_sum(float m, int lane) { return m + lane_xor(m, lane, 32); }
__device__ __forceinline__ float max3f(float a, float b, float c) { float r; asm("v_max3_f32 %0, %1, %2, %3" : "=v"(r) : "v"(a), "v"(b), "v"(c)); return r; }
__device__ __forceinline__ float max32(const f32x16& p0, const f32x16& p1) {
    float a = max3f(p0[0], p0[1], p1[0]), b = max3f(p0[2], p0[3], p1[1]); a = max3f(a, p1[2], p1[3]);
#pragma unroll
    for (int r = 4; r < 16; r += 4) { a = max3f(a, p0[r], p0[r + 1]); b = max3f(b, p0[r + 2], p0[r + 3]); a = max3f(a, p1[r], p1[r + 1]); b = max3f(b, p1[r + 2], p1[r + 3]); }
    return __builtin_fmaxf(a, b); }
__device__ __forceinline__ float max16(const f32x16& p) { float a = __builtin_fmaxf(p[0], p[1]), b = __builtin_fmaxf(p[2], p[3]);
#pragma unroll
    for (int r = 4; r < 16; r += 4) { a = __builtin_fmaxf(a, __builtin_fmaxf(p[r], p[r + 1])); b = __builtin_fmaxf(b, __builtin_fmaxf(p[r + 2], p[r + 3])); }
    return __builtin_fmaxf(a, b); }
__device__ __forceinline__ float sum16(const f32x16& p) { float a = p[0] + p[1], b = p[2] + p[3];
#pragma unroll
    for (int r = 4; r < 16; r += 4) { a += p[r] + p[r + 1]; b += p[r + 2] + p[r + 3]; }
    return a + b; }
#define ATT_BAR() asm volatile("s_waitcnt vmcnt(0) lgkmcnt(0)\n\ts_barrier" ::: "memory")

template <int DQ> __device__ __forceinline__ void qkt(f32x16& p0, f32x16& p1, lcp kslot, const bf16x8* qr, const f32x16& cinit, int r32, int hi) {
    lcp kb = kslot + hi * 1024 + r32 * 16;
    constexpr int NB = (DQ == 96) ? 3 : 4;
#pragma unroll
    for (int db = 0; db < DQ / 16; db += NB) {
        bf16x8 kf[2 * NB];
#pragma unroll
        for (int e = 0; e < NB; ++e) { kf[2 * e] = *(const LAS bf16x8*)(kb + (db + e) * 2048); kf[2 * e + 1] = *(const LAS bf16x8*)(kb + (db + e) * 2048 + 512); }
        __builtin_amdgcn_sched_barrier(0);
#pragma unroll
        for (int e = 0; e < NB; ++e) { const int d0 = db + e;
            if (d0 == 0) { p0 = __builtin_amdgcn_mfma_f32_32x32x16_bf16(kf[0], qr[0], cinit, 0, 0, 0); p1 = __builtin_amdgcn_mfma_f32_32x32x16_bf16(kf[1], qr[0], cinit, 0, 0, 0); }
            else { p0 = __builtin_amdgcn_mfma_f32_32x32x16_bf16(kf[2 * e], qr[d0], p0, 0, 0, 0); p1 = __builtin_amdgcn_mfma_f32_32x32x16_bf16(kf[2 * e + 1], qr[d0], p1, 0, 0, 0); }
        }
    }
}
__device__ __forceinline__ void vload_half(bf16x8 (&vf)[8], lcp vp, int d0) {
#pragma unroll
    for (int ks = 0; ks < 4; ++ks) {
        const s16x4 lo = vtr(vp + d0 * 4096 + ks * 1024), hh = vtr(vp + d0 * 4096 + ks * 1024 + 512);
        vf[d0 * 4 + ks] = (bf16x8){lo[0], lo[1], lo[2], lo[3], hh[0], hh[1], hh[2], hh[3]};
    }
    __builtin_amdgcn_sched_barrier(0);
}
__device__ __forceinline__ void vload(bf16x8 (&vf)[8], lcp vp) { vload_half(vf, vp, 0); vload_half(vf, vp, 1); }
__device__ __forceinline__ void pv_mma(f32x16 (&o)[2], const bf16x8 (&vf)[8], const f32x16& p0, const f32x16& p1) {
    u32x4 pw[4];
    pw[0] = (u32x4){cvtpk(p0[0], p0[1]), cvtpk(p0[2], p0[3]), cvtpk(p0[4], p0[5]), cvtpk(p0[6], p0[7])};
    pw[1] = (u32x4){cvtpk(p0[8], p0[9]), cvtpk(p0[10], p0[11]), cvtpk(p0[12], p0[13]), cvtpk(p0[14], p0[15])};
    pw[2] = (u32x4){cvtpk(p1[0], p1[1]), cvtpk(p1[2], p1[3]), cvtpk(p1[4], p1[5]), cvtpk(p1[6], p1[7])};
    pw[3] = (u32x4){cvtpk(p1[8], p1[9]), cvtpk(p1[10], p1[11]), cvtpk(p1[12], p1[13]), cvtpk(p1[14], p1[15])};
#pragma unroll
    for (int d0 = 0; d0 < 2; ++d0)
#pragma unroll
        for (int ks = 0; ks < 4; ++ks) o[d0] = __builtin_amdgcn_mfma_f32_32x32x16_bf16(__builtin_bit_cast(bf16x8, pw[ks]), vf[d0 * 4 + ks], o[d0], 0, 0, 0);
}
__device__ __forceinline__ void pv(f32x16 (&o)[2], lcp vp, const f32x16& p0, const f32x16& p1) { bf16x8 vf[8]; vload(vf, vp); pv_mma(o, vf, p0, p1); }
template <int DQ, bool SLOT = false, bool SLOTV = SLOT> __device__ __forceinline__ void dma_tile(unsigned lds0, const bf16_t* Kg, int kpitch, const bf16_t* Vg, int vpitch, int key0, int slot, int wid, int lane) {
    const bf16_t* ksrc = Kg + (size_t)(key0 + lane) * kpitch + (SLOT ? 128 * (wid >> 2) + 8 * (wid & 3) : wid * 8);
    glds16(ksrc, (unsigned)__builtin_amdgcn_readfirstlane(lds0 + L_K + slot * KSLOT + wid * 1024));
    if (DQ == 96) { if (wid < 4) glds16(ksrc + 64, (unsigned)__builtin_amdgcn_readfirstlane(lds0 + L_K + slot * KSLOT + (8 + wid) * 1024)); }
    const bf16_t* vsrc = Vg + (size_t)(key0 + 16 * (wid & 3) + (lane >> 2)) * vpitch + (wid >> 2) * (SLOTV ? 128 : 32) + (lane & 3) * 8;
    glds16(vsrc, (unsigned)__builtin_amdgcn_readfirstlane(lds0 + L_V + slot * VSLOT + wid * 1024));
}

#define ATT_LBAR() asm volatile("s_waitcnt lgkmcnt(0)\n\ts_barrier" ::: "memory")
struct NoNext { static constexpr int count = 0; __device__ __forceinline__ void dma(unsigned, int, int, int, int) const {} };
template <int DQ, bool SLOT, bool SLOTV, class Pol> struct NextTiles {
    const bf16_t* Kg; int kpitch; const bf16_t* Vg; int vpitch; const Pol* pol; int count;
    __device__ __forceinline__ void dma(unsigned lds0, int j, int slot, int wid, int lane) const { dma_tile<DQ, SLOT, SLOTV>(lds0, Kg, kpitch, Vg, vpitch, pol->key0(j), slot, wid, lane); }
};
template <int DQ, bool SLOT = false, bool SLOTV = SLOT, class Pol, class Next>
__device__ __forceinline__ void flash_loop(LAS unsigned char* L, const bf16_t* Kg, int kpitch, const bf16_t* Vg, int vpitch, const bf16x8* qr, const Pol& pol, int s0, int npre, const Next& next,
                                           f32x16 (&o)[2], float& l_out, int wid, int lane) {
    const int r32 = lane & 31, hi = lane >> 5;
    const unsigned lds0 = (unsigned)(uintptr_t)L;
    LAS float* wsf = (LAS float*)(L + L_WSF) + wid * 128;
    lcp vp0 = L + L_V + ((lane >> 4) & 1) * 32 + (lane & 3) * 8 + (4 * hi + ((lane & 15) >> 2)) * 64;
    float mhat = 0.f, l = 0.f;
    f32x16 negm;
#pragma unroll
    for (int r = 0; r < 16; ++r) { o[0][r] = 0.f; o[1][r] = 0.f; negm[r] = 0.f; }
    const int n = pol.ntiles, ntot = n + next.count;
    int slot = s0, slot1 = (s0 + 1) % NSLOT, slot2 = (s0 + 2) % NSLOT;
    if (npre < 1) dma_tile<DQ, SLOT, SLOTV>(lds0, Kg, kpitch, Vg, vpitch, pol.key0(0), slot, wid, lane);
    if (npre < 2 && ntot > 1) { if (n > 1) dma_tile<DQ, SLOT, SLOTV>(lds0, Kg, kpitch, Vg, vpitch, pol.key0(1), slot1, wid, lane); else next.dma(lds0, 0, slot1, wid, lane); }
    for (int i = 0; i < n; ++i) {
        if (i + 1 < ntot) { if (DQ == 96 && wid < 4) asm volatile("s_waitcnt vmcnt(3) lgkmcnt(0)\n\ts_barrier" ::: "memory"); else asm volatile("s_waitcnt vmcnt(2) lgkmcnt(0)\n\ts_barrier" ::: "memory"); }
        else ATT_BAR();
        if (i + 2 < ntot) { if (i + 2 < n) dma_tile<DQ, SLOT, SLOTV>(lds0, Kg, kpitch, Vg, vpitch, pol.key0(i + 2), slot2, wid, lane); else next.dma(lds0, i + 2 - n, slot2, wid, lane); }
        if (pol.active(i)) {
            f32x16 p0, p1;
            qkt<DQ>(p0, p1, L + L_K + slot * KSLOT, qr, negm, r32, hi);
            bf16x8 vf[8]; vload_half(vf, vp0 + slot * VSLOT, 0);
            pol.fix(p0, p1, i);
            asm volatile("s_nop 15\n\ts_nop 7" : "+v"(p0), "+v"(p1));
            const float rm = swap_max(max32(p0, p1), lane);
            const bool first = (i == 0);
            if (first || __any(rm > THR)) {
                float dl = first ? rm : __builtin_fmaxf(rm, 0.f);
                if (dl == -INFINITY) dl = 0.f;
                mhat += dl;
#pragma unroll
                for (int r = 0; r < 16; ++r) { p0[r] -= dl; p1[r] -= dl; negm[r] = -mhat; }
                if (!first) {
                    const float f = __builtin_amdgcn_exp2f(-dl); l *= f;
                    if (hi == 0) wsf[r32] = f;
#pragma unroll
                    for (int r = 0; r < 16; ++r) { const float fr_ = wsf[crow(r, hi)]; o[0][r] *= fr_; o[1][r] *= fr_; }
                }
            }
#pragma unroll
            for (int r = 0; r < 16; ++r) { p0[r] = __builtin_amdgcn_exp2f(p0[r]); p1[r] = __builtin_amdgcn_exp2f(p1[r]); }
            vload_half(vf, vp0 + slot * VSLOT, 1);
            l += sum16(p0) + sum16(p1);
            pv_mma(o, vf, p0, p1);
        }
        slot = slot1; slot1 = slot2; slot2 = (slot2 == NSLOT - 1) ? 0 : slot2 + 1;
    }
    ATT_LBAR();
    l_out = swap_sum(l, lane);
}

__device__ __forceinline__ void acc_scaled(f32x16 (&oc)[2], const f32x16 (&o)[2], float rowscale, LAS float* wsf, int r32, int hi) {
    if (hi == 0) wsf[32 + r32] = rowscale;
#pragma unroll
    for (int r = 0; r < 16; ++r) { const float s = wsf[32 + crow(r, hi)]; oc[0][r] += s * o[0][r]; oc[1][r] += s * o[1][r]; }
}
__device__ __forceinline__ void park_store(const f32x16 (&oc)[2], LAS float* park, int lane) {
#pragma unroll
    for (int d0 = 0; d0 < 2; ++d0)
#pragma unroll
        for (int r = 0; r < 16; ++r) park[(d0 * 16 + r) * 64 + lane] = oc[d0][r];
}
template <bool FINAL> __device__ __forceinline__ void park_acc(f32x16 (&oc)[2], LAS float* park, const f32x16 (&o)[2], float rowscale, LAS float* wsf, int lane) {
    const int r32 = lane & 31, hi = lane >> 5;
    if (hi == 0) wsf[32 + r32] = rowscale;
#pragma unroll
    for (int r = 0; r < 16; ++r) { const float s = wsf[32 + crow(r, hi)];
#pragma unroll
        for (int d0 = 0; d0 < 2; ++d0) { const float v = park[(d0 * 16 + r) * 64 + lane] + s * o[d0][r]; if (FINAL) oc[d0][r] = v; else park[(d0 * 16 + r) * 64 + lane] = v; } }
}
__device__ __forceinline__ void store_tile(const f32x16 (&oc)[2], bf16_t* dst, int pitch, LAS unsigned char* L, int wid, int lane, float* ssq) {
    const int r32 = lane & 31, hi = lane >> 5;
    LAS bf16_t* stg = (LAS bf16_t*)(L + L_OST + wid * 8192);
#pragma unroll
    for (int r = 0; r < 16; ++r) { const int orow = crow(r, hi);
#pragma unroll
        for (int d0 = 0; d0 < 2; ++d0) stg[orow * 64 + d0 * 32 + r32] = (bf16_t)f2bf(oc[d0][r]); }
    asm volatile("s_waitcnt lgkmcnt(0)" ::: "memory");
#pragma unroll
    for (int i = 0; i < 4; ++i) { const int row = i * 8 + (lane >> 3), ch = lane & 7; const u32x4 v = *(const LAS u32x4*)(stg + row * 64 + ch * 8); st16_wt(dst + (size_t)(i * 8) * pitch, (unsigned)((lane >> 3) * pitch + ch * 8) * 2u, v);
        float ss = sq8(__builtin_bit_cast(bf16x8, v)); ss += lane_xor(ss, lane, 1); ss += lane_xor(ss, lane, 2); ss += lane_xor(ss, lane, 4);
        if (ch == 0) __hip_atomic_fetch_add(ssq + 2 * row, ss, __ATOMIC_RELAXED, __HIP_MEMORY_SCOPE_AGENT); }
    asm volatile("s_waitcnt lgkmcnt(0)" ::: "memory");
}

#define PIN16(v) asm volatile("" : "+v"(v[0]), "+v"(v[1]), "+v"(v[2]), "+v"(v[3]), "+v"(v[4]), "+v"(v[5]), "+v"(v[6]), "+v"(v[7]), "+v"(v[8]), "+v"(v[9]), "+v"(v[10]), "+v"(v[11]), "+v"(v[12]), "+v"(v[13]), "+v"(v[14]), "+v"(v[15]))
__device__ __forceinline__ int clamp127(int d) { return d < 0 ? 0 : (d < 127 ? d : 127); }
struct PolMla { int ntiles, qw0, r32, hi;
    __device__ __forceinline__ int key0(int i) const { return 64 * i; }
    __device__ __forceinline__ bool active(int i) const { return 64 * i <= qw0 + 31; }
    __device__ __forceinline__ int nact() const { const int a = (qw0 + 31) / 64 + 1; return a < ntiles ? a : ntiles; }
    __device__ __forceinline__ void fix(f32x16& p0, f32x16& p1, int i) const {
        if (64 * i + 63 > qw0) { const int q = qw0 + r32, kb = 64 * i + 4 * hi;
#pragma unroll
            for (int r = 0; r < 16; ++r) { const int kv = kb + (r & 3) + 8 * (r >> 2); if (kv > q) p0[r] = -INFINITY; if (kv + 32 > q) p1[r] = -INFINITY; } }
    }
};
struct PolSel { int ntiles, qc, q, hi; unsigned selm; const LAS float* tbh;
    __device__ __forceinline__ int key0(int i) const { return 64 * (qc - i); }
    __device__ __forceinline__ bool active(int i) const { return __any((selm >> (qc - i)) & 1u) != 0; }
    __device__ __forceinline__ int nact() const { return ntiles; }
    __device__ __forceinline__ void fix(f32x16& p0, f32x16& p1, int i) const {
        const bool bit = ((selm >> (qc - i)) & 1u) != 0u;
        if (i <= 2) { const int kb = 64 * (qc - i) + 4 * hi; float bv0[16], bv1[16];
#pragma unroll
            for (int r = 0; r < 16; ++r) { const int d0 = q - (kb + (r & 3) + 8 * (r >> 2)); bv0[r] = tbh[clamp127(d0)]; bv1[r] = tbh[clamp127(d0 - 32)]; }
            PIN16(bv0); PIN16(bv1);
#pragma unroll
            for (int r = 0; r < 16; ++r) { const int d0 = q - (kb + (r & 3) + 8 * (r >> 2)), d1 = d0 - 32;
                p0[r] = (d0 < 0) ? -INFINITY : p0[r] + bv0[r]; p1[r] = (d1 < 0) ? -INFINITY : p1[r] + bv1[r]; } }
        if (!bit) {
#pragma unroll
            for (int r = 0; r < 16; ++r) { p0[r] = -INFINITY; p1[r] = -INFINITY; } }
    }
};
struct PolWin { int ntiles, qc, q, hi; const LAS float* tbh;
    __device__ __forceinline__ int key0(int i) const { return 64 * (qc - i); }
    __device__ __forceinline__ bool active(int) const { return true; }
    __device__ __forceinline__ int nact() const { return ntiles; }
    __device__ __forceinline__ void fix(f32x16& p0, f32x16& p1, int i) const {
        if (i <= 2) { const int kb = 64 * (qc - i) + 4 * hi; float bv0[16], bv1[16];
#pragma unroll
            for (int r = 0; r < 16; ++r) { const int d0 = q - (kb + (r & 3) + 8 * (r >> 2)); bv0[r] = tbh[clamp127(d0)]; bv1[r] = tbh[clamp127(d0 - 32)]; }
            PIN16(bv0); PIN16(bv1);
#pragma unroll
            for (int r = 0; r < 16; ++r) { const int d0 = q - (kb + (r & 3) + 8 * (r >> 2)), d1 = d0 - 32;
                p0[r] = (d0 < 0) ? -INFINITY : p0[r] + bv0[r]; p1[r] = (d1 < 0) ? -INFINITY : p1[r] + bv1[r]; } }
        else if (i == 8) { const int kb = 64 * (qc - i) + 4 * hi;
#pragma unroll
            for (int r = 0; r < 16; ++r) { const int d0 = q - (kb + (r & 3) + 8 * (r >> 2)), d1 = d0 - 32; if (d0 >= 512) p0[r] = -INFINITY; if (d1 >= 512) p1[r] = -INFINITY; } }
    }
};

__device__ __forceinline__ void mla_unit(unsigned char* ws, LAS unsigned char* L, int b, int h, int qb, int wv, int s0, int npre, int nnext) {
    asm volatile("" : "+s"(ws));
    const int tid = opaque_tid(wv), lane = tid & 63, wid = __builtin_amdgcn_readfirstlane(tid >> 6);
    const int r32 = lane & 31, hi = lane >> 5;
    const size_t rowbase = (size_t)b * SEQ; const int qw0 = 256 * qb + 32 * wid;
    bf16x8 qr[6];
    { const bf16_t* Qw = (const bf16_t*)(ws + WS_QM) + (rowbase + qw0 + r32) * MQ + 96 * h + 8 * hi;
      bf16x8 raw[6]; float ss = 0.f;
#pragma unroll
      for (int d0 = 0; d0 < 6; ++d0) { raw[d0] = *(const bf16x8*)(Qw + 16 * d0); ss += sq8(raw[d0]); }
      ss += lane_xor(ss, lane, 32);
      const float rstd = QS_MLA / sqrtf(ss * (1.f / 96) + EPS);
      const float* qg = inptr(7) + 8 * hi;
#pragma unroll
      for (int d0 = 0; d0 < 4; ++d0) qr[d0] = __builtin_bit_cast(bf16x8, scale8(raw[d0], rstd, *(const f32x4*)(qg + 16 * d0), *(const f32x4*)(qg + 16 * d0 + 4)));
      float o1[8], o2[8]; const float posf = (float)(qw0 + r32);
#pragma unroll
      for (int j = 0; j < 8; ++j) { const int i = 8 * hi + j; const float inv = exp2f(-(float)i * (13.287712379549449f / 16.f)); float sn, cs; sincosf(posf * inv, &sn, &cs);
          const float n1 = bf2f((unsigned short)raw[4][j]) * rstd * qg[64 + j], n2 = bf2f((unsigned short)raw[5][j]) * rstd * qg[80 + j];
          o1[j] = n1 * cs - n2 * sn; o2[j] = n2 * cs + n1 * sn; }
      u32x4 w4, w5; w4.x = pk2(o1[0], o1[1]); w4.y = pk2(o1[2], o1[3]); w4.z = pk2(o1[4], o1[5]); w4.w = pk2(o1[6], o1[7]);
      w5.x = pk2(o2[0], o2[1]); w5.y = pk2(o2[2], o2[3]); w5.z = pk2(o2[4], o2[5]); w5.w = pk2(o2[6], o2[7]);
      qr[4] = __builtin_bit_cast(bf16x8, w4); qr[5] = __builtin_bit_cast(bf16x8, w5); }
    const bf16_t* Kg = (const bf16_t*)(ws + WS_KMLA) + rowbase * MQ + 96 * h;
    const bf16_t* Vg = (const bf16_t*)(ws + WS_KVM) + rowbase * MKV + slot_base(4 * (h >> 1) + 2 + (h & 1));
    PolMla pol{4 * qb + 4, qw0, r32, hi};
    f32x16 o[2]; float l;
    const NextTiles<96, false, true, PolMla> nxt{Kg, MQ, Vg, MKV, &pol, nnext};
    flash_loop<96, false, true>(L, Kg, MQ, Vg, MKV, qr, pol, s0, npre, nxt, o, l, wid, lane);
    LAS float* wsf = (LAS float*)(L + L_WSF) + wid * 128;
    f32x16 oc[2];
#pragma unroll
    for (int r = 0; r < 16; ++r) { oc[0][r] = 0.f; oc[1][r] = 0.f; }
    acc_scaled(oc, o, (l > 0.f) ? 1.f / l : 0.f, wsf, r32, hi);
    store_tile(oc, (bf16_t*)(ws + WS_MIX) + (rowbase + qw0) * DM + 64 * h, DM, L, wid, lane, (float*)(ws + WS_SSQM) + 2 * (rowbase + qw0));
}

__device__ __forceinline__ void nsa_unit(unsigned char* ws, LAS unsigned char* L, int b, int g, int qc, int wv) {
    asm volatile("" : "+s"(ws));
#define NSA_IDS() const int tid = opaque_tid(wv), lane = tid & 63, wid = __builtin_amdgcn_readfirstlane(tid >> 6); \
    const int r32 = lane & 31, hi = lane >> 5, rh = wid & 3, qh = wid >> 2, h = 4 * g + rh, qloc = 32 * qh + r32, q = q0 + qloc; \
    const unsigned lds0 = (unsigned)(uintptr_t)L; LAS float* wsf = (LAS float*)(L + L_WSF) + wid * 128; const LAS float* tbh = (const LAS float*)(L + L_TB) + h * 128; \
    LAS float* gate = (LAS float*)(L + L_GATE); (void)tid; (void)lane; (void)r32; (void)hi; (void)rh; (void)qh; (void)h; (void)qloc; (void)q; (void)lds0; (void)wsf; (void)tbh; (void)gate
    const size_t rowbase = (size_t)b * SEQ; const int q0 = 64 * qc;
    const bf16_t* pr = (const bf16_t*)(ws + WS_PROJ);
    bf16x8 qr[4];
    {
    NSA_IDS();
    { const bf16_t* Kc = (const bf16_t*)(ws + WS_KCMP) + ((size_t)b * 256 + g) * 64; const bf16_t* Vc = (const bf16_t*)(ws + WS_VCMP) + ((size_t)b * 256 + g) * 64;
      dma_tile<64>(lds0, Kc, 128, Vc, 128, 0, 0, wid, lane);
      dma_tile<64>(lds0, Kc, 128, Vc, 128, 64, 1, wid, lane);
      dma_tile<64, true>(lds0, pr + rowbase * DINP + slot_base(S_KSEL + g), DINP, pr + rowbase * DINP + slot_base(S_VSEL + g), DINP, 64 * qc, 2, wid, lane); }
    for (int i = tid; i < 768; i += 512) { const int br = i >> 8, r = (i >> 6) & 3, qq = i & 63;
        const float x = bf2f(pr[(rowbase + q0 + qq) * DINP + P_GATE + 8 * br + 4 * g + r]); gate[i] = 1.f / (1.f + __expf(-x)); }
    { const bf16_t* Qw = pr + (rowbase + q) * DINP + slot_base(S_Q + h) + 8 * hi;
#pragma unroll
      for (int d0 = 0; d0 < 4; ++d0) qr[d0] = *(const bf16x8*)(Qw + 128 * (d0 >> 1) + 16 * (d0 & 1)); }
    }
    f32x16 oc[2];
    {
        NSA_IDS();
        ATT_BAR();
        lcp vp0 = L + L_V + ((lane >> 4) & 1) * 32 + (lane & 3) * 8 + (4 * hi + ((lane & 15) >> 2)) * 64;
        LAS float* imp = (LAS float*)(L + L_IMP) + (rh * 64 + qloc) * IMPS;
        f32x16 a0, a1, b0, b1;
        { f32x16 zero;
#pragma unroll
          for (int r = 0; r < 16; ++r) zero[r] = 0.f;
          qkt<64>(a0, a1, L + L_K, qr, zero, r32, hi); qkt<64>(b0, b1, L + L_K + KSLOT, qr, zero, r32, hi); }
#define CMP_FIX(P, coff, extra) do { float bv[16]; \
            _Pragma("unroll") for (int r = 0; r < 16; ++r) bv[r] = tbh[clamp127(q - 16 * (crow(r, hi) + (coff)) - 31)]; \
            PIN16(bv); \
            _Pragma("unroll") for (int r = 0; r < 16; ++r) { const int c = crow(r, hi) + (coff); const int d = q - 16 * c - 31; P[r] = (d < 0 || (extra && c >= NCMP)) ? -INFINITY : P[r] + bv[r]; } } while (0)
        { const int qw = q0 + 32 * qh;
          if (qw < 16 * 0 + 640) CMP_FIX(a0, 0, false);
          if (qw < 16 * 32 + 640) CMP_FIX(a1, 32, false);
          if (qw < 16 * 64 + 640) CMP_FIX(b0, 64, false);
          CMP_FIX(b1, 96, true); }
#undef CMP_FIX
        float m = swap_max(__builtin_fmaxf(__builtin_fmaxf(max16(a0), max16(a1)), __builtin_fmaxf(max16(b0), max16(b1))), lane);
        if (m == -INFINITY) m = 0.f;
#pragma unroll
        for (int r = 0; r < 16; ++r) { a0[r] = __builtin_amdgcn_exp2f(a0[r] - m); a1[r] = __builtin_amdgcn_exp2f(a1[r] - m); b0[r] = __builtin_amdgcn_exp2f(b0[r] - m); b1[r] = __builtin_amdgcn_exp2f(b1[r] - m); }
        const float lsum = swap_sum((sum16(a0) + sum16(a1)) + (sum16(b0) + sum16(b1)), lane);
        const float inv = (lsum > 0.f) ? 1.f / lsum : 0.f;
        float prev_last = 0.f;
#define CMP_IMP(T, P0, P1) do { float own[8], car[8]; \
            _Pragma("unroll") for (int a = 0; a < 4; ++a) { \
                own[a]     = P0[4 * a] + P0[4 * a + 1] + P0[4 * a + 2] + 0.5f * P0[4 * a + 3]; car[a]     = 0.5f * P0[4 * a + 3]; \
                own[4 + a] = P1[4 * a] + P1[4 * a + 1] + P1[4 * a + 2] + 0.5f * P1[4 * a + 3]; car[4 + a] = 0.5f * P1[4 * a + 3]; } \
            _Pragma("unroll") for (int k = 0; k < 8; ++k) car[k] = lane_xor(car[k], lane, 32); \
            _Pragma("unroll") for (int k = 0; k < 8; ++k) { const float add = hi ? car[k] : (k >= 1 ? car[k - 1] : prev_last); imp[16 * (T) + 2 * k + hi] = own[k] + add; } \
            prev_last = car[7]; } while (0)
        CMP_IMP(0, a0, a1); CMP_IMP(1, b0, b1);
#undef CMP_IMP
        if (hi == 0) ((LAS float*)(L + L_INVL))[rh * 64 + qloc] = inv;
        f32x16 o[2];
#pragma unroll
        for (int r = 0; r < 16; ++r) { o[0][r] = 0.f; o[1][r] = 0.f; }
        pv(o, vp0, a0, a1); pv(o, vp0 + VSLOT, b0, b1);
        ATT_BAR();
        if (qc >= 1) dma_tile<64, true>(lds0, pr + rowbase * DINP + slot_base(S_KSEL + g), DINP, pr + rowbase * DINP + slot_base(S_VSEL + g), DINP, 64 * (qc - 1), 0, wid, lane);
#pragma unroll
        for (int r = 0; r < 16; ++r) { oc[0][r] = 0.f; oc[1][r] = 0.f; }
        acc_scaled(oc, o, gate[(0 * 4 + rh) * 64 + qloc] * inv, wsf, r32, hi);
    }
    if (qc <= 15) {
        const int tid = opaque_tid(wv);
        if (tid < 64) ((LAS unsigned*)(L + L_SELM))[tid] = (qc == 31) ? 0xffffffffu : ((2u << qc) - 1u);
        ATT_LBAR();
    } else {
        const int tid = opaque_tid(wv);
        const LAS float* imp = (const LAS float*)(L + L_IMP); LAS float* sc = (LAS float*)(L + L_SC);
        const int qq = tid >> 3, jj = tid & 7;
        const LAS float* il = (const LAS float*)(L + L_INVL);
        const float i0 = il[qq], i1 = il[64 + qq], i2 = il[128 + qq], i3 = il[192 + qq];
#pragma unroll
        for (int k = 0; k < 4; ++k) { const int j = jj + 8 * k;
            const float tot = (imp[(0 * 64 + qq) * IMPS + j] * i0 + imp[(1 * 64 + qq) * IMPS + j] * i1) + (imp[(2 * 64 + qq) * IMPS + j] * i2 + imp[(3 * 64 + qq) * IMPS + j] * i3);
            float s; if (j > qc) s = -INFINITY; else if (j == 0 || j == qc || j == qc - 1) s = 1e4f; else s = tot; sc[qq * IMPS + j] = s; }
        ATT_LBAR();
        float v[32];
#pragma unroll
        for (int k = 0; k < 32; ++k) v[k] = sc[qq * IMPS + k];
        unsigned bits = 0u;
#pragma unroll
        for (int k = 0; k < 4; ++k) { const int j = jj + 8 * k; const float me = sc[qq * IMPS + j]; int rank = 0;
#pragma unroll
            for (int i = 0; i < 32; ++i) { const float si = v[i]; rank += (si > me || (si == me && i < j)) ? 1 : 0; }
            if (rank < 16) bits |= 1u << j; }
        { const int lane = tid & 63; bits |= lane_xor_u(bits, lane, 1); bits |= lane_xor_u(bits, lane, 2); bits |= lane_xor_u(bits, lane, 4); }
        if (jj == 0) ((LAS unsigned*)(L + L_SELM))[qq] = bits;
        ATT_LBAR();
    }
    { NSA_IDS(); park_store(oc, (LAS float*)(L + L_OST) + wid * 2048, lane); }
    {
        NSA_IDS();
        const unsigned selm = ((const LAS unsigned*)(L + L_SELM))[qloc];
        const bf16_t* Kg = pr + rowbase * DINP + slot_base(S_KSEL + g);
        const bf16_t* Vg = pr + rowbase * DINP + slot_base(S_VSEL + g);
        PolSel pol{qc + 1, qc, q, hi, selm, tbh};
        const PolWin polw{(qc < 8 ? qc : 8) + 1, qc, q, hi, tbh};
        const NextTiles<64, true, true, PolWin> nxt{pr + rowbase * DINP + slot_base(S_KWIN + g), DINP, pr + rowbase * DINP + slot_base(S_VWIN + g), DINP, &polw, polw.ntiles < 2 ? polw.ntiles : 2};
        f32x16 o[2]; float l;
        flash_loop<64, true>(L, Kg, DINP, Vg, DINP, qr, pol, 2, (qc + 1 < 2) ? qc + 1 : 2, nxt, o, l, wid, lane);
        { f32x16 dummy[2]; park_acc<false>(dummy, (LAS float*)(L + L_OST) + wid * 2048, o, (l > 0.f) ? gate[(1 * 4 + rh) * 64 + qloc] / l : 0.f, wsf, lane); }
    }
    {
        NSA_IDS();
        const bf16_t* Kg = pr + rowbase * DINP + slot_base(S_KWIN + g);
        const bf16_t* Vg = pr + rowbase * DINP + slot_base(S_VWIN + g);
        PolWin pol{(qc < 8 ? qc : 8) + 1, qc, q, hi, tbh};
        f32x16 o[2]; float l;
        flash_loop<64, true>(L, Kg, DINP, Vg, DINP, qr, pol, (2 + qc + 1) % NSLOT, pol.ntiles < 2 ? pol.ntiles : 2, NoNext{}, o, l, wid, lane);
        f32x16 fin[2]; park_acc<true>(fin, (LAS float*)(L + L_OST) + wid * 2048, o, (l > 0.f) ? gate[(2 * 4 + rh) * 64 + qloc] / l : 0.f, wsf, lane);
        store_tile(fin, (bf16_t*)(ws + WS_MIX) + (rowbase + q0 + 32 * qh) * DM + 512 + 64 * h, DM, L, wid, lane, (float*)(ws + WS_SSQM) + 2 * (rowbase + q0 + 32 * qh) + 1);
    }
    ATT_BAR();
}
#undef ATT_BAR
#undef ATT_LBAR
#undef NSA_IDS
}

#define XB_TMO      128
#define XB_XCNT(j)  (256  + 64 * (j))
#define XB_XSUB(j)  (1280 + 64 * (j))
#define XB_XGEN(j)  (2304 + 64 * (j))
#define XB_TOP      3328
#define XB_TOPGEN   3392
#define XCD_BAR_WORDS 3456
#define XB_SPIN_CAP (1u << 18)

__device__ __forceinline__ unsigned xb_ld(unsigned* p)              { return __hip_atomic_load(p, __ATOMIC_RELAXED, __HIP_MEMORY_SCOPE_AGENT); }
__device__ __forceinline__ unsigned xb_add(unsigned* p, unsigned v) { return __hip_atomic_fetch_add(p, v, __ATOMIC_RELAXED, __HIP_MEMORY_SCOPE_AGENT); }
__device__ __forceinline__ unsigned xb_xcc_id() { return (unsigned)__builtin_amdgcn_s_getreg((3 << 11) | 20) & 0xFu; }
#define XB_SPIN(cond, bar) do { unsigned _sp = 0; while (cond) { __builtin_amdgcn_s_sleep(1); \
    if ((++_sp & 255u) == 0u) { if (xb_ld(&(bar)[XB_TMO])) break; if (_sp > XB_SPIN_CAP) { atomicAdd(&(bar)[XB_TMO], 1u); break; } } } } while (0)

struct XcdBarrier {
    unsigned* bar; unsigned x;
    volatile LAS unsigned* st;
};

__device__ __forceinline__ XcdBarrier xcd_barrier_post(unsigned* bar, volatile LAS unsigned* st) {
    XcdBarrier b; b.bar = bar; b.x = xb_xcc_id(); b.st = st;
    if (threadIdx.x == 0) (void)xb_add(&bar[XB_XCNT(b.x)], 1u);
    return b;
}
__device__ __forceinline__ void xcd_barrier_complete(unsigned* bar, unsigned x, unsigned& nloc, unsigned& nx) {
    const unsigned G = gridDim.x * gridDim.y * gridDim.z;
    unsigned sum, cnt, mine, sp = 0u;
    for (;;) {
        sum = 0u; cnt = 0u; mine = 0u;
#pragma unroll
        for (unsigned j = 0; j < 16; ++j) { const unsigned c = xb_ld(&bar[XB_XCNT(j)]); sum += c; cnt += (c > 0u) ? 1u : 0u; mine = (j == x) ? c : mine; }
        if (sum == G) break;
        __builtin_amdgcn_s_sleep(1);
        if ((++sp & 255u) == 0u) { if (xb_ld(&bar[XB_TMO])) break; if (sp > XB_SPIN_CAP) { atomicAdd(&bar[XB_TMO], 1u); break; } }
    }
    nloc = mine > 0u ? mine : 1u; nx = cnt > 0u ? cnt : 1u;
}

__device__ __forceinline__ void xcd_barrier(const XcdBarrier& b, const unsigned char* pf = nullptr, int nchunk = 0, int wv = 0) {
    asm volatile("s_waitcnt vmcnt(0)" ::: "memory");
    __syncthreads();
    if (pf != nullptr && wv >= 1 && wv <= 4) {
        const int t = opaque_tid(wv) - 64;
        const pg8::u32x4* src = (const pg8::u32x4*)pf + (size_t)(blockIdx.x & 255) * nchunk;
        pg8::u32x4 v[9];
#pragma unroll
        for (int i = 0; i < 9; ++i) { int c = i * 256 + t; c = c < nchunk ? c : nchunk - 1; v[i] = src[c]; }
        asm volatile("" :: "v"(v[0]), "v"(v[1]), "v"(v[2]), "v"(v[3]), "v"(v[4]), "v"(v[5]), "v"(v[6]), "v"(v[7]), "v"(v[8]));
    }
    if (threadIdx.x == 0) {
        unsigned* bar = b.bar;
        __builtin_amdgcn_s_waitcnt(0);
        unsigned nloc = b.st[0], nx = b.st[1];
        if (nloc == 0u) { xcd_barrier_complete(bar, b.x, nloc, nx); b.st[0] = nloc; b.st[1] = nx; }
        const unsigned old = xb_add(&bar[XB_XSUB(b.x)], 1u);
        const unsigned gen = old / nloc;
        if (old + 1u == (gen + 1u) * nloc) {
            __builtin_amdgcn_fence(__ATOMIC_RELEASE, "agent");
            asm volatile("s_waitcnt vmcnt(0)" ::: "memory");
            const unsigned og = xb_add(&bar[XB_TOP], 1u);
            const unsigned tg = og / nx;
            if (og + 1u == (tg + 1u) * nx) xb_add(&bar[XB_TOPGEN], 1u);
            else XB_SPIN(xb_ld(&bar[XB_TOPGEN]) == tg, bar);
            __builtin_amdgcn_fence(__ATOMIC_ACQUIRE, "agent");
            xb_add(&bar[XB_XGEN(b.x)], 1u);
            asm volatile("s_waitcnt vmcnt(0)" ::: "memory");
        } else {
            XB_SPIN(xb_ld(&bar[XB_XGEN(b.x)]) == gen, bar);
            __builtin_amdgcn_fence(__ATOMIC_ACQUIRE, "agent");
            asm volatile("s_waitcnt vmcnt(0)" ::: "memory");
        }
    }
    __syncthreads();
}

template <bool RELEASE = false>
__device__ __forceinline__ void group_sync(unsigned* ctl, unsigned* a0, unsigned* a1, unsigned* a2, unsigned* a3, unsigned* w0, unsigned t0, unsigned* w1, unsigned t1, const unsigned char* pf = nullptr, int nchunk = 0, int wv = 0) {
    asm volatile("s_waitcnt vmcnt(0)" ::: "memory");
    __syncthreads();
    if (pf != nullptr && wv >= 1 && wv <= 4) {
        const int t = opaque_tid(wv) - 64;
        const pg8::u32x4* src = (const pg8::u32x4*)pf + (size_t)(blockIdx.x & 255) * nchunk;
        pg8::u32x4 v[9];
#pragma unroll
        for (int i = 0; i < 9; ++i) { int c = i * 256 + t; c = c < nchunk ? c : nchunk - 1; v[i] = src[c]; }
        asm volatile("" :: "v"(v[0]), "v"(v[1]), "v"(v[2]), "v"(v[3]), "v"(v[4]), "v"(v[5]), "v"(v[6]), "v"(v[7]), "v"(v[8]));
    }
    if (threadIdx.x == 0) {
        if (RELEASE) { __builtin_amdgcn_fence(__ATOMIC_RELEASE, "agent"); asm volatile("s_waitcnt vmcnt(0)" ::: "memory"); }
        (void)xb_add(a0, 1u); if (a1) (void)xb_add(a1, 1u); if (a2) (void)xb_add(a2, 1u); if (a3) (void)xb_add(a3, 1u);
        XB_SPIN(xb_ld(w0) < t0, ctl);
        if (w1 != nullptr) XB_SPIN(xb_ld(w1) < t1, ctl);
        __builtin_amdgcn_fence(__ATOMIC_ACQUIRE, "agent");
        asm volatile("s_waitcnt vmcnt(0)" ::: "memory");
    }
    __syncthreads();
}

__global__ void __launch_bounds__(512, 2) mega(Params p) {
    extern __shared__ __attribute__((aligned(16))) unsigned char lds[];
    const int G = gridDim.x, bid = blockIdx.x, NGW = G * NW;
    int wv = __builtin_amdgcn_readfirstlane((int)(threadIdx.x >> 6)); asm volatile("" : "+s"(wv));
#define PHASE_IDS() const int tid = opaque_tid(wv), lane = tid & 63, wave = __builtin_amdgcn_readfirstlane(tid >> 6), gw = bid * NW + wave; (void)tid; (void)lane; (void)gw
    unsigned char* ws = (unsigned char*)inptr(22);
    LAS unsigned char* L = (LAS unsigned char*)lds;
    volatile LAS unsigned* bst = (volatile LAS unsigned*)(L + LDS_BST);
    if (threadIdx.x < 4) bst[threadIdx.x] = 0u;
    __syncthreads();
    (void)xcd_barrier_post((unsigned*)(ws + WS_CTL), bst);
#define bar (XcdBarrier{(unsigned*)((unsigned char*)inptr(22) + WS_CTL), xb_xcc_id(), (volatile LAS unsigned*)((LAS unsigned char*)lds + LDS_BST)})

    {
        PHASE_IDS();
        LAS float* scr = (LAS float*)(L + wave * 8704);
        constexpr int I0 = (1024 / 64) * (DINP / 32), I1 = (QR / 64) * (MQ / 32), I2 = (KVR / 64) * (MKV / 32), I3 = 16 * 32, I4 = 16 * (FF / 32), I5 = (FF / 64) * 32;
        constexpr int I6 = (2048 / 64) * (128 / 32), I7 = (128 / 64) * (64 / 32);
        constexpr int NIT = I0 + I1 + I2 + I3 + I4 + I5 + 2 * I6 + 2 * I7;
        for (int it = gw; it < NIT; it += NGW) {
            int r = it;
            if (r < I0) { p0_transpose_item(inptr(2), 1024, DIN, DINP, (bf16_t*)(ws + WS_WIN), scr, r, lane, inptr(1), 0, 1); continue; } r -= I0;
            if (r < I1) { p0_transpose_item(inptr(5), QR, MQ, MQ, (bf16_t*)(ws + WS_WUQ), scr, r, lane, inptr(3)); continue; } r -= I1;
            if (r < I2) { p0_transpose_item(inptr(6), KVR, MKV, MKV, (bf16_t*)(ws + WS_WUKV), scr, r, lane, inptr(4), 0, 2); continue; } r -= I2;
            if (r < I3) { const int k0_ = 64 * (r / 32); p0_transpose_item(inptr(17), 1024, 1024, 1024, (bf16_t*)(ws + WS_WO), scr, r, lane, k0_ < 512 ? inptr(15) : inptr(16) - 512); continue; } r -= I3;
            if (r < I4) { p0_transpose_item(inptr(19), 1024, FF, FF, (bf16_t*)(ws + WS_WUP), scr, r, lane, inptr(18)); continue; } r -= I4;
            if (r < I5) { p0_transpose_item(inptr(20), FF, 1024, 1024, (bf16_t*)(ws + WS_WDN), scr, r, lane, nullptr, LDH); continue; } r -= I5;
            if (r < 2 * I6) { const int kv = r / I6; p0_transpose_item(inptr(12) + (size_t)kv * 2048 * 128, 2048, 128, 128, (bf16_t*)(ws + WS_W1T) + (size_t)kv * 128 * 2048, scr, r % I6, lane, nullptr, 0, 3); continue; } r -= 2 * I6;
            { const int kv = r / I7; p0_transpose_item(inptr(13) + kv * 128 * 64, 128, 64, 64, (bf16_t*)(ws + WS_W2T) + kv * 64 * 128, scr, r % I7, lane); }
        }
        for (int m = gw; m < M; m += 4 * NGW) rows_to_bf16_rstd<4>(inptr(0), (bf16_t*)(ws + WS_XB), (float*)(ws + WS_RS1), m, NGW, lane);
        for (int e = bid * 512 + tid; e < 2048 * 16; e += G * 512) { const int pos = e >> 4, i = e & 15; const float inv = exp2f(-(float)i * (13.287712379549449f / 16.f)); float sn, cs; sincosf((float)pos * inv, &sn, &cs);
            ((float*)(ws + WS_ROPE))[pos * 32 + i] = cs; ((float*)(ws + WS_ROPE))[pos * 32 + 16 + i] = sn; }
        for (int m = bid * 512 + tid; m < M; m += G * 512) { ((float*)(ws + WS_SSQ2))[m] = 0.f; ((float*)(ws + WS_RSQ))[m] = 0.f; ((float*)(ws + WS_RSKV))[m] = 0.f; ((float*)(ws + WS_SSQKR))[m] = 0.f; ((float*)(ws + WS_SSQM))[2 * m] = 0.f; ((float*)(ws + WS_SSQM))[2 * m + 1] = 0.f; }
    }
    xcd_barrier(bar);
    { pg8::Gemm g{(const bf16_t*)(ws + WS_XB), (const bf16_t*)(ws + WS_WIN), M, DINP, DM, DM, DM}; pg8::StaticOrder S; S.init(M, DINP, G, bid);
      PEpiProj E{(bf16_t*)(ws + WS_PROJ), DINP, (const float*)(ws + WS_RS1), (float*)(ws + WS_RSQ), (float*)(ws + WS_RSKV), (float*)(ws + WS_SSQKR), inptr(9), inptr(10), (const float*)(ws + WS_ROPE), inptr(8)}; pg8::gemm_phase<PEpiProj, pg8::StaticOrder, true, true>(L, g, S, E, wv); }
#define GCTL ((unsigned*)((unsigned char*)inptr(22) + WS_CTL))
#define GCNT(sp, pm) (GCTL + 4096 + ((sp) * 64 + (pm)) * 16)
    if (G == 256) { const int x_ = bid & 7, jj_ = (bid >> 3) & 7, k_ = bid >> 6;
        unsigned* c_ = GCNT(0, 8 * x_ + jj_); group_sync(GCTL, c_, nullptr, nullptr, nullptr, c_, 4u, ((k_ & 1) && jj_ < 7) ? GCNT(0, 8 * x_ + jj_ + 1) : nullptr, 4u); }
    else xcd_barrier(bar);
    { PHASE_IDS();
      __syncthreads();
      if (G == 256) { const int x_ = bid & 7, jj_ = (bid >> 3) & 7, k_ = bid >> 6; compress_block(ws, L, (2 * jj_ + (k_ & 1)) | (x_ << 4) | ((k_ >> 1) << 7), wv); }
      else for (int t = bid; t < 256; t += G) compress_block(ws, L, t, wv); }
    { pg8::Gemm g{(const bf16_t*)(ws + WS_PROJ) + P_HKV, (const bf16_t*)(ws + WS_WUKV), M, MKV, KVR, DINP, KVR}; pg8::StaticOrder S; S.init(M, MKV, G, bid);
      PEpiKV E{(bf16_t*)(ws + WS_KVM), (bf16_t*)(ws + WS_KMLA), (const bf16_t*)(ws + WS_PROJ), (const float*)(ws + WS_RSKV), (const float*)(ws + WS_SSQKR), (const float*)(ws + WS_ROPE), inptr(8)}; pg8::gemm_phase<PEpiKV, pg8::StaticOrder, true, true>(L, g, S, E, wv); }
    asm volatile("" : "+s"(wv));
    { pg8::Gemm g{(const bf16_t*)(ws + WS_PROJ) + P_HQ, (const bf16_t*)(ws + WS_WUQ), M, MQ, QR, DINP, QR}; pg8::StaticOrder S; S.init(M, MQ, G, bid);
      PEpiBf16<0> E{(bf16_t*)(ws + WS_QM), MQ, (const float*)(ws + WS_RSQ), 1.f / QR}; pg8::gemm_phase<PEpiBf16<0>, pg8::StaticOrder, true, false>(L, g, S, E, wv); }
    if (G == 256) { unsigned* c_ = GCNT(3, bid & 7); group_sync<true>(GCTL, c_, nullptr, nullptr, nullptr, c_, 32u, nullptr, 0u); }
    else xcd_barrier(bar);
    {
        PHASE_IDS();
        LAS float* tb = (LAS float*)L;
        for (int i = tid; i < 8 * 128; i += 512) { const int h = i >> 7, n = i & 127; tb[i] = (inptr(14)[t5_bucket(n) * 8 + h] - inptr(14)[31 * 8 + h]) * LOG2E; }
        __syncthreads();
        const int vcu = (G % 8 == 0) ? (bid % 8) * (G / 8) + bid / 8 : bid;
        for (int pr_ = vcu; pr_ < 256; pr_ += G) {
            { const int bg = pr_ >> 4, s_ = pr_ & 15;
#pragma unroll 1
              for (int u_ = 0; u_ < 2; ++u_) att::nsa_unit(ws, L, bg >> 1, bg & 1, (u_ & 1) ? s_ : 31 - s_, wv);
            }
            { const int bh = pr_ >> 2, s_ = pr_ & 3;
#pragma unroll 1
              for (int u_ = 0; u_ < 2; ++u_) att::mla_unit(ws, L, bh >> 3, bh & 7, u_ ? s_ : 7 - s_, wv, u_ ? (4 * (7 - s_) + 4) % att::NSLOT : 0, u_ ? 2 : 0, u_ ? 0 : 2);
            }
        }
    }
    if (G == 256) { const int x_ = bid & 7, j_ = bid >> 3, sn_ = j_ & 15, sm_ = j_ & 3;
        group_sync(GCTL, GCNT(4, 8 * x_ + ((31 - sn_) >> 2)), GCNT(4, 8 * x_ + (sn_ >> 2)), GCNT(4, 8 * x_ + 7 - sm_), GCNT(4, 8 * x_ + sm_), GCNT(4, 8 * x_ + (j_ & 7)), 16u, nullptr, 0u, ws + WS_WO, (int)((size_t)DM * DM * 2 / 16 / 256), wv); }
    else xcd_barrier(bar, ws + WS_WO, (int)((size_t)DM * DM * 2 / 16 / 256), wv);
    { pg8::Gemm g{(const bf16_t*)(ws + WS_MIX), (const bf16_t*)(ws + WS_WO), M, DM, DM, DM, DM}; pg8::StaticOrder S; S.init(M, DM, G, bid);
      PEpiWo E{(const bf16_t*)(ws + WS_XB), (bf16_t*)(ws + WS_H2), (float*)(ws + WS_SSQ2), (const float*)(ws + WS_SSQM), DM}; pg8::gemm_phase<PEpiWo, pg8::StaticOrder, true, true>(L, g, S, E, wv); }
    if (G == 256) { unsigned* c_ = GCNT(1, 8 * (bid & 7) + ((bid >> 3) & 7)); group_sync(GCTL, c_, nullptr, nullptr, nullptr, c_, 4u, nullptr, 0u, ws + WS_WUP, (int)((size_t)FF * DM * 2 / 16 / 256), wv); }
    else xcd_barrier(bar, ws + WS_WUP, (int)((size_t)FF * DM * 2 / 16 / 256), wv);
    { pg8::Gemm g{(const bf16_t*)(ws + WS_H2), (const bf16_t*)(ws + WS_WUP), M, FF, DM, DM, DM}; pg8::StaticOrder S; S.init(M, FF, G, bid);
      PEpiBf16<2> E{(bf16_t*)(ws + WS_HID), LDH, (const float*)(ws + WS_SSQ2), 1.f / 1024}; pg8::gemm_phase<PEpiBf16<2>, pg8::StaticOrder, true, true>(L, g, S, E, wv); }
    if (G == 256) { unsigned* c_ = GCNT(2, 8 * (bid & 7) + ((bid >> 3) & 7)); group_sync(GCTL, c_, nullptr, nullptr, nullptr, c_, 4u, nullptr, 0u, ws + WS_WDN, (int)((size_t)DM * LDH * 2 / 16 / 256), wv); }
    else xcd_barrier(bar, ws + WS_WDN, (int)((size_t)DM * LDH * 2 / 16 / 256), wv);
    { pg8::Gemm g{(const bf16_t*)(ws + WS_HID), (const bf16_t*)(ws + WS_WDN), M, DM, FF, LDH, LDH}; pg8::StaticOrder S; S.init(M, DM, G, bid);
      PEpiDown E{(const bf16_t*)(ws + WS_H2), ((float*)inptr(21)), DM}; pg8::gemm_phase<PEpiDown, pg8::StaticOrder, true, true>(L, g, S, E, wv); }
#undef bar
}

extern "C" void kernel_launch(void* const* d_in, const int* in_sizes, int n_in, void* d_out, int out_size,
                              void* d_ws, size_t ws_size, hipStream_t stream) {
    static int grid_blocks = 0;
    if (!grid_blocks) {
        int dev = 0, cus = 0, per_cu = 0;
        (void)hipGetDevice(&dev);
        (void)hipDeviceGetAttribute(&cus, hipDeviceAttributeMultiprocessorCount, dev);
        (void)hipFuncSetAttribute((const void*)mega, hipFuncAttributeMaxDynamicSharedMemorySize, LDS_BYTES);
        (void)hipOccupancyMaxActiveBlocksPerMultiprocessor(&per_cu, (const void*)mega, 512, LDS_BYTES);
        if (per_cu != 1) fprintf(stderr, "note: occupancy query reports %d blocks/CU; launching 1 per CU\n", per_cu);
        grid_blocks = cus;
        if (n_in != 21 || out_size != M * DM || ws_size < 256 * MiB) fprintf(stderr, "unexpected shapes: n_in %d out %d ws %zu\n", n_in, out_size, ws_size);
    }
    Params p{};
    for (int i = 0; i < 21; ++i) p.in[i] = (const float*)d_in[i];
    p.out = (float*)d_out; p.ws = (unsigned char*)d_ws;
    if (hipMemsetAsync((char*)d_ws + WS_CTL, 0, CTL_ZERO_BYTES, stream) != hipSuccess) { fprintf(stderr, "memset of the barrier words failed\n"); return; }
    hipLaunchKernelGGL(mega, dim3(grid_blocks), dim3(512), LDS_BYTES, stream, p);
    hipError_t e = hipPeekAtLastError();
    if (e != hipSuccess) fprintf(stderr, "launch failed: %s (grid %d)\n", hipGetErrorString(e), grid_blocks);
}
```

```cpp
#include <hip/hip_runtime.h>
#include <cstdio>
#include <cstdint>

#define LAS __attribute__((address_space(3)))
typedef unsigned short bf16_t;
typedef short bf16x8 __attribute__((ext_vector_type(8)));
typedef float f32x4 __attribute__((ext_vector_type(4)));
typedef unsigned u32x4 __attribute__((ext_vector_type(4)));
typedef unsigned u32x2 __attribute__((ext_vector_type(2)));

constexpr int BATCH = 8, SEQ = 2048, DM = 1024, M = BATCH * SEQ;
constexpr int DIN = 1976, DINP = 2048;
constexpr int C_HQ = 0, C_HKV = 384, C_HKR = 640, C_QB = 672, C_KVB = 1184, C_GATE = 1952;
constexpr int C_KCMP = C_KVB, C_VCMP = C_KVB + 128, C_KSEL = C_KVB + 256, C_VSEL = C_KVB + 384, C_KWIN = C_KVB + 512, C_VWIN = C_KVB + 640;
constexpr int P_HQ = 1280, P_HKV = 1664, P_HKR = 1920, P_GATE = 1952;
__host__ __device__ constexpr int slot_base(int s) { return 256 * (s >> 2) + 32 * (s & 3); }
constexpr int S_Q = 0, S_KCMP = 8, S_VCMP = 10, S_KSEL = 12, S_VSEL = 14, S_KWIN = 16, S_VWIN = 18;
constexpr int QR = 384, KVR = 256, MQ = 768, MKV = 1024, FF = 4096;
constexpr int LDH = FF + 64;
constexpr int NCMP = 127;
constexpr float EPS = 1e-6f;
constexpr float LOG2E = 1.4426950408889634f;
constexpr float QS_MLA = 0.10206207261596577f * LOG2E;
constexpr float QS_NSA = 0.125f * LOG2E;

constexpr size_t MiB = 1u << 20;
constexpr size_t WS_CTL = 0, CTL_ZERO_BYTES = 65536;
constexpr size_t WS_WIN = 1 * MiB, WS_WUQ = 5 * MiB, WS_WUKV = 6 * MiB, WS_WO = 7 * MiB, WS_WUP = 9 * MiB, WS_WDN = 17 * MiB;
constexpr size_t WS_KCMP = 26 * MiB, WS_VCMP = 26 * MiB + 512 * 1024;
constexpr size_t WS_W1T = 30 * MiB;
constexpr size_t WS_W2T = 27 * MiB;
constexpr size_t WS_RSQ = 28 * MiB, WS_RSKV = 28 * MiB + 65536, WS_SSQ2 = 28 * MiB + 131072, WS_SSQM = 28 * MiB + 262144, WS_RS1 = 28 * MiB + 262144 + 131072;
constexpr size_t WS_SSQKR = 28 * MiB + 524288;
constexpr size_t WS_ROPE = 29 * MiB + 65536;
constexpr size_t WS_XB = 32 * MiB;
constexpr size_t WS_DUMMY0 = 0;
constexpr size_t WS_HB = 32 * MiB;
constexpr size_t WS_MIX = 64 * MiB;
constexpr size_t WS_PROJ = 96 * MiB;
constexpr size_t WS_QM = 160 * MiB;
constexpr size_t WS_KVM = 184 * MiB;
constexpr size_t WS_KMLA = 216 * MiB;
constexpr size_t WS_QN = 208 * MiB;
constexpr size_t WS_KSEL = 240 * MiB;
constexpr size_t WS_KWIN = 244 * MiB;
constexpr size_t WS_HQN = 232 * MiB;
constexpr size_t WS_HKVN = 244 * MiB;
constexpr size_t WS_H2 = 224 * MiB;
constexpr size_t WS_HID = 32 * MiB;

constexpr int LDS_BYTES = 155648, LDS_BST = 154624;
constexpr int NW = 8;

struct Params {
    const float* in[21];
    float* out;
    unsigned char* ws;
};

typedef const float* cfptr_t;
__device__ __forceinline__ const float* inptr(int i) {
    const __attribute__((address_space(4))) char* ka = (const __attribute__((address_space(4))) char*)__builtin_amdgcn_kernarg_segment_ptr();
    int off = i * 8; asm volatile("" : "+s"(off));
    return *(const __attribute__((address_space(4))) cfptr_t*)(ka + off);
}
template <class V> __device__ __forceinline__ void st16_wt(const void* sbase, unsigned voff, const V& v) { static_assert(sizeof(V) == 16, "16-byte vector"); asm volatile("global_store_dwordx4 %0, %1, %2 sc1\n\ts_nop 1" :: "v"(voff), "v"(v), "s"(sbase) : "memory"); }
__device__ __forceinline__ unsigned f2bf(float f) { unsigned u = __builtin_bit_cast(unsigned, f); return (u + 0x7fffu + ((u >> 16) & 1u)) >> 16; }
__device__ __forceinline__ float bf2f(unsigned b) { return __builtin_bit_cast(float, b << 16); }
__device__ __forceinline__ unsigned pk2(float lo, float hi) { return f2bf(lo) | (f2bf(hi) << 16); }
__device__ __forceinline__ float wave_sum(float v) {
#pragma unroll
    for (int o = 1; o < 64; o <<= 1) v += __shfl_xor(v, o);
    return v;
}
__device__ __forceinline__ int t5_bucket(int n) {
    if (n < 16) return n;
    int b = 16;
    b += (n >= 19); b += (n >= 21); b += (n >= 24); b += (n >= 27); b += (n >= 31); b += (n >= 35); b += (n >= 40); b += (n >= 46);
    b += (n >= 52); b += (n >= 59); b += (n >= 67); b += (n >= 77); b += (n >= 87); b += (n >= 99); b += (n >= 113);
    return b;
}

__device__ __forceinline__ void p0_transpose_item(const float* W, int K, int N, int Npad, bf16_t* WT, LAS float* scr, int item, int lane, const float* gk = nullptr, int ldw = 0, int projmap = 0) {
    const int nblk = Npad / 32, kb = item / nblk, nb = item % nblk, k0 = 64 * kb, n0 = 32 * nb;
    int nsrc = n0;
    if (projmap == 2) { const int pn_ = n0 >> 8, bj_ = (n0 >> 7) & 1, wc_ = (n0 >> 5) & 3; nsrc = (wc_ < 2 ? 128 * (2 * pn_ + wc_) : 128 * (2 * pn_ + wc_ - 2) + 64) + 32 * bj_; }
    else if (projmap == 1) { if (n0 < 1280) { const int sl = 4 * (n0 >> 8) + ((n0 & 127) >> 5), e0 = 32 * ((n0 >> 7) & 1); nsrc = (sl < 8 ? C_QB + 64 * sl : C_KVB + 64 * (sl - 8)) + e0; }
                   else if (n0 < 1280 + 672) nsrc = n0 - 1280; else if (n0 == P_GATE) nsrc = C_GATE; else nsrc = N; }
    const int nn = nsrc + (lane & 31);
    float wv[32];
#pragma unroll
    for (int i = 0; i < 32; ++i) { const int kk = 2 * i + (lane >> 5); wv[i] = (nn < N) ? W[(size_t)(k0 + kk) * N + nn] : 0.f; }
#pragma unroll
    for (int i = 0; i < 32; ++i) { const int kk = 2 * i + (lane >> 5); const float gg = gk ? gk[k0 + kk] : 1.f; scr[kk * 33 + (lane & 31)] = wv[i] * gg; }
    asm volatile("s_waitcnt lgkmcnt(0)" ::: "memory");
    const int c = lane & 7;
#pragma unroll
    for (int j = 0; j < 4; ++j) { const int n = (lane >> 3) + 8 * j; const LAS float* s = scr + (8 * c) * 33 + n;
        u32x4 o; o.x = pk2(s[0 * 33], s[1 * 33]); o.y = pk2(s[2 * 33], s[3 * 33]); o.z = pk2(s[4 * 33], s[5 * 33]); o.w = pk2(s[6 * 33], s[7 * 33]);
        if (projmap == 3) { const int nn_ = n0 + n, k_ = k0 + 8 * c;
            *(u32x4*)(WT + ((size_t)(((k_ >> 5) * (Npad >> 4) + (nn_ >> 4)) * 64 + ((k_ >> 3) & 3) * 16 + (nn_ & 15))) * 8) = o; }
        else *(u32x4*)(WT + (size_t)(n0 + n) * (ldw ? ldw : K) + k0 + 8 * c) = o; }
    asm volatile("s_waitcnt lgkmcnt(0)" ::: "memory");
}
template <int NR>
__device__ __forceinline__ void rows_to_bf16_rstd(const float* x, bf16_t* o, float* rstd_out, int row0, int rstride, int lane) {
    f32x4 v[NR][4];
#pragma unroll
    for (int r = 0; r < NR; ++r) { const int rr = (row0 + r * rstride < M) ? row0 + r * rstride : row0; const f32x4* xr = (const f32x4*)(x + (size_t)rr * DM) + lane;
#pragma unroll
        for (int j = 0; j < 4; ++j) v[r][j] = xr[64 * j]; }
#pragma unroll
    for (int r = 0; r < NR; ++r) { if (row0 + r * rstride >= M) continue; float s = 0.f;
#pragma unroll
        for (int j = 0; j < 4; ++j) s += (v[r][j].x * v[r][j].x + v[r][j].y * v[r][j].y) + (v[r][j].z * v[r][j].z + v[r][j].w * v[r][j].w);
        s = wave_sum(s);
        if (lane == 0) rstd_out[row0 + r * rstride] = 1.f / sqrtf(s * (1.f / DM) + EPS);
        unsigned long long* o8 = (unsigned long long*)(o + (size_t)(row0 + r * rstride) * DM) + lane;
#pragma unroll
        for (int j = 0; j < 4; ++j) o8[64 * j] = (unsigned long long)pk2(v[r][j].x, v[r][j].y) | ((unsigned long long)pk2(v[r][j].z, v[r][j].w) << 32); }
}

__device__ __forceinline__ int opaque_tid(int wv) { int lane; asm volatile("v_mbcnt_lo_u32_b32 %0, -1, 0\n\tv_mbcnt_hi_u32_b32 %0, -1, %0" : "=v"(lane)); return (wv << 6) | lane; }
namespace pg8 {
#define PG8_LAS __attribute__((address_space(3)))
typedef unsigned short bf16_t;
typedef short bf16x8 __attribute__((ext_vector_type(8)));
typedef float f32x4 __attribute__((ext_vector_type(4)));
typedef unsigned u32x4 __attribute__((ext_vector_type(4)));
constexpr int BM = 256, BK = 64, HALF = 128, HTB = HALF * BK * 2  , STAGE_BYTES = 8 * HTB, NXCD = 8, WGM = 8;

__host__ __device__ __forceinline__ int lds_byte(int r, int c) { const int st = (r >> 4) * 2 + (c >> 5), rr = r & 15, cc = c & 31, ob = rr * 64 + cc * 2; return st * 1024 + (ob ^ (((ob >> 9) & 1) << 5)); }
__host__ __device__ __forceinline__ void stage_rc(int b, int& R, int& C) { const int st = b / 1024, sb = b % 1024, swz = sb ^ (((sb >> 9) & 1) << 5); R = (st >> 1) * 16 + swz / 64; C = (st & 1) * 32 + (swz % 64) / 2; }
__host__ __device__ __forceinline__ int perm32(int rho) { const int n = rho >> 4, i = rho & 15; return 8 * (i >> 2) + 4 * n + (i & 3); }

struct Unit { int pm, pn; };
struct Gemm { const bf16_t* A; const bf16_t* Bt; int M, N, K, lda, ldb; };

struct StaticOrder {
    int nM, nN, nwg, G, c;
    __host__ __device__ void init(int M, int N, int G_, int c_) { nM = M / BM; nN = N / BM; nwg = nM * nN; G = G_; c = c_; }
    __host__ __device__ bool next(int i, Unit& u) const {
        const long L = (long)i * G + c; if (L >= nwg) return false;
        int wgid = (int)L; { const int q = nwg / NXCD, r = nwg % NXCD, xcd = wgid % NXCD, off = wgid / NXCD; wgid = (xcd < r ? xcd * (q + 1) : r * (q + 1) + (xcd - r) * q) + off; }
        const int nig = WGM * nN, gid = wgid / nig, fm = gid * WGM, gsz = (nM - fm) < WGM ? (nM - fm) : WGM;
        u.pm = fm + ((wgid % nig) % gsz); u.pn = (wgid % nig) / gsz; return true;
    }
    __device__ __forceinline__ void a_ready(const Unit&) const {}
    __device__ __forceinline__ void done(const Unit&) const {}
};

template <class Epi, class Sched, bool ALIGN_EPI = false, bool SP2 = false>
__device__ __forceinline__ void gemm_phase(PG8_LAS unsigned char* lds, const Gemm g, const Sched& S, const Epi& E, int wv) {
    const int tid = opaque_tid(wv), wid = __builtin_amdgcn_readfirstlane(tid >> 6), lane = tid & 63, wr = wid >> 2, wc = wid & 3, fr = lane & 15, fq = lane >> 4;
    const int K = g.K, nt = K / BK;
    unsigned voffA[2], voffB[2];
#pragma unroll
    for (int i = 0; i < 2; ++i) { int R, C; stage_rc(tid * 16 + i * 8192, R, C); const int Rb = Epi::PERM ? ((R & ~31) + perm32(R & 31)) : R;
        voffA[i] = (unsigned)(R * g.lda + C) * 2u; voffB[i] = (unsigned)(Rb * g.ldb + C) * 2u; }
    const size_t kstep = (size_t)(BK * 2);
    const size_t hstepA = (size_t)HALF * g.lda * 2, hstepB = (size_t)HALF * g.ldb * 2;
    const size_t tstepA = 2 * hstepA, tstepB = 2 * hstepB;
    const unsigned ldsw = (unsigned)wid * 1024u;
    const int aoff = lds_byte(wr * 64 + fr, fq * 8), boff = lds_byte(wc * 32 + fr, fq * 8);
#define PG8_SA(b, h) (((b) * 2 + (h)) * HTB)
#define PG8_SB(b, h) ((4 + (b) * 2 + (h)) * HTB)
#define PG8_STAGE(bufoff, gbase, voff) do { _Pragma("unroll") for (int _i = 0; _i < 2; ++_i) \
        __builtin_amdgcn_global_load_lds((const unsigned*)((const char*)(gbase) + (voff)[_i]), (PG8_LAS unsigned*)(lds + (bufoff) + ldsw + _i * 8192), 16, 0, 0); } while (0)
#define PG8_LDA(dst, b, h) do { _Pragma("unroll") for (int m = 0; m < 4; ++m) _Pragma("unroll") for (int k = 0; k < 2; ++k) dst[m][k] = *(const PG8_LAS bf16x8*)(lds + PG8_SA(b, h) + aoff + m * 2048 + k * 1024); } while (0)
#define PG8_LDB(dst, b, h) do { _Pragma("unroll") for (int n = 0; n < 2; ++n) _Pragma("unroll") for (int k = 0; k < 2; ++k) dst[n][k] = *(const PG8_LAS bf16x8*)(lds + PG8_SB(b, h) + boff + n * 2048 + k * 1024); } while (0)
#define PG8_MMA(ai, bj, At, Bt) do { __builtin_amdgcn_s_setprio(1); _Pragma("unroll") for (int m = 0; m < 4; ++m) _Pragma("unroll") for (int n = 0; n < 2; ++n) _Pragma("unroll") for (int k = 0; k < 2; ++k) \
        acc[ai][bj][m][n] = __builtin_amdgcn_mfma_f32_16x16x32_bf16(Bt[n][k], At[m][k], acc[ai][bj][m][n], 0, 0, 0); __builtin_amdgcn_s_setprio(0); } while (0)
#define PG8_WAIT_V(n) asm volatile("s_waitcnt vmcnt(" #n ")" ::: "memory")
#define PG8_WAIT_L(n) asm volatile("s_waitcnt lgkmcnt(" #n ")" ::: "memory")
#define PG8_BAR __builtin_amdgcn_s_barrier()
#define PG8_SCHED __builtin_amdgcn_sched_barrier(0)
    Unit cur, nxt; int ui = 0;
    if (!S.next(0, cur)) return;
    f32x4 acc[2][2][4][2];
#pragma unroll
    for (int a = 0; a < 2; ++a)
#pragma unroll
        for (int b = 0; b < 2; ++b)
#pragma unroll
            for (int m = 0; m < 4; ++m)
#pragma unroll
                for (int n = 0; n < 2; ++n) acc[a][b][m][n] = (f32x4){0.f, 0.f, 0.f, 0.f};
    bf16x8 At[4][2], B0[2][2], B1[2][2];
    const char* cA = (const char*)g.A + (size_t)cur.pm * tstepA; const char* cB = (const char*)g.Bt + (size_t)cur.pn * tstepB;
    asm volatile("" : "+s"(cA), "+s"(cB));
    S.a_ready(cur);
    if constexpr (SP2) {
        PG8_STAGE(PG8_SB(0, 0), cB, voffB); PG8_STAGE(PG8_SB(0, 1), cB + hstepB, voffB); PG8_STAGE(PG8_SA(0, 0), cA, voffA); PG8_STAGE(PG8_SA(0, 1), cA + hstepA, voffA);
        if (wr == 1) PG8_BAR;
        PG8_WAIT_V(2); PG8_BAR;
        PG8_STAGE(PG8_SB(1, 0), cB + kstep, voffB); PG8_STAGE(PG8_SA(1, 0), cA + kstep, voffA); PG8_STAGE(PG8_SB(1, 1), cB + hstepB + kstep, voffB);
        PG8_WAIT_V(6); PG8_BAR;
    } else {
        PG8_STAGE(PG8_SB(0, 0), cB, voffB); PG8_STAGE(PG8_SA(0, 0), cA, voffA); PG8_STAGE(PG8_SB(0, 1), cB + hstepB, voffB); PG8_STAGE(PG8_SA(0, 1), cA + hstepA, voffA);
        if (wr == 1) PG8_BAR;
        PG8_WAIT_V(4); PG8_BAR;
        PG8_STAGE(PG8_SB(1, 0), cB + kstep, voffB); PG8_STAGE(PG8_SA(1, 0), cA + kstep, voffA); PG8_STAGE(PG8_SB(1, 1), cB + hstepB + kstep, voffB);
        PG8_WAIT_V(6); PG8_BAR;
    }
    for (;;) {
        const bool has_next = S.next(ui + 1, nxt);
        const char* nA = has_next ? (const char*)g.A + (size_t)nxt.pm * tstepA : cA; const char* nB = has_next ? (const char*)g.Bt + (size_t)nxt.pn * tstepB : cB;
        asm volatile("" : "+s"(nA), "+s"(nB));
        for (int t = 0; t < nt; t += 2) {
            if constexpr (Epi::MIDSCALE) { if (t == nt / 2) E.midscale(acc, cur, wr, fr); }
            const bool last = (t == nt - 2);
            const char* a1 = cA + (size_t)(t + 1) * kstep;
            const char* a2 = last ? nA : cA + (size_t)(t + 2) * kstep; const char* b2 = last ? nB : cB + (size_t)(t + 2) * kstep;
            const char* a3 = a2 + kstep; const char* b3 = b2 + kstep;
            asm volatile("" : "+s"(a1), "+s"(a2), "+s"(b2), "+s"(a3), "+s"(b3));
            if (last && has_next) S.a_ready(nxt);
            if constexpr (SP2) {
            PG8_LDB(B0, 0, 0); PG8_LDB(B1, 0, 1); PG8_SCHED; PG8_LDA(At, 0, 0); PG8_STAGE(PG8_SA(1, 1), a1 + hstepA, voffA);
            PG8_WAIT_V(8); PG8_WAIT_L(0); PG8_BAR; PG8_MMA(0, 0, At, B0); PG8_MMA(0, 1, At, B1); PG8_BAR; PG8_SCHED;
            PG8_LDA(At, 0, 1); PG8_STAGE(PG8_SB(0, 0), b2, voffB); PG8_STAGE(PG8_SB(0, 1), b2 + hstepB, voffB); PG8_STAGE(PG8_SA(0, 0), a2, voffA);
            PG8_WAIT_V(8); PG8_WAIT_L(0); PG8_BAR; PG8_MMA(1, 0, At, B0); PG8_MMA(1, 1, At, B1); PG8_BAR; PG8_SCHED;
            PG8_LDB(B0, 1, 0); PG8_LDB(B1, 1, 1); PG8_SCHED; PG8_LDA(At, 1, 0); PG8_STAGE(PG8_SA(0, 1), a2 + hstepA, voffA);
            PG8_WAIT_V(8); PG8_WAIT_L(0); PG8_BAR; PG8_MMA(0, 0, At, B0); PG8_MMA(0, 1, At, B1); PG8_BAR; PG8_SCHED;
            PG8_LDA(At, 1, 1); PG8_STAGE(PG8_SB(1, 0), b3, voffB); PG8_STAGE(PG8_SB(1, 1), b3 + hstepB, voffB); PG8_STAGE(PG8_SA(1, 0), a3, voffA);
            PG8_WAIT_V(8); PG8_WAIT_L(0); PG8_BAR; PG8_MMA(1, 0, At, B0); PG8_MMA(1, 1, At, B1); PG8_BAR; PG8_SCHED;
            } else {
            PG8_LDB(B0, 0, 0); PG8_SCHED; PG8_LDA(At, 0, 0); PG8_STAGE(PG8_SA(1, 1), a1 + hstepA, voffA);
            PG8_WAIT_L(8); PG8_BAR; PG8_WAIT_L(0); PG8_MMA(0, 0, At, B0); PG8_BAR; PG8_SCHED;
            PG8_LDB(B1, 0, 1); PG8_STAGE(PG8_SB(0, 0), b2, voffB);
            PG8_BAR; PG8_WAIT_L(0); PG8_MMA(0, 1, At, B1); PG8_BAR;
            PG8_LDA(At, 0, 1); PG8_STAGE(PG8_SA(0, 0), a2, voffA);
            PG8_BAR; PG8_WAIT_L(0); PG8_MMA(1, 0, At, B0); PG8_BAR; PG8_SCHED;
            PG8_STAGE(PG8_SB(0, 1), b2 + hstepB, voffB);
            PG8_WAIT_V(6); PG8_BAR; PG8_MMA(1, 1, At, B1); PG8_BAR;
            PG8_LDB(B0, 1, 0); PG8_SCHED; PG8_LDA(At, 1, 0); PG8_STAGE(PG8_SA(0, 1), a2 + hstepA, voffA);
            PG8_WAIT_L(8); PG8_BAR; PG8_WAIT_L(0); PG8_MMA(0, 0, At, B0); PG8_BAR; PG8_SCHED;
            PG8_LDB(B1, 1, 1); PG8_STAGE(PG8_SB(1, 0), b3, voffB);
            PG8_BAR; PG8_WAIT_L(0); PG8_MMA(0, 1, At, B1); PG8_BAR;
            PG8_LDA(At, 1, 1); PG8_STAGE(PG8_SA(1, 0), a3, voffA);
            PG8_BAR; PG8_WAIT_L(0); PG8_MMA(1, 0, At, B0); PG8_BAR; PG8_SCHED;
            PG8_STAGE(PG8_SB(1, 1), b3 + hstepB, voffB);
            PG8_WAIT_V(6); PG8_BAR; PG8_MMA(1, 1, At, B1); PG8_BAR;
            }
        }
        if constexpr (ALIGN_EPI) { if (wr == 0) PG8_BAR; }
        if constexpr (!Epi::AFTER_DRAIN) { const int l2_ = opaque_tid(wv) & 63; E(acc, cur, wr, wc, l2_ & 15, l2_ >> 4); S.done(cur); }
        if (!has_next) break;
#pragma unroll
        for (int a = 0; a < 2; ++a)
#pragma unroll
            for (int b = 0; b < 2; ++b)
#pragma unroll
                for (int m = 0; m < 4; ++m)
#pragma unroll
                    for (int n = 0; n < 2; ++n) acc[a][b][m][n] = (f32x4){0.f, 0.f, 0.f, 0.f};
        cur = nxt; cA = nA; cB = nB; ++ui;
        if constexpr (ALIGN_EPI) { if (wr == 1) PG8_BAR; }
    }
    PG8_WAIT_V(0);
    if constexpr (!ALIGN_EPI) { if (wr == 0) PG8_BAR; }
    PG8_BAR;
    if constexpr (Epi::AFTER_DRAIN) { E.fused(acc, cur, wr, wc, fr, fq, lds, wid, lane); S.done(cur); }
#undef PG8_SA
#undef PG8_SB
#undef PG8_STAGE
#undef PG8_LDA
#undef PG8_LDB
#undef PG8_MMA
#undef PG8_WAIT_V
#undef PG8_WAIT_L
#undef PG8_BAR
#undef PG8_SCHED
}
}

__device__ __forceinline__ unsigned cvt_pk_bf16(float lo, float hi) { unsigned r; asm volatile("v_cvt_pk_bf16_f32 %0, %1, %2" : "=v"(r) : "v"(lo), "v"(hi)); return r; }
__device__ __forceinline__ void overlay_gate(const unsigned* cnt, unsigned target) {
    if (cnt == nullptr) return;
    unsigned spins = 0;
    while ((unsigned)__builtin_amdgcn_readfirstlane((int)__hip_atomic_load(cnt, __ATOMIC_RELAXED, __HIP_MEMORY_SCOPE_AGENT)) < target) { __builtin_amdgcn_s_sleep(2); if (++spins > (1u << 20)) break; }
}
template <int ACT> struct PEpiBf16 {
    static constexpr bool PERM = true, AFTER_DRAIN = false, MIDSCALE = false;
    bf16_t* O; int ldc; const float* rs; float invn; const unsigned* gate;
    __device__ __forceinline__ void operator()(const f32x4 (&acc)[2][2][4][2], const pg8::Unit& u, int wr, int wc, int fr, int fq) const {
        const int row0 = u.pm * 256 + wr * 64 + fr, col0 = u.pn * 256 + wc * 32 + 8 * fq;
        overlay_gate(gate, 256u);
        float rsc[2][4];
#pragma unroll
        for (int ai = 0; ai < 2; ++ai)
#pragma unroll
            for (int m = 0; m < 4; ++m) rsc[ai][m] = rs ? rs[row0 + ai * 128 + m * 16] : 1.f;
        if (invn > 0.f) {
#pragma unroll
            for (int ai = 0; ai < 2; ++ai)
#pragma unroll
                for (int m = 0; m < 4; ++m) rsc[ai][m] = 1.f / sqrtf(rsc[ai][m] * invn + EPS); }
#pragma unroll
        for (int ai = 0; ai < 2; ++ai)
#pragma unroll
            for (int m = 0; m < 4; ++m) { const bf16_t* rowp = O + ((size_t)(u.pm * 256 + wr * 64 + ai * 128 + m * 16) * ldc + u.pn * 256 + wc * 32); const unsigned lo_ = (unsigned)(fr * ldc + 8 * fq) * 2u; const float sc_ = rsc[ai][m];
#pragma unroll
                for (int bj = 0; bj < 2; ++bj) { f32x4 v0 = acc[ai][bj][m][0] * sc_, v1 = acc[ai][bj][m][1] * sc_;
                    if (ACT == 2) {
#pragma unroll
                        for (int e = 0; e < 4; ++e) { const float a = fmaxf(v0[e], 0.f), b = fmaxf(v1[e], 0.f); v0[e] = a * a; v1[e] = b * b; } }
                    u32x4 w; w.x = cvt_pk_bf16(v0[0], v0[1]); w.y = cvt_pk_bf16(v0[2], v0[3]); w.z = cvt_pk_bf16(v1[0], v1[1]); w.w = cvt_pk_bf16(v1[2], v1[3]);
                    st16_wt(rowp + bj * 128, lo_, w); } }
    }
};
struct PEpiProj {
    static constexpr bool PERM = true, AFTER_DRAIN = false, MIDSCALE = false;
    bf16_t* O; int ldc; const float* rs1; float* ssq_q; float* ssq_kv; float* ssq_kr; const float* qgain; const float* kgain; const float* rope; const float* kgm;
    __device__ __forceinline__ void operator()(const f32x4 (&acc)[2][2][4][2], const pg8::Unit& u, int wr, int wc, int fr, int fq) const {
        const int row0 = u.pm * 256 + wr * 64 + fr, col0 = u.pn * 256 + wc * 32 + 8 * fq, lane = fq * 16 + fr;
        float rsc[2][4];
#pragma unroll
        for (int ai = 0; ai < 2; ++ai)
#pragma unroll
            for (int m = 0; m < 4; ++m) rsc[ai][m] = rs1[row0 + ai * 128 + m * 16];
        const int sl = 4 * u.pn + wc;
        int mode = 0; const float* g = nullptr; float gs = 1.f;
        if (u.pn < 5) { if (sl < 8) { mode = 1; g = qgain; gs = QS_NSA; } else if (sl == S_KSEL || sl == S_KSEL + 1) { mode = 1; g = kgain + 64; } else if (sl == S_KWIN || sl == S_KWIN + 1) { mode = 1; g = kgain + 128; } }
        f32x4 ga[2][2];
        if (mode == 1) {
#pragma unroll
            for (int bj = 0; bj < 2; ++bj) { ga[bj][0] = *(const f32x4*)(g + 32 * bj + 8 * fq) * gs; ga[bj][1] = *(const f32x4*)(g + 32 * bj + 8 * fq + 4) * gs; } }
#pragma unroll
        for (int ai = 0; ai < 2; ++ai)
#pragma unroll
            for (int m = 0; m < 4; ++m) { const int row = row0 + ai * 128 + m * 16; const bf16_t* rowp = O + ((size_t)(u.pm * 256 + wr * 64 + ai * 128 + m * 16) * ldc + u.pn * 256 + wc * 32); const unsigned lo_ = (unsigned)(fr * ldc + 8 * fq) * 2u; const float sc_ = rsc[ai][m];
                f32x4 v[2][2];
#pragma unroll
                for (int bj = 0; bj < 2; ++bj) { v[bj][0] = acc[ai][bj][m][0] * sc_; v[bj][1] = acc[ai][bj][m][1] * sc_; }
                if (mode == 1) {
                    float ss = 0.f;
#pragma unroll
                    for (int bj = 0; bj < 2; ++bj)
#pragma unroll
                        for (int n = 0; n < 2; ++n) ss += (v[bj][n][0] * v[bj][n][0] + v[bj][n][1] * v[bj][n][1]) + (v[bj][n][2] * v[bj][n][2] + v[bj][n][3] * v[bj][n][3]);
                    ss += __builtin_bit_cast(float, __builtin_amdgcn_ds_bpermute((lane ^ 16) << 2, __builtin_bit_cast(int, ss)));
                    ss += __builtin_bit_cast(float, __builtin_amdgcn_ds_bpermute((lane ^ 32) << 2, __builtin_bit_cast(int, ss)));
                    const float rstd = 1.f / sqrtf(ss * (1.f / 64) + EPS);
#pragma unroll
                    for (int bj = 0; bj < 2; ++bj) { v[bj][0] = v[bj][0] * rstd * ga[bj][0]; v[bj][1] = v[bj][1] * rstd * ga[bj][1]; }
                } else if (u.pn >= 5) {
#pragma unroll
                    for (int bj = 0; bj < 2; ++bj) { const int cb = u.pn * 256 + bj * 128;
                        float* dst = (cb < P_HKV) ? ssq_q : (cb < P_HKR ? ssq_kv : ((cb == P_HKR && wc == 0) ? ssq_kr : nullptr));
                        if (dst) { float ss = (v[bj][0][0] * v[bj][0][0] + v[bj][0][1] * v[bj][0][1]) + (v[bj][0][2] * v[bj][0][2] + v[bj][0][3] * v[bj][0][3]) + (v[bj][1][0] * v[bj][1][0] + v[bj][1][1] * v[bj][1][1]) + (v[bj][1][2] * v[bj][1][2] + v[bj][1][3] * v[bj][1][3]);
                            ss += __builtin_bit_cast(float, __builtin_amdgcn_ds_bpermute((lane ^ 16) << 2, __builtin_bit_cast(int, ss)));
                            ss += __builtin_bit_cast(float, __builtin_amdgcn_ds_bpermute((lane ^ 32) << 2, __builtin_bit_cast(int, ss)));
                            if (fq == 0) __hip_atomic_fetch_add(dst + row, ss, __ATOMIC_RELAXED, __HIP_MEMORY_SCOPE_AGENT); }
                        if (cb == P_HKR && wc == 0) {
                            const f32x4 g0 = *(const f32x4*)(kgm + 64 + 8 * fq), g1 = *(const f32x4*)(kgm + 64 + 8 * fq + 4);
                            const float* rp = rope + (size_t)(row & (SEQ - 1)) * 32 + 8 * (fq & 1);
                            const f32x4 c0 = *(const f32x4*)rp, c1 = *(const f32x4*)(rp + 4), s0 = *(const f32x4*)(rp + 16), s1 = *(const f32x4*)(rp + 20);
#pragma unroll
                            for (int n = 0; n < 2; ++n)
#pragma unroll
                                for (int j = 0; j < 4; ++j) { const float nv = v[bj][n][j] * (n ? g1[j] : g0[j]);
                                    const float pv = __builtin_bit_cast(float, __builtin_amdgcn_ds_bpermute((lane ^ 32) << 2, __builtin_bit_cast(int, nv)));
                                    const float cs = n ? c1[j] : c0[j], sn = n ? s1[j] : s0[j]; v[bj][n][j] = (fq < 2) ? nv * cs - pv * sn : nv * cs + pv * sn; } } }
                }
#pragma unroll
                for (int bj = 0; bj < 2; ++bj) { u32x4 w; w.x = cvt_pk_bf16(v[bj][0][0], v[bj][0][1]); w.y = cvt_pk_bf16(v[bj][0][2], v[bj][0][3]); w.z = cvt_pk_bf16(v[bj][1][0], v[bj][1][1]); w.w = cvt_pk_bf16(v[bj][1][2], v[bj][1][3]);
                    st16_wt(rowp + bj * 128, lo_, w); } }
    }
};
struct PEpiKV {
    static constexpr bool PERM = true, AFTER_DRAIN = false, MIDSCALE = false;
    bf16_t* V; bf16_t* K; const bf16_t* proj; const float* ssq_kv; const float* ssq_kr; const float* rope; const float* kgain;
    __device__ __forceinline__ void operator()(const f32x4 (&acc)[2][2][4][2], const pg8::Unit& u, int wr, int wc, int fr_, int fq_) const {
        int fr = fr_, fq = fq_; asm volatile("" : "+v"(fr), "+v"(fq)); const float* kgain = this->kgain; asm volatile("" : "+s"(kgain)); const float* rope = this->rope; asm volatile("" : "+s"(rope));
        const int row0 = u.pm * 256 + wr * 64 + fr, lane = fq * 16 + fr;
        float rsc[2][4];
#pragma unroll
        for (int ai = 0; ai < 2; ++ai)
#pragma unroll
            for (int m = 0; m < 4; ++m) rsc[ai][m] = 1.f / sqrtf(ssq_kv[row0 + ai * 128 + m * 16] * (1.f / KVR) + EPS);
        if (wc >= 2) {
            const int col0 = u.pn * 256 + wc * 32 + 8 * fq;
#pragma unroll
            for (int ai = 0; ai < 2; ++ai)
#pragma unroll
                for (int m = 0; m < 4; ++m) { const bf16_t* rowp = V + ((size_t)(u.pm * 256 + wr * 64 + ai * 128 + m * 16) * MKV + u.pn * 256 + wc * 32); const unsigned lo_ = (unsigned)(fr * MKV + 8 * fq) * 2u; const float sc_ = rsc[ai][m];
#pragma unroll
                    for (int bj = 0; bj < 2; ++bj) { const f32x4 v0 = acc[ai][bj][m][0] * sc_, v1 = acc[ai][bj][m][1] * sc_;
                        u32x4 w; w.x = cvt_pk_bf16(v0[0], v0[1]); w.y = cvt_pk_bf16(v0[2], v0[3]); w.z = cvt_pk_bf16(v1[0], v1[1]); w.w = cvt_pk_bf16(v1[2], v1[3]);
                        st16_wt(rowp + bj * 128, lo_, w); } }
            return;
        }
        const int hh = 2 * u.pn + wc;
#pragma unroll
        for (int ai = 0; ai < 2; ++ai)
#pragma unroll
            for (int m = 0; m < 4; ++m) { const int row = row0 + ai * 128 + m * 16; const float sc_ = rsc[ai][m];
                const bf16_t* ko = K + ((size_t)(u.pm * 256 + wr * 64 + ai * 128 + m * 16) * MQ + 96 * hh); const unsigned lo_ = (unsigned)(fr * MQ + 8 * fq) * 2u;
                float rstd;
                {
                    f32x4 v[2][2]; float ss = 0.f;
#pragma unroll
                    for (int bj = 0; bj < 2; ++bj)
#pragma unroll
                        for (int n = 0; n < 2; ++n) { v[bj][n] = acc[ai][bj][m][n] * sc_; ss += (v[bj][n][0] * v[bj][n][0] + v[bj][n][1] * v[bj][n][1]) + (v[bj][n][2] * v[bj][n][2] + v[bj][n][3] * v[bj][n][3]); }
                    ss += __builtin_bit_cast(float, __builtin_amdgcn_ds_bpermute((lane ^ 16) << 2, __builtin_bit_cast(int, ss)));
                    ss += __builtin_bit_cast(float, __builtin_amdgcn_ds_bpermute((lane ^ 32) << 2, __builtin_bit_cast(int, ss)));
                    rstd = 1.f / sqrtf((ss + ssq_kr[row]) * (1.f / 96) + EPS);
#pragma unroll
                    for (int bj = 0; bj < 2; ++bj) { const f32x4 g0 = *(const f32x4*)(kgain + 32 * bj + 8 * fq), g1 = *(const f32x4*)(kgain + 32 * bj + 8 * fq + 4);
                        const f32x4 a = v[bj][0] * rstd * g0, b = v[bj][1] * rstd * g1;
                        u32x4 w; w.x = cvt_pk_bf16(a[0], a[1]); w.y = cvt_pk_bf16(a[2], a[3]); w.z = cvt_pk_bf16(b[0], b[1]); w.w = cvt_pk_bf16(b[2], b[3]);
                        st16_wt(ko + 32 * bj, lo_, w); }
                }
                asm volatile("" ::: "memory");
                {
                    const bf16x8 kr8 = *(const bf16x8*)(proj + (size_t)row * DINP + P_HKR + 8 * fq);
                    u32x4 w; w.x = cvt_pk_bf16(bf2f((unsigned short)kr8[0]) * rstd, bf2f((unsigned short)kr8[1]) * rstd); w.y = cvt_pk_bf16(bf2f((unsigned short)kr8[2]) * rstd, bf2f((unsigned short)kr8[3]) * rstd);
                    w.z = cvt_pk_bf16(bf2f((unsigned short)kr8[4]) * rstd, bf2f((unsigned short)kr8[5]) * rstd); w.w = cvt_pk_bf16(bf2f((unsigned short)kr8[6]) * rstd, bf2f((unsigned short)kr8[7]) * rstd);
                    st16_wt(ko + 64, lo_, w);
                }
                asm volatile("" ::: "memory"); }
    }
};
struct PEpiWo {
    static constexpr bool PERM = true, AFTER_DRAIN = false, MIDSCALE = true;
    const bf16_t* base; bf16_t* xb; float* ssq; const float* ssqm; int ldc; const unsigned* gate;
    __device__ __forceinline__ void midscale(f32x4 (&acc)[2][2][4][2], const pg8::Unit& u, int wr, int fr) const {
#pragma unroll
        for (int ai = 0; ai < 2; ++ai)
#pragma unroll
            for (int m = 0; m < 4; ++m) { const int row = u.pm * 256 + ai * 128 + wr * 64 + m * 16 + fr;
                const float sa = ssqm[2 * row], sb = ssqm[2 * row + 1]; const float ratio = sqrtf((sb * (1.f / 512) + EPS) / (sa * (1.f / 512) + EPS));
#pragma unroll
                for (int bj = 0; bj < 2; ++bj)
#pragma unroll
                    for (int n = 0; n < 2; ++n) acc[ai][bj][m][n] *= ratio; }
    }
    __device__ __forceinline__ void operator()(const f32x4 (&acc)[2][2][4][2], const pg8::Unit& u, int wr, int wc, int fr, int fq) const {
        const int lane = fq * 16 + fr;
        const int rowb = u.pm * 256 + wr * 64 + fr;
        overlay_gate(gate, 256u);
        float rb[8];
#pragma unroll
        for (int g_ = 0; g_ < 8; ++g_) rb[g_] = ssqm[2 * (rowb + (g_ >> 2) * 128 + (g_ & 3) * 16) + 1];
        const size_t tile0 = (size_t)(u.pm * 256 + wr * 64) * ldc + u.pn * 256 + wc * 32;
        const unsigned lo_ = (unsigned)(fr * ldc + 8 * fq) * 2u;
        u32x4 nxt[2];
#pragma unroll
        for (int bj = 0; bj < 2; ++bj) nxt[bj] = *(const u32x4*)((const char*)(base + tile0 + bj * 128) + lo_);
#pragma unroll
        for (int g_ = 0; g_ < 8; ++g_) { const int ai = g_ >> 2, m = g_ & 3; const int row = rowb + ai * 128 + m * 16; const size_t roff = tile0 + (size_t)(ai * 128 + m * 16) * ldc; float ss = 0.f;
            u32x4 cur[2];
#pragma unroll
            for (int bj = 0; bj < 2; ++bj) cur[bj] = nxt[bj];
            if (g_ < 7) { const size_t roffn = tile0 + (size_t)(((g_ + 1) >> 2) * 128 + ((g_ + 1) & 3) * 16) * ldc;
#pragma unroll
                for (int bj = 0; bj < 2; ++bj) nxt[bj] = *(const u32x4*)((const char*)(base + roffn + bj * 128) + lo_); }
            const float rbs = 1.f / sqrtf(rb[g_] * (1.f / 512) + EPS);
#pragma unroll
            for (int bj = 0; bj < 2; ++bj) { const u32x4 cw = cur[bj];
                const f32x4 v0 = (f32x4){bf2f(cw.x & 0xffffu), bf2f(cw.x >> 16), bf2f(cw.y & 0xffffu), bf2f(cw.y >> 16)} + acc[ai][bj][m][0] * rbs;
                const f32x4 v1 = (f32x4){bf2f(cw.z & 0xffffu), bf2f(cw.z >> 16), bf2f(cw.w & 0xffffu), bf2f(cw.w >> 16)} + acc[ai][bj][m][1] * rbs;
                ss += ((v0[0] * v0[0] + v0[1] * v0[1]) + (v0[2] * v0[2] + v0[3] * v0[3])) + ((v1[0] * v1[0] + v1[1] * v1[1]) + (v1[2] * v1[2] + v1[3] * v1[3]));
                u32x4 w; w.x = cvt_pk_bf16(v0[0], v0[1]); w.y = cvt_pk_bf16(v0[2], v0[3]); w.z = cvt_pk_bf16(v1[0], v1[1]); w.w = cvt_pk_bf16(v1[2], v1[3]);
                st16_wt(xb + roff + bj * 128, lo_, w); }
            ss += __builtin_bit_cast(float, __builtin_amdgcn_ds_bpermute((lane ^ 16) << 2, __builtin_bit_cast(int, ss)));
            ss += __builtin_bit_cast(float, __builtin_amdgcn_ds_bpermute((lane ^ 32) << 2, __builtin_bit_cast(int, ss)));
            if (fq == 0) __hip_atomic_fetch_add(ssq + row, ss, __ATOMIC_RELAXED, __HIP_MEMORY_SCOPE_AGENT); }
    }
};


struct PEpiDown {
    static constexpr bool PERM = false, AFTER_DRAIN = false, MIDSCALE = false;
    const bf16_t* xb; float* out; int ldc;
    __device__ __forceinline__ void operator()(const f32x4 (&acc)[2][2][4][2], const pg8::Unit& u, int wr, int wc, int fr, int fq) const {
        const int col0 = u.pn * 256 + wc * 32 + 4 * fq; const int rowb = u.pm * 256 + wr * 64 + fr;
        u32x2 nxt[2][2];
#pragma unroll
        for (int bj = 0; bj < 2; ++bj)
#pragma unroll
            for (int n = 0; n < 2; ++n) nxt[bj][n] = *(const u32x2*)(xb + (size_t)rowb * ldc + col0 + bj * 128 + n * 16);
#pragma unroll
        for (int g_ = 0; g_ < 8; ++g_) { const int ai = g_ >> 2, m = g_ & 3; const size_t off = (size_t)(rowb + ai * 128 + m * 16) * ldc + col0;
            u32x2 cur[2][2];
#pragma unroll
            for (int bj = 0; bj < 2; ++bj)
#pragma unroll
                for (int n = 0; n < 2; ++n) cur[bj][n] = nxt[bj][n];
            if (g_ < 7) { const size_t offn = (size_t)(rowb + ((g_ + 1) >> 2) * 128 + ((g_ + 1) & 3) * 16) * ldc + col0;
#pragma unroll
                for (int bj = 0; bj < 2; ++bj)
#pragma unroll
                    for (int n = 0; n < 2; ++n) nxt[bj][n] = *(const u32x2*)(xb + offn + bj * 128 + n * 16); }
#pragma unroll
            for (int bj = 0; bj < 2; ++bj)
#pragma unroll
                for (int n = 0; n < 2; ++n) { const u32x2 w = cur[bj][n];
                    const f32x4 bs = (f32x4){bf2f(w.x & 0xffffu), bf2f(w.x >> 16), bf2f(w.y & 0xffffu), bf2f(w.y >> 16)};
                    __builtin_nontemporal_store(bs + acc[ai][bj][m][n], (f32x4*)(out + off + bj * 128 + n * 16)); } }
    }
};

__device__ __forceinline__ float sq8(const bf16x8 v) { float s = 0.f;
#pragma unroll
    for (int j = 0; j < 8; ++j) { const float f = bf2f((unsigned short)v[j]); s += f * f; }
    return s; }
__device__ __forceinline__ u32x4 scale8(const bf16x8 v, float sc, const f32x4 ga, const f32x4 gb) { u32x4 o;
    o.x = pk2(bf2f((unsigned short)v[0]) * sc * ga[0], bf2f((unsigned short)v[1]) * sc * ga[1]); o.y = pk2(bf2f((unsigned short)v[2]) * sc * ga[2], bf2f((unsigned short)v[3]) * sc * ga[3]);
    o.z = pk2(bf2f((unsigned short)v[4]) * sc * gb[0], bf2f((unsigned short)v[5]) * sc * gb[1]); o.w = pk2(bf2f((unsigned short)v[6]) * sc * gb[2], bf2f((unsigned short)v[7]) * sc * gb[3]);
    return o; }

__device__ __forceinline__ void compress_block(unsigned char* ws, LAS unsigned char* L, int task, int wv) {
    const int tid = opaque_tid(wv), lane = tid & 63, wid = __builtin_amdgcn_readfirstlane(tid >> 6), fr = lane & 15, fq = lane >> 4;
    const int tc = task & 15, b = (task >> 4) & 7, kv = task >> 7;
    int c = 8 * tc + (fr >> 1); const int g = fr & 1; if (c > NCMP - 1) c = NCMP - 1;
    const bf16_t* arow = (const bf16_t*)(ws + WS_PROJ) + (size_t)(b * SEQ + 16 * c) * DINP + slot_base((kv ? S_VCMP : S_KCMP) + g) + 8 * fq;
    const float* pe = inptr(11) + kv * 2048 + 8 * fq;
    const bf16_t* w1t = (const bf16_t*)(ws + WS_W1T) + (size_t)kv * 128 * 2048 + 8 * lane;
    f32x4 acc[8];
#pragma unroll
    for (int n = 0; n < 8; ++n) acc[n] = (f32x4){0.f, 0.f, 0.f, 0.f};
#pragma unroll 4
    for (int s8 = 0; s8 < 8; ++s8) {
        const int s = 8 * wid + s8, r = s >> 1, db = (s & 1) * 32;
        const bf16x8 araw = *(const bf16x8*)(arow + (size_t)r * DINP + 4 * db);
        const f32x4 pa = *(const f32x4*)(pe + r * 64 + db), pb = *(const f32x4*)(pe + r * 64 + db + 4);
        u32x4 aw; aw.x = pk2(bf2f((unsigned short)araw[0]) + pa[0], bf2f((unsigned short)araw[1]) + pa[1]); aw.y = pk2(bf2f((unsigned short)araw[2]) + pa[2], bf2f((unsigned short)araw[3]) + pa[3]);
        aw.z = pk2(bf2f((unsigned short)araw[4]) + pb[0], bf2f((unsigned short)araw[5]) + pb[1]); aw.w = pk2(bf2f((unsigned short)araw[6]) + pb[2], bf2f((unsigned short)araw[7]) + pb[3]);
        const bf16x8 a = __builtin_bit_cast(bf16x8, aw);
#pragma unroll
        for (int n = 0; n < 8; ++n) { const bf16x8 bb = *(const bf16x8*)(w1t + (size_t)(s * 8 + n) * 512);
            acc[n] = __builtin_amdgcn_mfma_f32_16x16x32_bf16(a, bb, acc[n], 0, 0, 0); }
    }
    LAS float* part = (LAS float*)L;
#pragma unroll
    for (int n = 0; n < 8; ++n)
#pragma unroll
        for (int j = 0; j < 4; ++j) part[(wid * 16 + 4 * fq + j) * 128 + 16 * n + fr] = acc[n][j];
    __syncthreads();
    LAS bf16_t* hb_ = (LAS bf16_t*)(L + 65536);
#pragma unroll
    for (int e = 0; e < 4; ++e) { const int idx = tid + 512 * e; float v = 0.f;
#pragma unroll
        for (int w = 0; w < 8; ++w) v += part[w * 2048 + idx];
        hb_[idx] = (bf16_t)f2bf(v / (1.f + __expf(-v))); }
    __syncthreads();
    if (wid == 0) {
        const bf16_t* w2t = (const bf16_t*)(ws + WS_W2T) + kv * 64 * 128 + fr * 128 + 8 * fq;
        f32x4 o[4];
#pragma unroll
        for (int n = 0; n < 4; ++n) o[n] = (f32x4){0.f, 0.f, 0.f, 0.f};
#pragma unroll
        for (int ks = 0; ks < 4; ++ks) { const bf16x8 a = *(const LAS bf16x8*)(hb_ + fr * 128 + 32 * ks + 8 * fq);
#pragma unroll
            for (int n = 0; n < 4; ++n) { const bf16x8 bb = *(const bf16x8*)(w2t + (size_t)(16 * n) * 128 + 32 * ks); o[n] = __builtin_amdgcn_mfma_f32_16x16x32_bf16(a, bb, o[n], 0, 0, 0); } }
        bf16_t* dstb = (bf16_t*)(ws + (kv ? WS_VCMP : WS_KCMP)) + (size_t)b * 128 * 2 * 64;
        const float* kg = inptr(10);
#pragma unroll
        for (int j = 0; j < 4; ++j) { const int row = 4 * fq + j, cc = 8 * tc + (row >> 1), gg = row & 1;
            float sc = 1.f;
            if (kv == 0) { float ss = o[0][j] * o[0][j] + o[1][j] * o[1][j] + o[2][j] * o[2][j] + o[3][j] * o[3][j];
                ss += __shfl_xor(ss, 1); ss += __shfl_xor(ss, 2); ss += __shfl_xor(ss, 4); ss += __shfl_xor(ss, 8); sc = 1.f / sqrtf(ss * (1.f / 64) + EPS); }
#pragma unroll
            for (int n = 0; n < 4; ++n) { const int col = 16 * n + fr; float v = o[n][j] * sc; if (kv == 0) v *= kg[col]; if (cc >= NCMP) v = 0.f;
                dstb[((size_t)cc * 2 + gg) * 64 + col] = (bf16_t)f2bf(v); } }
    }
    __syncthreads();
}

namespace att {
typedef float f32x16 __attribute__((ext_vector_type(16)));
typedef short s16x4 __attribute__((ext_vector_type(4)));
typedef short v4i16_t __attribute__((ext_vector_type(4)));
typedef float f32x2_t __attribute__((ext_vector_type(2)));
typedef __bf16 bf16x2_t __attribute__((ext_vector_type(2)));
typedef const LAS unsigned char* lcp;
constexpr int NSLOT = 3;
constexpr int L_TB = 0, L_K = 4096, KSLOT = 12288, L_V = L_K + NSLOT * KSLOT, VSLOT = 8192, L_WSF = L_V + NSLOT * VSLOT, L_OST = L_WSF + 4096,
              L_IMP = L_OST + 32768, IMPS = 33  , L_SELM = L_IMP + 4 * 64 * IMPS * 4, L_GATE = L_SELM + 256, L_SC = L_GATE + 3072, L_INVL = L_SC + 64 * IMPS * 4, L_END = L_INVL + 1024;
static_assert(L_V + NSLOT * VSLOT <= 65536, "LDS-DMA destinations stay below 64 KiB");
static_assert(L_END <= LDS_BST, "attention LDS map");
constexpr float THR = 8.0f;
__device__ __forceinline__ int crow(int r, int hi) { return (r & 3) + 8 * (r >> 2) + 4 * hi; }
__device__ __forceinline__ void glds16(const void* gsrc, unsigned lds_dst) { unsigned keep;
    asm volatile("s_mov_b32 %0, m0\n\ts_mov_b32 m0, %2\n\ts_nop 0\n\tglobal_load_lds_dwordx4 %1, off\n\ts_mov_b32 m0, %0" : "=&s"(keep) : "v"(gsrc), "s"(lds_dst) : "memory"); }
__device__ __forceinline__ unsigned cvtpk(float lo, float hi) { f32x2_t v = {lo, hi}; bf16x2_t b = __builtin_convertvector(v, bf16x2_t); return __builtin_bit_cast(unsigned, b); }
__device__ __forceinline__ s16x4 vtr(lcp p) { return __builtin_bit_cast(s16x4, __builtin_amdgcn_ds_read_tr16_b64_v4i16((LAS v4i16_t*)p)); }
__device__ __forceinline__ float lane_xor(float v, int lane, int x) { return __builtin_bit_cast(float, __builtin_amdgcn_ds_bpermute((lane ^ x) << 2, __builtin_bit_cast(int, v))); }
__device__ __forceinline__ unsigned lane_xor_u(unsigned v, int lane, int x) { return (unsigned)__builtin_amdgcn_ds_bpermute((lane ^ x) << 2, (int)v); }
__device__ __forceinline__ float swap_max(float m, int lane) { return __builtin_fmaxf(m, lane_xor(m, lane, 32)); }
__device__ __forceinline__ float swap_sum(float m, int lane) { return m + lane_xor(m, lane, 32); }
__device__ __forceinline__ float max3f(float a, float b, float c) { float r; asm("v_max3_f32 %0, %1, %2, %3" : "=v"(r) : "v"(a), "v"(b), "v"(c)); return r; }
__device__ __forceinline__ float max32(const f32x16& p0, const f32x16& p1) {
    float a = max3f(p0[0], p0[1], p1[0]), b = max3f(p0[2], p0[3], p1[1]); a = max3f(a, p1[2], p1[3]);
#pragma unroll
    for (int r = 4; r < 16; r += 4) { a = max3f(a, p0[r], p0[r + 1]); b = max3f(b, p0[r + 2], p0[r + 3]); a = max3f(a, p1[r], p1[r + 1]); b = max3f(b, p1[r + 2], p1[r + 3]); }
    return __builtin_fmaxf(a, b); }
__device__ __forceinline__ float max16(const f32x16& p) { float a = __builtin_fmaxf(p[0], p[1]), b = __builtin_fmaxf(p[2], p[3]);
#pragma unroll
    for (int r = 4; r < 16; r += 4) { a = __builtin_fmaxf(a, __builtin_fmaxf(p[r], p[r + 1])); b = __builtin_fmaxf(b, __builtin_fmaxf(p[r + 2], p[r + 3])); }
    return __builtin_fmaxf(a, b); }
__device__ __forceinline__ float sum16(const f32x16& p) { float a = p[0] + p[1], b = p[2] + p[3];
#pragma unroll
    for (int r = 4; r < 16; r += 4) { a += p[r] + p[r + 1]; b += p[r + 2] + p[r + 3]; }
    return a + b; }
#define ATT_BAR() asm volatile("s_waitcnt vmcnt(0) lgkmcnt(0)\n\ts_barrier" ::: "memory")

template <int DQ> __device__ __forceinline__ void qkt(f32x16& p0, f32x16& p1, lcp kslot, const bf16x8* qr, const f32x16& cinit, int r32, int hi) {
    lcp kb = kslot + hi * 1024 + r32 * 16;
    constexpr int NB = (DQ == 96) ? 3 : 4;
#pragma unroll
    for (int db = 0; db < DQ / 16; db += NB) {
        bf16x8 kf[2 * NB];
#pragma unroll
        for (int e = 0; e < NB; ++e) { kf[2 * e] = *(const LAS bf16x8*)(kb + (db + e) * 2048); kf[2 * e + 1] = *(const LAS bf16x8*)(kb + (db + e) * 2048 + 512); }
        __builtin_amdgcn_sched_barrier(0);
#pragma unroll
        for (int e = 0; e < NB; ++e) { const int d0 = db + e;
            if (d0 == 0) { p0 = __builtin_amdgcn_mfma_f32_32x32x16_bf16(kf[0], qr[0], cinit, 0, 0, 0); p1 = __builtin_amdgcn_mfma_f32_32x32x16_bf16(kf[1], qr[0], cinit, 0, 0, 0); }
            else { p0 = __builtin_amdgcn_mfma_f32_32x32x16_bf16(kf[2 * e], qr[d0], p0, 0, 0, 0); p1 = __builtin_amdgcn_mfma_f32_32x32x16_bf16(kf[2 * e + 1], qr[d0], p1, 0, 0, 0); }
        }
    }
}
__device__ __forceinline__ void vload_half(bf16x8 (&vf)[8], lcp vp, int d0) {
#pragma unroll
    for (int ks = 0; ks < 4; ++ks) {
        const s16x4 lo = vtr(vp + d0 * 4096 + ks * 1024), hh = vtr(vp + d0 * 4096 + ks * 1024 + 512);
        vf[d0 * 4 + ks] = (bf16x8){lo[0], lo[1], lo[2], lo[3], hh[0], hh[1], hh[2], hh[3]};
    }
    __builtin_amdgcn_sched_barrier(0);
}
__device__ __forceinline__ void vload(bf16x8 (&vf)[8], lcp vp) { vload_half(vf, vp, 0); vload_half(vf, vp, 1); }
__device__ __forceinline__ void pv_mma(f32x16 (&o)[2], const bf16x8 (&vf)[8], const f32x16& p0, const f32x16& p1) {
    u32x4 pw[4];
    pw[0] = (u32x4){cvtpk(p0[0], p0[1]), cvtpk(p0[2], p0[3]), cvtpk(p0[4], p0[5]), cvtpk(p0[6], p0[7])};
    pw[1] = (u32x4){cvtpk(p0[8], p0[9]), cvtpk(p0[10], p0[11]), cvtpk(p0[12], p0[13]), cvtpk(p0[14], p0[15])};
    pw[2] = (u32x4){cvtpk(p1[0], p1[1]), cvtpk(p1[2], p1[3]), cvtpk(p1[4], p1[5]), cvtpk(p1[6], p1[7])};
    pw[3] = (u32x4){cvtpk(p1[8], p1[9]), cvtpk(p1[10], p1[11]), cvtpk(p1[12], p1[13]), cvtpk(p1[14], p1[15])};
#pragma unroll
    for (int d0 = 0; d0 < 2; ++d0)
#pragma unroll
        for (int ks = 0; ks < 4; ++ks) o[d0] = __builtin_amdgcn_mfma_f32_32x32x16_bf16(__builtin_bit_cast(bf16x8, pw[ks]), vf[d0 * 4 + ks], o[d0], 0, 0, 0);
}
__device__ __forceinline__ void pv(f32x16 (&o)[2], lcp vp, const f32x16& p0, const f32x16& p1) { bf16x8 vf[8]; vload(vf, vp); pv_mma(o, vf, p0, p1); }
template <int DQ, bool SLOT = false, bool SLOTV = SLOT> __device__ __forceinline__ void dma_tile(unsigned lds0, const bf16_t* Kg, int kpitch, const bf16_t* Vg, int vpitch, int key0, int slot, int wid, int lane) {
    const bf16_t* ksrc = Kg + (size_t)(key0 + lane) * kpitch + (SLOT ? 128 * (wid >> 2) + 8 * (wid & 3) : wid * 8);
    glds16(ksrc, (unsigned)__builtin_amdgcn_readfirstlane(lds0 + L_K + slot * KSLOT + wid * 1024));
    if (DQ == 96) { if (wid < 4) glds16(ksrc + 64, (unsigned)__builtin_amdgcn_readfirstlane(lds0 + L_K + slot * KSLOT + (8 + wid) * 1024)); }
    const bf16_t* vsrc = Vg + (size_t)(key0 + 16 * (wid & 3) + (lane >> 2)) * vpitch + (wid >> 2) * (SLOTV ? 128 : 32) + (lane & 3) * 8;
    glds16(vsrc, (unsigned)__builtin_amdgcn_readfirstlane(lds0 + L_V + slot * VSLOT + wid * 1024));
}

#define ATT_LBAR() asm volatile("s_waitcnt lgkmcnt(0)\n\ts_barrier" ::: "memory")
struct NoNext { static constexpr int count = 0; __device__ __forceinline__ void dma(unsigned, int, int, int, int) const {} };
template <int DQ, bool SLOT, bool SLOTV, class Pol> struct NextTiles {
    const bf16_t* Kg; int kpitch; const bf16_t* Vg; int vpitch; const Pol* pol; int count;
    __device__ __forceinline__ void dma(unsigned lds0, int j, int slot, int wid, int lane) const { dma_tile<DQ, SLOT, SLOTV>(lds0, Kg, kpitch, Vg, vpitch, pol->key0(j), slot, wid, lane); }
};
template <int DQ, bool SLOT = false, bool SLOTV = SLOT, class Pol, class Next>
__device__ __forceinline__ void flash_loop(LAS unsigned char* L, const bf16_t* Kg, int kpitch, const bf16_t* Vg, int vpitch, const bf16x8* qr, const Pol& pol, int s0, int npre, const Next& next,
                                           f32x16 (&o)[2], float& l_out, int wid, int lane) {
    const int r32 = lane & 31, hi = lane >> 5;
    const unsigned lds0 = (unsigned)(uintptr_t)L;
    LAS float* wsf = (LAS float*)(L + L_WSF) + wid * 128;
    lcp vp0 = L + L_V + ((lane >> 4) & 1) * 32 + (lane & 3) * 8 + (4 * hi + ((lane & 15) >> 2)) * 64;
    float mhat = 0.f, l = 0.f;
    f32x16 negm;
#pragma unroll
    for (int r = 0; r < 16; ++r) { o[0][r] = 0.f; o[1][r] = 0.f; negm[r] = 0.f; }
    const int n = pol.ntiles, ntot = n + next.count;
    int slot = s0, slot1 = (s0 + 1) % NSLOT, slot2 = (s0 + 2) % NSLOT;
    if (npre < 1) dma_tile<DQ, SLOT, SLOTV>(lds0, Kg, kpitch, Vg, vpitch, pol.key0(0), slot, wid, lane);
    if (npre < 2 && ntot > 1) { if (n > 1) dma_tile<DQ, SLOT, SLOTV>(lds0, Kg, kpitch, Vg, vpitch, pol.key0(1), slot1, wid, lane); else next.dma(lds0, 0, slot1, wid, lane); }
    for (int i = 0; i < n; ++i) {
        if (i + 1 < ntot) { if (DQ == 96 && wid < 4) asm volatile("s_waitcnt vmcnt(3) lgkmcnt(0)\n\ts_barrier" ::: "memory"); else asm volatile("s_waitcnt vmcnt(2) lgkmcnt(0)\n\ts_barrier" ::: "memory"); }
        else ATT_BAR();
        if (i + 2 < ntot) { if (i + 2 < n) dma_tile<DQ, SLOT, SLOTV>(lds0, Kg, kpitch, Vg, vpitch, pol.key0(i + 2), slot2, wid, lane); else next.dma(lds0, i + 2 - n, slot2, wid, lane); }
        if (pol.active(i)) {
            f32x16 p0, p1;
            qkt<DQ>(p0, p1, L + L_K + slot * KSLOT, qr, negm, r32, hi);
            bf16x8 vf[8]; vload_half(vf, vp0 + slot * VSLOT, 0);
            pol.fix(p0, p1, i);
            asm volatile("s_nop 15\n\ts_nop 7" : "+v"(p0), "+v"(p1));
            const float rm = swap_max(max32(p0, p1), lane);
            const bool first = (i == 0);
            if (first || __any(rm > THR)) {
                float dl = first ? rm : __builtin_fmaxf(rm, 0.f);
                if (dl == -INFINITY) dl = 0.f;
                mhat += dl;
#pragma unroll
                for (int r = 0; r < 16; ++r) { p0[r] -= dl; p1[r] -= dl; negm[r] = -mhat; }
                if (!first) {
                    const float f = __builtin_amdgcn_exp2f(-dl); l *= f;
                    if (hi == 0) wsf[r32] = f;
#pragma unroll
                    for (int r = 0; r < 16; ++r) { const float fr_ = wsf[crow(r, hi)]; o[0][r] *= fr_; o[1][r] *= fr_; }
                }
            }
#pragma unroll
            for (int r = 0; r < 16; ++r) { p0[r] = __builtin_amdgcn_exp2f(p0[r]); p1[r] = __builtin_amdgcn_exp2f(p1[r]); }
            vload_half(vf, vp0 + slot * VSLOT, 1);
            l += sum16(p0) + sum16(p1);
            pv_mma(o, vf, p0, p1);
        }
        slot = slot1; slot1 = slot2; slot2 = (slot2 == NSLOT - 1) ? 0 : slot2 + 1;
    }
    ATT_LBAR();
    l_out = swap_sum(l, lane);
}

__device__ __forceinline__ void acc_scaled(f32x16 (&oc)[2], const f32x16 (&o)[2], float rowscale, LAS float* wsf, int r32, int hi) {
    if (hi == 0) wsf[32 + r32] = rowscale;
#pragma unroll
    for (int r = 0; r < 16; ++r) { const float s = wsf[32 + crow(r, hi)]; oc[0][r] += s * o[0][r]; oc[1][r] += s * o[1][r]; }
}
__device__ __forceinline__ void park_store(const f32x16 (&oc)[2], LAS float* park, int lane) {
#pragma unroll
    for (int d0 = 0; d0 < 2; ++d0)
#pragma unroll
        for (int r = 0; r < 16; ++r) park[(d0 * 16 + r) * 64 + lane] = oc[d0][r];
}
template <bool FINAL> __device__ __forceinline__ void park_acc(f32x16 (&oc)[2], LAS float* park, const f32x16 (&o)[2], float rowscale, LAS float* wsf, int lane) {
    const int r32 = lane & 31, hi = lane >> 5;
    if (hi == 0) wsf[32 + r32] = rowscale;
#pragma unroll
    for (int r = 0; r < 16; ++r) { const float s = wsf[32 + crow(r, hi)];
#pragma unroll
        for (int d0 = 0; d0 < 2; ++d0) { const float v = park[(d0 * 16 + r) * 64 + lane] + s * o[d0][r]; if (FINAL) oc[d0][r] = v; else park[(d0 * 16 + r) * 64 + lane] = v; } }
}
__device__ __forceinline__ void store_tile(const f32x16 (&oc)[2], bf16_t* dst, int pitch, LAS unsigned char* L, int wid, int lane, float* ssq) {
    const int r32 = lane & 31, hi = lane >> 5;
    LAS bf16_t* stg = (LAS bf16_t*)(L + L_OST + wid * 8192);
#pragma unroll
    for (int r = 0; r < 16; ++r) { const int orow = crow(r, hi);
#pragma unroll
        for (int d0 = 0; d0 < 2; ++d0) stg[orow * 64 + d0 * 32 + r32] = (bf16_t)f2bf(oc[d0][r]); }
    asm volatile("s_waitcnt lgkmcnt(0)" ::: "memory");
#pragma unroll
    for (int i = 0; i < 4; ++i) { const int row = i * 8 + (lane >> 3), ch = lane & 7; const u32x4 v = *(const LAS u32x4*)(stg + row * 64 + ch * 8); st16_wt(dst + (size_t)(i * 8) * pitch, (unsigned)((lane >> 3) * pitch + ch * 8) * 2u, v);
        float ss = sq8(__builtin_bit_cast(bf16x8, v)); ss += lane_xor(ss, lane, 1); ss += lane_xor(ss, lane, 2); ss += lane_xor(ss, lane, 4);
        if (ch == 0) __hip_atomic_fetch_add(ssq + 2 * row, ss, __ATOMIC_RELAXED, __HIP_MEMORY_SCOPE_AGENT); }
    asm volatile("s_waitcnt lgkmcnt(0)" ::: "memory");
}

#define PIN16(v) asm volatile("" : "+v"(v[0]), "+v"(v[1]), "+v"(v[2]), "+v"(v[3]), "+v"(v[4]), "+v"(v[5]), "+v"(v[6]), "+v"(v[7]), "+v"(v[8]), "+v"(v[9]), "+v"(v[10]), "+v"(v[11]), "+v"(v[12]), "+v"(v[13]), "+v"(v[14]), "+v"(v[15]))
__device__ __forceinline__ int clamp127(int d) { return d < 0 ? 0 : (d < 127 ? d : 127); }
struct PolMla { int ntiles, qw0, r32, hi;
    __device__ __forceinline__ int key0(int i) const { return 64 * i; }
    __device__ __forceinline__ bool active(int i) const { return 64 * i <= qw0 + 31; }
    __device__ __forceinline__ int nact() const { const int a = (qw0 + 31) / 64 + 1; return a < ntiles ? a : ntiles; }
    __device__ __forceinline__ void fix(f32x16& p0, f32x16& p1, int i) const {
        if (64 * i + 63 > qw0) { const int q = qw0 + r32, kb = 64 * i + 4 * hi;
#pragma unroll
            for (int r = 0; r < 16; ++r) { const int kv = kb + (r & 3) + 8 * (r >> 2); if (kv > q) p0[r] = -INFINITY; if (kv + 32 > q) p1[r] = -INFINITY; } }
    }
};
struct PolSel { int ntiles, qc, q, hi; unsigned selm; const LAS float* tbh;
    __device__ __forceinline__ int key0(int i) const { return 64 * (qc - i); }
    __device__ __forceinline__ bool active(int i) const { return __any((selm >> (qc - i)) & 1u) != 0; }
    __device__ __forceinline__ int nact() const { return ntiles; }
    __device__ __forceinline__ void fix(f32x16& p0, f32x16& p1, int i) const {
        const bool bit = ((selm >> (qc - i)) & 1u) != 0u;
        if (i <= 2) { const int kb = 64 * (qc - i) + 4 * hi; float bv0[16], bv1[16];
#pragma unroll
            for (int r = 0; r < 16; ++r) { const int d0 = q - (kb + (r & 3) + 8 * (r >> 2)); bv0[r] = tbh[clamp127(d0)]; bv1[r] = tbh[clamp127(d0 - 32)]; }
            PIN16(bv0); PIN16(bv1);
#pragma unroll
            for (int r = 0; r < 16; ++r) { const int d0 = q - (kb + (r & 3) + 8 * (r >> 2)), d1 = d0 - 32;
                p0[r] = (d0 < 0) ? -INFINITY : p0[r] + bv0[r]; p1[r] = (d1 < 0) ? -INFINITY : p1[r] + bv1[r]; } }
        if (!bit) {
#pragma unroll
            for (int r = 0; r < 16; ++r) { p0[r] = -INFINITY; p1[r] = -INFINITY; } }
    }
};
struct PolWin { int ntiles, qc, q, hi; const LAS float* tbh;
    __device__ __forceinline__ int key0(int i) const { return 64 * (qc - i); }
    __device__ __forceinline__ bool active(int) const { return true; }
    __device__ __forceinline__ int nact() const { return ntiles; }
    __device__ __forceinline__ void fix(f32x16& p0, f32x16& p1, int i) const {
        if (i <= 2) { const int kb = 64 * (qc - i) + 4 * hi; float bv0[16], bv1[16];
#pragma unroll
            for (int r = 0; r < 16; ++r) { const int d0 = q - (kb + (r & 3) + 8 * (r >> 2)); bv0[r] = tbh[clamp127(d0)]; bv1[r] = tbh[clamp127(d0 - 32)]; }
            PIN16(bv0); PIN16(bv1);
#pragma unroll
            for (int r = 0; r < 16; ++r) { const int d0 = q - (kb + (r & 3) + 8 * (r >> 2)), d1 = d0 - 32;
                p0[r] = (d0 < 0) ? -INFINITY : p0[r] + bv0[r]; p1[r] = (d1 < 0) ? -INFINITY : p1[r] + bv1[r]; } }
        else if (i == 8) { const int kb = 64 * (qc - i) + 4 * hi;
#pragma unroll
            for (int r = 0; r < 16; ++r) { const int d0 = q - (kb + (r & 3) + 8 * (r >> 2)), d1 = d0 - 32; if (d0 >= 512) p0[r] = -INFINITY; if (d1 >= 512) p1[r] = -INFINITY; } }
    }
};

__device__ __forceinline__ void mla_unit(unsigned char* ws, LAS unsigned char* L, int b, int h, int qb, int wv, int s0, int npre, int nnext) {
    asm volatile("" : "+s"(ws));
    const int tid = opaque_tid(wv), lane = tid & 63, wid = __builtin_amdgcn_readfirstlane(tid >> 6);
    const int r32 = lane & 31, hi = lane >> 5;
    const size_t rowbase = (size_t)b * SEQ; const int qw0 = 256 * qb + 32 * wid;
    bf16x8 qr[6];
    { const bf16_t* Qw = (const bf16_t*)(ws + WS_QM) + (rowbase + qw0 + r32) * MQ + 96 * h + 8 * hi;
      bf16x8 raw[6]; float ss = 0.f;
#pragma unroll
      for (int d0 = 0; d0 < 6; ++d0) { raw[d0] = *(const bf16x8*)(Qw + 16 * d0); ss += sq8(raw[d0]); }
      ss += lane_xor(ss, lane, 32);
      const float rstd = QS_MLA / sqrtf(ss * (1.f / 96) + EPS);
      const float* qg = inptr(7) + 8 * hi;
#pragma unroll
      for (int d0 = 0; d0 < 4; ++d0) qr[d0] = __builtin_bit_cast(bf16x8, scale8(raw[d0], rstd, *(const f32x4*)(qg + 16 * d0), *(const f32x4*)(qg + 16 * d0 + 4)));
      float o1[8], o2[8]; const float posf = (float)(qw0 + r32);
#pragma unroll
      for (int j = 0; j < 8; ++j) { const int i = 8 * hi + j; const float inv = exp2f(-(float)i * (13.287712379549449f / 16.f)); float sn, cs; sincosf(posf * inv, &sn, &cs);
          const float n1 = bf2f((unsigned short)raw[4][j]) * rstd * qg[64 + j], n2 = bf2f((unsigned short)raw[5][j]) * rstd * qg[80 + j];
          o1[j] = n1 * cs - n2 * sn; o2[j] = n2 * cs + n1 * sn; }
      u32x4 w4, w5; w4.x = pk2(o1[0], o1[1]); w4.y = pk2(o1[2], o1[3]); w4.z = pk2(o1[4], o1[5]); w4.w = pk2(o1[6], o1[7]);
      w5.x = pk2(o2[0], o2[1]); w5.y = pk2(o2[2], o2[3]); w5.z = pk2(o2[4], o2[5]); w5.w = pk2(o2[6], o2[7]);
      qr[4] = __builtin_bit_cast(bf16x8, w4); qr[5] = __builtin_bit_cast(bf16x8, w5); }
    const bf16_t* Kg = (const bf16_t*)(ws + WS_KMLA) + rowbase * MQ + 96 * h;
    const bf16_t* Vg = (const bf16_t*)(ws + WS_KVM) + rowbase * MKV + slot_base(4 * (h >> 1) + 2 + (h & 1));
    PolMla pol{4 * qb + 4, qw0, r32, hi};
    f32x16 o[2]; float l;
    const NextTiles<96, false, true, PolMla> nxt{Kg, MQ, Vg, MKV, &pol, nnext};
    flash_loop<96, false, true>(L, Kg, MQ, Vg, MKV, qr, pol, s0, npre, nxt, o, l, wid, lane);
    LAS float* wsf = (LAS float*)(L + L_WSF) + wid * 128;
    f32x16 oc[2];
#pragma unroll
    for (int r = 0; r < 16; ++r) { oc[0][r] = 0.f; oc[1][r] = 0.f; }
    acc_scaled(oc, o, (l > 0.f) ? 1.f / l : 0.f, wsf, r32, hi);
    store_tile(oc, (bf16_t*)(ws + WS_MIX) + (rowbase + qw0) * DM + 64 * h, DM, L, wid, lane, (float*)(ws + WS_SSQM) + 2 * (rowbase + qw0));
}

__device__ __forceinline__ void nsa_unit(unsigned char* ws, LAS unsigned char* L, int b, int g, int qc, int wv) {
    asm volatile("" : "+s"(ws));
#define NSA_IDS() const int tid = opaque_tid(wv), lane = tid & 63, wid = __builtin_amdgcn_readfirstlane(tid >> 6); \
    const int r32 = lane & 31, hi = lane >> 5, rh = wid & 3, qh = wid >> 2, h = 4 * g + rh, qloc = 32 * qh + r32, q = q0 + qloc; \
    const unsigned lds0 = (unsigned)(uintptr_t)L; LAS float* wsf = (LAS float*)(L + L_WSF) + wid * 128; const LAS float* tbh = (const LAS float*)(L + L_TB) + h * 128; \
    LAS float* gate = (LAS float*)(L + L_GATE); (void)tid; (void)lane; (void)r32; (void)hi; (void)rh; (void)qh; (void)h; (void)qloc; (void)q; (void)lds0; (void)wsf; (void)tbh; (void)gate
    const size_t rowbase = (size_t)b * SEQ; const int q0 = 64 * qc;
    const bf16_t* pr = (const bf16_t*)(ws + WS_PROJ);
    bf16x8 qr[4];
    {
    NSA_IDS();
    { const bf16_t* Kc = (const bf16_t*)(ws + WS_KCMP) + ((size_t)b * 256 + g) * 64; const bf16_t* Vc = (const bf16_t*)(ws + WS_VCMP) + ((size_t)b * 256 + g) * 64;
      dma_tile<64>(lds0, Kc, 128, Vc, 128, 0, 0, wid, lane);
      dma_tile<64>(lds0, Kc, 128, Vc, 128, 64, 1, wid, lane);
      dma_tile<64, true>(lds0, pr + rowbase * DINP + slot_base(S_KSEL + g), DINP, pr + rowbase * DINP + slot_base(S_VSEL + g), DINP, 64 * qc, 2, wid, lane); }
    for (int i = tid; i < 768; i += 512) { const int br = i >> 8, r = (i >> 6) & 3, qq = i & 63;
        const float x = bf2f(pr[(rowbase + q0 + qq) * DINP + P_GATE + 8 * br + 4 * g + r]); gate[i] = 1.f / (1.f + __expf(-x)); }
    { const bf16_t* Qw = pr + (rowbase + q) * DINP + slot_base(S_Q + h) + 8 * hi;
#pragma unroll
      for (int d0 = 0; d0 < 4; ++d0) qr[d0] = *(const bf16x8*)(Qw + 128 * (d0 >> 1) + 16 * (d0 & 1)); }
    }
    f32x16 oc[2];
    {
        NSA_IDS();
        ATT_BAR();
        lcp vp0 = L + L_V + ((lane >> 4) & 1) * 32 + (lane & 3) * 8 + (4 * hi + ((lane & 15) >> 2)) * 64;
        LAS float* imp = (LAS float*)(L + L_IMP) + (rh * 64 + qloc) * IMPS;
        f32x16 a0, a1, b0, b1;
        { f32x16 zero;
#pragma unroll
          for (int r = 0; r < 16; ++r) zero[r] = 0.f;
          qkt<64>(a0, a1, L + L_K, qr, zero, r32, hi); qkt<64>(b0, b1, L + L_K + KSLOT, qr, zero, r32, hi); }
#define CMP_FIX(P, coff, extra) do { float bv[16]; \
            _Pragma("unroll") for (int r = 0; r < 16; ++r) bv[r] = tbh[clamp127(q - 16 * (crow(r, hi) + (coff)) - 31)]; \
            PIN16(bv); \
            _Pragma("unroll") for (int r = 0; r < 16; ++r) { const int c = crow(r, hi) + (coff); const int d = q - 16 * c - 31; P[r] = (d < 0 || (extra && c >= NCMP)) ? -INFINITY : P[r] + bv[r]; } } while (0)
        { const int qw = q0 + 32 * qh;
          if (qw < 16 * 0 + 640) CMP_FIX(a0, 0, false);
          if (qw < 16 * 32 + 640) CMP_FIX(a1, 32, false);
          if (qw < 16 * 64 + 640) CMP_FIX(b0, 64, false);
          CMP_FIX(b1, 96, true); }
#undef CMP_FIX
        float m = swap_max(__builtin_fmaxf(__builtin_fmaxf(max16(a0), max16(a1)), __builtin_fmaxf(max16(b0), max16(b1))), lane);
        if (m == -INFINITY) m = 0.f;
#pragma unroll
        for (int r = 0; r < 16; ++r) { a0[r] = __builtin_amdgcn_exp2f(a0[r] - m); a1[r] = __builtin_amdgcn_exp2f(a1[r] - m); b0[r] = __builtin_amdgcn_exp2f(b0[r] - m); b1[r] = __builtin_amdgcn_exp2f(b1[r] - m); }
        const float lsum = swap_sum((sum16(a0) + sum16(a1)) + (sum16(b0) + sum16(b1)), lane);
        const float inv = (lsum > 0.f) ? 1.f / lsum : 0.f;
        float prev_last = 0.f;
#define CMP_IMP(T, P0, P1) do { float own[8], car[8]; \
            _Pragma("unroll") for (int a = 0; a < 4; ++a) { \
                own[a]     = P0[4 * a] + P0[4 * a + 1] + P0[4 * a + 2] + 0.5f * P0[4 * a + 3]; car[a]     = 0.5f * P0[4 * a + 3]; \
                own[4 + a] = P1[4 * a] + P1[4 * a + 1] + P1[4 * a + 2] + 0.5f * P1[4 * a + 3]; car[4 + a] = 0.5f * P1[4 * a + 3]; } \
            _Pragma("unroll") for (int k = 0; k < 8; ++k) car[k] = lane_xor(car[k], lane, 32); \
            _Pragma("unroll") for (int k = 0; k < 8; ++k) { const float add = hi ? car[k] : (k >= 1 ? car[k - 1] : prev_last); imp[16 * (T) + 2 * k + hi] = own[k] + add; } \
            prev_last = car[7]; } while (0)
        CMP_IMP(0, a0, a1); CMP_IMP(1, b0, b1);
#undef CMP_IMP
        if (hi == 0) ((LAS float*)(L + L_INVL))[rh * 64 + qloc] = inv;
        f32x16 o[2];
#pragma unroll
        for (int r = 0; r < 16; ++r) { o[0][r] = 0.f; o[1][r] = 0.f; }
        pv(o, vp0, a0, a1); pv(o, vp0 + VSLOT, b0, b1);
        ATT_BAR();
        if (qc >= 1) dma_tile<64, true>(lds0, pr + rowbase * DINP + slot_base(S_KSEL + g), DINP, pr + rowbase * DINP + slot_base(S_VSEL + g), DINP, 64 * (qc - 1), 0, wid, lane);
#pragma unroll
        for (int r = 0; r < 16; ++r) { oc[0][r] = 0.f; oc[1][r] = 0.f; }
        acc_scaled(oc, o, gate[(0 * 4 + rh) * 64 + qloc] * inv, wsf, r32, hi);
    }
    if (qc <= 15) {
        const int tid = opaque_tid(wv);
        if (tid < 64) ((LAS unsigned*)(L + L_SELM))[tid] = (qc == 31) ? 0xffffffffu : ((2u << qc) - 1u);
        ATT_LBAR();
    } else {
        const int tid = opaque_tid(wv);
        const LAS float* imp = (const LAS float*)(L + L_IMP); LAS float* sc = (LAS float*)(L + L_SC);
        const int qq = tid >> 3, jj = tid & 7;
        const LAS float* il = (const LAS float*)(L + L_INVL);
        const float i0 = il[qq], i1 = il[64 + qq], i2 = il[128 + qq], i3 = il[192 + qq];
#pragma unroll
        for (int k = 0; k < 4; ++k) { const int j = jj + 8 * k;
            const float tot = (imp[(0 * 64 + qq) * IMPS + j] * i0 + imp[(1 * 64 + qq) * IMPS + j] * i1) + (imp[(2 * 64 + qq) * IMPS + j] * i2 + imp[(3 * 64 + qq) * IMPS + j] * i3);
            float s; if (j > qc) s = -INFINITY; else if (j == 0 || j == qc || j == qc - 1) s = 1e4f; else s = tot; sc[qq * IMPS + j] = s; }
        ATT_LBAR();
        float v[32];
#pragma unroll
        for (int k = 0; k < 32; ++k) v[k] = sc[qq * IMPS + k];
        unsigned bits = 0u;
#pragma unroll
        for (int k = 0; k < 4; ++k) { const int j = jj + 8 * k; const float me = sc[qq * IMPS + j]; int rank = 0;
#pragma unroll
            for (int i = 0; i < 32; ++i) { const float si = v[i]; rank += (si > me || (si == me && i < j)) ? 1 : 0; }
            if (rank < 16) bits |= 1u << j; }
        { const int lane = tid & 63; bits |= lane_xor_u(bits, lane, 1); bits |= lane_xor_u(bits, lane, 2); bits |= lane_xor_u(bits, lane, 4); }
        if (jj == 0) ((LAS unsigned*)(L + L_SELM))[qq] = bits;
        ATT_LBAR();
    }
    { NSA_IDS(); park_store(oc, (LAS float*)(L + L_OST) + wid * 2048, lane); }
    {
        NSA_IDS();
        const unsigned selm = ((const LAS unsigned*)(L + L_SELM))[qloc];
        const bf16_t* Kg = pr + rowbase * DINP + slot_base(S_KSEL + g);
        const bf16_t* Vg = pr + rowbase * DINP + slot_base(S_VSEL + g);
        PolSel pol{qc + 1, qc, q, hi, selm, tbh};
        const PolWin polw{(qc < 8 ? qc : 8) + 1, qc, q, hi, tbh};
        const NextTiles<64, true, true, PolWin> nxt{pr + rowbase * DINP + slot_base(S_KWIN + g), DINP, pr + rowbase * DINP + slot_base(S_VWIN + g), DINP, &polw, polw.ntiles < 2 ? polw.ntiles : 2};
        f32x16 o[2]; float l;
        flash_loop<64, true>(L, Kg, DINP, Vg, DINP, qr, pol, 2, (qc + 1 < 2) ? qc + 1 : 2, nxt, o, l, wid, lane);
        { f32x16 dummy[2]; park_acc<false>(dummy, (LAS float*)(L + L_OST) + wid * 2048, o, (l > 0.f) ? gate[(1 * 4 + rh) * 64 + qloc] / l : 0.f, wsf, lane); }
    }
    {
        NSA_IDS();
        const bf16_t* Kg = pr + rowbase * DINP + slot_base(S_KWIN + g);
        const bf16_t* Vg = pr + rowbase * DINP + slot_base(S_VWIN + g);
        PolWin pol{(qc < 8 ? qc : 8) + 1, qc, q, hi, tbh};
        f32x16 o[2]; float l;
        flash_loop<64, true>(L, Kg, DINP, Vg, DINP, qr, pol, (2 + qc + 1) % NSLOT, pol.ntiles < 2 ? pol.ntiles : 2, NoNext{}, o, l, wid, lane);
        f32x16 fin[2]; park_acc<true>(fin, (LAS float*)(L + L_OST) + wid * 2048, o, (l > 0.f) ? gate[(2 * 4 + rh) * 64 + qloc] / l : 0.f, wsf, lane);
        store_tile(fin, (bf16_t*)(ws + WS_MIX) + (rowbase + q0 + 32 * qh) * DM + 512 + 64 * h, DM, L, wid, lane, (float*)(ws + WS_SSQM) + 2 * (rowbase + q0 + 32 * qh) + 1);
    }
    ATT_BAR();
}
#undef ATT_BAR
#undef ATT_LBAR
#undef NSA_IDS
}

#define XB_TMO      128
#define XB_XCNT(j)  (256  + 64 * (j))
#define XB_XSUB(j)  (1280 + 64 * (j))
#define XB_XGEN(j)  (2304 + 64 * (j))
#define XB_TOP      3328
#define XB_TOPGEN   3392
#define XCD_BAR_WORDS 3456
#define XB_SPIN_CAP (1u << 18)

__device__ __forceinline__ unsigned xb_ld(unsigned* p)              { return __hip_atomic_load(p, __ATOMIC_RELAXED, __HIP_MEMORY_SCOPE_AGENT); }
__device__ __forceinline__ unsigned xb_add(unsigned* p, unsigned v) { return __hip_atomic_fetch_add(p, v, __ATOMIC_RELAXED, __HIP_MEMORY_SCOPE_AGENT); }
__device__ __forceinline__ unsigned xb_xcc_id() { return (unsigned)__builtin_amdgcn_s_getreg((3 << 11) | 20) & 0xFu; }
#define XB_SPIN(cond, bar) do { unsigned _sp = 0; while (cond) { __builtin_amdgcn_s_sleep(1); \
    if ((++_sp & 255u) == 0u) { if (xb_ld(&(bar)[XB_TMO])) break; if (_sp > XB_SPIN_CAP) { atomicAdd(&(bar)[XB_TMO], 1u); break; } } } } while (0)

struct XcdBarrier {
    unsigned* bar; unsigned x;
    volatile LAS unsigned* st;
};

__device__ __forceinline__ XcdBarrier xcd_barrier_post(unsigned* bar, volatile LAS unsigned* st) {
    XcdBarrier b; b.bar = bar; b.x = xb_xcc_id(); b.st = st;
    if (threadIdx.x == 0) (void)xb_add(&bar[XB_XCNT(b.x)], 1u);
    return b;
}
__device__ __forceinline__ void xcd_barrier_complete(unsigned* bar, unsigned x, unsigned& nloc, unsigned& nx) {
    const unsigned G = gridDim.x * gridDim.y * gridDim.z;
    unsigned sum, cnt, mine, sp = 0u;
    for (;;) {
        sum = 0u; cnt = 0u; mine = 0u;
#pragma unroll
        for (unsigned j = 0; j < 16; ++j) { const unsigned c = xb_ld(&bar[XB_XCNT(j)]); sum += c; cnt += (c > 0u) ? 1u : 0u; mine = (j == x) ? c : mine; }
        if (sum == G) break;
        __builtin_amdgcn_s_sleep(1);
        if ((++sp & 255u) == 0u) { if (xb_ld(&bar[XB_TMO])) break; if (sp > XB_SPIN_CAP) { atomicAdd(&bar[XB_TMO], 1u); break; } }
    }
    nloc = mine > 0u ? mine : 1u; nx = cnt > 0u ? cnt : 1u;
}

__device__ __forceinline__ void xcd_barrier(const XcdBarrier& b, const unsigned char* pf = nullptr, int nchunk = 0, int wv = 0) {
    asm volatile("s_waitcnt vmcnt(0)" ::: "memory");
    __syncthreads();
    if (pf != nullptr && wv >= 1 && wv <= 4) {
        const int t = opaque_tid(wv) - 64;
        const pg8::u32x4* src = (const pg8::u32x4*)pf + (size_t)(blockIdx.x & 255) * nchunk;
        pg8::u32x4 v[9];
#pragma unroll
        for (int i = 0; i < 9; ++i) { int c = i * 256 + t; c = c < nchunk ? c : nchunk - 1; v[i] = src[c]; }
        asm volatile("" :: "v"(v[0]), "v"(v[1]), "v"(v[2]), "v"(v[3]), "v"(v[4]), "v"(v[5]), "v"(v[6]), "v"(v[7]), "v"(v[8]));
    }
    if (threadIdx.x == 0) {
        unsigned* bar = b.bar;
        __builtin_amdgcn_s_waitcnt(0);
        unsigned nloc = b.st[0], nx = b.st[1];
        if (nloc == 0u) { xcd_barrier_complete(bar, b.x, nloc, nx); b.st[0] = nloc; b.st[1] = nx; }
        const unsigned old = xb_add(&bar[XB_XSUB(b.x)], 1u);
        const unsigned gen = old / nloc;
        if (old + 1u == (gen + 1u) * nloc) {
            __builtin_amdgcn_fence(__ATOMIC_RELEASE, "agent");
            asm volatile("s_waitcnt vmcnt(0)" ::: "memory");
            const unsigned og = xb_add(&bar[XB_TOP], 1u);
            const unsigned tg = og / nx;
            if (og + 1u == (tg + 1u) * nx) xb_add(&bar[XB_TOPGEN], 1u);
            else XB_SPIN(xb_ld(&bar[XB_TOPGEN]) == tg, bar);
            __builtin_amdgcn_fence(__ATOMIC_ACQUIRE, "agent");
            xb_add(&bar[XB_XGEN(b.x)], 1u);
            asm volatile("s_waitcnt vmcnt(0)" ::: "memory");
        } else {
            XB_SPIN(xb_ld(&bar[XB_XGEN(b.x)]) == gen, bar);
            __builtin_amdgcn_fence(__ATOMIC_ACQUIRE, "agent");
            asm volatile("s_waitcnt vmcnt(0)" ::: "memory");
        }
    }
    __syncthreads();
}

template <bool RELEASE = false>
__device__ __forceinline__ void group_sync(unsigned* ctl, unsigned* a0, unsigned* a1, unsigned* a2, unsigned* a3, unsigned* w0, unsigned t0, unsigned* w1, unsigned t1, const unsigned char* pf = nullptr, int nchunk = 0, int wv = 0, unsigned* ag = nullptr) {
    asm volatile("s_waitcnt vmcnt(0)" ::: "memory");
    __syncthreads();
    if (pf != nullptr && wv >= 1 && wv <= 4) {
        const int t = opaque_tid(wv) - 64;
        const pg8::u32x4* src = (const pg8::u32x4*)pf + (size_t)(blockIdx.x & 255) * nchunk;
        pg8::u32x4 v[9];
#pragma unroll
        for (int i = 0; i < 9; ++i) { int c = i * 256 + t; c = c < nchunk ? c : nchunk - 1; v[i] = src[c]; }
        asm volatile("" :: "v"(v[0]), "v"(v[1]), "v"(v[2]), "v"(v[3]), "v"(v[4]), "v"(v[5]), "v"(v[6]), "v"(v[7]), "v"(v[8]));
    }
    if (threadIdx.x == 0) {
        if (RELEASE) { __builtin_amdgcn_fence(__ATOMIC_RELEASE, "agent"); asm volatile("s_waitcnt vmcnt(0)" ::: "memory"); }
        (void)xb_add(a0, 1u); if (a1) (void)xb_add(a1, 1u); if (a2) (void)xb_add(a2, 1u); if (a3) (void)xb_add(a3, 1u); if (ag) (void)xb_add(ag, 1u);
        XB_SPIN(xb_ld(w0) < t0, ctl);
        if (w1 != nullptr) XB_SPIN(xb_ld(w1) < t1, ctl);
        __builtin_amdgcn_fence(__ATOMIC_ACQUIRE, "agent");
        asm volatile("s_waitcnt vmcnt(0)" ::: "memory");
    }
    __syncthreads();
}

__global__ void __launch_bounds__(512, 2) mega(Params p) {
    extern __shared__ __attribute__((aligned(16))) unsigned char lds[];
    const int G = gridDim.x, bid = blockIdx.x, NGW = G * NW;
    int wv = __builtin_amdgcn_readfirstlane((int)(threadIdx.x >> 6)); asm volatile("" : "+s"(wv));
#define PHASE_IDS() const int tid = opaque_tid(wv), lane = tid & 63, wave = __builtin_amdgcn_readfirstlane(tid >> 6), gw = bid * NW + wave; (void)tid; (void)lane; (void)gw
    unsigned char* ws = (unsigned char*)inptr(22);
    LAS unsigned char* L = (LAS unsigned char*)lds;
    volatile LAS unsigned* bst = (volatile LAS unsigned*)(L + LDS_BST);
    if (threadIdx.x < 4) bst[threadIdx.x] = 0u;
    __syncthreads();
    (void)xcd_barrier_post((unsigned*)(ws + WS_CTL), bst);
#define bar (XcdBarrier{(unsigned*)((unsigned char*)inptr(22) + WS_CTL), xb_xcc_id(), (volatile LAS unsigned*)((LAS unsigned char*)lds + LDS_BST)})

    {
        PHASE_IDS();
        LAS float* scr = (LAS float*)(L + wave * 8704);
        constexpr int I0 = (1024 / 64) * (DINP / 32), I1 = (QR / 64) * (MQ / 32), I2 = (KVR / 64) * (MKV / 32), I3 = 16 * 32, I4 = 16 * (FF / 32), I5 = (FF / 64) * 32;
        constexpr int I6 = (2048 / 64) * (128 / 32), I7 = (128 / 64) * (64 / 32);
        constexpr int NIT = I0 + I1 + I2 + I3 + I4 + I5 + 2 * I6 + 2 * I7;
        for (int it = gw; it < NIT; it += NGW) {
            int r = it;
            if (r < I0) { p0_transpose_item(inptr(2), 1024, DIN, DINP, (bf16_t*)(ws + WS_WIN), scr, r, lane, inptr(1), 0, 1); continue; } r -= I0;
            if (r < I1) { p0_transpose_item(inptr(5), QR, MQ, MQ, (bf16_t*)(ws + WS_WUQ), scr, r, lane, inptr(3)); continue; } r -= I1;
            if (r < I2) { p0_transpose_item(inptr(6), KVR, MKV, MKV, (bf16_t*)(ws + WS_WUKV), scr, r, lane, inptr(4), 0, 2); continue; } r -= I2;
            if (r < I3) { const int k0_ = 64 * (r / 32); p0_transpose_item(inptr(17), 1024, 1024, 1024, (bf16_t*)(ws + WS_WO), scr, r, lane, k0_ < 512 ? inptr(15) : inptr(16) - 512); continue; } r -= I3;
            if (r < I4) { p0_transpose_item(inptr(19), 1024, FF, FF, (bf16_t*)(ws + WS_WUP), scr, r, lane, inptr(18)); continue; } r -= I4;
            if (r < I5) { p0_transpose_item(inptr(20), FF, 1024, 1024, (bf16_t*)(ws + WS_WDN), scr, r, lane, nullptr, LDH); continue; } r -= I5;
            if (r < 2 * I6) { const int kv = r / I6; p0_transpose_item(inptr(12) + (size_t)kv * 2048 * 128, 2048, 128, 128, (bf16_t*)(ws + WS_W1T) + (size_t)kv * 128 * 2048, scr, r % I6, lane, nullptr, 0, 3); continue; } r -= 2 * I6;
            { const int kv = r / I7; p0_transpose_item(inptr(13) + kv * 128 * 64, 128, 64, 64, (bf16_t*)(ws + WS_W2T) + kv * 64 * 128, scr, r % I7, lane); }
        }
        for (int m = gw; m < M; m += 4 * NGW) rows_to_bf16_rstd<4>(inptr(0), (bf16_t*)(ws + WS_XB), (float*)(ws + WS_RS1), m, NGW, lane);
        for (int e = bid * 512 + tid; e < 2048 * 16; e += G * 512) { const int pos = e >> 4, i = e & 15; const float inv = exp2f(-(float)i * (13.287712379549449f / 16.f)); float sn, cs; sincosf((float)pos * inv, &sn, &cs);
            ((float*)(ws + WS_ROPE))[pos * 32 + i] = cs; ((float*)(ws + WS_ROPE))[pos * 32 + 16 + i] = sn; }
        for (int m = bid * 512 + tid; m < M; m += G * 512) { ((float*)(ws + WS_SSQ2))[m] = 0.f; ((float*)(ws + WS_RSQ))[m] = 0.f; ((float*)(ws + WS_RSKV))[m] = 0.f; ((float*)(ws + WS_SSQKR))[m] = 0.f; ((float*)(ws + WS_SSQM))[2 * m] = 0.f; ((float*)(ws + WS_SSQM))[2 * m + 1] = 0.f; }
    }
    xcd_barrier(bar);
    { pg8::Gemm g{(const bf16_t*)(ws + WS_XB), (const bf16_t*)(ws + WS_WIN), M, DINP, DM, DM, DM}; pg8::StaticOrder S; S.init(M, DINP, G, bid);
      PEpiProj E{(bf16_t*)(ws + WS_PROJ), DINP, (const float*)(ws + WS_RS1), (float*)(ws + WS_RSQ), (float*)(ws + WS_RSKV), (float*)(ws + WS_SSQKR), inptr(9), inptr(10), (const float*)(ws + WS_ROPE), inptr(8)}; pg8::gemm_phase<PEpiProj, pg8::StaticOrder, true, true>(L, g, S, E, wv); }
#define GCTL ((unsigned*)((unsigned char*)inptr(22) + WS_CTL))
#define GCNT(sp, pm) (GCTL + 4096 + ((sp) * 64 + (pm)) * 16)
    if (G == 256) { const int x_ = bid & 7, jj_ = (bid >> 3) & 7, k_ = bid >> 6;
        unsigned* c_ = GCNT(0, 8 * x_ + jj_); group_sync(GCTL, c_, nullptr, nullptr, nullptr, c_, 4u, ((k_ & 1) && jj_ < 7) ? GCNT(0, 8 * x_ + jj_ + 1) : nullptr, 4u); }
    else xcd_barrier(bar);
    { PHASE_IDS();
      __syncthreads();
      if (G == 256) { const int x_ = bid & 7, jj_ = (bid >> 3) & 7, k_ = bid >> 6; compress_block(ws, L, (2 * jj_ + (k_ & 1)) | (x_ << 4) | ((k_ >> 1) << 7), wv); }
      else for (int t = bid; t < 256; t += G) compress_block(ws, L, t, wv); }
    { pg8::Gemm g{(const bf16_t*)(ws + WS_PROJ) + P_HKV, (const bf16_t*)(ws + WS_WUKV), M, MKV, KVR, DINP, KVR}; pg8::StaticOrder S; S.init(M, MKV, G, bid);
      PEpiKV E{(bf16_t*)(ws + WS_KVM), (bf16_t*)(ws + WS_KMLA), (const bf16_t*)(ws + WS_PROJ), (const float*)(ws + WS_RSKV), (const float*)(ws + WS_SSQKR), (const float*)(ws + WS_ROPE), inptr(8)}; pg8::gemm_phase<PEpiKV, pg8::StaticOrder, true, true>(L, g, S, E, wv); }
    asm volatile("" : "+s"(wv));
    { pg8::Gemm g{(const bf16_t*)(ws + WS_PROJ) + P_HQ, (const bf16_t*)(ws + WS_WUQ), M, MQ, QR, DINP, QR}; pg8::StaticOrder S; S.init(M, MQ, G, bid);
      PEpiBf16<0> E{(bf16_t*)(ws + WS_QM), MQ, (const float*)(ws + WS_RSQ), 1.f / QR, nullptr}; pg8::gemm_phase<PEpiBf16<0>, pg8::StaticOrder, true, false>(L, g, S, E, wv); }
    if (G == 256) { unsigned* c_ = GCNT(3, bid & 7); group_sync<true>(GCTL, c_, nullptr, nullptr, nullptr, c_, 32u, nullptr, 0u); }
    else xcd_barrier(bar);
    {
        PHASE_IDS();
        LAS float* tb = (LAS float*)L;
        for (int i = tid; i < 8 * 128; i += 512) { const int h = i >> 7, n = i & 127; tb[i] = (inptr(14)[t5_bucket(n) * 8 + h] - inptr(14)[31 * 8 + h]) * LOG2E; }
        __syncthreads();
        const int vcu = (G % 8 == 0) ? (bid % 8) * (G / 8) + bid / 8 : bid;
        for (int pr_ = vcu; pr_ < 256; pr_ += G) {
            { const int bg = pr_ >> 4, s_ = pr_ & 15;
#pragma unroll 1
              for (int u_ = 0; u_ < 2; ++u_) att::nsa_unit(ws, L, bg >> 1, bg & 1, (u_ & 1) ? s_ : 31 - s_, wv);
            }
            { const int bh = pr_ >> 2, s_ = pr_ & 3;
#pragma unroll 1
              for (int u_ = 0; u_ < 2; ++u_) att::mla_unit(ws, L, bh >> 3, bh & 7, u_ ? s_ : 7 - s_, wv, u_ ? (4 * (7 - s_) + 4) % att::NSLOT : 0, u_ ? 2 : 0, u_ ? 0 : 2);
            }
        }
    }
    if (G == 256) { const int x_ = bid & 7, j_ = bid >> 3, sn_ = j_ & 15, sm_ = j_ & 3;
        group_sync(GCTL, GCNT(4, 8 * x_ + ((31 - sn_) >> 2)), GCNT(4, 8 * x_ + (sn_ >> 2)), GCNT(4, 8 * x_ + 7 - sm_), GCNT(4, 8 * x_ + sm_), GCNT(4, 8 * x_ + (j_ & 7)), 16u, nullptr, 0u, ws + WS_WO, (int)((size_t)DM * DM * 2 / 16 / 256), wv, GCTL + 4096 + 5 * 64 * 16); }
    else xcd_barrier(bar, ws + WS_WO, (int)((size_t)DM * DM * 2 / 16 / 256), wv);
    { pg8::Gemm g{(const bf16_t*)(ws + WS_MIX), (const bf16_t*)(ws + WS_WO), M, DM, DM, DM, DM}; pg8::StaticOrder S; S.init(M, DM, G, bid);
      PEpiWo E{(const bf16_t*)(ws + WS_XB), (bf16_t*)(ws + WS_H2), (float*)(ws + WS_SSQ2), (const float*)(ws + WS_SSQM), DM, (G == 256) ? GCTL + 4096 + 5 * 64 * 16 : nullptr};
      pg8::gemm_phase<PEpiWo, pg8::StaticOrder, true, true>(L, g, S, E, wv); }
    if (G == 256) { unsigned* c_ = GCNT(1, 8 * (bid & 7) + ((bid >> 3) & 7)); group_sync(GCTL, c_, nullptr, nullptr, nullptr, c_, 4u, nullptr, 0u, ws + WS_WUP, (int)((size_t)FF * DM * 2 / 16 / 256), wv, GCTL + 4096 + 5 * 64 * 16 + 16); }
    else xcd_barrier(bar, ws + WS_WUP, (int)((size_t)FF * DM * 2 / 16 / 256), wv);
    { pg8::Gemm g{(const bf16_t*)(ws + WS_H2), (const bf16_t*)(ws + WS_WUP), M, FF, DM, DM, DM}; pg8::StaticOrder S; S.init(M, FF, G, bid);
      PEpiBf16<2> E{(bf16_t*)(ws + WS_HID), LDH, (const float*)(ws + WS_SSQ2), 1.f / 1024, (G == 256) ? GCTL + 4096 + 5 * 64 * 16 + 16 : nullptr};
      pg8::gemm_phase<PEpiBf16<2>, pg8::StaticOrder, true, true>(L, g, S, E, wv); }
    if (G == 256) { unsigned* c_ = GCNT(2, 8 * (bid & 7) + ((bid >> 3) & 7)); group_sync(GCTL, c_, nullptr, nullptr, nullptr, c_, 4u, nullptr, 0u, ws + WS_WDN, (int)((size_t)DM * LDH * 2 / 16 / 256), wv); }
    else xcd_barrier(bar, ws + WS_WDN, (int)((size_t)DM * LDH * 2 / 16 / 256), wv);
    { pg8::Gemm g{(const bf16_t*)(ws + WS_HID), (const bf16_t*)(ws + WS_WDN), M, DM, FF, LDH, LDH}; pg8::StaticOrder S; S.init(M, DM, G, bid);
      PEpiDown E{(const bf16_t*)(ws + WS_H2), ((float*)inptr(21)), DM}; pg8::gemm_phase<PEpiDown, pg8::StaticOrder, true, true>(L, g, S, E, wv); }
#undef bar
}

extern "C" void kernel_launch(void* const* d_in, const int* in_sizes, int n_in, void* d_out, int out_size,
                              void* d_ws, size_t ws_size, hipStream_t stream) {
    static int grid_blocks = 0;
    if (!grid_blocks) {
        int dev = 0, cus = 0, per_cu = 0;
        (void)hipGetDevice(&dev);
        (void)hipDeviceGetAttribute(&cus, hipDeviceAttributeMultiprocessorCount, dev);
        (void)hipFuncSetAttribute((const void*)mega, hipFuncAttributeMaxDynamicSharedMemorySize, LDS_BYTES);
        (void)hipOccupancyMaxActiveBlocksPerMultiprocessor(&per_cu, (const void*)mega, 512, LDS_BYTES);
        if (per_cu != 1) fprintf(stderr, "note: occupancy query reports %d blocks/CU; launching 1 per CU\n", per_cu);
        grid_blocks = cus;
        if (n_in != 21 || out_size != M * DM || ws_size < 256 * MiB) fprintf(stderr, "unexpected shapes: n_in %d out %d ws %zu\n", n_in, out_size, ws_size);
    }
    Params p{};
    for (int i = 0; i < 21; ++i) p.in[i] = (const float*)d_in[i];
    p.out = (float*)d_out; p.ws = (unsigned char*)d_ws;
    if (hipMemsetAsync((char*)d_ws + WS_CTL, 0, CTL_ZERO_BYTES, stream) != hipSuccess) { fprintf(stderr, "memset of the barrier words failed\n"); return; }
    hipLaunchKernelGGL(mega, dim3(grid_blocks), dim3(512), LDS_BYTES, stream, p);
    hipError_t e = hipPeekAtLastError();
    if (e != hipSuccess) fprintf(stderr, "launch failed: %s (grid %d)\n", hipGetErrorString(e), grid_blocks);
}
```

```cpp
#include <hip/hip_runtime.h>
#include <cstdio>
#include <cstdint>

#define LAS __attribute__((address_space(3)))
typedef unsigned short bf16_t;
typedef short bf16x8 __attribute__((ext_vector_type(8)));
typedef float f32x4 __attribute__((ext_vector_type(4)));
typedef unsigned u32x4 __attribute__((ext_vector_type(4)));
typedef unsigned u32x2 __attribute__((ext_vector_type(2)));

constexpr int BATCH = 8, SEQ = 2048, DM = 1024, M = BATCH * SEQ;
constexpr int DIN = 1976, DINP = 2048;
constexpr int C_HQ = 0, C_HKV = 384, C_HKR = 640, C_QB = 672, C_KVB = 1184, C_GATE = 1952;
constexpr int C_KCMP = C_KVB, C_VCMP = C_KVB + 128, C_KSEL = C_KVB + 256, C_VSEL = C_KVB + 384, C_KWIN = C_KVB + 512, C_VWIN = C_KVB + 640;
constexpr int P_HQ = 1280, P_HKV = 1664, P_HKR = 1920, P_GATE = 1952;
__host__ __device__ constexpr int slot_base(int s) { return 256 * (s >> 2) + 32 * (s & 3); }
constexpr int S_Q = 0, S_KCMP = 8, S_VCMP = 10, S_KSEL = 12, S_VSEL = 14, S_KWIN = 16, S_VWIN = 18;
constexpr int QR = 384, KVR = 256, MQ = 768, MKV = 1024, FF = 4096;
constexpr int LDH = FF + 64;
constexpr int NCMP = 127;
constexpr float EPS = 1e-6f;
constexpr float LOG2E = 1.4426950408889634f;
constexpr float QS_MLA = 0.10206207261596577f * LOG2E;
constexpr float QS_NSA = 0.125f * LOG2E;

constexpr size_t MiB = 1u << 20;
constexpr size_t WS_CTL = 0, CTL_ZERO_BYTES = 65536;
constexpr size_t WS_WIN = 1 * MiB, WS_WUQ = 5 * MiB, WS_WUKV = 6 * MiB, WS_WO = 7 * MiB, WS_WUP = 9 * MiB, WS_WDN = 17 * MiB;
constexpr size_t WS_KCMP = 26 * MiB, WS_VCMP = 26 * MiB + 512 * 1024;
constexpr size_t WS_W1T = 30 * MiB;
constexpr size_t WS_W2T = 27 * MiB;
constexpr size_t WS_RSQ = 28 * MiB, WS_RSKV = 28 * MiB + 65536, WS_SSQ2 = 28 * MiB + 131072, WS_SSQM = 28 * MiB + 262144, WS_RS1 = 28 * MiB + 262144 + 131072;
constexpr size_t WS_SSQKR = 28 * MiB + 524288;
constexpr size_t WS_ROPE = 29 * MiB + 65536;
constexpr size_t WS_XB = 32 * MiB;
constexpr size_t WS_DUMMY0 = 0;
constexpr size_t WS_HB = 32 * MiB;
constexpr size_t WS_MIX = 64 * MiB;
constexpr size_t WS_PROJ = 96 * MiB;
constexpr size_t WS_QM = 160 * MiB;
constexpr size_t WS_KVM = 184 * MiB;
constexpr size_t WS_KMLA = 216 * MiB;
constexpr size_t WS_QN = 208 * MiB;
constexpr size_t WS_KSEL = 240 * MiB;
constexpr size_t WS_KWIN = 244 * MiB;
constexpr size_t WS_HQN = 232 * MiB;
constexpr size_t WS_HKVN = 244 * MiB;
constexpr size_t WS_H2 = 224 * MiB;
constexpr size_t WS_HID = 32 * MiB;

constexpr int LDS_BYTES = 155648, LDS_BST = 154624;
constexpr int NW = 8;

struct Params {
    const float* in[21];
    float* out;
    unsigned char* ws;
};

typedef const float* cfptr_t;
__device__ __forceinline__ const float* inptr(int i) {
    const __attribute__((address_space(4))) char* ka = (const __attribute__((address_space(4))) char*)__builtin_amdgcn_kernarg_segment_ptr();
    int off = i * 8; asm volatile("" : "+s"(off));
    return *(const __attribute__((address_space(4))) cfptr_t*)(ka + off);
}
template <class V> __device__ __forceinline__ void st16_wt(const void* sbase, unsigned voff, const V& v) { static_assert(sizeof(V) == 16, "16-byte vector"); asm volatile("global_store_dwordx4 %0, %1, %2 sc1\n\ts_nop 1" :: "v"(voff), "v"(v), "s"(sbase) : "memory"); }
__device__ __forceinline__ unsigned f2bf(float f) { unsigned u = __builtin_bit_cast(unsigned, f); return (u + 0x7fffu + ((u >> 16) & 1u)) >> 16; }
__device__ __forceinline__ float bf2f(unsigned b) { return __builtin_bit_cast(float, b << 16); }
__device__ __forceinline__ unsigned pk2(float lo, float hi) { return f2bf(lo) | (f2bf(hi) << 16); }
__device__ __forceinline__ float wave_sum(float v) {
#pragma unroll
    for (int o = 1; o < 64; o <<= 1) v += __shfl_xor(v, o);
    return v;
}
__device__ __forceinline__ int t5_bucket(int n) {
    if (n < 16) return n;
    int b = 16;
    b += (n >= 19); b += (n >= 21); b += (n >= 24); b += (n >= 27); b += (n >= 31); b += (n >= 35); b += (n >= 40); b += (n >= 46);
    b += (n >= 52); b += (n >= 59); b += (n >= 67); b += (n >= 77); b += (n >= 87); b += (n >= 99); b += (n >= 113);
    return b;
}

__device__ __forceinline__ void p0_transpose_item(const float* W, int K, int N, int Npad, bf16_t* WT, LAS float* scr, int item, int lane, const float* gk = nullptr, int ldw = 0, int projmap = 0) {
    const int nblk = Npad / 32, kb = item / nblk, nb = item % nblk, k0 = 64 * kb, n0 = 32 * nb;
    int nsrc = n0;
    if (projmap == 2) { const int pn_ = n0 >> 8, bj_ = (n0 >> 7) & 1, wc_ = (n0 >> 5) & 3; nsrc = (wc_ < 2 ? 128 * (2 * pn_ + wc_) : 128 * (2 * pn_ + wc_ - 2) + 64) + 32 * bj_; }
    else if (projmap == 1) { if (n0 < 1280) { const int sl = 4 * (n0 >> 8) + ((n0 & 127) >> 5), e0 = 32 * ((n0 >> 7) & 1); nsrc = (sl < 8 ? C_QB + 64 * sl : C_KVB + 64 * (sl - 8)) + e0; }
                   else if (n0 < 1280 + 672) nsrc = n0 - 1280; else if (n0 == P_GATE) nsrc = C_GATE; else nsrc = N; }
    const int nn = nsrc + (lane & 31);
    float wv[32];
#pragma unroll
    for (int i = 0; i < 32; ++i) { const int kk = 2 * i + (lane >> 5); wv[i] = (nn < N) ? W[(size_t)(k0 + kk) * N + nn] : 0.f; }
#pragma unroll
    for (int i = 0; i < 32; ++i) { const int kk = 2 * i + (lane >> 5); const float gg = gk ? gk[k0 + kk] : 1.f; scr[kk * 33 + (lane & 31)] = wv[i] * gg; }
    asm volatile("s_waitcnt lgkmcnt(0)" ::: "memory");
    const int c = lane & 7;
#pragma unroll
    for (int j = 0; j < 4; ++j) { const int n = (lane >> 3) + 8 * j; const LAS float* s = scr + (8 * c) * 33 + n;
        u32x4 o; o.x = pk2(s[0 * 33], s[1 * 33]); o.y = pk2(s[2 * 33], s[3 * 33]); o.z = pk2(s[4 * 33], s[5 * 33]); o.w = pk2(s[6 * 33], s[7 * 33]);
        if (projmap == 3) { const int nn_ = n0 + n, k_ = k0 + 8 * c;
            *(u32x4*)(WT + ((size_t)(((k_ >> 5) * (Npad >> 4) + (nn_ >> 4)) * 64 + ((k_ >> 3) & 3) * 16 + (nn_ & 15))) * 8) = o; }
        else *(u32x4*)(WT + (size_t)(n0 + n) * (ldw ? ldw : K) + k0 + 8 * c) = o; }
    asm volatile("s_waitcnt lgkmcnt(0)" ::: "memory");
}
template <int NR>
__device__ __forceinline__ void rows_to_bf16_rstd(const float* x, bf16_t* o, float* rstd_out, int row0, int rstride, int lane) {
    f32x4 v[NR][4];
#pragma unroll
    for (int r = 0; r < NR; ++r) { const int rr = (row0 + r * rstride < M) ? row0 + r * rstride : row0; const f32x4* xr = (const f32x4*)(x + (size_t)rr * DM) + lane;
#pragma unroll
        for (int j = 0; j < 4; ++j) v[r][j] = xr[64 * j]; }
#pragma unroll
    for (int r = 0; r < NR; ++r) { if (row0 + r * rstride >= M) continue; float s = 0.f;
#pragma unroll
        for (int j = 0; j < 4; ++j) s += (v[r][j].x * v[r][j].x + v[r][j].y * v[r][j].y) + (v[r][j].z * v[r][j].z + v[r][j].w * v[r][j].w);
        s = wave_sum(s);
        if (lane == 0) rstd_out[row0 + r * rstride] = 1.f / sqrtf(s * (1.f / DM) + EPS);
        unsigned long long* o8 = (unsigned long long*)(o + (size_t)(row0 + r * rstride) * DM) + lane;
#pragma unroll
        for (int j = 0; j < 4; ++j) o8[64 * j] = (unsigned long long)pk2(v[r][j].x, v[r][j].y) | ((unsigned long long)pk2(v[r][j].z, v[r][j].w) << 32); }
}

__device__ __forceinline__ int opaque_tid(int wv) { int lane; asm volatile("v_mbcnt_lo_u32_b32 %0, -1, 0\n\tv_mbcnt_hi_u32_b32 %0, -1, %0" : "=v"(lane)); return (wv << 6) | lane; }
namespace pg8 {
#define PG8_LAS __attribute__((address_space(3)))
typedef unsigned short bf16_t;
typedef short bf16x8 __attribute__((ext_vector_type(8)));
typedef float f32x4 __attribute__((ext_vector_type(4)));
typedef unsigned u32x4 __attribute__((ext_vector_type(4)));
constexpr int BM = 256, BK = 64, HALF = 128, HTB = HALF * BK * 2  , STAGE_BYTES = 8 * HTB, NXCD = 8, WGM = 8;

__host__ __device__ __forceinline__ int lds_byte(int r, int c) { const int st = (r >> 4) * 2 + (c >> 5), rr = r & 15, cc = c & 31, ob = rr * 64 + cc * 2; return st * 1024 + (ob ^ (((ob >> 9) & 1) << 5)); }
__host__ __device__ __forceinline__ void stage_rc(int b, int& R, int& C) { const int st = b / 1024, sb = b % 1024, swz = sb ^ (((sb >> 9) & 1) << 5); R = (st >> 1) * 16 + swz / 64; C = (st & 1) * 32 + (swz % 64) / 2; }
__host__ __device__ __forceinline__ int perm32(int rho) { const int n = rho >> 4, i = rho & 15; return 8 * (i >> 2) + 4 * n + (i & 3); }

struct Unit { int pm, pn; };
struct Gemm { const bf16_t* A; const bf16_t* Bt; int M, N, K, lda, ldb; };

struct StaticOrder {
    int nM, nN, nwg, G, c;
    __host__ __device__ void init(int M, int N, int G_, int c_) { nM = M / BM; nN = N / BM; nwg = nM * nN; G = G_; c = c_; }
    __host__ __device__ bool next(int i, Unit& u) const {
        const long L = (long)i * G + c; if (L >= nwg) return false;
        int wgid = (int)L; { const int q = nwg / NXCD, r = nwg % NXCD, xcd = wgid % NXCD, off = wgid / NXCD; wgid = (xcd < r ? xcd * (q + 1) : r * (q + 1) + (xcd - r) * q) + off; }
        const int nig = WGM * nN, gid = wgid / nig, fm = gid * WGM, gsz = (nM - fm) < WGM ? (nM - fm) : WGM;
        u.pm = fm + ((wgid % nig) % gsz); u.pn = (wgid % nig) / gsz; return true;
    }
    __device__ __forceinline__ void a_ready(const Unit&) const {}
    __device__ __forceinline__ void done(const Unit&) const {}
};

template <class Epi, class Sched, bool ALIGN_EPI = false, bool SP2 = false>
__device__ __forceinline__ void gemm_phase(PG8_LAS unsigned char* lds, const Gemm g, const Sched& S, const Epi& E, int wv) {
    const int tid = opaque_tid(wv), wid = __builtin_amdgcn_readfirstlane(tid >> 6), lane = tid & 63, wr = wid >> 2, wc = wid & 3, fr = lane & 15, fq = lane >> 4;
    const int K = g.K, nt = K / BK;
    unsigned voffA[2], voffB[2];
#pragma unroll
    for (int i = 0; i < 2; ++i) { int R, C; stage_rc(tid * 16 + i * 8192, R, C); const int Rb = Epi::PERM ? ((R & ~31) + perm32(R & 31)) : R;
        voffA[i] = (unsigned)(R * g.lda + C) * 2u; voffB[i] = (unsigned)(Rb * g.ldb + C) * 2u; }
    const size_t kstep = (size_t)(BK * 2);
    const size_t hstepA = (size_t)HALF * g.lda * 2, hstepB = (size_t)HALF * g.ldb * 2;
    const size_t tstepA = 2 * hstepA, tstepB = 2 * hstepB;
    const unsigned ldsw = (unsigned)wid * 1024u;
    const int aoff = lds_byte(wr * 64 + fr, fq * 8), boff = lds_byte(wc * 32 + fr, fq * 8);
#define PG8_SA(b, h) (((b) * 2 + (h)) * HTB)
#define PG8_SB(b, h) ((4 + (b) * 2 + (h)) * HTB)
#define PG8_STAGE(bufoff, gbase, voff) do { _Pragma("unroll") for (int _i = 0; _i < 2; ++_i) \
        __builtin_amdgcn_global_load_lds((const unsigned*)((const char*)(gbase) + (voff)[_i]), (PG8_LAS unsigned*)(lds + (bufoff) + ldsw + _i * 8192), 16, 0, 0); } while (0)
#define PG8_LDA(dst, b, h) do { _Pragma("unroll") for (int m = 0; m < 4; ++m) _Pragma("unroll") for (int k = 0; k < 2; ++k) dst[m][k] = *(const PG8_LAS bf16x8*)(lds + PG8_SA(b, h) + aoff + m * 2048 + k * 1024); } while (0)
#define PG8_LDB(dst, b, h) do { _Pragma("unroll") for (int n = 0; n < 2; ++n) _Pragma("unroll") for (int k = 0; k < 2; ++k) dst[n][k] = *(const PG8_LAS bf16x8*)(lds + PG8_SB(b, h) + boff + n * 2048 + k * 1024); } while (0)
#define PG8_MMA(ai, bj, At, Bt) do { __builtin_amdgcn_s_setprio(1); _Pragma("unroll") for (int m = 0; m < 4; ++m) _Pragma("unroll") for (int n = 0; n < 2; ++n) _Pragma("unroll") for (int k = 0; k < 2; ++k) \
        acc[ai][bj][m][n] = __builtin_amdgcn_mfma_f32_16x16x32_bf16(Bt[n][k], At[m][k], acc[ai][bj][m][n], 0, 0, 0); __builtin_amdgcn_s_setprio(0); } while (0)
#define PG8_WAIT_V(n) asm volatile("s_waitcnt vmcnt(" #n ")" ::: "memory")
#define PG8_WAIT_L(n) asm volatile("s_waitcnt lgkmcnt(" #n ")" ::: "memory")
#define PG8_BAR __builtin_amdgcn_s_barrier()
#define PG8_SCHED __builtin_amdgcn_sched_barrier(0)
    Unit cur, nxt; int ui = 0;
    if (!S.next(0, cur)) return;
    f32x4 acc[2][2][4][2];
#pragma unroll
    for (int a = 0; a < 2; ++a)
#pragma unroll
        for (int b = 0; b < 2; ++b)
#pragma unroll
            for (int m = 0; m < 4; ++m)
#pragma unroll
                for (int n = 0; n < 2; ++n) acc[a][b][m][n] = (f32x4){0.f, 0.f, 0.f, 0.f};
    bf16x8 At[4][2], B0[2][2], B1[2][2];
    const char* cA = (const char*)g.A + (size_t)cur.pm * tstepA; const char* cB = (const char*)g.Bt + (size_t)cur.pn * tstepB;
    asm volatile("" : "+s"(cA), "+s"(cB));
    S.a_ready(cur);
    if constexpr (SP2) {
        PG8_STAGE(PG8_SB(0, 0), cB, voffB); PG8_STAGE(PG8_SB(0, 1), cB + hstepB, voffB); PG8_STAGE(PG8_SA(0, 0), cA, voffA); PG8_STAGE(PG8_SA(0, 1), cA + hstepA, voffA);
        if (wr == 1) PG8_BAR;
        PG8_WAIT_V(2); PG8_BAR;
        PG8_STAGE(PG8_SB(1, 0), cB + kstep, voffB); PG8_STAGE(PG8_SA(1, 0), cA + kstep, voffA); PG8_STAGE(PG8_SB(1, 1), cB + hstepB + kstep, voffB);
        PG8_WAIT_V(6); PG8_BAR;
    } else {
        PG8_STAGE(PG8_SB(0, 0), cB, voffB); PG8_STAGE(PG8_SA(0, 0), cA, voffA); PG8_STAGE(PG8_SB(0, 1), cB + hstepB, voffB); PG8_STAGE(PG8_SA(0, 1), cA + hstepA, voffA);
        if (wr == 1) PG8_BAR;
        PG8_WAIT_V(4); PG8_BAR;
        PG8_STAGE(PG8_SB(1, 0), cB + kstep, voffB); PG8_STAGE(PG8_SA(1, 0), cA + kstep, voffA); PG8_STAGE(PG8_SB(1, 1), cB + hstepB + kstep, voffB);
        PG8_WAIT_V(6); PG8_BAR;
    }
    for (;;) {
        const bool has_next = S.next(ui + 1, nxt);
        const char* nA = has_next ? (const char*)g.A + (size_t)nxt.pm * tstepA : cA; const char* nB = has_next ? (const char*)g.Bt + (size_t)nxt.pn * tstepB : cB;
        asm volatile("" : "+s"(nA), "+s"(nB));
        for (int t = 0; t < nt; t += 2) {
            if constexpr (Epi::MIDSCALE) { if (t == nt / 2) E.midscale(acc, cur, wr, fr); }
            const bool last = (t == nt - 2);
            const char* a1 = cA + (size_t)(t + 1) * kstep;
            const char* a2 = last ? nA : cA + (size_t)(t + 2) * kstep; const char* b2 = last ? nB : cB + (size_t)(t + 2) * kstep;
            const char* a3 = a2 + kstep; const char* b3 = b2 + kstep;
            asm volatile("" : "+s"(a1), "+s"(a2), "+s"(b2), "+s"(a3), "+s"(b3));
            if (last && has_next) S.a_ready(nxt);
            if constexpr (SP2) {
            PG8_LDB(B0, 0, 0); PG8_LDB(B1, 0, 1); PG8_SCHED; PG8_LDA(At, 0, 0); PG8_STAGE(PG8_SA(1, 1), a1 + hstepA, voffA);
            PG8_WAIT_V(8); PG8_WAIT_L(0); PG8_BAR; PG8_MMA(0, 0, At, B0); PG8_MMA(0, 1, At, B1); PG8_BAR; PG8_SCHED;
            PG8_LDA(At, 0, 1); PG8_STAGE(PG8_SB(0, 0), b2, voffB); PG8_STAGE(PG8_SB(0, 1), b2 + hstepB, voffB); PG8_STAGE(PG8_SA(0, 0), a2, voffA);
            PG8_WAIT_V(8); PG8_WAIT_L(0); PG8_BAR; PG8_MMA(1, 0, At, B0); PG8_MMA(1, 1, At, B1); PG8_BAR; PG8_SCHED;
            PG8_LDB(B0, 1, 0); PG8_LDB(B1, 1, 1); PG8_SCHED; PG8_LDA(At, 1, 0); PG8_STAGE(PG8_SA(0, 1), a2 + hstepA, voffA);
            PG8_WAIT_V(8); PG8_WAIT_L(0); PG8_BAR; PG8_MMA(0, 0, At, B0); PG8_MMA(0, 1, At, B1); PG8_BAR; PG8_SCHED;
            PG8_LDA(At, 1, 1); PG8_STAGE(PG8_SB(1, 0), b3, voffB); PG8_STAGE(PG8_SB(1, 1), b3 + hstepB, voffB); PG8_STAGE(PG8_SA(1, 0), a3, voffA);
            PG8_WAIT_V(8); PG8_WAIT_L(0); PG8_BAR; PG8_MMA(1, 0, At, B0); PG8_MMA(1, 1, At, B1); PG8_BAR; PG8_SCHED;
            } else {
            PG8_LDB(B0, 0, 0); PG8_SCHED; PG8_LDA(At, 0, 0); PG8_STAGE(PG8_SA(1, 1), a1 + hstepA, voffA);
            PG8_WAIT_L(8); PG8_BAR; PG8_WAIT_L(0); PG8_MMA(0, 0, At, B0); PG8_BAR; PG8_SCHED;
            PG8_LDB(B1, 0, 1); PG8_STAGE(PG8_SB(0, 0), b2, voffB);
            PG8_BAR; PG8_WAIT_L(0); PG8_MMA(0, 1, At, B1); PG8_BAR;
            PG8_LDA(At, 0, 1); PG8_STAGE(PG8_SA(0, 0), a2, voffA);
            PG8_BAR; PG8_WAIT_L(0); PG8_MMA(1, 0, At, B0); PG8_BAR; PG8_SCHED;
            PG8_STAGE(PG8_SB(0, 1), b2 + hstepB, voffB);
            PG8_WAIT_V(6); PG8_BAR; PG8_MMA(1, 1, At, B1); PG8_BAR;
            PG8_LDB(B0, 1, 0); PG8_SCHED; PG8_LDA(At, 1, 0); PG8_STAGE(PG8_SA(0, 1), a2 + hstepA, voffA);
            PG8_WAIT_L(8); PG8_BAR; PG8_WAIT_L(0); PG8_MMA(0, 0, At, B0); PG8_BAR; PG8_SCHED;
            PG8_LDB(B1, 1, 1); PG8_STAGE(PG8_SB(1, 0), b3, voffB);
            PG8_BAR; PG8_WAIT_L(0); PG8_MMA(0, 1, At, B1); PG8_BAR;
            PG8_LDA(At, 1, 1); PG8_STAGE(PG8_SA(1, 0), a3, voffA);
            PG8_BAR; PG8_WAIT_L(0); PG8_MMA(1, 0, At, B0); PG8_BAR; PG8_SCHED;
            PG8_STAGE(PG8_SB(1, 1), b3 + hstepB, voffB);
            PG8_WAIT_V(6); PG8_BAR; PG8_MMA(1, 1, At, B1); PG8_BAR;
            }
        }
        if constexpr (ALIGN_EPI) { if (wr == 0) PG8_BAR; }
        if constexpr (!Epi::AFTER_DRAIN) { const int l2_ = opaque_tid(wv) & 63; E(acc, cur, wr, wc, l2_ & 15, l2_ >> 4); S.done(cur); }
        if (!has_next) break;
#pragma unroll
        for (int a = 0; a < 2; ++a)
#pragma unroll
            for (int b = 0; b < 2; ++b)
#pragma unroll
                for (int m = 0; m < 4; ++m)
#pragma unroll
                    for (int n = 0; n < 2; ++n) acc[a][b][m][n] = (f32x4){0.f, 0.f, 0.f, 0.f};
        cur = nxt; cA = nA; cB = nB; ++ui;
        if constexpr (ALIGN_EPI) { if (wr == 1) PG8_BAR; }
    }
    PG8_WAIT_V(0);
    if constexpr (!ALIGN_EPI) { if (wr == 0) PG8_BAR; }
    PG8_BAR;
    if constexpr (Epi::AFTER_DRAIN) { E.fused(acc, cur, wr, wc, fr, fq, lds, wid, lane); S.done(cur); }
#undef PG8_SA
#undef PG8_SB
#undef PG8_STAGE
#undef PG8_LDA
#undef PG8_LDB
#undef PG8_MMA
#undef PG8_WAIT_V
#undef PG8_WAIT_L
#undef PG8_BAR
#undef PG8_SCHED
}
}

__device__ __forceinline__ unsigned cvt_pk_bf16(float lo, float hi) { unsigned r; asm volatile("v_cvt_pk_bf16_f32 %0, %1, %2" : "=v"(r) : "v"(lo), "v"(hi)); return r; }
__device__ __forceinline__ void overlay_gate(const unsigned* cnt, unsigned target) {
    if (cnt == nullptr) return;
    unsigned spins = 0;
    while ((unsigned)__builtin_amdgcn_readfirstlane((int)__hip_atomic_load(cnt, __ATOMIC_RELAXED, __HIP_MEMORY_SCOPE_AGENT)) < target) { __builtin_amdgcn_s_sleep(2); if (++spins > (1u << 20)) break; }
}
template <int ACT> struct PEpiBf16 {
    static constexpr bool PERM = true, AFTER_DRAIN = false, MIDSCALE = false;
    bf16_t* O; int ldc; const float* rs; float invn; const unsigned* gate;
    __device__ __forceinline__ void operator()(const f32x4 (&acc)[2][2][4][2], const pg8::Unit& u, int wr, int wc, int fr, int fq) const {
        const int row0 = u.pm * 256 + wr * 64 + fr, col0 = u.pn * 256 + wc * 32 + 8 * fq;
        overlay_gate(gate, 256u);
        float rsc[2][4];
#pragma unroll
        for (int ai = 0; ai < 2; ++ai)
#pragma unroll
            for (int m = 0; m < 4; ++m) rsc[ai][m] = rs ? rs[row0 + ai * 128 + m * 16] : 1.f;
        if (invn > 0.f) {
#pragma unroll
            for (int ai = 0; ai < 2; ++ai)
#pragma unroll
                for (int m = 0; m < 4; ++m) rsc[ai][m] = 1.f / sqrtf(rsc[ai][m] * invn + EPS); }
#pragma unroll
        for (int ai = 0; ai < 2; ++ai)
#pragma unroll
            for (int m = 0; m < 4; ++m) { const bf16_t* rowp = O + ((size_t)(u.pm * 256 + wr * 64 + ai * 128 + m * 16) * ldc + u.pn * 256 + wc * 32); const unsigned lo_ = (unsigned)(fr * ldc + 8 * fq) * 2u; const float sc_ = rsc[ai][m];
#pragma unroll
                for (int bj = 0; bj < 2; ++bj) { f32x4 v0 = acc[ai][bj][m][0] * sc_, v1 = acc[ai][bj][m][1] * sc_;
                    if (ACT == 2) {
#pragma unroll
                        for (int e = 0; e < 4; ++e) { const float a = fmaxf(v0[e], 0.f), b = fmaxf(v1[e], 0.f); v0[e] = a * a; v1[e] = b * b; } }
                    u32x4 w; w.x = cvt_pk_bf16(v0[0], v0[1]); w.y = cvt_pk_bf16(v0[2], v0[3]); w.z = cvt_pk_bf16(v1[0], v1[1]); w.w = cvt_pk_bf16(v1[2], v1[3]);
                    st16_wt(rowp + bj * 128, lo_, w); } }
    }
};
struct PEpiProj {
    static constexpr bool PERM = true, AFTER_DRAIN = false, MIDSCALE = false;
    bf16_t* O; int ldc; const float* rs1; float* ssq_q; float* ssq_kv; float* ssq_kr; const float* qgain; const float* kgain; const float* rope; const float* kgm;
    __device__ __forceinline__ void operator()(const f32x4 (&acc)[2][2][4][2], const pg8::Unit& u, int wr, int wc, int fr, int fq) const {
        const int row0 = u.pm * 256 + wr * 64 + fr, col0 = u.pn * 256 + wc * 32 + 8 * fq, lane = fq * 16 + fr;
        float rsc[2][4];
#pragma unroll
        for (int ai = 0; ai < 2; ++ai)
#pragma unroll
            for (int m = 0; m < 4; ++m) rsc[ai][m] = rs1[row0 + ai * 128 + m * 16];
        const int sl = 4 * u.pn + wc;
        int mode = 0; const float* g = nullptr; float gs = 1.f;
        if (u.pn < 5) { if (sl < 8) { mode = 1; g = qgain; gs = QS_NSA; } else if (sl == S_KSEL || sl == S_KSEL + 1) { mode = 1; g = kgain + 64; } else if (sl == S_KWIN || sl == S_KWIN + 1) { mode = 1; g = kgain + 128; } }
        f32x4 ga[2][2];
        if (mode == 1) {
#pragma unroll
            for (int bj = 0; bj < 2; ++bj) { ga[bj][0] = *(const f32x4*)(g + 32 * bj + 8 * fq) * gs; ga[bj][1] = *(const f32x4*)(g + 32 * bj + 8 * fq + 4) * gs; } }
#pragma unroll
        for (int ai = 0; ai < 2; ++ai)
#pragma unroll
            for (int m = 0; m < 4; ++m) { const int row = row0 + ai * 128 + m * 16; const bf16_t* rowp = O + ((size_t)(u.pm * 256 + wr * 64 + ai * 128 + m * 16) * ldc + u.pn * 256 + wc * 32); const unsigned lo_ = (unsigned)(fr * ldc + 8 * fq) * 2u; const float sc_ = rsc[ai][m];
                f32x4 v[2][2];
#pragma unroll
                for (int bj = 0; bj < 2; ++bj) { v[bj][0] = acc[ai][bj][m][0] * sc_; v[bj][1] = acc[ai][bj][m][1] * sc_; }
                if (mode == 1) {
                    float ss = 0.f;
#pragma unroll
                    for (int bj = 0; bj < 2; ++bj)
#pragma unroll
                        for (int n = 0; n < 2; ++n) ss += (v[bj][n][0] * v[bj][n][0] + v[bj][n][1] * v[bj][n][1]) + (v[bj][n][2] * v[bj][n][2] + v[bj][n][3] * v[bj][n][3]);
                    ss += __builtin_bit_cast(float, __builtin_amdgcn_ds_bpermute((lane ^ 16) << 2, __builtin_bit_cast(int, ss)));
                    ss += __builtin_bit_cast(float, __builtin_amdgcn_ds_bpermute((lane ^ 32) << 2, __builtin_bit_cast(int, ss)));
                    const float rstd = 1.f / sqrtf(ss * (1.f / 64) + EPS);
#pragma unroll
                    for (int bj = 0; bj < 2; ++bj) { v[bj][0] = v[bj][0] * rstd * ga[bj][0]; v[bj][1] = v[bj][1] * rstd * ga[bj][1]; }
                } else if (u.pn >= 5) {
#pragma unroll
                    for (int bj = 0; bj < 2; ++bj) { const int cb = u.pn * 256 + bj * 128;
                        float* dst = (cb < P_HKV) ? ssq_q : (cb < P_HKR ? ssq_kv : ((cb == P_HKR && wc == 0) ? ssq_kr : nullptr));
                        if (dst) { float ss = (v[bj][0][0] * v[bj][0][0] + v[bj][0][1] * v[bj][0][1]) + (v[bj][0][2] * v[bj][0][2] + v[bj][0][3] * v[bj][0][3]) + (v[bj][1][0] * v[bj][1][0] + v[bj][1][1] * v[bj][1][1]) + (v[bj][1][2] * v[bj][1][2] + v[bj][1][3] * v[bj][1][3]);
                            ss += __builtin_bit_cast(float, __builtin_amdgcn_ds_bpermute((lane ^ 16) << 2, __builtin_bit_cast(int, ss)));
                            ss += __builtin_bit_cast(float, __builtin_amdgcn_ds_bpermute((lane ^ 32) << 2, __builtin_bit_cast(int, ss)));
                            if (fq == 0) __hip_atomic_fetch_add(dst + row, ss, __ATOMIC_RELAXED, __HIP_MEMORY_SCOPE_AGENT); }
                        if (cb == P_HKR && wc == 0) {
                            const f32x4 g0 = *(const f32x4*)(kgm + 64 + 8 * fq), g1 = *(const f32x4*)(kgm + 64 + 8 * fq + 4);
                            const float* rp = rope + (size_t)(row & (SEQ - 1)) * 32 + 8 * (fq & 1);
                            const f32x4 c0 = *(const f32x4*)rp, c1 = *(const f32x4*)(rp + 4), s0 = *(const f32x4*)(rp + 16), s1 = *(const f32x4*)(rp + 20);
#pragma unroll
                            for (int n = 0; n < 2; ++n)
#pragma unroll
                                for (int j = 0; j < 4; ++j) { const float nv = v[bj][n][j] * (n ? g1[j] : g0[j]);
                                    const float pv = __builtin_bit_cast(float, __builtin_amdgcn_ds_bpermute((lane ^ 32) << 2, __builtin_bit_cast(int, nv)));
                                    const float cs = n ? c1[j] : c0[j], sn = n ? s1[j] : s0[j]; v[bj][n][j] = (fq < 2) ? nv * cs - pv * sn : nv * cs + pv * sn; } } }
                }
#pragma unroll
                for (int bj = 0; bj < 2; ++bj) { u32x4 w; w.x = cvt_pk_bf16(v[bj][0][0], v[bj][0][1]); w.y = cvt_pk_bf16(v[bj][0][2], v[bj][0][3]); w.z = cvt_pk_bf16(v[bj][1][0], v[bj][1][1]); w.w = cvt_pk_bf16(v[bj][1][2], v[bj][1][3]);
                    st16_wt(rowp + bj * 128, lo_, w); } }
    }
};
struct PEpiKV {
    static constexpr bool PERM = true, AFTER_DRAIN = false, MIDSCALE = false;
    bf16_t* V; bf16_t* K; const bf16_t* proj; const float* ssq_kv; const float* ssq_kr; const float* rope; const float* kgain;
    __device__ __forceinline__ void operator()(const f32x4 (&acc)[2][2][4][2], const pg8::Unit& u, int wr, int wc, int fr_, int fq_) const {
        int fr = fr_, fq = fq_; asm volatile("" : "+v"(fr), "+v"(fq)); const float* kgain = this->kgain; asm volatile("" : "+s"(kgain)); const float* rope = this->rope; asm volatile("" : "+s"(rope));
        const int row0 = u.pm * 256 + wr * 64 + fr, lane = fq * 16 + fr;
        float rsc[2][4];
#pragma unroll
        for (int ai = 0; ai < 2; ++ai)
#pragma unroll
            for (int m = 0; m < 4; ++m) rsc[ai][m] = 1.f / sqrtf(ssq_kv[row0 + ai * 128 + m * 16] * (1.f / KVR) + EPS);
        if (wc >= 2) {
            const int col0 = u.pn * 256 + wc * 32 + 8 * fq;
#pragma unroll
            for (int ai = 0; ai < 2; ++ai)
#pragma unroll
                for (int m = 0; m < 4; ++m) { const bf16_t* rowp = V + ((size_t)(u.pm * 256 + wr * 64 + ai * 128 + m * 16) * MKV + u.pn * 256 + wc * 32); const unsigned lo_ = (unsigned)(fr * MKV + 8 * fq) * 2u; const float sc_ = rsc[ai][m];
#pragma unroll
                    for (int bj = 0; bj < 2; ++bj) { const f32x4 v0 = acc[ai][bj][m][0] * sc_, v1 = acc[ai][bj][m][1] * sc_;
                        u32x4 w; w.x = cvt_pk_bf16(v0[0], v0[1]); w.y = cvt_pk_bf16(v0[2], v0[3]); w.z = cvt_pk_bf16(v1[0], v1[1]); w.w = cvt_pk_bf16(v1[2], v1[3]);
                        st16_wt(rowp + bj * 128, lo_, w); } }
            return;
        }
        const int hh = 2 * u.pn + wc;
#pragma unroll
        for (int ai = 0; ai < 2; ++ai)
#pragma unroll
            for (int m = 0; m < 4; ++m) { const int row = row0 + ai * 128 + m * 16; const float sc_ = rsc[ai][m];
                const bf16_t* ko = K + ((size_t)(u.pm * 256 + wr * 64 + ai * 128 + m * 16) * MQ + 96 * hh); const unsigned lo_ = (unsigned)(fr * MQ + 8 * fq) * 2u;
                float rstd;
                {
                    f32x4 v[2][2]; float ss = 0.f;
#pragma unroll
                    for (int bj = 0; bj < 2; ++bj)
#pragma unroll
                        for (int n = 0; n < 2; ++n) { v[bj][n] = acc[ai][bj][m][n] * sc_; ss += (v[bj][n][0] * v[bj][n][0] + v[bj][n][1] * v[bj][n][1]) + (v[bj][n][2] * v[bj][n][2] + v[bj][n][3] * v[bj][n][3]); }
                    ss += __builtin_bit_cast(float, __builtin_amdgcn_ds_bpermute((lane ^ 16) << 2, __builtin_bit_cast(int, ss)));
                    ss += __builtin_bit_cast(float, __builtin_amdgcn_ds_bpermute((lane ^ 32) << 2, __builtin_bit_cast(int, ss)));
                    rstd = 1.f / sqrtf((ss + ssq_kr[row]) * (1.f / 96) + EPS);
#pragma unroll
                    for (int bj = 0; bj < 2; ++bj) { const f32x4 g0 = *(const f32x4*)(kgain + 32 * bj + 8 * fq), g1 = *(const f32x4*)(kgain + 32 * bj + 8 * fq + 4);
                        const f32x4 a = v[bj][0] * rstd * g0, b = v[bj][1] * rstd * g1;
                        u32x4 w; w.x = cvt_pk_bf16(a[0], a[1]); w.y = cvt_pk_bf16(a[2], a[3]); w.z = cvt_pk_bf16(b[0], b[1]); w.w = cvt_pk_bf16(b[2], b[3]);
                        st16_wt(ko + 32 * bj, lo_, w); }
                }
                asm volatile("" ::: "memory");
                {
                    const bf16x8 kr8 = *(const bf16x8*)(proj + (size_t)row * DINP + P_HKR + 8 * fq);
                    u32x4 w; w.x = cvt_pk_bf16(bf2f((unsigned short)kr8[0]) * rstd, bf2f((unsigned short)kr8[1]) * rstd); w.y = cvt_pk_bf16(bf2f((unsigned short)kr8[2]) * rstd, bf2f((unsigned short)kr8[3]) * rstd);
                    w.z = cvt_pk_bf16(bf2f((unsigned short)kr8[4]) * rstd, bf2f((unsigned short)kr8[5]) * rstd); w.w = cvt_pk_bf16(bf2f((unsigned short)kr8[6]) * rstd, bf2f((unsigned short)kr8[7]) * rstd);
                    st16_wt(ko + 64, lo_, w);
                }
                asm volatile("" ::: "memory"); }
    }
};
struct PEpiWo {
    static constexpr bool PERM = true, AFTER_DRAIN = false, MIDSCALE = true;
    const bf16_t* base; bf16_t* xb; float* ssq; const float* ssqm; int ldc; const unsigned* gate;
    __device__ __forceinline__ void midscale(f32x4 (&acc)[2][2][4][2], const pg8::Unit& u, int wr, int fr) const {
#pragma unroll
        for (int ai = 0; ai < 2; ++ai)
#pragma unroll
            for (int m = 0; m < 4; ++m) { const int row = u.pm * 256 + ai * 128 + wr * 64 + m * 16 + fr;
                const float sa = ssqm[2 * row], sb = ssqm[2 * row + 1]; const float ratio = sqrtf((sb * (1.f / 512) + EPS) / (sa * (1.f / 512) + EPS));
#pragma unroll
                for (int bj = 0; bj < 2; ++bj)
#pragma unroll
                    for (int n = 0; n < 2; ++n) acc[ai][bj][m][n] *= ratio; }
    }
    __device__ __forceinline__ void operator()(const f32x4 (&acc)[2][2][4][2], const pg8::Unit& u, int wr, int wc, int fr, int fq) const {
        const int lane = fq * 16 + fr;
        const int rowb = u.pm * 256 + wr * 64 + fr;
        overlay_gate(gate, 256u);
        float rb[8];
#pragma unroll
        for (int g_ = 0; g_ < 8; ++g_) rb[g_] = ssqm[2 * (rowb + (g_ >> 2) * 128 + (g_ & 3) * 16) + 1];
        const size_t tile0 = (size_t)(u.pm * 256 + wr * 64) * ldc + u.pn * 256 + wc * 32;
        const unsigned lo_ = (unsigned)(fr * ldc + 8 * fq) * 2u;
        u32x4 nxt[2];
#pragma unroll
        for (int bj = 0; bj < 2; ++bj) nxt[bj] = *(const u32x4*)((const char*)(base + tile0 + bj * 128) + lo_);
#pragma unroll
        for (int g_ = 0; g_ < 8; ++g_) { const int ai = g_ >> 2, m = g_ & 3; const int row = rowb + ai * 128 + m * 16; const size_t roff = tile0 + (size_t)(ai * 128 + m * 16) * ldc; float ss = 0.f;
            u32x4 cur[2];
#pragma unroll
            for (int bj = 0; bj < 2; ++bj) cur[bj] = nxt[bj];
            if (g_ < 7) { const size_t roffn = tile0 + (size_t)(((g_ + 1) >> 2) * 128 + ((g_ + 1) & 3) * 16) * ldc;
#pragma unroll
                for (int bj = 0; bj < 2; ++bj) nxt[bj] = *(const u32x4*)((const char*)(base + roffn + bj * 128) + lo_); }
            const float rbs = 1.f / sqrtf(rb[g_] * (1.f / 512) + EPS);
#pragma unroll
            for (int bj = 0; bj < 2; ++bj) { const u32x4 cw = cur[bj];
                const f32x4 v0 = (f32x4){bf2f(cw.x & 0xffffu), bf2f(cw.x >> 16), bf2f(cw.y & 0xffffu), bf2f(cw.y >> 16)} + acc[ai][bj][m][0] * rbs;
                const f32x4 v1 = (f32x4){bf2f(cw.z & 0xffffu), bf2f(cw.z >> 16), bf2f(cw.w & 0xffffu), bf2f(cw.w >> 16)} + acc[ai][bj][m][1] * rbs;
                ss += ((v0[0] * v0[0] + v0[1] * v0[1]) + (v0[2] * v0[2] + v0[3] * v0[3])) + ((v1[0] * v1[0] + v1[1] * v1[1]) + (v1[2] * v1[2] + v1[3] * v1[3]));
                u32x4 w; w.x = cvt_pk_bf16(v0[0], v0[1]); w.y = cvt_pk_bf16(v0[2], v0[3]); w.z = cvt_pk_bf16(v1[0], v1[1]); w.w = cvt_pk_bf16(v1[2], v1[3]);
                st16_wt(xb + roff + bj * 128, lo_, w); }
            ss += __builtin_bit_cast(float, __builtin_amdgcn_ds_bpermute((lane ^ 16) << 2, __builtin_bit_cast(int, ss)));
            ss += __builtin_bit_cast(float, __builtin_amdgcn_ds_bpermute((lane ^ 32) << 2, __builtin_bit_cast(int, ss)));
            if (fq == 0) __hip_atomic_fetch_add(ssq + row, ss, __ATOMIC_RELAXED, __HIP_MEMORY_SCOPE_AGENT); }
    }
};


struct PEpiDown {
    static constexpr bool PERM = false, AFTER_DRAIN = false, MIDSCALE = false;
    const bf16_t* xb; float* out; int ldc;
    __device__ __forceinline__ void operator()(const f32x4 (&acc)[2][2][4][2], const pg8::Unit& u, int wr, int wc, int fr, int fq) const {
        const int col0 = u.pn * 256 + wc * 32 + 4 * fq; const int rowb = u.pm * 256 + wr * 64 + fr;
        u32x2 nxt[2][2];
#pragma unroll
        for (int bj = 0; bj < 2; ++bj)
#pragma unroll
            for (int n = 0; n < 2; ++n) nxt[bj][n] = *(const u32x2*)(xb + (size_t)rowb * ldc + col0 + bj * 128 + n * 16);
#pragma unroll
        for (int g_ = 0; g_ < 8; ++g_) { const int ai = g_ >> 2, m = g_ & 3; const size_t off = (size_t)(rowb + ai * 128 + m * 16) * ldc + col0;
            u32x2 cur[2][2];
#pragma unroll
            for (int bj = 0; bj < 2; ++bj)
#pragma unroll
                for (int n = 0; n < 2; ++n) cur[bj][n] = nxt[bj][n];
            if (g_ < 7) { const size_t offn = (size_t)(rowb + ((g_ + 1) >> 2) * 128 + ((g_ + 1) & 3) * 16) * ldc + col0;
#pragma unroll
                for (int bj = 0; bj < 2; ++bj)
#pragma unroll
                    for (int n = 0; n < 2; ++n) nxt[bj][n] = *(const u32x2*)(xb + offn + bj * 128 + n * 16); }
#pragma unroll
            for (int bj = 0; bj < 2; ++bj)
#pragma unroll
                for (int n = 0; n < 2; ++n) { const u32x2 w = cur[bj][n];
                    const f32x4 bs = (f32x4){bf2f(w.x & 0xffffu), bf2f(w.x >> 16), bf2f(w.y & 0xffffu), bf2f(w.y >> 16)};
                    __builtin_nontemporal_store(bs + acc[ai][bj][m][n], (f32x4*)(out + off + bj * 128 + n * 16)); } }
    }
};

__device__ __forceinline__ float sq8(const bf16x8 v) { float s = 0.f;
#pragma unroll
    for (int j = 0; j < 8; ++j) { const float f = bf2f((unsigned short)v[j]); s += f * f; }
    return s; }
__device__ __forceinline__ u32x4 scale8(const bf16x8 v, float sc, const f32x4 ga, const f32x4 gb) { u32x4 o;
    o.x = pk2(bf2f((unsigned short)v[0]) * sc * ga[0], bf2f((unsigned short)v[1]) * sc * ga[1]); o.y = pk2(bf2f((unsigned short)v[2]) * sc * ga[2], bf2f((unsigned short)v[3]) * sc * ga[3]);
    o.z = pk2(bf2f((unsigned short)v[4]) * sc * gb[0], bf2f((unsigned short)v[5]) * sc * gb[1]); o.w = pk2(bf2f((unsigned short)v[6]) * sc * gb[2], bf2f((unsigned short)v[7]) * sc * gb[3]);
    return o; }

__device__ __forceinline__ void compress_block(unsigned char* ws, LAS unsigned char* L, int task, int wv) {
    const int tid = opaque_tid(wv), lane = tid & 63, wid = __builtin_amdgcn_readfirstlane(tid >> 6), fr = lane & 15, fq = lane >> 4;
    const int tc = task & 15, b = (task >> 4) & 7, kv = task >> 7;
    int c = 8 * tc + (fr >> 1); const int g = fr & 1; if (c > NCMP - 1) c = NCMP - 1;
    const bf16_t* arow = (const bf16_t*)(ws + WS_PROJ) + (size_t)(b * SEQ + 16 * c) * DINP + slot_base((kv ? S_VCMP : S_KCMP) + g) + 8 * fq;
    const bf16_t* w1t = (const bf16_t*)(ws + WS_W1T) + (size_t)kv * 128 * 2048 + 8 * lane;
    bf16x8 araw[8];
#pragma unroll
    for (int s8 = 0; s8 < 8; ++s8) { const int s = 8 * wid + s8, r = s >> 1, db = (s & 1) * 32; araw[s8] = *(const bf16x8*)(arow + (size_t)r * DINP + 4 * db); }
    LAS float* pel = (LAS float*)(L + 98304);
    *(LAS f32x4*)(pel + 4 * tid) = *(const f32x4*)(inptr(11) + kv * 2048 + 4 * tid);
    f32x4 acc[8];
#pragma unroll
    for (int n = 0; n < 8; ++n) acc[n] = (f32x4){0.f, 0.f, 0.f, 0.f};
    bf16x8 bq[2][16];
#define CB_LOADQ(buf, q) do { _Pragma("unroll") for (int e = 0; e < 2; ++e) { const int s = 8 * wid + 2 * (q) + e; \
        _Pragma("unroll") for (int n = 0; n < 8; ++n) bq[buf][e * 8 + n] = *(const bf16x8*)(w1t + (size_t)(s * 8 + n) * 512); } __builtin_amdgcn_sched_barrier(0); } while (0)
#define CB_COMPQ(buf, q) do { _Pragma("unroll") for (int e = 0; e < 2; ++e) { const int s8 = 2 * (q) + e, s = 8 * wid + s8, r = s >> 1, db = (s & 1) * 32; \
        const f32x4 pa = *(const LAS f32x4*)(pel + r * 64 + db + 8 * fq), pb = *(const LAS f32x4*)(pel + r * 64 + db + 8 * fq + 4); const bf16x8 ar = araw[s8]; \
        u32x4 aw; aw.x = pk2(bf2f((unsigned short)ar[0]) + pa[0], bf2f((unsigned short)ar[1]) + pa[1]); aw.y = pk2(bf2f((unsigned short)ar[2]) + pa[2], bf2f((unsigned short)ar[3]) + pa[3]); \
        aw.z = pk2(bf2f((unsigned short)ar[4]) + pb[0], bf2f((unsigned short)ar[5]) + pb[1]); aw.w = pk2(bf2f((unsigned short)ar[6]) + pb[2], bf2f((unsigned short)ar[7]) + pb[3]); \
        const bf16x8 a = __builtin_bit_cast(bf16x8, aw); \
        _Pragma("unroll") for (int n = 0; n < 8; ++n) acc[n] = __builtin_amdgcn_mfma_f32_16x16x32_bf16(a, bq[buf][e * 8 + n], acc[n], 0, 0, 0); } __builtin_amdgcn_sched_barrier(0); } while (0)
    CB_LOADQ(0, 0); CB_LOADQ(1, 1);
    __syncthreads();
    CB_COMPQ(0, 0); CB_LOADQ(0, 2); CB_COMPQ(1, 1); CB_LOADQ(1, 3); CB_COMPQ(0, 2); CB_COMPQ(1, 3);
#undef CB_LOADQ
#undef CB_COMPQ
    bf16x8 w2f[16]; float kgv[4];
    if (wid == 0) { const bf16_t* w2t = (const bf16_t*)(ws + WS_W2T) + kv * 64 * 128 + fr * 128 + 8 * fq; const float* kg = inptr(10);
#pragma unroll
        for (int ks = 0; ks < 4; ++ks)
#pragma unroll
            for (int n = 0; n < 4; ++n) w2f[ks * 4 + n] = *(const bf16x8*)(w2t + (size_t)(16 * n) * 128 + 32 * ks);
#pragma unroll
        for (int n = 0; n < 4; ++n) kgv[n] = kg[16 * n + fr]; }
    LAS float* part = (LAS float*)L;
#pragma unroll
    for (int n = 0; n < 8; ++n)
#pragma unroll
        for (int j = 0; j < 4; ++j) part[(wid * 16 + 4 * fq + j) * 128 + 16 * n + fr] = acc[n][j];
    __syncthreads();
    LAS bf16_t* hb_ = (LAS bf16_t*)(L + 65536);
#pragma unroll
    for (int e = 0; e < 4; ++e) { const int idx = tid + 512 * e; float v = 0.f;
#pragma unroll
        for (int w = 0; w < 8; ++w) v += part[w * 2048 + idx];
        hb_[idx] = (bf16_t)f2bf(v / (1.f + __expf(-v))); }
    __syncthreads();
    if (wid == 0) {
        f32x4 o[4];
#pragma unroll
        for (int n = 0; n < 4; ++n) o[n] = (f32x4){0.f, 0.f, 0.f, 0.f};
#pragma unroll
        for (int ks = 0; ks < 4; ++ks) { const bf16x8 a = *(const LAS bf16x8*)(hb_ + fr * 128 + 32 * ks + 8 * fq);
#pragma unroll
            for (int n = 0; n < 4; ++n) o[n] = __builtin_amdgcn_mfma_f32_16x16x32_bf16(a, w2f[ks * 4 + n], o[n], 0, 0, 0); }
        bf16_t* dstb = (bf16_t*)(ws + (kv ? WS_VCMP : WS_KCMP)) + (size_t)b * 128 * 2 * 64;
#pragma unroll
        for (int j = 0; j < 4; ++j) { const int row = 4 * fq + j, cc = 8 * tc + (row >> 1), gg = row & 1;
            float sc = 1.f;
            if (kv == 0) { float ss = o[0][j] * o[0][j] + o[1][j] * o[1][j] + o[2][j] * o[2][j] + o[3][j] * o[3][j];
                ss += __shfl_xor(ss, 1); ss += __shfl_xor(ss, 2); ss += __shfl_xor(ss, 4); ss += __shfl_xor(ss, 8); sc = 1.f / sqrtf(ss * (1.f / 64) + EPS); }
#pragma unroll
            for (int n = 0; n < 4; ++n) { const int col = 16 * n + fr; float v = o[n][j] * sc; if (kv == 0) v *= kgv[n]; if (cc >= NCMP) v = 0.f;
                dstb[((size_t)cc * 2 + gg) * 64 + col] = (bf16_t)f2bf(v); } }
    }
    __syncthreads();
}

namespace att {
typedef float f32x16 __attribute__((ext_vector_type(16)));
typedef short s16x4 __attribute__((ext_vector_type(4)));
typedef short v4i16_t __attribute__((ext_vector_type(4)));
typedef float f32x2_t __attribute__((ext_vector_type(2)));
typedef __bf16 bf16x2_t __attribute__((ext_vector_type(2)));
typedef const LAS unsigned char* lcp;
constexpr int NSLOT = 3;
constexpr int L_TB = 0, L_K = 4096, KSLOT = 12288, L_V = L_K + NSLOT * KSLOT, VSLOT = 8192, L_WSF = L_V + NSLOT * VSLOT, L_OST = L_WSF + 4096,
              L_IMP = L_OST + 32768, IMPS = 33  , L_SELM = L_IMP + 4 * 64 * IMPS * 4, L_GATE = L_SELM + 256, L_SC = L_GATE + 3072, L_INVL = L_SC + 64 * IMPS * 4, L_END = L_INVL + 1024;
static_assert(L_V + NSLOT * VSLOT <= 65536, "LDS-DMA destinations stay below 64 KiB");
static_assert(L_END <= LDS_BST, "attention LDS map");
constexpr float THR = 8.0f;
__device__ __forceinline__ int crow(int r, int hi) { return (r & 3) + 8 * (r >> 2) + 4 * hi; }
__device__ __forceinline__ void glds16(const void* gsrc, unsigned lds_dst) { unsigned keep;
    asm volatile("s_mov_b32 %0, m0\n\ts_mov_b32 m0, %2\n\ts_nop 0\n\tglobal_load_lds_dwordx4 %1, off\n\ts_mov_b32 m0, %0" : "=&s"(keep) : "v"(gsrc), "s"(lds_dst) : "memory"); }
__device__ __forceinline__ unsigned cvtpk(float lo, float hi) { f32x2_t v = {lo, hi}; bf16x2_t b = __builtin_convertvector(v, bf16x2_t); return __builtin_bit_cast(unsigned, b); }
__device__ __forceinline__ s16x4 vtr(lcp p) { return __builtin_bit_cast(s16x4, __builtin_amdgcn_ds_read_tr16_b64_v4i16((LAS v4i16_t*)p)); }
__device__ __forceinline__ float lane_xor(float v, int lane, int x) { return __builtin_bit_cast(float, __builtin_amdgcn_ds_bpermute((lane ^ x) << 2, __builtin_bit_cast(int, v))); }
__device__ __forceinline__ unsigned lane_xor_u(unsigned v, int lane, int x) { return (unsigned)__builtin_amdgcn_ds_bpermute((lane ^ x) << 2, (int)v); }
__device__ __forceinline__ float swap_max(float m, int lane) { return __builtin_fmaxf(m, lane_xor(m, lane, 32)); }
__device__ __forceinline__ float swap_sum(float m, int lane) { return m + lane_xor(m, lane, 32); }
__device__ __forceinline__ float max3f(float a, float b, float c) { float r; asm("v_max3_f32 %0, %1, %2, %3" : "=v"(r) : "v"(a), "v"(b), "v"(c)); return r; }
__device__ __forceinline__ float max32(const f32x16& p0, const f32x16& p1) {
    float a = max3f(p0[0], p0[1], p1[0]), b = max3f(p0[2], p0[3], p1[1]); a = max3f(a, p1[2], p1[3]);
#pragma unroll
    for (int r = 4; r < 16; r += 4) { a = max3f(a, p0[r], p0[r + 1]); b = max3f(b, p0[r + 2], p0[r + 3]); a = max3f(a, p1[r], p1[r + 1]); b = max3f(b, p1[r + 2], p1[r + 3]); }
    return __builtin_fmaxf(a, b); }
__device__ __forceinline__ float max16(const f32x16& p) { float a = __builtin_fmaxf(p[0], p[1]), b = __builtin_fmaxf(p[2], p[3]);
#pragma unroll
    for (int r = 4; r < 16; r += 4) { a = __builtin_fmaxf(a, __builtin_fmaxf(p[r], p[r + 1])); b = __builtin_fmaxf(b, __builtin_fmaxf(p[r + 2], p[r + 3])); }
    return __builtin_fmaxf(a, b); }
__device__ __forceinline__ float sum16(const f32x16& p) { float a = p[0] + p[1], b = p[2] + p[3];
#pragma unroll
    for (int r = 4; r < 16; r += 4) { a += p[r] + p[r + 1]; b += p[r + 2] + p[r + 3]; }
    return a + b; }
#define ATT_BAR() asm volatile("s_waitcnt vmcnt(0) lgkmcnt(0)\n\ts_barrier" ::: "memory")

template <int DQ> __device__ __forceinline__ void qkt(f32x16& p0, f32x16& p1, lcp kslot, const bf16x8* qr, const f32x16& cinit, int r32, int hi) {
    lcp kb = kslot + hi * 1024 + r32 * 16;
    constexpr int NB = (DQ == 96) ? 3 : 4;
#pragma unroll
    for (int db = 0; db < DQ / 16; db += NB) {
        bf16x8 kf[2 * NB];
#pragma unroll
        for (int e = 0; e < NB; ++e) { kf[2 * e] = *(const LAS bf16x8*)(kb + (db + e) * 2048); kf[2 * e + 1] = *(const LAS bf16x8*)(kb + (db + e) * 2048 + 512); }
        __builtin_amdgcn_sched_barrier(0);
#pragma unroll
        for (int e = 0; e < NB; ++e) { const int d0 = db + e;
            if (d0 == 0) { p0 = __builtin_amdgcn_mfma_f32_32x32x16_bf16(kf[0], qr[0], cinit, 0, 0, 0); p1 = __builtin_amdgcn_mfma_f32_32x32x16_bf16(kf[1], qr[0], cinit, 0, 0, 0); }
            else { p0 = __builtin_amdgcn_mfma_f32_32x32x16_bf16(kf[2 * e], qr[d0], p0, 0, 0, 0); p1 = __builtin_amdgcn_mfma_f32_32x32x16_bf16(kf[2 * e + 1], qr[d0], p1, 0, 0, 0); }
        }
    }
}
__device__ __forceinline__ void vload_half(bf16x8 (&vf)[8], lcp vp, int d0) {
#pragma unroll
    for (int ks = 0; ks < 4; ++ks) {
        const s16x4 lo = vtr(vp + d0 * 4096 + ks * 1024), hh = vtr(vp + d0 * 4096 + ks * 1024 + 512);
        vf[d0 * 4 + ks] = (bf16x8){lo[0], lo[1], lo[2], lo[3], hh[0], hh[1], hh[2], hh[3]};
    }
    __builtin_amdgcn_sched_barrier(0);
}
__device__ __forceinline__ void vload(bf16x8 (&vf)[8], lcp vp) { vload_half(vf, vp, 0); vload_half(vf, vp, 1); }
__device__ __forceinline__ void pv_mma(f32x16 (&o)[2], const bf16x8 (&vf)[8], const f32x16& p0, const f32x16& p1) {
    u32x4 pw[4];
    pw[0] = (u32x4){cvtpk(p0[0], p0[1]), cvtpk(p0[2], p0[3]), cvtpk(p0[4], p0[5]), cvtpk(p0[6], p0[7])};
    pw[1] = (u32x4){cvtpk(p0[8], p0[9]), cvtpk(p0[10], p0[11]), cvtpk(p0[12], p0[13]), cvtpk(p0[14], p0[15])};
    pw[2] = (u32x4){cvtpk(p1[0], p1[1]), cvtpk(p1[2], p1[3]), cvtpk(p1[4], p1[5]), cvtpk(p1[6], p1[7])};
    pw[3] = (u32x4){cvtpk(p1[8], p1[9]), cvtpk(p1[10], p1[11]), cvtpk(p1[12], p1[13]), cvtpk(p1[14], p1[15])};
#pragma unroll
    for (int d0 = 0; d0 < 2; ++d0)
#pragma unroll
        for (int ks = 0; ks < 4; ++ks) o[d0] = __builtin_amdgcn_mfma_f32_32x32x16_bf16(__builtin_bit_cast(bf16x8, pw[ks]), vf[d0 * 4 + ks], o[d0], 0, 0, 0);
}
__device__ __forceinline__ void pv(f32x16 (&o)[2], lcp vp, const f32x16& p0, const f32x16& p1) { bf16x8 vf[8]; vload(vf, vp); pv_mma(o, vf, p0, p1); }
template <int DQ, bool SLOT = false, bool SLOTV = SLOT> __device__ __forceinline__ void dma_tile(unsigned lds0, const bf16_t* Kg, int kpitch, const bf16_t* Vg, int vpitch, int key0, int slot, int wid, int lane) {
    const bf16_t* ksrc = Kg + (size_t)(key0 + lane) * kpitch + (SLOT ? 128 * (wid >> 2) + 8 * (wid & 3) : wid * 8);
    glds16(ksrc, (unsigned)__builtin_amdgcn_readfirstlane(lds0 + L_K + slot * KSLOT + wid * 1024));
    if (DQ == 96) { if (wid < 4) glds16(ksrc + 64, (unsigned)__builtin_amdgcn_readfirstlane(lds0 + L_K + slot * KSLOT + (8 + wid) * 1024)); }
    const bf16_t* vsrc = Vg + (size_t)(key0 + 16 * (wid & 3) + (lane >> 2)) * vpitch + (wid >> 2) * (SLOTV ? 128 : 32) + (lane & 3) * 8;
    glds16(vsrc, (unsigned)__builtin_amdgcn_readfirstlane(lds0 + L_V + slot * VSLOT + wid * 1024));
}

#define ATT_LBAR() asm volatile("s_waitcnt lgkmcnt(0)\n\ts_barrier" ::: "memory")
struct NoNext { static constexpr int count = 0; __device__ __forceinline__ void dma(unsigned, int, int, int, int) const {} };
template <int DQ, bool SLOT, bool SLOTV, class Pol> struct NextTiles {
    const bf16_t* Kg; int kpitch; const bf16_t* Vg; int vpitch; const Pol* pol; int count;
    __device__ __forceinline__ void dma(unsigned lds0, int j, int slot, int wid, int lane) const { dma_tile<DQ, SLOT, SLOTV>(lds0, Kg, kpitch, Vg, vpitch, pol->key0(j), slot, wid, lane); }
};
template <int DQ, bool SLOT = false, bool SLOTV = SLOT, class Pol, class Next>
__device__ __forceinline__ void flash_loop(LAS unsigned char* L, const bf16_t* Kg, int kpitch, const bf16_t* Vg, int vpitch, const bf16x8* qr, const Pol& pol, int s0, int npre, const Next& next,
                                           f32x16 (&o)[2], float& l_out, int wid, int lane) {
    const int r32 = lane & 31, hi = lane >> 5;
    const unsigned lds0 = (unsigned)(uintptr_t)L;
    LAS float* wsf = (LAS float*)(L + L_WSF) + wid * 128;
    lcp vp0 = L + L_V + ((lane >> 4) & 1) * 32 + (lane & 3) * 8 + (4 * hi + ((lane & 15) >> 2)) * 64;
    float mhat = 0.f, l = 0.f;
    f32x16 negm;
#pragma unroll
    for (int r = 0; r < 16; ++r) { o[0][r] = 0.f; o[1][r] = 0.f; negm[r] = 0.f; }
    const int n = pol.ntiles, ntot = n + next.count;
    int slot = s0, slot1 = (s0 + 1) % NSLOT, slot2 = (s0 + 2) % NSLOT;
    if (npre < 1) dma_tile<DQ, SLOT, SLOTV>(lds0, Kg, kpitch, Vg, vpitch, pol.key0(0), slot, wid, lane);
    if (npre < 2 && ntot > 1) { if (n > 1) dma_tile<DQ, SLOT, SLOTV>(lds0, Kg, kpitch, Vg, vpitch, pol.key0(1), slot1, wid, lane); else next.dma(lds0, 0, slot1, wid, lane); }
    for (int i = 0; i < n; ++i) {
        if (i + 1 < ntot) { if (DQ == 96 && wid < 4) asm volatile("s_waitcnt vmcnt(3) lgkmcnt(0)\n\ts_barrier" ::: "memory"); else asm volatile("s_waitcnt vmcnt(2) lgkmcnt(0)\n\ts_barrier" ::: "memory"); }
        else ATT_BAR();
        if (i + 2 < ntot) { if (i + 2 < n) dma_tile<DQ, SLOT, SLOTV>(lds0, Kg, kpitch, Vg, vpitch, pol.key0(i + 2), slot2, wid, lane); else next.dma(lds0, i + 2 - n, slot2, wid, lane); }
        if (pol.active(i)) {
            f32x16 p0, p1;
            qkt<DQ>(p0, p1, L + L_K + slot * KSLOT, qr, negm, r32, hi);
            bf16x8 vf[8]; vload_half(vf, vp0 + slot * VSLOT, 0);
            pol.fix(p0, p1, i);
            asm volatile("s_nop 15\n\ts_nop 7" : "+v"(p0), "+v"(p1));
            const float rm = swap_max(max32(p0, p1), lane);
            const bool first = (i == 0);
            if (first || __any(rm > THR)) {
                float dl = first ? rm : __builtin_fmaxf(rm, 0.f);
                if (dl == -INFINITY) dl = 0.f;
                mhat += dl;
#pragma unroll
                for (int r = 0; r < 16; ++r) { p0[r] -= dl; p1[r] -= dl; negm[r] = -mhat; }
                if (!first) {
                    const float f = __builtin_amdgcn_exp2f(-dl); l *= f;
                    if (hi == 0) wsf[r32] = f;
#pragma unroll
                    for (int r = 0; r < 16; ++r) { const float fr_ = wsf[crow(r, hi)]; o[0][r] *= fr_; o[1][r] *= fr_; }
                }
            }
#pragma unroll
            for (int r = 0; r < 16; ++r) { p0[r] = __builtin_amdgcn_exp2f(p0[r]); p1[r] = __builtin_amdgcn_exp2f(p1[r]); }
            vload_half(vf, vp0 + slot * VSLOT, 1);
            l += sum16(p0) + sum16(p1);
            pv_mma(o, vf, p0, p1);
        }
        slot = slot1; slot1 = slot2; slot2 = (slot2 == NSLOT - 1) ? 0 : slot2 + 1;
    }
    ATT_LBAR();
    l_out = swap_sum(l, lane);
}

__device__ __forceinline__ void acc_scaled(f32x16 (&oc)[2], const f32x16 (&o)[2], float rowscale, LAS float* wsf, int r32, int hi) {
    if (hi == 0) wsf[32 + r32] = rowscale;
#pragma unroll
    for (int r = 0; r < 16; ++r) { const float s = wsf[32 + crow(r, hi)]; oc[0][r] += s * o[0][r]; oc[1][r] += s * o[1][r]; }
}
__device__ __forceinline__ void park_store(const f32x16 (&oc)[2], LAS float* park, int lane) {
#pragma unroll
    for (int d0 = 0; d0 < 2; ++d0)
#pragma unroll
        for (int r = 0; r < 16; ++r) park[(d0 * 16 + r) * 64 + lane] = oc[d0][r];
}
template <bool FINAL> __device__ __forceinline__ void park_acc(f32x16 (&oc)[2], LAS float* park, const f32x16 (&o)[2], float rowscale, LAS float* wsf, int lane) {
    const int r32 = lane & 31, hi = lane >> 5;
    if (hi == 0) wsf[32 + r32] = rowscale;
#pragma unroll
    for (int r = 0; r < 16; ++r) { const float s = wsf[32 + crow(r, hi)];
#pragma unroll
        for (int d0 = 0; d0 < 2; ++d0) { const float v = park[(d0 * 16 + r) * 64 + lane] + s * o[d0][r]; if (FINAL) oc[d0][r] = v; else park[(d0 * 16 + r) * 64 + lane] = v; } }
}
__device__ __forceinline__ void store_tile(const f32x16 (&oc)[2], bf16_t* dst, int pitch, LAS unsigned char* L, int wid, int lane, float* ssq) {
    const int r32 = lane & 31, hi = lane >> 5;
    LAS bf16_t* stg = (LAS bf16_t*)(L + L_OST + wid * 8192);
#pragma unroll
    for (int r = 0; r < 16; ++r) { const int orow = crow(r, hi);
#pragma unroll
        for (int d0 = 0; d0 < 2; ++d0) stg[orow * 64 + d0 * 32 + r32] = (bf16_t)f2bf(oc[d0][r]); }
    asm volatile("s_waitcnt lgkmcnt(0)" ::: "memory");
#pragma unroll
    for (int i = 0; i < 4; ++i) { const int row = i * 8 + (lane >> 3), ch = lane & 7; const u32x4 v = *(const LAS u32x4*)(stg + row * 64 + ch * 8); st16_wt(dst + (size_t)(i * 8) * pitch, (unsigned)((lane >> 3) * pitch + ch * 8) * 2u, v);
        float ss = sq8(__builtin_bit_cast(bf16x8, v)); ss += lane_xor(ss, lane, 1); ss += lane_xor(ss, lane, 2); ss += lane_xor(ss, lane, 4);
        if (ch == 0) __hip_atomic_fetch_add(ssq + 2 * row, ss, __ATOMIC_RELAXED, __HIP_MEMORY_SCOPE_AGENT); }
    asm volatile("s_waitcnt lgkmcnt(0)" ::: "memory");
}

#define PIN16(v) asm volatile("" : "+v"(v[0]), "+v"(v[1]), "+v"(v[2]), "+v"(v[3]), "+v"(v[4]), "+v"(v[5]), "+v"(v[6]), "+v"(v[7]), "+v"(v[8]), "+v"(v[9]), "+v"(v[10]), "+v"(v[11]), "+v"(v[12]), "+v"(v[13]), "+v"(v[14]), "+v"(v[15]))
__device__ __forceinline__ int clamp127(int d) { return d < 0 ? 0 : (d < 127 ? d : 127); }
struct PolMla { int ntiles, qw0, r32, hi;
    __device__ __forceinline__ int key0(int i) const { return 64 * i; }
    __device__ __forceinline__ bool active(int i) const { return 64 * i <= qw0 + 31; }
    __device__ __forceinline__ int nact() const { const int a = (qw0 + 31) / 64 + 1; return a < ntiles ? a : ntiles; }
    __device__ __forceinline__ void fix(f32x16& p0, f32x16& p1, int i) const {
        if (64 * i + 63 > qw0) { const int q = qw0 + r32, kb = 64 * i + 4 * hi;
#pragma unroll
            for (int r = 0; r < 16; ++r) { const int kv = kb + (r & 3) + 8 * (r >> 2); if (kv > q) p0[r] = -INFINITY; if (kv + 32 > q) p1[r] = -INFINITY; } }
    }
};
struct PolSel { int ntiles, qc, q, hi; unsigned selm; const LAS float* tbh;
    __device__ __forceinline__ int key0(int i) const { return 64 * (qc - i); }
    __device__ __forceinline__ bool active(int i) const { return __any((selm >> (qc - i)) & 1u) != 0; }
    __device__ __forceinline__ int nact() const { return ntiles; }
    __device__ __forceinline__ void fix(f32x16& p0, f32x16& p1, int i) const {
        const bool bit = ((selm >> (qc - i)) & 1u) != 0u;
        if (i <= 2) { const int kb = 64 * (qc - i) + 4 * hi; float bv0[16], bv1[16];
#pragma unroll
            for (int r = 0; r < 16; ++r) { const int d0 = q - (kb + (r & 3) + 8 * (r >> 2)); bv0[r] = tbh[clamp127(d0)]; bv1[r] = tbh[clamp127(d0 - 32)]; }
            PIN16(bv0); PIN16(bv1);
#pragma unroll
            for (int r = 0; r < 16; ++r) { const int d0 = q - (kb + (r & 3) + 8 * (r >> 2)), d1 = d0 - 32;
                p0[r] = (d0 < 0) ? -INFINITY : p0[r] + bv0[r]; p1[r] = (d1 < 0) ? -INFINITY : p1[r] + bv1[r]; } }
        if (!bit) {
#pragma unroll
            for (int r = 0; r < 16; ++r) { p0[r] = -INFINITY; p1[r] = -INFINITY; } }
    }
};
struct PolWin { int ntiles, qc, q, hi; const LAS float* tbh;
    __device__ __forceinline__ int key0(int i) const { return 64 * (qc - i); }
    __device__ __forceinline__ bool active(int) const { return true; }
    __device__ __forceinline__ int nact() const { return ntiles; }
    __device__ __forceinline__ void fix(f32x16& p0, f32x16& p1, int i) const {
        if (i <= 2) { const int kb = 64 * (qc - i) + 4 * hi; float bv0[16], bv1[16];
#pragma unroll
            for (int r = 0; r < 16; ++r) { const int d0 = q - (kb + (r & 3) + 8 * (r >> 2)); bv0[r] = tbh[clamp127(d0)]; bv1[r] = tbh[clamp127(d0 - 32)]; }
            PIN16(bv0); PIN16(bv1);
#pragma unroll
            for (int r = 0; r < 16; ++r) { const int d0 = q - (kb + (r & 3) + 8 * (r >> 2)), d1 = d0 - 32;
                p0[r] = (d0 < 0) ? -INFINITY : p0[r] + bv0[r]; p1[r] = (d1 < 0) ? -INFINITY : p1[r] + bv1[r]; } }
        else if (i == 8) { const int kb = 64 * (qc - i) + 4 * hi;
#pragma unroll
            for (int r = 0; r < 16; ++r) { const int d0 = q - (kb + (r & 3) + 8 * (r >> 2)), d1 = d0 - 32; if (d0 >= 512) p0[r] = -INFINITY; if (d1 >= 512) p1[r] = -INFINITY; } }
    }
};

__device__ __forceinline__ void mla_unit(unsigned char* ws, LAS unsigned char* L, int b, int h, int qb, int wv, int s0, int npre, int nnext) {
    asm volatile("" : "+s"(ws));
    const int tid = opaque_tid(wv), lane = tid & 63, wid = __builtin_amdgcn_readfirstlane(tid >> 6);
    const int r32 = lane & 31, hi = lane >> 5;
    const size_t rowbase = (size_t)b * SEQ; const int qw0 = 256 * qb + 32 * wid;
    bf16x8 qr[6];
    { const bf16_t* Qw = (const bf16_t*)(ws + WS_QM) + (rowbase + qw0 + r32) * MQ + 96 * h + 8 * hi;
      bf16x8 raw[6]; float ss = 0.f;
#pragma unroll
      for (int d0 = 0; d0 < 6; ++d0) { raw[d0] = *(const bf16x8*)(Qw + 16 * d0); ss += sq8(raw[d0]); }
      ss += lane_xor(ss, lane, 32);
      const float rstd = QS_MLA / sqrtf(ss * (1.f / 96) + EPS);
      const float* qg = inptr(7) + 8 * hi;
#pragma unroll
      for (int d0 = 0; d0 < 4; ++d0) qr[d0] = __builtin_bit_cast(bf16x8, scale8(raw[d0], rstd, *(const f32x4*)(qg + 16 * d0), *(const f32x4*)(qg + 16 * d0 + 4)));
      float o1[8], o2[8]; const float posf = (float)(qw0 + r32);
#pragma unroll
      for (int j = 0; j < 8; ++j) { const int i = 8 * hi + j; const float inv = exp2f(-(float)i * (13.287712379549449f / 16.f)); float sn, cs; sincosf(posf * inv, &sn, &cs);
          const float n1 = bf2f((unsigned short)raw[4][j]) * rstd * qg[64 + j], n2 = bf2f((unsigned short)raw[5][j]) * rstd * qg[80 + j];
          o1[j] = n1 * cs - n2 * sn; o2[j] = n2 * cs + n1 * sn; }
      u32x4 w4, w5; w4.x = pk2(o1[0], o1[1]); w4.y = pk2(o1[2], o1[3]); w4.z = pk2(o1[4], o1[5]); w4.w = pk2(o1[6], o1[7]);
      w5.x = pk2(o2[0], o2[1]); w5.y = pk2(o2[2], o2[3]); w5.z = pk2(o2[4], o2[5]); w5.w = pk2(o2[6], o2[7]);
      qr[4] = __builtin_bit_cast(bf16x8, w4); qr[5] = __builtin_bit_cast(bf16x8, w5); }
    const bf16_t* Kg = (const bf16_t*)(ws + WS_KMLA) + rowbase * MQ + 96 * h;
    const bf16_t* Vg = (const bf16_t*)(ws + WS_KVM) + rowbase * MKV + slot_base(4 * (h >> 1) + 2 + (h & 1));
    PolMla pol{4 * qb + 4, qw0, r32, hi};
    f32x16 o[2]; float l;
    const NextTiles<96, false, true, PolMla> nxt{Kg, MQ, Vg, MKV, &pol, nnext};
    flash_loop<96, false, true>(L, Kg, MQ, Vg, MKV, qr, pol, s0, npre, nxt, o, l, wid, lane);
    LAS float* wsf = (LAS float*)(L + L_WSF) + wid * 128;
    f32x16 oc[2];
#pragma unroll
    for (int r = 0; r < 16; ++r) { oc[0][r] = 0.f; oc[1][r] = 0.f; }
    acc_scaled(oc, o, (l > 0.f) ? 1.f / l : 0.f, wsf, r32, hi);
    store_tile(oc, (bf16_t*)(ws + WS_MIX) + (rowbase + qw0) * DM + 64 * h, DM, L, wid, lane, (float*)(ws + WS_SSQM) + 2 * (rowbase + qw0));
}

__device__ __forceinline__ void nsa_unit(unsigned char* ws, LAS unsigned char* L, int b, int g, int qc, int wv) {
    asm volatile("" : "+s"(ws));
#define NSA_IDS() const int tid = opaque_tid(wv), lane = tid & 63, wid = __builtin_amdgcn_readfirstlane(tid >> 6); \
    const int r32 = lane & 31, hi = lane >> 5, rh = wid & 3, qh = wid >> 2, h = 4 * g + rh, qloc = 32 * qh + r32, q = q0 + qloc; \
    const unsigned lds0 = (unsigned)(uintptr_t)L; LAS float* wsf = (LAS float*)(L + L_WSF) + wid * 128; const LAS float* tbh = (const LAS float*)(L + L_TB) + h * 128; \
    LAS float* gate = (LAS float*)(L + L_GATE); (void)tid; (void)lane; (void)r32; (void)hi; (void)rh; (void)qh; (void)h; (void)qloc; (void)q; (void)lds0; (void)wsf; (void)tbh; (void)gate
    const size_t rowbase = (size_t)b * SEQ; const int q0 = 64 * qc;
    const bf16_t* pr = (const bf16_t*)(ws + WS_PROJ);
    bf16x8 qr[4];
    {
    NSA_IDS();
    { const bf16_t* Kc = (const bf16_t*)(ws + WS_KCMP) + ((size_t)b * 256 + g) * 64; const bf16_t* Vc = (const bf16_t*)(ws + WS_VCMP) + ((size_t)b * 256 + g) * 64;
      dma_tile<64>(lds0, Kc, 128, Vc, 128, 0, 0, wid, lane);
      dma_tile<64>(lds0, Kc, 128, Vc, 128, 64, 1, wid, lane);
      dma_tile<64, true>(lds0, pr + rowbase * DINP + slot_base(S_KSEL + g), DINP, pr + rowbase * DINP + slot_base(S_VSEL + g), DINP, 64 * qc, 2, wid, lane); }
    for (int i = tid; i < 768; i += 512) { const int br = i >> 8, r = (i >> 6) & 3, qq = i & 63;
        const float x = bf2f(pr[(rowbase + q0 + qq) * DINP + P_GATE + 8 * br + 4 * g + r]); gate[i] = 1.f / (1.f + __expf(-x)); }
    { const bf16_t* Qw = pr + (rowbase + q) * DINP + slot_base(S_Q + h) + 8 * hi;
#pragma unroll
      for (int d0 = 0; d0 < 4; ++d0) qr[d0] = *(const bf16x8*)(Qw + 128 * (d0 >> 1) + 16 * (d0 & 1)); }
    }
    f32x16 oc[2];
    {
        NSA_IDS();
        ATT_BAR();
        lcp vp0 = L + L_V + ((lane >> 4) & 1) * 32 + (lane & 3) * 8 + (4 * hi + ((lane & 15) >> 2)) * 64;
        LAS float* imp = (LAS float*)(L + L_IMP) + (rh * 64 + qloc) * IMPS;
        f32x16 a0, a1, b0, b1;
        { f32x16 zero;
#pragma unroll
          for (int r = 0; r < 16; ++r) zero[r] = 0.f;
          qkt<64>(a0, a1, L + L_K, qr, zero, r32, hi); qkt<64>(b0, b1, L + L_K + KSLOT, qr, zero, r32, hi); }
#define CMP_FIX(P, coff, extra) do { float bv[16]; \
            _Pragma("unroll") for (int r = 0; r < 16; ++r) bv[r] = tbh[clamp127(q - 16 * (crow(r, hi) + (coff)) - 31)]; \
            PIN16(bv); \
            _Pragma("unroll") for (int r = 0; r < 16; ++r) { const int c = crow(r, hi) + (coff); const int d = q - 16 * c - 31; P[r] = (d < 0 || (extra && c >= NCMP)) ? -INFINITY : P[r] + bv[r]; } } while (0)
        { const int qw = q0 + 32 * qh;
          if (qw < 16 * 0 + 640) CMP_FIX(a0, 0, false);
          if (qw < 16 * 32 + 640) CMP_FIX(a1, 32, false);
          if (qw < 16 * 64 + 640) CMP_FIX(b0, 64, false);
          CMP_FIX(b1, 96, true); }
#undef CMP_FIX
        float m = swap_max(__builtin_fmaxf(__builtin_fmaxf(max16(a0), max16(a1)), __builtin_fmaxf(max16(b0), max16(b1))), lane);
        if (m == -INFINITY) m = 0.f;
#pragma unroll
        for (int r = 0; r < 16; ++r) { a0[r] = __builtin_amdgcn_exp2f(a0[r] - m); a1[r] = __builtin_amdgcn_exp2f(a1[r] - m); b0[r] = __builtin_amdgcn_exp2f(b0[r] - m); b1[r] = __builtin_amdgcn_exp2f(b1[r] - m); }
        const float lsum = swap_sum((sum16(a0) + sum16(a1)) + (sum16(b0) + sum16(b1)), lane);
        const float inv = (lsum > 0.f) ? 1.f / lsum : 0.f;
        float prev_last = 0.f;
#define CMP_IMP(T, P0, P1) do { float own[8], car[8]; \
            _Pragma("unroll") for (int a = 0; a < 4; ++a) { \
                own[a]     = P0[4 * a] + P0[4 * a + 1] + P0[4 * a + 2] + 0.5f * P0[4 * a + 3]; car[a]     = 0.5f * P0[4 * a + 3]; \
                own[4 + a] = P1[4 * a] + P1[4 * a + 1] + P1[4 * a + 2] + 0.5f * P1[4 * a + 3]; car[4 + a] = 0.5f * P1[4 * a + 3]; } \
            _Pragma("unroll") for (int k = 0; k < 8; ++k) car[k] = lane_xor(car[k], lane, 32); \
            _Pragma("unroll") for (int k = 0; k < 8; ++k) { const float add = hi ? car[k] : (k >= 1 ? car[k - 1] : prev_last); imp[16 * (T) + 2 * k + hi] = own[k] + add; } \
            prev_last = car[7]; } while (0)
        CMP_IMP(0, a0, a1); CMP_IMP(1, b0, b1);
#undef CMP_IMP
        if (hi == 0) ((LAS float*)(L + L_INVL))[rh * 64 + qloc] = inv;
        f32x16 o[2];
#pragma unroll
        for (int r = 0; r < 16; ++r) { o[0][r] = 0.f; o[1][r] = 0.f; }
        pv(o, vp0, a0, a1); pv(o, vp0 + VSLOT, b0, b1);
        ATT_BAR();
        if (qc >= 1) dma_tile<64, true>(lds0, pr + rowbase * DINP + slot_base(S_KSEL + g), DINP, pr + rowbase * DINP + slot_base(S_VSEL + g), DINP, 64 * (qc - 1), 0, wid, lane);
#pragma unroll
        for (int r = 0; r < 16; ++r) { oc[0][r] = 0.f; oc[1][r] = 0.f; }
        acc_scaled(oc, o, gate[(0 * 4 + rh) * 64 + qloc] * inv, wsf, r32, hi);
    }
    if (qc <= 15) {
        const int tid = opaque_tid(wv);
        if (tid < 64) ((LAS unsigned*)(L + L_SELM))[tid] = (qc == 31) ? 0xffffffffu : ((2u << qc) - 1u);
        ATT_LBAR();
    } else {
        const int tid = opaque_tid(wv);
        const LAS float* imp = (const LAS float*)(L + L_IMP); LAS float* sc = (LAS float*)(L + L_SC);
        const int qq = tid >> 3, jj = tid & 7;
        const LAS float* il = (const LAS float*)(L + L_INVL);
        const float i0 = il[qq], i1 = il[64 + qq], i2 = il[128 + qq], i3 = il[192 + qq];
#pragma unroll
        for (int k = 0; k < 4; ++k) { const int j = jj + 8 * k;
            const float tot = (imp[(0 * 64 + qq) * IMPS + j] * i0 + imp[(1 * 64 + qq) * IMPS + j] * i1) + (imp[(2 * 64 + qq) * IMPS + j] * i2 + imp[(3 * 64 + qq) * IMPS + j] * i3);
            float s; if (j > qc) s = -INFINITY; else if (j == 0 || j == qc || j == qc - 1) s = 1e4f; else s = tot; sc[qq * IMPS + j] = s; }
        ATT_LBAR();
        float v[32];
#pragma unroll
        for (int k = 0; k < 32; ++k) v[k] = sc[qq * IMPS + k];
        unsigned bits = 0u;
#pragma unroll
        for (int k = 0; k < 4; ++k) { const int j = jj + 8 * k; const float me = sc[qq * IMPS + j]; int rank = 0;
#pragma unroll
            for (int i = 0; i < 32; ++i) { const float si = v[i]; rank += (si > me || (si == me && i < j)) ? 1 : 0; }
            if (rank < 16) bits |= 1u << j; }
        { const int lane = tid & 63; bits |= lane_xor_u(bits, lane, 1); bits |= lane_xor_u(bits, lane, 2); bits |= lane_xor_u(bits, lane, 4); }
        if (jj == 0) ((LAS unsigned*)(L + L_SELM))[qq] = bits;
        ATT_LBAR();
    }
    { NSA_IDS(); park_store(oc, (LAS float*)(L + L_OST) + wid * 2048, lane); }
    {
        NSA_IDS();
        const unsigned selm = ((const LAS unsigned*)(L + L_SELM))[qloc];
        const bf16_t* Kg = pr + rowbase * DINP + slot_base(S_KSEL + g);
        const bf16_t* Vg = pr + rowbase * DINP + slot_base(S_VSEL + g);
        PolSel pol{qc + 1, qc, q, hi, selm, tbh};
        const PolWin polw{(qc < 8 ? qc : 8) + 1, qc, q, hi, tbh};
        const NextTiles<64, true, true, PolWin> nxt{pr + rowbase * DINP + slot_base(S_KWIN + g), DINP, pr + rowbase * DINP + slot_base(S_VWIN + g), DINP, &polw, polw.ntiles < 2 ? polw.ntiles : 2};
        f32x16 o[2]; float l;
        flash_loop<64, true>(L, Kg, DINP, Vg, DINP, qr, pol, 2, (qc + 1 < 2) ? qc + 1 : 2, nxt, o, l, wid, lane);
        { f32x16 dummy[2]; park_acc<false>(dummy, (LAS float*)(L + L_OST) + wid * 2048, o, (l > 0.f) ? gate[(1 * 4 + rh) * 64 + qloc] / l : 0.f, wsf, lane); }
    }
    {
        NSA_IDS();
        const bf16_t* Kg = pr + rowbase * DINP + slot_base(S_KWIN + g);
        const bf16_t* Vg = pr + rowbase * DINP + slot_base(S_VWIN + g);
        PolWin pol{(qc < 8 ? qc : 8) + 1, qc, q, hi, tbh};
        f32x16 o[2]; float l;
        flash_loop<64, true>(L, Kg, DINP, Vg, DINP, qr, pol, (2 + qc + 1) % NSLOT, pol.ntiles < 2 ? pol.ntiles : 2, NoNext{}, o, l, wid, lane);
        f32x16 fin[2]; park_acc<true>(fin, (LAS float*)(L + L_OST) + wid * 2048, o, (l > 0.f) ? gate[(2 * 4 + rh) * 64 + qloc] / l : 0.f, wsf, lane);
        store_tile(fin, (bf16_t*)(ws + WS_MIX) + (rowbase + q0 + 32 * qh) * DM + 512 + 64 * h, DM, L, wid, lane, (float*)(ws + WS_SSQM) + 2 * (rowbase + q0 + 32 * qh) + 1);
    }
    ATT_BAR();
}
#undef ATT_BAR
#undef ATT_LBAR
#undef NSA_IDS
}

#define XB_TMO      128
#define XB_XCNT(j)  (256  + 64 * (j))
#define XB_XSUB(j)  (1280 + 64 * (j))
#define XB_XGEN(j)  (2304 + 64 * (j))
#define XB_TOP      3328
#define XB_TOPGEN   3392
#define XCD_BAR_WORDS 3456
#define XB_SPIN_CAP (1u << 18)

__device__ __forceinline__ unsigned xb_ld(unsigned* p)              { return __hip_atomic_load(p, __ATOMIC_RELAXED, __HIP_MEMORY_SCOPE_AGENT); }
__device__ __forceinline__ unsigned xb_add(unsigned* p, unsigned v) { return __hip_atomic_fetch_add(p, v, __ATOMIC_RELAXED, __HIP_MEMORY_SCOPE_AGENT); }
__device__ __forceinline__ unsigned xb_xcc_id() { return (unsigned)__builtin_amdgcn_s_getreg((3 << 11) | 20) & 0xFu; }
#define XB_SPIN(cond, bar) do { unsigned _sp = 0; while (cond) { __builtin_amdgcn_s_sleep(1); \
    if ((++_sp & 255u) == 0u) { if (xb_ld(&(bar)[XB_TMO])) break; if (_sp > XB_SPIN_CAP) { atomicAdd(&(bar)[XB_TMO], 1u); break; } } } } while (0)

struct XcdBarrier {
    unsigned* bar; unsigned x;
    volatile LAS unsigned* st;
};

__device__ __forceinline__ XcdBarrier xcd_barrier_post(unsigned* bar, volatile LAS unsigned* st) {
    XcdBarrier b; b.bar = bar; b.x = xb_xcc_id(); b.st = st;
    if (threadIdx.x == 0) (void)xb_add(&bar[XB_XCNT(b.x)], 1u);
    return b;
}
__device__ __forceinline__ void xcd_barrier_complete(unsigned* bar, unsigned x, unsigned& nloc, unsigned& nx) {
    const unsigned G = gridDim.x * gridDim.y * gridDim.z;
    unsigned sum, cnt, mine, sp = 0u;
    for (;;) {
        sum = 0u; cnt = 0u; mine = 0u;
#pragma unroll
        for (unsigned j = 0; j < 16; ++j) { const unsigned c = xb_ld(&bar[XB_XCNT(j)]); sum += c; cnt += (c > 0u) ? 1u : 0u; mine = (j == x) ? c : mine; }
        if (sum == G) break;
        __builtin_amdgcn_s_sleep(1);
        if ((++sp & 255u) == 0u) { if (xb_ld(&bar[XB_TMO])) break; if (sp > XB_SPIN_CAP) { atomicAdd(&bar[XB_TMO], 1u); break; } }
    }
    nloc = mine > 0u ? mine : 1u; nx = cnt > 0u ? cnt : 1u;
}

__device__ __forceinline__ void xcd_barrier(const XcdBarrier& b, const unsigned char* pf = nullptr, int nchunk = 0, int wv = 0) {
    asm volatile("s_waitcnt vmcnt(0)" ::: "memory");
    __syncthreads();
    if (pf != nullptr && wv >= 1 && wv <= 4) {
        const int t = opaque_tid(wv) - 64;
        const pg8::u32x4* src = (const pg8::u32x4*)pf + (size_t)(blockIdx.x & 255) * nchunk;
        pg8::u32x4 v[9];
#pragma unroll
        for (int i = 0; i < 9; ++i) { int c = i * 256 + t; c = c < nchunk ? c : nchunk - 1; v[i] = src[c]; }
        asm volatile("" :: "v"(v[0]), "v"(v[1]), "v"(v[2]), "v"(v[3]), "v"(v[4]), "v"(v[5]), "v"(v[6]), "v"(v[7]), "v"(v[8]));
    }
    if (threadIdx.x == 0) {
        unsigned* bar = b.bar;
        __builtin_amdgcn_s_waitcnt(0);
        unsigned nloc = b.st[0], nx = b.st[1];
        if (nloc == 0u) { xcd_barrier_complete(bar, b.x, nloc, nx); b.st[0] = nloc; b.st[1] = nx; }
        const unsigned old = xb_add(&bar[XB_XSUB(b.x)], 1u);
        const unsigned gen = old / nloc;
        if (old + 1u == (gen + 1u) * nloc) {
            __builtin_amdgcn_fence(__ATOMIC_RELEASE, "agent");
            asm volatile("s_waitcnt vmcnt(0)" ::: "memory");
            const unsigned og = xb_add(&bar[XB_TOP], 1u);
            const unsigned tg = og / nx;
            if (og + 1u == (tg + 1u) * nx) xb_add(&bar[XB_TOPGEN], 1u);
            else XB_SPIN(xb_ld(&bar[XB_TOPGEN]) == tg, bar);
            __builtin_amdgcn_fence(__ATOMIC_ACQUIRE, "agent");
            xb_add(&bar[XB_XGEN(b.x)], 1u);
            asm volatile("s_waitcnt vmcnt(0)" ::: "memory");
        } else {
            XB_SPIN(xb_ld(&bar[XB_XGEN(b.x)]) == gen, bar);
            __builtin_amdgcn_fence(__ATOMIC_ACQUIRE, "agent");
            asm volatile("s_waitcnt vmcnt(0)" ::: "memory");
        }
    }
    __syncthreads();
}

template <bool RELEASE = false>
__device__ __forceinline__ void group_sync(unsigned* ctl, unsigned* a0, unsigned* a1, unsigned* a2, unsigned* a3, unsigned* w0, unsigned t0, unsigned* w1, unsigned t1, const unsigned char* pf = nullptr, int nchunk = 0, int wv = 0, unsigned* ag = nullptr) {
    asm volatile("s_waitcnt vmcnt(0)" ::: "memory");
    __syncthreads();
    if (pf != nullptr && wv >= 1 && wv <= 4) {
        const int t = opaque_tid(wv) - 64;
        const pg8::u32x4* src = (const pg8::u32x4*)pf + (size_t)(blockIdx.x & 255) * nchunk;
        pg8::u32x4 v[9];
#pragma unroll
        for (int i = 0; i < 9; ++i) { int c = i * 256 + t; c = c < nchunk ? c : nchunk - 1; v[i] = src[c]; }
        asm volatile("" :: "v"(v[0]), "v"(v[1]), "v"(v[2]), "v"(v[3]), "v"(v[4]), "v"(v[5]), "v"(v[6]), "v"(v[7]), "v"(v[8]));
    }
    if (threadIdx.x == 0) {
        if (RELEASE) { __builtin_amdgcn_fence(__ATOMIC_RELEASE, "agent"); asm volatile("s_waitcnt vmcnt(0)" ::: "memory"); }
        (void)xb_add(a0, 1u); if (a1) (void)xb_add(a1, 1u); if (a2) (void)xb_add(a2, 1u); if (a3) (void)xb_add(a3, 1u); if (ag) (void)xb_add(ag, 1u);
        XB_SPIN(xb_ld(w0) < t0, ctl);
        if (w1 != nullptr) XB_SPIN(xb_ld(w1) < t1, ctl);
        __builtin_amdgcn_fence(__ATOMIC_ACQUIRE, "agent");
        asm volatile("s_waitcnt vmcnt(0)" ::: "memory");
    }
    __syncthreads();
}

__global__ void __launch_bounds__(512, 2) mega(Params p) {
    extern __shared__ __attribute__((aligned(16))) unsigned char lds[];
    const int G = gridDim.x, bid = blockIdx.x, NGW = G * NW;
    int wv = __builtin_amdgcn_readfirstlane((int)(threadIdx.x >> 6)); asm volatile("" : "+s"(wv));
#define PHASE_IDS() const int tid = opaque_tid(wv), lane = tid & 63, wave = __builtin_amdgcn_readfirstlane(tid >> 6), gw = bid * NW + wave; (void)tid; (void)lane; (void)gw
    unsigned char* ws = (unsigned char*)inptr(22);
    LAS unsigned char* L = (LAS unsigned char*)lds;
    volatile LAS unsigned* bst = (volatile LAS unsigned*)(L + LDS_BST);
    if (threadIdx.x < 4) bst[threadIdx.x] = 0u;
    __syncthreads();
    (void)xcd_barrier_post((unsigned*)(ws + WS_CTL), bst);
#define bar (XcdBarrier{(unsigned*)((unsigned char*)inptr(22) + WS_CTL), xb_xcc_id(), (volatile LAS unsigned*)((LAS unsigned char*)lds + LDS_BST)})

    {
        PHASE_IDS();
        LAS float* scr = (LAS float*)(L + wave * 8704);
        constexpr int I0 = (1024 / 64) * (DINP / 32), I1 = (QR / 64) * (MQ / 32), I2 = (KVR / 64) * (MKV / 32), I3 = 16 * 32, I4 = 16 * (FF / 32), I5 = (FF / 64) * 32;
        constexpr int I6 = (2048 / 64) * (128 / 32), I7 = (128 / 64) * (64 / 32);
        constexpr int NIT = I0 + I1 + I2 + I3 + I4 + I5 + 2 * I6 + 2 * I7;
        for (int it = gw; it < NIT; it += NGW) {
            int r = it;
            if (r < I0) { p0_transpose_item(inptr(2), 1024, DIN, DINP, (bf16_t*)(ws + WS_WIN), scr, r, lane, inptr(1), 0, 1); continue; } r -= I0;
            if (r < I1) { p0_transpose_item(inptr(5), QR, MQ, MQ, (bf16_t*)(ws + WS_WUQ), scr, r, lane, inptr(3)); continue; } r -= I1;
            if (r < I2) { p0_transpose_item(inptr(6), KVR, MKV, MKV, (bf16_t*)(ws + WS_WUKV), scr, r, lane, inptr(4), 0, 2); continue; } r -= I2;
            if (r < I3) { const int k0_ = 64 * (r / 32); p0_transpose_item(inptr(17), 1024, 1024, 1024, (bf16_t*)(ws + WS_WO), scr, r, lane, k0_ < 512 ? inptr(15) : inptr(16) - 512); continue; } r -= I3;
            if (r < I4) { p0_transpose_item(inptr(19), 1024, FF, FF, (bf16_t*)(ws + WS_WUP), scr, r, lane, inptr(18)); continue; } r -= I4;
            if (r < I5) { p0_transpose_item(inptr(20), FF, 1024, 1024, (bf16_t*)(ws + WS_WDN), scr, r, lane, nullptr, LDH); continue; } r -= I5;
            if (r < 2 * I6) { const int kv = r / I6; p0_transpose_item(inptr(12) + (size_t)kv * 2048 * 128, 2048, 128, 128, (bf16_t*)(ws + WS_W1T) + (size_t)kv * 128 * 2048, scr, r % I6, lane, nullptr, 0, 3); continue; } r -= 2 * I6;
            { const int kv = r / I7; p0_transpose_item(inptr(13) + kv * 128 * 64, 128, 64, 64, (bf16_t*)(ws + WS_W2T) + kv * 64 * 128, scr, r % I7, lane); }
        }
        for (int m = gw; m < M; m += 4 * NGW) rows_to_bf16_rstd<4>(inptr(0), (bf16_t*)(ws + WS_XB), (float*)(ws + WS_RS1), m, NGW, lane);
        for (int e = bid * 512 + tid; e < 2048 * 16; e += G * 512) { const int pos = e >> 4, i = e & 15; const float inv = exp2f(-(float)i * (13.287712379549449f / 16.f)); float sn, cs; sincosf((float)pos * inv, &sn, &cs);
            ((float*)(ws + WS_ROPE))[pos * 32 + i] = cs; ((float*)(ws + WS_ROPE))[pos * 32 + 16 + i] = sn; }
        for (int m = bid * 512 + tid; m < M; m += G * 512) { ((float*)(ws + WS_SSQ2))[m] = 0.f; ((float*)(ws + WS_RSQ))[m] = 0.f; ((float*)(ws + WS_RSKV))[m] = 0.f; ((float*)(ws + WS_SSQKR))[m] = 0.f; ((float*)(ws + WS_SSQM))[2 * m] = 0.f; ((float*)(ws + WS_SSQM))[2 * m + 1] = 0.f; }
    }
    xcd_barrier(bar);
    { pg8::Gemm g{(const bf16_t*)(ws + WS_XB), (const bf16_t*)(ws + WS_WIN), M, DINP, DM, DM, DM}; pg8::StaticOrder S; S.init(M, DINP, G, bid);
      PEpiProj E{(bf16_t*)(ws + WS_PROJ), DINP, (const float*)(ws + WS_RS1), (float*)(ws + WS_RSQ), (float*)(ws + WS_RSKV), (float*)(ws + WS_SSQKR), inptr(9), inptr(10), (const float*)(ws + WS_ROPE), inptr(8)}; pg8::gemm_phase<PEpiProj, pg8::StaticOrder, true, true>(L, g, S, E, wv); }
#define GCTL ((unsigned*)((unsigned char*)inptr(22) + WS_CTL))
#define GCNT(sp, pm) (GCTL + 4096 + ((sp) * 64 + (pm)) * 16)
    if (G == 256) { const int x_ = bid & 7, jj_ = (bid >> 3) & 7, k_ = bid >> 6;
        unsigned* c_ = GCNT(0, 8 * x_ + jj_); group_sync(GCTL, c_, nullptr, nullptr, nullptr, c_, 4u, ((k_ & 1) && jj_ < 7) ? GCNT(0, 8 * x_ + jj_ + 1) : nullptr, 4u); }
    else xcd_barrier(bar);
    { PHASE_IDS();
      __syncthreads();
      if (G == 256) { const int x_ = bid & 7, jj_ = (bid >> 3) & 7, k_ = bid >> 6; compress_block(ws, L, (2 * jj_ + (k_ & 1)) | (x_ << 4) | ((k_ >> 1) << 7), wv); }
      else for (int t = bid; t < 256; t += G) compress_block(ws, L, t, wv); }
    { pg8::Gemm g{(const bf16_t*)(ws + WS_PROJ) + P_HKV, (const bf16_t*)(ws + WS_WUKV), M, MKV, KVR, DINP, KVR}; pg8::StaticOrder S; S.init(M, MKV, G, bid);
      PEpiKV E{(bf16_t*)(ws + WS_KVM), (bf16_t*)(ws + WS_KMLA), (const bf16_t*)(ws + WS_PROJ), (const float*)(ws + WS_RSKV), (const float*)(ws + WS_SSQKR), (const float*)(ws + WS_ROPE), inptr(8)}; pg8::gemm_phase<PEpiKV, pg8::StaticOrder, true, true>(L, g, S, E, wv); }
    asm volatile("" : "+s"(wv));
    { pg8::Gemm g{(const bf16_t*)(ws + WS_PROJ) + P_HQ, (const bf16_t*)(ws + WS_WUQ), M, MQ, QR, DINP, QR}; pg8::StaticOrder S; S.init(M, MQ, G, bid);
      PEpiBf16<0> E{(bf16_t*)(ws + WS_QM), MQ, (const float*)(ws + WS_RSQ), 1.f / QR, nullptr}; pg8::gemm_phase<PEpiBf16<0>, pg8::StaticOrder, true, false>(L, g, S, E, wv); }
    if (G == 256) { unsigned* c_ = GCNT(3, bid & 7); group_sync<true>(GCTL, c_, nullptr, nullptr, nullptr, c_, 32u, nullptr, 0u); }
    else xcd_barrier(bar);
    {
        PHASE_IDS();
        LAS float* tb = (LAS float*)L;
        for (int i = tid; i < 8 * 128; i += 512) { const int h = i >> 7, n = i & 127; tb[i] = (inptr(14)[t5_bucket(n) * 8 + h] - inptr(14)[31 * 8 + h]) * LOG2E; }
        __syncthreads();
        const int vcu = (G % 8 == 0) ? (bid % 8) * (G / 8) + bid / 8 : bid;
        for (int pr_ = vcu; pr_ < 256; pr_ += G) {
            { const int bg = pr_ >> 4, s_ = pr_ & 15;
#pragma unroll 1
              for (int u_ = 0; u_ < 2; ++u_) att::nsa_unit(ws, L, bg >> 1, bg & 1, (u_ & 1) ? s_ : 31 - s_, wv);
            }
            { const int bh = pr_ >> 2, s_ = pr_ & 3;
#pragma unroll 1
              for (int u_ = 0; u_ < 2; ++u_) att::mla_unit(ws, L, bh >> 3, bh & 7, u_ ? s_ : 7 - s_, wv, u_ ? (4 * (7 - s_) + 4) % att::NSLOT : 0, u_ ? 2 : 0, u_ ? 0 : 2);
            }
        }
    }
    if (G == 256) { const int x_ = bid & 7, j_ = bid >> 3, sn_ = j_ & 15, sm_ = j_ & 3;
        group_sync(GCTL, GCNT(4, 8 * x_ + ((31 - sn_) >> 2)), GCNT(4, 8 * x_ + (sn_ >> 2)), GCNT(4, 8 * x_ + 7 - sm_), GCNT(4, 8 * x_ + sm_), GCNT(4, 8 * x_ + (j_ & 7)), 16u, nullptr, 0u, ws + WS_WO, (int)((size_t)DM * DM * 2 / 16 / 256), wv, GCTL + 4096 + 5 * 64 * 16); }
    else xcd_barrier(bar, ws + WS_WO, (int)((size_t)DM * DM * 2 / 16 / 256), wv);
    { pg8::Gemm g{(const bf16_t*)(ws + WS_MIX), (const bf16_t*)(ws + WS_WO), M, DM, DM, DM, DM}; pg8::StaticOrder S; S.init(M, DM, G, bid);
      PEpiWo E{(const bf16_t*)(ws + WS_XB), (bf16_t*)(ws + WS_H2), (float*)(ws + WS_SSQ2), (const float*)(ws + WS_SSQM), DM, (G == 256) ? GCTL + 4096 + 5 * 64 * 16 : nullptr};
      pg8::gemm_phase<PEpiWo, pg8::StaticOrder, true, true>(L, g, S, E, wv); }
    if (G == 256) { unsigned* c_ = GCNT(1, 8 * (bid & 7) + ((bid >> 3) & 7)); group_sync(GCTL, c_, nullptr, nullptr, nullptr, c_, 4u, nullptr, 0u, ws + WS_WUP, (int)((size_t)FF * DM * 2 / 16 / 256), wv, GCTL + 4096 + 5 * 64 * 16 + 16); }
    else xcd_barrier(bar, ws + WS_WUP, (int)((size_t)FF * DM * 2 / 16 / 256), wv);
    { pg8::Gemm g{(const bf16_t*)(ws + WS_H2), (const bf16_t*)(ws + WS_WUP), M, FF, DM, DM, DM}; pg8::StaticOrder S; S.init(M, FF, G, bid);
      PEpiBf16<2> E{(bf16_t*)(ws + WS_HID), LDH, (const float*)(ws + WS_SSQ2), 1.f / 1024, (G == 256) ? GCTL + 4096 + 5 * 64 * 16 + 16 : nullptr};
      pg8::gemm_phase<PEpiBf16<2>, pg8::StaticOrder, true, true>(L, g, S, E, wv); }
    if (G == 256) { unsigned* c_ = GCNT(2, 8 * (bid & 7) + ((bid >> 3) & 7)); group_sync(GCTL, c_, nullptr, nullptr, nullptr, c_, 4u, nullptr, 0u, ws + WS_WDN, (int)((size_t)DM * LDH * 2 / 16 / 256), wv); }
    else xcd_barrier(bar, ws + WS_WDN, (int)((size_t)DM * LDH * 2 / 16 / 256), wv);
    { pg8::Gemm g{(const bf16_t*)(ws + WS_HID), (const bf16_t*)(ws + WS_WDN), M, DM, FF, LDH, LDH}; pg8::StaticOrder S; S.init(M, DM, G, bid);
      PEpiDown E{(const bf16_t*)(ws + WS_H2), ((float*)inptr(21)), DM}; pg8::gemm_phase<PEpiDown, pg8::StaticOrder, true, true>(L, g, S, E, wv); }
#undef bar
}

extern "C" void kernel_launch(void* const* d_in, const int* in_sizes, int n_in, void* d_out, int out_size,
                              void* d_ws, size_t ws_size, hipStream_t stream) {
    static int grid_blocks = 0;
    if (!grid_blocks) {
        int dev = 0, cus = 0, per_cu = 0;
        (void)hipGetDevice(&dev);
        (void)hipDeviceGetAttribute(&cus, hipDeviceAttributeMultiprocessorCount, dev);
        (void)hipFuncSetAttribute((const void*)mega, hipFuncAttributeMaxDynamicSharedMemorySize, LDS_BYTES);
        (void)hipOccupancyMaxActiveBlocksPerMultiprocessor(&per_cu, (const void*)mega, 512, LDS_BYTES);
        if (per_cu != 1) fprintf(stderr, "note: occupancy query reports %d blocks/CU; launching 1 per CU\n", per_cu);
        grid_blocks = cus;
        if (n_in != 21 || out_size != M * DM || ws_size < 256 * MiB) fprintf(stderr, "unexpected shapes: n_in %d out %d ws %zu\n", n_in, out_size, ws_size);
    }
    Params p{};
    for (int i = 0; i < 21; ++i) p.in[i] = (const float*)d_in[i];
    p.out = (float*)d_out; p.ws = (unsigned char*)d_ws;
    if (hipMemsetAsync((char*)d_ws + WS_CTL, 0, CTL_ZERO_BYTES, stream) != hipSuccess) { fprintf(stderr, "memset of the barrier words failed\n"); return; }
    hipLaunchKernelGGL(mega, dim3(grid_blocks), dim3(512), LDS_BYTES, stream, p);
    hipError_t e = hipPeekAtLastError();
    if (e != hipSuccess) fprintf(stderr, "launch failed: %s (grid %d)\n", hipGetErrorString(e), grid_blocks);
}
```
